# Optimizing an MI355X kernel written in HIP

```python
import math
import jax
import jax.numpy as jnp
from jax import lax
import numpy as np

D_MODEL = 2048
BATCH = 4
SEQ = 2048
DEPTH = 2

CTX_LEN = 256
GRID_W = 64
EPS = 1e-6
N_BRANCH = 3

POOL_WINDOWS = (2, 4, 8, 16)
POOL_WIDTH = D_MODEL // 2
POOL_GROUP = POOL_WIDTH // len(POOL_WINDOWS)

DIFF_HEADS = 8
DIFF_HEAD_DIM = 64
DIFF_VDIM = 2 * DIFF_HEAD_DIM
DIFF_WIDTH = DIFF_HEADS * DIFF_VDIM
ROPE_THETA = 10000.0
Q_BLOCK = 128

GLA_HEADS = 4
GLA_DV = D_MODEL // 2 // GLA_HEADS
GLA_DK = GLA_DV // 2
GLA_KW = GLA_HEADS * GLA_DK
GLA_VW = GLA_HEADS * GLA_DV
GLA_RANK = 16
GLA_NORMALIZER = 16.0
GLA_CHUNK = 64

IN_SIZES = (POOL_WIDTH, POOL_WIDTH,
            DIFF_WIDTH, DIFF_WIDTH, DIFF_WIDTH, DIFF_WIDTH,
            GLA_KW, GLA_KW, GLA_VW, GLA_VW,
            GLA_RANK, GLA_RANK,
            N_BRANCH * D_MODEL)
D_IN = sum(IN_SIZES)

kernel_name = "hybrid_pool_diffattn_gla_prefix_block"


def split_in(z):
    idx = np.cumsum(IN_SIZES)[:-1].tolist()
    return jnp.split(z, idx, axis=-1)


def rms_norm(x, gain):
    xf = x.astype(jnp.float32)
    y = xf * lax.rsqrt(jnp.mean(xf * xf, axis=-1, keepdims=True) + EPS)
    return (y * gain.astype(jnp.float32)).astype(x.dtype)


def axial_rope(rows, cols):
    n_freq = DIFF_HEAD_DIM // 4
    inv = ROPE_THETA ** (-jnp.arange(n_freq, dtype=jnp.float32) / n_freq)
    ang = jnp.concatenate([rows.astype(jnp.float32)[:, None] * inv,
                           cols.astype(jnp.float32)[:, None] * inv], axis=-1)
    return jnp.cos(ang), jnp.sin(ang)


def apply_rope(t, cos, sin):
    half = DIFF_HEAD_DIM // 2
    tf = t.astype(jnp.float32)
    t1, t2 = tf[..., :half], tf[..., half:]
    cs = cos[None, :, None, None, :]
    sn = sin[None, :, None, None, :]
    return jnp.concatenate([t1 * cs - t2 * sn, t2 * cs + t1 * sn], axis=-1).astype(t.dtype)


def pool_mix(u, w_grp, scale):
    B, L, _ = u.shape
    uf = u.astype(jnp.float32)
    cs = jnp.concatenate([jnp.zeros_like(uf[:, :1]), jnp.cumsum(uf, axis=1)], axis=1)
    t = jnp.arange(L)
    groups = []
    for gi, w in enumerate(POOL_WINDOWS):
        sl = slice(gi * POOL_GROUP, (gi + 1) * POOL_GROUP)
        hi = jnp.clip(t + w // 2, 0, L)
        lo = jnp.clip(t - w // 2, 0, L)
        cnt = (hi - lo).astype(jnp.float32)[None, :, None]
        mean = (cs[:, hi, sl] - cs[:, lo, sl]) / cnt
        groups.append(mean - uf[:, :, sl])
    d = jnp.stack(groups, axis=2)
    y = jnp.einsum('blgc,gcd->blgd', d, w_grp.astype(jnp.float32)).reshape(B, L, POOL_WIDTH)
    return (y * scale.astype(jnp.float32)).astype(u.dtype)


def diff_attend(q, k, v, lam):
    s = jnp.einsum('bqhjd,bkhjd->bhjqk', q, k).astype(jnp.float32) * DIFF_HEAD_DIM ** -0.5
    p = jax.nn.softmax(s, axis=-1)
    a = p[:, :, 0] - lam * p[:, :, 1]
    return jnp.einsum('bhqk,bkhe->bqhe', a.astype(v.dtype), v)


def diff_post(o, subln, lambda_init):
    B, L = o.shape[:2]
    return (rms_norm(o, subln) * (1.0 - lambda_init)).reshape(B, L, DIFF_WIDTH)


def gla_log_decay(lr, w2, b):
    return jax.nn.log_sigmoid((lr @ w2 + b).astype(jnp.float32)) / GLA_NORMALIZER


def gla_chunk_scan(q, k, v, g, s0):
    B, L, H, _ = q.shape
    n = L // GLA_CHUNK
    C = GLA_CHUNK

    def chunks(t):
        return jnp.moveaxis(t.reshape(B, n, C, H, t.shape[-1]), 1, 0)

    lower = jnp.tril(jnp.ones((C, C), dtype=bool))[None, :, :, None, None]

    def step(s, inp):
        qc, kc, vc, gc = inp
        b = jnp.cumsum(gc, axis=1)
        o = jnp.einsum('bthk,bhkv->bthv', qc * jnp.exp(b), s)
        rel = jnp.exp(jnp.where(lower, b[:, :, None] - b[:, None], -jnp.inf))
        att = jnp.einsum('bthk,btshk,bshk->bhts', qc, rel, kc)
        o = o + jnp.einsum('bhts,bshv->bthv', att, vc)
        b_last = b[:, -1]
        s = s * jnp.exp(b_last)[..., None] + jnp.einsum(
            'bshk,bshv->bhkv', kc * jnp.exp(b_last[:, None] - b), vc)
        return s, o

    s, o = lax.scan(step, s0, (chunks(q), chunks(k), chunks(v), chunks(g)))
    return jnp.moveaxis(o, 0, 1).reshape(B, L, H, v.shape[-1]), s


def gla_final_state(k, v, g):
    b = jnp.cumsum(g, axis=1)
    return jnp.einsum('blhk,blhv->bhkv', k * jnp.exp(b[:, -1:] - b), v)


def gla_post(o, gain, gate):
    B, L = o.shape[:2]
    return rms_norm(o, gain).reshape(B, L, GLA_VW).astype(gate.dtype) * jax.nn.silu(gate)


def flip(t):
    return jnp.flip(t, axis=1)


def merge_branches(pool_o, diff_o, gla_o, mg, wbp, wbd, wbg, w_out):
    gp, gd, gg = jnp.split(jax.nn.sigmoid(mg), N_BRANCH, axis=-1)
    y = gp * (pool_o @ wbp) + gd * (diff_o @ wbd) + gg * (gla_o @ wbg)
    return y @ w_out


def hybrid_layer(x, ctx, c, c_ctx, cos, sin, norm_g, w_ada, b_ada, w_in, pool_w, pool_scale,
                 q_norm, k_norm, lam_q1, lam_k1, lam_q2, lam_k2, subln,
                 wgf, bgf, wgb, bgb, gla_norm, wbp, wbd, wbg, w_out,
                 lambda_init, need_ctx_out):
    B, L, _ = x.shape
    Lc = ctx.shape[1]
    shift, scale, gate = jnp.split(jax.nn.silu(c) @ w_ada + b_ada, 3, axis=-1)
    shift_c, scale_c, gate_c = jnp.split(jax.nn.silu(c_ctx) @ w_ada + b_ada, 3, axis=-1)
    h = rms_norm(x, norm_g) * (1.0 + scale[:, None]) + shift[:, None]
    hc = rms_norm(ctx, norm_g) * (1.0 + scale_c) + shift_c
    (pu, pg, dq, dk, dv, dg, gq, gk, gv, gg, glf, glb, mg) = split_in(h @ w_in)
    (pu_c, pg_c, dq_c, dk_c, dv_c, dg_c, gq_c, gk_c, gv_c, gg_c, glf_c, glb_c, mg_c) = split_in(hc @ w_in)

    pool_l = pool_mix(pu, pool_w, pool_scale) * jax.nn.silu(pg)

    def qk_heads(t, gain):
        return rms_norm(t.reshape(t.shape[0], t.shape[1], DIFF_HEADS, 2, DIFF_HEAD_DIM), gain)

    lam = (jnp.exp(jnp.sum(lam_q1.astype(jnp.float32) * lam_k1.astype(jnp.float32)))
           - jnp.exp(jnp.sum(lam_q2.astype(jnp.float32) * lam_k2.astype(jnp.float32)))
           + lambda_init)
    q_l = apply_rope(qk_heads(dq, q_norm), cos, sin)
    k_l = apply_rope(qk_heads(dk, k_norm), cos, sin)
    v_l = dv.reshape(B, L, DIFF_HEADS, DIFF_VDIM)
    k_c = qk_heads(dk_c, k_norm)
    v_c = dv_c.reshape(B, Lc, DIFF_HEADS, DIFF_VDIM)
    k_all = jnp.concatenate([k_c, k_l], axis=1)
    v_all = jnp.concatenate([v_c, v_l], axis=1)
    nb = L // Q_BLOCK
    qb = jnp.swapaxes(q_l.reshape(B, nb, Q_BLOCK, DIFF_HEADS, 2, DIFF_HEAD_DIM), 0, 1)
    o_l = lax.map(lambda qq: diff_attend(qq, k_all, v_all, lam), qb)
    o_l = jnp.swapaxes(o_l, 0, 1).reshape(B, L, DIFF_HEADS, DIFF_VDIM)
    diff_l = diff_post(o_l, subln, lambda_init) * jax.nn.silu(dg)

    def gla_inputs(tq, tk, tv, tlf, tlb):
        n = tq.shape[1]
        q_ = (tq.astype(jnp.float32) * GLA_DK ** -0.5).reshape(B, n, GLA_HEADS, GLA_DK)
        k_ = tk.astype(jnp.float32).reshape(B, n, GLA_HEADS, GLA_DK)
        v_ = tv.astype(jnp.float32).reshape(B, n, GLA_HEADS, GLA_DV)
        gf_ = gla_log_decay(tlf, wgf, bgf).reshape(B, n, GLA_HEADS, GLA_DK)
        gb_ = gla_log_decay(tlb, wgb, bgb).reshape(B, n, GLA_HEADS, GLA_DK)
        return q_, k_, v_, gf_, gb_

    ql, kl, vl, gfl, gbl = gla_inputs(gq, gk, gv, glf, glb)
    qc, kc, vc, gfc, gbc = gla_inputs(gq_c, gk_c, gv_c, glf_c, glb_c)
    s0 = jnp.zeros((B, GLA_HEADS, GLA_DK, GLA_DV), jnp.float32)
    if need_ctx_out:
        oc_f, s_f = gla_chunk_scan(qc, kc, vc, gfc, s0)
        oc_b, s_b = gla_chunk_scan(flip(qc), flip(kc), flip(vc), flip(gbc), s0)
        gla_c = gla_post(oc_f + flip(oc_b), gla_norm, gg_c)
    else:
        s_f = gla_final_state(kc, vc, gfc)
        s_b = gla_final_state(flip(kc), flip(vc), flip(gbc))
    ol_f, _ = gla_chunk_scan(ql, kl, vl, gfl, s_f)
    ol_b, _ = gla_chunk_scan(flip(ql), flip(kl), flip(vl), flip(gbl), s_b)
    gla_l = gla_post(ol_f + flip(ol_b), gla_norm, gg)

    x_new = x + gate[:, None] * merge_branches(pool_l, diff_l, gla_l, mg, wbp, wbd, wbg, w_out)
    if need_ctx_out:
        pool_c = pool_mix(pu_c, pool_w, pool_scale) * jax.nn.silu(pg_c)
        q_c = qk_heads(dq_c, q_norm)
        o_c = diff_attend(q_c, k_c, v_c, lam)
        diff_c = diff_post(o_c, subln, lambda_init) * jax.nn.silu(dg_c)
        ctx_new = ctx + gate_c * merge_branches(pool_c, diff_c, gla_c, mg_c, wbp, wbd, wbg, w_out)
    else:
        ctx_new = ctx
    return x_new, ctx_new


def setup_inputs(seed: int = 0) -> dict:
    key = jax.random.key(seed)
    ks = jax.random.split(key, 32)
    D = D_MODEL
    NL = DEPTH

    def nrm(k, shape, s):
        return jax.random.normal(k, shape, jnp.float32) * s

    return {
        "x": nrm(ks[0], (BATCH, SEQ, D), 1.0),
        "c": nrm(ks[1], (BATCH, D), 1.0),
        "ctx": nrm(ks[2], (BATCH, CTX_LEN, D), 1.0),
        "c_ctx": nrm(ks[3], (D,), 1.0),
        "norm_g": 1.0 + nrm(ks[4], (NL, D), 0.02),
        "w_ada": nrm(ks[5], (NL, D, 3 * D), 0.5 * D ** -0.5),
        "b_ada": nrm(ks[6], (NL, 3 * D), 0.01),
        "w_in": nrm(ks[7], (NL, D, D_IN), D ** -0.5),
        "pool_w": nrm(ks[8], (NL, len(POOL_WINDOWS), POOL_GROUP, POOL_GROUP), POOL_GROUP ** -0.5),
        "pool_scale": 1.0 + nrm(ks[9], (NL, POOL_WIDTH), 0.02),
        "diff_q_norm": 1.0 + nrm(ks[10], (NL, DIFF_HEAD_DIM), 0.02),
        "diff_k_norm": 1.0 + nrm(ks[11], (NL, DIFF_HEAD_DIM), 0.02),
        "diff_lam_q1": nrm(ks[12], (NL, DIFF_HEAD_DIM), 0.1),
        "diff_lam_k1": nrm(ks[13], (NL, DIFF_HEAD_DIM), 0.1),
        "diff_lam_q2": nrm(ks[14], (NL, DIFF_HEAD_DIM), 0.1),
        "diff_lam_k2": nrm(ks[15], (NL, DIFF_HEAD_DIM), 0.1),
        "diff_subln": 1.0 + nrm(ks[16], (NL, DIFF_VDIM), 0.02),
        "gla_w_gate_f": nrm(ks[17], (NL, GLA_RANK, GLA_KW), GLA_RANK ** -0.5),
        "gla_b_gate_f": nrm(ks[18], (NL, GLA_KW), 0.01),
        "gla_w_gate_b": nrm(ks[19], (NL, GLA_RANK, GLA_KW), GLA_RANK ** -0.5),
        "gla_b_gate_b": nrm(ks[20], (NL, GLA_KW), 0.01),
        "gla_norm": 1.0 + nrm(ks[21], (NL, GLA_DV), 0.02),
        "w_branch_pool": nrm(ks[22], (NL, POOL_WIDTH, D), POOL_WIDTH ** -0.5),
        "w_branch_diff": nrm(ks[23], (NL, DIFF_WIDTH, D), DIFF_WIDTH ** -0.5),
        "w_branch_gla": nrm(ks[24], (NL, GLA_VW, D), GLA_VW ** -0.5),
        "w_out": nrm(ks[25], (NL, D, D), D ** -0.5),
    }


def reference(x, c, ctx, c_ctx, norm_g, w_ada, b_ada, w_in, pool_w, pool_scale,
              diff_q_norm, diff_k_norm, diff_lam_q1, diff_lam_k1, diff_lam_q2, diff_lam_k2,
              diff_subln, gla_w_gate_f, gla_b_gate_f, gla_w_gate_b, gla_b_gate_b, gla_norm,
              w_branch_pool, w_branch_diff, w_branch_gla, w_out):
    L = x.shape[1]
    ROWS = L // GRID_W
    rows = jnp.repeat(jnp.arange(ROWS), GRID_W)
    cols = jnp.tile(jnp.arange(GRID_W), ROWS)
    cos, sin = axial_rope(rows, cols)
    for l in range(DEPTH):
        lambda_init = 0.8 - 0.6 * math.exp(-0.3 * l)
        x, ctx = hybrid_layer(
            x, ctx, c, c_ctx, cos, sin, norm_g[l], w_ada[l], b_ada[l], w_in[l],
            pool_w[l], pool_scale[l], diff_q_norm[l], diff_k_norm[l],
            diff_lam_q1[l], diff_lam_k1[l], diff_lam_q2[l], diff_lam_k2[l], diff_subln[l],
            gla_w_gate_f[l], gla_b_gate_f[l], gla_w_gate_b[l], gla_b_gate_b[l], gla_norm[l],
            w_branch_pool[l], w_branch_diff[l], w_branch_gla[l], w_out[l],
            lambda_init, l < DEPTH - 1)
    return x
```

```cpp
#include <hip/hip_runtime.h>
#include <hip/hip_cooperative_groups.h>
#include <cstdio>
#include <cstdint>
namespace cg = cooperative_groups;

#ifndef MK_N_LAUNCHES
#define MK_N_LAUNCHES 1
#endif

#define LAS __attribute__((address_space(3)))
typedef unsigned short bf16_t;
typedef short bf16x8 __attribute__((ext_vector_type(8)));
typedef float f32x4 __attribute__((ext_vector_type(4)));
typedef float f32x16 __attribute__((ext_vector_type(16)));
typedef unsigned u32x4 __attribute__((ext_vector_type(4)));
typedef unsigned u32x2 __attribute__((ext_vector_type(2)));

constexpr int DM = 2048, NB = 4, SEQ = 2048, LC = 256, ML = NB * SEQ, MC = NB * LC, MT = ML + MC;
constexpr int DIN = 15392, NZ = 15616;
constexpr int ZC_PU = 0, ZC_PG = 1024, ZC_DQ = 2048, ZC_DK = 3072, ZC_DV = 4096, ZC_DG = 5120, ZC_GQ = 6144, ZC_GK = 6656, ZC_GV = 7168, ZC_GG = 8192, ZC_LR = 9216, ZC_MG = 9472;
constexpr int LK = LC + SEQ;
constexpr float EPS = 1e-6f, LOG2E = 1.4426950408889634f;
constexpr int NPH = 15;

constexpr size_t SZ_WIN = (size_t)NZ * DM * 2, SZ_WB = (size_t)3 * DM * 1024 * 2, SZ_WOUT = (size_t)DM * DM * 2, SZ_POOLT = (size_t)4 * 256 * 256 * 2;
constexpr size_t OFF_WIN = 0;
constexpr size_t OFF_WB = OFF_WIN + 2 * SZ_WIN;
constexpr size_t OFF_WOUT = OFF_WB + 2 * SZ_WB;
constexpr size_t OFF_POOLT = OFF_WOUT + 2 * SZ_WOUT;
constexpr size_t OFF_MOD = OFF_POOLT + 2 * SZ_POOLT;
constexpr size_t OFF_SCAL = OFF_MOD + (size_t)2 * 5 * 6144 * 4;
constexpr size_t OFF_H = OFF_SCAL + 256;
constexpr size_t OFF_Z = OFF_H + (size_t)MT * DM * 2;
constexpr size_t OFF_QN = OFF_Z + (size_t)MT * NZ * 2;
constexpr size_t OFF_QNC = OFF_QN + (size_t)ML * 1024 * 2;
constexpr size_t OFF_KN = OFF_QNC + (size_t)MC * 1024 * 2;
constexpr size_t OFF_VT = OFF_KN + (size_t)MT * 1024 * 2;
constexpr size_t SZ_G = (size_t)MT * 512 * 2;
constexpr size_t OFF_GQ = OFF_VT + (size_t)MT * 1024 * 2;
constexpr size_t OFF_GK = OFF_GQ + 2 * SZ_G;
constexpr size_t OFF_GH = OFF_GK + 2 * SZ_G;
constexpr size_t OFF_DEC = OFF_GH + 2 * SZ_G;
constexpr size_t OFF_OF = OFF_DEC + (size_t)2 * 144 * 512 * 4;
constexpr size_t OFF_DPOOL = OFF_OF + 2 * (size_t)MT * 1024 * 2;
constexpr size_t OFF_POOLO = OFF_DPOOL + (size_t)MT * 1024 * 2;
constexpr size_t OFF_DIFFO = OFF_POOLO + (size_t)MT * 1024 * 2;
constexpr size_t OFF_GLAO = OFF_DIFFO + (size_t)MT * 1024 * 2;
constexpr size_t OFF_YACC = OFF_GLAO + (size_t)MT * 1024 * 2;
constexpr size_t OFF_X1 = OFF_YACC + (size_t)MT * DM * 4;
constexpr size_t OFF_PGATE = OFF_X1 + (size_t)MT * DM * 4;
constexpr size_t WS_END = OFF_PGATE + (size_t)MT * 1024 * 2;

constexpr int LDS_BYTES = 135168;

#define BID opaque_s((int)blockIdx.x)
__device__ __forceinline__ unsigned char* opaque_ptr(unsigned char* p) { asm volatile("" : "+s"(p)); return p; }
__device__ __forceinline__ int opaque_s(int v) { asm volatile("" : "+s"(v)); return v; }
__device__ __forceinline__ int opaque_tid() { int t = threadIdx.x; asm volatile("" : "+v"(t)); return t; }
typedef float f32x2_t __attribute__((ext_vector_type(2))); typedef __bf16 bf16x2_t __attribute__((ext_vector_type(2)));
__device__ __forceinline__ unsigned cvt_pk_bf16(float lo, float hi) { f32x2_t v = {lo, hi}; bf16x2_t b = __builtin_convertvector(v, bf16x2_t); return __builtin_bit_cast(unsigned, b); }
__device__ __forceinline__ bf16_t f2bf(float f) { return (bf16_t)(cvt_pk_bf16(f, 0.f) & 0xffffu); }
__device__ __forceinline__ float bf2f(bf16_t v) { return __builtin_bit_cast(float, (unsigned)v << 16); }
__device__ __forceinline__ float bflo(unsigned u) { return __builtin_bit_cast(float, u << 16); }
__device__ __forceinline__ float bfhi(unsigned u) { return __builtin_bit_cast(float, u & 0xffff0000u); }
__device__ __forceinline__ float silu_f(float x) { return x / (1.f + __expf(-x)); }
__device__ __forceinline__ float sigmoid_f(float x) { return 1.f / (1.f + __expf(-x)); }
__device__ __forceinline__ float logsig_f(float a) { return fminf(a, 0.f) - log1pf(__expf(-fabsf(a))); }
__device__ __forceinline__ float wave_sum(float v) {
#pragma unroll
    for (int o = 1; o < 64; o <<= 1) v += __shfl_xor(v, o);
    return v;
}
__device__ __forceinline__ float wave_max(float v) {
#pragma unroll
    for (int o = 1; o < 64; o <<= 1) v = fmaxf(v, __shfl_xor(v, o));
    return v;
}
__device__ __forceinline__ void unpack8(u32x4 w, float* f) { f[0] = bflo(w.x); f[1] = bfhi(w.x); f[2] = bflo(w.y); f[3] = bfhi(w.y); f[4] = bflo(w.z); f[5] = bfhi(w.z); f[6] = bflo(w.w); f[7] = bfhi(w.w); }

namespace pg8 {
constexpr int BM = 256, BK = 64, HALF = 128, HTB = HALF * BK * 2, STAGE_BYTES = 8 * HTB, NXCD = 8, WGM = 8;
__host__ __device__ __forceinline__ int lds_byte(int r, int c) { const int st = (r >> 4) * 2 + (c >> 5), rr = r & 15, cc = c & 31, ob = rr * 64 + cc * 2; return st * 1024 + (ob ^ (((ob >> 9) & 1) << 5)); }
__host__ __device__ __forceinline__ void stage_rc(int b, int& R, int& C) { const int st = b / 1024, sb = b % 1024, swz = sb ^ (((sb >> 9) & 1) << 5); R = (st >> 1) * 16 + swz / 64; C = (st & 1) * 32 + (swz % 64) / 2; }
__host__ __device__ __forceinline__ int perm32(int rho) { const int n = rho >> 4, i = rho & 15; return 8 * (i >> 2) + 4 * n + (i & 3); }

struct Unit { int pm, pn; };
struct Gemm { const bf16_t* A; const bf16_t* Bt; int M, N, K; int lda, ldb; int a_pn_off; };

struct StaticOrder {
    int nM, nN, nwg, G, c;
    __host__ __device__ void init(int M, int N, int G_, int c_) { nM = M / BM; nN = N / BM; nwg = nM * nN; G = G_; c = c_; }
    __host__ __device__ bool next(int i, Unit& u) const {
        const long L = (long)i * G + c; if (L >= nwg) return false;
        int wgid = (int)L; { const int q = nwg / NXCD, r = nwg % NXCD, xcd = wgid % NXCD, off = wgid / NXCD; wgid = (xcd < r ? xcd * (q + 1) : r * (q + 1) + (xcd - r) * q) + off; }
        const int nig = WGM * nN, gid = wgid / nig, fm = gid * WGM, gsz = (nM - fm) < WGM ? (nM - fm) : WGM;
        u.pm = fm + ((wgid % nig) % gsz); u.pn = (wgid % nig) / gsz; return true;
    }
    __device__ __forceinline__ void a_ready(const Unit&) const {}
    __device__ __forceinline__ void done(const Unit&) const {}
};

struct EpiBf16 {
    static constexpr bool PERM = true, AFTER_DRAIN = false;
    bf16_t* O; int ldc;
    __device__ __forceinline__ void operator()(const f32x4 (&acc)[2][2][4][2], const Unit& u, int wr, int wc, int fr, int fq) const {
        const int row0 = u.pm * BM + wr * 64 + fr, col0 = u.pn * BM + wc * 32 + 8 * fq;
#pragma unroll
        for (int ai = 0; ai < 2; ++ai)
#pragma unroll
            for (int m = 0; m < 4; ++m) { bf16_t* rowp = O + (size_t)(row0 + ai * HALF + m * 16) * ldc + col0;
#pragma unroll
                for (int bj = 0; bj < 2; ++bj) { const f32x4 v0 = acc[ai][bj][m][0], v1 = acc[ai][bj][m][1];
                    u32x4 w; w.x = cvt_pk_bf16(v0[0], v0[1]); w.y = cvt_pk_bf16(v0[2], v0[3]); w.z = cvt_pk_bf16(v1[0], v1[1]); w.w = cvt_pk_bf16(v1[2], v1[3]);
                    *(u32x4*)(rowp + bj * HALF) = w; } }
    }
};

template <class Epi, class Sched, bool ALIGN_EPI = false, bool SP2 = false>
__device__ __forceinline__ void gemm_phase(LAS unsigned char* lds, const Gemm g, const Sched& S, const Epi& E) {
    const int tid = opaque_tid(), wid = __builtin_amdgcn_readfirstlane(tid >> 6), lane = tid & 63, wr = wid >> 2, wc = wid & 3, fr = lane & 15, fq = lane >> 4;
    const int K = opaque_s(g.K), nt = K / BK;
    unsigned voffA[2], voffB[2];
#pragma unroll
    for (int i = 0; i < 2; ++i) { int R, C; stage_rc(tid * 16 + i * 8192, R, C); const int Rb = Epi::PERM ? ((R & ~31) + perm32(R & 31)) : R;
        voffA[i] = (unsigned)(R * g.lda + C) * 2u; voffB[i] = (unsigned)(Rb * g.ldb + C) * 2u; }
    const size_t kstep = (size_t)(BK * 2);
    const size_t hstepA = (size_t)HALF * g.lda * 2, hstepB = (size_t)HALF * g.ldb * 2;
    const size_t tstepA = 2 * hstepA, tstepB = 2 * hstepB;
    const size_t pnA = (size_t)g.a_pn_off * 2;
    const unsigned ldsw = (unsigned)wid * 1024u;
    const int aoff = lds_byte(wr * 64 + fr, fq * 8), boff = lds_byte(wc * 32 + fr, fq * 8);
#define PG8_SA(b, h) (((b) * 2 + (h)) * HTB)
#define PG8_SB(b, h) ((4 + (b) * 2 + (h)) * HTB)
#define PG8_STAGE(bufoff, gbase, voff) do { _Pragma("unroll") for (int _i = 0; _i < 2; ++_i) \
        __builtin_amdgcn_global_load_lds((const unsigned*)((const char*)(gbase) + (voff)[_i]), (LAS unsigned*)(lds + (bufoff) + ldsw + _i * 8192), 16, 0, 0); } while (0)
#define PG8_LDA(dst, b, h) do { _Pragma("unroll") for (int m = 0; m < 4; ++m) _Pragma("unroll") for (int k = 0; k < 2; ++k) dst[m][k] = *(const LAS bf16x8*)(lds + PG8_SA(b, h) + aoff + m * 2048 + k * 1024); } while (0)
#define PG8_LDB(dst, b, h) do { _Pragma("unroll") for (int n = 0; n < 2; ++n) _Pragma("unroll") for (int k = 0; k < 2; ++k) dst[n][k] = *(const LAS bf16x8*)(lds + PG8_SB(b, h) + boff + n * 2048 + k * 1024); } while (0)
#define PG8_MMA(ai, bj, At, Bt) do { __builtin_amdgcn_s_setprio(1); _Pragma("unroll") for (int m = 0; m < 4; ++m) _Pragma("unroll") for (int n = 0; n < 2; ++n) _Pragma("unroll") for (int k = 0; k < 2; ++k) \
        acc[ai][bj][m][n] = __builtin_amdgcn_mfma_f32_16x16x32_bf16(Bt[n][k], At[m][k], acc[ai][bj][m][n], 0, 0, 0); __builtin_amdgcn_s_setprio(0); } while (0)
#define PG8_WAIT_V(n) asm volatile("s_waitcnt vmcnt(" #n ")" ::: "memory")
#define PG8_WAIT_L(n) asm volatile("s_waitcnt lgkmcnt(" #n ")" ::: "memory")
#define PG8_BAR __builtin_amdgcn_s_barrier()
#define PG8_SCHED __builtin_amdgcn_sched_barrier(0)
    Unit cur, nxt; int ui = 0;
    if (!S.next(0, cur)) return;
    f32x4 acc[2][2][4][2];
#pragma unroll
    for (int a = 0; a < 2; ++a)
#pragma unroll
        for (int b = 0; b < 2; ++b)
#pragma unroll
            for (int m = 0; m < 4; ++m)
#pragma unroll
                for (int n = 0; n < 2; ++n) acc[a][b][m][n] = (f32x4){0.f, 0.f, 0.f, 0.f};
    bf16x8 At[4][2], B0[2][2], B1[2][2];
    const char* cA = (const char*)g.A + (size_t)cur.pm * tstepA + (size_t)cur.pn * pnA; const char* cB = (const char*)g.Bt + (size_t)cur.pn * tstepB;
    S.a_ready(cur);
    if constexpr (SP2) {
        PG8_STAGE(PG8_SB(0, 0), cB, voffB); PG8_STAGE(PG8_SB(0, 1), cB + hstepB, voffB); PG8_STAGE(PG8_SA(0, 0), cA, voffA); PG8_STAGE(PG8_SA(0, 1), cA + hstepA, voffA);
        if (wr == 1) PG8_BAR;
        PG8_WAIT_V(2); PG8_BAR;
        PG8_STAGE(PG8_SB(1, 0), cB + kstep, voffB); PG8_STAGE(PG8_SA(1, 0), cA + kstep, voffA); PG8_STAGE(PG8_SB(1, 1), cB + hstepB + kstep, voffB);
        PG8_WAIT_V(6); PG8_BAR;
    } else {
        PG8_STAGE(PG8_SB(0, 0), cB, voffB); PG8_STAGE(PG8_SA(0, 0), cA, voffA); PG8_STAGE(PG8_SB(0, 1), cB + hstepB, voffB); PG8_STAGE(PG8_SA(0, 1), cA + hstepA, voffA);
        if (wr == 1) PG8_BAR;
        PG8_WAIT_V(4); PG8_BAR;
        PG8_STAGE(PG8_SB(1, 0), cB + kstep, voffB); PG8_STAGE(PG8_SA(1, 0), cA + kstep, voffA); PG8_STAGE(PG8_SB(1, 1), cB + hstepB + kstep, voffB);
        PG8_WAIT_V(6); PG8_BAR;
    }
    for (;;) {
        const bool has_next = S.next(ui + 1, nxt);
        const char* nA = has_next ? (const char*)g.A + (size_t)nxt.pm * tstepA + (size_t)nxt.pn * pnA : cA; const char* nB = has_next ? (const char*)g.Bt + (size_t)nxt.pn * tstepB : cB;
        for (int t = 0; t < nt; t += 2) {
            const bool last = (t == nt - 2);
            const char* a1 = cA + (size_t)(t + 1) * kstep;
            const char* a2 = last ? nA : cA + (size_t)(t + 2) * kstep; const char* b2 = last ? nB : cB + (size_t)(t + 2) * kstep;
            const char* a3 = a2 + kstep; const char* b3 = b2 + kstep;
            if (last && has_next) S.a_ready(nxt);
            if constexpr (SP2) {
            PG8_LDB(B0, 0, 0); PG8_LDB(B1, 0, 1); PG8_SCHED; PG8_LDA(At, 0, 0); PG8_STAGE(PG8_SA(1, 1), a1 + hstepA, voffA);
            PG8_WAIT_V(8); PG8_WAIT_L(0); PG8_BAR; PG8_MMA(0, 0, At, B0); PG8_MMA(0, 1, At, B1); PG8_BAR; PG8_SCHED;
            PG8_LDA(At, 0, 1); PG8_STAGE(PG8_SB(0, 0), b2, voffB); PG8_STAGE(PG8_SB(0, 1), b2 + hstepB, voffB); PG8_STAGE(PG8_SA(0, 0), a2, voffA);
            PG8_WAIT_V(8); PG8_WAIT_L(0); PG8_BAR; PG8_MMA(1, 0, At, B0); PG8_MMA(1, 1, At, B1); PG8_BAR; PG8_SCHED;
            PG8_LDB(B0, 1, 0); PG8_LDB(B1, 1, 1); PG8_SCHED; PG8_LDA(At, 1, 0); PG8_STAGE(PG8_SA(0, 1), a2 + hstepA, voffA);
            PG8_WAIT_V(8); PG8_WAIT_L(0); PG8_BAR; PG8_MMA(0, 0, At, B0); PG8_MMA(0, 1, At, B1); PG8_BAR; PG8_SCHED;
            PG8_LDA(At, 1, 1); PG8_STAGE(PG8_SB(1, 0), b3, voffB); PG8_STAGE(PG8_SB(1, 1), b3 + hstepB, voffB); PG8_STAGE(PG8_SA(1, 0), a3, voffA);
            PG8_WAIT_V(8); PG8_WAIT_L(0); PG8_BAR; PG8_MMA(1, 0, At, B0); PG8_MMA(1, 1, At, B1); PG8_BAR; PG8_SCHED;
            } else {
            PG8_LDB(B0, 0, 0); PG8_SCHED; PG8_LDA(At, 0, 0); PG8_STAGE(PG8_SA(1, 1), a1 + hstepA, voffA);
            PG8_WAIT_L(8); PG8_BAR; PG8_WAIT_L(0); PG8_MMA(0, 0, At, B0); PG8_BAR; PG8_SCHED;
            PG8_LDB(B1, 0, 1); PG8_STAGE(PG8_SB(0, 0), b2, voffB);
            PG8_BAR; PG8_WAIT_L(0); PG8_MMA(0, 1, At, B1); PG8_BAR;
            PG8_LDA(At, 0, 1); PG8_STAGE(PG8_SA(0, 0), a2, voffA);
            PG8_BAR; PG8_WAIT_L(0); PG8_MMA(1, 0, At, B0); PG8_BAR; PG8_SCHED;
            PG8_STAGE(PG8_SB(0, 1), b2 + hstepB, voffB);
            PG8_WAIT_V(6); PG8_BAR; PG8_MMA(1, 1, At, B1); PG8_BAR;
            PG8_LDB(B0, 1, 0); PG8_SCHED; PG8_LDA(At, 1, 0); PG8_STAGE(PG8_SA(0, 1), a2 + hstepA, voffA);
            PG8_WAIT_L(8); PG8_BAR; PG8_WAIT_L(0); PG8_MMA(0, 0, At, B0); PG8_BAR; PG8_SCHED;
            PG8_LDB(B1, 1, 1); PG8_STAGE(PG8_SB(1, 0), b3, voffB);
            PG8_BAR; PG8_WAIT_L(0); PG8_MMA(0, 1, At, B1); PG8_BAR;
            PG8_LDA(At, 1, 1); PG8_STAGE(PG8_SA(1, 0), a3, voffA);
            PG8_BAR; PG8_WAIT_L(0); PG8_MMA(1, 0, At, B0); PG8_BAR; PG8_SCHED;
            PG8_STAGE(PG8_SB(1, 1), b3 + hstepB, voffB);
            PG8_WAIT_V(6); PG8_BAR; PG8_MMA(1, 1, At, B1); PG8_BAR;
            }
        }
        if constexpr (ALIGN_EPI) { if (wr == 0) PG8_BAR; }
        E(acc, cur, wr, wc, fr, fq); S.done(cur);
        if (!has_next) break;
#pragma unroll
        for (int a = 0; a < 2; ++a)
#pragma unroll
            for (int b = 0; b < 2; ++b)
#pragma unroll
                for (int m = 0; m < 4; ++m)
#pragma unroll
                    for (int n = 0; n < 2; ++n) acc[a][b][m][n] = (f32x4){0.f, 0.f, 0.f, 0.f};
        cur = nxt; cA = nA; cB = nB; ++ui;
        if constexpr (ALIGN_EPI) { if (wr == 1) PG8_BAR; }
    }
    PG8_WAIT_V(0);
    if constexpr (!ALIGN_EPI) { if (wr == 0) PG8_BAR; }
    PG8_BAR;
#undef PG8_SA
#undef PG8_SB
#undef PG8_STAGE
#undef PG8_LDA
#undef PG8_LDB
#undef PG8_MMA
#undef PG8_WAIT_V
#undef PG8_WAIT_L
#undef PG8_BAR
#undef PG8_SCHED
}

struct EpiPool {
    static constexpr bool PERM = true, AFTER_DRAIN = false;
    bf16_t* O; const bf16_t* pgate;
    __device__ __forceinline__ void operator()(const f32x4 (&acc)[2][2][4][2], const Unit& u, int wr, int wc, int fr, int fq) const {
        const int row0 = u.pm * BM + wr * 64 + fr, col0 = u.pn * BM + wc * 32 + 8 * fq;
#pragma unroll
        for (int ai = 0; ai < 2; ++ai)
#pragma unroll
            for (int m = 0; m < 4; ++m)
#pragma unroll
                for (int bj = 0; bj < 2; ++bj) {
                    const int row = row0 + ai * HALF + m * 16, col = col0 + bj * HALF;
                    const u32x4 gz = *(const u32x4*)(pgate + (size_t)row * 1024 + col);
                    const f32x4 v0 = acc[ai][bj][m][0], v1 = acc[ai][bj][m][1];
                    u32x4 w;
                    w.x = cvt_pk_bf16(v0[0] * bflo(gz.x), v0[1] * bfhi(gz.x));
                    w.y = cvt_pk_bf16(v0[2] * bflo(gz.y), v0[3] * bfhi(gz.y));
                    w.z = cvt_pk_bf16(v1[0] * bflo(gz.z), v1[1] * bfhi(gz.z));
                    w.w = cvt_pk_bf16(v1[2] * bflo(gz.w), v1[3] * bfhi(gz.w));
                    *(u32x4*)(O + (size_t)row * 1024 + col) = w;
                    __builtin_amdgcn_sched_barrier(0);
                }
    }
};
template <int PASS> struct EpiMerge {
    static constexpr bool PERM = true, AFTER_DRAIN = false;
    float* yacc; bf16_t* y; const bf16_t* zg;
    __device__ __forceinline__ void operator()(const f32x4 (&acc)[2][2][4][2], const Unit& u, int wr, int wc, int fr, int fq) const {
        const int row0 = u.pm * BM + wr * 64 + fr, col0 = u.pn * BM + wc * 32 + 8 * fq;
#pragma unroll
        for (int ai = 0; ai < 2; ++ai)
#pragma unroll
            for (int m = 0; m < 4; ++m)
#pragma unroll
                for (int bj = 0; bj < 2; ++bj) {
                    const int row = row0 + ai * HALF + m * 16, col = col0 + bj * HALF;
                    float gz[8]; unpack8(*(const u32x4*)(zg + (size_t)row * NZ + col), gz);
                    const f32x4 v0 = acc[ai][bj][m][0], v1 = acc[ai][bj][m][1];
                    f32x4 r0, r1;
#pragma unroll
                    for (int e = 0; e < 4; ++e) { r0[e] = v0[e] * sigmoid_f(gz[e]); r1[e] = v1[e] * sigmoid_f(gz[4 + e]); }
                    float* yp = yacc + (size_t)row * DM + col;
                    if (PASS >= 1) { r0 += *(const f32x4*)yp; r1 += *(const f32x4*)(yp + 4); }
                    if (PASS <= 1) { *(f32x4*)yp = r0; *(f32x4*)(yp + 4) = r1; }
                    else { u32x4 w; w.x = cvt_pk_bf16(r0[0], r0[1]); w.y = cvt_pk_bf16(r0[2], r0[3]); w.z = cvt_pk_bf16(r1[0], r1[1]); w.w = cvt_pk_bf16(r1[2], r1[3]);
                        *(u32x4*)(y + (size_t)row * DM + col) = w; }
                    __builtin_amdgcn_sched_barrier(0);
                }
    }
};
struct EpiOut {
    static constexpr bool PERM = true, AFTER_DRAIN = false;
    const float* xlat; const float* xctx; float* xnew; const float* mod;
    __device__ __forceinline__ void operator()(const f32x4 (&acc)[2][2][4][2], const Unit& u, int wr, int wc, int fr, int fq) const {
        const int row0 = u.pm * BM + wr * 64 + fr, col0 = u.pn * BM + wc * 32 + 8 * fq;
        const int tile_row = u.pm * BM; const int mr = tile_row < ML ? tile_row / SEQ : 4;
        const float* xo = tile_row < ML ? xlat : (xctx - (size_t)ML * DM);
        const float* gm = mod + mr * 6144 + 4096;
#pragma unroll
        for (int ai = 0; ai < 2; ++ai)
#pragma unroll
            for (int m = 0; m < 4; ++m)
#pragma unroll
                for (int bj = 0; bj < 2; ++bj) {
                    const int row = row0 + ai * HALF + m * 16, col = col0 + bj * HALF;
                    const f32x4 g0 = *(const f32x4*)(gm + col), g1 = *(const f32x4*)(gm + col + 4);
                    const float* xp = xo + (size_t)row * DM + col;
                    const f32x4 r0 = *(const f32x4*)xp + g0 * acc[ai][bj][m][0], r1 = *(const f32x4*)(xp + 4) + g1 * acc[ai][bj][m][1];
                    float* op = xnew + (size_t)row * DM + col;
                    *(f32x4*)op = r0; *(f32x4*)(op + 4) = r1;
                    __builtin_amdgcn_sched_barrier(0);
                }
    }
};
}

struct Args { const float* in[26]; float* out; unsigned char* ws; int ph_lo, ph_hi; };
enum { I_X = 0, I_C, I_CTX, I_CCTX, I_NORMG, I_WADA, I_BADA, I_WIN, I_POOLW, I_POOLS, I_QNORM, I_KNORM, I_LQ1, I_LK1, I_LQ2, I_LK2, I_SUBLN, I_WGF, I_BGF, I_WGB, I_BGB, I_GLAN, I_WBP, I_WBD, I_WBG, I_WOUT };

__device__ __forceinline__ const float* inp(int i) { const float* const volatile __attribute__((address_space(4)))* kp = (const float* const volatile __attribute__((address_space(4)))*)__builtin_amdgcn_kernarg_segment_ptr(); return kp[i]; }
__device__ __forceinline__ float* arg_out() { float* const volatile __attribute__((address_space(4)))* kp = (float* const volatile __attribute__((address_space(4)))*)__builtin_amdgcn_kernarg_segment_ptr(); return kp[26]; }
__device__ __forceinline__ void transpose_item(const float* W, int K, int N, bf16_t* WT, int row_off, LAS float* scr, int kb, int nb, int lane) {
    const int k0 = 64 * kb, n0 = 32 * nb;
#pragma unroll 8
    for (int i = 0; i < 32; ++i) { const int kk = 2 * i + (lane >> 5); scr[kk * 33 + (lane & 31)] = W[(size_t)(k0 + kk) * N + n0 + (lane & 31)]; }
    asm volatile("s_waitcnt lgkmcnt(0)" ::: "memory");
    const int c = lane & 7;
#pragma unroll
    for (int j = 0; j < 4; ++j) { const int n = (lane >> 3) + 8 * j; const LAS float* s = scr + (8 * c) * 33 + n;
        u32x4 o; o.x = cvt_pk_bf16(s[0 * 33], s[1 * 33]); o.y = cvt_pk_bf16(s[2 * 33], s[3 * 33]); o.z = cvt_pk_bf16(s[4 * 33], s[5 * 33]); o.w = cvt_pk_bf16(s[6 * 33], s[7 * 33]);
        *(u32x4*)(WT + (size_t)(row_off + n0 + n) * K + k0 + 8 * c) = o; }
    asm volatile("s_waitcnt lgkmcnt(0)" ::: "memory");
}

__device__ __forceinline__ void phase_p0(const Args& a, LAS unsigned char* lds) {
    const int tid = opaque_tid(), lane = tid & 63, wave = __builtin_amdgcn_readfirstlane(tid >> 6), G = opaque_s(gridDim.x);
    unsigned char* ws = opaque_ptr(a.ws);
    {
        LAS float* sc = (LAS float*)(lds + 69632);
        LAS float* part = (LAS float*)(lds + 69632 + 40960);
        if (BID < 192) {
            for (int i = tid; i < 5 * 2048; i += 512) { const int r = i >> 11, k = i & 2047; const float v = r < 4 ? inp(I_C)[r * 2048 + k] : inp(I_CCTX)[k]; sc[i] = silu_f(v); }
            __syncthreads();
        }
        for (int it = BID; it < 192; it += G) {
            const int l = it / 96, cgp = it % 96, col = cgp * 64 + lane;
            const float* W = inp(I_WADA) + (size_t)l * 2048 * 6144 + col;
            float acc[5] = {0.f, 0.f, 0.f, 0.f, 0.f};
#pragma unroll 8
            for (int kk = 0; kk < 256; ++kk) { const int k = wave * 256 + kk; const float wv = W[(size_t)k * 6144];
#pragma unroll
                for (int r = 0; r < 5; ++r) acc[r] += sc[r * 2048 + k] * wv; }
#pragma unroll
            for (int r = 0; r < 5; ++r) part[(wave * 5 + r) * 64 + lane] = acc[r];
            __syncthreads();
            if (tid < 320) { const int r = tid >> 6, ln = tid & 63; float s = inp(I_BADA)[l * 6144 + cgp * 64 + ln];
#pragma unroll
                for (int w = 0; w < 8; ++w) s += part[(w * 5 + r) * 64 + ln];
                ((float*)(ws + OFF_MOD))[(l * 5 + r) * 6144 + cgp * 64 + ln] = s; }
            __syncthreads();
        }
    }
    if (BID == G - 1 && wave == 0) {
        for (int l = 0; l < 2; ++l) {
            const float s1 = wave_sum(inp(I_LQ1)[l * 64 + lane] * inp(I_LK1)[l * 64 + lane]);
            const float s2 = wave_sum(inp(I_LQ2)[l * 64 + lane] * inp(I_LK2)[l * 64 + lane]);
            const float mq = wave_max(fabsf(inp(I_QNORM)[l * 64 + lane])), mk = wave_max(fabsf(inp(I_KNORM)[l * 64 + lane]));
            const float lam_init = 0.8f - 0.6f * expf(-0.3f * (float)l);
            if (lane == 0) { float* sp = (float*)(ws + OFF_SCAL) + l * 4; sp[0] = expf(s1) - expf(s2) + lam_init; sp[1] = 8.f * LOG2E * mq * mk; sp[2] = lam_init; sp[3] = 0.f; }
        }
    }
    {
        const int nper = 224 * 2048 * 2 / 16;
        for (int i = BID * 512 + tid; i < 2 * nper; i += G * 512) { const int l = i / nper, j = i % nper;
            *(u32x4*)(ws + OFF_WIN + (size_t)l * SZ_WIN + (size_t)9248 * DM * 2 + (size_t)j * 16) = (u32x4){0u, 0u, 0u, 0u}; }
    }
    {
        LAS float* scr = (LAS float*)(lds + wave * 8704);
        const int gw = BID * 8 + wave, NGW = G * 8;
        constexpr int I_IN = 32 * 481, I_B = 16 * 64, I_O = 32 * 64, I_P = 4 * 32, PER_L = I_IN + 3 * I_B + I_O + I_P;
        for (int it = gw; it < 2 * PER_L; it += NGW) {
            const int l = it / PER_L; int r = it % PER_L;
            if (r < I_IN) { const int kb = r / 481, nb = r % 481;
                transpose_item(inp(I_WIN) + (size_t)l * DM * DIN, DM, DIN, (bf16_t*)(ws + OFF_WIN + (size_t)l * SZ_WIN), nb >= 289 ? 224 : 0, scr, kb, nb, lane); continue; }
            r -= I_IN;
            if (r < 3 * I_B) { const int br = r / I_B, rr = r % I_B; const float* W = (br == 0 ? inp(I_WBP) : br == 1 ? inp(I_WBD) : inp(I_WBG)) + (size_t)l * 1024 * DM;
                transpose_item(W, 1024, DM, (bf16_t*)(ws + OFF_WB + (size_t)l * SZ_WB + (size_t)br * DM * 1024 * 2), 0, scr, rr / 64, rr % 64, lane); continue; }
            r -= 3 * I_B;
            if (r < I_O) { transpose_item(inp(I_WOUT) + (size_t)l * DM * DM, DM, DM, (bf16_t*)(ws + OFF_WOUT + (size_t)l * SZ_WOUT), 0, scr, r / 64, r % 64, lane); continue; }
            r -= I_O;
            { const int g = r / 32, rr = r % 32;
              transpose_item(inp(I_POOLW) + (size_t)(l * 4 + g) * 65536, 256, 256, (bf16_t*)(ws + OFF_POOLT + (size_t)l * SZ_POOLT + (size_t)g * 65536 * 2), 0, scr, rr / 8, rr % 8, lane); }
        }
    }
}

__device__ __forceinline__ void phase_norm(const Args& a, int l) {
    const int tid = opaque_tid(), lane = tid & 63, wave = tid >> 6, G = opaque_s(gridDim.x);
    const int gw = BID * 8 + wave, NGW = G * 8;
    const float* mod = (const float*)(opaque_ptr(a.ws) + OFF_MOD) + (size_t)l * 5 * 6144;
    const float* x1 = (const float*)(opaque_ptr(a.ws) + OFF_X1);
    bf16_t* h = (bf16_t*)(opaque_ptr(a.ws) + OFF_H);
    const float* ng = inp(I_NORMG) + l * DM;
    for (int row = gw; row < MT; row += NGW) {
        const float* src = (l == 0) ? (row < ML ? inp(I_X) + (size_t)row * DM : inp(I_CTX) + (size_t)(row - ML) * DM) : x1 + (size_t)row * DM;
        const int mr = row < ML ? row / SEQ : 4;
        const float* md = mod + mr * 6144;
        f32x4 v[8]; float ss = 0.f;
#pragma unroll
        for (int j = 0; j < 8; ++j) { v[j] = *(const f32x4*)(src + 4 * lane + 256 * j); ss += (v[j][0] * v[j][0] + v[j][1] * v[j][1]) + (v[j][2] * v[j][2] + v[j][3] * v[j][3]); }
        ss = wave_sum(ss);
        const float rstd = rsqrtf(ss * (1.f / DM) + EPS);
#pragma unroll
        for (int j = 0; j < 8; ++j) { const int idx = 4 * lane + 256 * j;
            const f32x4 gg = *(const f32x4*)(ng + idx), sc = *(const f32x4*)(md + 2048 + idx), sh = *(const f32x4*)(md + idx);
            f32x4 o;
#pragma unroll
            for (int e = 0; e < 4; ++e) o[e] = v[j][e] * rstd * gg[e] * (1.f + sc[e]) + sh[e];
            u32x2 w; w.x = cvt_pk_bf16(o[0], o[1]); w.y = cvt_pk_bf16(o[2], o[3]);
            *(u32x2*)(h + (size_t)row * DM + idx) = w; }
    }
}

__device__ __forceinline__ int vt_pos(int key) { const int k = key & 15; return (key & ~15) | (((k >> 2) & 1) << 3) | (k & 3) | (((k >> 3) & 1) << 2); }

__device__ __forceinline__ void phase_prep(const Args& a, int l, LAS unsigned char* lds) {
    const int tid = opaque_tid(), lane = tid & 63, wave = tid >> 6, G = opaque_s(gridDim.x);
    unsigned char* ws = opaque_ptr(a.ws);
    const bf16_t* z = (const bf16_t*)(ws + OFF_Z);
    const bool need_ctx = (l == 0);
    for (int it = BID; it < 288; it += G) {
        if (it < 144) {
            const int c = it, rb = 64 * c;
            LAS float* lrs = (LAS float*)lds;
            for (int i = tid; i < 64 * 32; i += 512) { const int r = i >> 5, cc = i & 31; lrs[i] = bf2f(z[(size_t)(rb + r) * NZ + ZC_LR + cc]); }
            __syncthreads();
            const int ch = tid;
            float wf[16], wb[16];
#pragma unroll
            for (int r = 0; r < 16; ++r) { wf[r] = inp(I_WGF)[(size_t)l * 16 * 512 + r * 512 + ch]; wb[r] = inp(I_WGB)[(size_t)l * 16 * 512 + r * 512 + ch]; }
            const float bfv = inp(I_BGF)[l * 512 + ch], bbv = inp(I_BGB)[l * 512 + ch];
            float totf = 0.f, totb = 0.f;
            for (int t = 0; t < 64; ++t) { float af = bfv, ab = bbv;
#pragma unroll
                for (int r = 0; r < 16; ++r) { af += lrs[t * 32 + r] * wf[r]; ab += lrs[t * 32 + 16 + r] * wb[r]; }
                totf += logsig_f(af) * (1.f / 16.f); totb += logsig_f(ab) * (1.f / 16.f); }
            bf16_t* gq0 = (bf16_t*)(ws + OFF_GQ), *gq1 = (bf16_t*)(ws + OFF_GQ + SZ_G);
            bf16_t* gk0 = (bf16_t*)(ws + OFF_GK), *gk1 = (bf16_t*)(ws + OFF_GK + SZ_G);
            bf16_t* gh0 = (bf16_t*)(ws + OFF_GH), *gh1 = (bf16_t*)(ws + OFF_GH + SZ_G);
            float pf = 0.f, pb = 0.f;
            for (int t = 0; t < 64; ++t) { float af = bfv, ab = bbv;
#pragma unroll
                for (int r = 0; r < 16; ++r) { af += lrs[t * 32 + r] * wf[r]; ab += lrs[t * 32 + 16 + r] * wb[r]; }
                const float gf = logsig_f(af) * (1.f / 16.f), gb = logsig_f(ab) * (1.f / 16.f);
                pf += gf; const float bs = totb - pb; pb += gb;
                const size_t row = rb + t;
                const float q = bf2f(z[row * NZ + ZC_GQ + ch]) * 0.08838834764831845f, k = bf2f(z[row * NZ + ZC_GK + ch]);
                const size_t o = row * 512 + ch;
                gq0[o] = f2bf(q * __expf(pf)); gk0[o] = f2bf(k * __expf(-pf)); gh0[o] = f2bf(k * __expf(totf - pf));
                gq1[o] = f2bf(q * __expf(bs)); gk1[o] = f2bf(k * __expf(-bs)); gh1[o] = f2bf(k * __expf(totb - bs)); }
            float* dec = (float*)(ws + OFF_DEC);
            dec[(size_t)c * 512 + ch] = __expf(totf); dec[(size_t)(144 + c) * 512 + ch] = __expf(totb);
            __syncthreads();
        } else {
            const int c = it - 144; if (!need_ctx && c >= 128) continue;
            const int rb = 64 * c; const int seq0 = rb < ML ? (rb / SEQ) * SEQ : ML + ((rb - ML) / LC) * LC; const int L = rb < ML ? SEQ : LC;
            bf16_t* dp = (bf16_t*)(ws + OFF_DPOOL); bf16_t* pgt = (bf16_t*)(ws + OFF_PGATE);
#pragma unroll
            for (int rep = 0; rep < 2; ++rep) { const int ch = tid + 512 * rep, hw = 1 << (ch >> 8);
                const float psc = inp(I_POOLS)[l * 1024 + ch];
                for (int t = 0; t < 64; ++t) { const int row = rb + t, tl = row - seq0; const int lo = max(tl - hw, 0), hi = min(tl + hw, L);
                    float s = 0.f;
                    for (int p = lo; p < hi; ++p) s += bf2f(z[(size_t)(seq0 + p) * NZ + ZC_PU + ch]);
                    const float d = s / (float)(hi - lo) - bf2f(z[(size_t)row * NZ + ZC_PU + ch]);
                    dp[(size_t)row * 1024 + ch] = f2bf(d);
                    pgt[(size_t)row * 1024 + ch] = f2bf(psc * silu_f(bf2f(z[(size_t)row * NZ + ZC_PG + ch]))); } }
        }
    }
    {
        const int gw = BID * 8 + wave, NGW = G * 8;
        bf16_t* qn = (bf16_t*)(ws + OFF_QN); bf16_t* qnc = (bf16_t*)(ws + OFF_QNC); bf16_t* kn = (bf16_t*)(ws + OFF_KN); bf16_t* vT = (bf16_t*)(ws + OFF_VT);
        for (int it = gw; it < MT * 3; it += NGW) {
            const int row = it / 3, which = it % 3;
            const bool isctx = row >= ML; int b, t; if (!isctx) { b = row >> 11; t = row & 2047; } else { b = (row - ML) >> 8; t = (row - ML) & 255; }
            const bf16_t* zr = z + (size_t)row * NZ;
            if (which == 2) {
                float x[16]; unpack8(*(const u32x4*)(zr + ZC_DV + 16 * lane), x); unpack8(*(const u32x4*)(zr + ZC_DV + 16 * lane + 8), x + 8);
                const int h = lane >> 3, v0 = 16 * (lane & 7); const int pos = vt_pos(isctx ? t : LC + t);
                bf16_t* dst = vT + ((size_t)(b * 8 + h) * 128 + v0) * LK + pos;
#pragma unroll
                for (int e = 0; e < 16; ++e) dst[(size_t)e * LK] = f2bf(x[e]);
            } else {
                if (which == 0 && isctx && !need_ctx) continue;
                float x[16]; const bf16_t* src = zr + (which == 0 ? ZC_DQ : ZC_DK) + 16 * lane;
                unpack8(*(const u32x4*)src, x); unpack8(*(const u32x4*)(src + 8), x + 8);
                float ss = 0.f;
#pragma unroll
                for (int e = 0; e < 16; ++e) ss += x[e] * x[e];
                ss += __shfl_xor(ss, 1); ss += __shfl_xor(ss, 2);
                const float rstd = rsqrtf(ss * (1.f / 64.f) + EPS);
                const int m = lane & 3, sh = lane >> 2, h = sh >> 1, j = sh & 1;
                const float* gain = (which == 0 ? inp(I_QNORM) : inp(I_KNORM)) + l * 64 + 16 * m;
                float y[16];
#pragma unroll
                for (int e = 0; e < 16; ++e) y[e] = x[e] * rstd * gain[e];
                if (!isctx) {
                    const float posf = (float)((m & 1) ? (t & 63) : (t >> 6));
#pragma unroll
                    for (int e = 0; e < 16; ++e) { const float yp = __shfl_xor(y[e], 2);
                        const float ang = posf * exp2f(-(float)e * 0.8304820237218405f);
                        const float cs = __cosf(ang), sn = __sinf(ang);
                        y[e] = (m < 2) ? (y[e] * cs - yp * sn) : (y[e] * cs + yp * sn); }
                }
                bf16_t* dst;
                if (which == 0) {
#pragma unroll
                    for (int e = 0; e < 16; ++e) y[e] *= 0.125f * LOG2E;
                    dst = isctx ? qnc + (((size_t)(b * 8 + h) * 2 + j) * LC + t) * 64 + 16 * m : qn + (((size_t)(b * 8 + h) * 2 + j) * SEQ + t) * 64 + 16 * m;
                } else dst = kn + (((size_t)(b * 8 + h) * 2 + j) * LK + (isctx ? t : LC + t)) * 64 + 16 * m;
                u32x4 w0, w1;
                w0.x = cvt_pk_bf16(y[0], y[1]); w0.y = cvt_pk_bf16(y[2], y[3]); w0.z = cvt_pk_bf16(y[4], y[5]); w0.w = cvt_pk_bf16(y[6], y[7]);
                w1.x = cvt_pk_bf16(y[8], y[9]); w1.y = cvt_pk_bf16(y[10], y[11]); w1.z = cvt_pk_bf16(y[12], y[13]); w1.w = cvt_pk_bf16(y[14], y[15]);
                *(u32x4*)dst = w0; *(u32x4*)(dst + 8) = w1;
            }
        }
    }
}

constexpr int GL_Q = 0, GL_K = 17408, GL_KH = 34816, GL_VT = 53248, GL_ATT = 57856, GL_ST = 67072;
__device__ __forceinline__ void gla_unit(const Args& a, int l, LAS unsigned char* lds, int item) {
    const int tid = opaque_tid(), lane = tid & 63, w = __builtin_amdgcn_readfirstlane(tid >> 6);
    const int vs = item & 7, dir = (item >> 3) & 1, h = (item >> 4) & 3, b = item >> 6;
    const bool need_ctx = (l == 0);
    unsigned char* ws = opaque_ptr(a.ws);
    const bf16_t* z = (const bf16_t*)(ws + OFF_Z);
    const bf16_t* gq = (const bf16_t*)(ws + OFF_GQ + dir * SZ_G) + h * 128;
    const bf16_t* gk = (const bf16_t*)(ws + OFF_GK + dir * SZ_G) + h * 128;
    const bf16_t* gh = (const bf16_t*)(ws + OFF_GH + dir * SZ_G) + h * 128;
    const float* dec = (const float*)(ws + OFF_DEC) + (size_t)dir * 144 * 512 + h * 128;
    bf16_t* od = (bf16_t*)(ws + OFF_OF + (size_t)dir * MT * 1024 * 2) + h * 256 + vs * 32;
    const bf16_t* zv = z + ZC_GV + h * 256 + vs * 32;
    const int fr = lane & 15, fq = lane >> 4;
    f32x4 sacc[2] = {(f32x4){0.f, 0.f, 0.f, 0.f}, (f32x4){0.f, 0.f, 0.f, 0.f}};
    for (int i = tid; i < 32 * 136 / 2; i += 512) ((LAS unsigned*)(lds + GL_ST))[i] = 0u;
    u32x4 rq[2], rk[2], rh[2], rv; float rdec;
    auto rowbase = [&](int s) -> int { if (s < 4) { const int ci = dir == 0 ? s : 3 - s; return ML + b * LC + 64 * ci; } const int ci = dir == 0 ? s - 4 : 35 - s; return b * SEQ + 64 * ci; };
#define GLA_LOAD(s) do { const int _rb = rowbase(s); _Pragma("unroll") for (int _i = 0; _i < 2; ++_i) { const int _idx = tid + 512 * _i, _r = _idx >> 4, _c = (_idx & 15) * 8; const size_t _o = (size_t)(_rb + _r) * 512 + _c; \
        rq[_i] = *(const u32x4*)(gq + _o); rk[_i] = *(const u32x4*)(gk + _o); rh[_i] = *(const u32x4*)(gh + _o); } \
        if (tid < 256) rv = *(const u32x4*)(zv + (size_t)(_rb + (tid >> 2)) * NZ + (tid & 3) * 8); \
        rdec = dec[(size_t)(_rb >> 6) * 512 + 16 * w + fr]; } while (0)
    GLA_LOAD(0);
    for (int s = 0; s < 36; ++s) {
        const int rb = rowbase(s);
        const float dk = rdec;
#pragma unroll
        for (int i = 0; i < 2; ++i) { const int idx = tid + 512 * i, r = idx >> 4, c = (idx & 15) * 8;
            *(LAS u32x4*)(lds + GL_Q + r * 272 + c * 2) = rq[i]; *(LAS u32x4*)(lds + GL_K + r * 272 + c * 2) = rk[i];
            const unsigned hw[4] = {rh[i].x, rh[i].y, rh[i].z, rh[i].w};
#pragma unroll
            for (int e = 0; e < 8; ++e) *(LAS bf16_t*)(lds + GL_KH + (c + e) * 144 + r * 2) = (bf16_t)((e & 1) ? (hw[e >> 1] >> 16) : (hw[e >> 1] & 0xffffu)); }
        if (tid < 256) { const int r = tid >> 2, c = (tid & 3) * 8; const unsigned vw[4] = {rv.x, rv.y, rv.z, rv.w};
#pragma unroll
            for (int e = 0; e < 8; ++e) *(LAS bf16_t*)(lds + GL_VT + (c + e) * 144 + r * 2) = (bf16_t)((e & 1) ? (vw[e >> 1] >> 16) : (vw[e >> 1] & 0xffffu)); }
        __syncthreads();
        if (s + 1 < 36) GLA_LOAD(s + 1);
        {
            const int tt = w >> 1;
#pragma unroll
            for (int si = 0; si < 2; ++si) { const int st = 2 * (w & 1) + si; f32x4 acc = (f32x4){0.f, 0.f, 0.f, 0.f};
#pragma unroll
                for (int kk = 0; kk < 4; ++kk) { const bf16x8 af = *(const LAS bf16x8*)(lds + GL_Q + (16 * tt + fr) * 272 + (32 * kk + 8 * fq) * 2);
                    const bf16x8 bfr = *(const LAS bf16x8*)(lds + GL_K + (16 * st + fr) * 272 + (32 * kk + 8 * fq) * 2);
                    acc = __builtin_amdgcn_mfma_f32_16x16x32_bf16(af, bfr, acc, 0, 0, 0); }
#pragma unroll
                for (int j = 0; j < 4; ++j) { const int t = 16 * tt + 4 * fq + j, sc = 16 * st + fr; const bool keep = dir == 0 ? (sc <= t) : (sc >= t);
                    *(LAS bf16_t*)(lds + GL_ATT + t * 144 + sc * 2) = f2bf(keep ? acc[j] : 0.f); } }
        }
#pragma unroll
        for (int vt = 0; vt < 2; ++vt) { f32x4 acc = sacc[vt] * dk;
#pragma unroll
            for (int kk = 0; kk < 2; ++kk) { const bf16x8 af = *(const LAS bf16x8*)(lds + GL_VT + (16 * vt + fr) * 144 + (32 * kk + 8 * fq) * 2);
                const bf16x8 bfr = *(const LAS bf16x8*)(lds + GL_KH + (16 * w + fr) * 144 + (32 * kk + 8 * fq) * 2);
                acc = __builtin_amdgcn_mfma_f32_16x16x32_bf16(af, bfr, acc, 0, 0, 0); }
            sacc[vt] = acc; }
        __syncthreads();
        {
            const int tt = w >> 1, vt = w & 1; f32x4 acc = (f32x4){0.f, 0.f, 0.f, 0.f};
#pragma unroll
            for (int kk = 0; kk < 4; ++kk) { const bf16x8 af = *(const LAS bf16x8*)(lds + GL_Q + (16 * tt + fr) * 272 + (32 * kk + 8 * fq) * 2);
                const bf16x8 bfr = *(const LAS bf16x8*)(lds + GL_ST + (16 * vt + fr) * 272 + (32 * kk + 8 * fq) * 2);
                acc = __builtin_amdgcn_mfma_f32_16x16x32_bf16(af, bfr, acc, 0, 0, 0); }
#pragma unroll
            for (int kk = 0; kk < 2; ++kk) { const bf16x8 af = *(const LAS bf16x8*)(lds + GL_ATT + (16 * tt + fr) * 144 + (32 * kk + 8 * fq) * 2);
                const bf16x8 bfr = *(const LAS bf16x8*)(lds + GL_VT + (16 * vt + fr) * 144 + (32 * kk + 8 * fq) * 2);
                acc = __builtin_amdgcn_mfma_f32_16x16x32_bf16(af, bfr, acc, 0, 0, 0); }
            if (s >= 4 || need_ctx) {
#pragma unroll
                for (int j = 0; j < 4; ++j) od[(size_t)(rb + 16 * tt + 4 * fq + j) * 1024 + 16 * vt + fr] = f2bf(acc[j]); }
        }
        __syncthreads();
#pragma unroll
        for (int vt = 0; vt < 2; ++vt)
#pragma unroll
            for (int j = 0; j < 4; ++j) *(LAS bf16_t*)(lds + GL_ST + (16 * vt + 4 * fq + j) * 272 + (16 * w + fr) * 2) = f2bf(sacc[vt][j]);
    }
    __syncthreads();
#undef GLA_LOAD
}

constexpr int AT_BUF = 36864, AT_K = 0, AT_V = 18432;
__device__ __forceinline__ void attn_unit(LAS unsigned char* lds, const bf16_t* qbase, int Lq, int q0, const bf16_t* kbase, const bf16_t* vtbase, int nkeys,
                                          float c2, float lam, float post_scale, const float* subln, const bf16_t* dg, bf16_t* outp, int row0) {
    const int tid = opaque_tid(), lane = tid & 63, w = __builtin_amdgcn_readfirstlane(tid >> 6), q32 = lane & 31, hi = lane >> 5;
    const int j = w >> 2, qg = w & 3;
    bf16x8 qf[4];
#pragma unroll
    for (int kk = 0; kk < 4; ++kk) qf[kk] = *(const bf16x8*)(qbase + ((size_t)j * Lq + q0 + 32 * qg + q32) * 64 + 16 * kk + 8 * hi);
    f32x16 o[4];
#pragma unroll
    for (int vt = 0; vt < 4; ++vt)
#pragma unroll
        for (int r = 0; r < 16; ++r) o[vt][r] = 0.f;
    float lsum = 0.f;
    const int nt = nkeys >> 6;
    u32x4 sk[2], sv[2];
#define AT_LOAD(i) do { _Pragma("unroll") for (int _c = 0; _c < 2; ++_c) { const int _idx = tid + 512 * _c; \
        sk[_c] = *(const u32x4*)(kbase + ((size_t)(_idx >> 9) * LK + 64 * (i) + ((_idx & 511) >> 3)) * 64 + (_idx & 7) * 8); \
        sv[_c] = *(const u32x4*)(vtbase + (size_t)(_idx >> 3) * LK + 64 * (i) + (_idx & 7) * 8); } } while (0)
#define AT_STORE(p) do { _Pragma("unroll") for (int _c = 0; _c < 2; ++_c) { const int _idx = tid + 512 * _c; \
        *(LAS u32x4*)(lds + (p) * AT_BUF + AT_K + ((_idx >> 9) * 64 + ((_idx & 511) >> 3)) * 144 + (_idx & 7) * 16) = sk[_c]; \
        *(LAS u32x4*)(lds + (p) * AT_BUF + AT_V + (_idx >> 3) * 144 + (_idx & 7) * 16) = sv[_c]; } } while (0)
    AT_LOAD(0); AT_STORE(0);
    __syncthreads();
    for (int i = 0; i < nt; ++i) {
        const int p = i & 1;
        if (i + 1 < nt) AT_LOAD(i + 1);
        LAS unsigned char* Kb = lds + p * AT_BUF + AT_K + j * (64 * 144); LAS unsigned char* Vb = lds + p * AT_BUF + AT_V;
#pragma unroll
        for (int kb = 0; kb < 2; ++kb) {
            f32x16 s;
#pragma unroll
            for (int r = 0; r < 16; ++r) s[r] = -c2;
#pragma unroll
            for (int kk = 0; kk < 4; ++kk) {
                const bf16x8 a0 = *(const LAS bf16x8*)(Kb + (32 * kb + q32) * 144 + (16 * kk + 8 * hi) * 2);
                s = __builtin_amdgcn_mfma_f32_32x32x16_bf16(a0, qf[kk], s, 0, 0, 0);
            }
#pragma unroll
            for (int r = 0; r < 16; ++r) { s[r] = __builtin_amdgcn_exp2f(s[r]); lsum += s[r]; }
#pragma unroll
            for (int hf = 0; hf < 2; ++hf) {
                const int ks = 2 * kb + hf;
                u32x4 pw;
                pw.x = cvt_pk_bf16(s[8 * hf + 0], s[8 * hf + 1]); pw.y = cvt_pk_bf16(s[8 * hf + 2], s[8 * hf + 3]); pw.z = cvt_pk_bf16(s[8 * hf + 4], s[8 * hf + 5]); pw.w = cvt_pk_bf16(s[8 * hf + 6], s[8 * hf + 7]);
                const bf16x8 pb = __builtin_bit_cast(bf16x8, pw);
#pragma unroll
                for (int vt = 0; vt < 4; ++vt) {
                    const bf16x8 av = *(const LAS bf16x8*)(Vb + (32 * vt + q32) * 144 + (16 * ks + 8 * hi) * 2);
                    o[vt] = __builtin_amdgcn_mfma_f32_32x32x16_bf16(av, pb, o[vt], 0, 0, 0);
                }
            }
        }
        if (i + 1 < nt) AT_STORE(p ^ 1);
        __syncthreads();
    }
#undef AT_LOAD
#undef AT_STORE
    lsum += __shfl_xor(lsum, 32);
    LAS float* xch = (LAS float*)lds + (size_t)qg * 4096 + lane;
    if (j == 1) {
        const float sc = lam / lsum;
#pragma unroll
        for (int vt = 0; vt < 4; ++vt)
#pragma unroll
            for (int r = 0; r < 16; ++r) xch[(vt * 16 + r) * 64] = o[vt][r] * sc;
    }
    __syncthreads();
    if (j == 0) {
        const float i0 = 1.f / lsum;
        float ss = 0.f;
#pragma unroll
        for (int vt = 0; vt < 4; ++vt)
#pragma unroll
            for (int r = 0; r < 16; ++r) { const float v = o[vt][r] * i0 - xch[(vt * 16 + r) * 64]; o[vt][r] = v; ss += v * v; }
        ss += __shfl_xor(ss, 32);
        const float rstd = rsqrtf(ss * (1.f / 128.f) + EPS) * post_scale;
        const size_t row = (size_t)row0 + 32 * qg + q32;
#pragma unroll
        for (int vt = 0; vt < 4; ++vt)
#pragma unroll
            for (int g4 = 0; g4 < 4; ++g4) {
                const int v0 = 32 * vt + 8 * g4 + 4 * hi;
                const u32x2 gz = *(const u32x2*)(dg + row * NZ + v0);
                const f32x4 sl = *(const f32x4*)(subln + v0);
                const float r0 = o[vt][4 * g4 + 0] * rstd * sl[0] * silu_f(bflo(gz.x)), r1 = o[vt][4 * g4 + 1] * rstd * sl[1] * silu_f(bfhi(gz.x));
                const float r2 = o[vt][4 * g4 + 2] * rstd * sl[2] * silu_f(bflo(gz.y)), r3 = o[vt][4 * g4 + 3] * rstd * sl[3] * silu_f(bfhi(gz.y));
                u32x2 wv; wv.x = cvt_pk_bf16(r0, r1); wv.y = cvt_pk_bf16(r2, r3);
                *(u32x2*)(outp + row * 1024 + v0) = wv;
            }
    }
    __syncthreads();
}

__device__ __forceinline__ void phase_mix(const Args& a, int l, LAS unsigned char* lds) {
    const int G = opaque_s(gridDim.x);
    unsigned char* ws = opaque_ptr(a.ws);
    const bool need_ctx = (l == 0);
#ifndef NO_GLA
    for (int it = BID; it < 256; it += G) gla_unit(a, l, lds, it);
#endif
#ifndef NO_ATT
    {
        const float* scal = (const float*)(ws + OFF_SCAL) + l * 4;
        const float lam = scal[0], c2 = scal[1], post = 1.f - scal[2];
        const bf16_t* z = (const bf16_t*)(ws + OFF_Z);
        const int nun = 512 + (need_ctx ? 64 : 0);
        for (int u = BID; u < nun; u += G) {
            if (u < 512) { const int vc = (u & 7) * 64 + (u >> 3), bh = vc >> 4, qb = vc & 15, b = bh >> 3, h = bh & 7;
                attn_unit(lds, (const bf16_t*)(ws + OFF_QN) + (size_t)bh * 2 * SEQ * 64, SEQ, 128 * qb, (const bf16_t*)(ws + OFF_KN) + (size_t)bh * 2 * LK * 64,
                          (const bf16_t*)(ws + OFF_VT) + (size_t)bh * 128 * LK, LK, c2, lam, post, inp(I_SUBLN) + l * 128, z + ZC_DG + h * 128, (bf16_t*)(ws + OFF_DIFFO) + h * 128, b * SEQ + 128 * qb);
            } else { const int uu = u - 512, bh = uu >> 1, qb = uu & 1, b = bh >> 3, h = bh & 7;
                attn_unit(lds, (const bf16_t*)(ws + OFF_QNC) + (size_t)bh * 2 * LC * 64, LC, 128 * qb, (const bf16_t*)(ws + OFF_KN) + (size_t)bh * 2 * LK * 64,
                          (const bf16_t*)(ws + OFF_VT) + (size_t)bh * 128 * LK, LC, c2, lam, post, inp(I_SUBLN) + l * 128, z + ZC_DG + h * 128, (bf16_t*)(ws + OFF_DIFFO) + h * 128, ML + b * LC + 128 * qb);
            }
        }
    }
#endif
#ifndef NO_POOL
    {
        const int Mrows = need_ctx ? MT : ML;
        pg8::Gemm g{(const bf16_t*)(ws + OFF_DPOOL), (const bf16_t*)(ws + OFF_POOLT + (size_t)l * SZ_POOLT), Mrows, 1024, 256, 1024, 256, 256};
        pg8::StaticOrder S; S.init(Mrows, 1024, G, BID);
        pg8::EpiPool E{(bf16_t*)(ws + OFF_POOLO), (const bf16_t*)(ws + OFF_PGATE)};
        pg8::gemm_phase<pg8::EpiPool, pg8::StaticOrder, true, true>(lds, g, S, E);
    }
#endif
}

__device__ __forceinline__ void phase_post(const Args& a, int l) {
    const int tid = opaque_tid(), lane = tid & 63, wave = tid >> 6, G = opaque_s(gridDim.x);
    const int gw = BID * 8 + wave, NGW = G * 8;
    unsigned char* ws = opaque_ptr(a.ws);
    const bf16_t* z = (const bf16_t*)(ws + OFF_Z);
    const bf16_t* of = (const bf16_t*)(ws + OFF_OF); const bf16_t* ob = of + (size_t)MT * 1024;
    bf16_t* go = (bf16_t*)(ws + OFF_GLAO);
    const int Mrows = (l == 0) ? MT : ML;
    const float* gn = inp(I_GLAN) + l * 256 + ((16 * lane) & 255);
    for (int row = gw; row < Mrows; row += NGW) {
        float x[16], y[16], gz[16];
        const size_t o = (size_t)row * 1024 + 16 * lane;
        unpack8(*(const u32x4*)(of + o), x); unpack8(*(const u32x4*)(of + o + 8), x + 8);
        unpack8(*(const u32x4*)(ob + o), y); unpack8(*(const u32x4*)(ob + o + 8), y + 8);
        unpack8(*(const u32x4*)(z + (size_t)row * NZ + ZC_GG + 16 * lane), gz); unpack8(*(const u32x4*)(z + (size_t)row * NZ + ZC_GG + 16 * lane + 8), gz + 8);
        float ss = 0.f;
#pragma unroll
        for (int e = 0; e < 16; ++e) { x[e] += y[e]; ss += x[e] * x[e]; }
        ss += __shfl_xor(ss, 1); ss += __shfl_xor(ss, 2); ss += __shfl_xor(ss, 4); ss += __shfl_xor(ss, 8);
        const float rstd = rsqrtf(ss * (1.f / 256.f) + EPS);
        float r[16];
#pragma unroll
        for (int e = 0; e < 16; ++e) r[e] = x[e] * rstd * gn[e] * silu_f(gz[e]);
        u32x4 w0, w1;
        w0.x = cvt_pk_bf16(r[0], r[1]); w0.y = cvt_pk_bf16(r[2], r[3]); w0.z = cvt_pk_bf16(r[4], r[5]); w0.w = cvt_pk_bf16(r[6], r[7]);
        w1.x = cvt_pk_bf16(r[8], r[9]); w1.y = cvt_pk_bf16(r[10], r[11]); w1.z = cvt_pk_bf16(r[12], r[13]); w1.w = cvt_pk_bf16(r[14], r[15]);
        *(u32x4*)(go + o) = w0; *(u32x4*)(go + o + 8) = w1;
    }
}

__global__ void __launch_bounds__(512, 2) hybrid_fwd(Args a) {
    extern __shared__ __attribute__((aligned(16))) unsigned char smem[];
    LAS unsigned char* lds = (LAS unsigned char*)smem;
    cg::grid_group grid = cg::this_grid();
    for (int ph = a.ph_lo; ph < a.ph_hi; ++ph) {
        if (ph > a.ph_lo) grid.sync();
        unsigned char* ws = opaque_ptr(a.ws);
        const int G = opaque_s(gridDim.x);
#ifndef KMASK
#define KMASK 0xff
#endif
        if (ph == 0) { if (KMASK & 128) phase_p0(a, lds); continue; }
        const int l = (ph - 1) / 7, k = (ph - 1) % 7;
        const int Mout = (l == 0) ? MT : ML;
        if (k == 0) { if (KMASK & 1) phase_norm(a, l); }
        else if (k == 1) { if (KMASK & 2) {
            pg8::Gemm g{(const bf16_t*)(ws + OFF_H), (const bf16_t*)(ws + OFF_WIN + (size_t)l * SZ_WIN), MT, NZ, DM, DM, DM, 0};
            pg8::StaticOrder S; S.init(MT, NZ, G, BID);
            pg8::EpiBf16 E{(bf16_t*)(ws + OFF_Z), NZ};
            pg8::gemm_phase<pg8::EpiBf16, pg8::StaticOrder, true, true>(lds, g, S, E);
        } }
        else if (k == 2) { if (KMASK & 4) phase_prep(a, l, lds); }
        else if (k == 3) { if (KMASK & 8) phase_mix(a, l, lds); }
        else if (k == 4) { if (KMASK & 16) phase_post(a, l); }
        else if (k == 5) { if (KMASK & 32) {
            pg8::StaticOrder S; S.init(Mout, DM, G, BID);
            const bf16_t* zg = (const bf16_t*)(ws + OFF_Z) + ZC_MG;
            float* yacc = (float*)(ws + OFF_YACC); bf16_t* y = (bf16_t*)(ws + OFF_H);
            const bf16_t* wb = (const bf16_t*)(ws + OFF_WB + (size_t)l * SZ_WB);
            { pg8::Gemm g{(const bf16_t*)(ws + OFF_POOLO), wb, Mout, DM, 1024, 1024, 1024, 0}; pg8::EpiMerge<0> E{yacc, y, zg};
              pg8::gemm_phase<pg8::EpiMerge<0>, pg8::StaticOrder, true, true>(lds, g, S, E); }
            { pg8::Gemm g{(const bf16_t*)(ws + OFF_DIFFO), wb + (size_t)DM * 1024, Mout, DM, 1024, 1024, 1024, 0}; pg8::EpiMerge<1> E{yacc, y, zg + 2048};
              pg8::gemm_phase<pg8::EpiMerge<1>, pg8::StaticOrder, true, true>(lds, g, S, E); }
            { pg8::Gemm g{(const bf16_t*)(ws + OFF_GLAO), wb + (size_t)2 * DM * 1024, Mout, DM, 1024, 1024, 1024, 0}; pg8::EpiMerge<2> E{yacc, y, zg + 4096};
              pg8::gemm_phase<pg8::EpiMerge<2>, pg8::StaticOrder, true, true>(lds, g, S, E); }
        } }
        else if (KMASK & 64) {
            pg8::Gemm g{(const bf16_t*)(ws + OFF_H), (const bf16_t*)(ws + OFF_WOUT + (size_t)l * SZ_WOUT), Mout, DM, DM, DM, DM, 0};
            pg8::StaticOrder S; S.init(Mout, DM, G, BID);
            pg8::EpiOut E{l == 0 ? inp(I_X) : (const float*)(ws + OFF_X1), l == 0 ? inp(I_CTX) : (const float*)(ws + OFF_X1) + (size_t)ML * DM,
                          l == 0 ? (float*)(ws + OFF_X1) : arg_out(), (const float*)(ws + OFF_MOD) + (size_t)l * 5 * 6144};
            pg8::gemm_phase<pg8::EpiOut, pg8::StaticOrder, true, true>(lds, g, S, E);
        }
    }
}

extern "C" void kernel_launch(void* const* d_in, const int* in_sizes, int n_in, void* d_out, int out_size, void* d_ws, size_t ws_size, hipStream_t stream) {
    static int grid = 0;
    if (grid == 0) {
        if (n_in != 26 || out_size != ML * DM || ws_size < WS_END) { fprintf(stderr, "kernel_launch: expected 26 inputs, out %d, ws >= %zu; got n_in %d out %d ws %zu\n", ML * DM, (size_t)WS_END, n_in, out_size, ws_size); grid = -1; return; }
        int dev = 0, cus = 0, per_cu = 0;
        if (hipGetDevice(&dev) != hipSuccess || hipDeviceGetAttribute(&cus, hipDeviceAttributeMultiprocessorCount, dev) != hipSuccess) { grid = -1; return; }
        if (hipFuncSetAttribute((const void*)hybrid_fwd, hipFuncAttributeMaxDynamicSharedMemorySize, LDS_BYTES) != hipSuccess) { fprintf(stderr, "kernel_launch: hipFuncSetAttribute failed\n"); grid = -1; return; }
        if (hipOccupancyMaxActiveBlocksPerMultiprocessor(&per_cu, (const void*)hybrid_fwd, 512, LDS_BYTES) != hipSuccess || per_cu < 1) { fprintf(stderr, "kernel_launch: occupancy query says %d blocks per CU\n", per_cu); (void)hipGetLastError(); grid = -1; return; }
        grid = cus;
    }
    if (grid < 0) return;
    Args a{};
    for (int i = 0; i < 26; ++i) a.in[i] = (const float*)d_in[i];
    a.out = (float*)d_out; a.ws = (unsigned char*)d_ws;
    const int nl = MK_N_LAUNCHES;
    for (int li = 0; li < nl; ++li) {
        a.ph_lo = (nl == 1) ? 0 : li; a.ph_hi = (nl == 1) ? NPH : li + 1;
        void* args[] = {&a};
        const hipError_t e = hipLaunchCooperativeKernel((const void*)hybrid_fwd, dim3(grid), dim3(512), args, LDS_BYTES, stream);
        if (e != hipSuccess) { fprintf(stderr, "kernel_launch: cooperative launch %d failed: %s (grid %d)\n", li, hipGetErrorString(e), grid); break; }
    }
}
```

```cpp
#include <hip/hip_runtime.h>
#include <hip/hip_cooperative_groups.h>
#include <cstdio>
#include <cstdint>
namespace cg = cooperative_groups;

#ifndef MK_N_LAUNCHES
#define MK_N_LAUNCHES 1
#endif

#define LAS __attribute__((address_space(3)))
typedef unsigned short bf16_t;
typedef short bf16x8 __attribute__((ext_vector_type(8)));
typedef float f32x4 __attribute__((ext_vector_type(4)));
typedef float f32x16 __attribute__((ext_vector_type(16)));
typedef unsigned u32x4 __attribute__((ext_vector_type(4)));
typedef unsigned u32x2 __attribute__((ext_vector_type(2)));

constexpr int DM = 2048, NB = 4, SEQ = 2048, LC = 256, ML = NB * SEQ, MC = NB * LC, MT = ML + MC;
constexpr int DIN = 15392, NZ = 15616;
constexpr int ZC_PU = 0, ZC_PG = 1024, ZC_DQ = 2048, ZC_DK = 3072, ZC_DV = 4096, ZC_DG = 5120, ZC_GQ = 6144, ZC_GK = 6656, ZC_GV = 7168, ZC_GG = 8192, ZC_LR = 9216, ZC_MG = 9472;
constexpr int LK = LC + SEQ;
constexpr float EPS = 1e-6f, LOG2E = 1.4426950408889634f;
constexpr int NPH = 15;

constexpr size_t SZ_WIN = (size_t)NZ * DM * 2, SZ_WB = (size_t)3 * DM * 1024 * 2, SZ_WOUT = (size_t)DM * DM * 2, SZ_POOLT = (size_t)4 * 256 * 256 * 2;
constexpr size_t OFF_WIN = 0;
constexpr size_t OFF_WB = OFF_WIN + 2 * SZ_WIN;
constexpr size_t OFF_WOUT = OFF_WB + 2 * SZ_WB;
constexpr size_t OFF_POOLT = OFF_WOUT + 2 * SZ_WOUT;
constexpr size_t OFF_MOD = OFF_POOLT + 2 * SZ_POOLT;
constexpr size_t OFF_SCAL = OFF_MOD + (size_t)2 * 5 * 6144 * 4;
constexpr size_t OFF_H = OFF_SCAL + 256;
constexpr size_t OFF_Z = OFF_H + (size_t)MT * DM * 2;
constexpr size_t OFF_QN = OFF_Z + (size_t)MT * NZ * 2;
constexpr size_t OFF_QNC = OFF_QN + (size_t)ML * 1024 * 2;
constexpr size_t OFF_KN = OFF_QNC + (size_t)MC * 1024 * 2;
constexpr size_t OFF_VT = OFF_KN + (size_t)MT * 1024 * 2;
constexpr size_t SZ_G = (size_t)MT * 512 * 2;
constexpr size_t OFF_GQ = OFF_VT + (size_t)MT * 1024 * 2;
constexpr size_t OFF_GK = OFF_GQ + 2 * SZ_G;
constexpr size_t OFF_GH = OFF_GK + 2 * SZ_G;
constexpr size_t OFF_DEC = OFF_GH + 2 * SZ_G;
constexpr size_t OFF_OF = OFF_DEC + (size_t)2 * 144 * 512 * 4;
constexpr size_t OFF_DPOOL = OFF_OF + 2 * (size_t)MT * 1024 * 2;
constexpr size_t OFF_POOLO = OFF_DPOOL + (size_t)MT * 1024 * 2;
constexpr size_t OFF_DIFFO = OFF_POOLO + (size_t)MT * 1024 * 2;
constexpr size_t OFF_GLAO = OFF_DIFFO + (size_t)MT * 1024 * 2;
constexpr size_t OFF_YACC = OFF_GLAO + (size_t)MT * 1024 * 2;
constexpr size_t OFF_X1 = OFF_YACC + (size_t)MT * DM * 4;
constexpr size_t OFF_PGATE = OFF_X1 + (size_t)MT * DM * 4;
constexpr size_t WS_END = OFF_PGATE + (size_t)MT * 1024 * 2;

constexpr int LDS_BYTES = 135168;

#define BID opaque_s((int)blockIdx.x)
__device__ __forceinline__ unsigned char* opaque_ptr(unsigned char* p) { asm volatile("" : "+s"(p)); return p; }
__device__ __forceinline__ int opaque_s(int v) { asm volatile("" : "+s"(v)); return v; }
__device__ __forceinline__ int opaque_tid() { int t = threadIdx.x; asm volatile("" : "+v"(t)); return t; }
typedef float f32x2_t __attribute__((ext_vector_type(2))); typedef __bf16 bf16x2_t __attribute__((ext_vector_type(2)));
__device__ __forceinline__ unsigned cvt_pk_bf16(float lo, float hi) { f32x2_t v = {lo, hi}; bf16x2_t b = __builtin_convertvector(v, bf16x2_t); return __builtin_bit_cast(unsigned, b); }
__device__ __forceinline__ bf16_t f2bf(float f) { return (bf16_t)(cvt_pk_bf16(f, 0.f) & 0xffffu); }
__device__ __forceinline__ float bf2f(bf16_t v) { return __builtin_bit_cast(float, (unsigned)v << 16); }
__device__ __forceinline__ float bflo(unsigned u) { return __builtin_bit_cast(float, u << 16); }
__device__ __forceinline__ float bfhi(unsigned u) { return __builtin_bit_cast(float, u & 0xffff0000u); }
__device__ __forceinline__ float silu_f(float x) { return x / (1.f + __expf(-x)); }
__device__ __forceinline__ float sigmoid_f(float x) { return 1.f / (1.f + __expf(-x)); }
__device__ __forceinline__ float logsig_f(float a) { return fminf(a, 0.f) - log1pf(__expf(-fabsf(a))); }
__device__ __forceinline__ float wave_sum(float v) {
#pragma unroll
    for (int o = 1; o < 64; o <<= 1) v += __shfl_xor(v, o);
    return v;
}
__device__ __forceinline__ float wave_max(float v) {
#pragma unroll
    for (int o = 1; o < 64; o <<= 1) v = fmaxf(v, __shfl_xor(v, o));
    return v;
}
__device__ __forceinline__ void unpack8(u32x4 w, float* f) { f[0] = bflo(w.x); f[1] = bfhi(w.x); f[2] = bflo(w.y); f[3] = bfhi(w.y); f[4] = bflo(w.z); f[5] = bfhi(w.z); f[6] = bflo(w.w); f[7] = bfhi(w.w); }

namespace pg8 {
constexpr int BM = 256, BK = 64, HALF = 128, HTB = HALF * BK * 2, STAGE_BYTES = 8 * HTB, NXCD = 8, WGM = 8;
__host__ __device__ __forceinline__ int lds_byte(int r, int c) { const int st = (r >> 4) * 2 + (c >> 5), rr = r & 15, cc = c & 31, ob = rr * 64 + cc * 2; return st * 1024 + (ob ^ (((ob >> 9) & 1) << 5)); }
__host__ __device__ __forceinline__ void stage_rc(int b, int& R, int& C) { const int st = b / 1024, sb = b % 1024, swz = sb ^ (((sb >> 9) & 1) << 5); R = (st >> 1) * 16 + swz / 64; C = (st & 1) * 32 + (swz % 64) / 2; }
__host__ __device__ __forceinline__ int perm32(int rho) { const int n = rho >> 4, i = rho & 15; return 8 * (i >> 2) + 4 * n + (i & 3); }

struct Unit { int pm, pn; };
struct Gemm { const bf16_t* A; const bf16_t* Bt; int M, N, K; int lda, ldb; int a_pn_off; };

struct StaticOrder {
    int nM, nN, nwg, G, c;
    __host__ __device__ void init(int M, int N, int G_, int c_) { nM = M / BM; nN = N / BM; nwg = nM * nN; G = G_; c = c_; }
    __host__ __device__ bool next(int i, Unit& u) const {
        const long L = (long)i * G + c; if (L >= nwg) return false;
        int wgid = (int)L; { const int q = nwg / NXCD, r = nwg % NXCD, xcd = wgid % NXCD, off = wgid / NXCD; wgid = (xcd < r ? xcd * (q + 1) : r * (q + 1) + (xcd - r) * q) + off; }
        const int nig = WGM * nN, gid = wgid / nig, fm = gid * WGM, gsz = (nM - fm) < WGM ? (nM - fm) : WGM;
        u.pm = fm + ((wgid % nig) % gsz); u.pn = (wgid % nig) / gsz; return true;
    }
    __device__ __forceinline__ void a_ready(const Unit&) const {}
    __device__ __forceinline__ void done(const Unit&) const {}
};

struct EpiBf16 {
    static constexpr bool PERM = true, AFTER_DRAIN = false;
    bf16_t* O; int ldc;
    __device__ __forceinline__ void operator()(const f32x4 (&acc)[2][2][4][2], const Unit& u, int wr, int wc, int fr, int fq) const {
        const int row0 = u.pm * BM + wr * 64 + fr, col0 = u.pn * BM + wc * 32 + 8 * fq;
#pragma unroll
        for (int ai = 0; ai < 2; ++ai)
#pragma unroll
            for (int m = 0; m < 4; ++m) { bf16_t* rowp = O + (size_t)(row0 + ai * HALF + m * 16) * ldc + col0;
#pragma unroll
                for (int bj = 0; bj < 2; ++bj) { const f32x4 v0 = acc[ai][bj][m][0], v1 = acc[ai][bj][m][1];
                    u32x4 w; w.x = cvt_pk_bf16(v0[0], v0[1]); w.y = cvt_pk_bf16(v0[2], v0[3]); w.z = cvt_pk_bf16(v1[0], v1[1]); w.w = cvt_pk_bf16(v1[2], v1[3]);
                    *(u32x4*)(rowp + bj * HALF) = w; } }
    }
};

template <class Epi, class Sched, bool ALIGN_EPI = false, bool SP2 = false>
__device__ __forceinline__ void gemm_phase(LAS unsigned char* lds, const Gemm g, const Sched& S, const Epi& E) {
    const int tid = opaque_tid(), wid = __builtin_amdgcn_readfirstlane(tid >> 6), lane = tid & 63, wr = wid >> 2, wc = wid & 3, fr = lane & 15, fq = lane >> 4;
    const int K = opaque_s(g.K), nt = K / BK;
    unsigned voffA[2], voffB[2];
#pragma unroll
    for (int i = 0; i < 2; ++i) { int R, C; stage_rc(tid * 16 + i * 8192, R, C); const int Rb = Epi::PERM ? ((R & ~31) + perm32(R & 31)) : R;
        voffA[i] = (unsigned)(R * g.lda + C) * 2u; voffB[i] = (unsigned)(Rb * g.ldb + C) * 2u; }
    const size_t kstep = (size_t)(BK * 2);
    const size_t hstepA = (size_t)HALF * g.lda * 2, hstepB = (size_t)HALF * g.ldb * 2;
    const size_t tstepA = 2 * hstepA, tstepB = 2 * hstepB;
    const size_t pnA = (size_t)g.a_pn_off * 2;
    const unsigned ldsw = (unsigned)wid * 1024u;
    const int aoff = lds_byte(wr * 64 + fr, fq * 8), boff = lds_byte(wc * 32 + fr, fq * 8);
#define PG8_SA(b, h) (((b) * 2 + (h)) * HTB)
#define PG8_SB(b, h) ((4 + (b) * 2 + (h)) * HTB)
#define PG8_STAGE(bufoff, gbase, voff) do { _Pragma("unroll") for (int _i = 0; _i < 2; ++_i) \
        __builtin_amdgcn_global_load_lds((const unsigned*)((const char*)(gbase) + (voff)[_i]), (LAS unsigned*)(lds + (bufoff) + ldsw + _i * 8192), 16, 0, 0); } while (0)
#define PG8_LDA(dst, b, h) do { _Pragma("unroll") for (int m = 0; m < 4; ++m) _Pragma("unroll") for (int k = 0; k < 2; ++k) dst[m][k] = *(const LAS bf16x8*)(lds + PG8_SA(b, h) + aoff + m * 2048 + k * 1024); } while (0)
#define PG8_LDB(dst, b, h) do { _Pragma("unroll") for (int n = 0; n < 2; ++n) _Pragma("unroll") for (int k = 0; k < 2; ++k) dst[n][k] = *(const LAS bf16x8*)(lds + PG8_SB(b, h) + boff + n * 2048 + k * 1024); } while (0)
#define PG8_MMA(ai, bj, At, Bt) do { __builtin_amdgcn_s_setprio(1); _Pragma("unroll") for (int m = 0; m < 4; ++m) _Pragma("unroll") for (int n = 0; n < 2; ++n) _Pragma("unroll") for (int k = 0; k < 2; ++k) \
        acc[ai][bj][m][n] = __builtin_amdgcn_mfma_f32_16x16x32_bf16(Bt[n][k], At[m][k], acc[ai][bj][m][n], 0, 0, 0); __builtin_amdgcn_s_setprio(0); } while (0)
#define PG8_WAIT_V(n) asm volatile("s_waitcnt vmcnt(" #n ")" ::: "memory")
#define PG8_WAIT_L(n) asm volatile("s_waitcnt lgkmcnt(" #n ")" ::: "memory")
#define PG8_BAR __builtin_amdgcn_s_barrier()
#define PG8_SCHED __builtin_amdgcn_sched_barrier(0)
    Unit cur, nxt; int ui = 0;
    if (!S.next(0, cur)) return;
    f32x4 acc[2][2][4][2];
#pragma unroll
    for (int a = 0; a < 2; ++a)
#pragma unroll
        for (int b = 0; b < 2; ++b)
#pragma unroll
            for (int m = 0; m < 4; ++m)
#pragma unroll
                for (int n = 0; n < 2; ++n) acc[a][b][m][n] = (f32x4){0.f, 0.f, 0.f, 0.f};
    bf16x8 At[4][2], B0[2][2], B1[2][2];
    const char* cA = (const char*)g.A + (size_t)cur.pm * tstepA + (size_t)cur.pn * pnA; const char* cB = (const char*)g.Bt + (size_t)cur.pn * tstepB;
    S.a_ready(cur);
    if constexpr (SP2) {
        PG8_STAGE(PG8_SB(0, 0), cB, voffB); PG8_STAGE(PG8_SB(0, 1), cB + hstepB, voffB); PG8_STAGE(PG8_SA(0, 0), cA, voffA); PG8_STAGE(PG8_SA(0, 1), cA + hstepA, voffA);
        if (wr == 1) PG8_BAR;
        PG8_WAIT_V(2); PG8_BAR;
        PG8_STAGE(PG8_SB(1, 0), cB + kstep, voffB); PG8_STAGE(PG8_SA(1, 0), cA + kstep, voffA); PG8_STAGE(PG8_SB(1, 1), cB + hstepB + kstep, voffB);
        PG8_WAIT_V(6); PG8_BAR;
    } else {
        PG8_STAGE(PG8_SB(0, 0), cB, voffB); PG8_STAGE(PG8_SA(0, 0), cA, voffA); PG8_STAGE(PG8_SB(0, 1), cB + hstepB, voffB); PG8_STAGE(PG8_SA(0, 1), cA + hstepA, voffA);
        if (wr == 1) PG8_BAR;
        PG8_WAIT_V(4); PG8_BAR;
        PG8_STAGE(PG8_SB(1, 0), cB + kstep, voffB); PG8_STAGE(PG8_SA(1, 0), cA + kstep, voffA); PG8_STAGE(PG8_SB(1, 1), cB + hstepB + kstep, voffB);
        PG8_WAIT_V(6); PG8_BAR;
    }
    for (;;) {
        const bool has_next = S.next(ui + 1, nxt);
        const char* nA = has_next ? (const char*)g.A + (size_t)nxt.pm * tstepA + (size_t)nxt.pn * pnA : cA; const char* nB = has_next ? (const char*)g.Bt + (size_t)nxt.pn * tstepB : cB;
        for (int t = 0; t < nt; t += 2) {
            const bool last = (t == nt - 2);
            const char* a1 = cA + (size_t)(t + 1) * kstep;
            const char* a2 = last ? nA : cA + (size_t)(t + 2) * kstep; const char* b2 = last ? nB : cB + (size_t)(t + 2) * kstep;
            const char* a3 = a2 + kstep; const char* b3 = b2 + kstep;
            if (last && has_next) S.a_ready(nxt);
            if constexpr (SP2) {
            PG8_LDB(B0, 0, 0); PG8_LDB(B1, 0, 1); PG8_SCHED; PG8_LDA(At, 0, 0); PG8_STAGE(PG8_SA(1, 1), a1 + hstepA, voffA);
            PG8_WAIT_V(8); PG8_WAIT_L(0); PG8_BAR; PG8_MMA(0, 0, At, B0); PG8_MMA(0, 1, At, B1); PG8_BAR; PG8_SCHED;
            PG8_LDA(At, 0, 1); PG8_STAGE(PG8_SB(0, 0), b2, voffB); PG8_STAGE(PG8_SB(0, 1), b2 + hstepB, voffB); PG8_STAGE(PG8_SA(0, 0), a2, voffA);
            PG8_WAIT_V(8); PG8_WAIT_L(0); PG8_BAR; PG8_MMA(1, 0, At, B0); PG8_MMA(1, 1, At, B1); PG8_BAR; PG8_SCHED;
            PG8_LDB(B0, 1, 0); PG8_LDB(B1, 1, 1); PG8_SCHED; PG8_LDA(At, 1, 0); PG8_STAGE(PG8_SA(0, 1), a2 + hstepA, voffA);
            PG8_WAIT_V(8); PG8_WAIT_L(0); PG8_BAR; PG8_MMA(0, 0, At, B0); PG8_MMA(0, 1, At, B1); PG8_BAR; PG8_SCHED;
            PG8_LDA(At, 1, 1); PG8_STAGE(PG8_SB(1, 0), b3, voffB); PG8_STAGE(PG8_SB(1, 1), b3 + hstepB, voffB); PG8_STAGE(PG8_SA(1, 0), a3, voffA);
            PG8_WAIT_V(8); PG8_WAIT_L(0); PG8_BAR; PG8_MMA(1, 0, At, B0); PG8_MMA(1, 1, At, B1); PG8_BAR; PG8_SCHED;
            } else {
            PG8_LDB(B0, 0, 0); PG8_SCHED; PG8_LDA(At, 0, 0); PG8_STAGE(PG8_SA(1, 1), a1 + hstepA, voffA);
            PG8_WAIT_L(8); PG8_BAR; PG8_WAIT_L(0); PG8_MMA(0, 0, At, B0); PG8_BAR; PG8_SCHED;
            PG8_LDB(B1, 0, 1); PG8_STAGE(PG8_SB(0, 0), b2, voffB);
            PG8_BAR; PG8_WAIT_L(0); PG8_MMA(0, 1, At, B1); PG8_BAR;
            PG8_LDA(At, 0, 1); PG8_STAGE(PG8_SA(0, 0), a2, voffA);
            PG8_BAR; PG8_WAIT_L(0); PG8_MMA(1, 0, At, B0); PG8_BAR; PG8_SCHED;
            PG8_STAGE(PG8_SB(0, 1), b2 + hstepB, voffB);
            PG8_WAIT_V(6); PG8_BAR; PG8_MMA(1, 1, At, B1); PG8_BAR;
            PG8_LDB(B0, 1, 0); PG8_SCHED; PG8_LDA(At, 1, 0); PG8_STAGE(PG8_SA(0, 1), a2 + hstepA, voffA);
            PG8_WAIT_L(8); PG8_BAR; PG8_WAIT_L(0); PG8_MMA(0, 0, At, B0); PG8_BAR; PG8_SCHED;
            PG8_LDB(B1, 1, 1); PG8_STAGE(PG8_SB(1, 0), b3, voffB);
            PG8_BAR; PG8_WAIT_L(0); PG8_MMA(0, 1, At, B1); PG8_BAR;
            PG8_LDA(At, 1, 1); PG8_STAGE(PG8_SA(1, 0), a3, voffA);
            PG8_BAR; PG8_WAIT_L(0); PG8_MMA(1, 0, At, B0); PG8_BAR; PG8_SCHED;
            PG8_STAGE(PG8_SB(1, 1), b3 + hstepB, voffB);
            PG8_WAIT_V(6); PG8_BAR; PG8_MMA(1, 1, At, B1); PG8_BAR;
            }
        }
        if constexpr (ALIGN_EPI) { if (wr == 0) PG8_BAR; }
        E(acc, cur, wr, wc, fr, fq); S.done(cur);
        if (!has_next) break;
#pragma unroll
        for (int a = 0; a < 2; ++a)
#pragma unroll
            for (int b = 0; b < 2; ++b)
#pragma unroll
                for (int m = 0; m < 4; ++m)
#pragma unroll
                    for (int n = 0; n < 2; ++n) acc[a][b][m][n] = (f32x4){0.f, 0.f, 0.f, 0.f};
        cur = nxt; cA = nA; cB = nB; ++ui;
        if constexpr (ALIGN_EPI) { if (wr == 1) PG8_BAR; }
    }
    PG8_WAIT_V(0);
    if constexpr (!ALIGN_EPI) { if (wr == 0) PG8_BAR; }
    PG8_BAR;
#undef PG8_SA
#undef PG8_SB
#undef PG8_STAGE
#undef PG8_LDA
#undef PG8_LDB
#undef PG8_MMA
#undef PG8_WAIT_V
#undef PG8_WAIT_L
#undef PG8_BAR
#undef PG8_SCHED
}

struct EpiPool {
    static constexpr bool PERM = true, AFTER_DRAIN = false;
    bf16_t* O; const bf16_t* pgate;
    __device__ __forceinline__ void operator()(const f32x4 (&acc)[2][2][4][2], const Unit& u, int wr, int wc, int fr, int fq) const {
        const int row0 = u.pm * BM + wr * 64 + fr, col0 = u.pn * BM + wc * 32 + 8 * fq;
#pragma unroll
        for (int ai = 0; ai < 2; ++ai)
#pragma unroll
            for (int m = 0; m < 4; ++m)
#pragma unroll
                for (int bj = 0; bj < 2; ++bj) {
                    const int row = row0 + ai * HALF + m * 16, col = col0 + bj * HALF;
                    const u32x4 gz = *(const u32x4*)(pgate + (size_t)row * 1024 + col);
                    const f32x4 v0 = acc[ai][bj][m][0], v1 = acc[ai][bj][m][1];
                    u32x4 w;
                    w.x = cvt_pk_bf16(v0[0] * bflo(gz.x), v0[1] * bfhi(gz.x));
                    w.y = cvt_pk_bf16(v0[2] * bflo(gz.y), v0[3] * bfhi(gz.y));
                    w.z = cvt_pk_bf16(v1[0] * bflo(gz.z), v1[1] * bfhi(gz.z));
                    w.w = cvt_pk_bf16(v1[2] * bflo(gz.w), v1[3] * bfhi(gz.w));
                    *(u32x4*)(O + (size_t)row * 1024 + col) = w;
                    __builtin_amdgcn_sched_barrier(0);
                }
    }
};
template <int PASS> struct EpiMerge {
    static constexpr bool PERM = true, AFTER_DRAIN = false;
    float* yacc; bf16_t* y; const bf16_t* zg;
    __device__ __forceinline__ void operator()(const f32x4 (&acc)[2][2][4][2], const Unit& u, int wr, int wc, int fr, int fq) const {
        const int row0 = u.pm * BM + wr * 64 + fr, col0 = u.pn * BM + wc * 32 + 8 * fq;
#pragma unroll
        for (int ai = 0; ai < 2; ++ai)
#pragma unroll
            for (int m = 0; m < 4; ++m)
#pragma unroll
                for (int bj = 0; bj < 2; ++bj) {
                    const int row = row0 + ai * HALF + m * 16, col = col0 + bj * HALF;
                    float gz[8]; unpack8(*(const u32x4*)(zg + (size_t)row * NZ + col), gz);
                    const f32x4 v0 = acc[ai][bj][m][0], v1 = acc[ai][bj][m][1];
                    f32x4 r0, r1;
#pragma unroll
                    for (int e = 0; e < 4; ++e) { r0[e] = v0[e] * sigmoid_f(gz[e]); r1[e] = v1[e] * sigmoid_f(gz[4 + e]); }
                    float* yp = yacc + (size_t)row * DM + col;
                    if (PASS >= 1) { r0 += *(const f32x4*)yp; r1 += *(const f32x4*)(yp + 4); }
                    if (PASS <= 1) { *(f32x4*)yp = r0; *(f32x4*)(yp + 4) = r1; }
                    else { u32x4 w; w.x = cvt_pk_bf16(r0[0], r0[1]); w.y = cvt_pk_bf16(r0[2], r0[3]); w.z = cvt_pk_bf16(r1[0], r1[1]); w.w = cvt_pk_bf16(r1[2], r1[3]);
                        *(u32x4*)(y + (size_t)row * DM + col) = w; }
                    __builtin_amdgcn_sched_barrier(0);
                }
    }
};
struct EpiOut {
    static constexpr bool PERM = true, AFTER_DRAIN = false;
    const float* xlat; const float* xctx; float* xnew; const float* mod;
    __device__ __forceinline__ void operator()(const f32x4 (&acc)[2][2][4][2], const Unit& u, int wr, int wc, int fr, int fq) const {
        const int row0 = u.pm * BM + wr * 64 + fr, col0 = u.pn * BM + wc * 32 + 8 * fq;
        const int tile_row = u.pm * BM; const int mr = tile_row < ML ? tile_row / SEQ : 4;
        const float* xo = tile_row < ML ? xlat : (xctx - (size_t)ML * DM);
        const float* gm = mod + mr * 6144 + 4096;
#pragma unroll
        for (int ai = 0; ai < 2; ++ai)
#pragma unroll
            for (int m = 0; m < 4; ++m)
#pragma unroll
                for (int bj = 0; bj < 2; ++bj) {
                    const int row = row0 + ai * HALF + m * 16, col = col0 + bj * HALF;
                    const f32x4 g0 = *(const f32x4*)(gm + col), g1 = *(const f32x4*)(gm + col + 4);
                    const float* xp = xo + (size_t)row * DM + col;
                    const f32x4 r0 = *(const f32x4*)xp + g0 * acc[ai][bj][m][0], r1 = *(const f32x4*)(xp + 4) + g1 * acc[ai][bj][m][1];
                    float* op = xnew + (size_t)row * DM + col;
                    *(f32x4*)op = r0; *(f32x4*)(op + 4) = r1;
                    __builtin_amdgcn_sched_barrier(0);
                }
    }
};
}

struct Args { const float* in[26]; float* out; unsigned char* ws; int ph_lo, ph_hi; };
enum { I_X = 0, I_C, I_CTX, I_CCTX, I_NORMG, I_WADA, I_BADA, I_WIN, I_POOLW, I_POOLS, I_QNORM, I_KNORM, I_LQ1, I_LK1, I_LQ2, I_LK2, I_SUBLN, I_WGF, I_BGF, I_WGB, I_BGB, I_GLAN, I_WBP, I_WBD, I_WBG, I_WOUT };

__device__ __forceinline__ const float* inp(int i) { const float* const volatile __attribute__((address_space(4)))* kp = (const float* const volatile __attribute__((address_space(4)))*)__builtin_amdgcn_kernarg_segment_ptr(); return kp[i]; }
__device__ __forceinline__ float* arg_out() { float* const volatile __attribute__((address_space(4)))* kp = (float* const volatile __attribute__((address_space(4)))*)__builtin_amdgcn_kernarg_segment_ptr(); return kp[26]; }
__device__ __forceinline__ void transpose_item(const float* W, int K, int N, bf16_t* WT, int row_off, LAS float* scr, int kb, int nb, int lane) {
    const int k0 = 64 * kb, n0 = 32 * nb;
#pragma unroll 8
    for (int i = 0; i < 32; ++i) { const int kk = 2 * i + (lane >> 5); scr[kk * 33 + (lane & 31)] = W[(size_t)(k0 + kk) * N + n0 + (lane & 31)]; }
    asm volatile("s_waitcnt lgkmcnt(0)" ::: "memory");
    const int c = lane & 7;
#pragma unroll
    for (int j = 0; j < 4; ++j) { const int n = (lane >> 3) + 8 * j; const LAS float* s = scr + (8 * c) * 33 + n;
        u32x4 o; o.x = cvt_pk_bf16(s[0 * 33], s[1 * 33]); o.y = cvt_pk_bf16(s[2 * 33], s[3 * 33]); o.z = cvt_pk_bf16(s[4 * 33], s[5 * 33]); o.w = cvt_pk_bf16(s[6 * 33], s[7 * 33]);
        *(u32x4*)(WT + (size_t)(row_off + n0 + n) * K + k0 + 8 * c) = o; }
    asm volatile("s_waitcnt lgkmcnt(0)" ::: "memory");
}

__device__ __forceinline__ void phase_p0(const Args& a, LAS unsigned char* lds) {
    const int tid = opaque_tid(), lane = tid & 63, wave = __builtin_amdgcn_readfirstlane(tid >> 6), G = opaque_s(gridDim.x);
    unsigned char* ws = opaque_ptr(a.ws);
    {
        LAS float* sc = (LAS float*)(lds + 69632);
        LAS float* part = (LAS float*)(lds + 69632 + 40960);
        if (BID < 192) {
            for (int i = tid; i < 5 * 2048; i += 512) { const int r = i >> 11, k = i & 2047; const float v = r < 4 ? inp(I_C)[r * 2048 + k] : inp(I_CCTX)[k]; sc[i] = silu_f(v); }
            __syncthreads();
        }
        for (int it = BID; it < 192; it += G) {
            const int l = it / 96, cgp = it % 96, col = cgp * 64 + lane;
            const float* W = inp(I_WADA) + (size_t)l * 2048 * 6144 + col;
            float acc[5] = {0.f, 0.f, 0.f, 0.f, 0.f};
#pragma unroll 8
            for (int kk = 0; kk < 256; ++kk) { const int k = wave * 256 + kk; const float wv = W[(size_t)k * 6144];
#pragma unroll
                for (int r = 0; r < 5; ++r) acc[r] += sc[r * 2048 + k] * wv; }
#pragma unroll
            for (int r = 0; r < 5; ++r) part[(wave * 5 + r) * 64 + lane] = acc[r];
            __syncthreads();
            if (tid < 320) { const int r = tid >> 6, ln = tid & 63; float s = inp(I_BADA)[l * 6144 + cgp * 64 + ln];
#pragma unroll
                for (int w = 0; w < 8; ++w) s += part[(w * 5 + r) * 64 + ln];
                ((float*)(ws + OFF_MOD))[(l * 5 + r) * 6144 + cgp * 64 + ln] = s; }
            __syncthreads();
        }
    }
    if (BID == G - 1 && wave == 0) {
        for (int l = 0; l < 2; ++l) {
            const float s1 = wave_sum(inp(I_LQ1)[l * 64 + lane] * inp(I_LK1)[l * 64 + lane]);
            const float s2 = wave_sum(inp(I_LQ2)[l * 64 + lane] * inp(I_LK2)[l * 64 + lane]);
            const float mq = wave_max(fabsf(inp(I_QNORM)[l * 64 + lane])), mk = wave_max(fabsf(inp(I_KNORM)[l * 64 + lane]));
            const float lam_init = 0.8f - 0.6f * expf(-0.3f * (float)l);
            if (lane == 0) { float* sp = (float*)(ws + OFF_SCAL) + l * 4; sp[0] = expf(s1) - expf(s2) + lam_init; sp[1] = 8.f * LOG2E * mq * mk; sp[2] = lam_init; sp[3] = 0.f; }
        }
    }
    {
        const int nper = 224 * 2048 * 2 / 16;
        for (int i = BID * 512 + tid; i < 2 * nper; i += G * 512) { const int l = i / nper, j = i % nper;
            *(u32x4*)(ws + OFF_WIN + (size_t)l * SZ_WIN + (size_t)9248 * DM * 2 + (size_t)j * 16) = (u32x4){0u, 0u, 0u, 0u}; }
    }
    {
        LAS float* scr = (LAS float*)(lds + wave * 8704);
        const int gw = BID * 8 + wave, NGW = G * 8;
        constexpr int I_IN = 32 * 481, I_B = 16 * 64, I_O = 32 * 64, I_P = 4 * 32, PER_L = I_IN + 3 * I_B + I_O + I_P;
        for (int it = gw; it < 2 * PER_L; it += NGW) {
            const int l = it / PER_L; int r = it % PER_L;
            if (r < I_IN) { const int kb = r / 481, nb = r % 481;
                transpose_item(inp(I_WIN) + (size_t)l * DM * DIN, DM, DIN, (bf16_t*)(ws + OFF_WIN + (size_t)l * SZ_WIN), nb >= 289 ? 224 : 0, scr, kb, nb, lane); continue; }
            r -= I_IN;
            if (r < 3 * I_B) { const int br = r / I_B, rr = r % I_B; const float* W = (br == 0 ? inp(I_WBP) : br == 1 ? inp(I_WBD) : inp(I_WBG)) + (size_t)l * 1024 * DM;
                transpose_item(W, 1024, DM, (bf16_t*)(ws + OFF_WB + (size_t)l * SZ_WB + (size_t)br * DM * 1024 * 2), 0, scr, rr / 64, rr % 64, lane); continue; }
            r -= 3 * I_B;
            if (r < I_O) { transpose_item(inp(I_WOUT) + (size_t)l * DM * DM, DM, DM, (bf16_t*)(ws + OFF_WOUT + (size_t)l * SZ_WOUT), 0, scr, r / 64, r % 64, lane); continue; }
            r -= I_O;
            { const int g = r / 32, rr = r % 32;
              transpose_item(inp(I_POOLW) + (size_t)(l * 4 + g) * 65536, 256, 256, (bf16_t*)(ws + OFF_POOLT + (size_t)l * SZ_POOLT + (size_t)g * 65536 * 2), 0, scr, rr / 8, rr % 8, lane); }
        }
    }
}

__device__ __forceinline__ void phase_norm(const Args& a, int l) {
    const int tid = opaque_tid(), lane = tid & 63, wave = tid >> 6, G = opaque_s(gridDim.x);
    const int gw = BID * 8 + wave, NGW = G * 8;
    const float* mod = (const float*)(opaque_ptr(a.ws) + OFF_MOD) + (size_t)l * 5 * 6144;
    const float* x1 = (const float*)(opaque_ptr(a.ws) + OFF_X1);
    bf16_t* h = (bf16_t*)(opaque_ptr(a.ws) + OFF_H);
    const float* ng = inp(I_NORMG) + l * DM;
    for (int row = gw; row < MT; row += NGW) {
        const float* src = (l == 0) ? (row < ML ? inp(I_X) + (size_t)row * DM : inp(I_CTX) + (size_t)(row - ML) * DM) : x1 + (size_t)row * DM;
        const int mr = row < ML ? row / SEQ : 4;
        const float* md = mod + mr * 6144;
        f32x4 v[8]; float ss = 0.f;
#pragma unroll
        for (int j = 0; j < 8; ++j) { v[j] = *(const f32x4*)(src + 4 * lane + 256 * j); ss += (v[j][0] * v[j][0] + v[j][1] * v[j][1]) + (v[j][2] * v[j][2] + v[j][3] * v[j][3]); }
        ss = wave_sum(ss);
        const float rstd = rsqrtf(ss * (1.f / DM) + EPS);
#pragma unroll
        for (int j = 0; j < 8; ++j) { const int idx = 4 * lane + 256 * j;
            const f32x4 gg = *(const f32x4*)(ng + idx), sc = *(const f32x4*)(md + 2048 + idx), sh = *(const f32x4*)(md + idx);
            f32x4 o;
#pragma unroll
            for (int e = 0; e < 4; ++e) o[e] = v[j][e] * rstd * gg[e] * (1.f + sc[e]) + sh[e];
            u32x2 w; w.x = cvt_pk_bf16(o[0], o[1]); w.y = cvt_pk_bf16(o[2], o[3]);
            *(u32x2*)(h + (size_t)row * DM + idx) = w; }
    }
}

__device__ __forceinline__ int vt_pos(int key) { const int k = key & 15; return (key & ~15) | (((k >> 2) & 1) << 3) | (k & 3) | (((k >> 3) & 1) << 2); }

__device__ __forceinline__ void phase_prep(const Args& a, int l, LAS unsigned char* lds) {
    const int tid = opaque_tid(), lane = tid & 63, wave = tid >> 6, G = opaque_s(gridDim.x);
    unsigned char* ws = opaque_ptr(a.ws);
    const bf16_t* z = (const bf16_t*)(ws + OFF_Z);
    const bool need_ctx = (l == 0);
    for (int it = BID; it < 1728; it += G) {
        if (it < 1152) {
            const int c = it >> 3, cgp = it & 7, rb = 64 * c;
            LAS float* lrs = (LAS float*)lds;
            LAS float* segs = (LAS float*)(lds + 8192);
            for (int i = tid; i < 64 * 32; i += 512) { const int r = i >> 5, cc = i & 31; lrs[i] = bf2f(z[(size_t)(rb + r) * NZ + ZC_LR + cc]); }
            __syncthreads();
            const int seg = tid >> 6, chl = tid & 63, ch = cgp * 64 + chl;
            float wf[16], wb[16];
#pragma unroll
            for (int r = 0; r < 16; ++r) { wf[r] = inp(I_WGF)[(size_t)l * 16 * 512 + r * 512 + ch]; wb[r] = inp(I_WGB)[(size_t)l * 16 * 512 + r * 512 + ch]; }
            const float bfv = inp(I_BGF)[l * 512 + ch], bbv = inp(I_BGB)[l * 512 + ch];
            float gf[8], gb[8]; float sf = 0.f, sb = 0.f;
#pragma unroll
            for (int i = 0; i < 8; ++i) { const int t = seg * 8 + i; float af = bfv, ab = bbv;
#pragma unroll
                for (int r = 0; r < 16; ++r) { af += lrs[t * 32 + r] * wf[r]; ab += lrs[t * 32 + 16 + r] * wb[r]; }
                gf[i] = logsig_f(af) * (1.f / 16.f); gb[i] = logsig_f(ab) * (1.f / 16.f); sf += gf[i]; sb += gb[i]; }
            segs[seg * 64 + chl] = sf; segs[512 + seg * 64 + chl] = sb;
            __syncthreads();
            float pf = 0.f, pb = 0.f, totf = 0.f, totb = 0.f;
#pragma unroll
            for (int s2 = 0; s2 < 8; ++s2) { const float vf = segs[s2 * 64 + chl], vb = segs[512 + s2 * 64 + chl]; totf += vf; totb += vb; if (s2 < seg) { pf += vf; pb += vb; } }
            bf16_t* gq0 = (bf16_t*)(ws + OFF_GQ), *gq1 = (bf16_t*)(ws + OFF_GQ + SZ_G);
            bf16_t* gk0 = (bf16_t*)(ws + OFF_GK), *gk1 = (bf16_t*)(ws + OFF_GK + SZ_G);
            bf16_t* gh0 = (bf16_t*)(ws + OFF_GH), *gh1 = (bf16_t*)(ws + OFF_GH + SZ_G);
#pragma unroll
            for (int i = 0; i < 8; ++i) { const int t = seg * 8 + i;
                pf += gf[i]; const float bs = totb - pb; pb += gb[i];
                const size_t row = rb + t;
                const float q = bf2f(z[row * NZ + ZC_GQ + ch]) * 0.08838834764831845f, k = bf2f(z[row * NZ + ZC_GK + ch]);
                const size_t o = row * 512 + ch;
                gq0[o] = f2bf(q * __expf(pf)); gk0[o] = f2bf(k * __expf(-pf)); gh0[o] = f2bf(k * __expf(totf - pf));
                gq1[o] = f2bf(q * __expf(bs)); gk1[o] = f2bf(k * __expf(-bs)); gh1[o] = f2bf(k * __expf(totb - bs)); }
            if (seg == 0) { float* dec = (float*)(ws + OFF_DEC); dec[(size_t)c * 512 + ch] = __expf(totf); dec[(size_t)(144 + c) * 512 + ch] = __expf(totb); }
            __syncthreads();
        } else if (it < 1440) {
            const int rb = 32 * (it - 1152); if (!need_ctx && rb >= ML) continue;
            const int seq0 = rb < ML ? (rb / SEQ) * SEQ : ML + ((rb - ML) / LC) * LC; const int L = rb < ML ? SEQ : LC; const int tl0 = rb - seq0;
            unsigned* dp = (unsigned*)(ws + OFF_DPOOL); unsigned* pgt = (unsigned*)(ws + OFF_PGATE);
            const int ch2 = 2 * tid, hw = 1 << (ch2 >> 8);
            const float psc0 = inp(I_POOLS)[l * 1024 + ch2], psc1 = inp(I_POOLS)[l * 1024 + ch2 + 1];
            const bf16_t* zc = z + (size_t)seq0 * NZ + ZC_PU + ch2;
            float s0 = 0.f, s1 = 0.f;
            { const int lo = max(tl0 - hw, 0), hi = min(tl0 + hw, L);
              for (int p = lo; p < hi; ++p) { const unsigned u = *(const unsigned*)(zc + (size_t)p * NZ); s0 += bflo(u); s1 += bfhi(u); } }
#pragma unroll 4
            for (int t = 0; t < 32; ++t) { const int tl = tl0 + t; const int lo = max(tl - hw, 0), hi = min(tl + hw, L);
                const float rc = 1.f / (float)(hi - lo);
                const unsigned cur = *(const unsigned*)(zc + (size_t)tl * NZ), pgv = *(const unsigned*)(zc + (size_t)tl * NZ + (ZC_PG - ZC_PU));
                const unsigned ua = *(const unsigned*)(zc + (size_t)min(tl + hw, L - 1) * NZ), ur = *(const unsigned*)(zc + (size_t)max(tl - hw, 0) * NZ);
                const size_t o = ((size_t)(seq0 + tl) * 1024 + ch2) >> 1;
                dp[o] = cvt_pk_bf16(s0 * rc - bflo(cur), s1 * rc - bfhi(cur));
                pgt[o] = cvt_pk_bf16(psc0 * silu_f(bflo(pgv)), psc1 * silu_f(bfhi(pgv)));
                const float ma = (tl + hw < L) ? 1.f : 0.f, mr = (tl - hw >= 0) ? 1.f : 0.f;
                s0 += ma * bflo(ua) - mr * bflo(ur); s1 += ma * bfhi(ua) - mr * bfhi(ur); }
        } else {
            const int vi = it - 1440, c = vi >> 1, hv = vi & 1, rb = 64 * c;
            int b, key0; if (rb < ML) { b = rb >> 11; key0 = LC + (rb & 2047); } else { b = (rb - ML) >> 8; key0 = (rb - ML) & 255; }
            bf16_t* vT = (bf16_t*)(ws + OFF_VT);
#pragma unroll
            for (int i = 0; i < 8; ++i) { const int idx = tid + 512 * i, key = idx & 63, c8 = (idx >> 6) * 8;
                const u32x4 w = *(const u32x4*)(z + (size_t)(rb + key) * NZ + ZC_DV + hv * 512 + c8);
                const unsigned ww[4] = {w.x, w.y, w.z, w.w}; const int pos = vt_pos(key);
#pragma unroll
                for (int e = 0; e < 8; ++e) *(LAS bf16_t*)(lds + (c8 + e) * 144 + pos * 2) = (bf16_t)((e & 1) ? (ww[e >> 1] >> 16) : (ww[e >> 1] & 0xffffu)); }
            __syncthreads();
#pragma unroll
            for (int i = 0; i < 8; ++i) { const int idx = tid + 512 * i, col = idx >> 3, k8 = idx & 7, colg = hv * 512 + col, h = colg >> 7, v = colg & 127;
                *(u32x4*)(vT + ((size_t)(b * 8 + h) * 128 + v) * LK + key0 + k8 * 8) = *(const LAS u32x4*)(lds + col * 144 + k8 * 16); }
            __syncthreads();
        }
    }
    {
        const int gw = BID * 8 + wave, NGW = G * 8;
        bf16_t* qn = (bf16_t*)(ws + OFF_QN); bf16_t* qnc = (bf16_t*)(ws + OFF_QNC); bf16_t* kn = (bf16_t*)(ws + OFF_KN);
        for (int it = gw; it < MT * 2; it += NGW) {
            const int row = it >> 1, which = it & 1;
            const bool isctx = row >= ML; int b, t; if (!isctx) { b = row >> 11; t = row & 2047; } else { b = (row - ML) >> 8; t = (row - ML) & 255; }
            const bf16_t* zr = z + (size_t)row * NZ;
            {
                if (which == 0 && isctx && !need_ctx) continue;
                float x[16]; const bf16_t* src = zr + (which == 0 ? ZC_DQ : ZC_DK) + 16 * lane;
                unpack8(*(const u32x4*)src, x); unpack8(*(const u32x4*)(src + 8), x + 8);
                float ss = 0.f;
#pragma unroll
                for (int e = 0; e < 16; ++e) ss += x[e] * x[e];
                ss += __shfl_xor(ss, 1); ss += __shfl_xor(ss, 2);
                const float rstd = rsqrtf(ss * (1.f / 64.f) + EPS);
                const int m = lane & 3, sh = lane >> 2, h = sh >> 1, j = sh & 1;
                const float* gain = (which == 0 ? inp(I_QNORM) : inp(I_KNORM)) + l * 64 + 16 * m;
                float y[16];
#pragma unroll
                for (int e = 0; e < 16; ++e) y[e] = x[e] * rstd * gain[e];
                if (!isctx) {
                    const float posf = (float)((m & 1) ? (t & 63) : (t >> 6));
#pragma unroll
                    for (int e = 0; e < 16; ++e) { const float yp = __shfl_xor(y[e], 2);
                        const float ang = posf * exp2f(-(float)e * 0.8304820237218405f);
                        const float cs = __cosf(ang), sn = __sinf(ang);
                        y[e] = (m < 2) ? (y[e] * cs - yp * sn) : (y[e] * cs + yp * sn); }
                }
                bf16_t* dst;
                if (which == 0) {
#pragma unroll
                    for (int e = 0; e < 16; ++e) y[e] *= 0.125f * LOG2E;
                    dst = isctx ? qnc + (((size_t)(b * 8 + h) * 2 + j) * LC + t) * 64 + 16 * m : qn + (((size_t)(b * 8 + h) * 2 + j) * SEQ + t) * 64 + 16 * m;
                } else dst = kn + (((size_t)(b * 8 + h) * 2 + j) * LK + (isctx ? t : LC + t)) * 64 + 16 * m;
                u32x4 w0, w1;
                w0.x = cvt_pk_bf16(y[0], y[1]); w0.y = cvt_pk_bf16(y[2], y[3]); w0.z = cvt_pk_bf16(y[4], y[5]); w0.w = cvt_pk_bf16(y[6], y[7]);
                w1.x = cvt_pk_bf16(y[8], y[9]); w1.y = cvt_pk_bf16(y[10], y[11]); w1.z = cvt_pk_bf16(y[12], y[13]); w1.w = cvt_pk_bf16(y[14], y[15]);
                *(u32x4*)dst = w0; *(u32x4*)(dst + 8) = w1;
            }
        }
    }
}

constexpr int GL_Q = 0, GL_K = 17408, GL_KH = 34816, GL_VT = 53248, GL_ATT = 57856, GL_ST = 67072;
__device__ __forceinline__ void gla_unit(const Args& a, int l, LAS unsigned char* lds, int item) {
    const int tid = opaque_tid(), lane = tid & 63, w = __builtin_amdgcn_readfirstlane(tid >> 6);
    const int vs = item & 7, dir = (item >> 3) & 1, h = (item >> 4) & 3, b = item >> 6;
    const bool need_ctx = (l == 0);
    unsigned char* ws = opaque_ptr(a.ws);
    const bf16_t* z = (const bf16_t*)(ws + OFF_Z);
    const bf16_t* gq = (const bf16_t*)(ws + OFF_GQ + dir * SZ_G) + h * 128;
    const bf16_t* gk = (const bf16_t*)(ws + OFF_GK + dir * SZ_G) + h * 128;
    const bf16_t* gh = (const bf16_t*)(ws + OFF_GH + dir * SZ_G) + h * 128;
    const float* dec = (const float*)(ws + OFF_DEC) + (size_t)dir * 144 * 512 + h * 128;
    bf16_t* od = (bf16_t*)(ws + OFF_OF + (size_t)dir * MT * 1024 * 2) + h * 256 + vs * 32;
    const bf16_t* zv = z + ZC_GV + h * 256 + vs * 32;
    const int fr = lane & 15, fq = lane >> 4;
    f32x4 sacc[2] = {(f32x4){0.f, 0.f, 0.f, 0.f}, (f32x4){0.f, 0.f, 0.f, 0.f}};
    for (int i = tid; i < 32 * 136 / 2; i += 512) ((LAS unsigned*)(lds + GL_ST))[i] = 0u;
    u32x4 rq[2], rk[2], rh[2], rv; float rdec;
    auto rowbase = [&](int s) -> int { if (s < 4) { const int ci = dir == 0 ? s : 3 - s; return ML + b * LC + 64 * ci; } const int ci = dir == 0 ? s - 4 : 35 - s; return b * SEQ + 64 * ci; };
#define GLA_LOAD(s) do { const int _rb = rowbase(s); _Pragma("unroll") for (int _i = 0; _i < 2; ++_i) { const int _idx = tid + 512 * _i, _r = _idx >> 4, _c = (_idx & 15) * 8; const size_t _o = (size_t)(_rb + _r) * 512 + _c; \
        rq[_i] = *(const u32x4*)(gq + _o); rk[_i] = *(const u32x4*)(gk + _o); rh[_i] = *(const u32x4*)(gh + _o); } \
        if (tid < 256) rv = *(const u32x4*)(zv + (size_t)(_rb + (tid >> 2)) * NZ + (tid & 3) * 8); \
        rdec = dec[(size_t)(_rb >> 6) * 512 + 16 * w + fr]; } while (0)
    GLA_LOAD(0);
    for (int s = 0; s < 36; ++s) {
        const int rb = rowbase(s);
        const float dk = rdec;
#pragma unroll
        for (int i = 0; i < 2; ++i) { const int idx = tid + 512 * i, r = idx >> 4, c = (idx & 15) * 8;
            *(LAS u32x4*)(lds + GL_Q + r * 272 + c * 2) = rq[i]; *(LAS u32x4*)(lds + GL_K + r * 272 + c * 2) = rk[i];
            const unsigned hw[4] = {rh[i].x, rh[i].y, rh[i].z, rh[i].w};
#pragma unroll
            for (int e = 0; e < 8; ++e) *(LAS bf16_t*)(lds + GL_KH + (c + e) * 144 + r * 2) = (bf16_t)((e & 1) ? (hw[e >> 1] >> 16) : (hw[e >> 1] & 0xffffu)); }
        if (tid < 256) { const int r = tid >> 2, c = (tid & 3) * 8; const unsigned vw[4] = {rv.x, rv.y, rv.z, rv.w};
#pragma unroll
            for (int e = 0; e < 8; ++e) *(LAS bf16_t*)(lds + GL_VT + (c + e) * 144 + r * 2) = (bf16_t)((e & 1) ? (vw[e >> 1] >> 16) : (vw[e >> 1] & 0xffffu)); }
        __syncthreads();
        if (s + 1 < 36) GLA_LOAD(s + 1);
        {
            const int tt = w >> 1;
#pragma unroll
            for (int si = 0; si < 2; ++si) { const int st = 2 * (w & 1) + si; f32x4 acc = (f32x4){0.f, 0.f, 0.f, 0.f};
#pragma unroll
                for (int kk = 0; kk < 4; ++kk) { const bf16x8 af = *(const LAS bf16x8*)(lds + GL_Q + (16 * tt + fr) * 272 + (32 * kk + 8 * fq) * 2);
                    const bf16x8 bfr = *(const LAS bf16x8*)(lds + GL_K + (16 * st + fr) * 272 + (32 * kk + 8 * fq) * 2);
                    acc = __builtin_amdgcn_mfma_f32_16x16x32_bf16(af, bfr, acc, 0, 0, 0); }
#pragma unroll
                for (int j = 0; j < 4; ++j) { const int t = 16 * tt + 4 * fq + j, sc = 16 * st + fr; const bool keep = dir == 0 ? (sc <= t) : (sc >= t);
                    *(LAS bf16_t*)(lds + GL_ATT + t * 144 + sc * 2) = f2bf(keep ? acc[j] : 0.f); } }
        }
#pragma unroll
        for (int vt = 0; vt < 2; ++vt) { f32x4 acc = sacc[vt] * dk;
#pragma unroll
            for (int kk = 0; kk < 2; ++kk) { const bf16x8 af = *(const LAS bf16x8*)(lds + GL_VT + (16 * vt + fr) * 144 + (32 * kk + 8 * fq) * 2);
                const bf16x8 bfr = *(const LAS bf16x8*)(lds + GL_KH + (16 * w + fr) * 144 + (32 * kk + 8 * fq) * 2);
                acc = __builtin_amdgcn_mfma_f32_16x16x32_bf16(af, bfr, acc, 0, 0, 0); }
            sacc[vt] = acc; }
        __syncthreads();
        {
            const int tt = w >> 1, vt = w & 1; f32x4 acc = (f32x4){0.f, 0.f, 0.f, 0.f};
#pragma unroll
            for (int kk = 0; kk < 4; ++kk) { const bf16x8 af = *(const LAS bf16x8*)(lds + GL_Q + (16 * tt + fr) * 272 + (32 * kk + 8 * fq) * 2);
                const bf16x8 bfr = *(const LAS bf16x8*)(lds + GL_ST + (16 * vt + fr) * 272 + (32 * kk + 8 * fq) * 2);
                acc = __builtin_amdgcn_mfma_f32_16x16x32_bf16(af, bfr, acc, 0, 0, 0); }
#pragma unroll
            for (int kk = 0; kk < 2; ++kk) { const bf16x8 af = *(const LAS bf16x8*)(lds + GL_ATT + (16 * tt + fr) * 144 + (32 * kk + 8 * fq) * 2);
                const bf16x8 bfr = *(const LAS bf16x8*)(lds + GL_VT + (16 * vt + fr) * 144 + (32 * kk + 8 * fq) * 2);
                acc = __builtin_amdgcn_mfma_f32_16x16x32_bf16(af, bfr, acc, 0, 0, 0); }
            if (s >= 4 || need_ctx) {
#pragma unroll
                for (int j = 0; j < 4; ++j) od[(size_t)(rb + 16 * tt + 4 * fq + j) * 1024 + 16 * vt + fr] = f2bf(acc[j]); }
        }
        __syncthreads();
#pragma unroll
        for (int vt = 0; vt < 2; ++vt)
#pragma unroll
            for (int j = 0; j < 4; ++j) *(LAS bf16_t*)(lds + GL_ST + (16 * vt + 4 * fq + j) * 272 + (16 * w + fr) * 2) = f2bf(sacc[vt][j]);
    }
    __syncthreads();
#undef GLA_LOAD
}

constexpr int AT_BUF = 36864, AT_K = 0, AT_V = 18432;
__device__ __forceinline__ void attn_unit(LAS unsigned char* lds, const bf16_t* qbase, int Lq, int q0, const bf16_t* kbase, const bf16_t* vtbase, int nkeys,
                                          float c2, float lam, float post_scale, const float* subln, const bf16_t* dg, bf16_t* outp, int row0) {
    const int tid = opaque_tid(), lane = tid & 63, w = __builtin_amdgcn_readfirstlane(tid >> 6), q32 = lane & 31, hi = lane >> 5;
    const int j = w >> 2, qg = w & 3;
    bf16x8 qf[4];
#pragma unroll
    for (int kk = 0; kk < 4; ++kk) qf[kk] = *(const bf16x8*)(qbase + ((size_t)j * Lq + q0 + 32 * qg + q32) * 64 + 16 * kk + 8 * hi);
    f32x16 o[4];
#pragma unroll
    for (int vt = 0; vt < 4; ++vt)
#pragma unroll
        for (int r = 0; r < 16; ++r) o[vt][r] = 0.f;
    float lsum = 0.f;
    const int nt = nkeys >> 6;
    u32x4 sk[2], sv[2];
#define AT_LOAD(i) do { _Pragma("unroll") for (int _c = 0; _c < 2; ++_c) { const int _idx = tid + 512 * _c; \
        sk[_c] = *(const u32x4*)(kbase + ((size_t)(_idx >> 9) * LK + 64 * (i) + ((_idx & 511) >> 3)) * 64 + (_idx & 7) * 8); \
        sv[_c] = *(const u32x4*)(vtbase + (size_t)(_idx >> 3) * LK + 64 * (i) + (_idx & 7) * 8); } } while (0)
#define AT_STORE(p) do { _Pragma("unroll") for (int _c = 0; _c < 2; ++_c) { const int _idx = tid + 512 * _c; \
        *(LAS u32x4*)(lds + (p) * AT_BUF + AT_K + ((_idx >> 9) * 64 + ((_idx & 511) >> 3)) * 144 + (_idx & 7) * 16) = sk[_c]; \
        *(LAS u32x4*)(lds + (p) * AT_BUF + AT_V + (_idx >> 3) * 144 + (_idx & 7) * 16) = sv[_c]; } } while (0)
    AT_LOAD(0); AT_STORE(0);
    __syncthreads();
    for (int i = 0; i < nt; ++i) {
        const int p = i & 1;
        if (i + 1 < nt) AT_LOAD(i + 1);
        LAS unsigned char* Kb = lds + p * AT_BUF + AT_K + j * (64 * 144); LAS unsigned char* Vb = lds + p * AT_BUF + AT_V;
#pragma unroll
        for (int kb = 0; kb < 2; ++kb) {
            f32x16 s;
#pragma unroll
            for (int r = 0; r < 16; ++r) s[r] = -c2;
#pragma unroll
            for (int kk = 0; kk < 4; ++kk) {
                const bf16x8 a0 = *(const LAS bf16x8*)(Kb + (32 * kb + q32) * 144 + (16 * kk + 8 * hi) * 2);
                s = __builtin_amdgcn_mfma_f32_32x32x16_bf16(a0, qf[kk], s, 0, 0, 0);
            }
#pragma unroll
            for (int r = 0; r < 16; ++r) { s[r] = __builtin_amdgcn_exp2f(s[r]); lsum += s[r]; }
#pragma unroll
            for (int hf = 0; hf < 2; ++hf) {
                const int ks = 2 * kb + hf;
                u32x4 pw;
                pw.x = cvt_pk_bf16(s[8 * hf + 0], s[8 * hf + 1]); pw.y = cvt_pk_bf16(s[8 * hf + 2], s[8 * hf + 3]); pw.z = cvt_pk_bf16(s[8 * hf + 4], s[8 * hf + 5]); pw.w = cvt_pk_bf16(s[8 * hf + 6], s[8 * hf + 7]);
                const bf16x8 pb = __builtin_bit_cast(bf16x8, pw);
#pragma unroll
                for (int vt = 0; vt < 4; ++vt) {
                    const bf16x8 av = *(const LAS bf16x8*)(Vb + (32 * vt + q32) * 144 + (16 * ks + 8 * hi) * 2);
                    o[vt] = __builtin_amdgcn_mfma_f32_32x32x16_bf16(av, pb, o[vt], 0, 0, 0);
                }
            }
        }
        if (i + 1 < nt) AT_STORE(p ^ 1);
        __syncthreads();
    }
#undef AT_LOAD
#undef AT_STORE
    lsum += __shfl_xor(lsum, 32);
    LAS float* xch = (LAS float*)lds + (size_t)qg * 4096 + lane;
    if (j == 1) {
        const float sc = lam / lsum;
#pragma unroll
        for (int vt = 0; vt < 4; ++vt)
#pragma unroll
            for (int r = 0; r < 16; ++r) xch[(vt * 16 + r) * 64] = o[vt][r] * sc;
    }
    __syncthreads();
    if (j == 0) {
        const float i0 = 1.f / lsum;
        float ss = 0.f;
#pragma unroll
        for (int vt = 0; vt < 4; ++vt)
#pragma unroll
            for (int r = 0; r < 16; ++r) { const float v = o[vt][r] * i0 - xch[(vt * 16 + r) * 64]; o[vt][r] = v; ss += v * v; }
        ss += __shfl_xor(ss, 32);
        const float rstd = rsqrtf(ss * (1.f / 128.f) + EPS) * post_scale;
        const size_t row = (size_t)row0 + 32 * qg + q32;
#pragma unroll
        for (int vt = 0; vt < 4; ++vt)
#pragma unroll
            for (int g4 = 0; g4 < 4; ++g4) {
                const int v0 = 32 * vt + 8 * g4 + 4 * hi;
                const u32x2 gz = *(const u32x2*)(dg + row * NZ + v0);
                const f32x4 sl = *(const f32x4*)(subln + v0);
                const float r0 = o[vt][4 * g4 + 0] * rstd * sl[0] * silu_f(bflo(gz.x)), r1 = o[vt][4 * g4 + 1] * rstd * sl[1] * silu_f(bfhi(gz.x));
                const float r2 = o[vt][4 * g4 + 2] * rstd * sl[2] * silu_f(bflo(gz.y)), r3 = o[vt][4 * g4 + 3] * rstd * sl[3] * silu_f(bfhi(gz.y));
                u32x2 wv; wv.x = cvt_pk_bf16(r0, r1); wv.y = cvt_pk_bf16(r2, r3);
                *(u32x2*)(outp + row * 1024 + v0) = wv;
            }
    }
    __syncthreads();
}

__device__ __forceinline__ void phase_mix(const Args& a, int l, LAS unsigned char* lds) {
    const int G = opaque_s(gridDim.x);
    unsigned char* ws = opaque_ptr(a.ws);
    const bool need_ctx = (l == 0);
#ifndef NO_GLA
    for (int it = BID; it < 256; it += G) gla_unit(a, l, lds, it);
#endif
#ifndef NO_ATT
    {
        const float* scal = (const float*)(ws + OFF_SCAL) + l * 4;
        const float lam = scal[0], c2 = scal[1], post = 1.f - scal[2];
        const bf16_t* z = (const bf16_t*)(ws + OFF_Z);
        const int nun = 512 + (need_ctx ? 64 : 0);
        for (int u = BID; u < nun; u += G) {
            if (u < 512) { const int vc = (u & 7) * 64 + (u >> 3), bh = vc >> 4, qb = vc & 15, b = bh >> 3, h = bh & 7;
                attn_unit(lds, (const bf16_t*)(ws + OFF_QN) + (size_t)bh * 2 * SEQ * 64, SEQ, 128 * qb, (const bf16_t*)(ws + OFF_KN) + (size_t)bh * 2 * LK * 64,
                          (const bf16_t*)(ws + OFF_VT) + (size_t)bh * 128 * LK, LK, c2, lam, post, inp(I_SUBLN) + l * 128, z + ZC_DG + h * 128, (bf16_t*)(ws + OFF_DIFFO) + h * 128, b * SEQ + 128 * qb);
            } else { const int uu = u - 512, bh = uu >> 1, qb = uu & 1, b = bh >> 3, h = bh & 7;
                attn_unit(lds, (const bf16_t*)(ws + OFF_QNC) + (size_t)bh * 2 * LC * 64, LC, 128 * qb, (const bf16_t*)(ws + OFF_KN) + (size_t)bh * 2 * LK * 64,
                          (const bf16_t*)(ws + OFF_VT) + (size_t)bh * 128 * LK, LC, c2, lam, post, inp(I_SUBLN) + l * 128, z + ZC_DG + h * 128, (bf16_t*)(ws + OFF_DIFFO) + h * 128, ML + b * LC + 128 * qb);
            }
        }
    }
#endif
#ifndef NO_POOL
    {
        const int Mrows = need_ctx ? MT : ML;
        pg8::Gemm g{(const bf16_t*)(ws + OFF_DPOOL), (const bf16_t*)(ws + OFF_POOLT + (size_t)l * SZ_POOLT), Mrows, 1024, 256, 1024, 256, 256};
        pg8::StaticOrder S; S.init(Mrows, 1024, G, BID);
        pg8::EpiPool E{(bf16_t*)(ws + OFF_POOLO), (const bf16_t*)(ws + OFF_PGATE)};
        pg8::gemm_phase<pg8::EpiPool, pg8::StaticOrder, true, true>(lds, g, S, E);
    }
#endif
}

__device__ __forceinline__ void phase_post(const Args& a, int l) {
    const int tid = opaque_tid(), lane = tid & 63, wave = tid >> 6, G = opaque_s(gridDim.x);
    const int gw = BID * 8 + wave, NGW = G * 8;
    unsigned char* ws = opaque_ptr(a.ws);
    const bf16_t* z = (const bf16_t*)(ws + OFF_Z);
    const bf16_t* of = (const bf16_t*)(ws + OFF_OF); const bf16_t* ob = of + (size_t)MT * 1024;
    bf16_t* go = (bf16_t*)(ws + OFF_GLAO);
    const int Mrows = (l == 0) ? MT : ML;
    const float* gn = inp(I_GLAN) + l * 256 + ((16 * lane) & 255);
    for (int row = gw; row < Mrows; row += NGW) {
        float x[16], y[16], gz[16];
        const size_t o = (size_t)row * 1024 + 16 * lane;
        unpack8(*(const u32x4*)(of + o), x); unpack8(*(const u32x4*)(of + o + 8), x + 8);
        unpack8(*(const u32x4*)(ob + o), y); unpack8(*(const u32x4*)(ob + o + 8), y + 8);
        unpack8(*(const u32x4*)(z + (size_t)row * NZ + ZC_GG + 16 * lane), gz); unpack8(*(const u32x4*)(z + (size_t)row * NZ + ZC_GG + 16 * lane + 8), gz + 8);
        float ss = 0.f;
#pragma unroll
        for (int e = 0; e < 16; ++e) { x[e] += y[e]; ss += x[e] * x[e]; }
        ss += __shfl_xor(ss, 1); ss += __shfl_xor(ss, 2); ss += __shfl_xor(ss, 4); ss += __shfl_xor(ss, 8);
        const float rstd = rsqrtf(ss * (1.f / 256.f) + EPS);
        float r[16];
#pragma unroll
        for (int e = 0; e < 16; ++e) r[e] = x[e] * rstd * gn[e] * silu_f(gz[e]);
        u32x4 w0, w1;
        w0.x = cvt_pk_bf16(r[0], r[1]); w0.y = cvt_pk_bf16(r[2], r[3]); w0.z = cvt_pk_bf16(r[4], r[5]); w0.w = cvt_pk_bf16(r[6], r[7]);
        w1.x = cvt_pk_bf16(r[8], r[9]); w1.y = cvt_pk_bf16(r[10], r[11]); w1.z = cvt_pk_bf16(r[12], r[13]); w1.w = cvt_pk_bf16(r[14], r[15]);
        *(u32x4*)(go + o) = w0; *(u32x4*)(go + o + 8) = w1;
    }
}

__global__ void __launch_bounds__(512, 2) hybrid_fwd(Args a) {
    extern __shared__ __attribute__((aligned(16))) unsigned char smem[];
    LAS unsigned char* lds = (LAS unsigned char*)smem;
    cg::grid_group grid = cg::this_grid();
#ifndef REPEAT_K
#define REPEAT_K -1
#endif
    for (int ph2 = 2 * a.ph_lo; ph2 < 2 * a.ph_hi; ++ph2) {
        const int ph = ph2 >> 1;
        if (ph2 & 1) { if (REPEAT_K < 0) continue; if (!((ph == 0 && REPEAT_K == 7) || (ph > 0 && (ph - 1) % 7 == REPEAT_K))) continue; }
        else if (ph > a.ph_lo) grid.sync();
        unsigned char* ws = opaque_ptr(a.ws);
        const int G = opaque_s(gridDim.x);
#ifndef KMASK
#define KMASK 0xff
#endif
        if (ph == 0) { if (KMASK & 128) phase_p0(a, lds); continue; }
        const int l = (ph - 1) / 7, k = (ph - 1) % 7;
        const int Mout = (l == 0) ? MT : ML;
        if (k == 0) { if (KMASK & 1) phase_norm(a, l); }
        else if (k == 1) { if (KMASK & 2) {
            pg8::Gemm g{(const bf16_t*)(ws + OFF_H), (const bf16_t*)(ws + OFF_WIN + (size_t)l * SZ_WIN), MT, NZ, DM, DM, DM, 0};
            pg8::StaticOrder S; S.init(MT, NZ, G, BID);
            pg8::EpiBf16 E{(bf16_t*)(ws + OFF_Z), NZ};
            pg8::gemm_phase<pg8::EpiBf16, pg8::StaticOrder, true, true>(lds, g, S, E);
        } }
        else if (k == 2) { if (KMASK & 4) phase_prep(a, l, lds); }
        else if (k == 3) { if (KMASK & 8) phase_mix(a, l, lds); }
        else if (k == 4) { if (KMASK & 16) phase_post(a, l); }
        else if (k == 5) { if (KMASK & 32) {
            pg8::StaticOrder S; S.init(Mout, DM, G, BID);
            const bf16_t* zg = (const bf16_t*)(ws + OFF_Z) + ZC_MG;
            float* yacc = (float*)(ws + OFF_YACC); bf16_t* y = (bf16_t*)(ws + OFF_H);
            const bf16_t* wb = (const bf16_t*)(ws + OFF_WB + (size_t)l * SZ_WB);
            { pg8::Gemm g{(const bf16_t*)(ws + OFF_POOLO), wb, Mout, DM, 1024, 1024, 1024, 0}; pg8::EpiMerge<0> E{yacc, y, zg};
              pg8::gemm_phase<pg8::EpiMerge<0>, pg8::StaticOrder, true, true>(lds, g, S, E); }
            { pg8::Gemm g{(const bf16_t*)(ws + OFF_DIFFO), wb + (size_t)DM * 1024, Mout, DM, 1024, 1024, 1024, 0}; pg8::EpiMerge<1> E{yacc, y, zg + 2048};
              pg8::gemm_phase<pg8::EpiMerge<1>, pg8::StaticOrder, true, true>(lds, g, S, E); }
            { pg8::Gemm g{(const bf16_t*)(ws + OFF_GLAO), wb + (size_t)2 * DM * 1024, Mout, DM, 1024, 1024, 1024, 0}; pg8::EpiMerge<2> E{yacc, y, zg + 4096};
              pg8::gemm_phase<pg8::EpiMerge<2>, pg8::StaticOrder, true, true>(lds, g, S, E); }
        } }
        else if (KMASK & 64) {
            pg8::Gemm g{(const bf16_t*)(ws + OFF_H), (const bf16_t*)(ws + OFF_WOUT + (size_t)l * SZ_WOUT), Mout, DM, DM, DM, DM, 0};
            pg8::StaticOrder S; S.init(Mout, DM, G, BID);
            pg8::EpiOut E{l == 0 ? inp(I_X) : (const float*)(ws + OFF_X1), l == 0 ? inp(I_CTX) : (const float*)(ws + OFF_X1) + (size_t)ML * DM,
                          l == 0 ? (float*)(ws + OFF_X1) : arg_out(), (const float*)(ws + OFF_MOD) + (size_t)l * 5 * 6144};
            pg8::gemm_phase<pg8::EpiOut, pg8::StaticOrder, true, true>(lds, g, S, E);
        }
    }
}

extern "C" void kernel_launch(void* const* d_in, const int* in_sizes, int n_in, void* d_out, int out_size, void* d_ws, size_t ws_size, hipStream_t stream) {
    static int grid = 0;
    if (grid == 0) {
        if (n_in != 26 || out_size != ML * DM || ws_size < WS_END) { fprintf(stderr, "kernel_launch: expected 26 inputs, out %d, ws >= %zu; got n_in %d out %d ws %zu\n", ML * DM, (size_t)WS_END, n_in, out_size, ws_size); grid = -1; return; }
        int dev = 0, cus = 0, per_cu = 0;
        if (hipGetDevice(&dev) != hipSuccess || hipDeviceGetAttribute(&cus, hipDeviceAttributeMultiprocessorCount, dev) != hipSuccess) { grid = -1; return; }
        if (hipFuncSetAttribute((const void*)hybrid_fwd, hipFuncAttributeMaxDynamicSharedMemorySize, LDS_BYTES) != hipSuccess) { fprintf(stderr, "kernel_launch: hipFuncSetAttribute failed\n"); grid = -1; return; }
        if (hipOccupancyMaxActiveBlocksPerMultiprocessor(&per_cu, (const void*)hybrid_fwd, 512, LDS_BYTES) != hipSuccess || per_cu < 1) { fprintf(stderr, "kernel_launch: occupancy query says %d blocks per CU\n", per_cu); (void)hipGetLastError(); grid = -1; return; }
        grid = cus;
    }
    if (grid < 0) return;
    Args a{};
    for (int i = 0; i < 26; ++i) a.in[i] = (const float*)d_in[i];
    a.out = (float*)d_out; a.ws = (unsigned char*)d_ws;
    const int nl = MK_N_LAUNCHES;
    for (int li = 0; li < nl; ++li) {
        a.ph_lo = (nl == 1) ? 0 : li; a.ph_hi = (nl == 1) ? NPH : li + 1;
        void* args[] = {&a};
        const hipError_t e = hipLaunchCooperativeKernel((const void*)hybrid_fwd, dim3(grid), dim3(512), args, LDS_BYTES, stream);
        if (e != hipSuccess) { fprintf(stderr, "kernel_launch: cooperative launch %d failed: %s (grid %d)\n", li, hipGetErrorString(e), grid); break; }
    }
}
```

```cpp
#include <hip/hip_runtime.h>
#include <hip/hip_cooperative_groups.h>
#include <cstdio>
#include <cstdint>
namespace cg = cooperative_groups;

#ifndef MK_N_LAUNCHES
#define MK_N_LAUNCHES 1
#endif

#define LAS __attribute__((address_space(3)))
typedef unsigned short bf16_t;
typedef short bf16x8 __attribute__((ext_vector_type(8)));
typedef float f32x4 __attribute__((ext_vector_type(4)));
typedef float f32x16 __attribute__((ext_vector_type(16)));
typedef unsigned u32x4 __attribute__((ext_vector_type(4)));
typedef unsigned u32x2 __attribute__((ext_vector_type(2)));

constexpr int DM = 2048, NB = 4, SEQ = 2048, LC = 256, ML = NB * SEQ, MC = NB * LC, MT = ML + MC;
constexpr int DIN = 15392, NZ = 15616;
constexpr int ZC_PU = 0, ZC_PG = 1024, ZC_DQ = 2048, ZC_DK = 3072, ZC_DV = 4096, ZC_DG = 5120, ZC_GQ = 6144, ZC_GK = 6656, ZC_GV = 7168, ZC_GG = 8192, ZC_LR = 9216, ZC_MG = 9472;
constexpr int LK = LC + SEQ;
constexpr float EPS = 1e-6f, LOG2E = 1.4426950408889634f;
constexpr int NPH = 15;

constexpr size_t SZ_WIN = (size_t)NZ * DM * 2, SZ_WB = (size_t)3 * DM * 1024 * 2, SZ_WOUT = (size_t)DM * DM * 2, SZ_POOLT = (size_t)4 * 256 * 256 * 2;
constexpr size_t OFF_WIN = 0;
constexpr size_t OFF_WB = OFF_WIN + 2 * SZ_WIN;
constexpr size_t OFF_WOUT = OFF_WB + 2 * SZ_WB;
constexpr size_t OFF_POOLT = OFF_WOUT + 2 * SZ_WOUT;
constexpr size_t OFF_MOD = OFF_POOLT + 2 * SZ_POOLT;
constexpr size_t OFF_SCAL = OFF_MOD + (size_t)2 * 5 * 6144 * 4;
constexpr size_t OFF_H = OFF_SCAL + 256;
constexpr size_t OFF_Z = OFF_H + (size_t)MT * DM * 2;
constexpr size_t OFF_QN = OFF_Z + (size_t)MT * NZ * 2;
constexpr size_t OFF_QNC = OFF_QN + (size_t)ML * 1024 * 2;
constexpr size_t OFF_KN = OFF_QNC + (size_t)MC * 1024 * 2;
constexpr size_t OFF_VT = OFF_KN + (size_t)MT * 1024 * 2;
constexpr size_t SZ_G = (size_t)MT * 512 * 2;
constexpr size_t OFF_GQ = OFF_VT + (size_t)MT * 1024 * 2;
constexpr size_t OFF_GK = OFF_GQ + 2 * SZ_G;
constexpr size_t OFF_GH = OFF_GK + 2 * SZ_G;
constexpr size_t OFF_DEC = OFF_GH + 2 * SZ_G;
constexpr size_t OFF_OF = OFF_DEC + (size_t)2 * 144 * 512 * 4;
constexpr size_t OFF_DPOOL = OFF_OF + 2 * (size_t)MT * 1024 * 2;
constexpr size_t OFF_POOLO = OFF_DPOOL + (size_t)MT * 1024 * 2;
constexpr size_t OFF_DIFFO = OFF_POOLO + (size_t)MT * 1024 * 2;
constexpr size_t OFF_GLAO = OFF_DIFFO + (size_t)MT * 1024 * 2;
constexpr size_t OFF_YACC = OFF_GLAO + (size_t)MT * 1024 * 2;
constexpr size_t OFF_X1 = OFF_YACC + (size_t)MT * DM * 4;
constexpr size_t OFF_PGATE = OFF_X1 + (size_t)MT * DM * 4;
constexpr size_t OFF_BAR = OFF_PGATE + (size_t)MT * 1024 * 2;
constexpr size_t BAR_BYTES = 16384;
constexpr size_t WS_END = OFF_BAR + BAR_BYTES;

constexpr int LDS_BYTES = 135168;

#define BID opaque_s((int)blockIdx.x)
__device__ __forceinline__ unsigned char* opaque_ptr(unsigned char* p) { asm volatile("" : "+s"(p)); return p; }
__device__ __forceinline__ int opaque_s(int v) { asm volatile("" : "+s"(v)); return v; }
__device__ __forceinline__ int opaque_tid() { int t = threadIdx.x; asm volatile("" : "+v"(t)); return t; }
typedef float f32x2_t __attribute__((ext_vector_type(2))); typedef __bf16 bf16x2_t __attribute__((ext_vector_type(2)));
__device__ __forceinline__ unsigned cvt_pk_bf16(float lo, float hi) { f32x2_t v = {lo, hi}; bf16x2_t b = __builtin_convertvector(v, bf16x2_t); return __builtin_bit_cast(unsigned, b); }
__device__ __forceinline__ bf16_t f2bf(float f) { return (bf16_t)(cvt_pk_bf16(f, 0.f) & 0xffffu); }
__device__ __forceinline__ float bf2f(bf16_t v) { return __builtin_bit_cast(float, (unsigned)v << 16); }
__device__ __forceinline__ float bflo(unsigned u) { return __builtin_bit_cast(float, u << 16); }
__device__ __forceinline__ float bfhi(unsigned u) { return __builtin_bit_cast(float, u & 0xffff0000u); }
__device__ __forceinline__ float silu_f(float x) { return x / (1.f + __expf(-x)); }
__device__ __forceinline__ float sigmoid_f(float x) { return 1.f / (1.f + __expf(-x)); }
__device__ __forceinline__ float logsig_f(float a) { return fminf(a, 0.f) - log1pf(__expf(-fabsf(a))); }
__device__ __forceinline__ float wave_sum(float v) {
#pragma unroll
    for (int o = 1; o < 64; o <<= 1) v += __shfl_xor(v, o);
    return v;
}
__device__ __forceinline__ float wave_max(float v) {
#pragma unroll
    for (int o = 1; o < 64; o <<= 1) v = fmaxf(v, __shfl_xor(v, o));
    return v;
}
__device__ __forceinline__ void unpack8(u32x4 w, float* f) { f[0] = bflo(w.x); f[1] = bfhi(w.x); f[2] = bflo(w.y); f[3] = bfhi(w.y); f[4] = bflo(w.z); f[5] = bfhi(w.z); f[6] = bflo(w.w); f[7] = bfhi(w.w); }

namespace pg8 {
constexpr int BM = 256, BK = 64, HALF = 128, HTB = HALF * BK * 2, STAGE_BYTES = 8 * HTB, NXCD = 8, WGM = 8;
__host__ __device__ __forceinline__ int lds_byte(int r, int c) { const int st = (r >> 4) * 2 + (c >> 5), rr = r & 15, cc = c & 31, ob = rr * 64 + cc * 2; return st * 1024 + (ob ^ (((ob >> 9) & 1) << 5)); }
__host__ __device__ __forceinline__ void stage_rc(int b, int& R, int& C) { const int st = b / 1024, sb = b % 1024, swz = sb ^ (((sb >> 9) & 1) << 5); R = (st >> 1) * 16 + swz / 64; C = (st & 1) * 32 + (swz % 64) / 2; }
__host__ __device__ __forceinline__ int perm32(int rho) { const int n = rho >> 4, i = rho & 15; return 8 * (i >> 2) + 4 * n + (i & 3); }

struct Unit { int pm, pn; };
struct Gemm { const bf16_t* A; const bf16_t* Bt; int M, N, K; int lda, ldb; int a_pn_off; };

struct StaticOrder {
    int nM, nN, nwg, G, c;
    __host__ __device__ void init(int M, int N, int G_, int c_) { nM = M / BM; nN = N / BM; nwg = nM * nN; G = G_; c = c_; }
    __host__ __device__ bool next(int i, Unit& u) const {
        const long L = (long)i * G + c; if (L >= nwg) return false;
        int wgid = (int)L; { const int q = nwg / NXCD, r = nwg % NXCD, xcd = wgid % NXCD, off = wgid / NXCD; wgid = (xcd < r ? xcd * (q + 1) : r * (q + 1) + (xcd - r) * q) + off; }
        const int nig = WGM * nN, gid = wgid / nig, fm = gid * WGM, gsz = (nM - fm) < WGM ? (nM - fm) : WGM;
        u.pm = fm + ((wgid % nig) % gsz); u.pn = (wgid % nig) / gsz; return true;
    }
    __device__ __forceinline__ void a_ready(const Unit&) const {}
    __device__ __forceinline__ void done(const Unit&) const {}
};

struct EpiBf16 {
    static constexpr bool PERM = true, AFTER_DRAIN = false;
    bf16_t* O; int ldc;
    __device__ __forceinline__ void operator()(const f32x4 (&acc)[2][2][4][2], const Unit& u, int wr, int wc, int fr, int fq) const {
        const int row0 = u.pm * BM + wr * 64 + fr, col0 = u.pn * BM + wc * 32 + 8 * fq;
#pragma unroll
        for (int ai = 0; ai < 2; ++ai)
#pragma unroll
            for (int m = 0; m < 4; ++m) { bf16_t* rowp = O + (size_t)(row0 + ai * HALF + m * 16) * ldc + col0;
#pragma unroll
                for (int bj = 0; bj < 2; ++bj) { const f32x4 v0 = acc[ai][bj][m][0], v1 = acc[ai][bj][m][1];
                    u32x4 w; w.x = cvt_pk_bf16(v0[0], v0[1]); w.y = cvt_pk_bf16(v0[2], v0[3]); w.z = cvt_pk_bf16(v1[0], v1[1]); w.w = cvt_pk_bf16(v1[2], v1[3]);
                    *(u32x4*)(rowp + bj * HALF) = w; } }
    }
};

template <class Epi, class Sched, bool ALIGN_EPI = false, bool SP2 = false>
__device__ __forceinline__ void gemm_phase(LAS unsigned char* lds, const Gemm g, const Sched& S, const Epi& E) {
    const int tid = opaque_tid(), wid = __builtin_amdgcn_readfirstlane(tid >> 6), lane = tid & 63, wr = wid >> 2, wc = wid & 3, fr = lane & 15, fq = lane >> 4;
    const int K = opaque_s(g.K), nt = K / BK;
    unsigned voffA[2], voffB[2];
#pragma unroll
    for (int i = 0; i < 2; ++i) { int R, C; stage_rc(tid * 16 + i * 8192, R, C); const int Rb = Epi::PERM ? ((R & ~31) + perm32(R & 31)) : R;
        voffA[i] = (unsigned)(R * g.lda + C) * 2u; voffB[i] = (unsigned)(Rb * g.ldb + C) * 2u; }
    const size_t kstep = (size_t)(BK * 2);
    const size_t hstepA = (size_t)HALF * g.lda * 2, hstepB = (size_t)HALF * g.ldb * 2;
    const size_t tstepA = 2 * hstepA, tstepB = 2 * hstepB;
    const size_t pnA = (size_t)g.a_pn_off * 2;
    const unsigned ldsw = (unsigned)wid * 1024u;
    const int aoff = lds_byte(wr * 64 + fr, fq * 8), boff = lds_byte(wc * 32 + fr, fq * 8);
#define PG8_SA(b, h) (((b) * 2 + (h)) * HTB)
#define PG8_SB(b, h) ((4 + (b) * 2 + (h)) * HTB)
#define PG8_STAGE(bufoff, gbase, voff) do { _Pragma("unroll") for (int _i = 0; _i < 2; ++_i) \
        __builtin_amdgcn_global_load_lds((const unsigned*)((const char*)(gbase) + (voff)[_i]), (LAS unsigned*)(lds + (bufoff) + ldsw + _i * 8192), 16, 0, 0); } while (0)
#define PG8_LDA(dst, b, h) do { _Pragma("unroll") for (int m = 0; m < 4; ++m) _Pragma("unroll") for (int k = 0; k < 2; ++k) dst[m][k] = *(const LAS bf16x8*)(lds + PG8_SA(b, h) + aoff + m * 2048 + k * 1024); } while (0)
#define PG8_LDB(dst, b, h) do { _Pragma("unroll") for (int n = 0; n < 2; ++n) _Pragma("unroll") for (int k = 0; k < 2; ++k) dst[n][k] = *(const LAS bf16x8*)(lds + PG8_SB(b, h) + boff + n * 2048 + k * 1024); } while (0)
#define PG8_MMA(ai, bj, At, Bt) do { __builtin_amdgcn_s_setprio(1); _Pragma("unroll") for (int m = 0; m < 4; ++m) _Pragma("unroll") for (int n = 0; n < 2; ++n) _Pragma("unroll") for (int k = 0; k < 2; ++k) \
        acc[ai][bj][m][n] = __builtin_amdgcn_mfma_f32_16x16x32_bf16(Bt[n][k], At[m][k], acc[ai][bj][m][n], 0, 0, 0); __builtin_amdgcn_s_setprio(0); } while (0)
#define PG8_WAIT_V(n) asm volatile("s_waitcnt vmcnt(" #n ")" ::: "memory")
#define PG8_WAIT_L(n) asm volatile("s_waitcnt lgkmcnt(" #n ")" ::: "memory")
#define PG8_BAR __builtin_amdgcn_s_barrier()
#define PG8_SCHED __builtin_amdgcn_sched_barrier(0)
    Unit cur, nxt; int ui = 0;
    if (!S.next(0, cur)) return;
    f32x4 acc[2][2][4][2];
#pragma unroll
    for (int a = 0; a < 2; ++a)
#pragma unroll
        for (int b = 0; b < 2; ++b)
#pragma unroll
            for (int m = 0; m < 4; ++m)
#pragma unroll
                for (int n = 0; n < 2; ++n) acc[a][b][m][n] = (f32x4){0.f, 0.f, 0.f, 0.f};
    bf16x8 At[4][2], B0[2][2], B1[2][2];
    const char* cA = (const char*)g.A + (size_t)cur.pm * tstepA + (size_t)cur.pn * pnA; const char* cB = (const char*)g.Bt + (size_t)cur.pn * tstepB;
    S.a_ready(cur);
    if constexpr (SP2) {
        PG8_STAGE(PG8_SB(0, 0), cB, voffB); PG8_STAGE(PG8_SB(0, 1), cB + hstepB, voffB); PG8_STAGE(PG8_SA(0, 0), cA, voffA); PG8_STAGE(PG8_SA(0, 1), cA + hstepA, voffA);
        if (wr == 1) PG8_BAR;
        PG8_WAIT_V(2); PG8_BAR;
        PG8_STAGE(PG8_SB(1, 0), cB + kstep, voffB); PG8_STAGE(PG8_SA(1, 0), cA + kstep, voffA); PG8_STAGE(PG8_SB(1, 1), cB + hstepB + kstep, voffB);
        PG8_WAIT_V(6); PG8_BAR;
    } else {
        PG8_STAGE(PG8_SB(0, 0), cB, voffB); PG8_STAGE(PG8_SA(0, 0), cA, voffA); PG8_STAGE(PG8_SB(0, 1), cB + hstepB, voffB); PG8_STAGE(PG8_SA(0, 1), cA + hstepA, voffA);
        if (wr == 1) PG8_BAR;
        PG8_WAIT_V(4); PG8_BAR;
        PG8_STAGE(PG8_SB(1, 0), cB + kstep, voffB); PG8_STAGE(PG8_SA(1, 0), cA + kstep, voffA); PG8_STAGE(PG8_SB(1, 1), cB + hstepB + kstep, voffB);
        PG8_WAIT_V(6); PG8_BAR;
    }
    for (;;) {
        const bool has_next = S.next(ui + 1, nxt);
        const char* nA = has_next ? (const char*)g.A + (size_t)nxt.pm * tstepA + (size_t)nxt.pn * pnA : cA; const char* nB = has_next ? (const char*)g.Bt + (size_t)nxt.pn * tstepB : cB;
        for (int t = 0; t < nt; t += 2) {
            const bool last = (t == nt - 2);
            const char* a1 = cA + (size_t)(t + 1) * kstep;
            const char* a2 = last ? nA : cA + (size_t)(t + 2) * kstep; const char* b2 = last ? nB : cB + (size_t)(t + 2) * kstep;
            const char* a3 = a2 + kstep; const char* b3 = b2 + kstep;
            if (last && has_next) S.a_ready(nxt);
            if constexpr (SP2) {
            PG8_LDB(B0, 0, 0); PG8_LDB(B1, 0, 1); PG8_SCHED; PG8_LDA(At, 0, 0); PG8_STAGE(PG8_SA(1, 1), a1 + hstepA, voffA);
            PG8_WAIT_V(8); PG8_WAIT_L(0); PG8_BAR; PG8_MMA(0, 0, At, B0); PG8_MMA(0, 1, At, B1); PG8_BAR; PG8_SCHED;
            PG8_LDA(At, 0, 1); PG8_STAGE(PG8_SB(0, 0), b2, voffB); PG8_STAGE(PG8_SB(0, 1), b2 + hstepB, voffB); PG8_STAGE(PG8_SA(0, 0), a2, voffA);
            PG8_WAIT_V(8); PG8_WAIT_L(0); PG8_BAR; PG8_MMA(1, 0, At, B0); PG8_MMA(1, 1, At, B1); PG8_BAR; PG8_SCHED;
            PG8_LDB(B0, 1, 0); PG8_LDB(B1, 1, 1); PG8_SCHED; PG8_LDA(At, 1, 0); PG8_STAGE(PG8_SA(0, 1), a2 + hstepA, voffA);
            PG8_WAIT_V(8); PG8_WAIT_L(0); PG8_BAR; PG8_MMA(0, 0, At, B0); PG8_MMA(0, 1, At, B1); PG8_BAR; PG8_SCHED;
            PG8_LDA(At, 1, 1); PG8_STAGE(PG8_SB(1, 0), b3, voffB); PG8_STAGE(PG8_SB(1, 1), b3 + hstepB, voffB); PG8_STAGE(PG8_SA(1, 0), a3, voffA);
            PG8_WAIT_V(8); PG8_WAIT_L(0); PG8_BAR; PG8_MMA(1, 0, At, B0); PG8_MMA(1, 1, At, B1); PG8_BAR; PG8_SCHED;
            } else {
            PG8_LDB(B0, 0, 0); PG8_SCHED; PG8_LDA(At, 0, 0); PG8_STAGE(PG8_SA(1, 1), a1 + hstepA, voffA);
            PG8_WAIT_L(8); PG8_BAR; PG8_WAIT_L(0); PG8_MMA(0, 0, At, B0); PG8_BAR; PG8_SCHED;
            PG8_LDB(B1, 0, 1); PG8_STAGE(PG8_SB(0, 0), b2, voffB);
            PG8_BAR; PG8_WAIT_L(0); PG8_MMA(0, 1, At, B1); PG8_BAR;
            PG8_LDA(At, 0, 1); PG8_STAGE(PG8_SA(0, 0), a2, voffA);
            PG8_BAR; PG8_WAIT_L(0); PG8_MMA(1, 0, At, B0); PG8_BAR; PG8_SCHED;
            PG8_STAGE(PG8_SB(0, 1), b2 + hstepB, voffB);
            PG8_WAIT_V(6); PG8_BAR; PG8_MMA(1, 1, At, B1); PG8_BAR;
            PG8_LDB(B0, 1, 0); PG8_SCHED; PG8_LDA(At, 1, 0); PG8_STAGE(PG8_SA(0, 1), a2 + hstepA, voffA);
            PG8_WAIT_L(8); PG8_BAR; PG8_WAIT_L(0); PG8_MMA(0, 0, At, B0); PG8_BAR; PG8_SCHED;
            PG8_LDB(B1, 1, 1); PG8_STAGE(PG8_SB(1, 0), b3, voffB);
            PG8_BAR; PG8_WAIT_L(0); PG8_MMA(0, 1, At, B1); PG8_BAR;
            PG8_LDA(At, 1, 1); PG8_STAGE(PG8_SA(1, 0), a3, voffA);
            PG8_BAR; PG8_WAIT_L(0); PG8_MMA(1, 0, At, B0); PG8_BAR; PG8_SCHED;
            PG8_STAGE(PG8_SB(1, 1), b3 + hstepB, voffB);
            PG8_WAIT_V(6); PG8_BAR; PG8_MMA(1, 1, At, B1); PG8_BAR;
            }
        }
        if constexpr (ALIGN_EPI) { if (wr == 0) PG8_BAR; }
        E(acc, cur, wr, wc, fr, fq); S.done(cur);
        if (!has_next) break;
#pragma unroll
        for (int a = 0; a < 2; ++a)
#pragma unroll
            for (int b = 0; b < 2; ++b)
#pragma unroll
                for (int m = 0; m < 4; ++m)
#pragma unroll
                    for (int n = 0; n < 2; ++n) acc[a][b][m][n] = (f32x4){0.f, 0.f, 0.f, 0.f};
        cur = nxt; cA = nA; cB = nB; ++ui;
        if constexpr (ALIGN_EPI) { if (wr == 1) PG8_BAR; }
    }
    PG8_WAIT_V(0);
    if constexpr (!ALIGN_EPI) { if (wr == 0) PG8_BAR; }
    PG8_BAR;
#undef PG8_SA
#undef PG8_SB
#undef PG8_STAGE
#undef PG8_LDA
#undef PG8_LDB
#undef PG8_MMA
#undef PG8_WAIT_V
#undef PG8_WAIT_L
#undef PG8_BAR
#undef PG8_SCHED
}

struct EpiPool {
    static constexpr bool PERM = true, AFTER_DRAIN = false;
    bf16_t* O; const bf16_t* pgate;
    __device__ __forceinline__ void operator()(const f32x4 (&acc)[2][2][4][2], const Unit& u, int wr, int wc, int fr, int fq) const {
        const int row0 = u.pm * BM + wr * 64 + fr, col0 = u.pn * BM + wc * 32 + 8 * fq;
#pragma unroll
        for (int ai = 0; ai < 2; ++ai)
#pragma unroll
            for (int m = 0; m < 4; ++m)
#pragma unroll
                for (int bj = 0; bj < 2; ++bj) {
                    const int row = row0 + ai * HALF + m * 16, col = col0 + bj * HALF;
                    const u32x4 gz = *(const u32x4*)(pgate + (size_t)row * 1024 + col);
                    const f32x4 v0 = acc[ai][bj][m][0], v1 = acc[ai][bj][m][1];
                    u32x4 w;
                    w.x = cvt_pk_bf16(v0[0] * bflo(gz.x), v0[1] * bfhi(gz.x));
                    w.y = cvt_pk_bf16(v0[2] * bflo(gz.y), v0[3] * bfhi(gz.y));
                    w.z = cvt_pk_bf16(v1[0] * bflo(gz.z), v1[1] * bfhi(gz.z));
                    w.w = cvt_pk_bf16(v1[2] * bflo(gz.w), v1[3] * bfhi(gz.w));
                    *(u32x4*)(O + (size_t)row * 1024 + col) = w;
                    __builtin_amdgcn_sched_barrier(0);
                }
    }
};
template <int PASS> struct EpiMerge {
    static constexpr bool PERM = true, AFTER_DRAIN = false;
    float* yacc; bf16_t* y; const bf16_t* zg;
    __device__ __forceinline__ void operator()(const f32x4 (&acc)[2][2][4][2], const Unit& u, int wr, int wc, int fr, int fq) const {
        const int row0 = u.pm * BM + wr * 64 + fr, col0 = u.pn * BM + wc * 32 + 8 * fq;
#pragma unroll
        for (int ai = 0; ai < 2; ++ai)
#pragma unroll
            for (int m = 0; m < 4; ++m)
#pragma unroll
                for (int bj = 0; bj < 2; ++bj) {
                    const int row = row0 + ai * HALF + m * 16, col = col0 + bj * HALF;
                    float gz[8]; unpack8(*(const u32x4*)(zg + (size_t)row * NZ + col), gz);
                    const f32x4 v0 = acc[ai][bj][m][0], v1 = acc[ai][bj][m][1];
                    f32x4 r0, r1;
#pragma unroll
                    for (int e = 0; e < 4; ++e) { r0[e] = v0[e] * sigmoid_f(gz[e]); r1[e] = v1[e] * sigmoid_f(gz[4 + e]); }
                    float* yp = yacc + (size_t)row * DM + col;
                    if (PASS >= 1) { r0 += *(const f32x4*)yp; r1 += *(const f32x4*)(yp + 4); }
                    if (PASS <= 1) { *(f32x4*)yp = r0; *(f32x4*)(yp + 4) = r1; }
                    else { u32x4 w; w.x = cvt_pk_bf16(r0[0], r0[1]); w.y = cvt_pk_bf16(r0[2], r0[3]); w.z = cvt_pk_bf16(r1[0], r1[1]); w.w = cvt_pk_bf16(r1[2], r1[3]);
                        *(u32x4*)(y + (size_t)row * DM + col) = w; }
                    __builtin_amdgcn_sched_barrier(0);
                }
    }
};
struct EpiOut {
    static constexpr bool PERM = true, AFTER_DRAIN = false;
    const float* xlat; const float* xctx; float* xnew; const float* mod;
    __device__ __forceinline__ void operator()(const f32x4 (&acc)[2][2][4][2], const Unit& u, int wr, int wc, int fr, int fq) const {
        const int row0 = u.pm * BM + wr * 64 + fr, col0 = u.pn * BM + wc * 32 + 8 * fq;
        const int tile_row = u.pm * BM; const int mr = tile_row < ML ? tile_row / SEQ : 4;
        const float* xo = tile_row < ML ? xlat : (xctx - (size_t)ML * DM);
        const float* gm = mod + mr * 6144 + 4096;
#pragma unroll
        for (int ai = 0; ai < 2; ++ai)
#pragma unroll
            for (int m = 0; m < 4; ++m)
#pragma unroll
                for (int bj = 0; bj < 2; ++bj) {
                    const int row = row0 + ai * HALF + m * 16, col = col0 + bj * HALF;
                    const f32x4 g0 = *(const f32x4*)(gm + col), g1 = *(const f32x4*)(gm + col + 4);
                    const float* xp = xo + (size_t)row * DM + col;
                    const f32x4 r0 = *(const f32x4*)xp + g0 * acc[ai][bj][m][0], r1 = *(const f32x4*)(xp + 4) + g1 * acc[ai][bj][m][1];
                    float* op = xnew + (size_t)row * DM + col;
                    *(f32x4*)op = r0; *(f32x4*)(op + 4) = r1;
                    __builtin_amdgcn_sched_barrier(0);
                }
    }
};
}

struct Args { const float* in[26]; float* out; unsigned char* ws; int ph_lo, ph_hi; };
enum { I_X = 0, I_C, I_CTX, I_CCTX, I_NORMG, I_WADA, I_BADA, I_WIN, I_POOLW, I_POOLS, I_QNORM, I_KNORM, I_LQ1, I_LK1, I_LQ2, I_LK2, I_SUBLN, I_WGF, I_BGF, I_WGB, I_BGB, I_GLAN, I_WBP, I_WBD, I_WBG, I_WOUT };

__device__ __forceinline__ const float* inp(int i) { const float* const volatile __attribute__((address_space(4)))* kp = (const float* const volatile __attribute__((address_space(4)))*)__builtin_amdgcn_kernarg_segment_ptr(); return kp[i]; }
__device__ __forceinline__ float* arg_out() { float* const volatile __attribute__((address_space(4)))* kp = (float* const volatile __attribute__((address_space(4)))*)__builtin_amdgcn_kernarg_segment_ptr(); return kp[26]; }
__device__ __forceinline__ void transpose_item(const float* W, int K, int N, bf16_t* WT, int row_off, LAS float* scr, int kb, int nb, int lane) {
    const int k0 = 64 * kb, n0 = 32 * nb;
#pragma unroll 8
    for (int i = 0; i < 32; ++i) { const int kk = 2 * i + (lane >> 5); scr[kk * 33 + (lane & 31)] = W[(size_t)(k0 + kk) * N + n0 + (lane & 31)]; }
    asm volatile("s_waitcnt lgkmcnt(0)" ::: "memory");
    const int c = lane & 7;
#pragma unroll
    for (int j = 0; j < 4; ++j) { const int n = (lane >> 3) + 8 * j; const LAS float* s = scr + (8 * c) * 33 + n;
        u32x4 o; o.x = cvt_pk_bf16(s[0 * 33], s[1 * 33]); o.y = cvt_pk_bf16(s[2 * 33], s[3 * 33]); o.z = cvt_pk_bf16(s[4 * 33], s[5 * 33]); o.w = cvt_pk_bf16(s[6 * 33], s[7 * 33]);
        *(u32x4*)(WT + (size_t)(row_off + n0 + n) * K + k0 + 8 * c) = o; }
    asm volatile("s_waitcnt lgkmcnt(0)" ::: "memory");
}

__device__ __forceinline__ void phase_p0(const Args& a, LAS unsigned char* lds) {
    const int tid = opaque_tid(), lane = tid & 63, wave = __builtin_amdgcn_readfirstlane(tid >> 6), G = opaque_s(gridDim.x);
    unsigned char* ws = opaque_ptr(a.ws);
    {
        LAS float* sc = (LAS float*)(lds + 69632);
        LAS float* part = (LAS float*)(lds + 69632 + 40960);
        if (BID < 192) {
            for (int i = tid; i < 5 * 2048; i += 512) { const int r = i >> 11, k = i & 2047; const float v = r < 4 ? inp(I_C)[r * 2048 + k] : inp(I_CCTX)[k]; sc[i] = silu_f(v); }
            __syncthreads();
        }
        for (int it = BID; it < 192; it += G) {
            const int l = it / 96, cgp = it % 96, col = cgp * 64 + lane;
            const float* W = inp(I_WADA) + (size_t)l * 2048 * 6144 + col;
            float acc[5] = {0.f, 0.f, 0.f, 0.f, 0.f};
#pragma unroll 8
            for (int kk = 0; kk < 256; ++kk) { const int k = wave * 256 + kk; const float wv = W[(size_t)k * 6144];
#pragma unroll
                for (int r = 0; r < 5; ++r) acc[r] += sc[r * 2048 + k] * wv; }
#pragma unroll
            for (int r = 0; r < 5; ++r) part[(wave * 5 + r) * 64 + lane] = acc[r];
            __syncthreads();
            if (tid < 320) { const int r = tid >> 6, ln = tid & 63; float s = inp(I_BADA)[l * 6144 + cgp * 64 + ln];
#pragma unroll
                for (int w = 0; w < 8; ++w) s += part[(w * 5 + r) * 64 + ln];
                ((float*)(ws + OFF_MOD))[(l * 5 + r) * 6144 + cgp * 64 + ln] = s; }
            __syncthreads();
        }
    }
    if (BID == G - 1 && wave == 0) {
        for (int l = 0; l < 2; ++l) {
            const float s1 = wave_sum(inp(I_LQ1)[l * 64 + lane] * inp(I_LK1)[l * 64 + lane]);
            const float s2 = wave_sum(inp(I_LQ2)[l * 64 + lane] * inp(I_LK2)[l * 64 + lane]);
            const float mq = wave_max(fabsf(inp(I_QNORM)[l * 64 + lane])), mk = wave_max(fabsf(inp(I_KNORM)[l * 64 + lane]));
            const float lam_init = 0.8f - 0.6f * expf(-0.3f * (float)l);
            if (lane == 0) { float* sp = (float*)(ws + OFF_SCAL) + l * 4; sp[0] = expf(s1) - expf(s2) + lam_init; sp[1] = 8.f * LOG2E * mq * mk; sp[2] = lam_init; sp[3] = 0.f; }
        }
    }
    {
        const int nper = 224 * 2048 * 2 / 16;
        for (int i = BID * 512 + tid; i < 2 * nper; i += G * 512) { const int l = i / nper, j = i % nper;
            *(u32x4*)(ws + OFF_WIN + (size_t)l * SZ_WIN + (size_t)9248 * DM * 2 + (size_t)j * 16) = (u32x4){0u, 0u, 0u, 0u}; }
    }
    {
        LAS float* scr = (LAS float*)(lds + wave * 8704);
        const int gw = BID * 8 + wave, NGW = G * 8;
        constexpr int I_IN = 32 * 481, I_B = 16 * 64, I_O = 32 * 64, I_P = 4 * 32, PER_L = I_IN + 3 * I_B + I_O + I_P;
        for (int it = gw; it < 2 * PER_L; it += NGW) {
            const int l = it / PER_L; int r = it % PER_L;
            if (r < I_IN) { const int kb = r / 481, nb = r % 481;
                transpose_item(inp(I_WIN) + (size_t)l * DM * DIN, DM, DIN, (bf16_t*)(ws + OFF_WIN + (size_t)l * SZ_WIN), nb >= 289 ? 224 : 0, scr, kb, nb, lane); continue; }
            r -= I_IN;
            if (r < 3 * I_B) { const int br = r / I_B, rr = r % I_B; const float* W = (br == 0 ? inp(I_WBP) : br == 1 ? inp(I_WBD) : inp(I_WBG)) + (size_t)l * 1024 * DM;
                transpose_item(W, 1024, DM, (bf16_t*)(ws + OFF_WB + (size_t)l * SZ_WB + (size_t)br * DM * 1024 * 2), 0, scr, rr / 64, rr % 64, lane); continue; }
            r -= 3 * I_B;
            if (r < I_O) { transpose_item(inp(I_WOUT) + (size_t)l * DM * DM, DM, DM, (bf16_t*)(ws + OFF_WOUT + (size_t)l * SZ_WOUT), 0, scr, r / 64, r % 64, lane); continue; }
            r -= I_O;
            { const int g = r / 32, rr = r % 32;
              transpose_item(inp(I_POOLW) + (size_t)(l * 4 + g) * 65536, 256, 256, (bf16_t*)(ws + OFF_POOLT + (size_t)l * SZ_POOLT + (size_t)g * 65536 * 2), 0, scr, rr / 8, rr % 8, lane); }
        }
    }
}

__device__ __forceinline__ void phase_norm(const Args& a, int l) {
    const int tid = opaque_tid(), lane = tid & 63, wave = tid >> 6, G = opaque_s(gridDim.x);
    const int gw = BID * 8 + wave, NGW = G * 8;
    const float* mod = (const float*)(opaque_ptr(a.ws) + OFF_MOD) + (size_t)l * 5 * 6144;
    const float* x1 = (const float*)(opaque_ptr(a.ws) + OFF_X1);
    bf16_t* h = (bf16_t*)(opaque_ptr(a.ws) + OFF_H);
    const float* ng = inp(I_NORMG) + l * DM;
    for (int row = gw; row < MT; row += NGW) {
        const float* src = (l == 0) ? (row < ML ? inp(I_X) + (size_t)row * DM : inp(I_CTX) + (size_t)(row - ML) * DM) : x1 + (size_t)row * DM;
        const int mr = row < ML ? row / SEQ : 4;
        const float* md = mod + mr * 6144;
        f32x4 v[8]; float ss = 0.f;
#pragma unroll
        for (int j = 0; j < 8; ++j) { v[j] = *(const f32x4*)(src + 4 * lane + 256 * j); ss += (v[j][0] * v[j][0] + v[j][1] * v[j][1]) + (v[j][2] * v[j][2] + v[j][3] * v[j][3]); }
        ss = wave_sum(ss);
        const float rstd = rsqrtf(ss * (1.f / DM) + EPS);
#pragma unroll
        for (int j = 0; j < 8; ++j) { const int idx = 4 * lane + 256 * j;
            const f32x4 gg = *(const f32x4*)(ng + idx), sc = *(const f32x4*)(md + 2048 + idx), sh = *(const f32x4*)(md + idx);
            f32x4 o;
#pragma unroll
            for (int e = 0; e < 4; ++e) o[e] = v[j][e] * rstd * gg[e] * (1.f + sc[e]) + sh[e];
            u32x2 w; w.x = cvt_pk_bf16(o[0], o[1]); w.y = cvt_pk_bf16(o[2], o[3]);
            *(u32x2*)(h + (size_t)row * DM + idx) = w; }
    }
}

__device__ __forceinline__ int vt_pos(int key) { const int k = key & 15; return (key & ~15) | (((k >> 2) & 1) << 3) | (k & 3) | (((k >> 3) & 1) << 2); }

__device__ __forceinline__ void phase_prep(const Args& a, int l, LAS unsigned char* lds) {
    const int tid = opaque_tid(), lane = tid & 63, wave = tid >> 6, G = opaque_s(gridDim.x);
    unsigned char* ws = opaque_ptr(a.ws);
    const bf16_t* z = (const bf16_t*)(ws + OFF_Z);
    const bool need_ctx = (l == 0);
    for (int it = BID; it < 1728; it += G) {
        if (it < 1152) {
            const int c = it >> 3, cgp = it & 7, rb = 64 * c;
            LAS float* lrs = (LAS float*)lds;
            LAS float* segs = (LAS float*)(lds + 8192);
            for (int i = tid; i < 64 * 32; i += 512) { const int r = i >> 5, cc = i & 31; lrs[i] = bf2f(z[(size_t)(rb + r) * NZ + ZC_LR + cc]); }
            __syncthreads();
            const int seg = tid >> 6, chl = tid & 63, ch = cgp * 64 + chl;
            float wf[16], wb[16];
#pragma unroll
            for (int r = 0; r < 16; ++r) { wf[r] = inp(I_WGF)[(size_t)l * 16 * 512 + r * 512 + ch]; wb[r] = inp(I_WGB)[(size_t)l * 16 * 512 + r * 512 + ch]; }
            const float bfv = inp(I_BGF)[l * 512 + ch], bbv = inp(I_BGB)[l * 512 + ch];
            float gf[8], gb[8]; float sf = 0.f, sb = 0.f;
#pragma unroll
            for (int i = 0; i < 8; ++i) { const int t = seg * 8 + i; float af = bfv, ab = bbv;
#pragma unroll
                for (int r = 0; r < 16; ++r) { af += lrs[t * 32 + r] * wf[r]; ab += lrs[t * 32 + 16 + r] * wb[r]; }
                gf[i] = logsig_f(af) * (1.f / 16.f); gb[i] = logsig_f(ab) * (1.f / 16.f); sf += gf[i]; sb += gb[i]; }
            segs[seg * 64 + chl] = sf; segs[512 + seg * 64 + chl] = sb;
            __syncthreads();
            float pf = 0.f, pb = 0.f, totf = 0.f, totb = 0.f;
#pragma unroll
            for (int s2 = 0; s2 < 8; ++s2) { const float vf = segs[s2 * 64 + chl], vb = segs[512 + s2 * 64 + chl]; totf += vf; totb += vb; if (s2 < seg) { pf += vf; pb += vb; } }
            bf16_t* gq0 = (bf16_t*)(ws + OFF_GQ), *gq1 = (bf16_t*)(ws + OFF_GQ + SZ_G);
            bf16_t* gk0 = (bf16_t*)(ws + OFF_GK), *gk1 = (bf16_t*)(ws + OFF_GK + SZ_G);
            bf16_t* gh0 = (bf16_t*)(ws + OFF_GH), *gh1 = (bf16_t*)(ws + OFF_GH + SZ_G);
#pragma unroll
            for (int i = 0; i < 8; ++i) { const int t = seg * 8 + i;
                pf += gf[i]; const float bs = totb - pb; pb += gb[i];
                const size_t row = rb + t;
                const float q = bf2f(z[row * NZ + ZC_GQ + ch]) * 0.08838834764831845f, k = bf2f(z[row * NZ + ZC_GK + ch]);
                const size_t o = row * 512 + ch;
                gq0[o] = f2bf(q * __expf(pf)); gk0[o] = f2bf(k * __expf(-pf)); gh0[o] = f2bf(k * __expf(totf - pf));
                gq1[o] = f2bf(q * __expf(bs)); gk1[o] = f2bf(k * __expf(-bs)); gh1[o] = f2bf(k * __expf(totb - bs)); }
            if (seg == 0) { float* dec = (float*)(ws + OFF_DEC); dec[(size_t)c * 512 + ch] = __expf(totf); dec[(size_t)(144 + c) * 512 + ch] = __expf(totb); }
            __syncthreads();
        } else if (it < 1440) {
            const int rb = 32 * (it - 1152); if (!need_ctx && rb >= ML) continue;
            const int seq0 = rb < ML ? (rb / SEQ) * SEQ : ML + ((rb - ML) / LC) * LC; const int L = rb < ML ? SEQ : LC; const int tl0 = rb - seq0;
            unsigned* dp = (unsigned*)(ws + OFF_DPOOL); unsigned* pgt = (unsigned*)(ws + OFF_PGATE);
            const int ch2 = 2 * tid, hw = 1 << (ch2 >> 8);
            const float psc0 = inp(I_POOLS)[l * 1024 + ch2], psc1 = inp(I_POOLS)[l * 1024 + ch2 + 1];
            const bf16_t* zc = z + (size_t)seq0 * NZ + ZC_PU + ch2;
            float s0 = 0.f, s1 = 0.f;
            { const int lo = max(tl0 - hw, 0), hi = min(tl0 + hw, L);
              for (int p = lo; p < hi; ++p) { const unsigned u = *(const unsigned*)(zc + (size_t)p * NZ); s0 += bflo(u); s1 += bfhi(u); } }
#pragma unroll 4
            for (int t = 0; t < 32; ++t) { const int tl = tl0 + t; const int lo = max(tl - hw, 0), hi = min(tl + hw, L);
                const float rc = 1.f / (float)(hi - lo);
                const unsigned cur = *(const unsigned*)(zc + (size_t)tl * NZ), pgv = *(const unsigned*)(zc + (size_t)tl * NZ + (ZC_PG - ZC_PU));
                const unsigned ua = *(const unsigned*)(zc + (size_t)min(tl + hw, L - 1) * NZ), ur = *(const unsigned*)(zc + (size_t)max(tl - hw, 0) * NZ);
                const size_t o = ((size_t)(seq0 + tl) * 1024 + ch2) >> 1;
                dp[o] = cvt_pk_bf16(s0 * rc - bflo(cur), s1 * rc - bfhi(cur));
                pgt[o] = cvt_pk_bf16(psc0 * silu_f(bflo(pgv)), psc1 * silu_f(bfhi(pgv)));
                const float ma = (tl + hw < L) ? 1.f : 0.f, mr = (tl - hw >= 0) ? 1.f : 0.f;
                s0 += ma * bflo(ua) - mr * bflo(ur); s1 += ma * bfhi(ua) - mr * bfhi(ur); }
        } else {
            const int vi = it - 1440, c = vi >> 1, hv = vi & 1, rb = 64 * c;
            int b, key0; if (rb < ML) { b = rb >> 11; key0 = LC + (rb & 2047); } else { b = (rb - ML) >> 8; key0 = (rb - ML) & 255; }
            bf16_t* vT = (bf16_t*)(ws + OFF_VT);
#pragma unroll
            for (int i = 0; i < 8; ++i) { const int idx = tid + 512 * i, key = idx & 63, c8 = (idx >> 6) * 8;
                const u32x4 w = *(const u32x4*)(z + (size_t)(rb + key) * NZ + ZC_DV + hv * 512 + c8);
                const unsigned ww[4] = {w.x, w.y, w.z, w.w}; const int pos = vt_pos(key);
#pragma unroll
                for (int e = 0; e < 8; ++e) *(LAS bf16_t*)(lds + (c8 + e) * 144 + pos * 2) = (bf16_t)((e & 1) ? (ww[e >> 1] >> 16) : (ww[e >> 1] & 0xffffu)); }
            __syncthreads();
#pragma unroll
            for (int i = 0; i < 8; ++i) { const int idx = tid + 512 * i, col = idx >> 3, k8 = idx & 7, colg = hv * 512 + col, h = colg >> 7, v = colg & 127;
                *(u32x4*)(vT + ((size_t)(b * 8 + h) * 128 + v) * LK + key0 + k8 * 8) = *(const LAS u32x4*)(lds + col * 144 + k8 * 16); }
            __syncthreads();
        }
    }
    {
        const int gw = BID * 8 + wave, NGW = G * 8;
        bf16_t* qn = (bf16_t*)(ws + OFF_QN); bf16_t* qnc = (bf16_t*)(ws + OFF_QNC); bf16_t* kn = (bf16_t*)(ws + OFF_KN);
        for (int it = gw; it < MT * 2; it += NGW) {
            const int row = it >> 1, which = it & 1;
            const bool isctx = row >= ML; int b, t; if (!isctx) { b = row >> 11; t = row & 2047; } else { b = (row - ML) >> 8; t = (row - ML) & 255; }
            const bf16_t* zr = z + (size_t)row * NZ;
            {
                if (which == 0 && isctx && !need_ctx) continue;
                float x[16]; const bf16_t* src = zr + (which == 0 ? ZC_DQ : ZC_DK) + 16 * lane;
                unpack8(*(const u32x4*)src, x); unpack8(*(const u32x4*)(src + 8), x + 8);
                float ss = 0.f;
#pragma unroll
                for (int e = 0; e < 16; ++e) ss += x[e] * x[e];
                ss += __shfl_xor(ss, 1); ss += __shfl_xor(ss, 2);
                const float rstd = rsqrtf(ss * (1.f / 64.f) + EPS);
                const int m = lane & 3, sh = lane >> 2, h = sh >> 1, j = sh & 1;
                const float* gain = (which == 0 ? inp(I_QNORM) : inp(I_KNORM)) + l * 64 + 16 * m;
                float y[16];
#pragma unroll
                for (int e = 0; e < 16; ++e) y[e] = x[e] * rstd * gain[e];
                if (!isctx) {
                    const float posf = (float)((m & 1) ? (t & 63) : (t >> 6));
#pragma unroll
                    for (int e = 0; e < 16; ++e) { const float yp = __shfl_xor(y[e], 2);
                        const float ang = posf * exp2f(-(float)e * 0.8304820237218405f);
                        const float cs = __cosf(ang), sn = __sinf(ang);
                        y[e] = (m < 2) ? (y[e] * cs - yp * sn) : (y[e] * cs + yp * sn); }
                }
                bf16_t* dst;
                if (which == 0) {
#pragma unroll
                    for (int e = 0; e < 16; ++e) y[e] *= 0.125f * LOG2E;
                    dst = isctx ? qnc + (((size_t)(b * 8 + h) * 2 + j) * LC + t) * 64 + 16 * m : qn + (((size_t)(b * 8 + h) * 2 + j) * SEQ + t) * 64 + 16 * m;
                } else dst = kn + (((size_t)(b * 8 + h) * 2 + j) * LK + (isctx ? t : LC + t)) * 64 + 16 * m;
                u32x4 w0, w1;
                w0.x = cvt_pk_bf16(y[0], y[1]); w0.y = cvt_pk_bf16(y[2], y[3]); w0.z = cvt_pk_bf16(y[4], y[5]); w0.w = cvt_pk_bf16(y[6], y[7]);
                w1.x = cvt_pk_bf16(y[8], y[9]); w1.y = cvt_pk_bf16(y[10], y[11]); w1.z = cvt_pk_bf16(y[12], y[13]); w1.w = cvt_pk_bf16(y[14], y[15]);
                *(u32x4*)dst = w0; *(u32x4*)(dst + 8) = w1;
            }
        }
    }
}

constexpr int GL_Q = 0, GL_K = 17408, GL_KH = 34816, GL_VT = 53248, GL_ATT = 57856, GL_ST = 67072;
__device__ __forceinline__ void gla_unit(const Args& a, int l, LAS unsigned char* lds, int item) {
    const int tid = opaque_tid(), lane = tid & 63, w = __builtin_amdgcn_readfirstlane(tid >> 6);
    const int vs = item & 7, dir = (item >> 3) & 1, h = (item >> 4) & 3, b = item >> 6;
    const bool need_ctx = (l == 0);
    unsigned char* ws = opaque_ptr(a.ws);
    const bf16_t* z = (const bf16_t*)(ws + OFF_Z);
    const bf16_t* gq = (const bf16_t*)(ws + OFF_GQ + dir * SZ_G) + h * 128;
    const bf16_t* gk = (const bf16_t*)(ws + OFF_GK + dir * SZ_G) + h * 128;
    const bf16_t* gh = (const bf16_t*)(ws + OFF_GH + dir * SZ_G) + h * 128;
    const float* dec = (const float*)(ws + OFF_DEC) + (size_t)dir * 144 * 512 + h * 128;
    bf16_t* od = (bf16_t*)(ws + OFF_OF + (size_t)dir * MT * 1024 * 2) + h * 256 + vs * 32;
    const bf16_t* zv = z + ZC_GV + h * 256 + vs * 32;
    const int fr = lane & 15, fq = lane >> 4;
    f32x4 sacc[2] = {(f32x4){0.f, 0.f, 0.f, 0.f}, (f32x4){0.f, 0.f, 0.f, 0.f}};
    for (int i = tid; i < 32 * 136 / 2; i += 512) ((LAS unsigned*)(lds + GL_ST))[i] = 0u;
    u32x4 rq[2], rk[2], rh[2], rv; float rdec;
    auto rowbase = [&](int s) -> int { if (s < 4) { const int ci = dir == 0 ? s : 3 - s; return ML + b * LC + 64 * ci; } const int ci = dir == 0 ? s - 4 : 35 - s; return b * SEQ + 64 * ci; };
#define GLA_LOAD(s) do { const int _rb = rowbase(s); _Pragma("unroll") for (int _i = 0; _i < 2; ++_i) { const int _idx = tid + 512 * _i, _r = _idx >> 4, _c = (_idx & 15) * 8; const size_t _o = (size_t)(_rb + _r) * 512 + _c; \
        rq[_i] = *(const u32x4*)(gq + _o); rk[_i] = *(const u32x4*)(gk + _o); rh[_i] = *(const u32x4*)(gh + _o); } \
        if (tid < 256) rv = *(const u32x4*)(zv + (size_t)(_rb + (tid >> 2)) * NZ + (tid & 3) * 8); \
        rdec = dec[(size_t)(_rb >> 6) * 512 + 16 * w + fr]; } while (0)
    GLA_LOAD(0);
    for (int s = 0; s < 36; ++s) {
        const int rb = rowbase(s);
        const float dk = rdec;
#pragma unroll
        for (int i = 0; i < 2; ++i) { const int idx = tid + 512 * i, r = idx >> 4, c = (idx & 15) * 8;
            *(LAS u32x4*)(lds + GL_Q + r * 272 + c * 2) = rq[i]; *(LAS u32x4*)(lds + GL_K + r * 272 + c * 2) = rk[i];
            const unsigned hw[4] = {rh[i].x, rh[i].y, rh[i].z, rh[i].w};
#pragma unroll
            for (int e = 0; e < 8; ++e) *(LAS bf16_t*)(lds + GL_KH + (c + e) * 144 + r * 2) = (bf16_t)((e & 1) ? (hw[e >> 1] >> 16) : (hw[e >> 1] & 0xffffu)); }
        if (tid < 256) { const int r = tid >> 2, c = (tid & 3) * 8; const unsigned vw[4] = {rv.x, rv.y, rv.z, rv.w};
#pragma unroll
            for (int e = 0; e < 8; ++e) *(LAS bf16_t*)(lds + GL_VT + (c + e) * 144 + r * 2) = (bf16_t)((e & 1) ? (vw[e >> 1] >> 16) : (vw[e >> 1] & 0xffffu)); }
        __syncthreads();
        if (s + 1 < 36) GLA_LOAD(s + 1);
        {
            const int tt = w >> 1;
#pragma unroll
            for (int si = 0; si < 2; ++si) { const int st = 2 * (w & 1) + si; f32x4 acc = (f32x4){0.f, 0.f, 0.f, 0.f};
#pragma unroll
                for (int kk = 0; kk < 4; ++kk) { const bf16x8 af = *(const LAS bf16x8*)(lds + GL_Q + (16 * tt + fr) * 272 + (32 * kk + 8 * fq) * 2);
                    const bf16x8 bfr = *(const LAS bf16x8*)(lds + GL_K + (16 * st + fr) * 272 + (32 * kk + 8 * fq) * 2);
                    acc = __builtin_amdgcn_mfma_f32_16x16x32_bf16(af, bfr, acc, 0, 0, 0); }
#pragma unroll
                for (int j = 0; j < 4; ++j) { const int t = 16 * tt + 4 * fq + j, sc = 16 * st + fr; const bool keep = dir == 0 ? (sc <= t) : (sc >= t);
                    *(LAS bf16_t*)(lds + GL_ATT + t * 144 + sc * 2) = f2bf(keep ? acc[j] : 0.f); } }
        }
#pragma unroll
        for (int vt = 0; vt < 2; ++vt) { f32x4 acc = sacc[vt] * dk;
#pragma unroll
            for (int kk = 0; kk < 2; ++kk) { const bf16x8 af = *(const LAS bf16x8*)(lds + GL_VT + (16 * vt + fr) * 144 + (32 * kk + 8 * fq) * 2);
                const bf16x8 bfr = *(const LAS bf16x8*)(lds + GL_KH + (16 * w + fr) * 144 + (32 * kk + 8 * fq) * 2);
                acc = __builtin_amdgcn_mfma_f32_16x16x32_bf16(af, bfr, acc, 0, 0, 0); }
            sacc[vt] = acc; }
        __syncthreads();
        {
            const int tt = w >> 1, vt = w & 1; f32x4 acc = (f32x4){0.f, 0.f, 0.f, 0.f};
#pragma unroll
            for (int kk = 0; kk < 4; ++kk) { const bf16x8 af = *(const LAS bf16x8*)(lds + GL_Q + (16 * tt + fr) * 272 + (32 * kk + 8 * fq) * 2);
                const bf16x8 bfr = *(const LAS bf16x8*)(lds + GL_ST + (16 * vt + fr) * 272 + (32 * kk + 8 * fq) * 2);
                acc = __builtin_amdgcn_mfma_f32_16x16x32_bf16(af, bfr, acc, 0, 0, 0); }
#pragma unroll
            for (int kk = 0; kk < 2; ++kk) { const bf16x8 af = *(const LAS bf16x8*)(lds + GL_ATT + (16 * tt + fr) * 144 + (32 * kk + 8 * fq) * 2);
                const bf16x8 bfr = *(const LAS bf16x8*)(lds + GL_VT + (16 * vt + fr) * 144 + (32 * kk + 8 * fq) * 2);
                acc = __builtin_amdgcn_mfma_f32_16x16x32_bf16(af, bfr, acc, 0, 0, 0); }
            if (s >= 4 || need_ctx) {
#pragma unroll
                for (int j = 0; j < 4; ++j) od[(size_t)(rb + 16 * tt + 4 * fq + j) * 1024 + 16 * vt + fr] = f2bf(acc[j]); }
        }
        __syncthreads();
#pragma unroll
        for (int vt = 0; vt < 2; ++vt)
#pragma unroll
            for (int j = 0; j < 4; ++j) *(LAS bf16_t*)(lds + GL_ST + (16 * vt + 4 * fq + j) * 272 + (16 * w + fr) * 2) = f2bf(sacc[vt][j]);
    }
    __syncthreads();
#undef GLA_LOAD
}

constexpr int AT_BUF = 36864, AT_K = 0, AT_V = 18432;
__device__ __forceinline__ void attn_unit(LAS unsigned char* lds, const bf16_t* qbase, int Lq, int q0, const bf16_t* kbase, const bf16_t* vtbase, int nkeys,
                                          float c2, float lam, float post_scale, const float* subln, const bf16_t* dg, bf16_t* outp, int row0) {
    const int tid = opaque_tid(), lane = tid & 63, w = __builtin_amdgcn_readfirstlane(tid >> 6), q32 = lane & 31, hi = lane >> 5;
    const int j = w >> 2, qg = w & 3;
    bf16x8 qf[4];
#pragma unroll
    for (int kk = 0; kk < 4; ++kk) qf[kk] = *(const bf16x8*)(qbase + ((size_t)j * Lq + q0 + 32 * qg + q32) * 64 + 16 * kk + 8 * hi);
    f32x16 o[4];
#pragma unroll
    for (int vt = 0; vt < 4; ++vt)
#pragma unroll
        for (int r = 0; r < 16; ++r) o[vt][r] = 0.f;
    float lsum = 0.f;
    const int nt = nkeys >> 6;
    u32x4 sk[2], sv[2];
#define AT_LOAD(i) do { _Pragma("unroll") for (int _c = 0; _c < 2; ++_c) { const int _idx = tid + 512 * _c; \
        sk[_c] = *(const u32x4*)(kbase + ((size_t)(_idx >> 9) * LK + 64 * (i) + ((_idx & 511) >> 3)) * 64 + (_idx & 7) * 8); \
        sv[_c] = *(const u32x4*)(vtbase + (size_t)(_idx >> 3) * LK + 64 * (i) + (_idx & 7) * 8); } } while (0)
#define AT_STORE(p) do { _Pragma("unroll") for (int _c = 0; _c < 2; ++_c) { const int _idx = tid + 512 * _c; \
        *(LAS u32x4*)(lds + (p) * AT_BUF + AT_K + ((_idx >> 9) * 64 + ((_idx & 511) >> 3)) * 144 + (_idx & 7) * 16) = sk[_c]; \
        *(LAS u32x4*)(lds + (p) * AT_BUF + AT_V + (_idx >> 3) * 144 + (_idx & 7) * 16) = sv[_c]; } } while (0)
    AT_LOAD(0); AT_STORE(0);
    __syncthreads();
    for (int i = 0; i < nt; ++i) {
        const int p = i & 1;
        if (i + 1 < nt) AT_LOAD(i + 1);
        LAS unsigned char* Kb = lds + p * AT_BUF + AT_K + j * (64 * 144); LAS unsigned char* Vb = lds + p * AT_BUF + AT_V;
#pragma unroll
        for (int kb = 0; kb < 2; ++kb) {
            f32x16 s;
#pragma unroll
            for (int r = 0; r < 16; ++r) s[r] = -c2;
#pragma unroll
            for (int kk = 0; kk < 4; ++kk) {
                const bf16x8 a0 = *(const LAS bf16x8*)(Kb + (32 * kb + q32) * 144 + (16 * kk + 8 * hi) * 2);
                s = __builtin_amdgcn_mfma_f32_32x32x16_bf16(a0, qf[kk], s, 0, 0, 0);
            }
#pragma unroll
            for (int r = 0; r < 16; ++r) { s[r] = __builtin_amdgcn_exp2f(s[r]); lsum += s[r]; }
#pragma unroll
            for (int hf = 0; hf < 2; ++hf) {
                const int ks = 2 * kb + hf;
                u32x4 pw;
                pw.x = cvt_pk_bf16(s[8 * hf + 0], s[8 * hf + 1]); pw.y = cvt_pk_bf16(s[8 * hf + 2], s[8 * hf + 3]); pw.z = cvt_pk_bf16(s[8 * hf + 4], s[8 * hf + 5]); pw.w = cvt_pk_bf16(s[8 * hf + 6], s[8 * hf + 7]);
                const bf16x8 pb = __builtin_bit_cast(bf16x8, pw);
#pragma unroll
                for (int vt = 0; vt < 4; ++vt) {
                    const bf16x8 av = *(const LAS bf16x8*)(Vb + (32 * vt + q32) * 144 + (16 * ks + 8 * hi) * 2);
                    o[vt] = __builtin_amdgcn_mfma_f32_32x32x16_bf16(av, pb, o[vt], 0, 0, 0);
                }
            }
        }
        if (i + 1 < nt) AT_STORE(p ^ 1);
        __syncthreads();
    }
#undef AT_LOAD
#undef AT_STORE
    lsum += __shfl_xor(lsum, 32);
    LAS float* xch = (LAS float*)lds + (size_t)qg * 4096 + lane;
    if (j == 1) {
        const float sc = lam / lsum;
#pragma unroll
        for (int vt = 0; vt < 4; ++vt)
#pragma unroll
            for (int r = 0; r < 16; ++r) xch[(vt * 16 + r) * 64] = o[vt][r] * sc;
    }
    __syncthreads();
    if (j == 0) {
        const float i0 = 1.f / lsum;
        float ss = 0.f;
#pragma unroll
        for (int vt = 0; vt < 4; ++vt)
#pragma unroll
            for (int r = 0; r < 16; ++r) { const float v = o[vt][r] * i0 - xch[(vt * 16 + r) * 64]; o[vt][r] = v; ss += v * v; }
        ss += __shfl_xor(ss, 32);
        const float rstd = rsqrtf(ss * (1.f / 128.f) + EPS) * post_scale;
        const size_t row = (size_t)row0 + 32 * qg + q32;
#pragma unroll
        for (int vt = 0; vt < 4; ++vt)
#pragma unroll
            for (int g4 = 0; g4 < 4; ++g4) {
                const int v0 = 32 * vt + 8 * g4 + 4 * hi;
                const u32x2 gz = *(const u32x2*)(dg + row * NZ + v0);
                const f32x4 sl = *(const f32x4*)(subln + v0);
                const float r0 = o[vt][4 * g4 + 0] * rstd * sl[0] * silu_f(bflo(gz.x)), r1 = o[vt][4 * g4 + 1] * rstd * sl[1] * silu_f(bfhi(gz.x));
                const float r2 = o[vt][4 * g4 + 2] * rstd * sl[2] * silu_f(bflo(gz.y)), r3 = o[vt][4 * g4 + 3] * rstd * sl[3] * silu_f(bfhi(gz.y));
                u32x2 wv; wv.x = cvt_pk_bf16(r0, r1); wv.y = cvt_pk_bf16(r2, r3);
                *(u32x2*)(outp + row * 1024 + v0) = wv;
            }
    }
    __syncthreads();
}

__device__ __forceinline__ void phase_mix(const Args& a, int l, LAS unsigned char* lds) {
    const int G = opaque_s(gridDim.x);
    unsigned char* ws = opaque_ptr(a.ws);
    const bool need_ctx = (l == 0);
#ifndef NO_GLA
    for (int it = BID; it < 256; it += G) gla_unit(a, l, lds, it);
#endif
#ifndef NO_ATT
    {
        const float* scal = (const float*)(ws + OFF_SCAL) + l * 4;
        const float lam = scal[0], c2 = scal[1], post = 1.f - scal[2];
        const bf16_t* z = (const bf16_t*)(ws + OFF_Z);
        const int nun = 512 + (need_ctx ? 64 : 0);
        for (int u = BID; u < nun; u += G) {
            if (u < 512) { const int vc = (u & 7) * 64 + (u >> 3), bh = vc >> 4, qb = vc & 15, b = bh >> 3, h = bh & 7;
                attn_unit(lds, (const bf16_t*)(ws + OFF_QN) + (size_t)bh * 2 * SEQ * 64, SEQ, 128 * qb, (const bf16_t*)(ws + OFF_KN) + (size_t)bh * 2 * LK * 64,
                          (const bf16_t*)(ws + OFF_VT) + (size_t)bh * 128 * LK, LK, c2, lam, post, inp(I_SUBLN) + l * 128, z + ZC_DG + h * 128, (bf16_t*)(ws + OFF_DIFFO) + h * 128, b * SEQ + 128 * qb);
            } else { const int uu = u - 512, bh = uu >> 1, qb = uu & 1, b = bh >> 3, h = bh & 7;
                attn_unit(lds, (const bf16_t*)(ws + OFF_QNC) + (size_t)bh * 2 * LC * 64, LC, 128 * qb, (const bf16_t*)(ws + OFF_KN) + (size_t)bh * 2 * LK * 64,
                          (const bf16_t*)(ws + OFF_VT) + (size_t)bh * 128 * LK, LC, c2, lam, post, inp(I_SUBLN) + l * 128, z + ZC_DG + h * 128, (bf16_t*)(ws + OFF_DIFFO) + h * 128, ML + b * LC + 128 * qb);
            }
        }
    }
#endif
#ifndef NO_POOL
    {
        const int Mrows = need_ctx ? MT : ML;
        pg8::Gemm g{(const bf16_t*)(ws + OFF_DPOOL), (const bf16_t*)(ws + OFF_POOLT + (size_t)l * SZ_POOLT), Mrows, 1024, 256, 1024, 256, 256};
        pg8::StaticOrder S; S.init(Mrows, 1024, G, BID);
        pg8::EpiPool E{(bf16_t*)(ws + OFF_POOLO), (const bf16_t*)(ws + OFF_PGATE)};
        pg8::gemm_phase<pg8::EpiPool, pg8::StaticOrder, true, true>(lds, g, S, E);
    }
#endif
}

__device__ __forceinline__ void phase_post(const Args& a, int l) {
    const int tid = opaque_tid(), lane = tid & 63, wave = tid >> 6, G = opaque_s(gridDim.x);
    const int gw = BID * 8 + wave, NGW = G * 8;
    unsigned char* ws = opaque_ptr(a.ws);
    const bf16_t* z = (const bf16_t*)(ws + OFF_Z);
    const bf16_t* of = (const bf16_t*)(ws + OFF_OF); const bf16_t* ob = of + (size_t)MT * 1024;
    bf16_t* go = (bf16_t*)(ws + OFF_GLAO);
    const int Mrows = (l == 0) ? MT : ML;
    const float* gn = inp(I_GLAN) + l * 256 + ((16 * lane) & 255);
    for (int row = gw; row < Mrows; row += NGW) {
        float x[16], y[16], gz[16];
        const size_t o = (size_t)row * 1024 + 16 * lane;
        unpack8(*(const u32x4*)(of + o), x); unpack8(*(const u32x4*)(of + o + 8), x + 8);
        unpack8(*(const u32x4*)(ob + o), y); unpack8(*(const u32x4*)(ob + o + 8), y + 8);
        unpack8(*(const u32x4*)(z + (size_t)row * NZ + ZC_GG + 16 * lane), gz); unpack8(*(const u32x4*)(z + (size_t)row * NZ + ZC_GG + 16 * lane + 8), gz + 8);
        float ss = 0.f;
#pragma unroll
        for (int e = 0; e < 16; ++e) { x[e] += y[e]; ss += x[e] * x[e]; }
        ss += __shfl_xor(ss, 1); ss += __shfl_xor(ss, 2); ss += __shfl_xor(ss, 4); ss += __shfl_xor(ss, 8);
        const float rstd = rsqrtf(ss * (1.f / 256.f) + EPS);
        float r[16];
#pragma unroll
        for (int e = 0; e < 16; ++e) r[e] = x[e] * rstd * gn[e] * silu_f(gz[e]);
        u32x4 w0, w1;
        w0.x = cvt_pk_bf16(r[0], r[1]); w0.y = cvt_pk_bf16(r[2], r[3]); w0.z = cvt_pk_bf16(r[4], r[5]); w0.w = cvt_pk_bf16(r[6], r[7]);
        w1.x = cvt_pk_bf16(r[8], r[9]); w1.y = cvt_pk_bf16(r[10], r[11]); w1.z = cvt_pk_bf16(r[12], r[13]); w1.w = cvt_pk_bf16(r[14], r[15]);
        *(u32x4*)(go + o) = w0; *(u32x4*)(go + o + 8) = w1;
    }
}

#define XB_TMO      128
#define XB_XCNT(j)  (256  + 64 * (j))
#define XB_XSUB(j)  (1280 + 64 * (j))
#define XB_XGEN(j)  (2304 + 64 * (j))
#define XB_TOP      3328
#define XB_TOPGEN   3392
#define XCD_BAR_WORDS 3456
#define XB_SPIN_CAP (1u << 18)

__device__ __forceinline__ unsigned xb_ld(unsigned* p)              { return __hip_atomic_load(p, __ATOMIC_RELAXED, __HIP_MEMORY_SCOPE_AGENT); }
__device__ __forceinline__ unsigned xb_add(unsigned* p, unsigned v) { return __hip_atomic_fetch_add(p, v, __ATOMIC_RELAXED, __HIP_MEMORY_SCOPE_AGENT); }
__device__ __forceinline__ unsigned xb_xcc_id() { return (unsigned)__builtin_amdgcn_s_getreg((3 << 11) | 20) & 0xFu; }
#define XB_SPIN(cond, bar) do { unsigned _sp = 0; while (cond) { __builtin_amdgcn_s_sleep(1); \
    if ((++_sp & 255u) == 0u) { if (xb_ld(&(bar)[XB_TMO])) break; if (_sp > XB_SPIN_CAP) { atomicAdd(&(bar)[XB_TMO], 1u); break; } } } } while (0)

struct XcdBarrier {
    unsigned* bar; unsigned x;
    volatile LAS unsigned* st;
};

__device__ __forceinline__ XcdBarrier xcd_barrier_post(unsigned* bar, volatile LAS unsigned* st) {
    XcdBarrier b; b.bar = bar; b.x = xb_xcc_id(); b.st = st;
    if (threadIdx.x == 0) (void)xb_add(&bar[XB_XCNT(b.x)], 1u);
    return b;
}
__device__ __forceinline__ void xcd_barrier_complete(unsigned* bar, unsigned x, unsigned& nloc, unsigned& nx) {
    const unsigned G = gridDim.x * gridDim.y * gridDim.z;
    unsigned sum, cnt, mine, sp = 0u;
    for (;;) {
        sum = 0u; cnt = 0u; mine = 0u;
#pragma unroll
        for (unsigned j = 0; j < 16; ++j) { const unsigned c = xb_ld(&bar[XB_XCNT(j)]); sum += c; cnt += (c > 0u) ? 1u : 0u; mine = (j == x) ? c : mine; }
        if (sum == G) break;
        __builtin_amdgcn_s_sleep(1);
        if ((++sp & 255u) == 0u) { if (xb_ld(&bar[XB_TMO])) break; if (sp > XB_SPIN_CAP) { atomicAdd(&bar[XB_TMO], 1u); break; } }
    }
    nloc = mine > 0u ? mine : 1u; nx = cnt > 0u ? cnt : 1u;
}

__device__ __forceinline__ void xcd_barrier(const XcdBarrier& b) {
    asm volatile("s_waitcnt vmcnt(0)" ::: "memory");
    __syncthreads();
    if (threadIdx.x == 0) {
        unsigned* bar = b.bar;
        __builtin_amdgcn_s_waitcnt(0);
        unsigned nloc = b.st[0], nx = b.st[1];
        if (nloc == 0u) { xcd_barrier_complete(bar, b.x, nloc, nx); b.st[0] = nloc; b.st[1] = nx; }
        const unsigned old = xb_add(&bar[XB_XSUB(b.x)], 1u);
        const unsigned gen = old / nloc;
        if (old + 1u == (gen + 1u) * nloc) {
            __builtin_amdgcn_fence(__ATOMIC_RELEASE, "agent");
            asm volatile("s_waitcnt vmcnt(0)" ::: "memory");
            const unsigned og = xb_add(&bar[XB_TOP], 1u);
            const unsigned tg = og / nx;
            if (og + 1u == (tg + 1u) * nx) xb_add(&bar[XB_TOPGEN], 1u);
            else XB_SPIN(xb_ld(&bar[XB_TOPGEN]) == tg, bar);
            __builtin_amdgcn_fence(__ATOMIC_ACQUIRE, "agent");
            xb_add(&bar[XB_XGEN(b.x)], 1u);
            asm volatile("s_waitcnt vmcnt(0)" ::: "memory");
        } else {
            XB_SPIN(xb_ld(&bar[XB_XGEN(b.x)]) == gen, bar);
            __builtin_amdgcn_fence(__ATOMIC_ACQUIRE, "agent");
            asm volatile("s_waitcnt vmcnt(0)" ::: "memory");
        }
    }
    __syncthreads();
}

__global__ void __launch_bounds__(512, 2) hybrid_fwd(Args a) {
    extern __shared__ __attribute__((aligned(16))) unsigned char smem[];
    LAS unsigned char* lds = (LAS unsigned char*)smem;
    cg::grid_group grid = cg::this_grid();
    volatile LAS unsigned* bst = (volatile LAS unsigned*)(lds + 131072 + 512);
    if (threadIdx.x < 2) bst[threadIdx.x] = 0u;
    __syncthreads();
    const XcdBarrier xbar = xcd_barrier_post((unsigned*)(a.ws + OFF_BAR), bst);
#ifndef REPEAT_K
#define REPEAT_K -1
#endif
    for (int ph2 = 2 * a.ph_lo; ph2 < 2 * a.ph_hi; ++ph2) {
        const int ph = ph2 >> 1;
        if (ph2 & 1) { if (REPEAT_K < 0) continue; if (!((ph == 0 && REPEAT_K == 7) || (ph > 0 && (ph - 1) % 7 == REPEAT_K))) continue; }
        else if (ph > a.ph_lo) { if (ph == a.ph_lo + 1) grid.sync(); else xcd_barrier(xbar); }
        unsigned char* ws = opaque_ptr(a.ws);
        const int G = opaque_s(gridDim.x);
#ifndef KMASK
#define KMASK 0xff
#endif
        if (ph == 0) { if (KMASK & 128) phase_p0(a, lds); continue; }
        const int l = (ph - 1) / 7, k = (ph - 1) % 7;
        const int Mout = (l == 0) ? MT : ML;
        if (k == 0) { if (KMASK & 1) phase_norm(a, l); }
        else if (k == 1) { if (KMASK & 2) {
            pg8::Gemm g{(const bf16_t*)(ws + OFF_H), (const bf16_t*)(ws + OFF_WIN + (size_t)l * SZ_WIN), MT, NZ, DM, DM, DM, 0};
            pg8::StaticOrder S; S.init(MT, NZ, G, BID);
            pg8::EpiBf16 E{(bf16_t*)(ws + OFF_Z), NZ};
            pg8::gemm_phase<pg8::EpiBf16, pg8::StaticOrder, true, true>(lds, g, S, E);
        } }
        else if (k == 2) { if (KMASK & 4) phase_prep(a, l, lds); }
        else if (k == 3) { if (KMASK & 8) phase_mix(a, l, lds); }
        else if (k == 4) { if (KMASK & 16) phase_post(a, l); }
        else if (k == 5) { if (KMASK & 32) {
            pg8::StaticOrder S; S.init(Mout, DM, G, BID);
            const bf16_t* zg = (const bf16_t*)(ws + OFF_Z) + ZC_MG;
            float* yacc = (float*)(ws + OFF_YACC); bf16_t* y = (bf16_t*)(ws + OFF_H);
            const bf16_t* wb = (const bf16_t*)(ws + OFF_WB + (size_t)l * SZ_WB);
            { pg8::Gemm g{(const bf16_t*)(ws + OFF_POOLO), wb, Mout, DM, 1024, 1024, 1024, 0}; pg8::EpiMerge<0> E{yacc, y, zg};
              pg8::gemm_phase<pg8::EpiMerge<0>, pg8::StaticOrder, true, true>(lds, g, S, E); }
            { pg8::Gemm g{(const bf16_t*)(ws + OFF_DIFFO), wb + (size_t)DM * 1024, Mout, DM, 1024, 1024, 1024, 0}; pg8::EpiMerge<1> E{yacc, y, zg + 2048};
              pg8::gemm_phase<pg8::EpiMerge<1>, pg8::StaticOrder, true, true>(lds, g, S, E); }
            { pg8::Gemm g{(const bf16_t*)(ws + OFF_GLAO), wb + (size_t)2 * DM * 1024, Mout, DM, 1024, 1024, 1024, 0}; pg8::EpiMerge<2> E{yacc, y, zg + 4096};
              pg8::gemm_phase<pg8::EpiMerge<2>, pg8::StaticOrder, true, true>(lds, g, S, E); }
        } }
        else if (KMASK & 64) {
            pg8::Gemm g{(const bf16_t*)(ws + OFF_H), (const bf16_t*)(ws + OFF_WOUT + (size_t)l * SZ_WOUT), Mout, DM, DM, DM, DM, 0};
            pg8::StaticOrder S; S.init(Mout, DM, G, BID);
            pg8::EpiOut E{l == 0 ? inp(I_X) : (const float*)(ws + OFF_X1), l == 0 ? inp(I_CTX) : (const float*)(ws + OFF_X1) + (size_t)ML * DM,
                          l == 0 ? (float*)(ws + OFF_X1) : arg_out(), (const float*)(ws + OFF_MOD) + (size_t)l * 5 * 6144};
            pg8::gemm_phase<pg8::EpiOut, pg8::StaticOrder, true, true>(lds, g, S, E);
        }
    }
}

extern "C" void kernel_launch(void* const* d_in, const int* in_sizes, int n_in, void* d_out, int out_size, void* d_ws, size_t ws_size, hipStream_t stream) {
    static int grid = 0;
    if (grid == 0) {
        if (n_in != 26 || out_size != ML * DM || ws_size < WS_END) { fprintf(stderr, "kernel_launch: expected 26 inputs, out %d, ws >= %zu; got n_in %d out %d ws %zu\n", ML * DM, (size_t)WS_END, n_in, out_size, ws_size); grid = -1; return; }
        int dev = 0, cus = 0, per_cu = 0;
        if (hipGetDevice(&dev) != hipSuccess || hipDeviceGetAttribute(&cus, hipDeviceAttributeMultiprocessorCount, dev) != hipSuccess) { grid = -1; return; }
        if (hipFuncSetAttribute((const void*)hybrid_fwd, hipFuncAttributeMaxDynamicSharedMemorySize, LDS_BYTES) != hipSuccess) { fprintf(stderr, "kernel_launch: hipFuncSetAttribute failed\n"); grid = -1; return; }
        if (hipOccupancyMaxActiveBlocksPerMultiprocessor(&per_cu, (const void*)hybrid_fwd, 512, LDS_BYTES) != hipSuccess || per_cu < 1) { fprintf(stderr, "kernel_launch: occupancy query says %d blocks per CU\n", per_cu); (void)hipGetLastError(); grid = -1; return; }
        grid = cus;
    }
    if (grid < 0) return;
    if (hipMemsetAsync((char*)d_ws + OFF_BAR, 0, BAR_BYTES, stream) != hipSuccess) { fprintf(stderr, "kernel_launch: memset of the barrier words failed\n"); return; }
    Args a{};
    for (int i = 0; i < 26; ++i) a.in[i] = (const float*)d_in[i];
    a.out = (float*)d_out; a.ws = (unsigned char*)d_ws;
    const int nl = MK_N_LAUNCHES;
    for (int li = 0; li < nl; ++li) {
        a.ph_lo = (nl == 1) ? 0 : li; a.ph_hi = (nl == 1) ? NPH : li + 1;
        void* args[] = {&a};
        const hipError_t e = hipLaunchCooperativeKernel((const void*)hybrid_fwd, dim3(grid), dim3(512), args, LDS_BYTES, stream);
        if (e != hipSuccess) { fprintf(stderr, "kernel_launch: cooperative launch %d failed: %s (grid %d)\n", li, hipGetErrorString(e), grid); break; }
    }
}
```

```cpp
#include <hip/hip_runtime.h>
#include <hip/hip_cooperative_groups.h>
#include <cstdio>
#include <cstdint>
namespace cg = cooperative_groups;

#ifndef MK_N_LAUNCHES
#define MK_N_LAUNCHES 1
#endif

#define LAS __attribute__((address_space(3)))
typedef unsigned short bf16_t;
typedef short bf16x8 __attribute__((ext_vector_type(8)));
typedef float f32x4 __attribute__((ext_vector_type(4)));
typedef float f32x16 __attribute__((ext_vector_type(16)));
typedef unsigned u32x4 __attribute__((ext_vector_type(4)));
typedef unsigned u32x2 __attribute__((ext_vector_type(2)));

constexpr int DM = 2048, NB = 4, SEQ = 2048, LC = 256, ML = NB * SEQ, MC = NB * LC, MT = ML + MC;
constexpr int DIN = 15392, NZ = 15616;
constexpr int ZC_PU = 0, ZC_PG = 1024, ZC_DQ = 2048, ZC_DK = 3072, ZC_DV = 4096, ZC_DG = 5120, ZC_GQ = 6144, ZC_GK = 6656, ZC_GV = 7168, ZC_GG = 8192, ZC_LR = 9216, ZC_MG = 9472;
constexpr int LK = LC + SEQ;
constexpr float EPS = 1e-6f, LOG2E = 1.4426950408889634f;
constexpr int NPH = 15;

constexpr size_t SZ_WIN = (size_t)NZ * DM * 2, SZ_WB = (size_t)3 * DM * 1024 * 2, SZ_WOUT = (size_t)DM * DM * 2, SZ_POOLT = (size_t)4 * 256 * 256 * 2;
constexpr size_t OFF_WIN = 0;
constexpr size_t OFF_WB = OFF_WIN + 2 * SZ_WIN;
constexpr size_t OFF_WOUT = OFF_WB + 2 * SZ_WB;
constexpr size_t OFF_POOLT = OFF_WOUT + 2 * SZ_WOUT;
constexpr size_t OFF_MOD = OFF_POOLT + 2 * SZ_POOLT;
constexpr size_t OFF_SCAL = OFF_MOD + (size_t)2 * 5 * 6144 * 4;
constexpr size_t OFF_H = OFF_SCAL + 256;
constexpr size_t OFF_Z = OFF_H + (size_t)MT * DM * 2;
constexpr size_t OFF_QN = OFF_Z + (size_t)MT * NZ * 2;
constexpr size_t OFF_QNC = OFF_QN + (size_t)ML * 1024 * 2;
constexpr size_t OFF_KN = OFF_QNC + (size_t)MC * 1024 * 2;
constexpr size_t OFF_VT = OFF_KN + (size_t)MT * 1024 * 2;
constexpr size_t SZ_G = (size_t)MT * 512 * 2;
constexpr size_t OFF_GQ = OFF_VT + (size_t)MT * 1024 * 2;
constexpr size_t OFF_GK = OFF_GQ + 2 * SZ_G;
constexpr size_t OFF_GH = OFF_GK + 2 * SZ_G;
constexpr size_t OFF_DEC = OFF_GH + 2 * SZ_G;
constexpr size_t OFF_OF = OFF_DEC + (size_t)2 * 144 * 512 * 4;
constexpr size_t OFF_DPOOL = OFF_OF + 2 * (size_t)MT * 1024 * 2;
constexpr size_t OFF_POOLO = OFF_DPOOL + (size_t)MT * 1024 * 2;
constexpr size_t OFF_DIFFO = OFF_POOLO + (size_t)MT * 1024 * 2;
constexpr size_t OFF_GLAO = OFF_DIFFO + (size_t)MT * 1024 * 2;
constexpr size_t OFF_YACC = OFF_GLAO + (size_t)MT * 1024 * 2;
constexpr size_t OFF_X1 = OFF_YACC + (size_t)MT * DM * 4;
constexpr size_t OFF_PGATE = OFF_X1 + (size_t)MT * DM * 4;
constexpr size_t OFF_BAR = OFF_PGATE + (size_t)MT * 1024 * 2;
constexpr size_t BAR_BYTES = 16384;
constexpr size_t OFF_GVT = OFF_BAR + BAR_BYTES;
constexpr size_t WS_END = OFF_GVT + (size_t)MT * 1024 * 2;

constexpr int LDS_BYTES = 135168;

#define BID opaque_s((int)blockIdx.x)
__device__ __forceinline__ unsigned char* opaque_ptr(unsigned char* p) { asm volatile("" : "+s"(p)); return p; }
__device__ __forceinline__ int opaque_s(int v) { asm volatile("" : "+s"(v)); return v; }
__device__ __forceinline__ int opaque_tid() { int t = threadIdx.x; asm volatile("" : "+v"(t)); return t; }
typedef float f32x2_t __attribute__((ext_vector_type(2))); typedef __bf16 bf16x2_t __attribute__((ext_vector_type(2)));
__device__ __forceinline__ unsigned cvt_pk_bf16(float lo, float hi) { f32x2_t v = {lo, hi}; bf16x2_t b = __builtin_convertvector(v, bf16x2_t); return __builtin_bit_cast(unsigned, b); }
__device__ __forceinline__ bf16_t f2bf(float f) { return (bf16_t)(cvt_pk_bf16(f, 0.f) & 0xffffu); }
__device__ __forceinline__ float bf2f(bf16_t v) { return __builtin_bit_cast(float, (unsigned)v << 16); }
__device__ __forceinline__ float bflo(unsigned u) { return __builtin_bit_cast(float, u << 16); }
__device__ __forceinline__ float bfhi(unsigned u) { return __builtin_bit_cast(float, u & 0xffff0000u); }
__device__ __forceinline__ float silu_f(float x) { return x / (1.f + __expf(-x)); }
__device__ __forceinline__ float sigmoid_f(float x) { return 1.f / (1.f + __expf(-x)); }
__device__ __forceinline__ float logsig_f(float a) { return fminf(a, 0.f) - log1pf(__expf(-fabsf(a))); }
__device__ __forceinline__ float wave_sum(float v) {
#pragma unroll
    for (int o = 1; o < 64; o <<= 1) v += __shfl_xor(v, o);
    return v;
}
__device__ __forceinline__ float wave_max(float v) {
#pragma unroll
    for (int o = 1; o < 64; o <<= 1) v = fmaxf(v, __shfl_xor(v, o));
    return v;
}
__device__ __forceinline__ void unpack8(u32x4 w, float* f) { f[0] = bflo(w.x); f[1] = bfhi(w.x); f[2] = bflo(w.y); f[3] = bfhi(w.y); f[4] = bflo(w.z); f[5] = bfhi(w.z); f[6] = bflo(w.w); f[7] = bfhi(w.w); }

namespace pg8 {
constexpr int BM = 256, BK = 64, HALF = 128, HTB = HALF * BK * 2, STAGE_BYTES = 8 * HTB, NXCD = 8, WGM = 8;
__host__ __device__ __forceinline__ int lds_byte(int r, int c) { const int st = (r >> 4) * 2 + (c >> 5), rr = r & 15, cc = c & 31, ob = rr * 64 + cc * 2; return st * 1024 + (ob ^ (((ob >> 9) & 1) << 5)); }
__host__ __device__ __forceinline__ void stage_rc(int b, int& R, int& C) { const int st = b / 1024, sb = b % 1024, swz = sb ^ (((sb >> 9) & 1) << 5); R = (st >> 1) * 16 + swz / 64; C = (st & 1) * 32 + (swz % 64) / 2; }
__host__ __device__ __forceinline__ int perm32(int rho) { const int n = rho >> 4, i = rho & 15; return 8 * (i >> 2) + 4 * n + (i & 3); }

struct Unit { int pm, pn; };
struct Gemm { const bf16_t* A; const bf16_t* Bt; int M, N, K; int lda, ldb; int a_pn_off; };

struct StaticOrder {
    int nM, nN, nwg, G, c;
    __host__ __device__ void init(int M, int N, int G_, int c_) { nM = M / BM; nN = N / BM; nwg = nM * nN; G = G_; c = c_; }
    __host__ __device__ bool next(int i, Unit& u) const {
        const long L = (long)i * G + c; if (L >= nwg) return false;
        int wgid = (int)L; { const int q = nwg / NXCD, r = nwg % NXCD, xcd = wgid % NXCD, off = wgid / NXCD; wgid = (xcd < r ? xcd * (q + 1) : r * (q + 1) + (xcd - r) * q) + off; }
        const int nig = WGM * nN, gid = wgid / nig, fm = gid * WGM, gsz = (nM - fm) < WGM ? (nM - fm) : WGM;
        u.pm = fm + ((wgid % nig) % gsz); u.pn = (wgid % nig) / gsz; return true;
    }
    __device__ __forceinline__ void a_ready(const Unit&) const {}
    __device__ __forceinline__ void done(const Unit&) const {}
};

struct EpiBf16 {
    static constexpr bool PERM = true, AFTER_DRAIN = false;
    bf16_t* O; int ldc;
    __device__ __forceinline__ void operator()(const f32x4 (&acc)[2][2][4][2], const Unit& u, int wr, int wc, int fr, int fq) const {
        const int row0 = u.pm * BM + wr * 64 + fr, col0 = u.pn * BM + wc * 32 + 8 * fq;
#pragma unroll
        for (int ai = 0; ai < 2; ++ai)
#pragma unroll
            for (int m = 0; m < 4; ++m) { bf16_t* rowp = O + (size_t)(row0 + ai * HALF + m * 16) * ldc + col0;
#pragma unroll
                for (int bj = 0; bj < 2; ++bj) { const f32x4 v0 = acc[ai][bj][m][0], v1 = acc[ai][bj][m][1];
                    u32x4 w; w.x = cvt_pk_bf16(v0[0], v0[1]); w.y = cvt_pk_bf16(v0[2], v0[3]); w.z = cvt_pk_bf16(v1[0], v1[1]); w.w = cvt_pk_bf16(v1[2], v1[3]);
                    *(u32x4*)(rowp + bj * HALF) = w; } }
    }
};

template <class Epi, class Sched, bool ALIGN_EPI = false, bool SP2 = false>
__device__ __forceinline__ void gemm_phase(LAS unsigned char* lds, const Gemm g, const Sched& S, const Epi& E) {
    const int tid = opaque_tid(), wid = __builtin_amdgcn_readfirstlane(tid >> 6), lane = tid & 63, wr = wid >> 2, wc = wid & 3, fr = lane & 15, fq = lane >> 4;
    const int K = opaque_s(g.K), nt = K / BK;
    unsigned voffA[2], voffB[2];
#pragma unroll
    for (int i = 0; i < 2; ++i) { int R, C; stage_rc(tid * 16 + i * 8192, R, C); const int Rb = Epi::PERM ? ((R & ~31) + perm32(R & 31)) : R;
        voffA[i] = (unsigned)(R * g.lda + C) * 2u; voffB[i] = (unsigned)(Rb * g.ldb + C) * 2u; }
    const size_t kstep = (size_t)(BK * 2);
    const size_t hstepA = (size_t)HALF * g.lda * 2, hstepB = (size_t)HALF * g.ldb * 2;
    const size_t tstepA = 2 * hstepA, tstepB = 2 * hstepB;
    const size_t pnA = (size_t)g.a_pn_off * 2;
    const unsigned ldsw = (unsigned)wid * 1024u;
    const int aoff = lds_byte(wr * 64 + fr, fq * 8), boff = lds_byte(wc * 32 + fr, fq * 8);
#define PG8_SA(b, h) (((b) * 2 + (h)) * HTB)
#define PG8_SB(b, h) ((4 + (b) * 2 + (h)) * HTB)
#define PG8_STAGE(bufoff, gbase, voff) do { _Pragma("unroll") for (int _i = 0; _i < 2; ++_i) \
        __builtin_amdgcn_global_load_lds((const unsigned*)((const char*)(gbase) + (voff)[_i]), (LAS unsigned*)(lds + (bufoff) + ldsw + _i * 8192), 16, 0, 0); } while (0)
#define PG8_LDA(dst, b, h) do { _Pragma("unroll") for (int m = 0; m < 4; ++m) _Pragma("unroll") for (int k = 0; k < 2; ++k) dst[m][k] = *(const LAS bf16x8*)(lds + PG8_SA(b, h) + aoff + m * 2048 + k * 1024); } while (0)
#define PG8_LDB(dst, b, h) do { _Pragma("unroll") for (int n = 0; n < 2; ++n) _Pragma("unroll") for (int k = 0; k < 2; ++k) dst[n][k] = *(const LAS bf16x8*)(lds + PG8_SB(b, h) + boff + n * 2048 + k * 1024); } while (0)
#define PG8_MMA(ai, bj, At, Bt) do { __builtin_amdgcn_s_setprio(1); _Pragma("unroll") for (int m = 0; m < 4; ++m) _Pragma("unroll") for (int n = 0; n < 2; ++n) _Pragma("unroll") for (int k = 0; k < 2; ++k) \
        acc[ai][bj][m][n] = __builtin_amdgcn_mfma_f32_16x16x32_bf16(Bt[n][k], At[m][k], acc[ai][bj][m][n], 0, 0, 0); __builtin_amdgcn_s_setprio(0); } while (0)
#define PG8_WAIT_V(n) asm volatile("s_waitcnt vmcnt(" #n ")" ::: "memory")
#define PG8_WAIT_L(n) asm volatile("s_waitcnt lgkmcnt(" #n ")" ::: "memory")
#define PG8_BAR __builtin_amdgcn_s_barrier()
#define PG8_SCHED __builtin_amdgcn_sched_barrier(0)
    Unit cur, nxt; int ui = 0;
    if (!S.next(0, cur)) return;
    f32x4 acc[2][2][4][2];
#pragma unroll
    for (int a = 0; a < 2; ++a)
#pragma unroll
        for (int b = 0; b < 2; ++b)
#pragma unroll
            for (int m = 0; m < 4; ++m)
#pragma unroll
                for (int n = 0; n < 2; ++n) acc[a][b][m][n] = (f32x4){0.f, 0.f, 0.f, 0.f};
    bf16x8 At[4][2], B0[2][2], B1[2][2];
    const char* cA = (const char*)g.A + (size_t)cur.pm * tstepA + (size_t)cur.pn * pnA; const char* cB = (const char*)g.Bt + (size_t)cur.pn * tstepB;
    S.a_ready(cur);
    if constexpr (SP2) {
        PG8_STAGE(PG8_SB(0, 0), cB, voffB); PG8_STAGE(PG8_SB(0, 1), cB + hstepB, voffB); PG8_STAGE(PG8_SA(0, 0), cA, voffA); PG8_STAGE(PG8_SA(0, 1), cA + hstepA, voffA);
        if (wr == 1) PG8_BAR;
        PG8_WAIT_V(2); PG8_BAR;
        PG8_STAGE(PG8_SB(1, 0), cB + kstep, voffB); PG8_STAGE(PG8_SA(1, 0), cA + kstep, voffA); PG8_STAGE(PG8_SB(1, 1), cB + hstepB + kstep, voffB);
        PG8_WAIT_V(6); PG8_BAR;
    } else {
        PG8_STAGE(PG8_SB(0, 0), cB, voffB); PG8_STAGE(PG8_SA(0, 0), cA, voffA); PG8_STAGE(PG8_SB(0, 1), cB + hstepB, voffB); PG8_STAGE(PG8_SA(0, 1), cA + hstepA, voffA);
        if (wr == 1) PG8_BAR;
        PG8_WAIT_V(4); PG8_BAR;
        PG8_STAGE(PG8_SB(1, 0), cB + kstep, voffB); PG8_STAGE(PG8_SA(1, 0), cA + kstep, voffA); PG8_STAGE(PG8_SB(1, 1), cB + hstepB + kstep, voffB);
        PG8_WAIT_V(6); PG8_BAR;
    }
    for (;;) {
        const bool has_next = S.next(ui + 1, nxt);
        const char* nA = has_next ? (const char*)g.A + (size_t)nxt.pm * tstepA + (size_t)nxt.pn * pnA : cA; const char* nB = has_next ? (const char*)g.Bt + (size_t)nxt.pn * tstepB : cB;
        for (int t = 0; t < nt; t += 2) {
            const bool last = (t == nt - 2);
            const char* a1 = cA + (size_t)(t + 1) * kstep;
            const char* a2 = last ? nA : cA + (size_t)(t + 2) * kstep; const char* b2 = last ? nB : cB + (size_t)(t + 2) * kstep;
            const char* a3 = a2 + kstep; const char* b3 = b2 + kstep;
            if (last && has_next) S.a_ready(nxt);
            if constexpr (SP2) {
            PG8_LDB(B0, 0, 0); PG8_LDB(B1, 0, 1); PG8_SCHED; PG8_LDA(At, 0, 0); PG8_STAGE(PG8_SA(1, 1), a1 + hstepA, voffA);
            PG8_WAIT_V(8); PG8_WAIT_L(0); PG8_BAR; PG8_MMA(0, 0, At, B0); PG8_MMA(0, 1, At, B1); PG8_BAR; PG8_SCHED;
            PG8_LDA(At, 0, 1); PG8_STAGE(PG8_SB(0, 0), b2, voffB); PG8_STAGE(PG8_SB(0, 1), b2 + hstepB, voffB); PG8_STAGE(PG8_SA(0, 0), a2, voffA);
            PG8_WAIT_V(8); PG8_WAIT_L(0); PG8_BAR; PG8_MMA(1, 0, At, B0); PG8_MMA(1, 1, At, B1); PG8_BAR; PG8_SCHED;
            PG8_LDB(B0, 1, 0); PG8_LDB(B1, 1, 1); PG8_SCHED; PG8_LDA(At, 1, 0); PG8_STAGE(PG8_SA(0, 1), a2 + hstepA, voffA);
            PG8_WAIT_V(8); PG8_WAIT_L(0); PG8_BAR; PG8_MMA(0, 0, At, B0); PG8_MMA(0, 1, At, B1); PG8_BAR; PG8_SCHED;
            PG8_LDA(At, 1, 1); PG8_STAGE(PG8_SB(1, 0), b3, voffB); PG8_STAGE(PG8_SB(1, 1), b3 + hstepB, voffB); PG8_STAGE(PG8_SA(1, 0), a3, voffA);
            PG8_WAIT_V(8); PG8_WAIT_L(0); PG8_BAR; PG8_MMA(1, 0, At, B0); PG8_MMA(1, 1, At, B1); PG8_BAR; PG8_SCHED;
            } else {
            PG8_LDB(B0, 0, 0); PG8_SCHED; PG8_LDA(At, 0, 0); PG8_STAGE(PG8_SA(1, 1), a1 + hstepA, voffA);
            PG8_WAIT_L(8); PG8_BAR; PG8_WAIT_L(0); PG8_MMA(0, 0, At, B0); PG8_BAR; PG8_SCHED;
            PG8_LDB(B1, 0, 1); PG8_STAGE(PG8_SB(0, 0), b2, voffB);
            PG8_BAR; PG8_WAIT_L(0); PG8_MMA(0, 1, At, B1); PG8_BAR;
            PG8_LDA(At, 0, 1); PG8_STAGE(PG8_SA(0, 0), a2, voffA);
            PG8_BAR; PG8_WAIT_L(0); PG8_MMA(1, 0, At, B0); PG8_BAR; PG8_SCHED;
            PG8_STAGE(PG8_SB(0, 1), b2 + hstepB, voffB);
            PG8_WAIT_V(6); PG8_BAR; PG8_MMA(1, 1, At, B1); PG8_BAR;
            PG8_LDB(B0, 1, 0); PG8_SCHED; PG8_LDA(At, 1, 0); PG8_STAGE(PG8_SA(0, 1), a2 + hstepA, voffA);
            PG8_WAIT_L(8); PG8_BAR; PG8_WAIT_L(0); PG8_MMA(0, 0, At, B0); PG8_BAR; PG8_SCHED;
            PG8_LDB(B1, 1, 1); PG8_STAGE(PG8_SB(1, 0), b3, voffB);
            PG8_BAR; PG8_WAIT_L(0); PG8_MMA(0, 1, At, B1); PG8_BAR;
            PG8_LDA(At, 1, 1); PG8_STAGE(PG8_SA(1, 0), a3, voffA);
            PG8_BAR; PG8_WAIT_L(0); PG8_MMA(1, 0, At, B0); PG8_BAR; PG8_SCHED;
            PG8_STAGE(PG8_SB(1, 1), b3 + hstepB, voffB);
            PG8_WAIT_V(6); PG8_BAR; PG8_MMA(1, 1, At, B1); PG8_BAR;
            }
        }
        if constexpr (ALIGN_EPI) { if (wr == 0) PG8_BAR; }
        E(acc, cur, wr, wc, fr, fq); S.done(cur);
        if (!has_next) break;
#pragma unroll
        for (int a = 0; a < 2; ++a)
#pragma unroll
            for (int b = 0; b < 2; ++b)
#pragma unroll
                for (int m = 0; m < 4; ++m)
#pragma unroll
                    for (int n = 0; n < 2; ++n) acc[a][b][m][n] = (f32x4){0.f, 0.f, 0.f, 0.f};
        cur = nxt; cA = nA; cB = nB; ++ui;
        if constexpr (ALIGN_EPI) { if (wr == 1) PG8_BAR; }
    }
    PG8_WAIT_V(0);
    if constexpr (!ALIGN_EPI) { if (wr == 0) PG8_BAR; }
    PG8_BAR;
#undef PG8_SA
#undef PG8_SB
#undef PG8_STAGE
#undef PG8_LDA
#undef PG8_LDB
#undef PG8_MMA
#undef PG8_WAIT_V
#undef PG8_WAIT_L
#undef PG8_BAR
#undef PG8_SCHED
}

struct EpiPool {
    static constexpr bool PERM = true, AFTER_DRAIN = false;
    bf16_t* O; const bf16_t* pgate;
    __device__ __forceinline__ void operator()(const f32x4 (&acc)[2][2][4][2], const Unit& u, int wr, int wc, int fr, int fq) const {
        const int row0 = u.pm * BM + wr * 64 + fr, col0 = u.pn * BM + wc * 32 + 8 * fq;
#pragma unroll
        for (int ai = 0; ai < 2; ++ai)
#pragma unroll
            for (int m = 0; m < 4; ++m)
#pragma unroll
                for (int bj = 0; bj < 2; ++bj) {
                    const int row = row0 + ai * HALF + m * 16, col = col0 + bj * HALF;
                    const u32x4 gz = *(const u32x4*)(pgate + (size_t)row * 1024 + col);
                    const f32x4 v0 = acc[ai][bj][m][0], v1 = acc[ai][bj][m][1];
                    u32x4 w;
                    w.x = cvt_pk_bf16(v0[0] * bflo(gz.x), v0[1] * bfhi(gz.x));
                    w.y = cvt_pk_bf16(v0[2] * bflo(gz.y), v0[3] * bfhi(gz.y));
                    w.z = cvt_pk_bf16(v1[0] * bflo(gz.z), v1[1] * bfhi(gz.z));
                    w.w = cvt_pk_bf16(v1[2] * bflo(gz.w), v1[3] * bfhi(gz.w));
                    *(u32x4*)(O + (size_t)row * 1024 + col) = w;
                    __builtin_amdgcn_sched_barrier(0);
                }
    }
};
template <int PASS> struct EpiMerge {
    static constexpr bool PERM = true, AFTER_DRAIN = false;
    float* yacc; bf16_t* y; const bf16_t* zg;
    __device__ __forceinline__ void operator()(const f32x4 (&acc)[2][2][4][2], const Unit& u, int wr, int wc, int fr, int fq) const {
        const int row0 = u.pm * BM + wr * 64 + fr, col0 = u.pn * BM + wc * 32 + 8 * fq;
#pragma unroll
        for (int ai = 0; ai < 2; ++ai)
#pragma unroll
            for (int m = 0; m < 4; ++m)
#pragma unroll
                for (int bj = 0; bj < 2; ++bj) {
                    const int row = row0 + ai * HALF + m * 16, col = col0 + bj * HALF;
                    float gz[8]; unpack8(*(const u32x4*)(zg + (size_t)row * NZ + col), gz);
                    const f32x4 v0 = acc[ai][bj][m][0], v1 = acc[ai][bj][m][1];
                    f32x4 r0, r1;
#pragma unroll
                    for (int e = 0; e < 4; ++e) { r0[e] = v0[e] * sigmoid_f(gz[e]); r1[e] = v1[e] * sigmoid_f(gz[4 + e]); }
                    float* yp = yacc + (size_t)row * DM + col;
                    if (PASS >= 1) { r0 += *(const f32x4*)yp; r1 += *(const f32x4*)(yp + 4); }
                    if (PASS <= 1) { *(f32x4*)yp = r0; *(f32x4*)(yp + 4) = r1; }
                    else { u32x4 w; w.x = cvt_pk_bf16(r0[0], r0[1]); w.y = cvt_pk_bf16(r0[2], r0[3]); w.z = cvt_pk_bf16(r1[0], r1[1]); w.w = cvt_pk_bf16(r1[2], r1[3]);
                        *(u32x4*)(y + (size_t)row * DM + col) = w; }
                    __builtin_amdgcn_sched_barrier(0);
                }
    }
};
struct EpiOut {
    static constexpr bool PERM = true, AFTER_DRAIN = false;
    const float* xlat; const float* xctx; float* xnew; const float* mod;
    __device__ __forceinline__ void operator()(const f32x4 (&acc)[2][2][4][2], const Unit& u, int wr, int wc, int fr, int fq) const {
        const int row0 = u.pm * BM + wr * 64 + fr, col0 = u.pn * BM + wc * 32 + 8 * fq;
        const int tile_row = u.pm * BM; const int mr = tile_row < ML ? tile_row / SEQ : 4;
        const float* xo = tile_row < ML ? xlat : (xctx - (size_t)ML * DM);
        const float* gm = mod + mr * 6144 + 4096;
#pragma unroll
        for (int ai = 0; ai < 2; ++ai)
#pragma unroll
            for (int m = 0; m < 4; ++m)
#pragma unroll
                for (int bj = 0; bj < 2; ++bj) {
                    const int row = row0 + ai * HALF + m * 16, col = col0 + bj * HALF;
                    const f32x4 g0 = *(const f32x4*)(gm + col), g1 = *(const f32x4*)(gm + col + 4);
                    const float* xp = xo + (size_t)row * DM + col;
                    const f32x4 r0 = *(const f32x4*)xp + g0 * acc[ai][bj][m][0], r1 = *(const f32x4*)(xp + 4) + g1 * acc[ai][bj][m][1];
                    float* op = xnew + (size_t)row * DM + col;
                    *(f32x4*)op = r0; *(f32x4*)(op + 4) = r1;
                    __builtin_amdgcn_sched_barrier(0);
                }
    }
};
}

struct Args { const float* in[26]; float* out; unsigned char* ws; int ph_lo, ph_hi; };
enum { I_X = 0, I_C, I_CTX, I_CCTX, I_NORMG, I_WADA, I_BADA, I_WIN, I_POOLW, I_POOLS, I_QNORM, I_KNORM, I_LQ1, I_LK1, I_LQ2, I_LK2, I_SUBLN, I_WGF, I_BGF, I_WGB, I_BGB, I_GLAN, I_WBP, I_WBD, I_WBG, I_WOUT };

__device__ __forceinline__ const float* inp(int i) { const float* const volatile __attribute__((address_space(4)))* kp = (const float* const volatile __attribute__((address_space(4)))*)__builtin_amdgcn_kernarg_segment_ptr(); return kp[i]; }
__device__ __forceinline__ float* arg_out() { float* const volatile __attribute__((address_space(4)))* kp = (float* const volatile __attribute__((address_space(4)))*)__builtin_amdgcn_kernarg_segment_ptr(); return kp[26]; }
__device__ __forceinline__ void transpose_item(const float* W, int K, int N, bf16_t* WT, int row_off, LAS float* scr, int kb, int nb, int lane) {
    const int k0 = 64 * kb, n0 = 32 * nb;
    float tv[32];
#pragma unroll
    for (int i = 0; i < 32; ++i) { const int kk = 2 * i + (lane >> 5); tv[i] = __builtin_nontemporal_load(W + (size_t)(k0 + kk) * N + n0 + (lane & 31)); }
#pragma unroll
    for (int i = 0; i < 32; ++i) { const int kk = 2 * i + (lane >> 5); scr[kk * 33 + (lane & 31)] = tv[i]; }
    asm volatile("s_waitcnt lgkmcnt(0)" ::: "memory");
    const int c = lane & 7;
#pragma unroll
    for (int j = 0; j < 4; ++j) { const int n = (lane >> 3) + 8 * j; const LAS float* s = scr + (8 * c) * 33 + n;
        u32x4 o; o.x = cvt_pk_bf16(s[0 * 33], s[1 * 33]); o.y = cvt_pk_bf16(s[2 * 33], s[3 * 33]); o.z = cvt_pk_bf16(s[4 * 33], s[5 * 33]); o.w = cvt_pk_bf16(s[6 * 33], s[7 * 33]);
        *(u32x4*)(WT + (size_t)(row_off + n0 + n) * K + k0 + 8 * c) = o; }
    asm volatile("s_waitcnt lgkmcnt(0)" ::: "memory");
}

__device__ __forceinline__ void phase_p0(const Args& a, LAS unsigned char* lds) {
    const int tid = opaque_tid(), lane = tid & 63, wave = __builtin_amdgcn_readfirstlane(tid >> 6), G = opaque_s(gridDim.x);
    unsigned char* ws = opaque_ptr(a.ws);
    {
        LAS float* sc = (LAS float*)(lds + 69632);
        LAS float* part = (LAS float*)(lds + 69632 + 40960);
        if (BID < 192) {
            for (int i = tid; i < 5 * 2048; i += 512) { const int r = i >> 11, k = i & 2047; const float v = r < 4 ? inp(I_C)[r * 2048 + k] : inp(I_CCTX)[k]; sc[i] = silu_f(v); }
            __syncthreads();
        }
        for (int it = BID; it < 192; it += G) {
            const int l = it / 96, cgp = it % 96, col = cgp * 64 + lane;
            const float* W = inp(I_WADA) + (size_t)l * 2048 * 6144 + col;
            float acc[5] = {0.f, 0.f, 0.f, 0.f, 0.f};
#pragma unroll 32
            for (int kk = 0; kk < 256; ++kk) { const int k = wave * 256 + kk; const float wv = __builtin_nontemporal_load(W + (size_t)k * 6144);
#pragma unroll
                for (int r = 0; r < 5; ++r) acc[r] += sc[r * 2048 + k] * wv; }
#pragma unroll
            for (int r = 0; r < 5; ++r) part[(wave * 5 + r) * 64 + lane] = acc[r];
            __syncthreads();
            if (tid < 320) { const int r = tid >> 6, ln = tid & 63; float s = inp(I_BADA)[l * 6144 + cgp * 64 + ln];
#pragma unroll
                for (int w = 0; w < 8; ++w) s += part[(w * 5 + r) * 64 + ln];
                ((float*)(ws + OFF_MOD))[(l * 5 + r) * 6144 + cgp * 64 + ln] = s; }
            __syncthreads();
        }
    }
    if (BID == G - 1 && wave == 0) {
        for (int l = 0; l < 2; ++l) {
            const float s1 = wave_sum(inp(I_LQ1)[l * 64 + lane] * inp(I_LK1)[l * 64 + lane]);
            const float s2 = wave_sum(inp(I_LQ2)[l * 64 + lane] * inp(I_LK2)[l * 64 + lane]);
            const float mq = wave_max(fabsf(inp(I_QNORM)[l * 64 + lane])), mk = wave_max(fabsf(inp(I_KNORM)[l * 64 + lane]));
            const float lam_init = 0.8f - 0.6f * expf(-0.3f * (float)l);
            if (lane == 0) { float* sp = (float*)(ws + OFF_SCAL) + l * 4; sp[0] = expf(s1) - expf(s2) + lam_init; sp[1] = 8.f * LOG2E * mq * mk; sp[2] = lam_init; sp[3] = 0.f; }
        }
    }
    {
        const int nper = 224 * 2048 * 2 / 16;
        for (int i = BID * 512 + tid; i < 2 * nper; i += G * 512) { const int l = i / nper, j = i % nper;
            *(u32x4*)(ws + OFF_WIN + (size_t)l * SZ_WIN + (size_t)9248 * DM * 2 + (size_t)j * 16) = (u32x4){0u, 0u, 0u, 0u}; }
    }
    {
        LAS float* scr = (LAS float*)(lds + wave * 8704);
        const int gw = BID * 8 + wave, NGW = G * 8;
        constexpr int I_IN = 32 * 481, I_B = 16 * 64, I_O = 32 * 64, I_P = 4 * 32, PER_L = I_IN + 3 * I_B + I_O + I_P;
        for (int it = gw; it < 2 * PER_L; it += NGW) {
            const int l = it / PER_L; int r = it % PER_L;
            if (r < I_IN) { const int kb = r / 481, nb = r % 481;
                transpose_item(inp(I_WIN) + (size_t)l * DM * DIN, DM, DIN, (bf16_t*)(ws + OFF_WIN + (size_t)l * SZ_WIN), nb >= 289 ? 224 : 0, scr, kb, nb, lane); continue; }
            r -= I_IN;
            if (r < 3 * I_B) { const int br = r / I_B, rr = r % I_B; const float* W = (br == 0 ? inp(I_WBP) : br == 1 ? inp(I_WBD) : inp(I_WBG)) + (size_t)l * 1024 * DM;
                transpose_item(W, 1024, DM, (bf16_t*)(ws + OFF_WB + (size_t)l * SZ_WB + (size_t)br * DM * 1024 * 2), 0, scr, rr / 64, rr % 64, lane); continue; }
            r -= 3 * I_B;
            if (r < I_O) { transpose_item(inp(I_WOUT) + (size_t)l * DM * DM, DM, DM, (bf16_t*)(ws + OFF_WOUT + (size_t)l * SZ_WOUT), 0, scr, r / 64, r % 64, lane); continue; }
            r -= I_O;
            { const int g = r / 32, rr = r % 32;
              transpose_item(inp(I_POOLW) + (size_t)(l * 4 + g) * 65536, 256, 256, (bf16_t*)(ws + OFF_POOLT + (size_t)l * SZ_POOLT + (size_t)g * 65536 * 2), 0, scr, rr / 8, rr % 8, lane); }
        }
    }
}

__device__ __forceinline__ void phase_norm(const Args& a, int l) {
    const int tid = opaque_tid(), lane = tid & 63, wave = tid >> 6, G = opaque_s(gridDim.x);
    const int gw = BID * 8 + wave, NGW = G * 8;
    const float* mod = (const float*)(opaque_ptr(a.ws) + OFF_MOD) + (size_t)l * 5 * 6144;
    const float* x1 = (const float*)(opaque_ptr(a.ws) + OFF_X1);
    bf16_t* h = (bf16_t*)(opaque_ptr(a.ws) + OFF_H);
    const float* ng = inp(I_NORMG) + l * DM;
    for (int row = gw; row < MT; row += NGW) {
        const float* src = (l == 0) ? (row < ML ? inp(I_X) + (size_t)row * DM : inp(I_CTX) + (size_t)(row - ML) * DM) : x1 + (size_t)row * DM;
        const int mr = row < ML ? row / SEQ : 4;
        const float* md = mod + mr * 6144;
        f32x4 v[8]; float ss = 0.f;
#pragma unroll
        for (int j = 0; j < 8; ++j) { v[j] = *(const f32x4*)(src + 4 * lane + 256 * j); ss += (v[j][0] * v[j][0] + v[j][1] * v[j][1]) + (v[j][2] * v[j][2] + v[j][3] * v[j][3]); }
        ss = wave_sum(ss);
        const float rstd = rsqrtf(ss * (1.f / DM) + EPS);
#pragma unroll
        for (int j = 0; j < 8; ++j) { const int idx = 4 * lane + 256 * j;
            const f32x4 gg = *(const f32x4*)(ng + idx), sc = *(const f32x4*)(md + 2048 + idx), sh = *(const f32x4*)(md + idx);
            f32x4 o;
#pragma unroll
            for (int e = 0; e < 4; ++e) o[e] = v[j][e] * rstd * gg[e] * (1.f + sc[e]) + sh[e];
            u32x2 w; w.x = cvt_pk_bf16(o[0], o[1]); w.y = cvt_pk_bf16(o[2], o[3]);
            *(u32x2*)(h + (size_t)row * DM + idx) = w; }
    }
}

__device__ __forceinline__ int vt_pos(int key) { const int k = key & 15; return (key & ~15) | (((k >> 2) & 1) << 3) | (k & 3) | (((k >> 3) & 1) << 2); }

__device__ __forceinline__ void phase_prep(const Args& a, int l, LAS unsigned char* lds) {
    const int tid = opaque_tid(), lane = tid & 63, wave = tid >> 6, G = opaque_s(gridDim.x);
    unsigned char* ws = opaque_ptr(a.ws);
    const bf16_t* z = (const bf16_t*)(ws + OFF_Z);
    const bool need_ctx = (l == 0);
    for (int it = BID; it < 2016; it += G) {
        if (it < 1152) {
            const int c = it >> 3, cgp = it & 7, rb = 64 * c;
            LAS float* lrs = (LAS float*)lds;
            LAS float* segs = (LAS float*)(lds + 8192);
            for (int i = tid; i < 64 * 32; i += 512) { const int r = i >> 5, cc = i & 31; lrs[i] = bf2f(z[(size_t)(rb + r) * NZ + ZC_LR + cc]); }
            __syncthreads();
            const int seg = tid >> 6, chl = tid & 63, ch = cgp * 64 + chl;
            float wf[16], wb[16];
#pragma unroll
            for (int r = 0; r < 16; ++r) { wf[r] = inp(I_WGF)[(size_t)l * 16 * 512 + r * 512 + ch]; wb[r] = inp(I_WGB)[(size_t)l * 16 * 512 + r * 512 + ch]; }
            const float bfv = inp(I_BGF)[l * 512 + ch], bbv = inp(I_BGB)[l * 512 + ch];
            float gf[8], gb[8]; float sf = 0.f, sb = 0.f;
#pragma unroll
            for (int i = 0; i < 8; ++i) { const int t = seg * 8 + i; float af = bfv, ab = bbv;
#pragma unroll
                for (int r4 = 0; r4 < 4; ++r4) { const f32x4 lf = *(const LAS f32x4*)(lrs + t * 32 + 4 * r4), lb = *(const LAS f32x4*)(lrs + t * 32 + 16 + 4 * r4);
#pragma unroll
                    for (int e = 0; e < 4; ++e) { af += lf[e] * wf[4 * r4 + e]; ab += lb[e] * wb[4 * r4 + e]; } }
                gf[i] = logsig_f(af) * (1.f / 16.f); gb[i] = logsig_f(ab) * (1.f / 16.f); sf += gf[i]; sb += gb[i]; }
            segs[seg * 64 + chl] = sf; segs[512 + seg * 64 + chl] = sb;
            __syncthreads();
            float pf = 0.f, pb = 0.f, totf = 0.f, totb = 0.f;
#pragma unroll
            for (int s2 = 0; s2 < 8; ++s2) { const float vf = segs[s2 * 64 + chl], vb = segs[512 + s2 * 64 + chl]; totf += vf; totb += vb; if (s2 < seg) { pf += vf; pb += vb; } }
            bf16_t* gq0 = (bf16_t*)(ws + OFF_GQ), *gq1 = (bf16_t*)(ws + OFF_GQ + SZ_G);
            bf16_t* gk0 = (bf16_t*)(ws + OFF_GK), *gk1 = (bf16_t*)(ws + OFF_GK + SZ_G);
            bf16_t* gh0 = (bf16_t*)(ws + OFF_GH), *gh1 = (bf16_t*)(ws + OFF_GH + SZ_G);
            float h0[8], h1[8];
#pragma unroll
            for (int i = 0; i < 8; ++i) { const int t = seg * 8 + i;
                pf += gf[i]; const float bs = totb - pb; pb += gb[i];
                const size_t row = rb + t;
                const float q = bf2f(z[row * NZ + ZC_GQ + ch]) * 0.08838834764831845f, k = bf2f(z[row * NZ + ZC_GK + ch]);
                const size_t o = row * 512 + ch;
                gq0[o] = f2bf(q * __expf(pf)); gk0[o] = f2bf(k * __expf(-pf)); h0[i] = k * __expf(totf - pf);
                gq1[o] = f2bf(q * __expf(bs)); gk1[o] = f2bf(k * __expf(-bs)); h1[i] = k * __expf(totb - bs); }
            { u32x4 w0, w1;
              w0.x = cvt_pk_bf16(h0[0], h0[1]); w0.y = cvt_pk_bf16(h0[2], h0[3]); w0.z = cvt_pk_bf16(h0[4], h0[5]); w0.w = cvt_pk_bf16(h0[6], h0[7]);
              w1.x = cvt_pk_bf16(h1[0], h1[1]); w1.y = cvt_pk_bf16(h1[2], h1[3]); w1.z = cvt_pk_bf16(h1[4], h1[5]); w1.w = cvt_pk_bf16(h1[6], h1[7]);
              const size_t oh = ((size_t)c * 512 + ch) * 64 + seg * 8;
              *(u32x4*)(gh0 + oh) = w0; *(u32x4*)(gh1 + oh) = w1; }
            if (seg == 0) { float* dec = (float*)(ws + OFF_DEC); dec[(size_t)c * 512 + ch] = __expf(totf); dec[(size_t)(144 + c) * 512 + ch] = __expf(totb); }
            __syncthreads();
        } else if (it < 1440) {
            const int rb = 32 * (it - 1152); if (!need_ctx && rb >= ML) continue;
            const int seq0 = rb < ML ? (rb / SEQ) * SEQ : ML + ((rb - ML) / LC) * LC; const int L = rb < ML ? SEQ : LC;
            bf16_t* dp = (bf16_t*)(ws + OFF_DPOOL); bf16_t* pgt = (bf16_t*)(ws + OFF_PGATE);
            const int ch8 = 8 * (tid & 127), tg = tid >> 7, hw = 1 << (ch8 >> 8);
            const int tl0 = rb - seq0 + 8 * tg;
            float psc[8];
#pragma unroll
            for (int e = 0; e < 8; ++e) psc[e] = inp(I_POOLS)[l * 1024 + ch8 + e];
            const bf16_t* zc = z + (size_t)seq0 * NZ + ZC_PU + ch8;
            float sm[8] = {0.f, 0.f, 0.f, 0.f, 0.f, 0.f, 0.f, 0.f};
            { const int lo = max(tl0 - hw, 0), hi = min(tl0 + hw, L);
              for (int p = lo; p < hi; ++p) { float u[8]; unpack8(*(const u32x4*)(zc + (size_t)p * NZ), u);
#pragma unroll
                  for (int e = 0; e < 8; ++e) sm[e] += u[e]; } }
#pragma unroll
            for (int t = 0; t < 8; ++t) { const int tl = tl0 + t; const int lo = max(tl - hw, 0), hi = min(tl + hw, L);
                const float rc = 1.f / (float)(hi - lo);
                float cur[8], pgv[8], ua[8], ur[8];
                unpack8(*(const u32x4*)(zc + (size_t)tl * NZ), cur); unpack8(*(const u32x4*)(zc + (size_t)tl * NZ + (ZC_PG - ZC_PU)), pgv);
                unpack8(*(const u32x4*)(zc + (size_t)min(tl + hw, L - 1) * NZ), ua); unpack8(*(const u32x4*)(zc + (size_t)max(tl - hw, 0) * NZ), ur);
                const float ma = (tl + hw < L) ? 1.f : 0.f, mr = (tl - hw >= 0) ? 1.f : 0.f;
                u32x4 wd, wg;
                wd.x = cvt_pk_bf16(sm[0] * rc - cur[0], sm[1] * rc - cur[1]); wd.y = cvt_pk_bf16(sm[2] * rc - cur[2], sm[3] * rc - cur[3]);
                wd.z = cvt_pk_bf16(sm[4] * rc - cur[4], sm[5] * rc - cur[5]); wd.w = cvt_pk_bf16(sm[6] * rc - cur[6], sm[7] * rc - cur[7]);
                wg.x = cvt_pk_bf16(psc[0] * silu_f(pgv[0]), psc[1] * silu_f(pgv[1])); wg.y = cvt_pk_bf16(psc[2] * silu_f(pgv[2]), psc[3] * silu_f(pgv[3]));
                wg.z = cvt_pk_bf16(psc[4] * silu_f(pgv[4]), psc[5] * silu_f(pgv[5])); wg.w = cvt_pk_bf16(psc[6] * silu_f(pgv[6]), psc[7] * silu_f(pgv[7]));
                const size_t o = (size_t)(seq0 + tl) * 1024 + ch8;
                *(u32x4*)(dp + o) = wd; *(u32x4*)(pgt + o) = wg;
#pragma unroll
                for (int e = 0; e < 8; ++e) sm[e] += ma * ua[e] - mr * ur[e]; }
        } else {
            const int vi = it - 1440, isg = vi >= 288, vj = isg ? vi - 288 : vi, c = vj >> 1, hv = vj & 1, rb = 64 * c;
            int b, key0; if (rb < ML) { b = rb >> 11; key0 = LC + (rb & 2047); } else { b = (rb - ML) >> 8; key0 = (rb - ML) & 255; }
            bf16_t* vT = (bf16_t*)(ws + OFF_VT); bf16_t* gvT = (bf16_t*)(ws + OFF_GVT);
#pragma unroll
            for (int i = 0; i < 8; ++i) { const int idx = tid + 512 * i, key = idx & 63, c8 = (idx >> 6) * 8;
                const u32x4 w = *(const u32x4*)(z + (size_t)(rb + key) * NZ + (isg ? ZC_GV : ZC_DV) + hv * 512 + c8);
                const unsigned ww[4] = {w.x, w.y, w.z, w.w}; const int pos = isg ? key : vt_pos(key);
#pragma unroll
                for (int e = 0; e < 8; ++e) *(LAS bf16_t*)(lds + (c8 + e) * 144 + pos * 2) = (bf16_t)((e & 1) ? (ww[e >> 1] >> 16) : (ww[e >> 1] & 0xffffu)); }
            __syncthreads();
#pragma unroll
            for (int i = 0; i < 8; ++i) { const int idx = tid + 512 * i, col = idx >> 3, k8 = idx & 7, colg = hv * 512 + col, h = colg >> 7, v = colg & 127;
                bf16_t* dst = isg ? gvT + ((size_t)c * 1024 + colg) * 64 + k8 * 8 : vT + ((size_t)(b * 8 + h) * 128 + v) * LK + key0 + k8 * 8;
                *(u32x4*)dst = *(const LAS u32x4*)(lds + col * 144 + k8 * 16); }
            __syncthreads();
        }
    }
    {
        const int gw = BID * 8 + wave, NGW = G * 8;
        bf16_t* qn = (bf16_t*)(ws + OFF_QN); bf16_t* qnc = (bf16_t*)(ws + OFF_QNC); bf16_t* kn = (bf16_t*)(ws + OFF_KN);
        for (int it = gw; it < MT * 2; it += NGW) {
            const int row = it >> 1, which = it & 1;
            const bool isctx = row >= ML; int b, t; if (!isctx) { b = row >> 11; t = row & 2047; } else { b = (row - ML) >> 8; t = (row - ML) & 255; }
            const bf16_t* zr = z + (size_t)row * NZ;
            {
                if (which == 0 && isctx && !need_ctx) continue;
                float x[16]; const bf16_t* src = zr + (which == 0 ? ZC_DQ : ZC_DK) + 16 * lane;
                unpack8(*(const u32x4*)src, x); unpack8(*(const u32x4*)(src + 8), x + 8);
                float ss = 0.f;
#pragma unroll
                for (int e = 0; e < 16; ++e) ss += x[e] * x[e];
                ss += __shfl_xor(ss, 1); ss += __shfl_xor(ss, 2);
                const float rstd = rsqrtf(ss * (1.f / 64.f) + EPS);
                const int m = lane & 3, sh = lane >> 2, h = sh >> 1, j = sh & 1;
                const float* gain = (which == 0 ? inp(I_QNORM) : inp(I_KNORM)) + l * 64 + 16 * m;
                float y[16];
#pragma unroll
                for (int e = 0; e < 16; ++e) y[e] = x[e] * rstd * gain[e];
                if (!isctx) {
                    const float posf = (float)((m & 1) ? (t & 63) : (t >> 6));
#pragma unroll
                    for (int e = 0; e < 16; ++e) { const float yp = __shfl_xor(y[e], 2);
                        const float ang = posf * exp2f(-(float)e * 0.8304820237218405f);
                        const float cs = __cosf(ang), sn = __sinf(ang);
                        y[e] = (m < 2) ? (y[e] * cs - yp * sn) : (y[e] * cs + yp * sn); }
                }
                bf16_t* dst;
                if (which == 0) {
#pragma unroll
                    for (int e = 0; e < 16; ++e) y[e] *= 0.125f * LOG2E;
                    dst = isctx ? qnc + (((size_t)(b * 8 + h) * 2 + j) * LC + t) * 64 + 16 * m : qn + (((size_t)(b * 8 + h) * 2 + j) * SEQ + t) * 64 + 16 * m;
                } else dst = kn + (((size_t)(b * 8 + h) * 2 + j) * LK + (isctx ? t : LC + t)) * 64 + 16 * m;
                u32x4 w0, w1;
                w0.x = cvt_pk_bf16(y[0], y[1]); w0.y = cvt_pk_bf16(y[2], y[3]); w0.z = cvt_pk_bf16(y[4], y[5]); w0.w = cvt_pk_bf16(y[6], y[7]);
                w1.x = cvt_pk_bf16(y[8], y[9]); w1.y = cvt_pk_bf16(y[10], y[11]); w1.z = cvt_pk_bf16(y[12], y[13]); w1.w = cvt_pk_bf16(y[14], y[15]);
                *(u32x4*)dst = w0; *(u32x4*)(dst + 8) = w1;
            }
        }
    }
}

constexpr int GL_Q = 0, GL_K = 17408, GL_KH = 34816, GL_VT = 53248, GL_ATT = 57856, GL_ST = 67072;
__device__ __forceinline__ void gla_unit(const Args& a, int l, LAS unsigned char* lds, int item) {
    const int tid = opaque_tid(), lane = tid & 63, w = __builtin_amdgcn_readfirstlane(tid >> 6);
    const int vs = item & 7, dir = (item >> 3) & 1, h = (item >> 4) & 3, b = item >> 6;
    const bool need_ctx = (l == 0);
    unsigned char* ws = opaque_ptr(a.ws);
    const bf16_t* z = (const bf16_t*)(ws + OFF_Z);
    const bf16_t* gq = (const bf16_t*)(ws + OFF_GQ + dir * SZ_G) + h * 128;
    const bf16_t* gk = (const bf16_t*)(ws + OFF_GK + dir * SZ_G) + h * 128;
    const bf16_t* gh = (const bf16_t*)(ws + OFF_GH + dir * SZ_G) + (size_t)h * 128 * 64;
    const float* dec = (const float*)(ws + OFF_DEC) + (size_t)dir * 144 * 512 + h * 128;
    bf16_t* od = (bf16_t*)(ws + OFF_OF + (size_t)dir * MT * 1024 * 2) + h * 256 + vs * 32;
    const bf16_t* gvt = (const bf16_t*)(ws + OFF_GVT) + (size_t)(h * 256 + vs * 32) * 64;
    const int fr = lane & 15, fq = lane >> 4;
    f32x4 sacc[2] = {(f32x4){0.f, 0.f, 0.f, 0.f}, (f32x4){0.f, 0.f, 0.f, 0.f}};
    for (int i = tid; i < 32 * 136 / 2; i += 512) ((LAS unsigned*)(lds + GL_ST))[i] = 0u;
    u32x4 rq[2], rk[2], rh[2], rv; float rdec;
    auto rowbase = [&](int s) -> int { if (s < 4) { const int ci = dir == 0 ? s : 3 - s; return ML + b * LC + 64 * ci; } const int ci = dir == 0 ? s - 4 : 35 - s; return b * SEQ + 64 * ci; };
#define GLA_LOAD(s) do { const int _rb = rowbase(s); _Pragma("unroll") for (int _i = 0; _i < 2; ++_i) { const int _idx = tid + 512 * _i, _r = _idx >> 4, _c = (_idx & 15) * 8; const size_t _o = (size_t)(_rb + _r) * 512 + _c; \
        rq[_i] = *(const u32x4*)(gq + _o); rk[_i] = *(const u32x4*)(gk + _o); rh[_i] = *(const u32x4*)(gh + ((size_t)(_rb >> 6) * 512 + (_idx >> 3)) * 64 + (_idx & 7) * 8); } \
        if (tid < 256) rv = *(const u32x4*)(gvt + ((size_t)(_rb >> 6) * 1024 + (tid >> 3)) * 64 + (tid & 7) * 8); \
        rdec = dec[(size_t)(_rb >> 6) * 512 + 16 * w + fr]; } while (0)
    GLA_LOAD(0);
    for (int s = 0; s < 36; ++s) {
        const int rb = rowbase(s);
        const float dk = rdec;
#pragma unroll
        for (int i = 0; i < 2; ++i) { const int idx = tid + 512 * i, r = idx >> 4, c = (idx & 15) * 8;
            *(LAS u32x4*)(lds + GL_Q + r * 272 + c * 2) = rq[i]; *(LAS u32x4*)(lds + GL_K + r * 272 + c * 2) = rk[i];
            *(LAS u32x4*)(lds + GL_KH + (idx >> 3) * 144 + (idx & 7) * 16) = rh[i]; }
        if (tid < 256) *(LAS u32x4*)(lds + GL_VT + (tid >> 3) * 144 + (tid & 7) * 16) = rv;
        __syncthreads();
        if (s + 1 < 36) GLA_LOAD(s + 1);
        {
            const int tt = w >> 1;
#pragma unroll
            for (int si = 0; si < 2; ++si) { const int st = 2 * (w & 1) + si; f32x4 acc = (f32x4){0.f, 0.f, 0.f, 0.f};
#pragma unroll
                for (int kk = 0; kk < 4; ++kk) { const bf16x8 af = *(const LAS bf16x8*)(lds + GL_Q + (16 * tt + fr) * 272 + (32 * kk + 8 * fq) * 2);
                    const bf16x8 bfr = *(const LAS bf16x8*)(lds + GL_K + (16 * st + fr) * 272 + (32 * kk + 8 * fq) * 2);
                    acc = __builtin_amdgcn_mfma_f32_16x16x32_bf16(af, bfr, acc, 0, 0, 0); }
#pragma unroll
                for (int j = 0; j < 4; ++j) { const int t = 16 * tt + 4 * fq + j, sc = 16 * st + fr; const bool keep = dir == 0 ? (sc <= t) : (sc >= t);
                    *(LAS bf16_t*)(lds + GL_ATT + t * 144 + sc * 2) = f2bf(keep ? acc[j] : 0.f); } }
        }
#pragma unroll
        for (int vt = 0; vt < 2; ++vt) { f32x4 acc = sacc[vt] * dk;
#pragma unroll
            for (int kk = 0; kk < 2; ++kk) { const bf16x8 af = *(const LAS bf16x8*)(lds + GL_VT + (16 * vt + fr) * 144 + (32 * kk + 8 * fq) * 2);
                const bf16x8 bfr = *(const LAS bf16x8*)(lds + GL_KH + (16 * w + fr) * 144 + (32 * kk + 8 * fq) * 2);
                acc = __builtin_amdgcn_mfma_f32_16x16x32_bf16(af, bfr, acc, 0, 0, 0); }
            sacc[vt] = acc; }
        __syncthreads();
        {
            const int tt = w >> 1, vt = w & 1; f32x4 acc = (f32x4){0.f, 0.f, 0.f, 0.f};
#pragma unroll
            for (int kk = 0; kk < 4; ++kk) { const bf16x8 af = *(const LAS bf16x8*)(lds + GL_Q + (16 * tt + fr) * 272 + (32 * kk + 8 * fq) * 2);
                const bf16x8 bfr = *(const LAS bf16x8*)(lds + GL_ST + (16 * vt + fr) * 272 + (32 * kk + 8 * fq) * 2);
                acc = __builtin_amdgcn_mfma_f32_16x16x32_bf16(af, bfr, acc, 0, 0, 0); }
#pragma unroll
            for (int kk = 0; kk < 2; ++kk) { const bf16x8 af = *(const LAS bf16x8*)(lds + GL_ATT + (16 * tt + fr) * 144 + (32 * kk + 8 * fq) * 2);
                const bf16x8 bfr = *(const LAS bf16x8*)(lds + GL_VT + (16 * vt + fr) * 144 + (32 * kk + 8 * fq) * 2);
                acc = __builtin_amdgcn_mfma_f32_16x16x32_bf16(af, bfr, acc, 0, 0, 0); }
            if (s >= 4 || need_ctx) {
#pragma unroll
                for (int j = 0; j < 4; ++j) od[(size_t)(rb + 16 * tt + 4 * fq + j) * 1024 + 16 * vt + fr] = f2bf(acc[j]); }
        }
        __syncthreads();
#pragma unroll
        for (int vt = 0; vt < 2; ++vt)
#pragma unroll
            for (int j = 0; j < 4; ++j) *(LAS bf16_t*)(lds + GL_ST + (16 * vt + 4 * fq + j) * 272 + (16 * w + fr) * 2) = f2bf(sacc[vt][j]);
    }
    __syncthreads();
#undef GLA_LOAD
}

constexpr int AT_BUF = 36864, AT_K = 0, AT_V = 18432;
__device__ __forceinline__ void attn_unit(LAS unsigned char* lds, const bf16_t* qbase, int Lq, int q0, const bf16_t* kbase, const bf16_t* vtbase, int nkeys,
                                          float c2, float lam, float post_scale, const float* subln, const bf16_t* dg, bf16_t* outp, int row0) {
    const int tid = opaque_tid(), lane = tid & 63, w = __builtin_amdgcn_readfirstlane(tid >> 6), q32 = lane & 31, hi = lane >> 5;
    const int j = w >> 2, qg = w & 3;
    bf16x8 qf[4];
#pragma unroll
    for (int kk = 0; kk < 4; ++kk) qf[kk] = *(const bf16x8*)(qbase + ((size_t)j * Lq + q0 + 32 * qg + q32) * 64 + 16 * kk + 8 * hi);
    f32x16 o[4];
#pragma unroll
    for (int vt = 0; vt < 4; ++vt)
#pragma unroll
        for (int r = 0; r < 16; ++r) o[vt][r] = 0.f;
    float lsum = 0.f;
    const int nt = nkeys >> 6;
    u32x4 skA[2], svA[2], skB[2], svB[2];
#define AT_LOAD(sk, sv, i) do { _Pragma("unroll") for (int _c = 0; _c < 2; ++_c) { const int _idx = tid + 512 * _c; \
        sk[_c] = *(const u32x4*)(kbase + ((size_t)(_idx >> 9) * LK + 64 * (i) + ((_idx & 511) >> 3)) * 64 + (_idx & 7) * 8); \
        sv[_c] = *(const u32x4*)(vtbase + (size_t)(_idx >> 3) * LK + 64 * (i) + (_idx & 7) * 8); } } while (0)
#define AT_STORE(sk, sv, p) do { _Pragma("unroll") for (int _c = 0; _c < 2; ++_c) { const int _idx = tid + 512 * _c; \
        *(LAS u32x4*)(lds + (p) * AT_BUF + AT_K + ((_idx >> 9) * 64 + ((_idx & 511) >> 3)) * 144 + (_idx & 7) * 16) = sk[_c]; \
        *(LAS u32x4*)(lds + (p) * AT_BUF + AT_V + (_idx >> 3) * 144 + (_idx & 7) * 16) = sv[_c]; } } while (0)
#define AT_TILE(p) do { \
        LAS unsigned char* Kb = lds + (p) * AT_BUF + AT_K + j * (64 * 144); LAS unsigned char* Vb = lds + (p) * AT_BUF + AT_V; \
        _Pragma("unroll") for (int kb = 0; kb < 2; ++kb) { \
            f32x16 s; \
            _Pragma("unroll") for (int r = 0; r < 16; ++r) s[r] = -c2; \
            _Pragma("unroll") for (int kk = 0; kk < 4; ++kk) { \
                const bf16x8 a0 = *(const LAS bf16x8*)(Kb + (32 * kb + q32) * 144 + (16 * kk + 8 * hi) * 2); \
                s = __builtin_amdgcn_mfma_f32_32x32x16_bf16(a0, qf[kk], s, 0, 0, 0); } \
            _Pragma("unroll") for (int r = 0; r < 16; ++r) { s[r] = __builtin_amdgcn_exp2f(s[r]); lsum += s[r]; } \
            _Pragma("unroll") for (int hf = 0; hf < 2; ++hf) { \
                const int ks = 2 * kb + hf; \
                u32x4 pw; \
                pw.x = cvt_pk_bf16(s[8 * hf + 0], s[8 * hf + 1]); pw.y = cvt_pk_bf16(s[8 * hf + 2], s[8 * hf + 3]); pw.z = cvt_pk_bf16(s[8 * hf + 4], s[8 * hf + 5]); pw.w = cvt_pk_bf16(s[8 * hf + 6], s[8 * hf + 7]); \
                const bf16x8 pb = __builtin_bit_cast(bf16x8, pw); \
                _Pragma("unroll") for (int vt = 0; vt < 4; ++vt) { \
                    const bf16x8 av = *(const LAS bf16x8*)(Vb + (32 * vt + q32) * 144 + (16 * ks + 8 * hi) * 2); \
                    o[vt] = __builtin_amdgcn_mfma_f32_32x32x16_bf16(av, pb, o[vt], 0, 0, 0); } } } } while (0)
    AT_LOAD(skA, svA, 0); AT_STORE(skA, svA, 0);
    AT_LOAD(skA, svA, 1);
    __syncthreads();
    for (int i = 0; i < nt; i += 2) {
        if (i + 2 < nt) AT_LOAD(skB, svB, i + 2);
        AT_TILE(0);
        AT_STORE(skA, svA, 1);
        __syncthreads();
        if (i + 3 < nt) AT_LOAD(skA, svA, i + 3);
        AT_TILE(1);
        if (i + 2 < nt) AT_STORE(skB, svB, 0);
        __syncthreads();
    }
#undef AT_TILE
#undef AT_LOAD
#undef AT_STORE
    lsum += __shfl_xor(lsum, 32);
    LAS float* xch = (LAS float*)lds + (size_t)qg * 4096 + lane;
    if (j == 1) {
        const float sc = lam / lsum;
#pragma unroll
        for (int vt = 0; vt < 4; ++vt)
#pragma unroll
            for (int r = 0; r < 16; ++r) xch[(vt * 16 + r) * 64] = o[vt][r] * sc;
    }
    __syncthreads();
    if (j == 0) {
        const float i0 = 1.f / lsum;
        float ss = 0.f;
#pragma unroll
        for (int vt = 0; vt < 4; ++vt)
#pragma unroll
            for (int r = 0; r < 16; ++r) { const float v = o[vt][r] * i0 - xch[(vt * 16 + r) * 64]; o[vt][r] = v; ss += v * v; }
        ss += __shfl_xor(ss, 32);
        const float rstd = rsqrtf(ss * (1.f / 128.f) + EPS) * post_scale;
        const size_t row = (size_t)row0 + 32 * qg + q32;
#pragma unroll
        for (int vt = 0; vt < 4; ++vt)
#pragma unroll
            for (int g4 = 0; g4 < 4; ++g4) {
                const int v0 = 32 * vt + 8 * g4 + 4 * hi;
                const u32x2 gz = *(const u32x2*)(dg + row * NZ + v0);
                const f32x4 sl = *(const f32x4*)(subln + v0);
                const float r0 = o[vt][4 * g4 + 0] * rstd * sl[0] * silu_f(bflo(gz.x)), r1 = o[vt][4 * g4 + 1] * rstd * sl[1] * silu_f(bfhi(gz.x));
                const float r2 = o[vt][4 * g4 + 2] * rstd * sl[2] * silu_f(bflo(gz.y)), r3 = o[vt][4 * g4 + 3] * rstd * sl[3] * silu_f(bfhi(gz.y));
                u32x2 wv; wv.x = cvt_pk_bf16(r0, r1); wv.y = cvt_pk_bf16(r2, r3);
                *(u32x2*)(outp + row * 1024 + v0) = wv;
            }
    }
    __syncthreads();
}

__device__ __forceinline__ void phase_mix(const Args& a, int l, LAS unsigned char* lds) {
    const int G = opaque_s(gridDim.x);
    unsigned char* ws = opaque_ptr(a.ws);
    const bool need_ctx = (l == 0);
#ifndef NO_GLA
    for (int it = BID; it < 256; it += G) gla_unit(a, l, lds, ((it & 7) * 4 + (it >> 6)) * 8 + ((it >> 3) & 7));
#if defined(REPEAT_SUB) && REPEAT_SUB == 1
    for (int it = BID; it < 256; it += G) gla_unit(a, l, lds, it);
#endif
#endif
#ifndef NO_ATT
    {
        const float* scal = (const float*)(ws + OFF_SCAL) + l * 4;
        const float lam = scal[0], c2 = scal[1], post = 1.f - scal[2];
        const bf16_t* z = (const bf16_t*)(ws + OFF_Z);
        const int nun = 512 + (need_ctx ? 64 : 0);
#if defined(REPEAT_SUB) && REPEAT_SUB == 2
        for (int rep = 0; rep < 2; ++rep)
#endif
        for (int u = BID; u < nun; u += G) {
            if (u < 512) { const int vc = (u & 7) * 64 + (u >> 3), bh = vc >> 4, qb = vc & 15, b = bh >> 3, h = bh & 7;
                attn_unit(lds, (const bf16_t*)(ws + OFF_QN) + (size_t)bh * 2 * SEQ * 64, SEQ, 128 * qb, (const bf16_t*)(ws + OFF_KN) + (size_t)bh * 2 * LK * 64,
                          (const bf16_t*)(ws + OFF_VT) + (size_t)bh * 128 * LK, LK, c2, lam, post, inp(I_SUBLN) + l * 128, z + ZC_DG + h * 128, (bf16_t*)(ws + OFF_DIFFO) + h * 128, b * SEQ + 128 * qb);
            } else { const int uu = u - 512, bh = uu >> 1, qb = uu & 1, b = bh >> 3, h = bh & 7;
                attn_unit(lds, (const bf16_t*)(ws + OFF_QNC) + (size_t)bh * 2 * LC * 64, LC, 128 * qb, (const bf16_t*)(ws + OFF_KN) + (size_t)bh * 2 * LK * 64,
                          (const bf16_t*)(ws + OFF_VT) + (size_t)bh * 128 * LK, LC, c2, lam, post, inp(I_SUBLN) + l * 128, z + ZC_DG + h * 128, (bf16_t*)(ws + OFF_DIFFO) + h * 128, ML + b * LC + 128 * qb);
            }
        }
    }
#endif
#ifndef NO_POOL
    {
        const int Mrows = need_ctx ? MT : ML;
        pg8::Gemm g{(const bf16_t*)(ws + OFF_DPOOL), (const bf16_t*)(ws + OFF_POOLT + (size_t)l * SZ_POOLT), Mrows, 1024, 256, 1024, 256, 256};
        pg8::StaticOrder S; S.init(Mrows, 1024, G, BID);
        pg8::EpiPool E{(bf16_t*)(ws + OFF_POOLO), (const bf16_t*)(ws + OFF_PGATE)};
        pg8::gemm_phase<pg8::EpiPool, pg8::StaticOrder, true, true>(lds, g, S, E);
    }
#endif
}

__device__ __forceinline__ void phase_post(const Args& a, int l) {
    const int tid = opaque_tid(), lane = tid & 63, wave = tid >> 6, G = opaque_s(gridDim.x);
    const int gw = BID * 8 + wave, NGW = G * 8;
    unsigned char* ws = opaque_ptr(a.ws);
    const bf16_t* z = (const bf16_t*)(ws + OFF_Z);
    const bf16_t* of = (const bf16_t*)(ws + OFF_OF); const bf16_t* ob = of + (size_t)MT * 1024;
    bf16_t* go = (bf16_t*)(ws + OFF_GLAO);
    const int Mrows = (l == 0) ? MT : ML;
    const float* gn = inp(I_GLAN) + l * 256 + ((16 * lane) & 255);
    for (int row = gw; row < Mrows; row += NGW) {
        float x[16], y[16], gz[16];
        const size_t o = (size_t)row * 1024 + 16 * lane;
        unpack8(*(const u32x4*)(of + o), x); unpack8(*(const u32x4*)(of + o + 8), x + 8);
        unpack8(*(const u32x4*)(ob + o), y); unpack8(*(const u32x4*)(ob + o + 8), y + 8);
        unpack8(*(const u32x4*)(z + (size_t)row * NZ + ZC_GG + 16 * lane), gz); unpack8(*(const u32x4*)(z + (size_t)row * NZ + ZC_GG + 16 * lane + 8), gz + 8);
        float ss = 0.f;
#pragma unroll
        for (int e = 0; e < 16; ++e) { x[e] += y[e]; ss += x[e] * x[e]; }
        ss += __shfl_xor(ss, 1); ss += __shfl_xor(ss, 2); ss += __shfl_xor(ss, 4); ss += __shfl_xor(ss, 8);
        const float rstd = rsqrtf(ss * (1.f / 256.f) + EPS);
        float r[16];
#pragma unroll
        for (int e = 0; e < 16; ++e) r[e] = x[e] * rstd * gn[e] * silu_f(gz[e]);
        u32x4 w0, w1;
        w0.x = cvt_pk_bf16(r[0], r[1]); w0.y = cvt_pk_bf16(r[2], r[3]); w0.z = cvt_pk_bf16(r[4], r[5]); w0.w = cvt_pk_bf16(r[6], r[7]);
        w1.x = cvt_pk_bf16(r[8], r[9]); w1.y = cvt_pk_bf16(r[10], r[11]); w1.z = cvt_pk_bf16(r[12], r[13]); w1.w = cvt_pk_bf16(r[14], r[15]);
        *(u32x4*)(go + o) = w0; *(u32x4*)(go + o + 8) = w1;
    }
}

#define XB_TMO      128
#define XB_XCNT(j)  (256  + 64 * (j))
#define XB_XSUB(j)  (1280 + 64 * (j))
#define XB_XGEN(j)  (2304 + 64 * (j))
#define XB_TOP      3328
#define XB_TOPGEN   3392
#define XCD_BAR_WORDS 3456
#define XB_SPIN_CAP (1u << 18)

__device__ __forceinline__ unsigned xb_ld(unsigned* p)              { return __hip_atomic_load(p, __ATOMIC_RELAXED, __HIP_MEMORY_SCOPE_AGENT); }
__device__ __forceinline__ unsigned xb_add(unsigned* p, unsigned v) { return __hip_atomic_fetch_add(p, v, __ATOMIC_RELAXED, __HIP_MEMORY_SCOPE_AGENT); }
__device__ __forceinline__ unsigned xb_xcc_id() { return (unsigned)__builtin_amdgcn_s_getreg((3 << 11) | 20) & 0xFu; }
#define XB_SPIN(cond, bar) do { unsigned _sp = 0; while (cond) { __builtin_amdgcn_s_sleep(1); \
    if ((++_sp & 255u) == 0u) { if (xb_ld(&(bar)[XB_TMO])) break; if (_sp > XB_SPIN_CAP) { atomicAdd(&(bar)[XB_TMO], 1u); break; } } } } while (0)

struct XcdBarrier {
    unsigned* bar; unsigned x;
    volatile LAS unsigned* st;
};

__device__ __forceinline__ XcdBarrier xcd_barrier_post(unsigned* bar, volatile LAS unsigned* st) {
    XcdBarrier b; b.bar = bar; b.x = xb_xcc_id(); b.st = st;
    if (threadIdx.x == 0) (void)xb_add(&bar[XB_XCNT(b.x)], 1u);
    return b;
}
__device__ __forceinline__ void xcd_barrier_complete(unsigned* bar, unsigned x, unsigned& nloc, unsigned& nx) {
    const unsigned G = gridDim.x * gridDim.y * gridDim.z;
    unsigned sum, cnt, mine, sp = 0u;
    for (;;) {
        sum = 0u; cnt = 0u; mine = 0u;
#pragma unroll
        for (unsigned j = 0; j < 16; ++j) { const unsigned c = xb_ld(&bar[XB_XCNT(j)]); sum += c; cnt += (c > 0u) ? 1u : 0u; mine = (j == x) ? c : mine; }
        if (sum == G) break;
        __builtin_amdgcn_s_sleep(1);
        if ((++sp & 255u) == 0u) { if (xb_ld(&bar[XB_TMO])) break; if (sp > XB_SPIN_CAP) { atomicAdd(&bar[XB_TMO], 1u); break; } }
    }
    nloc = mine > 0u ? mine : 1u; nx = cnt > 0u ? cnt : 1u;
}

__device__ __forceinline__ void xcd_barrier(const XcdBarrier& b) {
    asm volatile("s_waitcnt vmcnt(0)" ::: "memory");
    __syncthreads();
    if (threadIdx.x == 0) {
        unsigned* bar = b.bar;
        __builtin_amdgcn_s_waitcnt(0);
        unsigned nloc = b.st[0], nx = b.st[1];
        if (nloc == 0u) { xcd_barrier_complete(bar, b.x, nloc, nx); b.st[0] = nloc; b.st[1] = nx; }
        const unsigned old = xb_add(&bar[XB_XSUB(b.x)], 1u);
        const unsigned gen = old / nloc;
        if (old + 1u == (gen + 1u) * nloc) {
            __builtin_amdgcn_fence(__ATOMIC_RELEASE, "agent");
            asm volatile("s_waitcnt vmcnt(0)" ::: "memory");
            const unsigned og = xb_add(&bar[XB_TOP], 1u);
            const unsigned tg = og / nx;
            if (og + 1u == (tg + 1u) * nx) xb_add(&bar[XB_TOPGEN], 1u);
            else XB_SPIN(xb_ld(&bar[XB_TOPGEN]) == tg, bar);
            __builtin_amdgcn_fence(__ATOMIC_ACQUIRE, "agent");
            xb_add(&bar[XB_XGEN(b.x)], 1u);
            asm volatile("s_waitcnt vmcnt(0)" ::: "memory");
        } else {
            XB_SPIN(xb_ld(&bar[XB_XGEN(b.x)]) == gen, bar);
            __builtin_amdgcn_fence(__ATOMIC_ACQUIRE, "agent");
            asm volatile("s_waitcnt vmcnt(0)" ::: "memory");
        }
    }
    __syncthreads();
}

__global__ void __launch_bounds__(512, 2) hybrid_fwd(Args a) {
    extern __shared__ __attribute__((aligned(16))) unsigned char smem[];
    LAS unsigned char* lds = (LAS unsigned char*)smem;
    cg::grid_group grid = cg::this_grid();
    volatile LAS unsigned* bst = (volatile LAS unsigned*)(lds + 131072 + 512);
    if (threadIdx.x < 2) bst[threadIdx.x] = 0u;
    __syncthreads();
    const XcdBarrier xbar = xcd_barrier_post((unsigned*)(a.ws + OFF_BAR), bst);
#ifndef REPEAT_K
#define REPEAT_K -1
#endif
    for (int ph2 = 2 * a.ph_lo; ph2 < 2 * a.ph_hi; ++ph2) {
        const int ph = ph2 >> 1;
        if (ph2 & 1) { if (REPEAT_K < 0) continue; if (!((ph == 0 && REPEAT_K == 7) || (ph > 0 && (ph - 1) % 7 == REPEAT_K))) continue; }
        else if (ph > a.ph_lo) { if (ph == a.ph_lo + 1) grid.sync(); else xcd_barrier(xbar); }
        unsigned char* ws = opaque_ptr(a.ws);
        const int G = opaque_s(gridDim.x);
#ifndef KMASK
#define KMASK 0xff
#endif
        if (ph == 0) { if (KMASK & 128) phase_p0(a, lds); continue; }
        const int l = (ph - 1) / 7, k = (ph - 1) % 7;
        const int Mout = (l == 0) ? MT : ML;
        if (k == 0) { if (KMASK & 1) phase_norm(a, l); }
        else if (k == 1) { if (KMASK & 2) {
            pg8::Gemm g{(const bf16_t*)(ws + OFF_H), (const bf16_t*)(ws + OFF_WIN + (size_t)l * SZ_WIN), MT, NZ, DM, DM, DM, 0};
            pg8::StaticOrder S; S.init(MT, NZ, G, BID);
            pg8::EpiBf16 E{(bf16_t*)(ws + OFF_Z), NZ};
            pg8::gemm_phase<pg8::EpiBf16, pg8::StaticOrder, true, true>(lds, g, S, E);
        } }
        else if (k == 2) { if (KMASK & 4) phase_prep(a, l, lds); }
        else if (k == 3) { if (KMASK & 8) phase_mix(a, l, lds); }
        else if (k == 4) { if (KMASK & 16) phase_post(a, l); }
        else if (k == 5) { if (KMASK & 32) {
            pg8::StaticOrder S; S.init(Mout, DM, G, BID);
            const bf16_t* zg = (const bf16_t*)(ws + OFF_Z) + ZC_MG;
            float* yacc = (float*)(ws + OFF_YACC); bf16_t* y = (bf16_t*)(ws + OFF_H);
            const bf16_t* wb = (const bf16_t*)(ws + OFF_WB + (size_t)l * SZ_WB);
            { pg8::Gemm g{(const bf16_t*)(ws + OFF_POOLO), wb, Mout, DM, 1024, 1024, 1024, 0}; pg8::EpiMerge<0> E{yacc, y, zg};
              pg8::gemm_phase<pg8::EpiMerge<0>, pg8::StaticOrder, true, true>(lds, g, S, E); }
            { pg8::Gemm g{(const bf16_t*)(ws + OFF_DIFFO), wb + (size_t)DM * 1024, Mout, DM, 1024, 1024, 1024, 0}; pg8::EpiMerge<1> E{yacc, y, zg + 2048};
              pg8::gemm_phase<pg8::EpiMerge<1>, pg8::StaticOrder, true, true>(lds, g, S, E); }
            { pg8::Gemm g{(const bf16_t*)(ws + OFF_GLAO), wb + (size_t)2 * DM * 1024, Mout, DM, 1024, 1024, 1024, 0}; pg8::EpiMerge<2> E{yacc, y, zg + 4096};
              pg8::gemm_phase<pg8::EpiMerge<2>, pg8::StaticOrder, true, true>(lds, g, S, E); }
        } }
        else if (KMASK & 64) {
            pg8::Gemm g{(const bf16_t*)(ws + OFF_H), (const bf16_t*)(ws + OFF_WOUT + (size_t)l * SZ_WOUT), Mout, DM, DM, DM, DM, 0};
            pg8::StaticOrder S; S.init(Mout, DM, G, BID);
            pg8::EpiOut E{l == 0 ? inp(I_X) : (const float*)(ws + OFF_X1), l == 0 ? inp(I_CTX) : (const float*)(ws + OFF_X1) + (size_t)ML * DM,
                          l == 0 ? (float*)(ws + OFF_X1) : arg_out(), (const float*)(ws + OFF_MOD) + (size_t)l * 5 * 6144};
            pg8::gemm_phase<pg8::EpiOut, pg8::StaticOrder, true, true>(lds, g, S, E);
        }
    }
}

extern "C" void kernel_launch(void* const* d_in, const int* in_sizes, int n_in, void* d_out, int out_size, void* d_ws, size_t ws_size, hipStream_t stream) {
    static int grid = 0;
    if (grid == 0) {
        if (n_in != 26 || out_size != ML * DM || ws_size < WS_END) { fprintf(stderr, "kernel_launch: expected 26 inputs, out %d, ws >= %zu; got n_in %d out %d ws %zu\n", ML * DM, (size_t)WS_END, n_in, out_size, ws_size); grid = -1; return; }
        int dev = 0, cus = 0, per_cu = 0;
        if (hipGetDevice(&dev) != hipSuccess || hipDeviceGetAttribute(&cus, hipDeviceAttributeMultiprocessorCount, dev) != hipSuccess) { grid = -1; return; }
        if (hipFuncSetAttribute((const void*)hybrid_fwd, hipFuncAttributeMaxDynamicSharedMemorySize, LDS_BYTES) != hipSuccess) { fprintf(stderr, "kernel_launch: hipFuncSetAttribute failed\n"); grid = -1; return; }
        if (hipOccupancyMaxActiveBlocksPerMultiprocessor(&per_cu, (const void*)hybrid_fwd, 512, LDS_BYTES) != hipSuccess || per_cu < 1) { fprintf(stderr, "kernel_launch: occupancy query says %d blocks per CU\n", per_cu); (void)hipGetLastError(); grid = -1; return; }
        grid = cus;
    }
    if (grid < 0) return;
    if (hipMemsetAsync((char*)d_ws + OFF_BAR, 0, BAR_BYTES, stream) != hipSuccess) { fprintf(stderr, "kernel_launch: memset of the barrier words failed\n"); return; }
    Args a{};
    for (int i = 0; i < 26; ++i) a.in[i] = (const float*)d_in[i];
    a.out = (float*)d_out; a.ws = (unsigned char*)d_ws;
    const int nl = MK_N_LAUNCHES;
    for (int li = 0; li < nl; ++li) {
        a.ph_lo = (nl == 1) ? 0 : li; a.ph_hi = (nl == 1) ? NPH : li + 1;
        void* args[] = {&a};
        const hipError_t e = hipLaunchCooperativeKernel((const void*)hybrid_fwd, dim3(grid), dim3(512), args, LDS_BYTES, stream);
        if (e != hipSuccess) { fprintf(stderr, "kernel_launch: cooperative launch %d failed: %s (grid %d)\n", li, hipGetErrorString(e), grid); break; }
    }
}
```

```cpp
#include <hip/hip_runtime.h>
#include <hip/hip_cooperative_groups.h>
#include <cstdio>
#include <cstdint>
namespace cg = cooperative_groups;

#ifndef MK_N_LAUNCHES
#define MK_N_LAUNCHES 1
#endif

#define LAS __attribute__((address_space(3)))
typedef unsigned short bf16_t;
typedef short bf16x8 __attribute__((ext_vector_type(8)));
typedef float f32x4 __attribute__((ext_vector_type(4)));
typedef float f32x16 __attribute__((ext_vector_type(16)));
typedef unsigned u32x4 __attribute__((ext_vector_type(4)));
typedef unsigned u32x2 __attribute__((ext_vector_type(2)));

constexpr int DM = 2048, NB = 4, SEQ = 2048, LC = 256, ML = NB * SEQ, MC = NB * LC, MT = ML + MC;
constexpr int DIN = 15392, NZ = 15616;
constexpr int ZC_PU = 0, ZC_PG = 1024, ZC_DQ = 2048, ZC_DK = 3072, ZC_DV = 4096, ZC_DG = 5120, ZC_GQ = 6144, ZC_GK = 6656, ZC_GV = 7168, ZC_GG = 8192, ZC_LR = 9216, ZC_MG = 9472;
constexpr int LK = LC + SEQ;
constexpr float EPS = 1e-6f, LOG2E = 1.4426950408889634f;
constexpr int NPH = 15;

constexpr size_t SZ_WIN = (size_t)NZ * DM * 2, SZ_WB = (size_t)3 * DM * 1024 * 2, SZ_WOUT = (size_t)DM * DM * 2, SZ_POOLT = (size_t)4 * 256 * 256 * 2;
constexpr size_t OFF_WIN = 0;
constexpr size_t OFF_WB = OFF_WIN + 2 * SZ_WIN;
constexpr size_t OFF_WOUT = OFF_WB + 2 * SZ_WB;
constexpr size_t OFF_POOLT = OFF_WOUT + 2 * SZ_WOUT;
constexpr size_t OFF_MOD = OFF_POOLT + 2 * SZ_POOLT;
constexpr size_t OFF_SCAL = OFF_MOD + (size_t)2 * 5 * 6144 * 4;
constexpr size_t OFF_H = OFF_SCAL + 256;
constexpr size_t OFF_Z = OFF_H + (size_t)MT * DM * 2;
constexpr size_t OFF_QN = OFF_Z + (size_t)MT * NZ * 2;
constexpr size_t OFF_QNC = OFF_QN + (size_t)ML * 1024 * 2;
constexpr size_t OFF_KN = OFF_QNC + (size_t)MC * 1024 * 2;
constexpr size_t OFF_VT = OFF_KN + (size_t)MT * 1024 * 2;
constexpr size_t SZ_G = (size_t)MT * 512 * 2;
constexpr size_t OFF_GQ = OFF_VT + (size_t)MT * 1024 * 2;
constexpr size_t OFF_GK = OFF_GQ + 2 * SZ_G;
constexpr size_t OFF_GH = OFF_GK + 2 * SZ_G;
constexpr size_t OFF_DEC = OFF_GH + 2 * SZ_G;
constexpr size_t OFF_OF = OFF_DEC + (size_t)2 * 144 * 512 * 4;
constexpr size_t OFF_DPOOL = OFF_OF + 2 * (size_t)MT * 1024 * 2;
constexpr size_t OFF_POOLO = OFF_DPOOL + (size_t)MT * 1024 * 2;
constexpr size_t OFF_DIFFO = OFF_POOLO + (size_t)MT * 1024 * 2;
constexpr size_t OFF_GLAO = OFF_DIFFO + (size_t)MT * 1024 * 2;
constexpr size_t OFF_YACC = OFF_GLAO + (size_t)MT * 1024 * 2;
constexpr size_t OFF_X1 = OFF_YACC + (size_t)MT * DM * 4;
constexpr size_t OFF_PGATE = OFF_X1 + (size_t)MT * DM * 4;
constexpr size_t OFF_BAR = OFF_PGATE + (size_t)MT * 1024 * 2;
constexpr size_t BAR_BYTES = 16384;
constexpr size_t OFF_GVT = OFF_BAR + BAR_BYTES;
constexpr size_t WS_END = OFF_GVT + (size_t)MT * 1024 * 2;

constexpr int LDS_BYTES = 135168;

#define BID opaque_s((int)blockIdx.x)
__device__ __forceinline__ unsigned char* opaque_ptr(unsigned char* p) { asm volatile("" : "+s"(p)); return p; }
__device__ __forceinline__ int opaque_s(int v) { asm volatile("" : "+s"(v)); return v; }
__device__ __forceinline__ int opaque_tid() { int t = threadIdx.x; asm volatile("" : "+v"(t)); return t; }
typedef float f32x2_t __attribute__((ext_vector_type(2))); typedef __bf16 bf16x2_t __attribute__((ext_vector_type(2)));
__device__ __forceinline__ unsigned cvt_pk_bf16(float lo, float hi) { f32x2_t v = {lo, hi}; bf16x2_t b = __builtin_convertvector(v, bf16x2_t); return __builtin_bit_cast(unsigned, b); }
__device__ __forceinline__ bf16_t f2bf(float f) { return (bf16_t)(cvt_pk_bf16(f, 0.f) & 0xffffu); }
__device__ __forceinline__ float bf2f(bf16_t v) { return __builtin_bit_cast(float, (unsigned)v << 16); }
__device__ __forceinline__ float bflo(unsigned u) { return __builtin_bit_cast(float, u << 16); }
__device__ __forceinline__ float bfhi(unsigned u) { return __builtin_bit_cast(float, u & 0xffff0000u); }
__device__ __forceinline__ float silu_f(float x) { return x / (1.f + __expf(-x)); }
__device__ __forceinline__ float sigmoid_f(float x) { return 1.f / (1.f + __expf(-x)); }
__device__ __forceinline__ float logsig_f(float a) { return fminf(a, 0.f) - log1pf(__expf(-fabsf(a))); }
__device__ __forceinline__ float wave_sum(float v) {
#pragma unroll
    for (int o = 1; o < 64; o <<= 1) v += __shfl_xor(v, o);
    return v;
}
__device__ __forceinline__ float wave_max(float v) {
#pragma unroll
    for (int o = 1; o < 64; o <<= 1) v = fmaxf(v, __shfl_xor(v, o));
    return v;
}
__device__ __forceinline__ void unpack8(u32x4 w, float* f) { f[0] = bflo(w.x); f[1] = bfhi(w.x); f[2] = bflo(w.y); f[3] = bfhi(w.y); f[4] = bflo(w.z); f[5] = bfhi(w.z); f[6] = bflo(w.w); f[7] = bfhi(w.w); }

namespace pg8 {
constexpr int BM = 256, BK = 64, HALF = 128, HTB = HALF * BK * 2, STAGE_BYTES = 8 * HTB, NXCD = 8, WGM = 8;
__host__ __device__ __forceinline__ int lds_byte(int r, int c) { const int st = (r >> 4) * 2 + (c >> 5), rr = r & 15, cc = c & 31, ob = rr * 64 + cc * 2; return st * 1024 + (ob ^ (((ob >> 9) & 1) << 5)); }
__host__ __device__ __forceinline__ void stage_rc(int b, int& R, int& C) { const int st = b / 1024, sb = b % 1024, swz = sb ^ (((sb >> 9) & 1) << 5); R = (st >> 1) * 16 + swz / 64; C = (st & 1) * 32 + (swz % 64) / 2; }
__host__ __device__ __forceinline__ int perm32(int rho) { const int n = rho >> 4, i = rho & 15; return 8 * (i >> 2) + 4 * n + (i & 3); }

struct Unit { int pm, pn, seg; };
struct Gemm { const bf16_t* A; const bf16_t* Bt; int M, N, K; int lda, ldb; int a_pn_off; const bf16_t* A1; const bf16_t* A2; const bf16_t* B1; const bf16_t* B2; };

struct StaticOrder {
    int nM, nN, nwg, G, c;
    __host__ __device__ void init(int M, int N, int G_, int c_) { nM = M / BM; nN = N / BM; nwg = nM * nN; G = G_; c = c_; }
    __host__ __device__ bool next(int i, Unit& u) const {
        const long L = (long)i * G + c; if (L >= nwg) return false;
        int wgid = (int)L; { const int q = nwg / NXCD, r = nwg % NXCD, xcd = wgid % NXCD, off = wgid / NXCD; wgid = (xcd < r ? xcd * (q + 1) : r * (q + 1) + (xcd - r) * q) + off; }
        const int nig = WGM * nN, gid = wgid / nig, fm = gid * WGM, gsz = (nM - fm) < WGM ? (nM - fm) : WGM;
        u.pm = fm + ((wgid % nig) % gsz); u.pn = (wgid % nig) / gsz; u.seg = 0; return true;
    }
    __device__ __forceinline__ void a_ready(const Unit&) const {}
    __device__ __forceinline__ void done(const Unit&) const {}
};

struct SegOrder3 {
    StaticOrder base;
    __host__ __device__ bool next(int i, Unit& u) const { const int q = i / 3; if (!base.next(q, u)) return false; u.seg = i - 3 * q; return true; }
    __device__ __forceinline__ void a_ready(const Unit&) const {}
    __device__ __forceinline__ void done(const Unit&) const {}
};
struct EpiBf16 {
    static constexpr bool PERM = true, AFTER_DRAIN = false;
    bf16_t* O; int ldc;
    __device__ __forceinline__ void operator()(const f32x4 (&acc)[2][2][4][2], const Unit& u, int wr, int wc, int fr, int fq) const {
        const int row0 = u.pm * BM + wr * 64 + fr, col0 = u.pn * BM + wc * 32 + 8 * fq;
#pragma unroll
        for (int ai = 0; ai < 2; ++ai)
#pragma unroll
            for (int m = 0; m < 4; ++m) { bf16_t* rowp = O + (size_t)(row0 + ai * HALF + m * 16) * ldc + col0;
#pragma unroll
                for (int bj = 0; bj < 2; ++bj) { const f32x4 v0 = acc[ai][bj][m][0], v1 = acc[ai][bj][m][1];
                    u32x4 w; w.x = cvt_pk_bf16(v0[0], v0[1]); w.y = cvt_pk_bf16(v0[2], v0[3]); w.z = cvt_pk_bf16(v1[0], v1[1]); w.w = cvt_pk_bf16(v1[2], v1[3]);
                    *(u32x4*)(rowp + bj * HALF) = w; } }
    }
};

template <class Epi, class Sched, bool ALIGN_EPI = false, bool SP2 = false, int NSEG = 1>
__device__ __forceinline__ void gemm_phase(LAS unsigned char* lds, const Gemm g, const Sched& S, const Epi& E) {
    const int tid = opaque_tid(), wid = __builtin_amdgcn_readfirstlane(tid >> 6), lane = tid & 63, wr = wid >> 2, wc = wid & 3, fr = lane & 15, fq = lane >> 4;
    const int K = opaque_s(g.K), nt = K / BK;
    unsigned voffA[2], voffB[2];
#pragma unroll
    for (int i = 0; i < 2; ++i) { int R, C; stage_rc(tid * 16 + i * 8192, R, C); const int Rb = Epi::PERM ? ((R & ~31) + perm32(R & 31)) : R;
        voffA[i] = (unsigned)(R * g.lda + C) * 2u; voffB[i] = (unsigned)(Rb * g.ldb + C) * 2u; }
    const size_t kstep = (size_t)(BK * 2);
    const size_t hstepA = (size_t)HALF * g.lda * 2, hstepB = (size_t)HALF * g.ldb * 2;
    const size_t tstepA = 2 * hstepA, tstepB = 2 * hstepB;
    const size_t pnA = (size_t)g.a_pn_off * 2;
    const unsigned ldsw = (unsigned)wid * 1024u;
    const int aoff = lds_byte(wr * 64 + fr, fq * 8), boff = lds_byte(wc * 32 + fr, fq * 8);
#define PG8_SA(b, h) (((b) * 2 + (h)) * HTB)
#define PG8_SB(b, h) ((4 + (b) * 2 + (h)) * HTB)
#define PG8_STAGE(bufoff, gbase, voff) do { _Pragma("unroll") for (int _i = 0; _i < 2; ++_i) \
        __builtin_amdgcn_global_load_lds((const unsigned*)((const char*)(gbase) + (voff)[_i]), (LAS unsigned*)(lds + (bufoff) + ldsw + _i * 8192), 16, 0, 0); } while (0)
#define PG8_LDA(dst, b, h) do { _Pragma("unroll") for (int m = 0; m < 4; ++m) _Pragma("unroll") for (int k = 0; k < 2; ++k) dst[m][k] = *(const LAS bf16x8*)(lds + PG8_SA(b, h) + aoff + m * 2048 + k * 1024); } while (0)
#define PG8_LDB(dst, b, h) do { _Pragma("unroll") for (int n = 0; n < 2; ++n) _Pragma("unroll") for (int k = 0; k < 2; ++k) dst[n][k] = *(const LAS bf16x8*)(lds + PG8_SB(b, h) + boff + n * 2048 + k * 1024); } while (0)
#define PG8_MMA(ai, bj, At, Bt) do { __builtin_amdgcn_s_setprio(1); _Pragma("unroll") for (int m = 0; m < 4; ++m) _Pragma("unroll") for (int n = 0; n < 2; ++n) _Pragma("unroll") for (int k = 0; k < 2; ++k) \
        acc[ai][bj][m][n] = __builtin_amdgcn_mfma_f32_16x16x32_bf16(Bt[n][k], At[m][k], acc[ai][bj][m][n], 0, 0, 0); __builtin_amdgcn_s_setprio(0); } while (0)
#define PG8_WAIT_V(n) asm volatile("s_waitcnt vmcnt(" #n ")" ::: "memory")
#define PG8_WAIT_L(n) asm volatile("s_waitcnt lgkmcnt(" #n ")" ::: "memory")
#define PG8_BAR __builtin_amdgcn_s_barrier()
#define PG8_SCHED __builtin_amdgcn_sched_barrier(0)
    Unit cur, nxt; int ui = 0;
    if (!S.next(0, cur)) return;
    f32x4 acc[2][2][4][2];
#pragma unroll
    for (int a = 0; a < 2; ++a)
#pragma unroll
        for (int b = 0; b < 2; ++b)
#pragma unroll
            for (int m = 0; m < 4; ++m)
#pragma unroll
                for (int n = 0; n < 2; ++n) acc[a][b][m][n] = (f32x4){0.f, 0.f, 0.f, 0.f};
    bf16x8 At[4][2], B0[2][2], B1[2][2];
#define PG8_ASEG(u) ((const char*)(NSEG == 1 || (u).seg == 0 ? g.A : ((u).seg == 1 ? g.A1 : g.A2)))
#define PG8_BSEG(u) ((const char*)(NSEG == 1 || (u).seg == 0 ? g.Bt : ((u).seg == 1 ? g.B1 : g.B2)))
    const char* cA = PG8_ASEG(cur) + (size_t)cur.pm * tstepA + (size_t)cur.pn * pnA; const char* cB = PG8_BSEG(cur) + (size_t)cur.pn * tstepB;
    S.a_ready(cur);
    if constexpr (SP2) {
        PG8_STAGE(PG8_SB(0, 0), cB, voffB); PG8_STAGE(PG8_SB(0, 1), cB + hstepB, voffB); PG8_STAGE(PG8_SA(0, 0), cA, voffA); PG8_STAGE(PG8_SA(0, 1), cA + hstepA, voffA);
        if (wr == 1) PG8_BAR;
        PG8_WAIT_V(2); PG8_BAR;
        PG8_STAGE(PG8_SB(1, 0), cB + kstep, voffB); PG8_STAGE(PG8_SA(1, 0), cA + kstep, voffA); PG8_STAGE(PG8_SB(1, 1), cB + hstepB + kstep, voffB);
        PG8_WAIT_V(6); PG8_BAR;
    } else {
        PG8_STAGE(PG8_SB(0, 0), cB, voffB); PG8_STAGE(PG8_SA(0, 0), cA, voffA); PG8_STAGE(PG8_SB(0, 1), cB + hstepB, voffB); PG8_STAGE(PG8_SA(0, 1), cA + hstepA, voffA);
        if (wr == 1) PG8_BAR;
        PG8_WAIT_V(4); PG8_BAR;
        PG8_STAGE(PG8_SB(1, 0), cB + kstep, voffB); PG8_STAGE(PG8_SA(1, 0), cA + kstep, voffA); PG8_STAGE(PG8_SB(1, 1), cB + hstepB + kstep, voffB);
        PG8_WAIT_V(6); PG8_BAR;
    }
    for (;;) {
        const bool has_next = S.next(ui + 1, nxt);
        const char* nA = has_next ? PG8_ASEG(nxt) + (size_t)nxt.pm * tstepA + (size_t)nxt.pn * pnA : cA; const char* nB = has_next ? PG8_BSEG(nxt) + (size_t)nxt.pn * tstepB : cB;
        for (int t = 0; t < nt; t += 2) {
            const bool last = (t == nt - 2);
            const char* a1 = cA + (size_t)(t + 1) * kstep;
            const char* a2 = last ? nA : cA + (size_t)(t + 2) * kstep; const char* b2 = last ? nB : cB + (size_t)(t + 2) * kstep;
            const char* a3 = a2 + kstep; const char* b3 = b2 + kstep;
            if (last && has_next) S.a_ready(nxt);
            if constexpr (SP2) {
            PG8_LDB(B0, 0, 0); PG8_LDB(B1, 0, 1); PG8_SCHED; PG8_LDA(At, 0, 0); PG8_STAGE(PG8_SA(1, 1), a1 + hstepA, voffA);
            PG8_WAIT_V(8); PG8_WAIT_L(0); PG8_BAR; PG8_MMA(0, 0, At, B0); PG8_MMA(0, 1, At, B1); PG8_BAR; PG8_SCHED;
            PG8_LDA(At, 0, 1); PG8_STAGE(PG8_SB(0, 0), b2, voffB); PG8_STAGE(PG8_SB(0, 1), b2 + hstepB, voffB); PG8_STAGE(PG8_SA(0, 0), a2, voffA);
            PG8_WAIT_V(8); PG8_WAIT_L(0); PG8_BAR; PG8_MMA(1, 0, At, B0); PG8_MMA(1, 1, At, B1); PG8_BAR; PG8_SCHED;
            PG8_LDB(B0, 1, 0); PG8_LDB(B1, 1, 1); PG8_SCHED; PG8_LDA(At, 1, 0); PG8_STAGE(PG8_SA(0, 1), a2 + hstepA, voffA);
            PG8_WAIT_V(8); PG8_WAIT_L(0); PG8_BAR; PG8_MMA(0, 0, At, B0); PG8_MMA(0, 1, At, B1); PG8_BAR; PG8_SCHED;
            PG8_LDA(At, 1, 1); PG8_STAGE(PG8_SB(1, 0), b3, voffB); PG8_STAGE(PG8_SB(1, 1), b3 + hstepB, voffB); PG8_STAGE(PG8_SA(1, 0), a3, voffA);
            PG8_WAIT_V(8); PG8_WAIT_L(0); PG8_BAR; PG8_MMA(1, 0, At, B0); PG8_MMA(1, 1, At, B1); PG8_BAR; PG8_SCHED;
            } else {
            PG8_LDB(B0, 0, 0); PG8_SCHED; PG8_LDA(At, 0, 0); PG8_STAGE(PG8_SA(1, 1), a1 + hstepA, voffA);
            PG8_WAIT_L(8); PG8_BAR; PG8_WAIT_L(0); PG8_MMA(0, 0, At, B0); PG8_BAR; PG8_SCHED;
            PG8_LDB(B1, 0, 1); PG8_STAGE(PG8_SB(0, 0), b2, voffB);
            PG8_BAR; PG8_WAIT_L(0); PG8_MMA(0, 1, At, B1); PG8_BAR;
            PG8_LDA(At, 0, 1); PG8_STAGE(PG8_SA(0, 0), a2, voffA);
            PG8_BAR; PG8_WAIT_L(0); PG8_MMA(1, 0, At, B0); PG8_BAR; PG8_SCHED;
            PG8_STAGE(PG8_SB(0, 1), b2 + hstepB, voffB);
            PG8_WAIT_V(6); PG8_BAR; PG8_MMA(1, 1, At, B1); PG8_BAR;
            PG8_LDB(B0, 1, 0); PG8_SCHED; PG8_LDA(At, 1, 0); PG8_STAGE(PG8_SA(0, 1), a2 + hstepA, voffA);
            PG8_WAIT_L(8); PG8_BAR; PG8_WAIT_L(0); PG8_MMA(0, 0, At, B0); PG8_BAR; PG8_SCHED;
            PG8_LDB(B1, 1, 1); PG8_STAGE(PG8_SB(1, 0), b3, voffB);
            PG8_BAR; PG8_WAIT_L(0); PG8_MMA(0, 1, At, B1); PG8_BAR;
            PG8_LDA(At, 1, 1); PG8_STAGE(PG8_SA(1, 0), a3, voffA);
            PG8_BAR; PG8_WAIT_L(0); PG8_MMA(1, 0, At, B0); PG8_BAR; PG8_SCHED;
            PG8_STAGE(PG8_SB(1, 1), b3 + hstepB, voffB);
            PG8_WAIT_V(6); PG8_BAR; PG8_MMA(1, 1, At, B1); PG8_BAR;
            }
        }
        if constexpr (ALIGN_EPI) { if (wr == 0) PG8_BAR; }
        E(acc, cur, wr, wc, fr, fq); S.done(cur);
        if (!has_next) break;
        if (NSEG == 1 || cur.seg == NSEG - 1)
#pragma unroll
        for (int a = 0; a < 2; ++a)
#pragma unroll
            for (int b = 0; b < 2; ++b)
#pragma unroll
                for (int m = 0; m < 4; ++m)
#pragma unroll
                    for (int n = 0; n < 2; ++n) acc[a][b][m][n] = (f32x4){0.f, 0.f, 0.f, 0.f};
        cur = nxt; cA = nA; cB = nB; ++ui;
        if constexpr (ALIGN_EPI) { if (wr == 1) PG8_BAR; }
    }
    PG8_WAIT_V(0);
    if constexpr (!ALIGN_EPI) { if (wr == 0) PG8_BAR; }
    PG8_BAR;
#undef PG8_ASEG
#undef PG8_BSEG
#undef PG8_SA
#undef PG8_SB
#undef PG8_STAGE
#undef PG8_LDA
#undef PG8_LDB
#undef PG8_MMA
#undef PG8_WAIT_V
#undef PG8_WAIT_L
#undef PG8_BAR
#undef PG8_SCHED
}

struct EpiPool {
    static constexpr bool PERM = true, AFTER_DRAIN = false;
    bf16_t* O; const bf16_t* pgate;
    __device__ __forceinline__ void operator()(const f32x4 (&acc)[2][2][4][2], const Unit& u, int wr, int wc, int fr, int fq) const {
        const int row0 = u.pm * BM + wr * 64 + fr, col0 = u.pn * BM + wc * 32 + 8 * fq;
#pragma unroll
        for (int ai = 0; ai < 2; ++ai)
#pragma unroll
            for (int m = 0; m < 4; ++m)
#pragma unroll
                for (int bj = 0; bj < 2; ++bj) {
                    const int row = row0 + ai * HALF + m * 16, col = col0 + bj * HALF;
                    const u32x4 gz = *(const u32x4*)(pgate + (size_t)row * 1024 + col);
                    const f32x4 v0 = acc[ai][bj][m][0], v1 = acc[ai][bj][m][1];
                    u32x4 w;
                    w.x = cvt_pk_bf16(v0[0] * bflo(gz.x), v0[1] * bfhi(gz.x));
                    w.y = cvt_pk_bf16(v0[2] * bflo(gz.y), v0[3] * bfhi(gz.y));
                    w.z = cvt_pk_bf16(v1[0] * bflo(gz.z), v1[1] * bfhi(gz.z));
                    w.w = cvt_pk_bf16(v1[2] * bflo(gz.w), v1[3] * bfhi(gz.w));
                    *(u32x4*)(O + (size_t)row * 1024 + col) = w;
                    __builtin_amdgcn_sched_barrier(0);
                }
    }
};
template <int PASS> struct EpiMerge {
    static constexpr bool PERM = true, AFTER_DRAIN = false;
    float* yacc; bf16_t* y; const bf16_t* zg;
    __device__ __forceinline__ void operator()(const f32x4 (&acc)[2][2][4][2], const Unit& u, int wr, int wc, int fr, int fq) const {
        const int row0 = u.pm * BM + wr * 64 + fr, col0 = u.pn * BM + wc * 32 + 8 * fq;
#pragma unroll
        for (int ai = 0; ai < 2; ++ai)
#pragma unroll
            for (int m = 0; m < 4; ++m)
#pragma unroll
                for (int bj = 0; bj < 2; ++bj) {
                    const int row = row0 + ai * HALF + m * 16, col = col0 + bj * HALF;
                    float gz[8]; unpack8(*(const u32x4*)(zg + (size_t)row * NZ + col), gz);
                    const f32x4 v0 = acc[ai][bj][m][0], v1 = acc[ai][bj][m][1];
                    f32x4 r0, r1;
#pragma unroll
                    for (int e = 0; e < 4; ++e) { r0[e] = v0[e] * sigmoid_f(gz[e]); r1[e] = v1[e] * sigmoid_f(gz[4 + e]); }
                    float* yp = yacc + (size_t)row * DM + col;
                    if (PASS >= 1) { r0 += *(const f32x4*)yp; r1 += *(const f32x4*)(yp + 4); }
                    if (PASS <= 1) { *(f32x4*)yp = r0; *(f32x4*)(yp + 4) = r1; }
                    else { u32x4 w; w.x = cvt_pk_bf16(r0[0], r0[1]); w.y = cvt_pk_bf16(r0[2], r0[3]); w.z = cvt_pk_bf16(r1[0], r1[1]); w.w = cvt_pk_bf16(r1[2], r1[3]);
                        *(u32x4*)(y + (size_t)row * DM + col) = w; }
                    __builtin_amdgcn_sched_barrier(0);
                }
    }
};
struct EpiMerge3 {
    static constexpr bool PERM = true, AFTER_DRAIN = false;
    bf16_t* y; const bf16_t* zg;
    __device__ __forceinline__ void operator()(f32x4 (&acc)[2][2][4][2], const Unit& u, int wr, int wc, int fr, int fq) const {
        const int row0 = u.pm * BM + wr * 64 + fr, col0 = u.pn * BM + wc * 32 + 8 * fq;
#pragma unroll
        for (int ai = 0; ai < 2; ++ai)
#pragma unroll
            for (int m = 0; m < 4; ++m)
#pragma unroll
                for (int bj = 0; bj < 2; ++bj) {
                    const int row = row0 + ai * HALF + m * 16, col = col0 + bj * HALF;
                    const bf16_t* zp = zg + (size_t)row * NZ + col + u.seg * 2048;
                    float ga[8]; unpack8(*(const u32x4*)zp, ga);
                    if (u.seg < 2) {
                        float gb[8]; unpack8(*(const u32x4*)(zp + 2048), gb);
#pragma unroll
                        for (int e = 0; e < 8; ++e) { const float ea = __expf(-fminf(fmaxf(ga[e], -30.f), 30.f)), eb = __expf(-fminf(fmaxf(gb[e], -30.f), 30.f));
                            const float ratio = (1.f + eb) / (1.f + ea); acc[ai][bj][m][e >> 2][e & 3] *= ratio; }
                    } else {
                        float r[8];
#pragma unroll
                        for (int e = 0; e < 8; ++e) r[e] = acc[ai][bj][m][e >> 2][e & 3] / (1.f + __expf(-fminf(fmaxf(ga[e], -30.f), 30.f)));
                        u32x4 w; w.x = cvt_pk_bf16(r[0], r[1]); w.y = cvt_pk_bf16(r[2], r[3]); w.z = cvt_pk_bf16(r[4], r[5]); w.w = cvt_pk_bf16(r[6], r[7]);
                        *(u32x4*)(y + (size_t)row * DM + col) = w;
                    }
                    __builtin_amdgcn_sched_barrier(0);
                }
    }
};
struct EpiOut {
    static constexpr bool PERM = true, AFTER_DRAIN = false;
    const float* xlat; const float* xctx; float* xnew; const float* mod;
    __device__ __forceinline__ void operator()(const f32x4 (&acc)[2][2][4][2], const Unit& u, int wr, int wc, int fr, int fq) const {
        const int row0 = u.pm * BM + wr * 64 + fr, col0 = u.pn * BM + wc * 32 + 8 * fq;
        const int tile_row = u.pm * BM; const int mr = tile_row < ML ? tile_row / SEQ : 4;
        const float* xo = tile_row < ML ? xlat : (xctx - (size_t)ML * DM);
        const float* gm = mod + mr * 6144 + 4096;
#pragma unroll
        for (int ai = 0; ai < 2; ++ai)
#pragma unroll
            for (int m = 0; m < 4; ++m)
#pragma unroll
                for (int bj = 0; bj < 2; ++bj) {
                    const int row = row0 + ai * HALF + m * 16, col = col0 + bj * HALF;
                    const f32x4 g0 = *(const f32x4*)(gm + col), g1 = *(const f32x4*)(gm + col + 4);
                    const float* xp = xo + (size_t)row * DM + col;
                    const f32x4 r0 = *(const f32x4*)xp + g0 * acc[ai][bj][m][0], r1 = *(const f32x4*)(xp + 4) + g1 * acc[ai][bj][m][1];
                    float* op = xnew + (size_t)row * DM + col;
                    *(f32x4*)op = r0; *(f32x4*)(op + 4) = r1;
                    __builtin_amdgcn_sched_barrier(0);
                }
    }
};
}

struct Args { const float* in[26]; float* out; unsigned char* ws; int ph_lo, ph_hi; };
enum { I_X = 0, I_C, I_CTX, I_CCTX, I_NORMG, I_WADA, I_BADA, I_WIN, I_POOLW, I_POOLS, I_QNORM, I_KNORM, I_LQ1, I_LK1, I_LQ2, I_LK2, I_SUBLN, I_WGF, I_BGF, I_WGB, I_BGB, I_GLAN, I_WBP, I_WBD, I_WBG, I_WOUT };

__device__ __forceinline__ const float* inp(int i) { const float* const volatile __attribute__((address_space(4)))* kp = (const float* const volatile __attribute__((address_space(4)))*)__builtin_amdgcn_kernarg_segment_ptr(); return kp[i]; }
__device__ __forceinline__ float* arg_out() { float* const volatile __attribute__((address_space(4)))* kp = (float* const volatile __attribute__((address_space(4)))*)__builtin_amdgcn_kernarg_segment_ptr(); return kp[26]; }
__device__ __forceinline__ void transpose_item(const float* W, int K, int N, bf16_t* WT, int row_off, LAS float* scr, int kb, int nb, int lane) {
    const int k0 = 64 * kb, n0 = 32 * nb;
    float tv[32];
#pragma unroll
    for (int i = 0; i < 32; ++i) { const int kk = 2 * i + (lane >> 5); tv[i] = __builtin_nontemporal_load(W + (size_t)(k0 + kk) * N + n0 + (lane & 31)); }
#pragma unroll
    for (int i = 0; i < 32; ++i) { const int kk = 2 * i + (lane >> 5); scr[kk * 33 + (lane & 31)] = tv[i]; }
    asm volatile("s_waitcnt lgkmcnt(0)" ::: "memory");
    const int c = lane & 7;
#pragma unroll
    for (int j = 0; j < 4; ++j) { const int n = (lane >> 3) + 8 * j; const LAS float* s = scr + (8 * c) * 33 + n;
        u32x4 o; o.x = cvt_pk_bf16(s[0 * 33], s[1 * 33]); o.y = cvt_pk_bf16(s[2 * 33], s[3 * 33]); o.z = cvt_pk_bf16(s[4 * 33], s[5 * 33]); o.w = cvt_pk_bf16(s[6 * 33], s[7 * 33]);
        *(u32x4*)(WT + (size_t)(row_off + n0 + n) * K + k0 + 8 * c) = o; }
    asm volatile("s_waitcnt lgkmcnt(0)" ::: "memory");
}

__device__ __forceinline__ void phase_p0(const Args& a, LAS unsigned char* lds) {
    const int tid = opaque_tid(), lane = tid & 63, wave = __builtin_amdgcn_readfirstlane(tid >> 6), G = opaque_s(gridDim.x);
    unsigned char* ws = opaque_ptr(a.ws);
    {
        LAS float* sc = (LAS float*)(lds + 69632);
        LAS float* part = (LAS float*)(lds + 69632 + 40960);
        if (BID < 192) {
            for (int i = tid; i < 5 * 2048; i += 512) { const int r = i >> 11, k = i & 2047; const float v = r < 4 ? inp(I_C)[r * 2048 + k] : inp(I_CCTX)[k]; sc[i] = silu_f(v); }
            __syncthreads();
        }
        for (int it = BID; it < 192; it += G) {
            const int l = it / 96, cgp = it % 96, col = cgp * 64 + lane;
            const float* W = inp(I_WADA) + (size_t)l * 2048 * 6144 + col;
            float acc[5] = {0.f, 0.f, 0.f, 0.f, 0.f};
#pragma unroll 32
            for (int kk = 0; kk < 256; ++kk) { const int k = wave * 256 + kk; const float wv = __builtin_nontemporal_load(W + (size_t)k * 6144);
#pragma unroll
                for (int r = 0; r < 5; ++r) acc[r] += sc[r * 2048 + k] * wv; }
#pragma unroll
            for (int r = 0; r < 5; ++r) part[(wave * 5 + r) * 64 + lane] = acc[r];
            __syncthreads();
            if (tid < 320) { const int r = tid >> 6, ln = tid & 63; float s = inp(I_BADA)[l * 6144 + cgp * 64 + ln];
#pragma unroll
                for (int w = 0; w < 8; ++w) s += part[(w * 5 + r) * 64 + ln];
                ((float*)(ws + OFF_MOD))[(l * 5 + r) * 6144 + cgp * 64 + ln] = s; }
            __syncthreads();
        }
    }
    if (BID == G - 1 && wave == 0) {
        for (int l = 0; l < 2; ++l) {
            const float s1 = wave_sum(inp(I_LQ1)[l * 64 + lane] * inp(I_LK1)[l * 64 + lane]);
            const float s2 = wave_sum(inp(I_LQ2)[l * 64 + lane] * inp(I_LK2)[l * 64 + lane]);
            const float mq = wave_max(fabsf(inp(I_QNORM)[l * 64 + lane])), mk = wave_max(fabsf(inp(I_KNORM)[l * 64 + lane]));
            const float lam_init = 0.8f - 0.6f * expf(-0.3f * (float)l);
            if (lane == 0) { float* sp = (float*)(ws + OFF_SCAL) + l * 4; sp[0] = expf(s1) - expf(s2) + lam_init; sp[1] = 8.f * LOG2E * mq * mk; sp[2] = lam_init; sp[3] = 0.f; }
        }
    }
    {
        const int nper = 224 * 2048 * 2 / 16;
        for (int i = BID * 512 + tid; i < 2 * nper; i += G * 512) { const int l = i / nper, j = i % nper;
            *(u32x4*)(ws + OFF_WIN + (size_t)l * SZ_WIN + (size_t)9248 * DM * 2 + (size_t)j * 16) = (u32x4){0u, 0u, 0u, 0u}; }
    }
    {
        LAS float* scr = (LAS float*)(lds + wave * 8704);
        const int gw = BID * 8 + wave, NGW = G * 8;
        constexpr int I_IN = 32 * 481, I_B = 16 * 64, I_O = 32 * 64, I_P = 4 * 32, PER_L = I_IN + 3 * I_B + I_O + I_P;
        for (int it = gw; it < 2 * PER_L; it += NGW) {
            const int l = it / PER_L; int r = it % PER_L;
            if (r < I_IN) { const int kb = r / 481, nb = r % 481;
                transpose_item(inp(I_WIN) + (size_t)l * DM * DIN, DM, DIN, (bf16_t*)(ws + OFF_WIN + (size_t)l * SZ_WIN), nb >= 289 ? 224 : 0, scr, kb, nb, lane); continue; }
            r -= I_IN;
            if (r < 3 * I_B) { const int br = r / I_B, rr = r % I_B; const float* W = (br == 0 ? inp(I_WBP) : br == 1 ? inp(I_WBD) : inp(I_WBG)) + (size_t)l * 1024 * DM;
                transpose_item(W, 1024, DM, (bf16_t*)(ws + OFF_WB + (size_t)l * SZ_WB + (size_t)br * DM * 1024 * 2), 0, scr, rr / 64, rr % 64, lane); continue; }
            r -= 3 * I_B;
            if (r < I_O) { transpose_item(inp(I_WOUT) + (size_t)l * DM * DM, DM, DM, (bf16_t*)(ws + OFF_WOUT + (size_t)l * SZ_WOUT), 0, scr, r / 64, r % 64, lane); continue; }
            r -= I_O;
            { const int g = r / 32, rr = r % 32;
              transpose_item(inp(I_POOLW) + (size_t)(l * 4 + g) * 65536, 256, 256, (bf16_t*)(ws + OFF_POOLT + (size_t)l * SZ_POOLT + (size_t)g * 65536 * 2), 0, scr, rr / 8, rr % 8, lane); }
        }
    }
}

__device__ __forceinline__ void phase_norm(const Args& a, int l) {
    const int tid = opaque_tid(), lane = tid & 63, wave = tid >> 6, G = opaque_s(gridDim.x);
    const int gw = BID * 8 + wave, NGW = G * 8;
    const float* mod = (const float*)(opaque_ptr(a.ws) + OFF_MOD) + (size_t)l * 5 * 6144;
    const float* x1 = (const float*)(opaque_ptr(a.ws) + OFF_X1);
    bf16_t* h = (bf16_t*)(opaque_ptr(a.ws) + OFF_H);
    const float* ng = inp(I_NORMG) + l * DM;
    for (int row = gw; row < MT; row += NGW) {
        const float* src = (l == 0) ? (row < ML ? inp(I_X) + (size_t)row * DM : inp(I_CTX) + (size_t)(row - ML) * DM) : x1 + (size_t)row * DM;
        const int mr = row < ML ? row / SEQ : 4;
        const float* md = mod + mr * 6144;
        f32x4 v[8]; float ss = 0.f;
#pragma unroll
        for (int j = 0; j < 8; ++j) { v[j] = *(const f32x4*)(src + 4 * lane + 256 * j); ss += (v[j][0] * v[j][0] + v[j][1] * v[j][1]) + (v[j][2] * v[j][2] + v[j][3] * v[j][3]); }
        ss = wave_sum(ss);
        const float rstd = rsqrtf(ss * (1.f / DM) + EPS);
#pragma unroll
        for (int j = 0; j < 8; ++j) { const int idx = 4 * lane + 256 * j;
            const f32x4 gg = *(const f32x4*)(ng + idx), sc = *(const f32x4*)(md + 2048 + idx), sh = *(const f32x4*)(md + idx);
            f32x4 o;
#pragma unroll
            for (int e = 0; e < 4; ++e) o[e] = v[j][e] * rstd * gg[e] * (1.f + sc[e]) + sh[e];
            u32x2 w; w.x = cvt_pk_bf16(o[0], o[1]); w.y = cvt_pk_bf16(o[2], o[3]);
            *(u32x2*)(h + (size_t)row * DM + idx) = w; }
    }
}

__device__ __forceinline__ int vt_pos(int key) { const int k = key & 15; return (key & ~15) | (((k >> 2) & 1) << 3) | (k & 3) | (((k >> 3) & 1) << 2); }

__device__ __forceinline__ void phase_prep(const Args& a, int l, LAS unsigned char* lds) {
    const int tid = opaque_tid(), lane = tid & 63, wave = tid >> 6, G = opaque_s(gridDim.x);
    unsigned char* ws = opaque_ptr(a.ws);
    const bf16_t* z = (const bf16_t*)(ws + OFF_Z);
    const bool need_ctx = (l == 0);
    for (int it = BID; it < 2016; it += G) {
        if (it < 1152) {
            const int c = it >> 3, cgp = it & 7, rb = 64 * c;
            LAS float* lrs = (LAS float*)lds;
            LAS float* segs = (LAS float*)(lds + 8192);
            for (int i = tid; i < 64 * 32; i += 512) { const int r = i >> 5, cc = i & 31; lrs[i] = bf2f(z[(size_t)(rb + r) * NZ + ZC_LR + cc]); }
            __syncthreads();
            const int seg = tid >> 6, chl = tid & 63, ch = cgp * 64 + chl;
            float wf[16], wb[16];
#pragma unroll
            for (int r = 0; r < 16; ++r) { wf[r] = inp(I_WGF)[(size_t)l * 16 * 512 + r * 512 + ch]; wb[r] = inp(I_WGB)[(size_t)l * 16 * 512 + r * 512 + ch]; }
            const float bfv = inp(I_BGF)[l * 512 + ch], bbv = inp(I_BGB)[l * 512 + ch];
            float gf[8], gb[8]; float sf = 0.f, sb = 0.f;
#pragma unroll
            for (int i = 0; i < 8; ++i) { const int t = seg * 8 + i; float af = bfv, ab = bbv;
#pragma unroll
                for (int r4 = 0; r4 < 4; ++r4) { const f32x4 lf = *(const LAS f32x4*)(lrs + t * 32 + 4 * r4), lb = *(const LAS f32x4*)(lrs + t * 32 + 16 + 4 * r4);
#pragma unroll
                    for (int e = 0; e < 4; ++e) { af += lf[e] * wf[4 * r4 + e]; ab += lb[e] * wb[4 * r4 + e]; } }
                gf[i] = logsig_f(af) * (1.f / 16.f); gb[i] = logsig_f(ab) * (1.f / 16.f); sf += gf[i]; sb += gb[i]; }
            segs[seg * 64 + chl] = sf; segs[512 + seg * 64 + chl] = sb;
            __syncthreads();
            float pf = 0.f, pb = 0.f, totf = 0.f, totb = 0.f;
#pragma unroll
            for (int s2 = 0; s2 < 8; ++s2) { const float vf = segs[s2 * 64 + chl], vb = segs[512 + s2 * 64 + chl]; totf += vf; totb += vb; if (s2 < seg) { pf += vf; pb += vb; } }
            bf16_t* gq0 = (bf16_t*)(ws + OFF_GQ), *gq1 = (bf16_t*)(ws + OFF_GQ + SZ_G);
            bf16_t* gk0 = (bf16_t*)(ws + OFF_GK), *gk1 = (bf16_t*)(ws + OFF_GK + SZ_G);
            bf16_t* gh0 = (bf16_t*)(ws + OFF_GH), *gh1 = (bf16_t*)(ws + OFF_GH + SZ_G);
            float h0[8], h1[8];
#pragma unroll
            for (int i = 0; i < 8; ++i) { const int t = seg * 8 + i;
                pf += gf[i]; const float bs = totb - pb; pb += gb[i];
                const size_t row = rb + t;
                const float q = bf2f(z[row * NZ + ZC_GQ + ch]) * 0.08838834764831845f, k = bf2f(z[row * NZ + ZC_GK + ch]);
                const size_t o = row * 512 + ch;
                gq0[o] = f2bf(q * __expf(pf)); gk0[o] = f2bf(k * __expf(-pf)); h0[i] = k * __expf(totf - pf);
                gq1[o] = f2bf(q * __expf(bs)); gk1[o] = f2bf(k * __expf(-bs)); h1[i] = k * __expf(totb - bs); }
            { u32x4 w0, w1;
              w0.x = cvt_pk_bf16(h0[0], h0[1]); w0.y = cvt_pk_bf16(h0[2], h0[3]); w0.z = cvt_pk_bf16(h0[4], h0[5]); w0.w = cvt_pk_bf16(h0[6], h0[7]);
              w1.x = cvt_pk_bf16(h1[0], h1[1]); w1.y = cvt_pk_bf16(h1[2], h1[3]); w1.z = cvt_pk_bf16(h1[4], h1[5]); w1.w = cvt_pk_bf16(h1[6], h1[7]);
              const size_t oh = ((size_t)c * 512 + ch) * 64 + seg * 8;
              *(u32x4*)(gh0 + oh) = w0; *(u32x4*)(gh1 + oh) = w1; }
            if (seg == 0) { float* dec = (float*)(ws + OFF_DEC); dec[(size_t)c * 512 + ch] = __expf(totf); dec[(size_t)(144 + c) * 512 + ch] = __expf(totb); }
            __syncthreads();
        } else if (it < 1440) {
            const int rb = 32 * (it - 1152); if (!need_ctx && rb >= ML) continue;
            const int seq0 = rb < ML ? (rb / SEQ) * SEQ : ML + ((rb - ML) / LC) * LC; const int L = rb < ML ? SEQ : LC;
            bf16_t* dp = (bf16_t*)(ws + OFF_DPOOL); bf16_t* pgt = (bf16_t*)(ws + OFF_PGATE);
            const int ch8 = 8 * (tid & 127), tg = tid >> 7, hw = 1 << (ch8 >> 8);
            const int tl0 = rb - seq0 + 8 * tg;
            float psc[8];
#pragma unroll
            for (int e = 0; e < 8; ++e) psc[e] = inp(I_POOLS)[l * 1024 + ch8 + e];
            const bf16_t* zc = z + (size_t)seq0 * NZ + ZC_PU + ch8;
            float sm[8] = {0.f, 0.f, 0.f, 0.f, 0.f, 0.f, 0.f, 0.f};
            { const int lo = max(tl0 - hw, 0), hi = min(tl0 + hw, L);
              for (int p = lo; p < hi; ++p) { float u[8]; unpack8(*(const u32x4*)(zc + (size_t)p * NZ), u);
#pragma unroll
                  for (int e = 0; e < 8; ++e) sm[e] += u[e]; } }
#pragma unroll
            for (int t = 0; t < 8; ++t) { const int tl = tl0 + t; const int lo = max(tl - hw, 0), hi = min(tl + hw, L);
                const float rc = 1.f / (float)(hi - lo);
                float cur[8], pgv[8], ua[8], ur[8];
                unpack8(*(const u32x4*)(zc + (size_t)tl * NZ), cur); unpack8(*(const u32x4*)(zc + (size_t)tl * NZ + (ZC_PG - ZC_PU)), pgv);
                unpack8(*(const u32x4*)(zc + (size_t)min(tl + hw, L - 1) * NZ), ua); unpack8(*(const u32x4*)(zc + (size_t)max(tl - hw, 0) * NZ), ur);
                const float ma = (tl + hw < L) ? 1.f : 0.f, mr = (tl - hw >= 0) ? 1.f : 0.f;
                u32x4 wd, wg;
                wd.x = cvt_pk_bf16(sm[0] * rc - cur[0], sm[1] * rc - cur[1]); wd.y = cvt_pk_bf16(sm[2] * rc - cur[2], sm[3] * rc - cur[3]);
                wd.z = cvt_pk_bf16(sm[4] * rc - cur[4], sm[5] * rc - cur[5]); wd.w = cvt_pk_bf16(sm[6] * rc - cur[6], sm[7] * rc - cur[7]);
                wg.x = cvt_pk_bf16(psc[0] * silu_f(pgv[0]), psc[1] * silu_f(pgv[1])); wg.y = cvt_pk_bf16(psc[2] * silu_f(pgv[2]), psc[3] * silu_f(pgv[3]));
                wg.z = cvt_pk_bf16(psc[4] * silu_f(pgv[4]), psc[5] * silu_f(pgv[5])); wg.w = cvt_pk_bf16(psc[6] * silu_f(pgv[6]), psc[7] * silu_f(pgv[7]));
                const size_t o = (size_t)(seq0 + tl) * 1024 + ch8;
                *(u32x4*)(dp + o) = wd; *(u32x4*)(pgt + o) = wg;
#pragma unroll
                for (int e = 0; e < 8; ++e) sm[e] += ma * ua[e] - mr * ur[e]; }
        } else {
            const int vi = it - 1440, isg = vi >= 288, vj = isg ? vi - 288 : vi, c = vj >> 1, hv = vj & 1, rb = 64 * c;
            int b, key0; if (rb < ML) { b = rb >> 11; key0 = LC + (rb & 2047); } else { b = (rb - ML) >> 8; key0 = (rb - ML) & 255; }
            bf16_t* vT = (bf16_t*)(ws + OFF_VT); bf16_t* gvT = (bf16_t*)(ws + OFF_GVT);
#pragma unroll
            for (int i = 0; i < 8; ++i) { const int idx = tid + 512 * i, key = idx & 63, c8 = (idx >> 6) * 8;
                const u32x4 w = *(const u32x4*)(z + (size_t)(rb + key) * NZ + (isg ? ZC_GV : ZC_DV) + hv * 512 + c8);
                const unsigned ww[4] = {w.x, w.y, w.z, w.w}; const int pos = isg ? key : vt_pos(key);
#pragma unroll
                for (int e = 0; e < 8; ++e) *(LAS bf16_t*)(lds + (c8 + e) * 144 + pos * 2) = (bf16_t)((e & 1) ? (ww[e >> 1] >> 16) : (ww[e >> 1] & 0xffffu)); }
            __syncthreads();
#pragma unroll
            for (int i = 0; i < 8; ++i) { const int idx = tid + 512 * i, col = idx >> 3, k8 = idx & 7, colg = hv * 512 + col, h = colg >> 7, v = colg & 127;
                bf16_t* dst = isg ? gvT + ((size_t)c * 1024 + colg) * 64 + k8 * 8 : vT + ((size_t)(b * 8 + h) * 128 + v) * LK + key0 + k8 * 8;
                *(u32x4*)dst = *(const LAS u32x4*)(lds + col * 144 + k8 * 16); }
            __syncthreads();
        }
    }
    {
        const int gw = BID * 8 + wave, NGW = G * 8;
        bf16_t* qn = (bf16_t*)(ws + OFF_QN); bf16_t* qnc = (bf16_t*)(ws + OFF_QNC); bf16_t* kn = (bf16_t*)(ws + OFF_KN);
        for (int it = gw; it < MT * 2; it += NGW) {
            const int row = it >> 1, which = it & 1;
            const bool isctx = row >= ML; int b, t; if (!isctx) { b = row >> 11; t = row & 2047; } else { b = (row - ML) >> 8; t = (row - ML) & 255; }
            const bf16_t* zr = z + (size_t)row * NZ;
            {
                if (which == 0 && isctx && !need_ctx) continue;
                float x[16]; const bf16_t* src = zr + (which == 0 ? ZC_DQ : ZC_DK) + 16 * lane;
                unpack8(*(const u32x4*)src, x); unpack8(*(const u32x4*)(src + 8), x + 8);
                float ss = 0.f;
#pragma unroll
                for (int e = 0; e < 16; ++e) ss += x[e] * x[e];
                ss += __shfl_xor(ss, 1); ss += __shfl_xor(ss, 2);
                const float rstd = rsqrtf(ss * (1.f / 64.f) + EPS);
                const int m = lane & 3, sh = lane >> 2, h = sh >> 1, j = sh & 1;
                const float* gain = (which == 0 ? inp(I_QNORM) : inp(I_KNORM)) + l * 64 + 16 * m;
                float y[16];
#pragma unroll
                for (int e = 0; e < 16; ++e) y[e] = x[e] * rstd * gain[e];
                if (!isctx) {
                    const float posf = (float)((m & 1) ? (t & 63) : (t >> 6));
#pragma unroll
                    for (int e = 0; e < 16; ++e) { const float yp = __shfl_xor(y[e], 2);
                        const float ang = posf * exp2f(-(float)e * 0.8304820237218405f);
                        const float cs = __cosf(ang), sn = __sinf(ang);
                        y[e] = (m < 2) ? (y[e] * cs - yp * sn) : (y[e] * cs + yp * sn); }
                }
                bf16_t* dst;
                if (which == 0) {
#pragma unroll
                    for (int e = 0; e < 16; ++e) y[e] *= 0.125f * LOG2E;
                    dst = isctx ? qnc + (((size_t)(b * 8 + h) * 2 + j) * LC + t) * 64 + 16 * m : qn + (((size_t)(b * 8 + h) * 2 + j) * SEQ + t) * 64 + 16 * m;
                } else dst = kn + (((size_t)(b * 8 + h) * 2 + j) * LK + (isctx ? t : LC + t)) * 64 + 16 * m;
                u32x4 w0, w1;
                w0.x = cvt_pk_bf16(y[0], y[1]); w0.y = cvt_pk_bf16(y[2], y[3]); w0.z = cvt_pk_bf16(y[4], y[5]); w0.w = cvt_pk_bf16(y[6], y[7]);
                w1.x = cvt_pk_bf16(y[8], y[9]); w1.y = cvt_pk_bf16(y[10], y[11]); w1.z = cvt_pk_bf16(y[12], y[13]); w1.w = cvt_pk_bf16(y[14], y[15]);
                *(u32x4*)dst = w0; *(u32x4*)(dst + 8) = w1;
            }
        }
    }
}

constexpr int GL_Q = 0, GL_K = 17408, GL_KH = 34816, GL_VT = 53248, GL_ATT = 57856, GL_ST = 67072;
__device__ __forceinline__ void gla_unit(const Args& a, int l, LAS unsigned char* lds, int item) {
    const int tid = opaque_tid(), lane = tid & 63, w = __builtin_amdgcn_readfirstlane(tid >> 6);
    const int vs = item & 7, dir = (item >> 3) & 1, h = (item >> 4) & 3, b = item >> 6;
    const bool need_ctx = (l == 0);
    unsigned char* ws = opaque_ptr(a.ws);
    const bf16_t* z = (const bf16_t*)(ws + OFF_Z);
    const bf16_t* gq = (const bf16_t*)(ws + OFF_GQ + dir * SZ_G) + h * 128;
    const bf16_t* gk = (const bf16_t*)(ws + OFF_GK + dir * SZ_G) + h * 128;
    const bf16_t* gh = (const bf16_t*)(ws + OFF_GH + dir * SZ_G) + (size_t)h * 128 * 64;
    const float* dec = (const float*)(ws + OFF_DEC) + (size_t)dir * 144 * 512 + h * 128;
    bf16_t* od = (bf16_t*)(ws + OFF_OF + (size_t)dir * MT * 1024 * 2) + h * 256 + vs * 32;
    const bf16_t* gvt = (const bf16_t*)(ws + OFF_GVT) + (size_t)(h * 256 + vs * 32) * 64;
    const int fr = lane & 15, fq = lane >> 4;
    f32x4 sacc[2] = {(f32x4){0.f, 0.f, 0.f, 0.f}, (f32x4){0.f, 0.f, 0.f, 0.f}};
    for (int i = tid; i < 32 * 136 / 2; i += 512) ((LAS unsigned*)(lds + GL_ST))[i] = 0u;
    u32x4 rq[2], rk[2], rh[2], rv; float rdec;
    auto rowbase = [&](int s) -> int { if (s < 4) { const int ci = dir == 0 ? s : 3 - s; return ML + b * LC + 64 * ci; } const int ci = dir == 0 ? s - 4 : 35 - s; return b * SEQ + 64 * ci; };
#define GLA_LOAD(s) do { const int _rb = rowbase(s); _Pragma("unroll") for (int _i = 0; _i < 2; ++_i) { const int _idx = tid + 512 * _i, _r = _idx >> 4, _c = (_idx & 15) * 8; const size_t _o = (size_t)(_rb + _r) * 512 + _c; \
        rq[_i] = *(const u32x4*)(gq + _o); rk[_i] = *(const u32x4*)(gk + _o); rh[_i] = *(const u32x4*)(gh + ((size_t)(_rb >> 6) * 512 + (_idx >> 3)) * 64 + (_idx & 7) * 8); } \
        if (tid < 256) rv = *(const u32x4*)(gvt + ((size_t)(_rb >> 6) * 1024 + (tid >> 3)) * 64 + (tid & 7) * 8); \
        rdec = dec[(size_t)(_rb >> 6) * 512 + 16 * w + fr]; } while (0)
    GLA_LOAD(0);
    for (int s = 0; s < 36; ++s) {
        const int rb = rowbase(s);
        const float dk = rdec;
#pragma unroll
        for (int i = 0; i < 2; ++i) { const int idx = tid + 512 * i, r = idx >> 4, c = (idx & 15) * 8;
            *(LAS u32x4*)(lds + GL_Q + r * 272 + c * 2) = rq[i]; *(LAS u32x4*)(lds + GL_K + r * 272 + c * 2) = rk[i];
            *(LAS u32x4*)(lds + GL_KH + (idx >> 3) * 144 + (idx & 7) * 16) = rh[i]; }
        if (tid < 256) *(LAS u32x4*)(lds + GL_VT + (tid >> 3) * 144 + (tid & 7) * 16) = rv;
        __syncthreads();
        if (s + 1 < 36) GLA_LOAD(s + 1);
        {
            const int tt = w >> 1;
#pragma unroll
            for (int si = 0; si < 2; ++si) { const int st = 2 * (w & 1) + si; f32x4 acc = (f32x4){0.f, 0.f, 0.f, 0.f};
#pragma unroll
                for (int kk = 0; kk < 4; ++kk) { const bf16x8 af = *(const LAS bf16x8*)(lds + GL_Q + (16 * tt + fr) * 272 + (32 * kk + 8 * fq) * 2);
                    const bf16x8 bfr = *(const LAS bf16x8*)(lds + GL_K + (16 * st + fr) * 272 + (32 * kk + 8 * fq) * 2);
                    acc = __builtin_amdgcn_mfma_f32_16x16x32_bf16(af, bfr, acc, 0, 0, 0); }
#pragma unroll
                for (int j = 0; j < 4; ++j) { const int t = 16 * tt + 4 * fq + j, sc = 16 * st + fr; const bool keep = dir == 0 ? (sc <= t) : (sc >= t);
                    *(LAS bf16_t*)(lds + GL_ATT + t * 144 + sc * 2) = f2bf(keep ? acc[j] : 0.f); } }
        }
#pragma unroll
        for (int vt = 0; vt < 2; ++vt) { f32x4 acc = sacc[vt] * dk;
#pragma unroll
            for (int kk = 0; kk < 2; ++kk) { const bf16x8 af = *(const LAS bf16x8*)(lds + GL_VT + (16 * vt + fr) * 144 + (32 * kk + 8 * fq) * 2);
                const bf16x8 bfr = *(const LAS bf16x8*)(lds + GL_KH + (16 * w + fr) * 144 + (32 * kk + 8 * fq) * 2);
                acc = __builtin_amdgcn_mfma_f32_16x16x32_bf16(af, bfr, acc, 0, 0, 0); }
            sacc[vt] = acc; }
        __syncthreads();
        {
            const int tt = w >> 1, vt = w & 1; f32x4 acc = (f32x4){0.f, 0.f, 0.f, 0.f};
#pragma unroll
            for (int kk = 0; kk < 4; ++kk) { const bf16x8 af = *(const LAS bf16x8*)(lds + GL_Q + (16 * tt + fr) * 272 + (32 * kk + 8 * fq) * 2);
                const bf16x8 bfr = *(const LAS bf16x8*)(lds + GL_ST + (16 * vt + fr) * 272 + (32 * kk + 8 * fq) * 2);
                acc = __builtin_amdgcn_mfma_f32_16x16x32_bf16(af, bfr, acc, 0, 0, 0); }
#pragma unroll
            for (int kk = 0; kk < 2; ++kk) { const bf16x8 af = *(const LAS bf16x8*)(lds + GL_ATT + (16 * tt + fr) * 144 + (32 * kk + 8 * fq) * 2);
                const bf16x8 bfr = *(const LAS bf16x8*)(lds + GL_VT + (16 * vt + fr) * 144 + (32 * kk + 8 * fq) * 2);
                acc = __builtin_amdgcn_mfma_f32_16x16x32_bf16(af, bfr, acc, 0, 0, 0); }
            if (s >= 4 || need_ctx) {
#pragma unroll
                for (int j = 0; j < 4; ++j) od[(size_t)(rb + 16 * tt + 4 * fq + j) * 1024 + 16 * vt + fr] = f2bf(acc[j]); }
        }
        __syncthreads();
#pragma unroll
        for (int vt = 0; vt < 2; ++vt)
#pragma unroll
            for (int j = 0; j < 4; ++j) *(LAS bf16_t*)(lds + GL_ST + (16 * vt + 4 * fq + j) * 272 + (16 * w + fr) * 2) = f2bf(sacc[vt][j]);
    }
    __syncthreads();
#undef GLA_LOAD
}

constexpr int AT_BUF = 36864, AT_K = 0, AT_V = 18432;
__device__ __forceinline__ void attn_unit(LAS unsigned char* lds, const bf16_t* qbase, int Lq, int q0, const bf16_t* kbase, const bf16_t* vtbase, int nkeys,
                                          float c2, float lam, float post_scale, const float* subln, const bf16_t* dg, bf16_t* outp, int row0) {
    const int tid = opaque_tid(), lane = tid & 63, w = __builtin_amdgcn_readfirstlane(tid >> 6), q32 = lane & 31, hi = lane >> 5;
    const int j = w >> 2, qg = w & 3;
    bf16x8 qf[4];
#pragma unroll
    for (int kk = 0; kk < 4; ++kk) qf[kk] = *(const bf16x8*)(qbase + ((size_t)j * Lq + q0 + 32 * qg + q32) * 64 + 16 * kk + 8 * hi);
    f32x16 o[4];
#pragma unroll
    for (int vt = 0; vt < 4; ++vt)
#pragma unroll
        for (int r = 0; r < 16; ++r) o[vt][r] = 0.f;
    float lsum = 0.f;
    const int nt = nkeys >> 6;
    u32x4 skA[2], svA[2], skB[2], svB[2];
#define AT_LOAD(sk, sv, i) do { _Pragma("unroll") for (int _c = 0; _c < 2; ++_c) { const int _idx = tid + 512 * _c; \
        sk[_c] = *(const u32x4*)(kbase + ((size_t)(_idx >> 9) * LK + 64 * (i) + ((_idx & 511) >> 3)) * 64 + (_idx & 7) * 8); \
        sv[_c] = *(const u32x4*)(vtbase + (size_t)(_idx >> 3) * LK + 64 * (i) + (_idx & 7) * 8); } } while (0)
#define AT_STORE(sk, sv, p) do { _Pragma("unroll") for (int _c = 0; _c < 2; ++_c) { const int _idx = tid + 512 * _c; \
        *(LAS u32x4*)(lds + (p) * AT_BUF + AT_K + ((_idx >> 9) * 64 + ((_idx & 511) >> 3)) * 144 + (_idx & 7) * 16) = sk[_c]; \
        *(LAS u32x4*)(lds + (p) * AT_BUF + AT_V + (_idx >> 3) * 144 + (_idx & 7) * 16) = sv[_c]; } } while (0)
#define AT_TILE(p) do { \
        LAS unsigned char* Kb = lds + (p) * AT_BUF + AT_K + j * (64 * 144); LAS unsigned char* Vb = lds + (p) * AT_BUF + AT_V; \
        _Pragma("unroll") for (int kb = 0; kb < 2; ++kb) { \
            f32x16 s; \
            _Pragma("unroll") for (int r = 0; r < 16; ++r) s[r] = -c2; \
            _Pragma("unroll") for (int kk = 0; kk < 4; ++kk) { \
                const bf16x8 a0 = *(const LAS bf16x8*)(Kb + (32 * kb + q32) * 144 + (16 * kk + 8 * hi) * 2); \
                s = __builtin_amdgcn_mfma_f32_32x32x16_bf16(a0, qf[kk], s, 0, 0, 0); } \
            _Pragma("unroll") for (int r = 0; r < 16; ++r) { s[r] = __builtin_amdgcn_exp2f(s[r]); lsum += s[r]; } \
            _Pragma("unroll") for (int hf = 0; hf < 2; ++hf) { \
                const int ks = 2 * kb + hf; \
                u32x4 pw; \
                pw.x = cvt_pk_bf16(s[8 * hf + 0], s[8 * hf + 1]); pw.y = cvt_pk_bf16(s[8 * hf + 2], s[8 * hf + 3]); pw.z = cvt_pk_bf16(s[8 * hf + 4], s[8 * hf + 5]); pw.w = cvt_pk_bf16(s[8 * hf + 6], s[8 * hf + 7]); \
                const bf16x8 pb = __builtin_bit_cast(bf16x8, pw); \
                _Pragma("unroll") for (int vt = 0; vt < 4; ++vt) { \
                    const bf16x8 av = *(const LAS bf16x8*)(Vb + (32 * vt + q32) * 144 + (16 * ks + 8 * hi) * 2); \
                    o[vt] = __builtin_amdgcn_mfma_f32_32x32x16_bf16(av, pb, o[vt], 0, 0, 0); } } } } while (0)
    AT_LOAD(skA, svA, 0); AT_STORE(skA, svA, 0);
    AT_LOAD(skA, svA, 1);
    __syncthreads();
    for (int i = 0; i < nt; i += 2) {
        if (i + 2 < nt) AT_LOAD(skB, svB, i + 2);
        AT_TILE(0);
        AT_STORE(skA, svA, 1);
        __syncthreads();
        if (i + 3 < nt) AT_LOAD(skA, svA, i + 3);
        AT_TILE(1);
        if (i + 2 < nt) AT_STORE(skB, svB, 0);
        __syncthreads();
    }
#undef AT_TILE
#undef AT_LOAD
#undef AT_STORE
    lsum += __shfl_xor(lsum, 32);
    LAS float* xch = (LAS float*)lds + (size_t)qg * 4096 + lane;
    if (j == 1) {
        const float sc = lam / lsum;
#pragma unroll
        for (int vt = 0; vt < 4; ++vt)
#pragma unroll
            for (int r = 0; r < 16; ++r) xch[(vt * 16 + r) * 64] = o[vt][r] * sc;
    }
    __syncthreads();
    if (j == 0) {
        const float i0 = 1.f / lsum;
        float ss = 0.f;
#pragma unroll
        for (int vt = 0; vt < 4; ++vt)
#pragma unroll
            for (int r = 0; r < 16; ++r) { const float v = o[vt][r] * i0 - xch[(vt * 16 + r) * 64]; o[vt][r] = v; ss += v * v; }
        ss += __shfl_xor(ss, 32);
        const float rstd = rsqrtf(ss * (1.f / 128.f) + EPS) * post_scale;
        const size_t row = (size_t)row0 + 32 * qg + q32;
#pragma unroll
        for (int vt = 0; vt < 4; ++vt)
#pragma unroll
            for (int g4 = 0; g4 < 4; ++g4) {
                const int v0 = 32 * vt + 8 * g4 + 4 * hi;
                const u32x2 gz = *(const u32x2*)(dg + row * NZ + v0);
                const f32x4 sl = *(const f32x4*)(subln + v0);
                const float r0 = o[vt][4 * g4 + 0] * rstd * sl[0] * silu_f(bflo(gz.x)), r1 = o[vt][4 * g4 + 1] * rstd * sl[1] * silu_f(bfhi(gz.x));
                const float r2 = o[vt][4 * g4 + 2] * rstd * sl[2] * silu_f(bflo(gz.y)), r3 = o[vt][4 * g4 + 3] * rstd * sl[3] * silu_f(bfhi(gz.y));
                u32x2 wv; wv.x = cvt_pk_bf16(r0, r1); wv.y = cvt_pk_bf16(r2, r3);
                *(u32x2*)(outp + row * 1024 + v0) = wv;
            }
    }
    __syncthreads();
}

__device__ __forceinline__ void phase_mix(const Args& a, int l, LAS unsigned char* lds) {
    const int G = opaque_s(gridDim.x);
    unsigned char* ws = opaque_ptr(a.ws);
    const bool need_ctx = (l == 0);
#ifndef NO_GLA
    for (int it = BID; it < 256; it += G) gla_unit(a, l, lds, ((it & 7) * 4 + (it >> 6)) * 8 + ((it >> 3) & 7));
#if defined(REPEAT_SUB) && REPEAT_SUB == 1
    for (int it = BID; it < 256; it += G) gla_unit(a, l, lds, it);
#endif
#endif
#ifndef NO_ATT
    {
        const float* scal = (const float*)(ws + OFF_SCAL) + l * 4;
        const float lam = scal[0], c2 = scal[1], post = 1.f - scal[2];
        const bf16_t* z = (const bf16_t*)(ws + OFF_Z);
        const int nun = 512 + (need_ctx ? 64 : 0);
#if defined(REPEAT_SUB) && REPEAT_SUB == 2
        for (int rep = 0; rep < 2; ++rep)
#endif
        for (int u = BID; u < nun; u += G) {
            if (u < 512) { const int vc = (u & 7) * 64 + (u >> 3), bh = vc >> 4, qb = vc & 15, b = bh >> 3, h = bh & 7;
                attn_unit(lds, (const bf16_t*)(ws + OFF_QN) + (size_t)bh * 2 * SEQ * 64, SEQ, 128 * qb, (const bf16_t*)(ws + OFF_KN) + (size_t)bh * 2 * LK * 64,
                          (const bf16_t*)(ws + OFF_VT) + (size_t)bh * 128 * LK, LK, c2, lam, post, inp(I_SUBLN) + l * 128, z + ZC_DG + h * 128, (bf16_t*)(ws + OFF_DIFFO) + h * 128, b * SEQ + 128 * qb);
            } else { const int uu = u - 512, bh = uu >> 1, qb = uu & 1, b = bh >> 3, h = bh & 7;
                attn_unit(lds, (const bf16_t*)(ws + OFF_QNC) + (size_t)bh * 2 * LC * 64, LC, 128 * qb, (const bf16_t*)(ws + OFF_KN) + (size_t)bh * 2 * LK * 64,
                          (const bf16_t*)(ws + OFF_VT) + (size_t)bh * 128 * LK, LC, c2, lam, post, inp(I_SUBLN) + l * 128, z + ZC_DG + h * 128, (bf16_t*)(ws + OFF_DIFFO) + h * 128, ML + b * LC + 128 * qb);
            }
        }
    }
#endif
#ifndef NO_POOL
    {
        const int Mrows = need_ctx ? MT : ML;
        pg8::Gemm g{(const bf16_t*)(ws + OFF_DPOOL), (const bf16_t*)(ws + OFF_POOLT + (size_t)l * SZ_POOLT), Mrows, 1024, 256, 1024, 256, 256};
        pg8::StaticOrder S; S.init(Mrows, 1024, G, BID);
        pg8::EpiPool E{(bf16_t*)(ws + OFF_POOLO), (const bf16_t*)(ws + OFF_PGATE)};
        pg8::gemm_phase<pg8::EpiPool, pg8::StaticOrder, true, true>(lds, g, S, E);
    }
#endif
}

__device__ __forceinline__ void phase_post(const Args& a, int l) {
    const int tid = opaque_tid(), lane = tid & 63, wave = tid >> 6, G = opaque_s(gridDim.x);
    const int gw = BID * 8 + wave, NGW = G * 8;
    unsigned char* ws = opaque_ptr(a.ws);
    const bf16_t* z = (const bf16_t*)(ws + OFF_Z);
    const bf16_t* of = (const bf16_t*)(ws + OFF_OF); const bf16_t* ob = of + (size_t)MT * 1024;
    bf16_t* go = (bf16_t*)(ws + OFF_GLAO);
    const int Mrows = (l == 0) ? MT : ML;
    const float* gn = inp(I_GLAN) + l * 256 + ((16 * lane) & 255);
    for (int row = gw; row < Mrows; row += NGW) {
        float x[16], y[16], gz[16];
        const size_t o = (size_t)row * 1024 + 16 * lane;
        unpack8(*(const u32x4*)(of + o), x); unpack8(*(const u32x4*)(of + o + 8), x + 8);
        unpack8(*(const u32x4*)(ob + o), y); unpack8(*(const u32x4*)(ob + o + 8), y + 8);
        unpack8(*(const u32x4*)(z + (size_t)row * NZ + ZC_GG + 16 * lane), gz); unpack8(*(const u32x4*)(z + (size_t)row * NZ + ZC_GG + 16 * lane + 8), gz + 8);
        float ss = 0.f;
#pragma unroll
        for (int e = 0; e < 16; ++e) { x[e] += y[e]; ss += x[e] * x[e]; }
        ss += __shfl_xor(ss, 1); ss += __shfl_xor(ss, 2); ss += __shfl_xor(ss, 4); ss += __shfl_xor(ss, 8);
        const float rstd = rsqrtf(ss * (1.f / 256.f) + EPS);
        float r[16];
#pragma unroll
        for (int e = 0; e < 16; ++e) r[e] = x[e] * rstd * gn[e] * silu_f(gz[e]);
        u32x4 w0, w1;
        w0.x = cvt_pk_bf16(r[0], r[1]); w0.y = cvt_pk_bf16(r[2], r[3]); w0.z = cvt_pk_bf16(r[4], r[5]); w0.w = cvt_pk_bf16(r[6], r[7]);
        w1.x = cvt_pk_bf16(r[8], r[9]); w1.y = cvt_pk_bf16(r[10], r[11]); w1.z = cvt_pk_bf16(r[12], r[13]); w1.w = cvt_pk_bf16(r[14], r[15]);
        *(u32x4*)(go + o) = w0; *(u32x4*)(go + o + 8) = w1;
    }
}

#define XB_TMO      128
#define XB_XCNT(j)  (256  + 64 * (j))
#define XB_XSUB(j)  (1280 + 64 * (j))
#define XB_XGEN(j)  (2304 + 64 * (j))
#define XB_TOP      3328
#define XB_TOPGEN   3392
#define XCD_BAR_WORDS 3456
#define XB_SPIN_CAP (1u << 18)

__device__ __forceinline__ unsigned xb_ld(unsigned* p)              { return __hip_atomic_load(p, __ATOMIC_RELAXED, __HIP_MEMORY_SCOPE_AGENT); }
__device__ __forceinline__ unsigned xb_add(unsigned* p, unsigned v) { return __hip_atomic_fetch_add(p, v, __ATOMIC_RELAXED, __HIP_MEMORY_SCOPE_AGENT); }
__device__ __forceinline__ unsigned xb_xcc_id() { return (unsigned)__builtin_amdgcn_s_getreg((3 << 11) | 20) & 0xFu; }
#define XB_SPIN(cond, bar) do { unsigned _sp = 0; while (cond) { __builtin_amdgcn_s_sleep(1); \
    if ((++_sp & 255u) == 0u) { if (xb_ld(&(bar)[XB_TMO])) break; if (_sp > XB_SPIN_CAP) { atomicAdd(&(bar)[XB_TMO], 1u); break; } } } } while (0)

struct XcdBarrier {
    unsigned* bar; unsigned x;
    volatile LAS unsigned* st;
};

__device__ __forceinline__ XcdBarrier xcd_barrier_post(unsigned* bar, volatile LAS unsigned* st) {
    XcdBarrier b; b.bar = bar; b.x = xb_xcc_id(); b.st = st;
    if (threadIdx.x == 0) (void)xb_add(&bar[XB_XCNT(b.x)], 1u);
    return b;
}
__device__ __forceinline__ void xcd_barrier_complete(unsigned* bar, unsigned x, unsigned& nloc, unsigned& nx) {
    const unsigned G = gridDim.x * gridDim.y * gridDim.z;
    unsigned sum, cnt, mine, sp = 0u;
    for (;;) {
        sum = 0u; cnt = 0u; mine = 0u;
#pragma unroll
        for (unsigned j = 0; j < 16; ++j) { const unsigned c = xb_ld(&bar[XB_XCNT(j)]); sum += c; cnt += (c > 0u) ? 1u : 0u; mine = (j == x) ? c : mine; }
        if (sum == G) break;
        __builtin_amdgcn_s_sleep(1);
        if ((++sp & 255u) == 0u) { if (xb_ld(&bar[XB_TMO])) break; if (sp > XB_SPIN_CAP) { atomicAdd(&bar[XB_TMO], 1u); break; } }
    }
    nloc = mine > 0u ? mine : 1u; nx = cnt > 0u ? cnt : 1u;
}

__device__ __forceinline__ void xcd_barrier(const XcdBarrier& b) {
    asm volatile("s_waitcnt vmcnt(0)" ::: "memory");
    __syncthreads();
    if (threadIdx.x == 0) {
        unsigned* bar = b.bar;
        __builtin_amdgcn_s_waitcnt(0);
        unsigned nloc = b.st[0], nx = b.st[1];
        if (nloc == 0u) { xcd_barrier_complete(bar, b.x, nloc, nx); b.st[0] = nloc; b.st[1] = nx; }
        const unsigned old = xb_add(&bar[XB_XSUB(b.x)], 1u);
        const unsigned gen = old / nloc;
        if (old + 1u == (gen + 1u) * nloc) {
            __builtin_amdgcn_fence(__ATOMIC_RELEASE, "agent");
            asm volatile("s_waitcnt vmcnt(0)" ::: "memory");
            const unsigned og = xb_add(&bar[XB_TOP], 1u);
            const unsigned tg = og / nx;
            if (og + 1u == (tg + 1u) * nx) xb_add(&bar[XB_TOPGEN], 1u);
            else XB_SPIN(xb_ld(&bar[XB_TOPGEN]) == tg, bar);
            __builtin_amdgcn_fence(__ATOMIC_ACQUIRE, "agent");
            xb_add(&bar[XB_XGEN(b.x)], 1u);
            asm volatile("s_waitcnt vmcnt(0)" ::: "memory");
        } else {
            XB_SPIN(xb_ld(&bar[XB_XGEN(b.x)]) == gen, bar);
            __builtin_amdgcn_fence(__ATOMIC_ACQUIRE, "agent");
            asm volatile("s_waitcnt vmcnt(0)" ::: "memory");
        }
    }
    __syncthreads();
}

__global__ void __launch_bounds__(512, 2) hybrid_fwd(Args a) {
    extern __shared__ __attribute__((aligned(16))) unsigned char smem[];
    LAS unsigned char* lds = (LAS unsigned char*)smem;
    cg::grid_group grid = cg::this_grid();
    volatile LAS unsigned* bst = (volatile LAS unsigned*)(lds + 131072 + 512);
    if (threadIdx.x < 2) bst[threadIdx.x] = 0u;
    __syncthreads();
    const XcdBarrier xbar = xcd_barrier_post((unsigned*)(a.ws + OFF_BAR), bst);
#ifndef REPEAT_K
#define REPEAT_K -1
#endif
    for (int ph2 = 2 * a.ph_lo; ph2 < 2 * a.ph_hi; ++ph2) {
        const int ph = ph2 >> 1;
        if (ph2 & 1) { if (REPEAT_K < 0) continue; if (!((ph == 0 && REPEAT_K == 7) || (ph > 0 && (ph - 1) % 7 == REPEAT_K))) continue; }
        else if (ph > a.ph_lo) { if (ph == a.ph_lo + 1) grid.sync(); else xcd_barrier(xbar); }
        unsigned char* ws = opaque_ptr(a.ws);
        const int G = opaque_s(gridDim.x);
#ifndef KMASK
#define KMASK 0xff
#endif
        if (ph == 0) { if (KMASK & 128) phase_p0(a, lds); continue; }
        const int l = (ph - 1) / 7, k = (ph - 1) % 7;
        const int Mout = (l == 0) ? MT : ML;
        if (k == 0) { if (KMASK & 1) phase_norm(a, l); }
        else if (k == 1) { if (KMASK & 2) {
            pg8::Gemm g{(const bf16_t*)(ws + OFF_H), (const bf16_t*)(ws + OFF_WIN + (size_t)l * SZ_WIN), MT, NZ, DM, DM, DM, 0};
            pg8::StaticOrder S; S.init(MT, NZ, G, BID);
            pg8::EpiBf16 E{(bf16_t*)(ws + OFF_Z), NZ};
            pg8::gemm_phase<pg8::EpiBf16, pg8::StaticOrder, true, true>(lds, g, S, E);
        } }
        else if (k == 2) { if (KMASK & 4) phase_prep(a, l, lds); }
        else if (k == 3) { if (KMASK & 8) phase_mix(a, l, lds); }
        else if (k == 4) { if (KMASK & 16) phase_post(a, l); }
        else if (k == 5) { if (KMASK & 32) {
            pg8::SegOrder3 S; S.base.init(Mout, DM, G, BID);
            const bf16_t* wb = (const bf16_t*)(ws + OFF_WB + (size_t)l * SZ_WB);
            pg8::Gemm g{(const bf16_t*)(ws + OFF_POOLO), wb, Mout, DM, 1024, 1024, 1024, 0,
                        (const bf16_t*)(ws + OFF_DIFFO), (const bf16_t*)(ws + OFF_GLAO), wb + (size_t)DM * 1024, wb + (size_t)2 * DM * 1024};
            pg8::EpiMerge3 E{(bf16_t*)(ws + OFF_H), (const bf16_t*)(ws + OFF_Z) + ZC_MG};
            pg8::gemm_phase<pg8::EpiMerge3, pg8::SegOrder3, true, true, 3>(lds, g, S, E);
        } }
        else if (KMASK & 64) {
            pg8::Gemm g{(const bf16_t*)(ws + OFF_H), (const bf16_t*)(ws + OFF_WOUT + (size_t)l * SZ_WOUT), Mout, DM, DM, DM, DM, 0};
            pg8::StaticOrder S; S.init(Mout, DM, G, BID);
            pg8::EpiOut E{l == 0 ? inp(I_X) : (const float*)(ws + OFF_X1), l == 0 ? inp(I_CTX) : (const float*)(ws + OFF_X1) + (size_t)ML * DM,
                          l == 0 ? (float*)(ws + OFF_X1) : arg_out(), (const float*)(ws + OFF_MOD) + (size_t)l * 5 * 6144};
            pg8::gemm_phase<pg8::EpiOut, pg8::StaticOrder, true, true>(lds, g, S, E);
        }
    }
}

extern "C" void kernel_launch(void* const* d_in, const int* in_sizes, int n_in, void* d_out, int out_size, void* d_ws, size_t ws_size, hipStream_t stream) {
    static int grid = 0;
    if (grid == 0) {
        if (n_in != 26 || out_size != ML * DM || ws_size < WS_END) { fprintf(stderr, "kernel_launch: expected 26 inputs, out %d, ws >= %zu; got n_in %d out %d ws %zu\n", ML * DM, (size_t)WS_END, n_in, out_size, ws_size); grid = -1; return; }
        int dev = 0, cus = 0, per_cu = 0;
        if (hipGetDevice(&dev) != hipSuccess || hipDeviceGetAttribute(&cus, hipDeviceAttributeMultiprocessorCount, dev) != hipSuccess) { grid = -1; return; }
        if (hipFuncSetAttribute((const void*)hybrid_fwd, hipFuncAttributeMaxDynamicSharedMemorySize, LDS_BYTES) != hipSuccess) { fprintf(stderr, "kernel_launch: hipFuncSetAttribute failed\n"); grid = -1; return; }
        if (hipOccupancyMaxActiveBlocksPerMultiprocessor(&per_cu, (const void*)hybrid_fwd, 512, LDS_BYTES) != hipSuccess || per_cu < 1) { fprintf(stderr, "kernel_launch: occupancy query says %d blocks per CU\n", per_cu); (void)hipGetLastError(); grid = -1; return; }
        grid = cus;
    }
    if (grid < 0) return;
    if (hipMemsetAsync((char*)d_ws + OFF_BAR, 0, BAR_BYTES, stream) != hipSuccess) { fprintf(stderr, "kernel_launch: memset of the barrier words failed\n"); return; }
    Args a{};
    for (int i = 0; i < 26; ++i) a.in[i] = (const float*)d_in[i];
    a.out = (float*)d_out; a.ws = (unsigned char*)d_ws;
    const int nl = MK_N_LAUNCHES;
    for (int li = 0; li < nl; ++li) {
        a.ph_lo = (nl == 1) ? 0 : li; a.ph_hi = (nl == 1) ? NPH : li + 1;
        void* args[] = {&a};
        const hipError_t e = hipLaunchCooperativeKernel((const void*)hybrid_fwd, dim3(grid), dim3(512), args, LDS_BYTES, stream);
        if (e != hipSuccess) { fprintf(stderr, "kernel_launch: cooperative launch %d failed: %s (grid %d)\n", li, hipGetErrorString(e), grid); break; }
    }
}
```

```cpp
#include <hip/hip_runtime.h>
#include <hip/hip_cooperative_groups.h>
#include <cstdio>
#include <cstdint>
namespace cg = cooperative_groups;

#ifndef MK_N_LAUNCHES
#define MK_N_LAUNCHES 1
#endif

#define LAS __attribute__((address_space(3)))
typedef unsigned short bf16_t;
typedef short bf16x8 __attribute__((ext_vector_type(8)));
typedef float f32x4 __attribute__((ext_vector_type(4)));
typedef float f32x16 __attribute__((ext_vector_type(16)));
typedef unsigned u32x4 __attribute__((ext_vector_type(4)));
typedef unsigned u32x2 __attribute__((ext_vector_type(2)));

constexpr int DM = 2048, NB = 4, SEQ = 2048, LC = 256, ML = NB * SEQ, MC = NB * LC, MT = ML + MC;
constexpr int DIN = 15392, NZ = 15616;
constexpr int ZC_PU = 0, ZC_PG = 1024, ZC_DQ = 2048, ZC_DK = 3072, ZC_DV = 4096, ZC_DG = 5120, ZC_GQ = 6144, ZC_GK = 6656, ZC_GV = 7168, ZC_GG = 8192, ZC_LR = 9216, ZC_MG = 9472;
constexpr int LK = LC + SEQ;
constexpr float EPS = 1e-6f, LOG2E = 1.4426950408889634f;
constexpr int NPH = 15;

constexpr size_t SZ_WIN = (size_t)NZ * DM * 2, SZ_WB = (size_t)3 * DM * 1024 * 2, SZ_WOUT = (size_t)DM * DM * 2, SZ_POOLT = (size_t)4 * 256 * 256 * 2;
constexpr size_t OFF_WIN = 0;
constexpr size_t OFF_WB = OFF_WIN + 2 * SZ_WIN;
constexpr size_t OFF_WOUT = OFF_WB + 2 * SZ_WB;
constexpr size_t OFF_POOLT = OFF_WOUT + 2 * SZ_WOUT;
constexpr size_t OFF_MOD = OFF_POOLT + 2 * SZ_POOLT;
constexpr size_t OFF_SCAL = OFF_MOD + (size_t)2 * 5 * 6144 * 4;
constexpr size_t OFF_H = OFF_SCAL + 256;
constexpr size_t OFF_Z = OFF_H + (size_t)MT * DM * 2;
constexpr size_t OFF_QN = OFF_Z + (size_t)MT * NZ * 2;
constexpr size_t OFF_QNC = OFF_QN + (size_t)ML * 1024 * 2;
constexpr size_t OFF_KN = OFF_QNC + (size_t)MC * 1024 * 2;
constexpr size_t OFF_VT = OFF_KN + (size_t)MT * 1024 * 2;
constexpr size_t SZ_G = (size_t)MT * 512 * 2;
constexpr size_t OFF_GQ = OFF_VT + (size_t)MT * 1024 * 2;
constexpr size_t OFF_GK = OFF_GQ + 2 * SZ_G;
constexpr size_t OFF_GH = OFF_GK + 2 * SZ_G;
constexpr size_t OFF_DEC = OFF_GH + 2 * SZ_G;
constexpr size_t OFF_OF = OFF_DEC + (size_t)2 * 144 * 512 * 4;
constexpr size_t OFF_DPOOL = OFF_OF + 2 * (size_t)MT * 1024 * 2;
constexpr size_t OFF_POOLO = OFF_DPOOL + (size_t)MT * 1024 * 2;
constexpr size_t OFF_DIFFO = OFF_POOLO + (size_t)MT * 1024 * 2;
constexpr size_t OFF_GLAO = OFF_DIFFO + (size_t)MT * 1024 * 2;
constexpr size_t OFF_YACC = OFF_GLAO + (size_t)MT * 1024 * 2;
constexpr size_t OFF_X1 = OFF_YACC + (size_t)MT * DM * 4;
constexpr size_t OFF_PGATE = OFF_X1 + (size_t)MT * DM * 4;
constexpr size_t OFF_BAR = OFF_PGATE + (size_t)MT * 1024 * 2;
constexpr size_t BAR_BYTES = 16384;
constexpr size_t OFF_GVT = OFF_BAR + BAR_BYTES;
constexpr size_t WS_END = OFF_GVT + (size_t)MT * 1024 * 2;

constexpr int LDS_BYTES = 135168;

#define BID opaque_s((int)blockIdx.x)
#define GAS __attribute__((address_space(1)))
__device__ __forceinline__ unsigned char* opaque_ptr(unsigned char* p) { GAS unsigned char* q = (GAS unsigned char*)p; asm volatile("" : "+s"(q)); return (unsigned char*)q; }
__device__ __forceinline__ int opaque_s(int v) { asm volatile("" : "+s"(v)); return v; }
__device__ __forceinline__ int opaque_tid() { int t = threadIdx.x; asm volatile("" : "+v"(t)); return t; }
typedef float f32x2_t __attribute__((ext_vector_type(2))); typedef __bf16 bf16x2_t __attribute__((ext_vector_type(2)));
__device__ __forceinline__ unsigned cvt_pk_bf16(float lo, float hi) { f32x2_t v = {lo, hi}; bf16x2_t b = __builtin_convertvector(v, bf16x2_t); return __builtin_bit_cast(unsigned, b); }
__device__ __forceinline__ bf16_t f2bf(float f) { return (bf16_t)(cvt_pk_bf16(f, 0.f) & 0xffffu); }
__device__ __forceinline__ float bf2f(bf16_t v) { return __builtin_bit_cast(float, (unsigned)v << 16); }
__device__ __forceinline__ float bflo(unsigned u) { return __builtin_bit_cast(float, u << 16); }
__device__ __forceinline__ float bfhi(unsigned u) { return __builtin_bit_cast(float, u & 0xffff0000u); }
__device__ __forceinline__ float silu_f(float x) { return x / (1.f + __expf(-x)); }
__device__ __forceinline__ float sigmoid_f(float x) { return 1.f / (1.f + __expf(-x)); }
__device__ __forceinline__ float logsig_f(float a) { return fminf(a, 0.f) - log1pf(__expf(-fabsf(a))); }
__device__ __forceinline__ float wave_sum(float v) {
#pragma unroll
    for (int o = 1; o < 64; o <<= 1) v += __shfl_xor(v, o);
    return v;
}
__device__ __forceinline__ float wave_max(float v) {
#pragma unroll
    for (int o = 1; o < 64; o <<= 1) v = fmaxf(v, __shfl_xor(v, o));
    return v;
}
__device__ __forceinline__ void unpack8(u32x4 w, float* f) { f[0] = bflo(w.x); f[1] = bfhi(w.x); f[2] = bflo(w.y); f[3] = bfhi(w.y); f[4] = bflo(w.z); f[5] = bfhi(w.z); f[6] = bflo(w.w); f[7] = bfhi(w.w); }

namespace pg8 {
constexpr int BM = 256, BK = 64, HALF = 128, HTB = HALF * BK * 2, STAGE_BYTES = 8 * HTB, NXCD = 8, WGM = 8;
__host__ __device__ __forceinline__ int lds_byte(int r, int c) { const int st = (r >> 4) * 2 + (c >> 5), rr = r & 15, cc = c & 31, ob = rr * 64 + cc * 2; return st * 1024 + (ob ^ (((ob >> 9) & 1) << 5)); }
__host__ __device__ __forceinline__ void stage_rc(int b, int& R, int& C) { const int st = b / 1024, sb = b % 1024, swz = sb ^ (((sb >> 9) & 1) << 5); R = (st >> 1) * 16 + swz / 64; C = (st & 1) * 32 + (swz % 64) / 2; }
__host__ __device__ __forceinline__ int perm32(int rho) { const int n = rho >> 4, i = rho & 15; return 8 * (i >> 2) + 4 * n + (i & 3); }

struct Unit { int pm, pn, seg; };
struct Gemm { const bf16_t* A; const bf16_t* Bt; int M, N, K; int lda, ldb; int a_pn_off; const bf16_t* A1; const bf16_t* A2; const bf16_t* B1; const bf16_t* B2; };

struct StaticOrder {
    int nM, nN, nwg, G, c;
    __host__ __device__ void init(int M, int N, int G_, int c_) { nM = M / BM; nN = N / BM; nwg = nM * nN; G = G_; c = c_; }
    __host__ __device__ bool next(int i, Unit& u) const {
        const long L = (long)i * G + c; if (L >= nwg) return false;
        int wgid = (int)L; { const int q = nwg / NXCD, r = nwg % NXCD, xcd = wgid % NXCD, off = wgid / NXCD; wgid = (xcd < r ? xcd * (q + 1) : r * (q + 1) + (xcd - r) * q) + off; }
        const int nig = WGM * nN, gid = wgid / nig, fm = gid * WGM, gsz = (nM - fm) < WGM ? (nM - fm) : WGM;
        u.pm = fm + ((wgid % nig) % gsz); u.pn = (wgid % nig) / gsz; u.seg = 0; return true;
    }
    __device__ __forceinline__ void a_ready(const Unit&) const {}
    __device__ __forceinline__ void done(const Unit&) const {}
};

struct CtxSkipOrder {
    StaticOrder base; int nbase;
    __host__ __device__ void init(int G_, int c_) { base.init(ML, NZ, G_, c_); nbase = base.nwg; }
    __host__ __device__ bool next(int i, Unit& u) const {
        const long L = (long)i * base.G + base.c;
        if (L < nbase) return base.next(i, u);
        const int e = (int)(L - nbase); if (e >= 4 * 15) return false;
        const int j = e % 15; u.pm = 32 + e / 15; u.pn = j < 8 ? 12 + j : (j < 14 ? 18 + j : 36); u.seg = 0; return true;
    }
    __device__ __forceinline__ void a_ready(const Unit&) const {}
    __device__ __forceinline__ void done(const Unit&) const {}
};
struct SegOrder3 {
    StaticOrder base;
    __host__ __device__ bool next(int i, Unit& u) const { const int q = i / 3; if (!base.next(q, u)) return false; u.seg = i - 3 * q; return true; }
    __device__ __forceinline__ void a_ready(const Unit&) const {}
    __device__ __forceinline__ void done(const Unit&) const {}
};
struct EpiBf16 {
    static constexpr bool PERM = true, AFTER_DRAIN = false;
    bf16_t* O; int ldc;
    __device__ __forceinline__ void operator()(const f32x4 (&acc)[2][2][4][2], const Unit& u, int wr, int wc, int fr, int fq) const {
        const int row0 = u.pm * BM + wr * 64 + fr, col0 = u.pn * BM + wc * 32 + 8 * fq;
#pragma unroll
        for (int ai = 0; ai < 2; ++ai)
#pragma unroll
            for (int m = 0; m < 4; ++m) { bf16_t* rowp = O + (size_t)(row0 + ai * HALF + m * 16) * ldc + col0;
#pragma unroll
                for (int bj = 0; bj < 2; ++bj) { const f32x4 v0 = acc[ai][bj][m][0], v1 = acc[ai][bj][m][1];
                    u32x4 w; w.x = cvt_pk_bf16(v0[0], v0[1]); w.y = cvt_pk_bf16(v0[2], v0[3]); w.z = cvt_pk_bf16(v1[0], v1[1]); w.w = cvt_pk_bf16(v1[2], v1[3]);
                    *(u32x4*)(rowp + bj * HALF) = w; } }
    }
};

template <class Epi, class Sched, bool ALIGN_EPI = false, bool SP2 = false, int NSEG = 1>
__device__ __forceinline__ void gemm_phase(LAS unsigned char* lds, const Gemm g, const Sched& S, const Epi& E) {
    const int tid = opaque_tid(), wid = __builtin_amdgcn_readfirstlane(tid >> 6), lane = tid & 63, wr = wid >> 2, wc = wid & 3, fr = lane & 15, fq = lane >> 4;
    const int K = opaque_s(g.K), nt = K / BK;
    unsigned voffA[2], voffB[2];
#pragma unroll
    for (int i = 0; i < 2; ++i) { int R, C; stage_rc(tid * 16 + i * 8192, R, C); const int Rb = Epi::PERM ? ((R & ~31) + perm32(R & 31)) : R;
        voffA[i] = (unsigned)(R * g.lda + C) * 2u; voffB[i] = (unsigned)(Rb * g.ldb + C) * 2u; }
    const size_t kstep = (size_t)(BK * 2);
    const size_t hstepA = (size_t)HALF * g.lda * 2, hstepB = (size_t)HALF * g.ldb * 2;
    const size_t tstepA = 2 * hstepA, tstepB = 2 * hstepB;
    const size_t pnA = (size_t)g.a_pn_off * 2;
    const unsigned ldsw = (unsigned)wid * 1024u;
    const int aoff = lds_byte(wr * 64 + fr, fq * 8), boff = lds_byte(wc * 32 + fr, fq * 8);
#define PG8_SA(b, h) (((b) * 2 + (h)) * HTB)
#define PG8_SB(b, h) ((4 + (b) * 2 + (h)) * HTB)
#define PG8_STAGE(bufoff, gbase, voff) do { _Pragma("unroll") for (int _i = 0; _i < 2; ++_i) \
        __builtin_amdgcn_global_load_lds((const unsigned*)((const char*)(gbase) + (voff)[_i]), (LAS unsigned*)(lds + (bufoff) + ldsw + _i * 8192), 16, 0, 0); } while (0)
#define PG8_LDA(dst, b, h) do { _Pragma("unroll") for (int m = 0; m < 4; ++m) _Pragma("unroll") for (int k = 0; k < 2; ++k) dst[m][k] = *(const LAS bf16x8*)(lds + PG8_SA(b, h) + aoff + m * 2048 + k * 1024); } while (0)
#define PG8_LDB(dst, b, h) do { _Pragma("unroll") for (int n = 0; n < 2; ++n) _Pragma("unroll") for (int k = 0; k < 2; ++k) dst[n][k] = *(const LAS bf16x8*)(lds + PG8_SB(b, h) + boff + n * 2048 + k * 1024); } while (0)
#define PG8_MMA(ai, bj, At, Bt) do { __builtin_amdgcn_s_setprio(1); _Pragma("unroll") for (int m = 0; m < 4; ++m) _Pragma("unroll") for (int n = 0; n < 2; ++n) _Pragma("unroll") for (int k = 0; k < 2; ++k) \
        acc[ai][bj][m][n] = __builtin_amdgcn_mfma_f32_16x16x32_bf16(Bt[n][k], At[m][k], acc[ai][bj][m][n], 0, 0, 0); __builtin_amdgcn_s_setprio(0); } while (0)
#define PG8_WAIT_V(n) asm volatile("s_waitcnt vmcnt(" #n ")" ::: "memory")
#define PG8_WAIT_L(n) asm volatile("s_waitcnt lgkmcnt(" #n ")" ::: "memory")
#define PG8_BAR __builtin_amdgcn_s_barrier()
#define PG8_SCHED __builtin_amdgcn_sched_barrier(0)
    Unit cur, nxt; int ui = 0;
    if (!S.next(0, cur)) return;
    f32x4 acc[2][2][4][2];
#pragma unroll
    for (int a = 0; a < 2; ++a)
#pragma unroll
        for (int b = 0; b < 2; ++b)
#pragma unroll
            for (int m = 0; m < 4; ++m)
#pragma unroll
                for (int n = 0; n < 2; ++n) acc[a][b][m][n] = (f32x4){0.f, 0.f, 0.f, 0.f};
    bf16x8 At[4][2], B0[2][2], B1[2][2];
#define PG8_ASEG(u) ((const char*)(NSEG == 1 || (u).seg == 0 ? g.A : ((u).seg == 1 ? g.A1 : g.A2)))
#define PG8_BSEG(u) ((const char*)(NSEG == 1 || (u).seg == 0 ? g.Bt : ((u).seg == 1 ? g.B1 : g.B2)))
    const char* cA = PG8_ASEG(cur) + (size_t)cur.pm * tstepA + (size_t)cur.pn * pnA; const char* cB = PG8_BSEG(cur) + (size_t)cur.pn * tstepB;
    S.a_ready(cur);
    if constexpr (SP2) {
        PG8_STAGE(PG8_SB(0, 0), cB, voffB); PG8_STAGE(PG8_SB(0, 1), cB + hstepB, voffB); PG8_STAGE(PG8_SA(0, 0), cA, voffA); PG8_STAGE(PG8_SA(0, 1), cA + hstepA, voffA);
        if (wr == 1) PG8_BAR;
        PG8_WAIT_V(2); PG8_BAR;
        PG8_STAGE(PG8_SB(1, 0), cB + kstep, voffB); PG8_STAGE(PG8_SA(1, 0), cA + kstep, voffA); PG8_STAGE(PG8_SB(1, 1), cB + hstepB + kstep, voffB);
        PG8_WAIT_V(6); PG8_BAR;
    } else {
        PG8_STAGE(PG8_SB(0, 0), cB, voffB); PG8_STAGE(PG8_SA(0, 0), cA, voffA); PG8_STAGE(PG8_SB(0, 1), cB + hstepB, voffB); PG8_STAGE(PG8_SA(0, 1), cA + hstepA, voffA);
        if (wr == 1) PG8_BAR;
        PG8_WAIT_V(4); PG8_BAR;
        PG8_STAGE(PG8_SB(1, 0), cB + kstep, voffB); PG8_STAGE(PG8_SA(1, 0), cA + kstep, voffA); PG8_STAGE(PG8_SB(1, 1), cB + hstepB + kstep, voffB);
        PG8_WAIT_V(6); PG8_BAR;
    }
    for (;;) {
        const bool has_next = S.next(ui + 1, nxt);
        const char* nA = has_next ? PG8_ASEG(nxt) + (size_t)nxt.pm * tstepA + (size_t)nxt.pn * pnA : cA; const char* nB = has_next ? PG8_BSEG(nxt) + (size_t)nxt.pn * tstepB : cB;
        for (int t = 0; t < nt; t += 2) {
            const bool last = (t == nt - 2);
            const char* a1 = cA + (size_t)(t + 1) * kstep;
            const char* a2 = last ? nA : cA + (size_t)(t + 2) * kstep; const char* b2 = last ? nB : cB + (size_t)(t + 2) * kstep;
            const char* a3 = a2 + kstep; const char* b3 = b2 + kstep;
            if (last && has_next) S.a_ready(nxt);
            if constexpr (SP2) {
            PG8_LDB(B0, 0, 0); PG8_LDB(B1, 0, 1); PG8_SCHED; PG8_LDA(At, 0, 0); PG8_STAGE(PG8_SA(1, 1), a1 + hstepA, voffA);
            PG8_WAIT_V(8); PG8_WAIT_L(0); PG8_BAR; PG8_MMA(0, 0, At, B0); PG8_MMA(0, 1, At, B1); PG8_BAR; PG8_SCHED;
            PG8_LDA(At, 0, 1); PG8_STAGE(PG8_SB(0, 0), b2, voffB); PG8_STAGE(PG8_SB(0, 1), b2 + hstepB, voffB); PG8_STAGE(PG8_SA(0, 0), a2, voffA);
            PG8_WAIT_V(8); PG8_WAIT_L(0); PG8_BAR; PG8_MMA(1, 0, At, B0); PG8_MMA(1, 1, At, B1); PG8_BAR; PG8_SCHED;
            PG8_LDB(B0, 1, 0); PG8_LDB(B1, 1, 1); PG8_SCHED; PG8_LDA(At, 1, 0); PG8_STAGE(PG8_SA(0, 1), a2 + hstepA, voffA);
            PG8_WAIT_V(8); PG8_WAIT_L(0); PG8_BAR; PG8_MMA(0, 0, At, B0); PG8_MMA(0, 1, At, B1); PG8_BAR; PG8_SCHED;
            PG8_LDA(At, 1, 1); PG8_STAGE(PG8_SB(1, 0), b3, voffB); PG8_STAGE(PG8_SB(1, 1), b3 + hstepB, voffB); PG8_STAGE(PG8_SA(1, 0), a3, voffA);
            PG8_WAIT_V(8); PG8_WAIT_L(0); PG8_BAR; PG8_MMA(1, 0, At, B0); PG8_MMA(1, 1, At, B1); PG8_BAR; PG8_SCHED;
            } else {
            PG8_LDB(B0, 0, 0); PG8_SCHED; PG8_LDA(At, 0, 0); PG8_STAGE(PG8_SA(1, 1), a1 + hstepA, voffA);
            PG8_WAIT_L(8); PG8_BAR; PG8_WAIT_L(0); PG8_MMA(0, 0, At, B0); PG8_BAR; PG8_SCHED;
            PG8_LDB(B1, 0, 1); PG8_STAGE(PG8_SB(0, 0), b2, voffB);
            PG8_BAR; PG8_WAIT_L(0); PG8_MMA(0, 1, At, B1); PG8_BAR;
            PG8_LDA(At, 0, 1); PG8_STAGE(PG8_SA(0, 0), a2, voffA);
            PG8_BAR; PG8_WAIT_L(0); PG8_MMA(1, 0, At, B0); PG8_BAR; PG8_SCHED;
            PG8_STAGE(PG8_SB(0, 1), b2 + hstepB, voffB);
            PG8_WAIT_V(6); PG8_BAR; PG8_MMA(1, 1, At, B1); PG8_BAR;
            PG8_LDB(B0, 1, 0); PG8_SCHED; PG8_LDA(At, 1, 0); PG8_STAGE(PG8_SA(0, 1), a2 + hstepA, voffA);
            PG8_WAIT_L(8); PG8_BAR; PG8_WAIT_L(0); PG8_MMA(0, 0, At, B0); PG8_BAR; PG8_SCHED;
            PG8_LDB(B1, 1, 1); PG8_STAGE(PG8_SB(1, 0), b3, voffB);
            PG8_BAR; PG8_WAIT_L(0); PG8_MMA(0, 1, At, B1); PG8_BAR;
            PG8_LDA(At, 1, 1); PG8_STAGE(PG8_SA(1, 0), a3, voffA);
            PG8_BAR; PG8_WAIT_L(0); PG8_MMA(1, 0, At, B0); PG8_BAR; PG8_SCHED;
            PG8_STAGE(PG8_SB(1, 1), b3 + hstepB, voffB);
            PG8_WAIT_V(6); PG8_BAR; PG8_MMA(1, 1, At, B1); PG8_BAR;
            }
        }
        if constexpr (ALIGN_EPI) { if (wr == 0) PG8_BAR; }
        E(acc, cur, wr, wc, fr, fq); S.done(cur);
        if (!has_next) break;
        if (NSEG == 1 || cur.seg == NSEG - 1)
#pragma unroll
        for (int a = 0; a < 2; ++a)
#pragma unroll
            for (int b = 0; b < 2; ++b)
#pragma unroll
                for (int m = 0; m < 4; ++m)
#pragma unroll
                    for (int n = 0; n < 2; ++n) acc[a][b][m][n] = (f32x4){0.f, 0.f, 0.f, 0.f};
        cur = nxt; cA = nA; cB = nB; ++ui;
        if constexpr (ALIGN_EPI) { if (wr == 1) PG8_BAR; }
    }
    PG8_WAIT_V(0);
    if constexpr (!ALIGN_EPI) { if (wr == 0) PG8_BAR; }
    PG8_BAR;
#undef PG8_ASEG
#undef PG8_BSEG
#undef PG8_SA
#undef PG8_SB
#undef PG8_STAGE
#undef PG8_LDA
#undef PG8_LDB
#undef PG8_MMA
#undef PG8_WAIT_V
#undef PG8_WAIT_L
#undef PG8_BAR
#undef PG8_SCHED
}

struct EpiPool {
    static constexpr bool PERM = true, AFTER_DRAIN = false;
    bf16_t* O; const bf16_t* pgate;
    __device__ __forceinline__ void operator()(const f32x4 (&acc)[2][2][4][2], const Unit& u, int wr, int wc, int fr, int fq) const {
        const int row0 = u.pm * BM + wr * 64 + fr, col0 = u.pn * BM + wc * 32 + 8 * fq;
#pragma unroll
        for (int ai = 0; ai < 2; ++ai)
#pragma unroll
            for (int m = 0; m < 4; ++m)
#pragma unroll
                for (int bj = 0; bj < 2; ++bj) {
                    const int row = row0 + ai * HALF + m * 16, col = col0 + bj * HALF;
                    const u32x4 gz = *(const u32x4*)(pgate + (size_t)row * 1024 + col);
                    const f32x4 v0 = acc[ai][bj][m][0], v1 = acc[ai][bj][m][1];
                    u32x4 w;
                    w.x = cvt_pk_bf16(v0[0] * bflo(gz.x), v0[1] * bfhi(gz.x));
                    w.y = cvt_pk_bf16(v0[2] * bflo(gz.y), v0[3] * bfhi(gz.y));
                    w.z = cvt_pk_bf16(v1[0] * bflo(gz.z), v1[1] * bfhi(gz.z));
                    w.w = cvt_pk_bf16(v1[2] * bflo(gz.w), v1[3] * bfhi(gz.w));
                    *(u32x4*)(O + (size_t)row * 1024 + col) = w;
                    __builtin_amdgcn_sched_barrier(0);
                }
    }
};
template <int PASS> struct EpiMerge {
    static constexpr bool PERM = true, AFTER_DRAIN = false;
    float* yacc; bf16_t* y; const bf16_t* zg;
    __device__ __forceinline__ void operator()(const f32x4 (&acc)[2][2][4][2], const Unit& u, int wr, int wc, int fr, int fq) const {
        const int row0 = u.pm * BM + wr * 64 + fr, col0 = u.pn * BM + wc * 32 + 8 * fq;
#pragma unroll
        for (int ai = 0; ai < 2; ++ai)
#pragma unroll
            for (int m = 0; m < 4; ++m)
#pragma unroll
                for (int bj = 0; bj < 2; ++bj) {
                    const int row = row0 + ai * HALF + m * 16, col = col0 + bj * HALF;
                    float gz[8]; unpack8(*(const u32x4*)(zg + (size_t)row * NZ + col), gz);
                    const f32x4 v0 = acc[ai][bj][m][0], v1 = acc[ai][bj][m][1];
                    f32x4 r0, r1;
#pragma unroll
                    for (int e = 0; e < 4; ++e) { r0[e] = v0[e] * sigmoid_f(gz[e]); r1[e] = v1[e] * sigmoid_f(gz[4 + e]); }
                    float* yp = yacc + (size_t)row * DM + col;
                    if (PASS >= 1) { r0 += *(const f32x4*)yp; r1 += *(const f32x4*)(yp + 4); }
                    if (PASS <= 1) { *(f32x4*)yp = r0; *(f32x4*)(yp + 4) = r1; }
                    else { u32x4 w; w.x = cvt_pk_bf16(r0[0], r0[1]); w.y = cvt_pk_bf16(r0[2], r0[3]); w.z = cvt_pk_bf16(r1[0], r1[1]); w.w = cvt_pk_bf16(r1[2], r1[3]);
                        *(u32x4*)(y + (size_t)row * DM + col) = w; }
                    __builtin_amdgcn_sched_barrier(0);
                }
    }
};
struct EpiMerge3 {
    static constexpr bool PERM = true, AFTER_DRAIN = false;
    bf16_t* y; const bf16_t* zg;
    __device__ __forceinline__ void operator()(f32x4 (&acc)[2][2][4][2], const Unit& u, int wr, int wc, int fr, int fq) const {
        const int row0 = u.pm * BM + wr * 64 + fr, col0 = u.pn * BM + wc * 32 + 8 * fq;
#pragma unroll
        for (int ai = 0; ai < 2; ++ai)
#pragma unroll
            for (int m = 0; m < 4; ++m)
#pragma unroll
                for (int bj = 0; bj < 2; ++bj) {
                    const int row = row0 + ai * HALF + m * 16, col = col0 + bj * HALF;
                    const bf16_t* zp = zg + (size_t)row * NZ + col + u.seg * 2048;
                    float ga[8]; unpack8(*(const u32x4*)zp, ga);
                    if (u.seg < 2) {
                        float gb[8]; unpack8(*(const u32x4*)(zp + 2048), gb);
#pragma unroll
                        for (int e = 0; e < 8; ++e) { const float ea = __expf(-fminf(fmaxf(ga[e], -30.f), 30.f)), eb = __expf(-fminf(fmaxf(gb[e], -30.f), 30.f));
                            const float ratio = (1.f + eb) / (1.f + ea); acc[ai][bj][m][e >> 2][e & 3] *= ratio; }
                    } else {
                        float r[8];
#pragma unroll
                        for (int e = 0; e < 8; ++e) r[e] = acc[ai][bj][m][e >> 2][e & 3] / (1.f + __expf(-fminf(fmaxf(ga[e], -30.f), 30.f)));
                        u32x4 w; w.x = cvt_pk_bf16(r[0], r[1]); w.y = cvt_pk_bf16(r[2], r[3]); w.z = cvt_pk_bf16(r[4], r[5]); w.w = cvt_pk_bf16(r[6], r[7]);
                        *(u32x4*)(y + (size_t)row * DM + col) = w;
                    }
                    __builtin_amdgcn_sched_barrier(0);
                }
    }
};
struct EpiOut {
    static constexpr bool PERM = true, AFTER_DRAIN = false;
    const float* xlat; const float* xctx; float* xnew; const float* mod;
    __device__ __forceinline__ void operator()(const f32x4 (&acc)[2][2][4][2], const Unit& u, int wr, int wc, int fr, int fq) const {
        const int row0 = u.pm * BM + wr * 64 + fr, col0 = u.pn * BM + wc * 32 + 8 * fq;
        const int tile_row = u.pm * BM; const int mr = tile_row < ML ? tile_row / SEQ : 4;
        const float* xo = tile_row < ML ? xlat : (xctx - (size_t)ML * DM);
        const float* gm = mod + mr * 6144 + 4096;
#pragma unroll
        for (int ai = 0; ai < 2; ++ai)
#pragma unroll
            for (int m = 0; m < 4; ++m)
#pragma unroll
                for (int bj = 0; bj < 2; ++bj) {
                    const int row = row0 + ai * HALF + m * 16, col = col0 + bj * HALF;
                    const f32x4 g0 = *(const f32x4*)(gm + col), g1 = *(const f32x4*)(gm + col + 4);
                    const float* xp = xo + (size_t)row * DM + col;
                    const f32x4 r0 = *(const f32x4*)xp + g0 * acc[ai][bj][m][0], r1 = *(const f32x4*)(xp + 4) + g1 * acc[ai][bj][m][1];
                    float* op = xnew + (size_t)row * DM + col;
                    *(f32x4*)op = r0; *(f32x4*)(op + 4) = r1;
                    __builtin_amdgcn_sched_barrier(0);
                }
    }
};
}

struct Args { const float* in[26]; float* out; unsigned char* ws; int ph_lo, ph_hi; };
enum { I_X = 0, I_C, I_CTX, I_CCTX, I_NORMG, I_WADA, I_BADA, I_WIN, I_POOLW, I_POOLS, I_QNORM, I_KNORM, I_LQ1, I_LK1, I_LQ2, I_LK2, I_SUBLN, I_WGF, I_BGF, I_WGB, I_BGB, I_GLAN, I_WBP, I_WBD, I_WBG, I_WOUT };

__device__ __forceinline__ const float* inp(int i) { const float* const volatile __attribute__((address_space(4)))* kp = (const float* const volatile __attribute__((address_space(4)))*)__builtin_amdgcn_kernarg_segment_ptr(); const GAS float* q = (const GAS float*)kp[i]; asm volatile("" : "+s"(q)); return (const float*)q; }
__device__ __forceinline__ float* arg_out() { float* const volatile __attribute__((address_space(4)))* kp = (float* const volatile __attribute__((address_space(4)))*)__builtin_amdgcn_kernarg_segment_ptr(); GAS float* q = (GAS float*)kp[26]; asm volatile("" : "+s"(q)); return (float*)q; }
__device__ __forceinline__ void transpose_item(const float* W, int K, int N, bf16_t* WT, int row_off, LAS float* scr, int kb, int nb, int lane) {
    const int k0 = 64 * kb, n0 = 32 * nb;
    float tv[32];
#pragma unroll
    for (int i = 0; i < 32; ++i) { const int kk = 2 * i + (lane >> 5); tv[i] = __builtin_nontemporal_load(W + (size_t)(k0 + kk) * N + n0 + (lane & 31)); }
#pragma unroll
    for (int i = 0; i < 32; ++i) { const int kk = 2 * i + (lane >> 5); scr[kk * 33 + (lane & 31)] = tv[i]; }
    asm volatile("s_waitcnt lgkmcnt(0)" ::: "memory");
    const int c = lane & 7;
#pragma unroll
    for (int j = 0; j < 4; ++j) { const int n = (lane >> 3) + 8 * j; const LAS float* s = scr + (8 * c) * 33 + n;
        u32x4 o; o.x = cvt_pk_bf16(s[0 * 33], s[1 * 33]); o.y = cvt_pk_bf16(s[2 * 33], s[3 * 33]); o.z = cvt_pk_bf16(s[4 * 33], s[5 * 33]); o.w = cvt_pk_bf16(s[6 * 33], s[7 * 33]);
        *(u32x4*)(WT + (size_t)(row_off + n0 + n) * K + k0 + 8 * c) = o; }
    asm volatile("s_waitcnt lgkmcnt(0)" ::: "memory");
}

__device__ __forceinline__ void phase_p0(const Args& a, LAS unsigned char* lds) {
    const int tid = opaque_tid(), lane = tid & 63, wave = __builtin_amdgcn_readfirstlane(tid >> 6), G = opaque_s(gridDim.x);
    unsigned char* ws = opaque_ptr(a.ws);
    {
        LAS float* sc = (LAS float*)(lds + 69632);
        LAS float* part = (LAS float*)(lds + 69632 + 40960);
        if (BID < 192) {
            for (int i = tid; i < 5 * 2048; i += 512) { const int r = i >> 11, k = i & 2047; const float v = r < 4 ? inp(I_C)[r * 2048 + k] : inp(I_CCTX)[k]; sc[i] = silu_f(v); }
            __syncthreads();
        }
        for (int it = BID; it < 192; it += G) {
            const int l = it / 96, cgp = it % 96, col = cgp * 64 + lane;
            const float* W = inp(I_WADA) + (size_t)l * 2048 * 6144 + col;
            float acc[5] = {0.f, 0.f, 0.f, 0.f, 0.f};
#pragma unroll 32
            for (int kk = 0; kk < 256; ++kk) { const int k = wave * 256 + kk; const float wv = __builtin_nontemporal_load(W + (size_t)k * 6144);
#pragma unroll
                for (int r = 0; r < 5; ++r) acc[r] += sc[r * 2048 + k] * wv; }
#pragma unroll
            for (int r = 0; r < 5; ++r) part[(wave * 5 + r) * 64 + lane] = acc[r];
            __syncthreads();
            if (tid < 320) { const int r = tid >> 6, ln = tid & 63; float s = inp(I_BADA)[l * 6144 + cgp * 64 + ln];
#pragma unroll
                for (int w = 0; w < 8; ++w) s += part[(w * 5 + r) * 64 + ln];
                ((float*)(ws + OFF_MOD))[(l * 5 + r) * 6144 + cgp * 64 + ln] = s; }
            __syncthreads();
        }
    }
    if (BID == G - 1 && wave == 0) {
        for (int l = 0; l < 2; ++l) {
            const float s1 = wave_sum(inp(I_LQ1)[l * 64 + lane] * inp(I_LK1)[l * 64 + lane]);
            const float s2 = wave_sum(inp(I_LQ2)[l * 64 + lane] * inp(I_LK2)[l * 64 + lane]);
            const float mq = wave_max(fabsf(inp(I_QNORM)[l * 64 + lane])), mk = wave_max(fabsf(inp(I_KNORM)[l * 64 + lane]));
            const float lam_init = 0.8f - 0.6f * expf(-0.3f * (float)l);
            if (lane == 0) { float* sp = (float*)(ws + OFF_SCAL) + l * 4; sp[0] = expf(s1) - expf(s2) + lam_init; sp[1] = 8.f * LOG2E * mq * mk; sp[2] = lam_init; sp[3] = 0.f; }
        }
    }
    {
        const int nper = 224 * 2048 * 2 / 16;
        for (int i = BID * 512 + tid; i < 2 * nper; i += G * 512) { const int l = i / nper, j = i % nper;
            *(u32x4*)(ws + OFF_WIN + (size_t)l * SZ_WIN + (size_t)9248 * DM * 2 + (size_t)j * 16) = (u32x4){0u, 0u, 0u, 0u}; }
    }
    {
        LAS float* scr = (LAS float*)(lds + wave * 8704);
        const int gw = BID * 8 + wave, NGW = G * 8;
        constexpr int I_IN = 32 * 481, I_B = 16 * 64, I_O = 32 * 64, I_P = 4 * 32, PER_L = I_IN + 3 * I_B + I_O + I_P;
        for (int it = gw; it < 2 * PER_L; it += NGW) {
            const int l = it / PER_L; int r = it % PER_L;
            if (r < I_IN) { const int kb = r / 481, nb = r % 481;
                transpose_item(inp(I_WIN) + (size_t)l * DM * DIN, DM, DIN, (bf16_t*)(ws + OFF_WIN + (size_t)l * SZ_WIN), nb >= 289 ? 224 : 0, scr, kb, nb, lane); continue; }
            r -= I_IN;
            if (r < 3 * I_B) { const int br = r / I_B, rr = r % I_B; const float* W = (br == 0 ? inp(I_WBP) : br == 1 ? inp(I_WBD) : inp(I_WBG)) + (size_t)l * 1024 * DM;
                transpose_item(W, 1024, DM, (bf16_t*)(ws + OFF_WB + (size_t)l * SZ_WB + (size_t)br * DM * 1024 * 2), 0, scr, rr / 64, rr % 64, lane); continue; }
            r -= 3 * I_B;
            if (r < I_O) { transpose_item(inp(I_WOUT) + (size_t)l * DM * DM, DM, DM, (bf16_t*)(ws + OFF_WOUT + (size_t)l * SZ_WOUT), 0, scr, r / 64, r % 64, lane); continue; }
            r -= I_O;
            { const int g = r / 32, rr = r % 32;
              transpose_item(inp(I_POOLW) + (size_t)(l * 4 + g) * 65536, 256, 256, (bf16_t*)(ws + OFF_POOLT + (size_t)l * SZ_POOLT + (size_t)g * 65536 * 2), 0, scr, rr / 8, rr % 8, lane); }
        }
    }
}

__device__ __forceinline__ void phase_norm(const Args& a, int l) {
    const int tid = opaque_tid(), lane = tid & 63, wave = tid >> 6, G = opaque_s(gridDim.x);
    const int gw = BID * 8 + wave, NGW = G * 8;
    const float* mod = (const float*)(opaque_ptr(a.ws) + OFF_MOD) + (size_t)l * 5 * 6144;
    const float* x1 = (const float*)(opaque_ptr(a.ws) + OFF_X1);
    bf16_t* h = (bf16_t*)(opaque_ptr(a.ws) + OFF_H);
    const float* ng = inp(I_NORMG) + l * DM;
    for (int row = gw; row < MT; row += NGW) {
        const float* src = (l == 0) ? (row < ML ? inp(I_X) + (size_t)row * DM : inp(I_CTX) + (size_t)(row - ML) * DM) : x1 + (size_t)row * DM;
        const int mr = row < ML ? row / SEQ : 4;
        const float* md = mod + mr * 6144;
        f32x4 v[8]; float ss = 0.f;
#pragma unroll
        for (int j = 0; j < 8; ++j) { v[j] = *(const f32x4*)(src + 4 * lane + 256 * j); ss += (v[j][0] * v[j][0] + v[j][1] * v[j][1]) + (v[j][2] * v[j][2] + v[j][3] * v[j][3]); }
        ss = wave_sum(ss);
        const float rstd = rsqrtf(ss * (1.f / DM) + EPS);
#pragma unroll
        for (int j = 0; j < 8; ++j) { const int idx = 4 * lane + 256 * j;
            const f32x4 gg = *(const f32x4*)(ng + idx), sc = *(const f32x4*)(md + 2048 + idx), sh = *(const f32x4*)(md + idx);
            f32x4 o;
#pragma unroll
            for (int e = 0; e < 4; ++e) o[e] = v[j][e] * rstd * gg[e] * (1.f + sc[e]) + sh[e];
            u32x2 w; w.x = cvt_pk_bf16(o[0], o[1]); w.y = cvt_pk_bf16(o[2], o[3]);
            *(u32x2*)(h + (size_t)row * DM + idx) = w; }
    }
}

__device__ __forceinline__ int vt_pos(int key) { const int k = key & 15; return (key & ~15) | (((k >> 2) & 1) << 3) | (k & 3) | (((k >> 3) & 1) << 2); }

__device__ __forceinline__ void phase_prep(const Args& a, int l, LAS unsigned char* lds) {
    const int tid = opaque_tid(), lane = tid & 63, wave = tid >> 6, G = opaque_s(gridDim.x);
    unsigned char* ws = opaque_ptr(a.ws);
    const bf16_t* z = (const bf16_t*)(ws + OFF_Z);
    const bool need_ctx = (l == 0);
    for (int it = BID; it < 2016; it += G) {
        if (it < 1152) {
            const int c = it >> 3, cgp = it & 7, rb = 64 * c;
            LAS float* lrs = (LAS float*)lds;
            LAS float* segs = (LAS float*)(lds + 8192);
            for (int i = tid; i < 64 * 32; i += 512) { const int r = i >> 5, cc = i & 31; lrs[i] = bf2f(z[(size_t)(rb + r) * NZ + ZC_LR + cc]); }
            __syncthreads();
            const int seg = tid >> 6, chl = tid & 63, ch = cgp * 64 + chl;
            float wf[16], wb[16];
#pragma unroll
            for (int r = 0; r < 16; ++r) { wf[r] = inp(I_WGF)[(size_t)l * 16 * 512 + r * 512 + ch]; wb[r] = inp(I_WGB)[(size_t)l * 16 * 512 + r * 512 + ch]; }
            const float bfv = inp(I_BGF)[l * 512 + ch], bbv = inp(I_BGB)[l * 512 + ch];
            float gf[8], gb[8]; float sf = 0.f, sb = 0.f;
#pragma unroll
            for (int i = 0; i < 8; ++i) { const int t = seg * 8 + i; float af = bfv, ab = bbv;
#pragma unroll
                for (int r4 = 0; r4 < 4; ++r4) { const f32x4 lf = *(const LAS f32x4*)(lrs + t * 32 + 4 * r4), lb = *(const LAS f32x4*)(lrs + t * 32 + 16 + 4 * r4);
#pragma unroll
                    for (int e = 0; e < 4; ++e) { af += lf[e] * wf[4 * r4 + e]; ab += lb[e] * wb[4 * r4 + e]; } }
                gf[i] = logsig_f(af) * (1.f / 16.f); gb[i] = logsig_f(ab) * (1.f / 16.f); sf += gf[i]; sb += gb[i]; }
            segs[seg * 64 + chl] = sf; segs[512 + seg * 64 + chl] = sb;
            __syncthreads();
            float pf = 0.f, pb = 0.f, totf = 0.f, totb = 0.f;
#pragma unroll
            for (int s2 = 0; s2 < 8; ++s2) { const float vf = segs[s2 * 64 + chl], vb = segs[512 + s2 * 64 + chl]; totf += vf; totb += vb; if (s2 < seg) { pf += vf; pb += vb; } }
            bf16_t* gq0 = (bf16_t*)(ws + OFF_GQ), *gq1 = (bf16_t*)(ws + OFF_GQ + SZ_G);
            bf16_t* gk0 = (bf16_t*)(ws + OFF_GK), *gk1 = (bf16_t*)(ws + OFF_GK + SZ_G);
            bf16_t* gh0 = (bf16_t*)(ws + OFF_GH), *gh1 = (bf16_t*)(ws + OFF_GH + SZ_G);
            float h0[8], h1[8];
#pragma unroll
            for (int i = 0; i < 8; ++i) { const int t = seg * 8 + i;
                pf += gf[i]; const float bs = totb - pb; pb += gb[i];
                const size_t row = rb + t;
                const float q = bf2f(z[row * NZ + ZC_GQ + ch]) * 0.08838834764831845f, k = bf2f(z[row * NZ + ZC_GK + ch]);
                const size_t o = row * 512 + ch;
                gq0[o] = f2bf(q * __expf(pf)); gk0[o] = f2bf(k * __expf(-pf)); h0[i] = k * __expf(totf - pf);
                gq1[o] = f2bf(q * __expf(bs)); gk1[o] = f2bf(k * __expf(-bs)); h1[i] = k * __expf(totb - bs); }
            { u32x4 w0, w1;
              w0.x = cvt_pk_bf16(h0[0], h0[1]); w0.y = cvt_pk_bf16(h0[2], h0[3]); w0.z = cvt_pk_bf16(h0[4], h0[5]); w0.w = cvt_pk_bf16(h0[6], h0[7]);
              w1.x = cvt_pk_bf16(h1[0], h1[1]); w1.y = cvt_pk_bf16(h1[2], h1[3]); w1.z = cvt_pk_bf16(h1[4], h1[5]); w1.w = cvt_pk_bf16(h1[6], h1[7]);
              const size_t oh = ((size_t)c * 512 + ch) * 64 + seg * 8;
              *(u32x4*)(gh0 + oh) = w0; *(u32x4*)(gh1 + oh) = w1; }
            if (seg == 0) { float* dec = (float*)(ws + OFF_DEC); dec[(size_t)c * 512 + ch] = __expf(totf); dec[(size_t)(144 + c) * 512 + ch] = __expf(totb); }
            __syncthreads();
        } else if (it < 1440) {
            const int rb = 32 * (it - 1152); if (!need_ctx && rb >= ML) continue;
            const int seq0 = rb < ML ? (rb / SEQ) * SEQ : ML + ((rb - ML) / LC) * LC; const int L = rb < ML ? SEQ : LC;
            bf16_t* dp = (bf16_t*)(ws + OFF_DPOOL); bf16_t* pgt = (bf16_t*)(ws + OFF_PGATE);
            const int ch8 = 8 * (tid & 127), tg = tid >> 7, hw = 1 << (ch8 >> 8);
            const int tl0 = rb - seq0 + 8 * tg;
            float psc[8];
#pragma unroll
            for (int e = 0; e < 8; ++e) psc[e] = inp(I_POOLS)[l * 1024 + ch8 + e];
            const bf16_t* zc = z + (size_t)seq0 * NZ + ZC_PU + ch8;
            float sm[8] = {0.f, 0.f, 0.f, 0.f, 0.f, 0.f, 0.f, 0.f};
            { const int lo = max(tl0 - hw, 0), hi = min(tl0 + hw, L);
              for (int p = lo; p < hi; ++p) { float u[8]; unpack8(*(const u32x4*)(zc + (size_t)p * NZ), u);
#pragma unroll
                  for (int e = 0; e < 8; ++e) sm[e] += u[e]; } }
#pragma unroll
            for (int t = 0; t < 8; ++t) { const int tl = tl0 + t; const int lo = max(tl - hw, 0), hi = min(tl + hw, L);
                const float rc = 1.f / (float)(hi - lo);
                float cur[8], pgv[8], ua[8], ur[8];
                unpack8(*(const u32x4*)(zc + (size_t)tl * NZ), cur); unpack8(*(const u32x4*)(zc + (size_t)tl * NZ + (ZC_PG - ZC_PU)), pgv);
                unpack8(*(const u32x4*)(zc + (size_t)min(tl + hw, L - 1) * NZ), ua); unpack8(*(const u32x4*)(zc + (size_t)max(tl - hw, 0) * NZ), ur);
                const float ma = (tl + hw < L) ? 1.f : 0.f, mr = (tl - hw >= 0) ? 1.f : 0.f;
                u32x4 wd, wg;
                wd.x = cvt_pk_bf16(sm[0] * rc - cur[0], sm[1] * rc - cur[1]); wd.y = cvt_pk_bf16(sm[2] * rc - cur[2], sm[3] * rc - cur[3]);
                wd.z = cvt_pk_bf16(sm[4] * rc - cur[4], sm[5] * rc - cur[5]); wd.w = cvt_pk_bf16(sm[6] * rc - cur[6], sm[7] * rc - cur[7]);
                wg.x = cvt_pk_bf16(psc[0] * silu_f(pgv[0]), psc[1] * silu_f(pgv[1])); wg.y = cvt_pk_bf16(psc[2] * silu_f(pgv[2]), psc[3] * silu_f(pgv[3]));
                wg.z = cvt_pk_bf16(psc[4] * silu_f(pgv[4]), psc[5] * silu_f(pgv[5])); wg.w = cvt_pk_bf16(psc[6] * silu_f(pgv[6]), psc[7] * silu_f(pgv[7]));
                const size_t o = (size_t)(seq0 + tl) * 1024 + ch8;
                *(u32x4*)(dp + o) = wd; *(u32x4*)(pgt + o) = wg;
#pragma unroll
                for (int e = 0; e < 8; ++e) sm[e] += ma * ua[e] - mr * ur[e]; }
        } else {
            const int vi = it - 1440, isg = vi >= 288, vj = isg ? vi - 288 : vi, c = vj >> 1, hv = vj & 1, rb = 64 * c;
            int b, key0; if (rb < ML) { b = rb >> 11; key0 = LC + (rb & 2047); } else { b = (rb - ML) >> 8; key0 = (rb - ML) & 255; }
            bf16_t* vT = (bf16_t*)(ws + OFF_VT); bf16_t* gvT = (bf16_t*)(ws + OFF_GVT);
#pragma unroll
            for (int i = 0; i < 8; ++i) { const int idx = tid + 512 * i, key = idx & 63, c8 = (idx >> 6) * 8;
                const u32x4 w = *(const u32x4*)(z + (size_t)(rb + key) * NZ + (isg ? ZC_GV : ZC_DV) + hv * 512 + c8);
                const unsigned ww[4] = {w.x, w.y, w.z, w.w}; const int pos = isg ? key : vt_pos(key);
#pragma unroll
                for (int e = 0; e < 8; ++e) *(LAS bf16_t*)(lds + (c8 + e) * 144 + pos * 2) = (bf16_t)((e & 1) ? (ww[e >> 1] >> 16) : (ww[e >> 1] & 0xffffu)); }
            __syncthreads();
#pragma unroll
            for (int i = 0; i < 8; ++i) { const int idx = tid + 512 * i, col = idx >> 3, k8 = idx & 7, colg = hv * 512 + col, h = colg >> 7, v = colg & 127;
                bf16_t* dst = isg ? gvT + ((size_t)c * 1024 + colg) * 64 + k8 * 8 : vT + ((size_t)(b * 8 + h) * 128 + v) * LK + key0 + k8 * 8;
                *(u32x4*)dst = *(const LAS u32x4*)(lds + col * 144 + k8 * 16); }
            __syncthreads();
        }
    }
    {
        const int gw = BID * 8 + wave, NGW = G * 8;
        bf16_t* qn = (bf16_t*)(ws + OFF_QN); bf16_t* qnc = (bf16_t*)(ws + OFF_QNC); bf16_t* kn = (bf16_t*)(ws + OFF_KN);
        for (int it = gw; it < MT * 2; it += NGW) {
            const int row = it >> 1, which = it & 1;
            const bool isctx = row >= ML; int b, t; if (!isctx) { b = row >> 11; t = row & 2047; } else { b = (row - ML) >> 8; t = (row - ML) & 255; }
            const bf16_t* zr = z + (size_t)row * NZ;
            {
                if (which == 0 && isctx && !need_ctx) continue;
                float x[16]; const bf16_t* src = zr + (which == 0 ? ZC_DQ : ZC_DK) + 16 * lane;
                unpack8(*(const u32x4*)src, x); unpack8(*(const u32x4*)(src + 8), x + 8);
                float ss = 0.f;
#pragma unroll
                for (int e = 0; e < 16; ++e) ss += x[e] * x[e];
                ss += __shfl_xor(ss, 1); ss += __shfl_xor(ss, 2);
                const float rstd = rsqrtf(ss * (1.f / 64.f) + EPS);
                const int m = lane & 3, sh = lane >> 2, h = sh >> 1, j = sh & 1;
                const float* gain = (which == 0 ? inp(I_QNORM) : inp(I_KNORM)) + l * 64 + 16 * m;
                float y[16];
#pragma unroll
                for (int e = 0; e < 16; ++e) y[e] = x[e] * rstd * gain[e];
                if (!isctx) {
                    const float posf = (float)((m & 1) ? (t & 63) : (t >> 6));
#pragma unroll
                    for (int e = 0; e < 16; ++e) { const float yp = __shfl_xor(y[e], 2);
                        const float ang = posf * exp2f(-(float)e * 0.8304820237218405f);
                        const float cs = __cosf(ang), sn = __sinf(ang);
                        y[e] = (m < 2) ? (y[e] * cs - yp * sn) : (y[e] * cs + yp * sn); }
                }
                bf16_t* dst;
                if (which == 0) {
#pragma unroll
                    for (int e = 0; e < 16; ++e) y[e] *= 0.125f * LOG2E;
                    dst = isctx ? qnc + (((size_t)(b * 8 + h) * 2 + j) * LC + t) * 64 + 16 * m : qn + (((size_t)(b * 8 + h) * 2 + j) * SEQ + t) * 64 + 16 * m;
                } else dst = kn + (((size_t)(b * 8 + h) * 2 + j) * LK + (isctx ? t : LC + t)) * 64 + 16 * m;
                u32x4 w0, w1;
                w0.x = cvt_pk_bf16(y[0], y[1]); w0.y = cvt_pk_bf16(y[2], y[3]); w0.z = cvt_pk_bf16(y[4], y[5]); w0.w = cvt_pk_bf16(y[6], y[7]);
                w1.x = cvt_pk_bf16(y[8], y[9]); w1.y = cvt_pk_bf16(y[10], y[11]); w1.z = cvt_pk_bf16(y[12], y[13]); w1.w = cvt_pk_bf16(y[14], y[15]);
                *(u32x4*)dst = w0; *(u32x4*)(dst + 8) = w1;
            }
        }
    }
}

constexpr int GL_Q = 0, GL_K = 17408, GL_KH = 34816, GL_VT = 53248, GL_ATT = 57856, GL_ST = 67072;
__device__ __forceinline__ void gla_unit(const Args& a, int l, LAS unsigned char* lds, int item) {
    const int tid = opaque_tid(), lane = tid & 63, w = __builtin_amdgcn_readfirstlane(tid >> 6);
    const int vs = item & 7, dir = (item >> 3) & 1, h = (item >> 4) & 3, b = item >> 6;
    const bool need_ctx = (l == 0);
    unsigned char* ws = opaque_ptr(a.ws);
    const bf16_t* z = (const bf16_t*)(ws + OFF_Z);
    const bf16_t* gq = (const bf16_t*)(ws + OFF_GQ + dir * SZ_G) + h * 128;
    const bf16_t* gk = (const bf16_t*)(ws + OFF_GK + dir * SZ_G) + h * 128;
    const bf16_t* gh = (const bf16_t*)(ws + OFF_GH + dir * SZ_G) + (size_t)h * 128 * 64;
    const float* dec = (const float*)(ws + OFF_DEC) + (size_t)dir * 144 * 512 + h * 128;
    bf16_t* od = (bf16_t*)(ws + OFF_OF + (size_t)dir * MT * 1024 * 2) + h * 256 + vs * 32;
    const bf16_t* gvt = (const bf16_t*)(ws + OFF_GVT) + (size_t)(h * 256 + vs * 32) * 64;
    const int fr = lane & 15, fq = lane >> 4;
    f32x4 sacc[2] = {(f32x4){0.f, 0.f, 0.f, 0.f}, (f32x4){0.f, 0.f, 0.f, 0.f}};
    for (int i = tid; i < 32 * 136 / 2; i += 512) ((LAS unsigned*)(lds + GL_ST))[i] = 0u;
    u32x4 rq[2], rk[2], rh[2], rv; float rdec;
    auto rowbase = [&](int s) -> int { if (s < 4) { const int ci = dir == 0 ? s : 3 - s; return ML + b * LC + 64 * ci; } const int ci = dir == 0 ? s - 4 : 35 - s; return b * SEQ + 64 * ci; };
#define GLA_LOAD(s) do { const int _rb = rowbase(s); _Pragma("unroll") for (int _i = 0; _i < 2; ++_i) { const int _idx = tid + 512 * _i, _r = _idx >> 4, _c = (_idx & 15) * 8; const size_t _o = (size_t)(_rb + _r) * 512 + _c; \
        rq[_i] = *(const u32x4*)(gq + _o); rk[_i] = *(const u32x4*)(gk + _o); rh[_i] = *(const u32x4*)(gh + ((size_t)(_rb >> 6) * 512 + (_idx >> 3)) * 64 + (_idx & 7) * 8); } \
        if (tid < 256) rv = *(const u32x4*)(gvt + ((size_t)(_rb >> 6) * 1024 + (tid >> 3)) * 64 + (tid & 7) * 8); \
        rdec = dec[(size_t)(_rb >> 6) * 512 + 16 * w + fr]; } while (0)
    GLA_LOAD(0);
    for (int s = 0; s < 36; ++s) {
        const int rb = rowbase(s);
        const float dk = rdec;
#pragma unroll
        for (int i = 0; i < 2; ++i) { const int idx = tid + 512 * i, r = idx >> 4, c = (idx & 15) * 8;
            *(LAS u32x4*)(lds + GL_Q + r * 272 + c * 2) = rq[i]; *(LAS u32x4*)(lds + GL_K + r * 272 + c * 2) = rk[i];
            *(LAS u32x4*)(lds + GL_KH + (idx >> 3) * 144 + (idx & 7) * 16) = rh[i]; }
        if (tid < 256) *(LAS u32x4*)(lds + GL_VT + (tid >> 3) * 144 + (tid & 7) * 16) = rv;
        __syncthreads();
        if (s + 1 < 36) GLA_LOAD(s + 1);
        {
            const int tt = w >> 1;
#pragma unroll
            for (int si = 0; si < 2; ++si) { const int st = 2 * (w & 1) + si; f32x4 acc = (f32x4){0.f, 0.f, 0.f, 0.f};
#pragma unroll
                for (int kk = 0; kk < 4; ++kk) { const bf16x8 af = *(const LAS bf16x8*)(lds + GL_Q + (16 * tt + fr) * 272 + (32 * kk + 8 * fq) * 2);
                    const bf16x8 bfr = *(const LAS bf16x8*)(lds + GL_K + (16 * st + fr) * 272 + (32 * kk + 8 * fq) * 2);
                    acc = __builtin_amdgcn_mfma_f32_16x16x32_bf16(af, bfr, acc, 0, 0, 0); }
#pragma unroll
                for (int j = 0; j < 4; ++j) { const int t = 16 * tt + 4 * fq + j, sc = 16 * st + fr; const bool keep = dir == 0 ? (sc <= t) : (sc >= t);
                    *(LAS bf16_t*)(lds + GL_ATT + t * 144 + sc * 2) = f2bf(keep ? acc[j] : 0.f); } }
        }
#pragma unroll
        for (int vt = 0; vt < 2; ++vt) { f32x4 acc = sacc[vt] * dk;
#pragma unroll
            for (int kk = 0; kk < 2; ++kk) { const bf16x8 af = *(const LAS bf16x8*)(lds + GL_VT + (16 * vt + fr) * 144 + (32 * kk + 8 * fq) * 2);
                const bf16x8 bfr = *(const LAS bf16x8*)(lds + GL_KH + (16 * w + fr) * 144 + (32 * kk + 8 * fq) * 2);
                acc = __builtin_amdgcn_mfma_f32_16x16x32_bf16(af, bfr, acc, 0, 0, 0); }
            sacc[vt] = acc; }
        __syncthreads();
        {
            const int tt = w >> 1, vt = w & 1; f32x4 acc = (f32x4){0.f, 0.f, 0.f, 0.f};
#pragma unroll
            for (int kk = 0; kk < 4; ++kk) { const bf16x8 af = *(const LAS bf16x8*)(lds + GL_Q + (16 * tt + fr) * 272 + (32 * kk + 8 * fq) * 2);
                const bf16x8 bfr = *(const LAS bf16x8*)(lds + GL_ST + (16 * vt + fr) * 272 + (32 * kk + 8 * fq) * 2);
                acc = __builtin_amdgcn_mfma_f32_16x16x32_bf16(af, bfr, acc, 0, 0, 0); }
#pragma unroll
            for (int kk = 0; kk < 2; ++kk) { const bf16x8 af = *(const LAS bf16x8*)(lds + GL_ATT + (16 * tt + fr) * 144 + (32 * kk + 8 * fq) * 2);
                const bf16x8 bfr = *(const LAS bf16x8*)(lds + GL_VT + (16 * vt + fr) * 144 + (32 * kk + 8 * fq) * 2);
                acc = __builtin_amdgcn_mfma_f32_16x16x32_bf16(af, bfr, acc, 0, 0, 0); }
            if (s >= 4 || need_ctx) {
#pragma unroll
                for (int j = 0; j < 4; ++j) od[(size_t)(rb + 16 * tt + 4 * fq + j) * 1024 + 16 * vt + fr] = f2bf(acc[j]); }
        }
        __syncthreads();
#pragma unroll
        for (int vt = 0; vt < 2; ++vt)
#pragma unroll
            for (int j = 0; j < 4; ++j) *(LAS bf16_t*)(lds + GL_ST + (16 * vt + 4 * fq + j) * 272 + (16 * w + fr) * 2) = f2bf(sacc[vt][j]);
    }
    __syncthreads();
#undef GLA_LOAD
}

constexpr int AT_BUF = 36864, AT_K = 0, AT_V = 18432;
template <bool SHIFT>
__device__ __forceinline__ void attn_unit(LAS unsigned char* lds, const bf16_t* qbase, int Lq, int q0, const bf16_t* kbase, const bf16_t* vtbase, int nkeys,
                                          float c2, float lam, float post_scale, const float* subln, const bf16_t* dg, bf16_t* outp, int row0) {
    const int tid = opaque_tid(), lane = tid & 63, w = __builtin_amdgcn_readfirstlane(tid >> 6), q32 = lane & 31, hi = lane >> 5;
    const int j = w >> 2, qg = w & 3;
    bf16x8 qf[4];
#pragma unroll
    for (int kk = 0; kk < 4; ++kk) qf[kk] = *(const bf16x8*)(qbase + ((size_t)j * Lq + q0 + 32 * qg + q32) * 64 + 16 * kk + 8 * hi);
    f32x16 o[4];
#pragma unroll
    for (int vt = 0; vt < 4; ++vt)
#pragma unroll
        for (int r = 0; r < 16; ++r) o[vt][r] = 0.f;
    float lsum = 0.f;
    const int nt = nkeys >> 6;
    u32x4 skA[2], svA[2];
#define AT_LOAD(sk, sv, i) do { _Pragma("unroll") for (int _c = 0; _c < 2; ++_c) { const int _idx = tid + 512 * _c; \
        sk[_c] = *(const u32x4*)(kbase + ((size_t)(_idx >> 9) * LK + 64 * (i) + ((_idx & 511) >> 3)) * 64 + (_idx & 7) * 8); \
        sv[_c] = *(const u32x4*)(vtbase + (size_t)(_idx >> 3) * LK + 64 * (i) + (_idx & 7) * 8); } } while (0)
#define AT_STORE(sk, sv, p) do { _Pragma("unroll") for (int _c = 0; _c < 2; ++_c) { const int _idx = tid + 512 * _c; \
        *(LAS u32x4*)(lds + (p) * AT_BUF + AT_K + ((_idx >> 9) * 64 + ((_idx & 511) >> 3)) * 144 + (_idx & 7) * 16) = sk[_c]; \
        *(LAS u32x4*)(lds + (p) * AT_BUF + AT_V + (_idx >> 3) * 144 + (_idx & 7) * 16) = sv[_c]; } } while (0)
#define AT_KF(kb, kk) (*(const LAS bf16x8*)(Kb + (32 * (kb) + q32) * 144 + (16 * (kk) + 8 * hi) * 2))
#define AT_VF(ks, vt) (*(const LAS bf16x8*)(Vb + (32 * (vt) + q32) * 144 + (16 * (ks) + 8 * hi) * 2))
#define AT_TILE(p) do { \
        LAS unsigned char* Kb = lds + (p) * AT_BUF + AT_K + j * (64 * 144); LAS unsigned char* Vb = lds + (p) * AT_BUF + AT_V; \
        bf16x8 kf[4], vf[4], vg[4]; \
        _Pragma("unroll") for (int kk = 0; kk < 4; ++kk) kf[kk] = AT_KF(0, kk); \
        _Pragma("unroll") for (int kb = 0; kb < 2; ++kb) { \
            _Pragma("unroll") for (int vt = 0; vt < 4; ++vt) vf[vt] = AT_VF(2 * kb, vt); \
            __builtin_amdgcn_sched_barrier(0); \
            f32x16 s; \
            _Pragma("unroll") for (int r = 0; r < 16; ++r) s[r] = 0.f; \
            _Pragma("unroll") for (int kk = 0; kk < 4; ++kk) s = __builtin_amdgcn_mfma_f32_32x32x16_bf16(kf[kk], qf[kk], s, 0, 0, 0); \
            __builtin_amdgcn_sched_barrier(0); \
            _Pragma("unroll") for (int vt = 0; vt < 4; ++vt) vg[vt] = AT_VF(2 * kb + 1, vt); \
            if (kb == 0) { _Pragma("unroll") for (int kk = 0; kk < 4; ++kk) kf[kk] = AT_KF(1, kk); } \
            __builtin_amdgcn_sched_barrier(0); \
            _Pragma("unroll") for (int r = 0; r < 16; ++r) { s[r] = __builtin_amdgcn_exp2f(SHIFT ? s[r] - c2 : s[r]); lsum += s[r]; } \
            u32x4 pw0, pw1; \
            pw0.x = cvt_pk_bf16(s[0], s[1]); pw0.y = cvt_pk_bf16(s[2], s[3]); pw0.z = cvt_pk_bf16(s[4], s[5]); pw0.w = cvt_pk_bf16(s[6], s[7]); \
            pw1.x = cvt_pk_bf16(s[8], s[9]); pw1.y = cvt_pk_bf16(s[10], s[11]); pw1.z = cvt_pk_bf16(s[12], s[13]); pw1.w = cvt_pk_bf16(s[14], s[15]); \
            const bf16x8 pb0 = __builtin_bit_cast(bf16x8, pw0), pb1 = __builtin_bit_cast(bf16x8, pw1); \
            _Pragma("unroll") for (int vt = 0; vt < 4; ++vt) o[vt] = __builtin_amdgcn_mfma_f32_32x32x16_bf16(vf[vt], pb0, o[vt], 0, 0, 0); \
            _Pragma("unroll") for (int vt = 0; vt < 4; ++vt) o[vt] = __builtin_amdgcn_mfma_f32_32x32x16_bf16(vg[vt], pb1, o[vt], 0, 0, 0); \
            __builtin_amdgcn_sched_barrier(0); \
        } } while (0)
    AT_LOAD(skA, svA, 0); AT_STORE(skA, svA, 0);
    __syncthreads();
    for (int i = 0; i < nt; i += 2) {
        AT_LOAD(skA, svA, i + 1);
        AT_TILE(0);
        AT_STORE(skA, svA, 1);
        __syncthreads();
        if (i + 2 < nt) AT_LOAD(skA, svA, i + 2);
        AT_TILE(1);
        if (i + 2 < nt) AT_STORE(skA, svA, 0);
        __syncthreads();
    }
#undef AT_TILE
#undef AT_KF
#undef AT_VF
#undef AT_LOAD
#undef AT_STORE
    lsum += __shfl_xor(lsum, 32);
    LAS float* xch = (LAS float*)lds + (size_t)qg * 4096 + lane;
    if (j == 1) {
        const float sc = lam / lsum;
#pragma unroll
        for (int vt = 0; vt < 4; ++vt)
#pragma unroll
            for (int r = 0; r < 16; ++r) xch[(vt * 16 + r) * 64] = o[vt][r] * sc;
    }
    __syncthreads();
    if (j == 0) {
        const float i0 = 1.f / lsum;
        float ss = 0.f;
#pragma unroll
        for (int vt = 0; vt < 4; ++vt)
#pragma unroll
            for (int r = 0; r < 16; ++r) { const float v = o[vt][r] * i0 - xch[(vt * 16 + r) * 64]; o[vt][r] = v; ss += v * v; }
        ss += __shfl_xor(ss, 32);
        const float rstd = rsqrtf(ss * (1.f / 128.f) + EPS) * post_scale;
        const size_t row = (size_t)row0 + 32 * qg + q32;
#pragma unroll
        for (int vt = 0; vt < 4; ++vt)
#pragma unroll
            for (int g4 = 0; g4 < 4; ++g4) {
                const int v0 = 32 * vt + 8 * g4 + 4 * hi;
                const u32x2 gz = *(const u32x2*)(dg + row * NZ + v0);
                const f32x4 sl = *(const f32x4*)(subln + v0);
                const float r0 = o[vt][4 * g4 + 0] * rstd * sl[0] * silu_f(bflo(gz.x)), r1 = o[vt][4 * g4 + 1] * rstd * sl[1] * silu_f(bfhi(gz.x));
                const float r2 = o[vt][4 * g4 + 2] * rstd * sl[2] * silu_f(bflo(gz.y)), r3 = o[vt][4 * g4 + 3] * rstd * sl[3] * silu_f(bfhi(gz.y));
                u32x2 wv; wv.x = cvt_pk_bf16(r0, r1); wv.y = cvt_pk_bf16(r2, r3);
                *(u32x2*)(outp + row * 1024 + v0) = wv;
            }
    }
    __syncthreads();
}

__device__ __forceinline__ void phase_mix(const Args& a, int l, LAS unsigned char* lds) {
    const int G = opaque_s(gridDim.x);
    unsigned char* ws = opaque_ptr(a.ws);
    const bool need_ctx = (l == 0);
#ifndef NO_GLA
    for (int it = BID; it < 256; it += G) gla_unit(a, l, lds, ((it & 7) * 4 + (it >> 6)) * 8 + ((it >> 3) & 7));
#if defined(REPEAT_SUB) && REPEAT_SUB == 1
    for (int it = BID; it < 256; it += G) gla_unit(a, l, lds, it);
#endif
#endif
#ifndef NO_ATT
    {
        const float* scal = (const float*)(ws + OFF_SCAL) + l * 4;
        const float lam = scal[0], c2 = scal[1], post = 1.f - scal[2];
        const bf16_t* z = (const bf16_t*)(ws + OFF_Z);
        const int nun = 512 + (need_ctx ? 64 : 0);
        const bool big = c2 > 48.f;
#define ATTN_UNIT(...) do { if (big) attn_unit<true>(__VA_ARGS__); else attn_unit<false>(__VA_ARGS__); } while (0)
#if defined(REPEAT_SUB) && REPEAT_SUB == 2
        for (int rep = 0; rep < 2; ++rep)
#endif
        for (int u = BID; u < nun; u += G) {
            if (u < 512) { const int vc = (u & 7) * 64 + (u >> 3), bh = vc >> 4, qb = vc & 15, b = bh >> 3, h = bh & 7;
                ATTN_UNIT(lds, (const bf16_t*)(ws + OFF_QN) + (size_t)bh * 2 * SEQ * 64, SEQ, 128 * qb, (const bf16_t*)(ws + OFF_KN) + (size_t)bh * 2 * LK * 64,
                          (const bf16_t*)(ws + OFF_VT) + (size_t)bh * 128 * LK, LK, c2, lam, post, inp(I_SUBLN) + l * 128, z + ZC_DG + h * 128, (bf16_t*)(ws + OFF_DIFFO) + h * 128, b * SEQ + 128 * qb);
            } else { const int uu = u - 512, bh = uu >> 1, qb = uu & 1, b = bh >> 3, h = bh & 7;
                ATTN_UNIT(lds, (const bf16_t*)(ws + OFF_QNC) + (size_t)bh * 2 * LC * 64, LC, 128 * qb, (const bf16_t*)(ws + OFF_KN) + (size_t)bh * 2 * LK * 64,
                          (const bf16_t*)(ws + OFF_VT) + (size_t)bh * 128 * LK, LC, c2, lam, post, inp(I_SUBLN) + l * 128, z + ZC_DG + h * 128, (bf16_t*)(ws + OFF_DIFFO) + h * 128, ML + b * LC + 128 * qb);
            }
        }
    }
#endif
#ifndef NO_POOL
    {
        const int Mrows = need_ctx ? MT : ML;
        pg8::Gemm g{(const bf16_t*)(ws + OFF_DPOOL), (const bf16_t*)(ws + OFF_POOLT + (size_t)l * SZ_POOLT), Mrows, 1024, 256, 1024, 256, 256};
        pg8::StaticOrder S; S.init(Mrows, 1024, G, BID);
        pg8::EpiPool E{(bf16_t*)(ws + OFF_POOLO), (const bf16_t*)(ws + OFF_PGATE)};
        pg8::gemm_phase<pg8::EpiPool, pg8::StaticOrder, true, true>(lds, g, S, E);
    }
#endif
}

__device__ __forceinline__ void phase_post(const Args& a, int l) {
    const int tid = opaque_tid(), lane = tid & 63, wave = tid >> 6, G = opaque_s(gridDim.x);
    const int gw = BID * 8 + wave, NGW = G * 8;
    unsigned char* ws = opaque_ptr(a.ws);
    const bf16_t* z = (const bf16_t*)(ws + OFF_Z);
    const bf16_t* of = (const bf16_t*)(ws + OFF_OF); const bf16_t* ob = of + (size_t)MT * 1024;
    bf16_t* go = (bf16_t*)(ws + OFF_GLAO);
    const int Mrows = (l == 0) ? MT : ML;
    const float* gn = inp(I_GLAN) + l * 256 + ((16 * lane) & 255);
    for (int row = gw; row < Mrows; row += NGW) {
        float x[16], y[16], gz[16];
        const size_t o = (size_t)row * 1024 + 16 * lane;
        unpack8(*(const u32x4*)(of + o), x); unpack8(*(const u32x4*)(of + o + 8), x + 8);
        unpack8(*(const u32x4*)(ob + o), y); unpack8(*(const u32x4*)(ob + o + 8), y + 8);
        unpack8(*(const u32x4*)(z + (size_t)row * NZ + ZC_GG + 16 * lane), gz); unpack8(*(const u32x4*)(z + (size_t)row * NZ + ZC_GG + 16 * lane + 8), gz + 8);
        float ss = 0.f;
#pragma unroll
        for (int e = 0; e < 16; ++e) { x[e] += y[e]; ss += x[e] * x[e]; }
        ss += __shfl_xor(ss, 1); ss += __shfl_xor(ss, 2); ss += __shfl_xor(ss, 4); ss += __shfl_xor(ss, 8);
        const float rstd = rsqrtf(ss * (1.f / 256.f) + EPS);
        float r[16];
#pragma unroll
        for (int e = 0; e < 16; ++e) r[e] = x[e] * rstd * gn[e] * silu_f(gz[e]);
        u32x4 w0, w1;
        w0.x = cvt_pk_bf16(r[0], r[1]); w0.y = cvt_pk_bf16(r[2], r[3]); w0.z = cvt_pk_bf16(r[4], r[5]); w0.w = cvt_pk_bf16(r[6], r[7]);
        w1.x = cvt_pk_bf16(r[8], r[9]); w1.y = cvt_pk_bf16(r[10], r[11]); w1.z = cvt_pk_bf16(r[12], r[13]); w1.w = cvt_pk_bf16(r[14], r[15]);
        *(u32x4*)(go + o) = w0; *(u32x4*)(go + o + 8) = w1;
    }
}

#define XB_TMO      128
#define XB_XCNT(j)  (256  + 64 * (j))
#define XB_XSUB(j)  (1280 + 64 * (j))
#define XB_XGEN(j)  (2304 + 64 * (j))
#define XB_TOP      3328
#define XB_TOPGEN   3392
#define XCD_BAR_WORDS 3456
#define XB_SPIN_CAP (1u << 18)

__device__ __forceinline__ unsigned xb_ld(unsigned* p)              { return __hip_atomic_load(p, __ATOMIC_RELAXED, __HIP_MEMORY_SCOPE_AGENT); }
__device__ __forceinline__ unsigned xb_add(unsigned* p, unsigned v) { return __hip_atomic_fetch_add(p, v, __ATOMIC_RELAXED, __HIP_MEMORY_SCOPE_AGENT); }
__device__ __forceinline__ unsigned xb_xcc_id() { return (unsigned)__builtin_amdgcn_s_getreg((3 << 11) | 20) & 0xFu; }
#define XB_SPIN(cond, bar) do { unsigned _sp = 0; while (cond) { __builtin_amdgcn_s_sleep(1); \
    if ((++_sp & 255u) == 0u) { if (xb_ld(&(bar)[XB_TMO])) break; if (_sp > XB_SPIN_CAP) { atomicAdd(&(bar)[XB_TMO], 1u); break; } } } } while (0)

struct XcdBarrier {
    unsigned* bar; unsigned x;
    volatile LAS unsigned* st;
};

__device__ __forceinline__ XcdBarrier xcd_barrier_post(unsigned* bar, volatile LAS unsigned* st) {
    XcdBarrier b; b.bar = bar; b.x = xb_xcc_id(); b.st = st;
    if (threadIdx.x == 0) (void)xb_add(&bar[XB_XCNT(b.x)], 1u);
    return b;
}
__device__ __forceinline__ void xcd_barrier_complete(unsigned* bar, unsigned x, unsigned& nloc, unsigned& nx) {
    const unsigned G = gridDim.x * gridDim.y * gridDim.z;
    unsigned sum, cnt, mine, sp = 0u;
    for (;;) {
        sum = 0u; cnt = 0u; mine = 0u;
#pragma unroll
        for (unsigned j = 0; j < 16; ++j) { const unsigned c = xb_ld(&bar[XB_XCNT(j)]); sum += c; cnt += (c > 0u) ? 1u : 0u; mine = (j == x) ? c : mine; }
        if (sum == G) break;
        __builtin_amdgcn_s_sleep(1);
        if ((++sp & 255u) == 0u) { if (xb_ld(&bar[XB_TMO])) break; if (sp > XB_SPIN_CAP) { atomicAdd(&bar[XB_TMO], 1u); break; } }
    }
    nloc = mine > 0u ? mine : 1u; nx = cnt > 0u ? cnt : 1u;
}

__device__ __forceinline__ void xcd_barrier(const XcdBarrier& b) {
    asm volatile("s_waitcnt vmcnt(0)" ::: "memory");
    __syncthreads();
    if (threadIdx.x == 0) {
        unsigned* bar = b.bar;
        __builtin_amdgcn_s_waitcnt(0);
        unsigned nloc = b.st[0], nx = b.st[1];
        if (nloc == 0u) { xcd_barrier_complete(bar, b.x, nloc, nx); b.st[0] = nloc; b.st[1] = nx; }
        const unsigned old = xb_add(&bar[XB_XSUB(b.x)], 1u);
        const unsigned gen = old / nloc;
        if (old + 1u == (gen + 1u) * nloc) {
            __builtin_amdgcn_fence(__ATOMIC_RELEASE, "agent");
            asm volatile("s_waitcnt vmcnt(0)" ::: "memory");
            const unsigned og = xb_add(&bar[XB_TOP], 1u);
            const unsigned tg = og / nx;
            if (og + 1u == (tg + 1u) * nx) xb_add(&bar[XB_TOPGEN], 1u);
            else XB_SPIN(xb_ld(&bar[XB_TOPGEN]) == tg, bar);
            __builtin_amdgcn_fence(__ATOMIC_ACQUIRE, "agent");
            xb_add(&bar[XB_XGEN(b.x)], 1u);
            asm volatile("s_waitcnt vmcnt(0)" ::: "memory");
        } else {
            XB_SPIN(xb_ld(&bar[XB_XGEN(b.x)]) == gen, bar);
            __builtin_amdgcn_fence(__ATOMIC_ACQUIRE, "agent");
            asm volatile("s_waitcnt vmcnt(0)" ::: "memory");
        }
    }
    __syncthreads();
}

#ifndef REPEAT_K
#define REPEAT_K -1
#endif
#define SEAM() do { XcdBarrier xb; xb.bar = (unsigned*)(opaque_ptr(a.ws) + OFF_BAR); xb.x = xb_xcc_id(); xb.st = (volatile LAS unsigned*)(lds + 131072 + 512); xcd_barrier(xb); } while (0)
#define REP(k) for (int rep_ = 0; rep_ < (REPEAT_K == (k) ? 2 : 1); ++rep_)
template <int l> __device__ __forceinline__ void run_layer(const Args& a, LAS unsigned char* lds) {
    constexpr int Mout = (l == 0) ? MT : ML;
    REP(0) phase_norm(a, l);
    SEAM();
    REP(1) {
        unsigned char* ws = opaque_ptr(a.ws); const int G = opaque_s(gridDim.x);
        pg8::Gemm g{(const bf16_t*)(ws + OFF_H), (const bf16_t*)(ws + OFF_WIN + (size_t)l * SZ_WIN), MT, NZ, DM, DM, DM, 0};
        pg8::EpiBf16 E{(bf16_t*)(ws + OFF_Z), NZ};
        if (l == 0) { pg8::StaticOrder S; S.init(MT, NZ, G, BID); pg8::gemm_phase<pg8::EpiBf16, pg8::StaticOrder, true, true>(lds, g, S, E); }
        else { pg8::CtxSkipOrder S; S.init(G, BID); pg8::gemm_phase<pg8::EpiBf16, pg8::CtxSkipOrder, true, true>(lds, g, S, E); }
    }
    SEAM();
    REP(2) phase_prep(a, l, lds);
    SEAM();
    REP(3) phase_mix(a, l, lds);
    SEAM();
    REP(4) phase_post(a, l);
    SEAM();
    REP(5) {
        unsigned char* ws = opaque_ptr(a.ws); const int G = opaque_s(gridDim.x);
        pg8::SegOrder3 S; S.base.init(Mout, DM, G, BID);
        const bf16_t* wb = (const bf16_t*)(ws + OFF_WB + (size_t)l * SZ_WB);
        pg8::Gemm g{(const bf16_t*)(ws + OFF_POOLO), wb, Mout, DM, 1024, 1024, 1024, 0,
                    (const bf16_t*)(ws + OFF_DIFFO), (const bf16_t*)(ws + OFF_GLAO), wb + (size_t)DM * 1024, wb + (size_t)2 * DM * 1024};
        pg8::EpiMerge3 E{(bf16_t*)(ws + OFF_H), (const bf16_t*)(ws + OFF_Z) + ZC_MG};
        pg8::gemm_phase<pg8::EpiMerge3, pg8::SegOrder3, true, true, 3>(lds, g, S, E);
    }
    SEAM();
    REP(6) {
        unsigned char* ws = opaque_ptr(a.ws); const int G = opaque_s(gridDim.x);
        pg8::Gemm g{(const bf16_t*)(ws + OFF_H), (const bf16_t*)(ws + OFF_WOUT + (size_t)l * SZ_WOUT), Mout, DM, DM, DM, DM, 0};
        pg8::StaticOrder S; S.init(Mout, DM, G, BID);
        pg8::EpiOut E{l == 0 ? inp(I_X) : (const float*)(ws + OFF_X1), l == 0 ? inp(I_CTX) : (const float*)(ws + OFF_X1) + (size_t)ML * DM,
                      l == 0 ? (float*)(ws + OFF_X1) : arg_out(), (const float*)(ws + OFF_MOD) + (size_t)l * 5 * 6144};
        pg8::gemm_phase<pg8::EpiOut, pg8::StaticOrder, true, true>(lds, g, S, E);
    }
}

__global__ void __launch_bounds__(512, 2) hybrid_fwd(Args a) {
    extern __shared__ __attribute__((aligned(16))) unsigned char smem[];
    LAS unsigned char* lds = (LAS unsigned char*)smem;
    cg::grid_group grid = cg::this_grid();
    volatile LAS unsigned* bst = (volatile LAS unsigned*)(lds + 131072 + 512);
    if (threadIdx.x < 2) bst[threadIdx.x] = 0u;
    __syncthreads();
    (void)xcd_barrier_post((unsigned*)(a.ws + OFF_BAR), bst);
    REP(7) phase_p0(a, lds);
    grid.sync();
    run_layer<0>(a, lds);
    SEAM();
    run_layer<1>(a, lds);
}

extern "C" void kernel_launch(void* const* d_in, const int* in_sizes, int n_in, void* d_out, int out_size, void* d_ws, size_t ws_size, hipStream_t stream) {
    static int grid = 0;
    if (grid == 0) {
        if (n_in != 26 || out_size != ML * DM || ws_size < WS_END) { fprintf(stderr, "kernel_launch: expected 26 inputs, out %d, ws >= %zu; got n_in %d out %d ws %zu\n", ML * DM, (size_t)WS_END, n_in, out_size, ws_size); grid = -1; return; }
        int dev = 0, cus = 0, per_cu = 0;
        if (hipGetDevice(&dev) != hipSuccess || hipDeviceGetAttribute(&cus, hipDeviceAttributeMultiprocessorCount, dev) != hipSuccess) { grid = -1; return; }
        if (hipFuncSetAttribute((const void*)hybrid_fwd, hipFuncAttributeMaxDynamicSharedMemorySize, LDS_BYTES) != hipSuccess) { fprintf(stderr, "kernel_launch: hipFuncSetAttribute failed\n"); grid = -1; return; }
        if (hipOccupancyMaxActiveBlocksPerMultiprocessor(&per_cu, (const void*)hybrid_fwd, 512, LDS_BYTES) != hipSuccess || per_cu < 1) { fprintf(stderr, "kernel_launch: occupancy query says %d blocks per CU\n", per_cu); (void)hipGetLastError(); grid = -1; return; }
        grid = cus;
    }
    if (grid < 0) return;
    if (hipMemsetAsync((char*)d_ws + OFF_BAR, 0, BAR_BYTES, stream) != hipSuccess) { fprintf(stderr, "kernel_launch: memset of the barrier words failed\n"); return; }
    Args a{};
    for (int i = 0; i < 26; ++i) a.in[i] = (const float*)d_in[i];
    a.out = (float*)d_out; a.ws = (unsigned char*)d_ws;
    a.ph_lo = 0; a.ph_hi = NPH;
    void* args[] = {&a};
    const hipError_t e = hipLaunchCooperativeKernel((const void*)hybrid_fwd, dim3(grid), dim3(512), args, LDS_BYTES, stream);
    if (e != hipSuccess) fprintf(stderr, "kernel_launch: cooperative launch failed: %s (grid %d)\n", hipGetErrorString(e), grid);
}
```

```cpp
#include <hip/hip_runtime.h>
#include <hip/hip_cooperative_groups.h>
#include <cstdio>
#include <cstdint>
namespace cg = cooperative_groups;

#ifndef MK_N_LAUNCHES
#define MK_N_LAUNCHES 1
#endif

#define LAS __attribute__((address_space(3)))
typedef unsigned short bf16_t;
typedef short bf16x8 __attribute__((ext_vector_type(8)));
typedef float f32x4 __attribute__((ext_vector_type(4)));
typedef float f32x16 __attribute__((ext_vector_type(16)));
typedef unsigned u32x4 __attribute__((ext_vector_type(4)));
typedef unsigned u32x2 __attribute__((ext_vector_type(2)));

constexpr int DM = 2048, NB = 4, SEQ = 2048, LC = 256, ML = NB * SEQ, MC = NB * LC, MT = ML + MC;
constexpr int DIN = 15392, NZ = 15616;
constexpr int ZC_PU = 0, ZC_PG = 1024, ZC_DQ = 2048, ZC_DK = 3072, ZC_DV = 4096, ZC_DG = 5120, ZC_GQ = 6144, ZC_GK = 6656, ZC_GV = 7168, ZC_GG = 8192, ZC_LR = 9216, ZC_MG = 9472;
constexpr int LK = LC + SEQ;
constexpr float EPS = 1e-6f, LOG2E = 1.4426950408889634f;
constexpr int NPH = 15;

constexpr size_t SZ_WIN = (size_t)NZ * DM * 2, SZ_WB = (size_t)3 * DM * 1024 * 2, SZ_WOUT = (size_t)DM * DM * 2, SZ_POOLT = (size_t)4 * 256 * 256 * 2;
constexpr size_t OFF_WIN = 0;
constexpr size_t OFF_WB = OFF_WIN + 2 * SZ_WIN;
constexpr size_t OFF_WOUT = OFF_WB + 2 * SZ_WB;
constexpr size_t OFF_POOLT = OFF_WOUT + 2 * SZ_WOUT;
constexpr size_t OFF_MOD = OFF_POOLT + 2 * SZ_POOLT;
constexpr size_t OFF_SCAL = OFF_MOD + (size_t)2 * 5 * 6144 * 4;
constexpr size_t OFF_H = OFF_SCAL + 256;
constexpr size_t OFF_Z = OFF_H + (size_t)MT * DM * 2;
constexpr size_t OFF_QN = OFF_Z + (size_t)MT * NZ * 2;
constexpr size_t OFF_QNC = OFF_QN + (size_t)ML * 1024 * 2;
constexpr size_t OFF_KN = OFF_QNC + (size_t)MC * 1024 * 2;
constexpr size_t OFF_VT = OFF_KN + (size_t)MT * 1024 * 2;
constexpr size_t SZ_G = (size_t)MT * 512 * 2;
constexpr size_t OFF_GQ = OFF_VT + (size_t)MT * 1024 * 2;
constexpr size_t OFF_GK = OFF_GQ + 2 * SZ_G;
constexpr size_t OFF_GH = OFF_GK + 2 * SZ_G;
constexpr size_t OFF_DEC = OFF_GH + 2 * SZ_G;
constexpr size_t OFF_OF = OFF_DEC + (size_t)2 * 144 * 512 * 4;
constexpr size_t OFF_DPOOL = OFF_OF + 2 * (size_t)MT * 1024 * 2;
constexpr size_t OFF_POOLO = OFF_DPOOL + (size_t)MT * 1024 * 2;
constexpr size_t OFF_DIFFO = OFF_POOLO + (size_t)MT * 1024 * 2;
constexpr size_t OFF_GLAO = OFF_DIFFO + (size_t)MT * 1024 * 2;
constexpr size_t OFF_YACC = OFF_GLAO + (size_t)MT * 1024 * 2;
constexpr size_t OFF_X1 = OFF_YACC + (size_t)MT * DM * 4;
constexpr size_t OFF_PGATE = OFF_X1 + (size_t)MT * DM * 4;
constexpr size_t OFF_BAR = OFF_PGATE + (size_t)MT * 1024 * 2;
constexpr size_t BAR_BYTES = 16384;
constexpr size_t OFF_GVT = OFF_BAR + BAR_BYTES;
constexpr size_t WS_END = OFF_GVT + (size_t)MT * 1024 * 2;

constexpr int LDS_BYTES = 135168;

#define BID opaque_s((int)blockIdx.x)
#define GAS __attribute__((address_space(1)))
__device__ __forceinline__ unsigned char* opaque_ptr(unsigned char* p) { GAS unsigned char* q = (GAS unsigned char*)p; asm volatile("" : "+s"(q)); return (unsigned char*)q; }
__device__ __forceinline__ int opaque_s(int v) { asm volatile("" : "+s"(v)); return v; }
__device__ __forceinline__ int opaque_tid() { int t = threadIdx.x; asm volatile("" : "+v"(t)); return t; }
typedef float f32x2_t __attribute__((ext_vector_type(2))); typedef __bf16 bf16x2_t __attribute__((ext_vector_type(2)));
__device__ __forceinline__ unsigned cvt_pk_bf16(float lo, float hi) { f32x2_t v = {lo, hi}; bf16x2_t b = __builtin_convertvector(v, bf16x2_t); return __builtin_bit_cast(unsigned, b); }
__device__ __forceinline__ bf16_t f2bf(float f) { return (bf16_t)(cvt_pk_bf16(f, 0.f) & 0xffffu); }
__device__ __forceinline__ float bf2f(bf16_t v) { return __builtin_bit_cast(float, (unsigned)v << 16); }
__device__ __forceinline__ float bflo(unsigned u) { return __builtin_bit_cast(float, u << 16); }
__device__ __forceinline__ float bfhi(unsigned u) { return __builtin_bit_cast(float, u & 0xffff0000u); }
__device__ __forceinline__ float silu_f(float x) { return x * __builtin_amdgcn_rcpf(1.f + __expf(-x)); }
__device__ __forceinline__ float sigmoid_f(float x) { return __builtin_amdgcn_rcpf(1.f + __expf(-x)); }
__device__ __forceinline__ float logsig_f(float a) { return fminf(a, 0.f) - __logf(1.f + __expf(-fabsf(a))); }
__device__ __forceinline__ float wave_sum(float v) {
#pragma unroll
    for (int o = 1; o < 64; o <<= 1) v += __shfl_xor(v, o);
    return v;
}
__device__ __forceinline__ float wave_max(float v) {
#pragma unroll
    for (int o = 1; o < 64; o <<= 1) v = fmaxf(v, __shfl_xor(v, o));
    return v;
}
__device__ __forceinline__ void unpack8(u32x4 w, float* f) { f[0] = bflo(w.x); f[1] = bfhi(w.x); f[2] = bflo(w.y); f[3] = bfhi(w.y); f[4] = bflo(w.z); f[5] = bfhi(w.z); f[6] = bflo(w.w); f[7] = bfhi(w.w); }

namespace pg8 {
constexpr int BM = 256, BK = 64, HALF = 128, HTB = HALF * BK * 2, STAGE_BYTES = 8 * HTB, NXCD = 8, WGM = 8;
__host__ __device__ __forceinline__ int lds_byte(int r, int c) { const int st = (r >> 4) * 2 + (c >> 5), rr = r & 15, cc = c & 31, ob = rr * 64 + cc * 2; return st * 1024 + (ob ^ (((ob >> 9) & 1) << 5)); }
__host__ __device__ __forceinline__ void stage_rc(int b, int& R, int& C) { const int st = b / 1024, sb = b % 1024, swz = sb ^ (((sb >> 9) & 1) << 5); R = (st >> 1) * 16 + swz / 64; C = (st & 1) * 32 + (swz % 64) / 2; }
__host__ __device__ __forceinline__ int perm32(int rho) { const int n = rho >> 4, i = rho & 15; return 8 * (i >> 2) + 4 * n + (i & 3); }

struct Unit { int pm, pn, seg; };
struct Gemm { const bf16_t* A; const bf16_t* Bt; int M, N, K; int lda, ldb; int a_pn_off; const bf16_t* A1; const bf16_t* A2; const bf16_t* B1; const bf16_t* B2; };

struct StaticOrder {
    int nM, nN, nwg, G, c;
    __host__ __device__ void init(int M, int N, int G_, int c_) { nM = M / BM; nN = N / BM; nwg = nM * nN; G = G_; c = c_; }
    __host__ __device__ bool next(int i, Unit& u) const {
        const long L = (long)i * G + c; if (L >= nwg) return false;
        int wgid = (int)L; { const int q = nwg / NXCD, r = nwg % NXCD, xcd = wgid % NXCD, off = wgid / NXCD; wgid = (xcd < r ? xcd * (q + 1) : r * (q + 1) + (xcd - r) * q) + off; }
        const int nig = WGM * nN, gid = wgid / nig, fm = gid * WGM, gsz = (nM - fm) < WGM ? (nM - fm) : WGM;
        u.pm = fm + ((wgid % nig) % gsz); u.pn = (wgid % nig) / gsz; u.seg = 0; return true;
    }
    __device__ __forceinline__ void a_ready(const Unit&) const {}
    __device__ __forceinline__ void done(const Unit&) const {}
};

struct CtxSkipOrder {
    StaticOrder base; int nbase;
    __host__ __device__ void init(int G_, int c_) { base.init(ML, NZ, G_, c_); nbase = base.nwg; }
    __host__ __device__ bool next(int i, Unit& u) const {
        const long L = (long)i * base.G + base.c;
        if (L < nbase) return base.next(i, u);
        const int e = (int)(L - nbase); if (e >= 4 * 15) return false;
        const int j = e % 15; u.pm = 32 + e / 15; u.pn = j < 8 ? 12 + j : (j < 14 ? 18 + j : 36); u.seg = 0; return true;
    }
    __device__ __forceinline__ void a_ready(const Unit&) const {}
    __device__ __forceinline__ void done(const Unit&) const {}
};
struct SegOrder3 {
    StaticOrder base;
    __host__ __device__ bool next(int i, Unit& u) const { const int q = i / 3; if (!base.next(q, u)) return false; u.seg = i - 3 * q; return true; }
    __device__ __forceinline__ void a_ready(const Unit&) const {}
    __device__ __forceinline__ void done(const Unit&) const {}
};
struct EpiBf16 {
    static constexpr bool PERM = true, AFTER_DRAIN = false;
    bf16_t* O; int ldc;
    __device__ __forceinline__ void operator()(const f32x4 (&acc)[2][2][4][2], const Unit& u, int wr, int wc, int fr, int fq) const {
        const int row0 = u.pm * BM + wr * 64 + fr, col0 = u.pn * BM + wc * 32 + 8 * fq;
#pragma unroll
        for (int ai = 0; ai < 2; ++ai)
#pragma unroll
            for (int m = 0; m < 4; ++m) { bf16_t* rowp = O + (size_t)(row0 + ai * HALF + m * 16) * ldc + col0;
#pragma unroll
                for (int bj = 0; bj < 2; ++bj) { const f32x4 v0 = acc[ai][bj][m][0], v1 = acc[ai][bj][m][1];
                    u32x4 w; w.x = cvt_pk_bf16(v0[0], v0[1]); w.y = cvt_pk_bf16(v0[2], v0[3]); w.z = cvt_pk_bf16(v1[0], v1[1]); w.w = cvt_pk_bf16(v1[2], v1[3]);
                    *(u32x4*)(rowp + bj * HALF) = w; } }
    }
};

template <class Epi, class Sched, bool ALIGN_EPI = false, bool SP2 = false, int NSEG = 1>
__device__ __forceinline__ void gemm_phase(LAS unsigned char* lds, const Gemm g, const Sched& S, const Epi& E) {
    const int tid = opaque_tid(), wid = __builtin_amdgcn_readfirstlane(tid >> 6), lane = tid & 63, wr = wid >> 2, wc = wid & 3, fr = lane & 15, fq = lane >> 4;
    const int K = opaque_s(g.K), nt = K / BK;
    unsigned voffA[2], voffB[2];
#pragma unroll
    for (int i = 0; i < 2; ++i) { int R, C; stage_rc(tid * 16 + i * 8192, R, C); const int Rb = Epi::PERM ? ((R & ~31) + perm32(R & 31)) : R;
        voffA[i] = (unsigned)(R * g.lda + C) * 2u; voffB[i] = (unsigned)(Rb * g.ldb + C) * 2u; }
    const size_t kstep = (size_t)(BK * 2);
    const size_t hstepA = (size_t)HALF * g.lda * 2, hstepB = (size_t)HALF * g.ldb * 2;
    const size_t tstepA = 2 * hstepA, tstepB = 2 * hstepB;
    const size_t pnA = (size_t)g.a_pn_off * 2;
    const unsigned ldsw = (unsigned)wid * 1024u;
    const int aoff = lds_byte(wr * 64 + fr, fq * 8), boff = lds_byte(wc * 32 + fr, fq * 8);
#define PG8_SA(b, h) (((b) * 2 + (h)) * HTB)
#define PG8_SB(b, h) ((4 + (b) * 2 + (h)) * HTB)
#define PG8_STAGE(bufoff, gbase, voff) do { _Pragma("unroll") for (int _i = 0; _i < 2; ++_i) \
        __builtin_amdgcn_global_load_lds((const unsigned*)((const char*)(gbase) + (voff)[_i]), (LAS unsigned*)(lds + (bufoff) + ldsw + _i * 8192), 16, 0, 0); } while (0)
#define PG8_LDA(dst, b, h) do { _Pragma("unroll") for (int m = 0; m < 4; ++m) _Pragma("unroll") for (int k = 0; k < 2; ++k) dst[m][k] = *(const LAS bf16x8*)(lds + PG8_SA(b, h) + aoff + m * 2048 + k * 1024); } while (0)
#define PG8_LDB(dst, b, h) do { _Pragma("unroll") for (int n = 0; n < 2; ++n) _Pragma("unroll") for (int k = 0; k < 2; ++k) dst[n][k] = *(const LAS bf16x8*)(lds + PG8_SB(b, h) + boff + n * 2048 + k * 1024); } while (0)
#define PG8_MMA(ai, bj, At, Bt) do { __builtin_amdgcn_s_setprio(1); _Pragma("unroll") for (int m = 0; m < 4; ++m) _Pragma("unroll") for (int n = 0; n < 2; ++n) _Pragma("unroll") for (int k = 0; k < 2; ++k) \
        acc[ai][bj][m][n] = __builtin_amdgcn_mfma_f32_16x16x32_bf16(Bt[n][k], At[m][k], acc[ai][bj][m][n], 0, 0, 0); __builtin_amdgcn_s_setprio(0); } while (0)
#define PG8_WAIT_V(n) asm volatile("s_waitcnt vmcnt(" #n ")" ::: "memory")
#define PG8_WAIT_L(n) asm volatile("s_waitcnt lgkmcnt(" #n ")" ::: "memory")
#define PG8_BAR __builtin_amdgcn_s_barrier()
#define PG8_SCHED __builtin_amdgcn_sched_barrier(0)
    Unit cur, nxt; int ui = 0;
    if (!S.next(0, cur)) return;
    f32x4 acc[2][2][4][2];
#pragma unroll
    for (int a = 0; a < 2; ++a)
#pragma unroll
        for (int b = 0; b < 2; ++b)
#pragma unroll
            for (int m = 0; m < 4; ++m)
#pragma unroll
                for (int n = 0; n < 2; ++n) acc[a][b][m][n] = (f32x4){0.f, 0.f, 0.f, 0.f};
    bf16x8 At[4][2], B0[2][2], B1[2][2];
#define PG8_ASEG(u) ((const char*)(NSEG == 1 || (u).seg == 0 ? g.A : ((u).seg == 1 ? g.A1 : g.A2)))
#define PG8_BSEG(u) ((const char*)(NSEG == 1 || (u).seg == 0 ? g.Bt : ((u).seg == 1 ? g.B1 : g.B2)))
    const char* cA = PG8_ASEG(cur) + (size_t)cur.pm * tstepA + (size_t)cur.pn * pnA; const char* cB = PG8_BSEG(cur) + (size_t)cur.pn * tstepB;
    S.a_ready(cur);
    if constexpr (SP2) {
        PG8_STAGE(PG8_SB(0, 0), cB, voffB); PG8_STAGE(PG8_SB(0, 1), cB + hstepB, voffB); PG8_STAGE(PG8_SA(0, 0), cA, voffA); PG8_STAGE(PG8_SA(0, 1), cA + hstepA, voffA);
        if (wr == 1) PG8_BAR;
        PG8_WAIT_V(2); PG8_BAR;
        PG8_STAGE(PG8_SB(1, 0), cB + kstep, voffB); PG8_STAGE(PG8_SA(1, 0), cA + kstep, voffA); PG8_STAGE(PG8_SB(1, 1), cB + hstepB + kstep, voffB);
        PG8_WAIT_V(6); PG8_BAR;
    } else {
        PG8_STAGE(PG8_SB(0, 0), cB, voffB); PG8_STAGE(PG8_SA(0, 0), cA, voffA); PG8_STAGE(PG8_SB(0, 1), cB + hstepB, voffB); PG8_STAGE(PG8_SA(0, 1), cA + hstepA, voffA);
        if (wr == 1) PG8_BAR;
        PG8_WAIT_V(4); PG8_BAR;
        PG8_STAGE(PG8_SB(1, 0), cB + kstep, voffB); PG8_STAGE(PG8_SA(1, 0), cA + kstep, voffA); PG8_STAGE(PG8_SB(1, 1), cB + hstepB + kstep, voffB);
        PG8_WAIT_V(6); PG8_BAR;
    }
    for (;;) {
        const bool has_next = S.next(ui + 1, nxt);
        const char* nA = has_next ? PG8_ASEG(nxt) + (size_t)nxt.pm * tstepA + (size_t)nxt.pn * pnA : cA; const char* nB = has_next ? PG8_BSEG(nxt) + (size_t)nxt.pn * tstepB : cB;
        for (int t = 0; t < nt; t += 2) {
            const bool last = (t == nt - 2);
            const char* a1 = cA + (size_t)(t + 1) * kstep;
            const char* a2 = last ? nA : cA + (size_t)(t + 2) * kstep; const char* b2 = last ? nB : cB + (size_t)(t + 2) * kstep;
            const char* a3 = a2 + kstep; const char* b3 = b2 + kstep;
            if (last && has_next) S.a_ready(nxt);
            if constexpr (SP2) {
            PG8_LDB(B0, 0, 0); PG8_LDB(B1, 0, 1); PG8_SCHED; PG8_LDA(At, 0, 0); PG8_STAGE(PG8_SA(1, 1), a1 + hstepA, voffA);
            PG8_WAIT_V(8); PG8_WAIT_L(0); PG8_BAR; PG8_MMA(0, 0, At, B0); PG8_MMA(0, 1, At, B1); PG8_BAR; PG8_SCHED;
            PG8_LDA(At, 0, 1); PG8_STAGE(PG8_SB(0, 0), b2, voffB); PG8_STAGE(PG8_SB(0, 1), b2 + hstepB, voffB); PG8_STAGE(PG8_SA(0, 0), a2, voffA);
            PG8_WAIT_V(8); PG8_WAIT_L(0); PG8_BAR; PG8_MMA(1, 0, At, B0); PG8_MMA(1, 1, At, B1); PG8_BAR; PG8_SCHED;
            PG8_LDB(B0, 1, 0); PG8_LDB(B1, 1, 1); PG8_SCHED; PG8_LDA(At, 1, 0); PG8_STAGE(PG8_SA(0, 1), a2 + hstepA, voffA);
            PG8_WAIT_V(8); PG8_WAIT_L(0); PG8_BAR; PG8_MMA(0, 0, At, B0); PG8_MMA(0, 1, At, B1); PG8_BAR; PG8_SCHED;
            PG8_LDA(At, 1, 1); PG8_STAGE(PG8_SB(1, 0), b3, voffB); PG8_STAGE(PG8_SB(1, 1), b3 + hstepB, voffB); PG8_STAGE(PG8_SA(1, 0), a3, voffA);
            PG8_WAIT_V(8); PG8_WAIT_L(0); PG8_BAR; PG8_MMA(1, 0, At, B0); PG8_MMA(1, 1, At, B1); PG8_BAR; PG8_SCHED;
            } else {
            PG8_LDB(B0, 0, 0); PG8_SCHED; PG8_LDA(At, 0, 0); PG8_STAGE(PG8_SA(1, 1), a1 + hstepA, voffA);
            PG8_WAIT_L(8); PG8_BAR; PG8_WAIT_L(0); PG8_MMA(0, 0, At, B0); PG8_BAR; PG8_SCHED;
            PG8_LDB(B1, 0, 1); PG8_STAGE(PG8_SB(0, 0), b2, voffB);
            PG8_BAR; PG8_WAIT_L(0); PG8_MMA(0, 1, At, B1); PG8_BAR;
            PG8_LDA(At, 0, 1); PG8_STAGE(PG8_SA(0, 0), a2, voffA);
            PG8_BAR; PG8_WAIT_L(0); PG8_MMA(1, 0, At, B0); PG8_BAR; PG8_SCHED;
            PG8_STAGE(PG8_SB(0, 1), b2 + hstepB, voffB);
            PG8_WAIT_V(6); PG8_BAR; PG8_MMA(1, 1, At, B1); PG8_BAR;
            PG8_LDB(B0, 1, 0); PG8_SCHED; PG8_LDA(At, 1, 0); PG8_STAGE(PG8_SA(0, 1), a2 + hstepA, voffA);
            PG8_WAIT_L(8); PG8_BAR; PG8_WAIT_L(0); PG8_MMA(0, 0, At, B0); PG8_BAR; PG8_SCHED;
            PG8_LDB(B1, 1, 1); PG8_STAGE(PG8_SB(1, 0), b3, voffB);
            PG8_BAR; PG8_WAIT_L(0); PG8_MMA(0, 1, At, B1); PG8_BAR;
            PG8_LDA(At, 1, 1); PG8_STAGE(PG8_SA(1, 0), a3, voffA);
            PG8_BAR; PG8_WAIT_L(0); PG8_MMA(1, 0, At, B0); PG8_BAR; PG8_SCHED;
            PG8_STAGE(PG8_SB(1, 1), b3 + hstepB, voffB);
            PG8_WAIT_V(6); PG8_BAR; PG8_MMA(1, 1, At, B1); PG8_BAR;
            }
        }
        if constexpr (ALIGN_EPI) { if (wr == 0) PG8_BAR; }
        E(acc, cur, wr, wc, fr, fq); S.done(cur);
        if (!has_next) break;
        if (NSEG == 1 || cur.seg == NSEG - 1)
#pragma unroll
        for (int a = 0; a < 2; ++a)
#pragma unroll
            for (int b = 0; b < 2; ++b)
#pragma unroll
                for (int m = 0; m < 4; ++m)
#pragma unroll
                    for (int n = 0; n < 2; ++n) acc[a][b][m][n] = (f32x4){0.f, 0.f, 0.f, 0.f};
        cur = nxt; cA = nA; cB = nB; ++ui;
        if constexpr (ALIGN_EPI) { if (wr == 1) PG8_BAR; }
    }
    PG8_WAIT_V(0);
    if constexpr (!ALIGN_EPI) { if (wr == 0) PG8_BAR; }
    PG8_BAR;
#undef PG8_ASEG
#undef PG8_BSEG
#undef PG8_SA
#undef PG8_SB
#undef PG8_STAGE
#undef PG8_LDA
#undef PG8_LDB
#undef PG8_MMA
#undef PG8_WAIT_V
#undef PG8_WAIT_L
#undef PG8_BAR
#undef PG8_SCHED
}

struct EpiPool {
    static constexpr bool PERM = true, AFTER_DRAIN = false;
    bf16_t* O; const bf16_t* pgate;
    __device__ __forceinline__ void operator()(const f32x4 (&acc)[2][2][4][2], const Unit& u, int wr, int wc, int fr, int fq) const {
        const int row0 = u.pm * BM + wr * 64 + fr, col0 = u.pn * BM + wc * 32 + 8 * fq;
#pragma unroll
        for (int ai = 0; ai < 2; ++ai)
#pragma unroll
            for (int m = 0; m < 4; ++m)
#pragma unroll
                for (int bj = 0; bj < 2; ++bj) {
                    const int row = row0 + ai * HALF + m * 16, col = col0 + bj * HALF;
                    const u32x4 gz = *(const u32x4*)(pgate + (size_t)row * 1024 + col);
                    const f32x4 v0 = acc[ai][bj][m][0], v1 = acc[ai][bj][m][1];
                    u32x4 w;
                    w.x = cvt_pk_bf16(v0[0] * bflo(gz.x), v0[1] * bfhi(gz.x));
                    w.y = cvt_pk_bf16(v0[2] * bflo(gz.y), v0[3] * bfhi(gz.y));
                    w.z = cvt_pk_bf16(v1[0] * bflo(gz.z), v1[1] * bfhi(gz.z));
                    w.w = cvt_pk_bf16(v1[2] * bflo(gz.w), v1[3] * bfhi(gz.w));
                    *(u32x4*)(O + (size_t)row * 1024 + col) = w;
                    __builtin_amdgcn_sched_barrier(0);
                }
    }
};
template <int PASS> struct EpiMerge {
    static constexpr bool PERM = true, AFTER_DRAIN = false;
    float* yacc; bf16_t* y; const bf16_t* zg;
    __device__ __forceinline__ void operator()(const f32x4 (&acc)[2][2][4][2], const Unit& u, int wr, int wc, int fr, int fq) const {
        const int row0 = u.pm * BM + wr * 64 + fr, col0 = u.pn * BM + wc * 32 + 8 * fq;
#pragma unroll
        for (int ai = 0; ai < 2; ++ai)
#pragma unroll
            for (int m = 0; m < 4; ++m)
#pragma unroll
                for (int bj = 0; bj < 2; ++bj) {
                    const int row = row0 + ai * HALF + m * 16, col = col0 + bj * HALF;
                    float gz[8]; unpack8(*(const u32x4*)(zg + (size_t)row * NZ + col), gz);
                    const f32x4 v0 = acc[ai][bj][m][0], v1 = acc[ai][bj][m][1];
                    f32x4 r0, r1;
#pragma unroll
                    for (int e = 0; e < 4; ++e) { r0[e] = v0[e] * sigmoid_f(gz[e]); r1[e] = v1[e] * sigmoid_f(gz[4 + e]); }
                    float* yp = yacc + (size_t)row * DM + col;
                    if (PASS >= 1) { r0 += *(const f32x4*)yp; r1 += *(const f32x4*)(yp + 4); }
                    if (PASS <= 1) { *(f32x4*)yp = r0; *(f32x4*)(yp + 4) = r1; }
                    else { u32x4 w; w.x = cvt_pk_bf16(r0[0], r0[1]); w.y = cvt_pk_bf16(r0[2], r0[3]); w.z = cvt_pk_bf16(r1[0], r1[1]); w.w = cvt_pk_bf16(r1[2], r1[3]);
                        *(u32x4*)(y + (size_t)row * DM + col) = w; }
                    __builtin_amdgcn_sched_barrier(0);
                }
    }
};
struct EpiMerge3 {
    static constexpr bool PERM = true, AFTER_DRAIN = false;
    bf16_t* y; const bf16_t* zg;
    __device__ __forceinline__ void operator()(f32x4 (&acc)[2][2][4][2], const Unit& u, int wr, int wc, int fr, int fq) const {
        const int row0 = u.pm * BM + wr * 64 + fr, col0 = u.pn * BM + wc * 32 + 8 * fq;
#pragma unroll
        for (int ai = 0; ai < 2; ++ai)
#pragma unroll
            for (int m = 0; m < 4; ++m)
#pragma unroll
                for (int bj = 0; bj < 2; ++bj) {
                    const int row = row0 + ai * HALF + m * 16, col = col0 + bj * HALF;
                    const bf16_t* zp = zg + (size_t)row * NZ + col + u.seg * 2048;
                    float ga[8]; unpack8(*(const u32x4*)zp, ga);
                    if (u.seg < 2) {
                        float gb[8]; unpack8(*(const u32x4*)(zp + 2048), gb);
#pragma unroll
                        for (int e = 0; e < 8; ++e) { const float ea = __expf(-fminf(fmaxf(ga[e], -30.f), 30.f)), eb = __expf(-fminf(fmaxf(gb[e], -30.f), 30.f));
                            const float ratio = (1.f + eb) / (1.f + ea); acc[ai][bj][m][e >> 2][e & 3] *= ratio; }
                    } else {
                        float r[8];
#pragma unroll
                        for (int e = 0; e < 8; ++e) r[e] = acc[ai][bj][m][e >> 2][e & 3] / (1.f + __expf(-fminf(fmaxf(ga[e], -30.f), 30.f)));
                        u32x4 w; w.x = cvt_pk_bf16(r[0], r[1]); w.y = cvt_pk_bf16(r[2], r[3]); w.z = cvt_pk_bf16(r[4], r[5]); w.w = cvt_pk_bf16(r[6], r[7]);
                        *(u32x4*)(y + (size_t)row * DM + col) = w;
                    }
                    __builtin_amdgcn_sched_barrier(0);
                }
    }
};
struct EpiOut {
    static constexpr bool PERM = true, AFTER_DRAIN = false;
    const float* xlat; const float* xctx; float* xnew; const float* mod;
    __device__ __forceinline__ void operator()(const f32x4 (&acc)[2][2][4][2], const Unit& u, int wr, int wc, int fr, int fq) const {
        const int row0 = u.pm * BM + wr * 64 + fr, col0 = u.pn * BM + wc * 32 + 8 * fq;
        const int tile_row = u.pm * BM; const int mr = tile_row < ML ? tile_row / SEQ : 4;
        const float* xo = tile_row < ML ? xlat : (xctx - (size_t)ML * DM);
        const float* gm = mod + mr * 6144 + 4096;
#pragma unroll
        for (int ai = 0; ai < 2; ++ai)
#pragma unroll
            for (int m = 0; m < 4; ++m)
#pragma unroll
                for (int bj = 0; bj < 2; ++bj) {
                    const int row = row0 + ai * HALF + m * 16, col = col0 + bj * HALF;
                    const f32x4 g0 = *(const f32x4*)(gm + col), g1 = *(const f32x4*)(gm + col + 4);
                    const float* xp = xo + (size_t)row * DM + col;
                    const f32x4 r0 = *(const f32x4*)xp + g0 * acc[ai][bj][m][0], r1 = *(const f32x4*)(xp + 4) + g1 * acc[ai][bj][m][1];
                    float* op = xnew + (size_t)row * DM + col;
                    *(f32x4*)op = r0; *(f32x4*)(op + 4) = r1;
                    __builtin_amdgcn_sched_barrier(0);
                }
    }
};
}

struct Args { const float* in[26]; float* out; unsigned char* ws; int ph_lo, ph_hi; };
enum { I_X = 0, I_C, I_CTX, I_CCTX, I_NORMG, I_WADA, I_BADA, I_WIN, I_POOLW, I_POOLS, I_QNORM, I_KNORM, I_LQ1, I_LK1, I_LQ2, I_LK2, I_SUBLN, I_WGF, I_BGF, I_WGB, I_BGB, I_GLAN, I_WBP, I_WBD, I_WBG, I_WOUT };

__device__ __forceinline__ const float* inp(int i) { const float* const volatile __attribute__((address_space(4)))* kp = (const float* const volatile __attribute__((address_space(4)))*)__builtin_amdgcn_kernarg_segment_ptr(); const GAS float* q = (const GAS float*)kp[i]; asm volatile("" : "+s"(q)); return (const float*)q; }
__device__ __forceinline__ float* arg_out() { float* const volatile __attribute__((address_space(4)))* kp = (float* const volatile __attribute__((address_space(4)))*)__builtin_amdgcn_kernarg_segment_ptr(); GAS float* q = (GAS float*)kp[26]; asm volatile("" : "+s"(q)); return (float*)q; }
__device__ __forceinline__ void transpose_item(const float* W, int K, int N, bf16_t* WT, int row_off, LAS float* scr, int kb, int nb, int lane) {
    const int k0 = 64 * kb, n0 = 32 * nb;
    float tv[32];
#pragma unroll
    for (int i = 0; i < 32; ++i) { const int kk = 2 * i + (lane >> 5); tv[i] = __builtin_nontemporal_load(W + (size_t)(k0 + kk) * N + n0 + (lane & 31)); }
#pragma unroll
    for (int i = 0; i < 32; ++i) { const int kk = 2 * i + (lane >> 5); scr[kk * 33 + (lane & 31)] = tv[i]; }
    asm volatile("s_waitcnt lgkmcnt(0)" ::: "memory");
    const int c = lane & 7;
#pragma unroll
    for (int j = 0; j < 4; ++j) { const int n = (lane >> 3) + 8 * j; const LAS float* s = scr + (8 * c) * 33 + n;
        u32x4 o; o.x = cvt_pk_bf16(s[0 * 33], s[1 * 33]); o.y = cvt_pk_bf16(s[2 * 33], s[3 * 33]); o.z = cvt_pk_bf16(s[4 * 33], s[5 * 33]); o.w = cvt_pk_bf16(s[6 * 33], s[7 * 33]);
        *(u32x4*)(WT + (size_t)(row_off + n0 + n) * K + k0 + 8 * c) = o; }
    asm volatile("s_waitcnt lgkmcnt(0)" ::: "memory");
}

__device__ __forceinline__ void phase_p0(const Args& a, LAS unsigned char* lds) {
    const int tid = opaque_tid(), lane = tid & 63, wave = __builtin_amdgcn_readfirstlane(tid >> 6), G = opaque_s(gridDim.x);
    unsigned char* ws = opaque_ptr(a.ws);
    {
        LAS float* sc = (LAS float*)(lds + 69632);
        LAS float* part = (LAS float*)(lds + 69632 + 40960);
        if (BID < 192) {
            for (int i = tid; i < 5 * 2048; i += 512) { const int r = i >> 11, k = i & 2047; const float v = r < 4 ? inp(I_C)[r * 2048 + k] : inp(I_CCTX)[k]; sc[i] = silu_f(v); }
            __syncthreads();
        }
        for (int it = BID; it < 192; it += G) {
            const int l = it / 96, cgp = it % 96, col = cgp * 64 + lane;
            const float* W = inp(I_WADA) + (size_t)l * 2048 * 6144 + col;
            float acc[5] = {0.f, 0.f, 0.f, 0.f, 0.f};
#pragma unroll 32
            for (int kk = 0; kk < 256; ++kk) { const int k = wave * 256 + kk; const float wv = __builtin_nontemporal_load(W + (size_t)k * 6144);
#pragma unroll
                for (int r = 0; r < 5; ++r) acc[r] += sc[r * 2048 + k] * wv; }
#pragma unroll
            for (int r = 0; r < 5; ++r) part[(wave * 5 + r) * 64 + lane] = acc[r];
            __syncthreads();
            if (tid < 320) { const int r = tid >> 6, ln = tid & 63; float s = inp(I_BADA)[l * 6144 + cgp * 64 + ln];
#pragma unroll
                for (int w = 0; w < 8; ++w) s += part[(w * 5 + r) * 64 + ln];
                ((float*)(ws + OFF_MOD))[(l * 5 + r) * 6144 + cgp * 64 + ln] = s; }
            __syncthreads();
        }
    }
    if (BID == G - 1 && wave == 0) {
        for (int l = 0; l < 2; ++l) {
            const float s1 = wave_sum(inp(I_LQ1)[l * 64 + lane] * inp(I_LK1)[l * 64 + lane]);
            const float s2 = wave_sum(inp(I_LQ2)[l * 64 + lane] * inp(I_LK2)[l * 64 + lane]);
            const float mq = wave_max(fabsf(inp(I_QNORM)[l * 64 + lane])), mk = wave_max(fabsf(inp(I_KNORM)[l * 64 + lane]));
            const float lam_init = 0.8f - 0.6f * expf(-0.3f * (float)l);
            if (lane == 0) { float* sp = (float*)(ws + OFF_SCAL) + l * 4; sp[0] = expf(s1) - expf(s2) + lam_init; sp[1] = 8.f * LOG2E * mq * mk; sp[2] = lam_init; sp[3] = 0.f; }
        }
    }
    {
        const int nper = 224 * 2048 * 2 / 16;
        for (int i = BID * 512 + tid; i < 2 * nper; i += G * 512) { const int l = i / nper, j = i % nper;
            *(u32x4*)(ws + OFF_WIN + (size_t)l * SZ_WIN + (size_t)9248 * DM * 2 + (size_t)j * 16) = (u32x4){0u, 0u, 0u, 0u}; }
    }
    {
        LAS float* scr = (LAS float*)(lds + wave * 8704);
        const int gw = BID * 8 + wave, NGW = G * 8;
        constexpr int I_IN = 32 * 481, I_B = 16 * 64, I_O = 32 * 64, I_P = 4 * 32, PER_L = I_IN + 3 * I_B + I_O + I_P;
        for (int it = gw; it < 2 * PER_L; it += NGW) {
            const int l = it / PER_L; int r = it % PER_L;
            if (r < I_IN) { const int kb = r / 481, nb = r % 481;
                transpose_item(inp(I_WIN) + (size_t)l * DM * DIN, DM, DIN, (bf16_t*)(ws + OFF_WIN + (size_t)l * SZ_WIN), nb >= 289 ? 224 : 0, scr, kb, nb, lane); continue; }
            r -= I_IN;
            if (r < 3 * I_B) { const int br = r / I_B, rr = r % I_B; const float* W = (br == 0 ? inp(I_WBP) : br == 1 ? inp(I_WBD) : inp(I_WBG)) + (size_t)l * 1024 * DM;
                transpose_item(W, 1024, DM, (bf16_t*)(ws + OFF_WB + (size_t)l * SZ_WB + (size_t)br * DM * 1024 * 2), 0, scr, rr / 64, rr % 64, lane); continue; }
            r -= 3 * I_B;
            if (r < I_O) { transpose_item(inp(I_WOUT) + (size_t)l * DM * DM, DM, DM, (bf16_t*)(ws + OFF_WOUT + (size_t)l * SZ_WOUT), 0, scr, r / 64, r % 64, lane); continue; }
            r -= I_O;
            { const int g = r / 32, rr = r % 32;
              transpose_item(inp(I_POOLW) + (size_t)(l * 4 + g) * 65536, 256, 256, (bf16_t*)(ws + OFF_POOLT + (size_t)l * SZ_POOLT + (size_t)g * 65536 * 2), 0, scr, rr / 8, rr % 8, lane); }
        }
    }
}

__device__ __forceinline__ void phase_norm(const Args& a, int l) {
    const int tid = opaque_tid(), lane = tid & 63, wave = tid >> 6, G = opaque_s(gridDim.x);
    const int gw = BID * 8 + wave, NGW = G * 8;
    const float* mod = (const float*)(opaque_ptr(a.ws) + OFF_MOD) + (size_t)l * 5 * 6144;
    const float* x1 = (const float*)(opaque_ptr(a.ws) + OFF_X1);
    bf16_t* h = (bf16_t*)(opaque_ptr(a.ws) + OFF_H);
    const float* ng = inp(I_NORMG) + l * DM;
    for (int row = gw; row < MT; row += NGW) {
        const float* src = (l == 0) ? (row < ML ? inp(I_X) + (size_t)row * DM : inp(I_CTX) + (size_t)(row - ML) * DM) : x1 + (size_t)row * DM;
        const int mr = row < ML ? row / SEQ : 4;
        const float* md = mod + mr * 6144;
        f32x4 v[8]; float ss = 0.f;
#pragma unroll
        for (int j = 0; j < 8; ++j) { v[j] = *(const f32x4*)(src + 4 * lane + 256 * j); ss += (v[j][0] * v[j][0] + v[j][1] * v[j][1]) + (v[j][2] * v[j][2] + v[j][3] * v[j][3]); }
        ss = wave_sum(ss);
        const float rstd = rsqrtf(ss * (1.f / DM) + EPS);
#pragma unroll
        for (int j = 0; j < 8; ++j) { const int idx = 4 * lane + 256 * j;
            const f32x4 gg = *(const f32x4*)(ng + idx), sc = *(const f32x4*)(md + 2048 + idx), sh = *(const f32x4*)(md + idx);
            f32x4 o;
#pragma unroll
            for (int e = 0; e < 4; ++e) o[e] = v[j][e] * rstd * gg[e] * (1.f + sc[e]) + sh[e];
            u32x2 w; w.x = cvt_pk_bf16(o[0], o[1]); w.y = cvt_pk_bf16(o[2], o[3]);
            *(u32x2*)(h + (size_t)row * DM + idx) = w; }
    }
}

__device__ __forceinline__ int vt_pos(int key) { const int k = key & 15; return (key & ~15) | (((k >> 2) & 1) << 3) | (k & 3) | (((k >> 3) & 1) << 2); }

__device__ __forceinline__ void phase_prep(const Args& a, int l, LAS unsigned char* lds) {
    const int tid = opaque_tid(), lane = tid & 63, wave = tid >> 6, G = opaque_s(gridDim.x);
    unsigned char* ws = opaque_ptr(a.ws);
    const bf16_t* z = (const bf16_t*)(ws + OFF_Z);
    const bool need_ctx = (l == 0);
    for (int it = BID; it < 1440; it += G) {
        if (it < 576) {
            const int c = it >> 2, cgp = it & 3, rb = 64 * c;
            LAS float* lrs = (LAS float*)lds;
            LAS float* segs = (LAS float*)(lds + 8192);
            for (int i = tid; i < 64 * 32; i += 512) { const int r = i >> 5, cc = i & 31; lrs[i] = bf2f(z[(size_t)(rb + r) * NZ + ZC_LR + cc]); }
            __syncthreads();
            const int seg = tid >> 6, cp = tid & 63, ch = cgp * 128 + 2 * cp;
            typedef float f32x2v __attribute__((ext_vector_type(2)));
            const float* wgf = inp(I_WGF) + (size_t)l * 16 * 512 + ch; const float* wgb = inp(I_WGB) + (size_t)l * 16 * 512 + ch;
            f32x2v wf[16], wb[16];
#pragma unroll
            for (int r = 0; r < 16; ++r) { wf[r] = *(const f32x2v*)(wgf + r * 512); wb[r] = *(const f32x2v*)(wgb + r * 512); }
            const f32x2v bfv = *(const f32x2v*)(inp(I_BGF) + l * 512 + ch), bbv = *(const f32x2v*)(inp(I_BGB) + l * 512 + ch);
            f32x2v gf[8], gb[8]; f32x2v sf = {0.f, 0.f}, sb = {0.f, 0.f};
#pragma unroll
            for (int i = 0; i < 8; ++i) { const int t = seg * 8 + i; f32x2v af = bfv, ab = bbv;
#pragma unroll
                for (int r4 = 0; r4 < 4; ++r4) { const f32x4 lf = *(const LAS f32x4*)(lrs + t * 32 + 4 * r4), lb = *(const LAS f32x4*)(lrs + t * 32 + 16 + 4 * r4);
#pragma unroll
                    for (int e = 0; e < 4; ++e) { af += lf[e] * wf[4 * r4 + e]; ab += lb[e] * wb[4 * r4 + e]; } }
                gf[i].x = logsig_f(af.x) * (1.f / 16.f); gf[i].y = logsig_f(af.y) * (1.f / 16.f);
                gb[i].x = logsig_f(ab.x) * (1.f / 16.f); gb[i].y = logsig_f(ab.y) * (1.f / 16.f); sf += gf[i]; sb += gb[i]; }
            *(LAS f32x2v*)(segs + seg * 128 + 2 * cp) = sf; *(LAS f32x2v*)(segs + 1024 + seg * 128 + 2 * cp) = sb;
            __syncthreads();
            f32x2v pf = {0.f, 0.f}, pb = {0.f, 0.f}, totf = {0.f, 0.f}, totb = {0.f, 0.f};
#pragma unroll
            for (int s2 = 0; s2 < 8; ++s2) { const f32x2v vf = *(const LAS f32x2v*)(segs + s2 * 128 + 2 * cp), vb = *(const LAS f32x2v*)(segs + 1024 + s2 * 128 + 2 * cp);
                totf += vf; totb += vb; if (s2 < seg) { pf += vf; pb += vb; } }
            unsigned* gq0 = (unsigned*)(ws + OFF_GQ), *gq1 = (unsigned*)(ws + OFF_GQ + SZ_G);
            unsigned* gk0 = (unsigned*)(ws + OFF_GK), *gk1 = (unsigned*)(ws + OFF_GK + SZ_G);
            bf16_t* gh0 = (bf16_t*)(ws + OFF_GH), *gh1 = (bf16_t*)(ws + OFF_GH + SZ_G);
            f32x2v h0[8], h1[8];
#pragma unroll
            for (int i = 0; i < 8; ++i) { const int t = seg * 8 + i;
                pf += gf[i]; const f32x2v bs = totb - pb; pb += gb[i];
                const size_t row = rb + t;
                const unsigned qw = *(const unsigned*)(z + row * NZ + ZC_GQ + ch), kw = *(const unsigned*)(z + row * NZ + ZC_GK + ch);
                const float q0 = bflo(qw) * 0.08838834764831845f, q1 = bfhi(qw) * 0.08838834764831845f, k0 = bflo(kw), k1 = bfhi(kw);
                const size_t o = (row * 512 + ch) >> 1;
                gq0[o] = cvt_pk_bf16(q0 * __expf(pf.x), q1 * __expf(pf.y)); gk0[o] = cvt_pk_bf16(k0 * __expf(-pf.x), k1 * __expf(-pf.y));
                gq1[o] = cvt_pk_bf16(q0 * __expf(bs.x), q1 * __expf(bs.y)); gk1[o] = cvt_pk_bf16(k0 * __expf(-bs.x), k1 * __expf(-bs.y));
                h0[i].x = k0 * __expf(totf.x - pf.x); h0[i].y = k1 * __expf(totf.y - pf.y);
                h1[i].x = k0 * __expf(totb.x - bs.x); h1[i].y = k1 * __expf(totb.y - bs.y); }
            {
#pragma unroll
                for (int cc = 0; cc < 2; ++cc) { u32x4 w0, w1;
                    w0.x = cvt_pk_bf16(h0[0][cc], h0[1][cc]); w0.y = cvt_pk_bf16(h0[2][cc], h0[3][cc]); w0.z = cvt_pk_bf16(h0[4][cc], h0[5][cc]); w0.w = cvt_pk_bf16(h0[6][cc], h0[7][cc]);
                    w1.x = cvt_pk_bf16(h1[0][cc], h1[1][cc]); w1.y = cvt_pk_bf16(h1[2][cc], h1[3][cc]); w1.z = cvt_pk_bf16(h1[4][cc], h1[5][cc]); w1.w = cvt_pk_bf16(h1[6][cc], h1[7][cc]);
                    const size_t oh = ((size_t)c * 512 + ch + cc) * 64 + seg * 8;
                    *(u32x4*)(gh0 + oh) = w0; *(u32x4*)(gh1 + oh) = w1; } }
            if (seg == 0) { float* dec = (float*)(ws + OFF_DEC);
                *(f32x2v*)(dec + (size_t)c * 512 + ch) = (f32x2v){__expf(totf.x), __expf(totf.y)}; *(f32x2v*)(dec + (size_t)(144 + c) * 512 + ch) = (f32x2v){__expf(totb.x), __expf(totb.y)}; }
            __syncthreads();
        } else if (it < 864) {
            const int rb = 32 * (it - 576); if (!need_ctx && rb >= ML) continue;
            const int seq0 = rb < ML ? (rb / SEQ) * SEQ : ML + ((rb - ML) / LC) * LC; const int L = rb < ML ? SEQ : LC;
            bf16_t* dp = (bf16_t*)(ws + OFF_DPOOL); bf16_t* pgt = (bf16_t*)(ws + OFF_PGATE);
            const int ch8 = 8 * (tid & 127), tg = tid >> 7, hw = 1 << (ch8 >> 8);
            const int tl0 = rb - seq0 + 8 * tg;
            float psc[8];
#pragma unroll
            for (int e = 0; e < 8; ++e) psc[e] = inp(I_POOLS)[l * 1024 + ch8 + e];
            const bf16_t* zc = z + (size_t)seq0 * NZ + ZC_PU + ch8;
            float sm[8] = {0.f, 0.f, 0.f, 0.f, 0.f, 0.f, 0.f, 0.f};
            { const int lo = max(tl0 - hw, 0), hi = min(tl0 + hw, L);
              for (int p = lo; p < hi; ++p) { float u[8]; unpack8(*(const u32x4*)(zc + (size_t)p * NZ), u);
#pragma unroll
                  for (int e = 0; e < 8; ++e) sm[e] += u[e]; } }
#pragma unroll
            for (int t = 0; t < 8; ++t) { const int tl = tl0 + t; const int lo = max(tl - hw, 0), hi = min(tl + hw, L);
                const float rc = 1.f / (float)(hi - lo);
                float cur[8], pgv[8], ua[8], ur[8];
                unpack8(*(const u32x4*)(zc + (size_t)tl * NZ), cur); unpack8(*(const u32x4*)(zc + (size_t)tl * NZ + (ZC_PG - ZC_PU)), pgv);
                unpack8(*(const u32x4*)(zc + (size_t)min(tl + hw, L - 1) * NZ), ua); unpack8(*(const u32x4*)(zc + (size_t)max(tl - hw, 0) * NZ), ur);
                const float ma = (tl + hw < L) ? 1.f : 0.f, mr = (tl - hw >= 0) ? 1.f : 0.f;
                u32x4 wd, wg;
                wd.x = cvt_pk_bf16(sm[0] * rc - cur[0], sm[1] * rc - cur[1]); wd.y = cvt_pk_bf16(sm[2] * rc - cur[2], sm[3] * rc - cur[3]);
                wd.z = cvt_pk_bf16(sm[4] * rc - cur[4], sm[5] * rc - cur[5]); wd.w = cvt_pk_bf16(sm[6] * rc - cur[6], sm[7] * rc - cur[7]);
                wg.x = cvt_pk_bf16(psc[0] * silu_f(pgv[0]), psc[1] * silu_f(pgv[1])); wg.y = cvt_pk_bf16(psc[2] * silu_f(pgv[2]), psc[3] * silu_f(pgv[3]));
                wg.z = cvt_pk_bf16(psc[4] * silu_f(pgv[4]), psc[5] * silu_f(pgv[5])); wg.w = cvt_pk_bf16(psc[6] * silu_f(pgv[6]), psc[7] * silu_f(pgv[7]));
                const size_t o = (size_t)(seq0 + tl) * 1024 + ch8;
                *(u32x4*)(dp + o) = wd; *(u32x4*)(pgt + o) = wg;
#pragma unroll
                for (int e = 0; e < 8; ++e) sm[e] += ma * ua[e] - mr * ur[e]; }
        } else {
            const int vi = it - 864, isg = vi >= 288, vj = isg ? vi - 288 : vi, c = vj >> 1, hv = vj & 1, rb = 64 * c;
            int b, key0; if (rb < ML) { b = rb >> 11; key0 = LC + (rb & 2047); } else { b = (rb - ML) >> 8; key0 = (rb - ML) & 255; }
            bf16_t* vT = (bf16_t*)(ws + OFF_VT); bf16_t* gvT = (bf16_t*)(ws + OFF_GVT);
#pragma unroll
            for (int i = 0; i < 8; ++i) { const int idx = tid + 512 * i, key = idx & 63, c8 = (idx >> 6) * 8;
                const u32x4 w = *(const u32x4*)(z + (size_t)(rb + key) * NZ + (isg ? ZC_GV : ZC_DV) + hv * 512 + c8);
                const unsigned ww[4] = {w.x, w.y, w.z, w.w}; const int pos = isg ? key : vt_pos(key);
#pragma unroll
                for (int e = 0; e < 8; ++e) *(LAS bf16_t*)(lds + (c8 + e) * 144 + pos * 2) = (bf16_t)((e & 1) ? (ww[e >> 1] >> 16) : (ww[e >> 1] & 0xffffu)); }
            __syncthreads();
#pragma unroll
            for (int i = 0; i < 8; ++i) { const int idx = tid + 512 * i, col = idx >> 3, k8 = idx & 7, colg = hv * 512 + col, h = colg >> 7, v = colg & 127;
                bf16_t* dst = isg ? gvT + ((size_t)c * 1024 + colg) * 64 + k8 * 8 : vT + ((size_t)(b * 8 + h) * 128 + v) * LK + key0 + k8 * 8;
                *(u32x4*)dst = *(const LAS u32x4*)(lds + col * 144 + k8 * 16); }
            __syncthreads();
        }
    }
    {
        const int gw = BID * 8 + wave, NGW = G * 8;
        bf16_t* qn = (bf16_t*)(ws + OFF_QN); bf16_t* qnc = (bf16_t*)(ws + OFF_QNC); bf16_t* kn = (bf16_t*)(ws + OFF_KN);
        for (int it = gw; it < MT * 2; it += NGW) {
            const int row = it >> 1, which = it & 1;
            const bool isctx = row >= ML; int b, t; if (!isctx) { b = row >> 11; t = row & 2047; } else { b = (row - ML) >> 8; t = (row - ML) & 255; }
            const bf16_t* zr = z + (size_t)row * NZ;
            {
                if (which == 0 && isctx && !need_ctx) continue;
                float x[16]; const bf16_t* src = zr + (which == 0 ? ZC_DQ : ZC_DK) + 16 * lane;
                unpack8(*(const u32x4*)src, x); unpack8(*(const u32x4*)(src + 8), x + 8);
                float ss = 0.f;
#pragma unroll
                for (int e = 0; e < 16; ++e) ss += x[e] * x[e];
                ss += __shfl_xor(ss, 1); ss += __shfl_xor(ss, 2);
                const float rstd = rsqrtf(ss * (1.f / 64.f) + EPS);
                const int m = lane & 3, sh = lane >> 2, h = sh >> 1, j = sh & 1;
                const float* gain = (which == 0 ? inp(I_QNORM) : inp(I_KNORM)) + l * 64 + 16 * m;
                float y[16];
#pragma unroll
                for (int e = 0; e < 16; ++e) y[e] = x[e] * rstd * gain[e];
                if (!isctx) {
                    const float posf = (float)((m & 1) ? (t & 63) : (t >> 6));
#pragma unroll
                    for (int e = 0; e < 16; ++e) { const float yp = __shfl_xor(y[e], 2);
                        const float ang = posf * exp2f(-(float)e * 0.8304820237218405f);
                        const float cs = __cosf(ang), sn = __sinf(ang);
                        y[e] = (m < 2) ? (y[e] * cs - yp * sn) : (y[e] * cs + yp * sn); }
                }
                bf16_t* dst;
                if (which == 0) {
#pragma unroll
                    for (int e = 0; e < 16; ++e) y[e] *= 0.125f * LOG2E;
                    dst = isctx ? qnc + (((size_t)(b * 8 + h) * 2 + j) * LC + t) * 64 + 16 * m : qn + (((size_t)(b * 8 + h) * 2 + j) * SEQ + t) * 64 + 16 * m;
                } else dst = kn + (((size_t)(b * 8 + h) * 2 + j) * LK + (isctx ? t : LC + t)) * 64 + 16 * m;
                u32x4 w0, w1;
                w0.x = cvt_pk_bf16(y[0], y[1]); w0.y = cvt_pk_bf16(y[2], y[3]); w0.z = cvt_pk_bf16(y[4], y[5]); w0.w = cvt_pk_bf16(y[6], y[7]);
                w1.x = cvt_pk_bf16(y[8], y[9]); w1.y = cvt_pk_bf16(y[10], y[11]); w1.z = cvt_pk_bf16(y[12], y[13]); w1.w = cvt_pk_bf16(y[14], y[15]);
                *(u32x4*)dst = w0; *(u32x4*)(dst + 8) = w1;
            }
        }
    }
}

constexpr int GL_Q = 0, GL_K = 17408, GL_KH = 34816, GL_VT = 53248, GL_ATT = 57856, GL_ST = 67072;
__device__ __forceinline__ void gla_unit(const Args& a, int l, LAS unsigned char* lds, int item) {
    const int tid = opaque_tid(), lane = tid & 63, w = __builtin_amdgcn_readfirstlane(tid >> 6);
    const int vs = item & 7, dir = (item >> 3) & 1, h = (item >> 4) & 3, b = item >> 6;
    const bool need_ctx = (l == 0);
    unsigned char* ws = opaque_ptr(a.ws);
    const bf16_t* z = (const bf16_t*)(ws + OFF_Z);
    const bf16_t* gq = (const bf16_t*)(ws + OFF_GQ + dir * SZ_G) + h * 128;
    const bf16_t* gk = (const bf16_t*)(ws + OFF_GK + dir * SZ_G) + h * 128;
    const bf16_t* gh = (const bf16_t*)(ws + OFF_GH + dir * SZ_G) + (size_t)h * 128 * 64;
    const float* dec = (const float*)(ws + OFF_DEC) + (size_t)dir * 144 * 512 + h * 128;
    bf16_t* od = (bf16_t*)(ws + OFF_OF + (size_t)dir * MT * 1024 * 2) + h * 256 + vs * 32;
    const bf16_t* gvt = (const bf16_t*)(ws + OFF_GVT) + (size_t)(h * 256 + vs * 32) * 64;
    const int fr = lane & 15, fq = lane >> 4;
    f32x4 sacc[2] = {(f32x4){0.f, 0.f, 0.f, 0.f}, (f32x4){0.f, 0.f, 0.f, 0.f}};
    for (int i = tid; i < 32 * 136 / 2; i += 512) ((LAS unsigned*)(lds + GL_ST))[i] = 0u;
    u32x4 rq[2], rk[2], rh[2], rv; float rdec;
    auto rowbase = [&](int s) -> int { if (s < 4) { const int ci = dir == 0 ? s : 3 - s; return ML + b * LC + 64 * ci; } const int ci = dir == 0 ? s - 4 : 35 - s; return b * SEQ + 64 * ci; };
#define GLA_LOAD(s) do { const int _rb = rowbase(s); _Pragma("unroll") for (int _i = 0; _i < 2; ++_i) { const int _idx = tid + 512 * _i, _r = _idx >> 4, _c = (_idx & 15) * 8; const size_t _o = (size_t)(_rb + _r) * 512 + _c; \
        rq[_i] = *(const u32x4*)(gq + _o); rk[_i] = *(const u32x4*)(gk + _o); rh[_i] = *(const u32x4*)(gh + ((size_t)(_rb >> 6) * 512 + (_idx >> 3)) * 64 + (_idx & 7) * 8); } \
        if (tid < 256) rv = *(const u32x4*)(gvt + ((size_t)(_rb >> 6) * 1024 + (tid >> 3)) * 64 + (tid & 7) * 8); \
        rdec = dec[(size_t)(_rb >> 6) * 512 + 16 * w + fr]; } while (0)
    GLA_LOAD(0);
    for (int s = 0; s < 36; ++s) {
        const int rb = rowbase(s);
        const float dk = rdec;
#pragma unroll
        for (int i = 0; i < 2; ++i) { const int idx = tid + 512 * i, r = idx >> 4, c = (idx & 15) * 8;
            *(LAS u32x4*)(lds + GL_Q + r * 272 + c * 2) = rq[i]; *(LAS u32x4*)(lds + GL_K + r * 272 + c * 2) = rk[i];
            *(LAS u32x4*)(lds + GL_KH + (idx >> 3) * 144 + (idx & 7) * 16) = rh[i]; }
        if (tid < 256) *(LAS u32x4*)(lds + GL_VT + (tid >> 3) * 144 + (tid & 7) * 16) = rv;
        __syncthreads();
        if (s + 1 < 36) GLA_LOAD(s + 1);
        {
            const int tt = w >> 1;
#pragma unroll
            for (int si = 0; si < 2; ++si) { const int st = 2 * (w & 1) + si; f32x4 acc = (f32x4){0.f, 0.f, 0.f, 0.f};
#pragma unroll
                for (int kk = 0; kk < 4; ++kk) { const bf16x8 af = *(const LAS bf16x8*)(lds + GL_Q + (16 * tt + fr) * 272 + (32 * kk + 8 * fq) * 2);
                    const bf16x8 bfr = *(const LAS bf16x8*)(lds + GL_K + (16 * st + fr) * 272 + (32 * kk + 8 * fq) * 2);
                    acc = __builtin_amdgcn_mfma_f32_16x16x32_bf16(af, bfr, acc, 0, 0, 0); }
#pragma unroll
                for (int j = 0; j < 4; ++j) { const int t = 16 * tt + 4 * fq + j, sc = 16 * st + fr; const bool keep = dir == 0 ? (sc <= t) : (sc >= t);
                    *(LAS bf16_t*)(lds + GL_ATT + t * 144 + sc * 2) = f2bf(keep ? acc[j] : 0.f); } }
        }
#pragma unroll
        for (int vt = 0; vt < 2; ++vt) { f32x4 acc = sacc[vt] * dk;
#pragma unroll
            for (int kk = 0; kk < 2; ++kk) { const bf16x8 af = *(const LAS bf16x8*)(lds + GL_VT + (16 * vt + fr) * 144 + (32 * kk + 8 * fq) * 2);
                const bf16x8 bfr = *(const LAS bf16x8*)(lds + GL_KH + (16 * w + fr) * 144 + (32 * kk + 8 * fq) * 2);
                acc = __builtin_amdgcn_mfma_f32_16x16x32_bf16(af, bfr, acc, 0, 0, 0); }
            sacc[vt] = acc; }
        __syncthreads();
        {
            const int tt = w >> 1, vt = w & 1; f32x4 acc = (f32x4){0.f, 0.f, 0.f, 0.f};
#pragma unroll
            for (int kk = 0; kk < 4; ++kk) { const bf16x8 af = *(const LAS bf16x8*)(lds + GL_Q + (16 * tt + fr) * 272 + (32 * kk + 8 * fq) * 2);
                const bf16x8 bfr = *(const LAS bf16x8*)(lds + GL_ST + (16 * vt + fr) * 272 + (32 * kk + 8 * fq) * 2);
                acc = __builtin_amdgcn_mfma_f32_16x16x32_bf16(af, bfr, acc, 0, 0, 0); }
#pragma unroll
            for (int kk = 0; kk < 2; ++kk) { const bf16x8 af = *(const LAS bf16x8*)(lds + GL_ATT + (16 * tt + fr) * 144 + (32 * kk + 8 * fq) * 2);
                const bf16x8 bfr = *(const LAS bf16x8*)(lds + GL_VT + (16 * vt + fr) * 144 + (32 * kk + 8 * fq) * 2);
                acc = __builtin_amdgcn_mfma_f32_16x16x32_bf16(af, bfr, acc, 0, 0, 0); }
            if (s >= 4 || need_ctx) {
#pragma unroll
                for (int j = 0; j < 4; ++j) od[(size_t)(rb + 16 * tt + 4 * fq + j) * 1024 + 16 * vt + fr] = f2bf(acc[j]); }
        }
        __syncthreads();
#pragma unroll
        for (int vt = 0; vt < 2; ++vt)
#pragma unroll
            for (int j = 0; j < 4; ++j) *(LAS bf16_t*)(lds + GL_ST + (16 * vt + 4 * fq + j) * 272 + (16 * w + fr) * 2) = f2bf(sacc[vt][j]);
    }
    __syncthreads();
#undef GLA_LOAD
}

constexpr int AT_BUF = 36864, AT_K = 0, AT_V = 18432;
template <bool SHIFT>
__device__ __forceinline__ void attn_unit(LAS unsigned char* lds, const bf16_t* qbase, int Lq, int q0, const bf16_t* kbase, const bf16_t* vtbase, int nkeys,
                                          float c2, float lam, float post_scale, const float* subln, const bf16_t* dg, bf16_t* outp, int row0) {
    const int tid = opaque_tid(), lane = tid & 63, w = __builtin_amdgcn_readfirstlane(tid >> 6), q32 = lane & 31, hi = lane >> 5;
    const int j = w >> 2, qg = w & 3;
    bf16x8 qf[4];
#pragma unroll
    for (int kk = 0; kk < 4; ++kk) qf[kk] = *(const bf16x8*)(qbase + ((size_t)j * Lq + q0 + 32 * qg + q32) * 64 + 16 * kk + 8 * hi);
    f32x16 o[4];
#pragma unroll
    for (int vt = 0; vt < 4; ++vt)
#pragma unroll
        for (int r = 0; r < 16; ++r) o[vt][r] = 0.f;
    float lsum = 0.f;
    const int nt = nkeys >> 6;
    u32x4 skA[2], svA[2];
#define AT_LOAD(sk, sv, i) do { _Pragma("unroll") for (int _c = 0; _c < 2; ++_c) { const int _idx = tid + 512 * _c; \
        sk[_c] = *(const u32x4*)(kbase + ((size_t)(_idx >> 9) * LK + 64 * (i) + ((_idx & 511) >> 3)) * 64 + (_idx & 7) * 8); \
        sv[_c] = *(const u32x4*)(vtbase + (size_t)(_idx >> 3) * LK + 64 * (i) + (_idx & 7) * 8); } } while (0)
#define AT_STORE(sk, sv, p) do { _Pragma("unroll") for (int _c = 0; _c < 2; ++_c) { const int _idx = tid + 512 * _c; \
        *(LAS u32x4*)(lds + (p) * AT_BUF + AT_K + ((_idx >> 9) * 64 + ((_idx & 511) >> 3)) * 144 + (_idx & 7) * 16) = sk[_c]; \
        *(LAS u32x4*)(lds + (p) * AT_BUF + AT_V + (_idx >> 3) * 144 + (_idx & 7) * 16) = sv[_c]; } } while (0)
#define AT_KF(kb, kk) (*(const LAS bf16x8*)(Kb + (32 * (kb) + q32) * 144 + (16 * (kk) + 8 * hi) * 2))
#define AT_VF(ks, vt) (*(const LAS bf16x8*)(Vb + (32 * (vt) + q32) * 144 + (16 * (ks) + 8 * hi) * 2))
#define AT_TILE(p) do { \
        LAS unsigned char* Kb = lds + (p) * AT_BUF + AT_K + j * (64 * 144); LAS unsigned char* Vb = lds + (p) * AT_BUF + AT_V; \
        bf16x8 kf[4], vf[4], vg[4]; \
        _Pragma("unroll") for (int kk = 0; kk < 4; ++kk) kf[kk] = AT_KF(0, kk); \
        _Pragma("unroll") for (int kb = 0; kb < 2; ++kb) { \
            _Pragma("unroll") for (int vt = 0; vt < 4; ++vt) vf[vt] = AT_VF(2 * kb, vt); \
            __builtin_amdgcn_sched_barrier(0); \
            f32x16 s; \
            _Pragma("unroll") for (int r = 0; r < 16; ++r) s[r] = 0.f; \
            _Pragma("unroll") for (int kk = 0; kk < 4; ++kk) s = __builtin_amdgcn_mfma_f32_32x32x16_bf16(kf[kk], qf[kk], s, 0, 0, 0); \
            __builtin_amdgcn_sched_barrier(0); \
            _Pragma("unroll") for (int vt = 0; vt < 4; ++vt) vg[vt] = AT_VF(2 * kb + 1, vt); \
            if (kb == 0) { _Pragma("unroll") for (int kk = 0; kk < 4; ++kk) kf[kk] = AT_KF(1, kk); } \
            __builtin_amdgcn_sched_barrier(0); \
            _Pragma("unroll") for (int r = 0; r < 16; ++r) { s[r] = __builtin_amdgcn_exp2f(SHIFT ? s[r] - c2 : s[r]); lsum += s[r]; } \
            u32x4 pw0, pw1; \
            pw0.x = cvt_pk_bf16(s[0], s[1]); pw0.y = cvt_pk_bf16(s[2], s[3]); pw0.z = cvt_pk_bf16(s[4], s[5]); pw0.w = cvt_pk_bf16(s[6], s[7]); \
            pw1.x = cvt_pk_bf16(s[8], s[9]); pw1.y = cvt_pk_bf16(s[10], s[11]); pw1.z = cvt_pk_bf16(s[12], s[13]); pw1.w = cvt_pk_bf16(s[14], s[15]); \
            const bf16x8 pb0 = __builtin_bit_cast(bf16x8, pw0), pb1 = __builtin_bit_cast(bf16x8, pw1); \
            _Pragma("unroll") for (int vt = 0; vt < 4; ++vt) o[vt] = __builtin_amdgcn_mfma_f32_32x32x16_bf16(vf[vt], pb0, o[vt], 0, 0, 0); \
            _Pragma("unroll") for (int vt = 0; vt < 4; ++vt) o[vt] = __builtin_amdgcn_mfma_f32_32x32x16_bf16(vg[vt], pb1, o[vt], 0, 0, 0); \
            __builtin_amdgcn_sched_barrier(0); \
        } } while (0)
    AT_LOAD(skA, svA, 0); AT_STORE(skA, svA, 0);
    __syncthreads();
    for (int i = 0; i < nt; i += 2) {
        AT_LOAD(skA, svA, i + 1);
        AT_TILE(0);
        AT_STORE(skA, svA, 1);
        __syncthreads();
        if (i + 2 < nt) AT_LOAD(skA, svA, i + 2);
        AT_TILE(1);
        if (i + 2 < nt) AT_STORE(skA, svA, 0);
        __syncthreads();
    }
#undef AT_TILE
#undef AT_KF
#undef AT_VF
#undef AT_LOAD
#undef AT_STORE
    lsum += __shfl_xor(lsum, 32);
    LAS float* xch = (LAS float*)lds + (size_t)qg * 4096 + lane;
    if (j == 1) {
        const float sc = lam / lsum;
#pragma unroll
        for (int vt = 0; vt < 4; ++vt)
#pragma unroll
            for (int r = 0; r < 16; ++r) xch[(vt * 16 + r) * 64] = o[vt][r] * sc;
    }
    __syncthreads();
    if (j == 0) {
        const float i0 = 1.f / lsum;
        float ss = 0.f;
#pragma unroll
        for (int vt = 0; vt < 4; ++vt)
#pragma unroll
            for (int r = 0; r < 16; ++r) { const float v = o[vt][r] * i0 - xch[(vt * 16 + r) * 64]; o[vt][r] = v; ss += v * v; }
        ss += __shfl_xor(ss, 32);
        const float rstd = rsqrtf(ss * (1.f / 128.f) + EPS) * post_scale;
        const size_t row = (size_t)row0 + 32 * qg + q32;
#pragma unroll
        for (int vt = 0; vt < 4; ++vt)
#pragma unroll
            for (int g4 = 0; g4 < 4; ++g4) {
                const int v0 = 32 * vt + 8 * g4 + 4 * hi;
                const u32x2 gz = *(const u32x2*)(dg + row * NZ + v0);
                const f32x4 sl = *(const f32x4*)(subln + v0);
                const float r0 = o[vt][4 * g4 + 0] * rstd * sl[0] * silu_f(bflo(gz.x)), r1 = o[vt][4 * g4 + 1] * rstd * sl[1] * silu_f(bfhi(gz.x));
                const float r2 = o[vt][4 * g4 + 2] * rstd * sl[2] * silu_f(bflo(gz.y)), r3 = o[vt][4 * g4 + 3] * rstd * sl[3] * silu_f(bfhi(gz.y));
                u32x2 wv; wv.x = cvt_pk_bf16(r0, r1); wv.y = cvt_pk_bf16(r2, r3);
                *(u32x2*)(outp + row * 1024 + v0) = wv;
            }
    }
    __syncthreads();
}

__device__ __forceinline__ void phase_mix(const Args& a, int l, LAS unsigned char* lds) {
    const int G = opaque_s(gridDim.x);
    unsigned char* ws = opaque_ptr(a.ws);
    const bool need_ctx = (l == 0);
#ifndef NO_GLA
    for (int it = BID; it < 256; it += G) gla_unit(a, l, lds, ((it & 7) * 4 + (it >> 6)) * 8 + ((it >> 3) & 7));
#if defined(REPEAT_SUB) && REPEAT_SUB == 1
    for (int it = BID; it < 256; it += G) gla_unit(a, l, lds, it);
#endif
#endif
#ifndef NO_ATT
    {
        const float* scal = (const float*)(ws + OFF_SCAL) + l * 4;
        const float lam = scal[0], c2 = scal[1], post = 1.f - scal[2];
        const bf16_t* z = (const bf16_t*)(ws + OFF_Z);
        const int nun = 512 + (need_ctx ? 64 : 0);
        const bool big = c2 > 48.f;
#define ATTN_UNIT(...) do { if (big) attn_unit<true>(__VA_ARGS__); else attn_unit<false>(__VA_ARGS__); } while (0)
#if defined(REPEAT_SUB) && REPEAT_SUB == 2
        for (int rep = 0; rep < 2; ++rep)
#endif
        for (int u = BID; u < nun; u += G) {
            if (u < 512) { const int vc = (u & 7) * 64 + (u >> 3), bh = vc >> 4, qb = vc & 15, b = bh >> 3, h = bh & 7;
                ATTN_UNIT(lds, (const bf16_t*)(ws + OFF_QN) + (size_t)bh * 2 * SEQ * 64, SEQ, 128 * qb, (const bf16_t*)(ws + OFF_KN) + (size_t)bh * 2 * LK * 64,
                          (const bf16_t*)(ws + OFF_VT) + (size_t)bh * 128 * LK, LK, c2, lam, post, inp(I_SUBLN) + l * 128, z + ZC_DG + h * 128, (bf16_t*)(ws + OFF_DIFFO) + h * 128, b * SEQ + 128 * qb);
            } else { const int uu = u - 512, bh = uu >> 1, qb = uu & 1, b = bh >> 3, h = bh & 7;
                ATTN_UNIT(lds, (const bf16_t*)(ws + OFF_QNC) + (size_t)bh * 2 * LC * 64, LC, 128 * qb, (const bf16_t*)(ws + OFF_KN) + (size_t)bh * 2 * LK * 64,
                          (const bf16_t*)(ws + OFF_VT) + (size_t)bh * 128 * LK, LC, c2, lam, post, inp(I_SUBLN) + l * 128, z + ZC_DG + h * 128, (bf16_t*)(ws + OFF_DIFFO) + h * 128, ML + b * LC + 128 * qb);
            }
        }
    }
#endif
#ifndef NO_POOL
    {
        const int Mrows = need_ctx ? MT : ML;
        pg8::Gemm g{(const bf16_t*)(ws + OFF_DPOOL), (const bf16_t*)(ws + OFF_POOLT + (size_t)l * SZ_POOLT), Mrows, 1024, 256, 1024, 256, 256};
        pg8::StaticOrder S; S.init(Mrows, 1024, G, BID);
        pg8::EpiPool E{(bf16_t*)(ws + OFF_POOLO), (const bf16_t*)(ws + OFF_PGATE)};
        pg8::gemm_phase<pg8::EpiPool, pg8::StaticOrder, true, true>(lds, g, S, E);
    }
#endif
}

__device__ __forceinline__ void phase_post(const Args& a, int l) {
    const int tid = opaque_tid(), lane = tid & 63, wave = tid >> 6, G = opaque_s(gridDim.x);
    const int gw = BID * 8 + wave, NGW = G * 8;
    unsigned char* ws = opaque_ptr(a.ws);
    const bf16_t* z = (const bf16_t*)(ws + OFF_Z);
    const bf16_t* of = (const bf16_t*)(ws + OFF_OF); const bf16_t* ob = of + (size_t)MT * 1024;
    bf16_t* go = (bf16_t*)(ws + OFF_GLAO);
    const int Mrows = (l == 0) ? MT : ML;
    const float* gn = inp(I_GLAN) + l * 256 + ((16 * lane) & 255);
    for (int row = gw; row < Mrows; row += NGW) {
        float x[16], y[16], gz[16];
        const size_t o = (size_t)row * 1024 + 16 * lane;
        unpack8(*(const u32x4*)(of + o), x); unpack8(*(const u32x4*)(of + o + 8), x + 8);
        unpack8(*(const u32x4*)(ob + o), y); unpack8(*(const u32x4*)(ob + o + 8), y + 8);
        unpack8(*(const u32x4*)(z + (size_t)row * NZ + ZC_GG + 16 * lane), gz); unpack8(*(const u32x4*)(z + (size_t)row * NZ + ZC_GG + 16 * lane + 8), gz + 8);
        float ss = 0.f;
#pragma unroll
        for (int e = 0; e < 16; ++e) { x[e] += y[e]; ss += x[e] * x[e]; }
        ss += __shfl_xor(ss, 1); ss += __shfl_xor(ss, 2); ss += __shfl_xor(ss, 4); ss += __shfl_xor(ss, 8);
        const float rstd = rsqrtf(ss * (1.f / 256.f) + EPS);
        float r[16];
#pragma unroll
        for (int e = 0; e < 16; ++e) r[e] = x[e] * rstd * gn[e] * silu_f(gz[e]);
        u32x4 w0, w1;
        w0.x = cvt_pk_bf16(r[0], r[1]); w0.y = cvt_pk_bf16(r[2], r[3]); w0.z = cvt_pk_bf16(r[4], r[5]); w0.w = cvt_pk_bf16(r[6], r[7]);
        w1.x = cvt_pk_bf16(r[8], r[9]); w1.y = cvt_pk_bf16(r[10], r[11]); w1.z = cvt_pk_bf16(r[12], r[13]); w1.w = cvt_pk_bf16(r[14], r[15]);
        *(u32x4*)(go + o) = w0; *(u32x4*)(go + o + 8) = w1;
    }
}

#define XB_TMO      128
#define XB_XCNT(j)  (256  + 64 * (j))
#define XB_XSUB(j)  (1280 + 64 * (j))
#define XB_XGEN(j)  (2304 + 64 * (j))
#define XB_TOP      3328
#define XB_TOPGEN   3392
#define XCD_BAR_WORDS 3456
#define XB_SPIN_CAP (1u << 18)

__device__ __forceinline__ unsigned xb_ld(unsigned* p)              { return __hip_atomic_load(p, __ATOMIC_RELAXED, __HIP_MEMORY_SCOPE_AGENT); }
__device__ __forceinline__ unsigned xb_add(unsigned* p, unsigned v) { return __hip_atomic_fetch_add(p, v, __ATOMIC_RELAXED, __HIP_MEMORY_SCOPE_AGENT); }
__device__ __forceinline__ unsigned xb_xcc_id() { return (unsigned)__builtin_amdgcn_s_getreg((3 << 11) | 20) & 0xFu; }
#define XB_SPIN(cond, bar) do { unsigned _sp = 0; while (cond) { __builtin_amdgcn_s_sleep(1); \
    if ((++_sp & 255u) == 0u) { if (xb_ld(&(bar)[XB_TMO])) break; if (_sp > XB_SPIN_CAP) { atomicAdd(&(bar)[XB_TMO], 1u); break; } } } } while (0)

struct XcdBarrier {
    unsigned* bar; unsigned x;
    volatile LAS unsigned* st;
};

__device__ __forceinline__ XcdBarrier xcd_barrier_post(unsigned* bar, volatile LAS unsigned* st) {
    XcdBarrier b; b.bar = bar; b.x = xb_xcc_id(); b.st = st;
    if (threadIdx.x == 0) (void)xb_add(&bar[XB_XCNT(b.x)], 1u);
    return b;
}
__device__ __forceinline__ void xcd_barrier_complete(unsigned* bar, unsigned x, unsigned& nloc, unsigned& nx) {
    const unsigned G = gridDim.x * gridDim.y * gridDim.z;
    unsigned sum, cnt, mine, sp = 0u;
    for (;;) {
        sum = 0u; cnt = 0u; mine = 0u;
#pragma unroll
        for (unsigned j = 0; j < 16; ++j) { const unsigned c = xb_ld(&bar[XB_XCNT(j)]); sum += c; cnt += (c > 0u) ? 1u : 0u; mine = (j == x) ? c : mine; }
        if (sum == G) break;
        __builtin_amdgcn_s_sleep(1);
        if ((++sp & 255u) == 0u) { if (xb_ld(&bar[XB_TMO])) break; if (sp > XB_SPIN_CAP) { atomicAdd(&bar[XB_TMO], 1u); break; } }
    }
    nloc = mine > 0u ? mine : 1u; nx = cnt > 0u ? cnt : 1u;
}

__device__ __forceinline__ void xcd_barrier(const XcdBarrier& b) {
    asm volatile("s_waitcnt vmcnt(0)" ::: "memory");
    __syncthreads();
    if (threadIdx.x == 0) {
        unsigned* bar = b.bar;
        __builtin_amdgcn_s_waitcnt(0);
        unsigned nloc = b.st[0], nx = b.st[1];
        if (nloc == 0u) { xcd_barrier_complete(bar, b.x, nloc, nx); b.st[0] = nloc; b.st[1] = nx; }
        const unsigned old = xb_add(&bar[XB_XSUB(b.x)], 1u);
        const unsigned gen = old / nloc;
        if (old + 1u == (gen + 1u) * nloc) {
            __builtin_amdgcn_fence(__ATOMIC_RELEASE, "agent");
            asm volatile("s_waitcnt vmcnt(0)" ::: "memory");
            const unsigned og = xb_add(&bar[XB_TOP], 1u);
            const unsigned tg = og / nx;
            if (og + 1u == (tg + 1u) * nx) xb_add(&bar[XB_TOPGEN], 1u);
            else XB_SPIN(xb_ld(&bar[XB_TOPGEN]) == tg, bar);
            __builtin_amdgcn_fence(__ATOMIC_ACQUIRE, "agent");
            xb_add(&bar[XB_XGEN(b.x)], 1u);
            asm volatile("s_waitcnt vmcnt(0)" ::: "memory");
        } else {
            XB_SPIN(xb_ld(&bar[XB_XGEN(b.x)]) == gen, bar);
            __builtin_amdgcn_fence(__ATOMIC_ACQUIRE, "agent");
            asm volatile("s_waitcnt vmcnt(0)" ::: "memory");
        }
    }
    __syncthreads();
}

#ifndef REPEAT_K
#define REPEAT_K -1
#endif
#define SEAM() do { XcdBarrier xb; xb.bar = (unsigned*)(opaque_ptr(a.ws) + OFF_BAR); xb.x = xb_xcc_id(); xb.st = (volatile LAS unsigned*)(lds + 131072 + 512); xcd_barrier(xb); } while (0)
#define REP(k) for (int rep_ = 0; rep_ < (REPEAT_K == (k) ? 2 : 1); ++rep_)
template <int l> __device__ __forceinline__ void run_layer(const Args& a, LAS unsigned char* lds) {
    constexpr int Mout = (l == 0) ? MT : ML;
    REP(0) phase_norm(a, l);
    SEAM();
    REP(1) {
        unsigned char* ws = opaque_ptr(a.ws); const int G = opaque_s(gridDim.x);
        pg8::Gemm g{(const bf16_t*)(ws + OFF_H), (const bf16_t*)(ws + OFF_WIN + (size_t)l * SZ_WIN), MT, NZ, DM, DM, DM, 0};
        pg8::EpiBf16 E{(bf16_t*)(ws + OFF_Z), NZ};
        if (l == 0) { pg8::StaticOrder S; S.init(MT, NZ, G, BID); pg8::gemm_phase<pg8::EpiBf16, pg8::StaticOrder, true, true>(lds, g, S, E); }
        else { pg8::CtxSkipOrder S; S.init(G, BID); pg8::gemm_phase<pg8::EpiBf16, pg8::CtxSkipOrder, true, true>(lds, g, S, E); }
    }
    SEAM();
    REP(2) phase_prep(a, l, lds);
    SEAM();
    REP(3) phase_mix(a, l, lds);
    SEAM();
    REP(4) phase_post(a, l);
    SEAM();
    REP(5) {
        unsigned char* ws = opaque_ptr(a.ws); const int G = opaque_s(gridDim.x);
        pg8::SegOrder3 S; S.base.init(Mout, DM, G, BID);
        const bf16_t* wb = (const bf16_t*)(ws + OFF_WB + (size_t)l * SZ_WB);
        pg8::Gemm g{(const bf16_t*)(ws + OFF_POOLO), wb, Mout, DM, 1024, 1024, 1024, 0,
                    (const bf16_t*)(ws + OFF_DIFFO), (const bf16_t*)(ws + OFF_GLAO), wb + (size_t)DM * 1024, wb + (size_t)2 * DM * 1024};
        pg8::EpiMerge3 E{(bf16_t*)(ws + OFF_H), (const bf16_t*)(ws + OFF_Z) + ZC_MG};
        pg8::gemm_phase<pg8::EpiMerge3, pg8::SegOrder3, true, true, 3>(lds, g, S, E);
    }
    SEAM();
    REP(6) {
        unsigned char* ws = opaque_ptr(a.ws); const int G = opaque_s(gridDim.x);
        pg8::Gemm g{(const bf16_t*)(ws + OFF_H), (const bf16_t*)(ws + OFF_WOUT + (size_t)l * SZ_WOUT), Mout, DM, DM, DM, DM, 0};
        pg8::StaticOrder S; S.init(Mout, DM, G, BID);
        pg8::EpiOut E{l == 0 ? inp(I_X) : (const float*)(ws + OFF_X1), l == 0 ? inp(I_CTX) : (const float*)(ws + OFF_X1) + (size_t)ML * DM,
                      l == 0 ? (float*)(ws + OFF_X1) : arg_out(), (const float*)(ws + OFF_MOD) + (size_t)l * 5 * 6144};
        pg8::gemm_phase<pg8::EpiOut, pg8::StaticOrder, true, true>(lds, g, S, E);
    }
}

__global__ void __launch_bounds__(512, 2) hybrid_fwd(Args a) {
    extern __shared__ __attribute__((aligned(16))) unsigned char smem[];
    LAS unsigned char* lds = (LAS unsigned char*)smem;
    cg::grid_group grid = cg::this_grid();
    volatile LAS unsigned* bst = (volatile LAS unsigned*)(lds + 131072 + 512);
    if (threadIdx.x < 2) bst[threadIdx.x] = 0u;
    __syncthreads();
    (void)xcd_barrier_post((unsigned*)(a.ws + OFF_BAR), bst);
    REP(7) phase_p0(a, lds);
    grid.sync();
    run_layer<0>(a, lds);
    SEAM();
    run_layer<1>(a, lds);
}

extern "C" void kernel_launch(void* const* d_in, const int* in_sizes, int n_in, void* d_out, int out_size, void* d_ws, size_t ws_size, hipStream_t stream) {
    static int grid = 0;
    if (grid == 0) {
        if (n_in != 26 || out_size != ML * DM || ws_size < WS_END) { fprintf(stderr, "kernel_launch: expected 26 inputs, out %d, ws >= %zu; got n_in %d out %d ws %zu\n", ML * DM, (size_t)WS_END, n_in, out_size, ws_size); grid = -1; return; }
        int dev = 0, cus = 0, per_cu = 0;
        if (hipGetDevice(&dev) != hipSuccess || hipDeviceGetAttribute(&cus, hipDeviceAttributeMultiprocessorCount, dev) != hipSuccess) { grid = -1; return; }
        if (hipFuncSetAttribute((const void*)hybrid_fwd, hipFuncAttributeMaxDynamicSharedMemorySize, LDS_BYTES) != hipSuccess) { fprintf(stderr, "kernel_launch: hipFuncSetAttribute failed\n"); grid = -1; return; }
        if (hipOccupancyMaxActiveBlocksPerMultiprocessor(&per_cu, (const void*)hybrid_fwd, 512, LDS_BYTES) != hipSuccess || per_cu < 1) { fprintf(stderr, "kernel_launch: occupancy query says %d blocks per CU\n", per_cu); (void)hipGetLastError(); grid = -1; return; }
        grid = cus;
    }
    if (grid < 0) return;
    if (hipMemsetAsync((char*)d_ws + OFF_BAR, 0, BAR_BYTES, stream) != hipSuccess) { fprintf(stderr, "kernel_launch: memset of the barrier words failed\n"); return; }
    Args a{};
    for (int i = 0; i < 26; ++i) a.in[i] = (const float*)d_in[i];
    a.out = (float*)d_out; a.ws = (unsigned char*)d_ws;
    a.ph_lo = 0; a.ph_hi = NPH;
    void* args[] = {&a};
    const hipError_t e = hipLaunchCooperativeKernel((const void*)hybrid_fwd, dim3(grid), dim3(512), args, LDS_BYTES, stream);
    if (e != hipSuccess) fprintf(stderr, "kernel_launch: cooperative launch failed: %s (grid %d)\n", hipGetErrorString(e), grid);
}
```

```cpp
#include <hip/hip_runtime.h>
#include <hip/hip_cooperative_groups.h>
#include <cstdio>
#include <cstdint>
namespace cg = cooperative_groups;

#ifndef MK_N_LAUNCHES
#define MK_N_LAUNCHES 1
#endif

#define LAS __attribute__((address_space(3)))
typedef unsigned short bf16_t;
typedef short bf16x8 __attribute__((ext_vector_type(8)));
typedef float f32x4 __attribute__((ext_vector_type(4)));
typedef float f32x16 __attribute__((ext_vector_type(16)));
typedef unsigned u32x4 __attribute__((ext_vector_type(4)));
typedef unsigned u32x2 __attribute__((ext_vector_type(2)));

constexpr int DM = 2048, NB = 4, SEQ = 2048, LC = 256, ML = NB * SEQ, MC = NB * LC, MT = ML + MC;
constexpr int DIN = 15392, NZ = 15616;
constexpr int ZC_PU = 0, ZC_PG = 1024, ZC_DQ = 2048, ZC_DK = 3072, ZC_DV = 4096, ZC_DG = 5120, ZC_GQ = 6144, ZC_GK = 6656, ZC_GV = 7168, ZC_GG = 8192, ZC_LR = 9216, ZC_MG = 9472;
constexpr int LK = LC + SEQ;
constexpr float EPS = 1e-6f, LOG2E = 1.4426950408889634f;
constexpr int NPH = 15;

constexpr size_t SZ_WIN = (size_t)NZ * DM * 2, SZ_WB = (size_t)3 * DM * 1024 * 2, SZ_WOUT = (size_t)DM * DM * 2, SZ_POOLT = (size_t)4 * 256 * 256 * 2;
constexpr size_t OFF_WIN = 0;
constexpr size_t OFF_WB = OFF_WIN + 2 * SZ_WIN;
constexpr size_t OFF_WOUT = OFF_WB + 2 * SZ_WB;
constexpr size_t OFF_POOLT = OFF_WOUT + 2 * SZ_WOUT;
constexpr size_t OFF_MOD = OFF_POOLT + 2 * SZ_POOLT;
constexpr size_t OFF_SCAL = OFF_MOD + (size_t)2 * 5 * 6144 * 4;
constexpr size_t OFF_H = OFF_SCAL + 256;
constexpr size_t OFF_Z = OFF_H + (size_t)MT * DM * 2;
constexpr size_t OFF_QN = OFF_Z + (size_t)MT * NZ * 2;
constexpr size_t OFF_QNC = OFF_QN + (size_t)ML * 1024 * 2;
constexpr size_t OFF_KN = OFF_QNC + (size_t)MC * 1024 * 2;
constexpr size_t OFF_VT = OFF_KN + (size_t)MT * 1024 * 2;
constexpr size_t SZ_G = (size_t)MT * 512 * 2;
constexpr size_t OFF_GQ = OFF_VT + (size_t)MT * 1024 * 2;
constexpr size_t OFF_GK = OFF_GQ + 2 * SZ_G;
constexpr size_t OFF_GH = OFF_GK + 2 * SZ_G;
constexpr size_t OFF_DEC = OFF_GH + 2 * SZ_G;
constexpr size_t OFF_OF = OFF_DEC + (size_t)2 * 144 * 512 * 4;
constexpr size_t OFF_DPOOL = OFF_OF + 2 * (size_t)MT * 1024 * 2;
constexpr size_t OFF_POOLO = OFF_DPOOL + (size_t)MT * 1024 * 2;
constexpr size_t OFF_DIFFO = OFF_POOLO + (size_t)MT * 1024 * 2;
constexpr size_t OFF_GLAO = OFF_DIFFO + (size_t)MT * 1024 * 2;
constexpr size_t OFF_YACC = OFF_GLAO + (size_t)MT * 1024 * 2;
constexpr size_t OFF_X1 = OFF_YACC + (size_t)MT * DM * 4;
constexpr size_t OFF_PGATE = OFF_X1 + (size_t)MT * DM * 4;
constexpr size_t OFF_BAR = OFF_PGATE + (size_t)MT * 1024 * 2;
constexpr size_t BAR_BYTES = 16384;
constexpr size_t OFF_GVT = OFF_BAR + BAR_BYTES;
constexpr size_t WS_END = OFF_GVT + (size_t)MT * 1024 * 2;

constexpr int LDS_BYTES = 135168;

#define BID opaque_s((int)blockIdx.x)
#define GAS __attribute__((address_space(1)))
__device__ __forceinline__ unsigned char* opaque_ptr(unsigned char* p) { GAS unsigned char* q = (GAS unsigned char*)p; asm volatile("" : "+s"(q)); return (unsigned char*)q; }
__device__ __forceinline__ int opaque_s(int v) { asm volatile("" : "+s"(v)); return v; }
__device__ __forceinline__ int opaque_tid() { int t = threadIdx.x; asm volatile("" : "+v"(t)); return t; }
typedef float f32x2_t __attribute__((ext_vector_type(2))); typedef __bf16 bf16x2_t __attribute__((ext_vector_type(2)));
__device__ __forceinline__ unsigned cvt_pk_bf16(float lo, float hi) { f32x2_t v = {lo, hi}; bf16x2_t b = __builtin_convertvector(v, bf16x2_t); return __builtin_bit_cast(unsigned, b); }
__device__ __forceinline__ bf16_t f2bf(float f) { return (bf16_t)(cvt_pk_bf16(f, 0.f) & 0xffffu); }
__device__ __forceinline__ float bf2f(bf16_t v) { return __builtin_bit_cast(float, (unsigned)v << 16); }
__device__ __forceinline__ float bflo(unsigned u) { return __builtin_bit_cast(float, u << 16); }
__device__ __forceinline__ float bfhi(unsigned u) { return __builtin_bit_cast(float, u & 0xffff0000u); }
__device__ __forceinline__ float silu_f(float x) { return x * __builtin_amdgcn_rcpf(1.f + __expf(-x)); }
__device__ __forceinline__ float sigmoid_f(float x) { return __builtin_amdgcn_rcpf(1.f + __expf(-x)); }
__device__ __forceinline__ float logsig_f(float a) { return fminf(a, 0.f) - __logf(1.f + __expf(-fabsf(a))); }
__device__ __forceinline__ float wave_sum(float v) {
#pragma unroll
    for (int o = 1; o < 64; o <<= 1) v += __shfl_xor(v, o);
    return v;
}
__device__ __forceinline__ float wave_max(float v) {
#pragma unroll
    for (int o = 1; o < 64; o <<= 1) v = fmaxf(v, __shfl_xor(v, o));
    return v;
}
__device__ __forceinline__ void unpack8(u32x4 w, float* f) { f[0] = bflo(w.x); f[1] = bfhi(w.x); f[2] = bflo(w.y); f[3] = bfhi(w.y); f[4] = bflo(w.z); f[5] = bfhi(w.z); f[6] = bflo(w.w); f[7] = bfhi(w.w); }

namespace pg8 {
constexpr int BM = 256, BK = 64, HALF = 128, HTB = HALF * BK * 2, STAGE_BYTES = 8 * HTB, NXCD = 8, WGM = 8;
__host__ __device__ __forceinline__ int lds_byte(int r, int c) { const int st = (r >> 4) * 2 + (c >> 5), rr = r & 15, cc = c & 31, ob = rr * 64 + cc * 2; return st * 1024 + (ob ^ (((ob >> 9) & 1) << 5)); }
__host__ __device__ __forceinline__ void stage_rc(int b, int& R, int& C) { const int st = b / 1024, sb = b % 1024, swz = sb ^ (((sb >> 9) & 1) << 5); R = (st >> 1) * 16 + swz / 64; C = (st & 1) * 32 + (swz % 64) / 2; }
__host__ __device__ __forceinline__ int perm32(int rho) { const int n = rho >> 4, i = rho & 15; return 8 * (i >> 2) + 4 * n + (i & 3); }

struct Unit { int pm, pn, seg; };
struct Gemm { const bf16_t* A; const bf16_t* Bt; int M, N, K; int lda, ldb; int a_pn_off; const bf16_t* A1; const bf16_t* A2; const bf16_t* B1; const bf16_t* B2; };

struct StaticOrder {
    int nM, nN, nwg, G, c;
    __host__ __device__ void init(int M, int N, int G_, int c_) { nM = M / BM; nN = N / BM; nwg = nM * nN; G = G_; c = c_; }
    __host__ __device__ bool next(int i, Unit& u) const {
        const long L = (long)i * G + c; if (L >= nwg) return false;
        int wgid = (int)L; { const int q = nwg / NXCD, r = nwg % NXCD, xcd = wgid % NXCD, off = wgid / NXCD; wgid = (xcd < r ? xcd * (q + 1) : r * (q + 1) + (xcd - r) * q) + off; }
        const int nig = WGM * nN, gid = wgid / nig, fm = gid * WGM, gsz = (nM - fm) < WGM ? (nM - fm) : WGM;
        u.pm = fm + ((wgid % nig) % gsz); u.pn = (wgid % nig) / gsz; u.seg = 0; return true;
    }
    __device__ __forceinline__ void a_ready(const Unit&) const {}
    __device__ __forceinline__ void done(const Unit&) const {}
};

struct CtxSkipOrder {
    StaticOrder base; int nbase;
    __host__ __device__ void init(int G_, int c_) { base.init(ML, NZ, G_, c_); nbase = base.nwg; }
    __host__ __device__ bool next(int i, Unit& u) const {
        const long L = (long)i * base.G + base.c;
        if (L < nbase) return base.next(i, u);
        const int e = (int)(L - nbase); if (e >= 4 * 15) return false;
        const int j = e % 15; u.pm = 32 + e / 15; u.pn = j < 8 ? 12 + j : (j < 14 ? 18 + j : 36); u.seg = 0; return true;
    }
    __device__ __forceinline__ void a_ready(const Unit&) const {}
    __device__ __forceinline__ void done(const Unit&) const {}
};
struct SegOrder3 {
    StaticOrder base;
    __host__ __device__ bool next(int i, Unit& u) const { const int q = i / 3; if (!base.next(q, u)) return false; u.seg = i - 3 * q; return true; }
    __device__ __forceinline__ void a_ready(const Unit&) const {}
    __device__ __forceinline__ void done(const Unit&) const {}
};
struct EpiBf16 {
    static constexpr bool PERM = true, AFTER_DRAIN = false;
    bf16_t* O; int ldc;
    __device__ __forceinline__ void operator()(const f32x4 (&acc)[2][2][4][2], const Unit& u, int wr, int wc, int fr, int fq) const {
        const int row0 = u.pm * BM + wr * 64 + fr, col0 = u.pn * BM + wc * 32 + 8 * fq;
#pragma unroll
        for (int ai = 0; ai < 2; ++ai)
#pragma unroll
            for (int m = 0; m < 4; ++m) { bf16_t* rowp = O + (size_t)(row0 + ai * HALF + m * 16) * ldc + col0;
#pragma unroll
                for (int bj = 0; bj < 2; ++bj) { const f32x4 v0 = acc[ai][bj][m][0], v1 = acc[ai][bj][m][1];
                    u32x4 w; w.x = cvt_pk_bf16(v0[0], v0[1]); w.y = cvt_pk_bf16(v0[2], v0[3]); w.z = cvt_pk_bf16(v1[0], v1[1]); w.w = cvt_pk_bf16(v1[2], v1[3]);
                    *(u32x4*)(rowp + bj * HALF) = w; } }
    }
};

template <class Epi, class Sched, bool ALIGN_EPI = false, bool SP2 = false, int NSEG = 1>
__device__ __forceinline__ void gemm_phase(LAS unsigned char* lds, const Gemm g, const Sched& S, const Epi& E) {
    const int tid = opaque_tid(), wid = __builtin_amdgcn_readfirstlane(tid >> 6), lane = tid & 63, wr = wid >> 2, wc = wid & 3, fr = lane & 15, fq = lane >> 4;
    const int K = opaque_s(g.K), nt = K / BK;
    unsigned voffA[2], voffB[2];
#pragma unroll
    for (int i = 0; i < 2; ++i) { int R, C; stage_rc(tid * 16 + i * 8192, R, C); const int Rb = Epi::PERM ? ((R & ~31) + perm32(R & 31)) : R;
        voffA[i] = (unsigned)(R * g.lda + C) * 2u; voffB[i] = (unsigned)(Rb * g.ldb + C) * 2u; }
    const size_t kstep = (size_t)(BK * 2);
    const size_t hstepA = (size_t)HALF * g.lda * 2, hstepB = (size_t)HALF * g.ldb * 2;
    const size_t tstepA = 2 * hstepA, tstepB = 2 * hstepB;
    const size_t pnA = (size_t)g.a_pn_off * 2;
    const unsigned ldsw = (unsigned)wid * 1024u;
    const int aoff = lds_byte(wr * 64 + fr, fq * 8), boff = lds_byte(wc * 32 + fr, fq * 8);
#define PG8_SA(b, h) (((b) * 2 + (h)) * HTB)
#define PG8_SB(b, h) ((4 + (b) * 2 + (h)) * HTB)
#define PG8_STAGE(bufoff, gbase, voff) do { _Pragma("unroll") for (int _i = 0; _i < 2; ++_i) \
        __builtin_amdgcn_global_load_lds((const unsigned*)((const char*)(gbase) + (voff)[_i]), (LAS unsigned*)(lds + (bufoff) + ldsw + _i * 8192), 16, 0, 0); } while (0)
#define PG8_LDA(dst, b, h) do { _Pragma("unroll") for (int m = 0; m < 4; ++m) _Pragma("unroll") for (int k = 0; k < 2; ++k) dst[m][k] = *(const LAS bf16x8*)(lds + PG8_SA(b, h) + aoff + m * 2048 + k * 1024); } while (0)
#define PG8_LDB(dst, b, h) do { _Pragma("unroll") for (int n = 0; n < 2; ++n) _Pragma("unroll") for (int k = 0; k < 2; ++k) dst[n][k] = *(const LAS bf16x8*)(lds + PG8_SB(b, h) + boff + n * 2048 + k * 1024); } while (0)
#define PG8_MMA(ai, bj, At, Bt) do { __builtin_amdgcn_s_setprio(1); _Pragma("unroll") for (int m = 0; m < 4; ++m) _Pragma("unroll") for (int n = 0; n < 2; ++n) _Pragma("unroll") for (int k = 0; k < 2; ++k) \
        acc[ai][bj][m][n] = __builtin_amdgcn_mfma_f32_16x16x32_bf16(Bt[n][k], At[m][k], acc[ai][bj][m][n], 0, 0, 0); __builtin_amdgcn_s_setprio(0); } while (0)
#define PG8_WAIT_V(n) asm volatile("s_waitcnt vmcnt(" #n ")" ::: "memory")
#define PG8_WAIT_L(n) asm volatile("s_waitcnt lgkmcnt(" #n ")" ::: "memory")
#define PG8_BAR __builtin_amdgcn_s_barrier()
#define PG8_SCHED __builtin_amdgcn_sched_barrier(0)
    Unit cur, nxt; int ui = 0;
    if (!S.next(0, cur)) return;
    f32x4 acc[2][2][4][2];
#pragma unroll
    for (int a = 0; a < 2; ++a)
#pragma unroll
        for (int b = 0; b < 2; ++b)
#pragma unroll
            for (int m = 0; m < 4; ++m)
#pragma unroll
                for (int n = 0; n < 2; ++n) acc[a][b][m][n] = (f32x4){0.f, 0.f, 0.f, 0.f};
    bf16x8 At[4][2], B0[2][2], B1[2][2];
#define PG8_ASEG(u) ((const char*)(NSEG == 1 || (u).seg == 0 ? g.A : ((u).seg == 1 ? g.A1 : g.A2)))
#define PG8_BSEG(u) ((const char*)(NSEG == 1 || (u).seg == 0 ? g.Bt : ((u).seg == 1 ? g.B1 : g.B2)))
    const char* cA = PG8_ASEG(cur) + (size_t)cur.pm * tstepA + (size_t)cur.pn * pnA; const char* cB = PG8_BSEG(cur) + (size_t)cur.pn * tstepB;
    S.a_ready(cur);
    if constexpr (SP2) {
        PG8_STAGE(PG8_SB(0, 0), cB, voffB); PG8_STAGE(PG8_SB(0, 1), cB + hstepB, voffB); PG8_STAGE(PG8_SA(0, 0), cA, voffA); PG8_STAGE(PG8_SA(0, 1), cA + hstepA, voffA);
        if (wr == 1) PG8_BAR;
        PG8_WAIT_V(2); PG8_BAR;
        PG8_STAGE(PG8_SB(1, 0), cB + kstep, voffB); PG8_STAGE(PG8_SA(1, 0), cA + kstep, voffA); PG8_STAGE(PG8_SB(1, 1), cB + hstepB + kstep, voffB);
        PG8_WAIT_V(6); PG8_BAR;
    } else {
        PG8_STAGE(PG8_SB(0, 0), cB, voffB); PG8_STAGE(PG8_SA(0, 0), cA, voffA); PG8_STAGE(PG8_SB(0, 1), cB + hstepB, voffB); PG8_STAGE(PG8_SA(0, 1), cA + hstepA, voffA);
        if (wr == 1) PG8_BAR;
        PG8_WAIT_V(4); PG8_BAR;
        PG8_STAGE(PG8_SB(1, 0), cB + kstep, voffB); PG8_STAGE(PG8_SA(1, 0), cA + kstep, voffA); PG8_STAGE(PG8_SB(1, 1), cB + hstepB + kstep, voffB);
        PG8_WAIT_V(6); PG8_BAR;
    }
    for (;;) {
        const bool has_next = S.next(ui + 1, nxt);
        const char* nA = has_next ? PG8_ASEG(nxt) + (size_t)nxt.pm * tstepA + (size_t)nxt.pn * pnA : cA; const char* nB = has_next ? PG8_BSEG(nxt) + (size_t)nxt.pn * tstepB : cB;
        for (int t = 0; t < nt; t += 2) {
            const bool last = (t == nt - 2);
            const char* a1 = cA + (size_t)(t + 1) * kstep;
            const char* a2 = last ? nA : cA + (size_t)(t + 2) * kstep; const char* b2 = last ? nB : cB + (size_t)(t + 2) * kstep;
            const char* a3 = a2 + kstep; const char* b3 = b2 + kstep;
            if (last && has_next) S.a_ready(nxt);
            if constexpr (SP2) {
            PG8_LDB(B0, 0, 0); PG8_LDB(B1, 0, 1); PG8_SCHED; PG8_LDA(At, 0, 0); PG8_STAGE(PG8_SA(1, 1), a1 + hstepA, voffA);
            PG8_WAIT_V(8); PG8_WAIT_L(0); PG8_BAR; PG8_MMA(0, 0, At, B0); PG8_MMA(0, 1, At, B1); PG8_BAR; PG8_SCHED;
            PG8_LDA(At, 0, 1); PG8_STAGE(PG8_SB(0, 0), b2, voffB); PG8_STAGE(PG8_SB(0, 1), b2 + hstepB, voffB); PG8_STAGE(PG8_SA(0, 0), a2, voffA);
            PG8_WAIT_V(8); PG8_WAIT_L(0); PG8_BAR; PG8_MMA(1, 0, At, B0); PG8_MMA(1, 1, At, B1); PG8_BAR; PG8_SCHED;
            PG8_LDB(B0, 1, 0); PG8_LDB(B1, 1, 1); PG8_SCHED; PG8_LDA(At, 1, 0); PG8_STAGE(PG8_SA(0, 1), a2 + hstepA, voffA);
            PG8_WAIT_V(8); PG8_WAIT_L(0); PG8_BAR; PG8_MMA(0, 0, At, B0); PG8_MMA(0, 1, At, B1); PG8_BAR; PG8_SCHED;
            PG8_LDA(At, 1, 1); PG8_STAGE(PG8_SB(1, 0), b3, voffB); PG8_STAGE(PG8_SB(1, 1), b3 + hstepB, voffB); PG8_STAGE(PG8_SA(1, 0), a3, voffA);
            PG8_WAIT_V(8); PG8_WAIT_L(0); PG8_BAR; PG8_MMA(1, 0, At, B0); PG8_MMA(1, 1, At, B1); PG8_BAR; PG8_SCHED;
            } else {
            PG8_LDB(B0, 0, 0); PG8_SCHED; PG8_LDA(At, 0, 0); PG8_STAGE(PG8_SA(1, 1), a1 + hstepA, voffA);
            PG8_WAIT_L(8); PG8_BAR; PG8_WAIT_L(0); PG8_MMA(0, 0, At, B0); PG8_BAR; PG8_SCHED;
            PG8_LDB(B1, 0, 1); PG8_STAGE(PG8_SB(0, 0), b2, voffB);
            PG8_BAR; PG8_WAIT_L(0); PG8_MMA(0, 1, At, B1); PG8_BAR;
            PG8_LDA(At, 0, 1); PG8_STAGE(PG8_SA(0, 0), a2, voffA);
            PG8_BAR; PG8_WAIT_L(0); PG8_MMA(1, 0, At, B0); PG8_BAR; PG8_SCHED;
            PG8_STAGE(PG8_SB(0, 1), b2 + hstepB, voffB);
            PG8_WAIT_V(6); PG8_BAR; PG8_MMA(1, 1, At, B1); PG8_BAR;
            PG8_LDB(B0, 1, 0); PG8_SCHED; PG8_LDA(At, 1, 0); PG8_STAGE(PG8_SA(0, 1), a2 + hstepA, voffA);
            PG8_WAIT_L(8); PG8_BAR; PG8_WAIT_L(0); PG8_MMA(0, 0, At, B0); PG8_BAR; PG8_SCHED;
            PG8_LDB(B1, 1, 1); PG8_STAGE(PG8_SB(1, 0), b3, voffB);
            PG8_BAR; PG8_WAIT_L(0); PG8_MMA(0, 1, At, B1); PG8_BAR;
            PG8_LDA(At, 1, 1); PG8_STAGE(PG8_SA(1, 0), a3, voffA);
            PG8_BAR; PG8_WAIT_L(0); PG8_MMA(1, 0, At, B0); PG8_BAR; PG8_SCHED;
            PG8_STAGE(PG8_SB(1, 1), b3 + hstepB, voffB);
            PG8_WAIT_V(6); PG8_BAR; PG8_MMA(1, 1, At, B1); PG8_BAR;
            }
        }
        if constexpr (ALIGN_EPI) { if (wr == 0) PG8_BAR; }
        E(acc, cur, wr, wc, fr, fq); S.done(cur);
        if (!has_next) break;
        if (NSEG == 1 || cur.seg == NSEG - 1)
#pragma unroll
        for (int a = 0; a < 2; ++a)
#pragma unroll
            for (int b = 0; b < 2; ++b)
#pragma unroll
                for (int m = 0; m < 4; ++m)
#pragma unroll
                    for (int n = 0; n < 2; ++n) acc[a][b][m][n] = (f32x4){0.f, 0.f, 0.f, 0.f};
        cur = nxt; cA = nA; cB = nB; ++ui;
        if constexpr (ALIGN_EPI) { if (wr == 1) PG8_BAR; }
    }
    PG8_WAIT_V(0);
    if constexpr (!ALIGN_EPI) { if (wr == 0) PG8_BAR; }
    PG8_BAR;
#undef PG8_ASEG
#undef PG8_BSEG
#undef PG8_SA
#undef PG8_SB
#undef PG8_STAGE
#undef PG8_LDA
#undef PG8_LDB
#undef PG8_MMA
#undef PG8_WAIT_V
#undef PG8_WAIT_L
#undef PG8_BAR
#undef PG8_SCHED
}

struct EpiPool {
    static constexpr bool PERM = true, AFTER_DRAIN = false;
    bf16_t* O; const bf16_t* pgate;
    __device__ __forceinline__ void operator()(const f32x4 (&acc)[2][2][4][2], const Unit& u, int wr, int wc, int fr, int fq) const {
        const int row0 = u.pm * BM + wr * 64 + fr, col0 = u.pn * BM + wc * 32 + 8 * fq;
#pragma unroll
        for (int ai = 0; ai < 2; ++ai)
#pragma unroll
            for (int m = 0; m < 4; ++m)
#pragma unroll
                for (int bj = 0; bj < 2; ++bj) {
                    const int row = row0 + ai * HALF + m * 16, col = col0 + bj * HALF;
                    const u32x4 gz = *(const u32x4*)(pgate + (size_t)row * 1024 + col);
                    const f32x4 v0 = acc[ai][bj][m][0], v1 = acc[ai][bj][m][1];
                    u32x4 w;
                    w.x = cvt_pk_bf16(v0[0] * bflo(gz.x), v0[1] * bfhi(gz.x));
                    w.y = cvt_pk_bf16(v0[2] * bflo(gz.y), v0[3] * bfhi(gz.y));
                    w.z = cvt_pk_bf16(v1[0] * bflo(gz.z), v1[1] * bfhi(gz.z));
                    w.w = cvt_pk_bf16(v1[2] * bflo(gz.w), v1[3] * bfhi(gz.w));
                    *(u32x4*)(O + (size_t)row * 1024 + col) = w;
                    __builtin_amdgcn_sched_barrier(0);
                }
    }
};
template <int PASS> struct EpiMerge {
    static constexpr bool PERM = true, AFTER_DRAIN = false;
    float* yacc; bf16_t* y; const bf16_t* zg;
    __device__ __forceinline__ void operator()(const f32x4 (&acc)[2][2][4][2], const Unit& u, int wr, int wc, int fr, int fq) const {
        const int row0 = u.pm * BM + wr * 64 + fr, col0 = u.pn * BM + wc * 32 + 8 * fq;
#pragma unroll
        for (int ai = 0; ai < 2; ++ai)
#pragma unroll
            for (int m = 0; m < 4; ++m)
#pragma unroll
                for (int bj = 0; bj < 2; ++bj) {
                    const int row = row0 + ai * HALF + m * 16, col = col0 + bj * HALF;
                    float gz[8]; unpack8(*(const u32x4*)(zg + (size_t)row * NZ + col), gz);
                    const f32x4 v0 = acc[ai][bj][m][0], v1 = acc[ai][bj][m][1];
                    f32x4 r0, r1;
#pragma unroll
                    for (int e = 0; e < 4; ++e) { r0[e] = v0[e] * sigmoid_f(gz[e]); r1[e] = v1[e] * sigmoid_f(gz[4 + e]); }
                    float* yp = yacc + (size_t)row * DM + col;
                    if (PASS >= 1) { r0 += *(const f32x4*)yp; r1 += *(const f32x4*)(yp + 4); }
                    if (PASS <= 1) { *(f32x4*)yp = r0; *(f32x4*)(yp + 4) = r1; }
                    else { u32x4 w; w.x = cvt_pk_bf16(r0[0], r0[1]); w.y = cvt_pk_bf16(r0[2], r0[3]); w.z = cvt_pk_bf16(r1[0], r1[1]); w.w = cvt_pk_bf16(r1[2], r1[3]);
                        *(u32x4*)(y + (size_t)row * DM + col) = w; }
                    __builtin_amdgcn_sched_barrier(0);
                }
    }
};
struct EpiMerge3 {
    static constexpr bool PERM = true, AFTER_DRAIN = false;
    bf16_t* y; const bf16_t* zg;
    __device__ __forceinline__ void operator()(f32x4 (&acc)[2][2][4][2], const Unit& u, int wr, int wc, int fr, int fq) const {
        const int row0 = u.pm * BM + wr * 64 + fr, col0 = u.pn * BM + wc * 32 + 8 * fq;
#pragma unroll
        for (int ai = 0; ai < 2; ++ai)
#pragma unroll
            for (int m = 0; m < 4; ++m)
#pragma unroll
                for (int bj = 0; bj < 2; ++bj) {
                    const int row = row0 + ai * HALF + m * 16, col = col0 + bj * HALF;
                    const bf16_t* zp = zg + (size_t)row * NZ + col + u.seg * 2048;
                    float ga[8]; unpack8(*(const u32x4*)zp, ga);
                    if (u.seg < 2) {
                        float gb[8]; unpack8(*(const u32x4*)(zp + 2048), gb);
#pragma unroll
                        for (int e = 0; e < 8; ++e) { const float ea = __expf(-fminf(fmaxf(ga[e], -30.f), 30.f)), eb = __expf(-fminf(fmaxf(gb[e], -30.f), 30.f));
                            const float ratio = (1.f + eb) / (1.f + ea); acc[ai][bj][m][e >> 2][e & 3] *= ratio; }
                    } else {
                        float r[8];
#pragma unroll
                        for (int e = 0; e < 8; ++e) r[e] = acc[ai][bj][m][e >> 2][e & 3] / (1.f + __expf(-fminf(fmaxf(ga[e], -30.f), 30.f)));
                        u32x4 w; w.x = cvt_pk_bf16(r[0], r[1]); w.y = cvt_pk_bf16(r[2], r[3]); w.z = cvt_pk_bf16(r[4], r[5]); w.w = cvt_pk_bf16(r[6], r[7]);
                        *(u32x4*)(y + (size_t)row * DM + col) = w;
                    }
                    __builtin_amdgcn_sched_barrier(0);
                }
    }
};
struct EpiOut {
    static constexpr bool PERM = true, AFTER_DRAIN = false;
    const float* xlat; const float* xctx; float* xnew; const float* mod;
    __device__ __forceinline__ void operator()(const f32x4 (&acc)[2][2][4][2], const Unit& u, int wr, int wc, int fr, int fq) const {
        const int row0 = u.pm * BM + wr * 64 + fr, col0 = u.pn * BM + wc * 32 + 8 * fq;
        const int tile_row = u.pm * BM; const int mr = tile_row < ML ? tile_row / SEQ : 4;
        const float* xo = tile_row < ML ? xlat : (xctx - (size_t)ML * DM);
        const float* gm = mod + mr * 6144 + 4096;
#pragma unroll
        for (int ai = 0; ai < 2; ++ai)
#pragma unroll
            for (int m = 0; m < 4; ++m)
#pragma unroll
                for (int bj = 0; bj < 2; ++bj) {
                    const int row = row0 + ai * HALF + m * 16, col = col0 + bj * HALF;
                    const f32x4 g0 = *(const f32x4*)(gm + col), g1 = *(const f32x4*)(gm + col + 4);
                    const float* xp = xo + (size_t)row * DM + col;
                    const f32x4 r0 = *(const f32x4*)xp + g0 * acc[ai][bj][m][0], r1 = *(const f32x4*)(xp + 4) + g1 * acc[ai][bj][m][1];
                    float* op = xnew + (size_t)row * DM + col;
                    *(f32x4*)op = r0; *(f32x4*)(op + 4) = r1;
                    __builtin_amdgcn_sched_barrier(0);
                }
    }
};
}

struct Args { const float* in[26]; float* out; unsigned char* ws; int ph_lo, ph_hi; };
enum { I_X = 0, I_C, I_CTX, I_CCTX, I_NORMG, I_WADA, I_BADA, I_WIN, I_POOLW, I_POOLS, I_QNORM, I_KNORM, I_LQ1, I_LK1, I_LQ2, I_LK2, I_SUBLN, I_WGF, I_BGF, I_WGB, I_BGB, I_GLAN, I_WBP, I_WBD, I_WBG, I_WOUT };

__device__ __forceinline__ const float* inp(int i) { const float* const volatile __attribute__((address_space(4)))* kp = (const float* const volatile __attribute__((address_space(4)))*)__builtin_amdgcn_kernarg_segment_ptr(); const GAS float* q = (const GAS float*)kp[i]; asm volatile("" : "+s"(q)); return (const float*)q; }
__device__ __forceinline__ float* arg_out() { float* const volatile __attribute__((address_space(4)))* kp = (float* const volatile __attribute__((address_space(4)))*)__builtin_amdgcn_kernarg_segment_ptr(); GAS float* q = (GAS float*)kp[26]; asm volatile("" : "+s"(q)); return (float*)q; }
__device__ __forceinline__ void transpose_item(const float* W, int K, int N, bf16_t* WT, int row_off, LAS float* scr, int kb, int nb, int lane) {
    const int k0 = 64 * kb, n0 = 32 * nb;
    float tv[32];
#pragma unroll
    for (int i = 0; i < 32; ++i) { const int kk = 2 * i + (lane >> 5); tv[i] = __builtin_nontemporal_load(W + (size_t)(k0 + kk) * N + n0 + (lane & 31)); }
#pragma unroll
    for (int i = 0; i < 32; ++i) { const int kk = 2 * i + (lane >> 5); scr[kk * 33 + (lane & 31)] = tv[i]; }
    asm volatile("s_waitcnt lgkmcnt(0)" ::: "memory");
    const int c = lane & 7;
#pragma unroll
    for (int j = 0; j < 4; ++j) { const int n = (lane >> 3) + 8 * j; const LAS float* s = scr + (8 * c) * 33 + n;
        u32x4 o; o.x = cvt_pk_bf16(s[0 * 33], s[1 * 33]); o.y = cvt_pk_bf16(s[2 * 33], s[3 * 33]); o.z = cvt_pk_bf16(s[4 * 33], s[5 * 33]); o.w = cvt_pk_bf16(s[6 * 33], s[7 * 33]);
        *(u32x4*)(WT + (size_t)(row_off + n0 + n) * K + k0 + 8 * c) = o; }
    asm volatile("s_waitcnt lgkmcnt(0)" ::: "memory");
}

__device__ __forceinline__ void ada_items(const Args& a, LAS unsigned char* lds, int l, int bidx, int nb) {
    const int tid = opaque_tid(), lane = tid & 63, wave = __builtin_amdgcn_readfirstlane(tid >> 6);
    unsigned char* ws = opaque_ptr(a.ws);
    LAS float* sc = (LAS float*)(lds + 69632);
    LAS float* part = (LAS float*)(lds + 69632 + 40960);
    if (bidx < 96) {
        for (int i = tid; i < 5 * 2048; i += 512) { const int r = i >> 11, k = i & 2047; const float v = r < 4 ? inp(I_C)[r * 2048 + k] : inp(I_CCTX)[k]; sc[i] = silu_f(v); }
        __syncthreads();
    }
    for (int it = bidx; it < 96; it += nb) {
        const int cgp = it, col = cgp * 64 + lane;
        const float* W = inp(I_WADA) + (size_t)l * 2048 * 6144 + col;
        float acc[5] = {0.f, 0.f, 0.f, 0.f, 0.f};
#pragma unroll 32
        for (int kk = 0; kk < 256; ++kk) { const int k = wave * 256 + kk; const float wv = __builtin_nontemporal_load(W + (size_t)k * 6144);
#pragma unroll
            for (int r = 0; r < 5; ++r) acc[r] += sc[r * 2048 + k] * wv; }
#pragma unroll
        for (int r = 0; r < 5; ++r) part[(wave * 5 + r) * 64 + lane] = acc[r];
        __syncthreads();
        if (tid < 320) { const int r = tid >> 6, ln = tid & 63; float s2 = inp(I_BADA)[l * 6144 + cgp * 64 + ln];
#pragma unroll
            for (int w = 0; w < 8; ++w) s2 += part[(w * 5 + r) * 64 + ln];
            ((float*)(ws + OFF_MOD))[(l * 5 + r) * 6144 + cgp * 64 + ln] = s2; }
        __syncthreads();
    }
}

__device__ __forceinline__ void convert_layer_weights(const Args& a, LAS unsigned char* lds, int l, int widx, int nw) {
    const int lane = opaque_tid() & 63, wave = __builtin_amdgcn_readfirstlane((int)threadIdx.x >> 6);
    unsigned char* ws = opaque_ptr(a.ws);
    LAS float* scr = (LAS float*)(lds + wave * 8704);
    constexpr int I_IN = 32 * 481, I_B = 16 * 64, I_O = 32 * 64, I_P = 4 * 32, PER_L = I_IN + 3 * I_B + I_O + I_P;
    for (int it = widx; it < PER_L; it += nw) {
        int r = it;
        if (r < I_IN) { const int kb = r / 481, nb = r % 481;
            transpose_item(inp(I_WIN) + (size_t)l * DM * DIN, DM, DIN, (bf16_t*)(ws + OFF_WIN + (size_t)l * SZ_WIN), nb >= 289 ? 224 : 0, scr, kb, nb, lane); continue; }
        r -= I_IN;
        if (r < 3 * I_B) { const int br = r / I_B, rr = r % I_B; const float* W = (br == 0 ? inp(I_WBP) : br == 1 ? inp(I_WBD) : inp(I_WBG)) + (size_t)l * 1024 * DM;
            transpose_item(W, 1024, DM, (bf16_t*)(ws + OFF_WB + (size_t)l * SZ_WB + (size_t)br * DM * 1024 * 2), 0, scr, rr / 64, rr % 64, lane); continue; }
        r -= 3 * I_B;
        if (r < I_O) { transpose_item(inp(I_WOUT) + (size_t)l * DM * DM, DM, DM, (bf16_t*)(ws + OFF_WOUT + (size_t)l * SZ_WOUT), 0, scr, r / 64, r % 64, lane); continue; }
        r -= I_O;
        { const int g = r / 32, rr = r % 32;
          transpose_item(inp(I_POOLW) + (size_t)(l * 4 + g) * 65536, 256, 256, (bf16_t*)(ws + OFF_POOLT + (size_t)l * SZ_POOLT + (size_t)g * 65536 * 2), 0, scr, rr / 8, rr % 8, lane); }
    }
}

__device__ __forceinline__ void phase_p0(const Args& a, LAS unsigned char* lds) {
    const int tid = opaque_tid(), lane = tid & 63, wave = __builtin_amdgcn_readfirstlane(tid >> 6), G = opaque_s(gridDim.x);
    unsigned char* ws = opaque_ptr(a.ws);
    ada_items(a, lds, 0, BID, G);
    if (BID == G - 1 && wave == 0) {
        for (int l = 0; l < 2; ++l) {
            const float s1 = wave_sum(inp(I_LQ1)[l * 64 + lane] * inp(I_LK1)[l * 64 + lane]);
            const float s2 = wave_sum(inp(I_LQ2)[l * 64 + lane] * inp(I_LK2)[l * 64 + lane]);
            const float mq = wave_max(fabsf(inp(I_QNORM)[l * 64 + lane])), mk = wave_max(fabsf(inp(I_KNORM)[l * 64 + lane]));
            const float lam_init = 0.8f - 0.6f * expf(-0.3f * (float)l);
            if (lane == 0) { float* sp = (float*)(ws + OFF_SCAL) + l * 4; sp[0] = expf(s1) - expf(s2) + lam_init; sp[1] = 8.f * LOG2E * mq * mk; sp[2] = lam_init; sp[3] = 0.f; }
        }
    }
    {
        const int nper = 224 * 2048 * 2 / 16;
        for (int i = BID * 512 + tid; i < 2 * nper; i += G * 512) { const int l = i / nper, j = i % nper;
            *(u32x4*)(ws + OFF_WIN + (size_t)l * SZ_WIN + (size_t)9248 * DM * 2 + (size_t)j * 16) = (u32x4){0u, 0u, 0u, 0u}; }
    }
    convert_layer_weights(a, lds, 0, BID * 8 + wave, G * 8);
}

__device__ __forceinline__ void phase_norm(const Args& a, int l) {
    const int tid = opaque_tid(), lane = tid & 63, wave = tid >> 6, G = opaque_s(gridDim.x);
    const int gw = BID * 8 + wave, NGW = G * 8;
    const float* mod = (const float*)(opaque_ptr(a.ws) + OFF_MOD) + (size_t)l * 5 * 6144;
    const float* x1 = (const float*)(opaque_ptr(a.ws) + OFF_X1);
    bf16_t* h = (bf16_t*)(opaque_ptr(a.ws) + OFF_H);
    const float* ng = inp(I_NORMG) + l * DM;
    for (int row = gw; row < MT; row += NGW) {
        const float* src = (l == 0) ? (row < ML ? inp(I_X) + (size_t)row * DM : inp(I_CTX) + (size_t)(row - ML) * DM) : x1 + (size_t)row * DM;
        const int mr = row < ML ? row / SEQ : 4;
        const float* md = mod + mr * 6144;
        f32x4 v[8]; float ss = 0.f;
#pragma unroll
        for (int j = 0; j < 8; ++j) { v[j] = *(const f32x4*)(src + 4 * lane + 256 * j); ss += (v[j][0] * v[j][0] + v[j][1] * v[j][1]) + (v[j][2] * v[j][2] + v[j][3] * v[j][3]); }
        ss = wave_sum(ss);
        const float rstd = rsqrtf(ss * (1.f / DM) + EPS);
#pragma unroll
        for (int j = 0; j < 8; ++j) { const int idx = 4 * lane + 256 * j;
            const f32x4 gg = *(const f32x4*)(ng + idx), sc = *(const f32x4*)(md + 2048 + idx), sh = *(const f32x4*)(md + idx);
            f32x4 o;
#pragma unroll
            for (int e = 0; e < 4; ++e) o[e] = v[j][e] * rstd * gg[e] * (1.f + sc[e]) + sh[e];
            u32x2 w; w.x = cvt_pk_bf16(o[0], o[1]); w.y = cvt_pk_bf16(o[2], o[3]);
            *(u32x2*)(h + (size_t)row * DM + idx) = w; }
    }
}

__device__ __forceinline__ int vt_pos(int key) { const int k = key & 15; return (key & ~15) | (((k >> 2) & 1) << 3) | (k & 3) | (((k >> 3) & 1) << 2); }

__device__ __forceinline__ void phase_prep(const Args& a, int l, LAS unsigned char* lds) {
    const int tid = opaque_tid(), lane = tid & 63, wave = tid >> 6, G = opaque_s(gridDim.x);
    unsigned char* ws = opaque_ptr(a.ws);
    const bf16_t* z = (const bf16_t*)(ws + OFF_Z);
    const bool need_ctx = (l == 0);
    for (int it = BID; it < 1440; it += G) {
        if (it < 576) {
            const int c = it >> 2, cgp = it & 3, rb = 64 * c;
            LAS float* lrs = (LAS float*)lds;
            LAS float* segs = (LAS float*)(lds + 8192);
            for (int i = tid; i < 64 * 32; i += 512) { const int r = i >> 5, cc = i & 31; lrs[i] = bf2f(z[(size_t)(rb + r) * NZ + ZC_LR + cc]); }
            __syncthreads();
            const int seg = tid >> 6, cp = tid & 63, ch = cgp * 128 + 2 * cp;
            typedef float f32x2v __attribute__((ext_vector_type(2)));
            const float* wgf = inp(I_WGF) + (size_t)l * 16 * 512 + ch; const float* wgb = inp(I_WGB) + (size_t)l * 16 * 512 + ch;
            f32x2v wf[16], wb[16];
#pragma unroll
            for (int r = 0; r < 16; ++r) { wf[r] = *(const f32x2v*)(wgf + r * 512); wb[r] = *(const f32x2v*)(wgb + r * 512); }
            const f32x2v bfv = *(const f32x2v*)(inp(I_BGF) + l * 512 + ch), bbv = *(const f32x2v*)(inp(I_BGB) + l * 512 + ch);
            f32x2v gf[8], gb[8]; f32x2v sf = {0.f, 0.f}, sb = {0.f, 0.f};
#pragma unroll
            for (int i = 0; i < 8; ++i) { const int t = seg * 8 + i; f32x2v af = bfv, ab = bbv;
#pragma unroll
                for (int r4 = 0; r4 < 4; ++r4) { const f32x4 lf = *(const LAS f32x4*)(lrs + t * 32 + 4 * r4), lb = *(const LAS f32x4*)(lrs + t * 32 + 16 + 4 * r4);
#pragma unroll
                    for (int e = 0; e < 4; ++e) { af += lf[e] * wf[4 * r4 + e]; ab += lb[e] * wb[4 * r4 + e]; } }
                gf[i].x = logsig_f(af.x) * (1.f / 16.f); gf[i].y = logsig_f(af.y) * (1.f / 16.f);
                gb[i].x = logsig_f(ab.x) * (1.f / 16.f); gb[i].y = logsig_f(ab.y) * (1.f / 16.f); sf += gf[i]; sb += gb[i]; }
            *(LAS f32x2v*)(segs + seg * 128 + 2 * cp) = sf; *(LAS f32x2v*)(segs + 1024 + seg * 128 + 2 * cp) = sb;
            __syncthreads();
            f32x2v pf = {0.f, 0.f}, pb = {0.f, 0.f}, totf = {0.f, 0.f}, totb = {0.f, 0.f};
#pragma unroll
            for (int s2 = 0; s2 < 8; ++s2) { const f32x2v vf = *(const LAS f32x2v*)(segs + s2 * 128 + 2 * cp), vb = *(const LAS f32x2v*)(segs + 1024 + s2 * 128 + 2 * cp);
                totf += vf; totb += vb; if (s2 < seg) { pf += vf; pb += vb; } }
            unsigned* gq0 = (unsigned*)(ws + OFF_GQ), *gq1 = (unsigned*)(ws + OFF_GQ + SZ_G);
            unsigned* gk0 = (unsigned*)(ws + OFF_GK), *gk1 = (unsigned*)(ws + OFF_GK + SZ_G);
            bf16_t* gh0 = (bf16_t*)(ws + OFF_GH), *gh1 = (bf16_t*)(ws + OFF_GH + SZ_G);
            f32x2v h0[8], h1[8];
#pragma unroll
            for (int i = 0; i < 8; ++i) { const int t = seg * 8 + i;
                pf += gf[i]; const f32x2v bs = totb - pb; pb += gb[i];
                const size_t row = rb + t;
                const unsigned qw = *(const unsigned*)(z + row * NZ + ZC_GQ + ch), kw = *(const unsigned*)(z + row * NZ + ZC_GK + ch);
                const float q0 = bflo(qw) * 0.08838834764831845f, q1 = bfhi(qw) * 0.08838834764831845f, k0 = bflo(kw), k1 = bfhi(kw);
                const size_t o = (row * 512 + ch) >> 1;
                gq0[o] = cvt_pk_bf16(q0 * __expf(pf.x), q1 * __expf(pf.y)); gk0[o] = cvt_pk_bf16(k0 * __expf(-pf.x), k1 * __expf(-pf.y));
                gq1[o] = cvt_pk_bf16(q0 * __expf(bs.x), q1 * __expf(bs.y)); gk1[o] = cvt_pk_bf16(k0 * __expf(-bs.x), k1 * __expf(-bs.y));
                h0[i].x = k0 * __expf(totf.x - pf.x); h0[i].y = k1 * __expf(totf.y - pf.y);
                h1[i].x = k0 * __expf(totb.x - bs.x); h1[i].y = k1 * __expf(totb.y - bs.y); }
            {
#pragma unroll
                for (int cc = 0; cc < 2; ++cc) { u32x4 w0, w1;
                    w0.x = cvt_pk_bf16(h0[0][cc], h0[1][cc]); w0.y = cvt_pk_bf16(h0[2][cc], h0[3][cc]); w0.z = cvt_pk_bf16(h0[4][cc], h0[5][cc]); w0.w = cvt_pk_bf16(h0[6][cc], h0[7][cc]);
                    w1.x = cvt_pk_bf16(h1[0][cc], h1[1][cc]); w1.y = cvt_pk_bf16(h1[2][cc], h1[3][cc]); w1.z = cvt_pk_bf16(h1[4][cc], h1[5][cc]); w1.w = cvt_pk_bf16(h1[6][cc], h1[7][cc]);
                    const size_t oh = ((size_t)c * 512 + ch + cc) * 64 + seg * 8;
                    *(u32x4*)(gh0 + oh) = w0; *(u32x4*)(gh1 + oh) = w1; } }
            if (seg == 0) { float* dec = (float*)(ws + OFF_DEC);
                *(f32x2v*)(dec + (size_t)c * 512 + ch) = (f32x2v){__expf(totf.x), __expf(totf.y)}; *(f32x2v*)(dec + (size_t)(144 + c) * 512 + ch) = (f32x2v){__expf(totb.x), __expf(totb.y)}; }
            __syncthreads();
        } else if (it < 864) {
            const int rb = 32 * (it - 576); if (!need_ctx && rb >= ML) continue;
            const int seq0 = rb < ML ? (rb / SEQ) * SEQ : ML + ((rb - ML) / LC) * LC; const int L = rb < ML ? SEQ : LC;
            const int ts = rb - seq0;
            bf16_t* dp = (bf16_t*)(ws + OFF_DPOOL); bf16_t* pgt = (bf16_t*)(ws + OFF_PGATE);
#pragma unroll
            for (int i = 0; i < 12; ++i) { const int idx = tid + 512 * i, rr = idx >> 7, c8 = (idx & 127) * 8, p = ts - 8 + rr;
                if (p >= 0 && p < L) *(LAS u32x4*)(lds + rr * 2048 + c8 * 2) = *(const u32x4*)(z + (size_t)(seq0 + p) * NZ + ZC_PU + c8); }
            __syncthreads();
            const int ch8 = 8 * (tid & 127), tg = tid >> 7, hw = 1 << (ch8 >> 8);
            const int tl0 = ts + 8 * tg;
            float psc[8];
            { const float* pp = inp(I_POOLS) + l * 1024 + ch8; const f32x4 p0 = *(const f32x4*)pp, p1 = *(const f32x4*)(pp + 4);
#pragma unroll
              for (int e = 0; e < 4; ++e) { psc[e] = p0[e]; psc[4 + e] = p1[e]; } }
            u32x4 pgw[8];
#pragma unroll
            for (int t = 0; t < 8; ++t) pgw[t] = *(const u32x4*)(z + (size_t)(seq0 + tl0 + t) * NZ + ZC_PG + ch8);
            const LAS unsigned char* lc = lds + ch8 * 2 - (ts - 8) * 2048;
            float sm[8] = {0.f, 0.f, 0.f, 0.f, 0.f, 0.f, 0.f, 0.f};
            { const int lo = max(tl0 - hw, 0), hi = min(tl0 + hw, L);
              for (int p = lo; p < hi; ++p) { float u[8]; unpack8(*(const LAS u32x4*)(lc + p * 2048), u);
#pragma unroll
                  for (int e = 0; e < 8; ++e) sm[e] += u[e]; } }
#pragma unroll
            for (int t = 0; t < 8; ++t) { const int tl = tl0 + t; const int lo = max(tl - hw, 0), hi = min(tl + hw, L);
                const float rc = __builtin_amdgcn_rcpf((float)(hi - lo));
                float cur[8], pgv[8], ua[8], ur[8];
                unpack8(*(const LAS u32x4*)(lc + tl * 2048), cur); unpack8(pgw[t], pgv);
                unpack8(*(const LAS u32x4*)(lc + min(tl + hw, L - 1) * 2048), ua); unpack8(*(const LAS u32x4*)(lc + max(tl - hw, 0) * 2048), ur);
                const float ma = (tl + hw < L) ? 1.f : 0.f, mr = (tl - hw >= 0) ? 1.f : 0.f;
                u32x4 wd, wg;
                wd.x = cvt_pk_bf16(sm[0] * rc - cur[0], sm[1] * rc - cur[1]); wd.y = cvt_pk_bf16(sm[2] * rc - cur[2], sm[3] * rc - cur[3]);
                wd.z = cvt_pk_bf16(sm[4] * rc - cur[4], sm[5] * rc - cur[5]); wd.w = cvt_pk_bf16(sm[6] * rc - cur[6], sm[7] * rc - cur[7]);
                wg.x = cvt_pk_bf16(psc[0] * silu_f(pgv[0]), psc[1] * silu_f(pgv[1])); wg.y = cvt_pk_bf16(psc[2] * silu_f(pgv[2]), psc[3] * silu_f(pgv[3]));
                wg.z = cvt_pk_bf16(psc[4] * silu_f(pgv[4]), psc[5] * silu_f(pgv[5])); wg.w = cvt_pk_bf16(psc[6] * silu_f(pgv[6]), psc[7] * silu_f(pgv[7]));
                const size_t o = (size_t)(seq0 + tl) * 1024 + ch8;
                *(u32x4*)(dp + o) = wd; *(u32x4*)(pgt + o) = wg;
#pragma unroll
                for (int e = 0; e < 8; ++e) sm[e] += ma * ua[e] - mr * ur[e]; }
            __syncthreads();
        } else {
            const int vi = it - 864, isg = vi >= 288, vj = isg ? vi - 288 : vi, c = vj >> 1, hv = vj & 1, rb = 64 * c;
            int b, key0; if (rb < ML) { b = rb >> 11; key0 = LC + (rb & 2047); } else { b = (rb - ML) >> 8; key0 = (rb - ML) & 255; }
            bf16_t* vT = (bf16_t*)(ws + OFF_VT); bf16_t* gvT = (bf16_t*)(ws + OFF_GVT);
#pragma unroll
            for (int i = 0; i < 8; ++i) { const int idx = tid + 512 * i, key = idx & 63, c8 = (idx >> 6) * 8;
                const u32x4 w = *(const u32x4*)(z + (size_t)(rb + key) * NZ + (isg ? ZC_GV : ZC_DV) + hv * 512 + c8);
                const unsigned ww[4] = {w.x, w.y, w.z, w.w}; const int pos = isg ? key : vt_pos(key);
#pragma unroll
                for (int e = 0; e < 8; ++e) *(LAS bf16_t*)(lds + (c8 + e) * 144 + pos * 2) = (bf16_t)((e & 1) ? (ww[e >> 1] >> 16) : (ww[e >> 1] & 0xffffu)); }
            __syncthreads();
#pragma unroll
            for (int i = 0; i < 8; ++i) { const int idx = tid + 512 * i, col = idx >> 3, k8 = idx & 7, colg = hv * 512 + col, h = colg >> 7, v = colg & 127;
                bf16_t* dst = isg ? gvT + ((size_t)c * 1024 + colg) * 64 + k8 * 8 : vT + ((size_t)(b * 8 + h) * 128 + v) * LK + key0 + k8 * 8;
                *(u32x4*)dst = *(const LAS u32x4*)(lds + col * 144 + k8 * 16); }
            __syncthreads();
        }
    }
    {
        const int gw = BID * 8 + wave, NGW = G * 8;
        bf16_t* qn = (bf16_t*)(ws + OFF_QN); bf16_t* qnc = (bf16_t*)(ws + OFF_QNC); bf16_t* kn = (bf16_t*)(ws + OFF_KN);
        for (int it = gw; it < MT * 2; it += NGW) {
            const int row = it >> 1, which = it & 1;
            const bool isctx = row >= ML; int b, t; if (!isctx) { b = row >> 11; t = row & 2047; } else { b = (row - ML) >> 8; t = (row - ML) & 255; }
            const bf16_t* zr = z + (size_t)row * NZ;
            {
                if (which == 0 && isctx && !need_ctx) continue;
                float x[16]; const bf16_t* src = zr + (which == 0 ? ZC_DQ : ZC_DK) + 16 * lane;
                unpack8(*(const u32x4*)src, x); unpack8(*(const u32x4*)(src + 8), x + 8);
                float ss = 0.f;
#pragma unroll
                for (int e = 0; e < 16; ++e) ss += x[e] * x[e];
                ss += __shfl_xor(ss, 1); ss += __shfl_xor(ss, 2);
                const float rstd = rsqrtf(ss * (1.f / 64.f) + EPS);
                const int m = lane & 3, sh = lane >> 2, h = sh >> 1, j = sh & 1;
                const float* gain = (which == 0 ? inp(I_QNORM) : inp(I_KNORM)) + l * 64 + 16 * m;
                float y[16];
#pragma unroll
                for (int e = 0; e < 16; ++e) y[e] = x[e] * rstd * gain[e];
                if (!isctx) {
                    const float posf = (float)((m & 1) ? (t & 63) : (t >> 6));
#pragma unroll
                    for (int e = 0; e < 16; ++e) { const float yp = __shfl_xor(y[e], 2);
                        const float ang = posf * exp2f(-(float)e * 0.8304820237218405f);
                        const float cs = __cosf(ang), sn = __sinf(ang);
                        y[e] = (m < 2) ? (y[e] * cs - yp * sn) : (y[e] * cs + yp * sn); }
                }
                bf16_t* dst;
                if (which == 0) {
#pragma unroll
                    for (int e = 0; e < 16; ++e) y[e] *= 0.125f * LOG2E;
                    dst = isctx ? qnc + (((size_t)(b * 8 + h) * 2 + j) * LC + t) * 64 + 16 * m : qn + (((size_t)(b * 8 + h) * 2 + j) * SEQ + t) * 64 + 16 * m;
                } else dst = kn + (((size_t)(b * 8 + h) * 2 + j) * LK + (isctx ? t : LC + t)) * 64 + 16 * m;
                u32x4 w0, w1;
                w0.x = cvt_pk_bf16(y[0], y[1]); w0.y = cvt_pk_bf16(y[2], y[3]); w0.z = cvt_pk_bf16(y[4], y[5]); w0.w = cvt_pk_bf16(y[6], y[7]);
                w1.x = cvt_pk_bf16(y[8], y[9]); w1.y = cvt_pk_bf16(y[10], y[11]); w1.z = cvt_pk_bf16(y[12], y[13]); w1.w = cvt_pk_bf16(y[14], y[15]);
                *(u32x4*)dst = w0; *(u32x4*)(dst + 8) = w1;
            }
        }
    }
}

constexpr int GL_Q = 0, GL_K = 17408, GL_KH = 34816, GL_VT = 53248, GL_ATT = 57856, GL_ST = 67072;
__device__ __forceinline__ void gla_unit(const Args& a, int l, LAS unsigned char* lds, int item) {
    const int tid = opaque_tid(), lane = tid & 63, w = __builtin_amdgcn_readfirstlane(tid >> 6);
    const int vs = item & 7, dir = (item >> 3) & 1, h = (item >> 4) & 3, b = item >> 6;
    const bool need_ctx = (l == 0);
    unsigned char* ws = opaque_ptr(a.ws);
    const bf16_t* z = (const bf16_t*)(ws + OFF_Z);
    const bf16_t* gq = (const bf16_t*)(ws + OFF_GQ + dir * SZ_G) + h * 128;
    const bf16_t* gk = (const bf16_t*)(ws + OFF_GK + dir * SZ_G) + h * 128;
    const bf16_t* gh = (const bf16_t*)(ws + OFF_GH + dir * SZ_G) + (size_t)h * 128 * 64;
    const float* dec = (const float*)(ws + OFF_DEC) + (size_t)dir * 144 * 512 + h * 128;
    bf16_t* od = (bf16_t*)(ws + OFF_OF + (size_t)dir * MT * 1024 * 2) + h * 256 + vs * 32;
    const bf16_t* gvt = (const bf16_t*)(ws + OFF_GVT) + (size_t)(h * 256 + vs * 32) * 64;
    const int fr = lane & 15, fq = lane >> 4;
    f32x4 sacc[2] = {(f32x4){0.f, 0.f, 0.f, 0.f}, (f32x4){0.f, 0.f, 0.f, 0.f}};
    for (int i = tid; i < 32 * 136 / 2; i += 512) ((LAS unsigned*)(lds + GL_ST))[i] = 0u;
    u32x4 rq[2], rk[2], rh[2], rv; float rdec;
    auto rowbase = [&](int s) -> int { if (s < 4) { const int ci = dir == 0 ? s : 3 - s; return ML + b * LC + 64 * ci; } const int ci = dir == 0 ? s - 4 : 35 - s; return b * SEQ + 64 * ci; };
#define GLA_LOAD(s) do { const int _rb = rowbase(s); _Pragma("unroll") for (int _i = 0; _i < 2; ++_i) { const int _idx = tid + 512 * _i, _r = _idx >> 4, _c = (_idx & 15) * 8; const size_t _o = (size_t)(_rb + _r) * 512 + _c; \
        rq[_i] = *(const u32x4*)(gq + _o); rk[_i] = *(const u32x4*)(gk + _o); rh[_i] = *(const u32x4*)(gh + ((size_t)(_rb >> 6) * 512 + (_idx >> 3)) * 64 + (_idx & 7) * 8); } \
        if (tid < 256) rv = *(const u32x4*)(gvt + ((size_t)(_rb >> 6) * 1024 + (tid >> 3)) * 64 + (tid & 7) * 8); \
        rdec = dec[(size_t)(_rb >> 6) * 512 + 16 * w + fr]; } while (0)
    GLA_LOAD(0);
    for (int s = 0; s < 36; ++s) {
        const int rb = rowbase(s);
        const float dk = rdec;
#pragma unroll
        for (int i = 0; i < 2; ++i) { const int idx = tid + 512 * i, r = idx >> 4, c = (idx & 15) * 8;
            *(LAS u32x4*)(lds + GL_Q + r * 272 + c * 2) = rq[i]; *(LAS u32x4*)(lds + GL_K + r * 272 + c * 2) = rk[i];
            *(LAS u32x4*)(lds + GL_KH + (idx >> 3) * 144 + (idx & 7) * 16) = rh[i]; }
        if (tid < 256) *(LAS u32x4*)(lds + GL_VT + (tid >> 3) * 144 + (tid & 7) * 16) = rv;
        __syncthreads();
        if (s + 1 < 36) GLA_LOAD(s + 1);
        {
            const int tt = w >> 1;
#pragma unroll
            for (int si = 0; si < 2; ++si) { const int st = 2 * (w & 1) + si; f32x4 acc = (f32x4){0.f, 0.f, 0.f, 0.f};
#pragma unroll
                for (int kk = 0; kk < 4; ++kk) { const bf16x8 af = *(const LAS bf16x8*)(lds + GL_Q + (16 * tt + fr) * 272 + (32 * kk + 8 * fq) * 2);
                    const bf16x8 bfr = *(const LAS bf16x8*)(lds + GL_K + (16 * st + fr) * 272 + (32 * kk + 8 * fq) * 2);
                    acc = __builtin_amdgcn_mfma_f32_16x16x32_bf16(af, bfr, acc, 0, 0, 0); }
#pragma unroll
                for (int j = 0; j < 4; ++j) { const int t = 16 * tt + 4 * fq + j, sc = 16 * st + fr; const bool keep = dir == 0 ? (sc <= t) : (sc >= t);
                    *(LAS bf16_t*)(lds + GL_ATT + t * 144 + sc * 2) = f2bf(keep ? acc[j] : 0.f); } }
        }
#pragma unroll
        for (int vt = 0; vt < 2; ++vt) { f32x4 acc = sacc[vt] * dk;
#pragma unroll
            for (int kk = 0; kk < 2; ++kk) { const bf16x8 af = *(const LAS bf16x8*)(lds + GL_VT + (16 * vt + fr) * 144 + (32 * kk + 8 * fq) * 2);
                const bf16x8 bfr = *(const LAS bf16x8*)(lds + GL_KH + (16 * w + fr) * 144 + (32 * kk + 8 * fq) * 2);
                acc = __builtin_amdgcn_mfma_f32_16x16x32_bf16(af, bfr, acc, 0, 0, 0); }
            sacc[vt] = acc; }
        __syncthreads();
        {
            const int tt = w >> 1, vt = w & 1; f32x4 acc = (f32x4){0.f, 0.f, 0.f, 0.f};
#pragma unroll
            for (int kk = 0; kk < 4; ++kk) { const bf16x8 af = *(const LAS bf16x8*)(lds + GL_Q + (16 * tt + fr) * 272 + (32 * kk + 8 * fq) * 2);
                const bf16x8 bfr = *(const LAS bf16x8*)(lds + GL_ST + (16 * vt + fr) * 272 + (32 * kk + 8 * fq) * 2);
                acc = __builtin_amdgcn_mfma_f32_16x16x32_bf16(af, bfr, acc, 0, 0, 0); }
#pragma unroll
            for (int kk = 0; kk < 2; ++kk) { const bf16x8 af = *(const LAS bf16x8*)(lds + GL_ATT + (16 * tt + fr) * 144 + (32 * kk + 8 * fq) * 2);
                const bf16x8 bfr = *(const LAS bf16x8*)(lds + GL_VT + (16 * vt + fr) * 144 + (32 * kk + 8 * fq) * 2);
                acc = __builtin_amdgcn_mfma_f32_16x16x32_bf16(af, bfr, acc, 0, 0, 0); }
            if (s >= 4 || need_ctx) {
#pragma unroll
                for (int j = 0; j < 4; ++j) od[(size_t)(rb + 16 * tt + 4 * fq + j) * 1024 + 16 * vt + fr] = f2bf(acc[j]); }
        }
        __syncthreads();
#pragma unroll
        for (int vt = 0; vt < 2; ++vt)
#pragma unroll
            for (int j = 0; j < 4; ++j) *(LAS bf16_t*)(lds + GL_ST + (16 * vt + 4 * fq + j) * 272 + (16 * w + fr) * 2) = f2bf(sacc[vt][j]);
    }
    __syncthreads();
#undef GLA_LOAD
}

constexpr int AT_BUF = 36864, AT_K = 0, AT_V = 18432;
template <bool SHIFT>
__device__ __forceinline__ void attn_unit(LAS unsigned char* lds, const bf16_t* qbase, int Lq, int q0, const bf16_t* kbase, const bf16_t* vtbase, int nkeys,
                                          float c2, float lam, float post_scale, const float* subln, const bf16_t* dg, bf16_t* outp, int row0) {
    const int tid = opaque_tid(), lane = tid & 63, w = __builtin_amdgcn_readfirstlane(tid >> 6), q32 = lane & 31, hi = lane >> 5;
    const int j = w >> 2, qg = w & 3;
    bf16x8 qf[4];
#pragma unroll
    for (int kk = 0; kk < 4; ++kk) qf[kk] = *(const bf16x8*)(qbase + ((size_t)j * Lq + q0 + 32 * qg + q32) * 64 + 16 * kk + 8 * hi);
    f32x16 o[4];
#pragma unroll
    for (int vt = 0; vt < 4; ++vt)
#pragma unroll
        for (int r = 0; r < 16; ++r) o[vt][r] = 0.f;
    float lsum = 0.f;
    const int nt = nkeys >> 6;
    u32x4 skA[2], svA[2];
#define AT_LOAD(sk, sv, i) do { _Pragma("unroll") for (int _c = 0; _c < 2; ++_c) { const int _idx = tid + 512 * _c; \
        sk[_c] = *(const u32x4*)(kbase + ((size_t)(_idx >> 9) * LK + 64 * (i) + ((_idx & 511) >> 3)) * 64 + (_idx & 7) * 8); \
        sv[_c] = *(const u32x4*)(vtbase + (size_t)(_idx >> 3) * LK + 64 * (i) + (_idx & 7) * 8); } } while (0)
#define AT_STORE(sk, sv, p) do { _Pragma("unroll") for (int _c = 0; _c < 2; ++_c) { const int _idx = tid + 512 * _c; \
        *(LAS u32x4*)(lds + (p) * AT_BUF + AT_K + ((_idx >> 9) * 64 + ((_idx & 511) >> 3)) * 144 + (_idx & 7) * 16) = sk[_c]; \
        *(LAS u32x4*)(lds + (p) * AT_BUF + AT_V + (_idx >> 3) * 144 + (_idx & 7) * 16) = sv[_c]; } } while (0)
#define AT_KF(kb, kk) (*(const LAS bf16x8*)(Kb + (32 * (kb) + q32) * 144 + (16 * (kk) + 8 * hi) * 2))
#define AT_VF(ks, vt) (*(const LAS bf16x8*)(Vb + (32 * (vt) + q32) * 144 + (16 * (ks) + 8 * hi) * 2))
#define AT_TILE(p) do { \
        LAS unsigned char* Kb = lds + (p) * AT_BUF + AT_K + j * (64 * 144); LAS unsigned char* Vb = lds + (p) * AT_BUF + AT_V; \
        bf16x8 kf[4], vf[4], vg[4]; \
        _Pragma("unroll") for (int kk = 0; kk < 4; ++kk) kf[kk] = AT_KF(0, kk); \
        _Pragma("unroll") for (int kb = 0; kb < 2; ++kb) { \
            _Pragma("unroll") for (int vt = 0; vt < 4; ++vt) vf[vt] = AT_VF(2 * kb, vt); \
            __builtin_amdgcn_sched_barrier(0); \
            f32x16 s; \
            _Pragma("unroll") for (int r = 0; r < 16; ++r) s[r] = 0.f; \
            _Pragma("unroll") for (int kk = 0; kk < 4; ++kk) s = __builtin_amdgcn_mfma_f32_32x32x16_bf16(kf[kk], qf[kk], s, 0, 0, 0); \
            __builtin_amdgcn_sched_barrier(0); \
            _Pragma("unroll") for (int vt = 0; vt < 4; ++vt) vg[vt] = AT_VF(2 * kb + 1, vt); \
            if (kb == 0) { _Pragma("unroll") for (int kk = 0; kk < 4; ++kk) kf[kk] = AT_KF(1, kk); } \
            __builtin_amdgcn_sched_barrier(0); \
            _Pragma("unroll") for (int r = 0; r < 16; ++r) { s[r] = __builtin_amdgcn_exp2f(SHIFT ? s[r] - c2 : s[r]); lsum += s[r]; } \
            u32x4 pw0, pw1; \
            pw0.x = cvt_pk_bf16(s[0], s[1]); pw0.y = cvt_pk_bf16(s[2], s[3]); pw0.z = cvt_pk_bf16(s[4], s[5]); pw0.w = cvt_pk_bf16(s[6], s[7]); \
            pw1.x = cvt_pk_bf16(s[8], s[9]); pw1.y = cvt_pk_bf16(s[10], s[11]); pw1.z = cvt_pk_bf16(s[12], s[13]); pw1.w = cvt_pk_bf16(s[14], s[15]); \
            const bf16x8 pb0 = __builtin_bit_cast(bf16x8, pw0), pb1 = __builtin_bit_cast(bf16x8, pw1); \
            _Pragma("unroll") for (int vt = 0; vt < 4; ++vt) o[vt] = __builtin_amdgcn_mfma_f32_32x32x16_bf16(vf[vt], pb0, o[vt], 0, 0, 0); \
            _Pragma("unroll") for (int vt = 0; vt < 4; ++vt) o[vt] = __builtin_amdgcn_mfma_f32_32x32x16_bf16(vg[vt], pb1, o[vt], 0, 0, 0); \
            __builtin_amdgcn_sched_barrier(0); \
        } } while (0)
    AT_LOAD(skA, svA, 0); AT_STORE(skA, svA, 0);
    __syncthreads();
    for (int i = 0; i < nt; i += 2) {
        AT_LOAD(skA, svA, i + 1);
        AT_TILE(0);
        AT_STORE(skA, svA, 1);
        __syncthreads();
        if (i + 2 < nt) AT_LOAD(skA, svA, i + 2);
        AT_TILE(1);
        if (i + 2 < nt) AT_STORE(skA, svA, 0);
        __syncthreads();
    }
#undef AT_TILE
#undef AT_KF
#undef AT_VF
#undef AT_LOAD
#undef AT_STORE
    lsum += __shfl_xor(lsum, 32);
    LAS float* xch = (LAS float*)lds + (size_t)qg * 4096 + lane;
    if (j == 1) {
        const float sc = lam / lsum;
#pragma unroll
        for (int vt = 0; vt < 4; ++vt)
#pragma unroll
            for (int r = 0; r < 16; ++r) xch[(vt * 16 + r) * 64] = o[vt][r] * sc;
    }
    __syncthreads();
    if (j == 0) {
        const float i0 = 1.f / lsum;
        float ss = 0.f;
#pragma unroll
        for (int vt = 0; vt < 4; ++vt)
#pragma unroll
            for (int r = 0; r < 16; ++r) { const float v = o[vt][r] * i0 - xch[(vt * 16 + r) * 64]; o[vt][r] = v; ss += v * v; }
        ss += __shfl_xor(ss, 32);
        const float rstd = rsqrtf(ss * (1.f / 128.f) + EPS) * post_scale;
        const size_t row = (size_t)row0 + 32 * qg + q32;
#pragma unroll
        for (int vt = 0; vt < 4; ++vt)
#pragma unroll
            for (int g4 = 0; g4 < 4; ++g4) {
                const int v0 = 32 * vt + 8 * g4 + 4 * hi;
                const u32x2 gz = *(const u32x2*)(dg + row * NZ + v0);
                const f32x4 sl = *(const f32x4*)(subln + v0);
                const float r0 = o[vt][4 * g4 + 0] * rstd * sl[0] * silu_f(bflo(gz.x)), r1 = o[vt][4 * g4 + 1] * rstd * sl[1] * silu_f(bfhi(gz.x));
                const float r2 = o[vt][4 * g4 + 2] * rstd * sl[2] * silu_f(bflo(gz.y)), r3 = o[vt][4 * g4 + 3] * rstd * sl[3] * silu_f(bfhi(gz.y));
                u32x2 wv; wv.x = cvt_pk_bf16(r0, r1); wv.y = cvt_pk_bf16(r2, r3);
                *(u32x2*)(outp + row * 1024 + v0) = wv;
            }
    }
    __syncthreads();
}

__device__ __forceinline__ void phase_mix(const Args& a, int l, LAS unsigned char* lds) {
    const int G = opaque_s(gridDim.x);
    unsigned char* ws = opaque_ptr(a.ws);
    const bool need_ctx = (l == 0);
#ifndef NO_GLA
    for (int it = BID; it < 256; it += G) gla_unit(a, l, lds, ((it & 7) * 4 + (it >> 6)) * 8 + ((it >> 3) & 7));
#if defined(REPEAT_SUB) && REPEAT_SUB == 1
    for (int it = BID; it < 256; it += G) gla_unit(a, l, lds, it);
#endif
#endif
#ifndef NO_ATT
    {
        const float* scal = (const float*)(ws + OFF_SCAL) + l * 4;
        const float lam = scal[0], c2 = scal[1], post = 1.f - scal[2];
        const bf16_t* z = (const bf16_t*)(ws + OFF_Z);
        const int nun = 512 + (need_ctx ? 64 : 0);
        const bool big = c2 > 48.f;
#define ATTN_UNIT(...) do { if (big) attn_unit<true>(__VA_ARGS__); else attn_unit<false>(__VA_ARGS__); } while (0)
#if defined(REPEAT_SUB) && REPEAT_SUB == 2
        for (int rep = 0; rep < 2; ++rep)
#endif
        for (int u = BID; u < nun; u += G) {
            if (u < 512) { const int vc = (u & 7) * 64 + (u >> 3), bh = vc >> 4, qb = vc & 15, b = bh >> 3, h = bh & 7;
                ATTN_UNIT(lds, (const bf16_t*)(ws + OFF_QN) + (size_t)bh * 2 * SEQ * 64, SEQ, 128 * qb, (const bf16_t*)(ws + OFF_KN) + (size_t)bh * 2 * LK * 64,
                          (const bf16_t*)(ws + OFF_VT) + (size_t)bh * 128 * LK, LK, c2, lam, post, inp(I_SUBLN) + l * 128, z + ZC_DG + h * 128, (bf16_t*)(ws + OFF_DIFFO) + h * 128, b * SEQ + 128 * qb);
            } else { const int uu = u - 512, bh = uu >> 1, qb = uu & 1, b = bh >> 3, h = bh & 7;
                ATTN_UNIT(lds, (const bf16_t*)(ws + OFF_QNC) + (size_t)bh * 2 * LC * 64, LC, 128 * qb, (const bf16_t*)(ws + OFF_KN) + (size_t)bh * 2 * LK * 64,
                          (const bf16_t*)(ws + OFF_VT) + (size_t)bh * 128 * LK, LC, c2, lam, post, inp(I_SUBLN) + l * 128, z + ZC_DG + h * 128, (bf16_t*)(ws + OFF_DIFFO) + h * 128, ML + b * LC + 128 * qb);
            }
        }
    }
#endif
#ifndef NO_POOL
    {
        const int Mrows = need_ctx ? MT : ML;
        pg8::Gemm g{(const bf16_t*)(ws + OFF_DPOOL), (const bf16_t*)(ws + OFF_POOLT + (size_t)l * SZ_POOLT), Mrows, 1024, 256, 1024, 256, 256};
        pg8::StaticOrder S; S.init(Mrows, 1024, G, BID);
        pg8::EpiPool E{(bf16_t*)(ws + OFF_POOLO), (const bf16_t*)(ws + OFF_PGATE)};
        pg8::gemm_phase<pg8::EpiPool, pg8::StaticOrder, true, true>(lds, g, S, E);
    }
#endif
}

__device__ __forceinline__ void phase_post(const Args& a, int l) {
    const int tid = opaque_tid(), lane = tid & 63, wave = tid >> 6, G = opaque_s(gridDim.x);
    const int gw = BID * 8 + wave, NGW = G * 8;
    unsigned char* ws = opaque_ptr(a.ws);
    const bf16_t* z = (const bf16_t*)(ws + OFF_Z);
    const bf16_t* of = (const bf16_t*)(ws + OFF_OF); const bf16_t* ob = of + (size_t)MT * 1024;
    bf16_t* go = (bf16_t*)(ws + OFF_GLAO);
    const int Mrows = (l == 0) ? MT : ML;
    const float* gn = inp(I_GLAN) + l * 256 + ((16 * lane) & 255);
    for (int row = gw; row < Mrows; row += NGW) {
        float x[16], y[16], gz[16];
        const size_t o = (size_t)row * 1024 + 16 * lane;
        unpack8(*(const u32x4*)(of + o), x); unpack8(*(const u32x4*)(of + o + 8), x + 8);
        unpack8(*(const u32x4*)(ob + o), y); unpack8(*(const u32x4*)(ob + o + 8), y + 8);
        unpack8(*(const u32x4*)(z + (size_t)row * NZ + ZC_GG + 16 * lane), gz); unpack8(*(const u32x4*)(z + (size_t)row * NZ + ZC_GG + 16 * lane + 8), gz + 8);
        float ss = 0.f;
#pragma unroll
        for (int e = 0; e < 16; ++e) { x[e] += y[e]; ss += x[e] * x[e]; }
        ss += __shfl_xor(ss, 1); ss += __shfl_xor(ss, 2); ss += __shfl_xor(ss, 4); ss += __shfl_xor(ss, 8);
        const float rstd = rsqrtf(ss * (1.f / 256.f) + EPS);
        float r[16];
#pragma unroll
        for (int e = 0; e < 16; ++e) r[e] = x[e] * rstd * gn[e] * silu_f(gz[e]);
        u32x4 w0, w1;
        w0.x = cvt_pk_bf16(r[0], r[1]); w0.y = cvt_pk_bf16(r[2], r[3]); w0.z = cvt_pk_bf16(r[4], r[5]); w0.w = cvt_pk_bf16(r[6], r[7]);
        w1.x = cvt_pk_bf16(r[8], r[9]); w1.y = cvt_pk_bf16(r[10], r[11]); w1.z = cvt_pk_bf16(r[12], r[13]); w1.w = cvt_pk_bf16(r[14], r[15]);
        *(u32x4*)(go + o) = w0; *(u32x4*)(go + o + 8) = w1;
    }
}

#define XB_TMO      128
#define XB_XCNT(j)  (256  + 64 * (j))
#define XB_XSUB(j)  (1280 + 64 * (j))
#define XB_XGEN(j)  (2304 + 64 * (j))
#define XB_TOP      3328
#define XB_TOPGEN   3392
#define XCD_BAR_WORDS 3456
#define XB_SPIN_CAP (1u << 18)

__device__ __forceinline__ unsigned xb_ld(unsigned* p)              { return __hip_atomic_load(p, __ATOMIC_RELAXED, __HIP_MEMORY_SCOPE_AGENT); }
__device__ __forceinline__ unsigned xb_add(unsigned* p, unsigned v) { return __hip_atomic_fetch_add(p, v, __ATOMIC_RELAXED, __HIP_MEMORY_SCOPE_AGENT); }
__device__ __forceinline__ unsigned xb_xcc_id() { return (unsigned)__builtin_amdgcn_s_getreg((3 << 11) | 20) & 0xFu; }
#define XB_SPIN(cond, bar) do { unsigned _sp = 0; while (cond) { __builtin_amdgcn_s_sleep(1); \
    if ((++_sp & 255u) == 0u) { if (xb_ld(&(bar)[XB_TMO])) break; if (_sp > XB_SPIN_CAP) { atomicAdd(&(bar)[XB_TMO], 1u); break; } } } } while (0)

struct XcdBarrier {
    unsigned* bar; unsigned x;
    volatile LAS unsigned* st;
};

__device__ __forceinline__ XcdBarrier xcd_barrier_post(unsigned* bar, volatile LAS unsigned* st) {
    XcdBarrier b; b.bar = bar; b.x = xb_xcc_id(); b.st = st;
    if (threadIdx.x == 0) (void)xb_add(&bar[XB_XCNT(b.x)], 1u);
    return b;
}
__device__ __forceinline__ void xcd_barrier_complete(unsigned* bar, unsigned x, unsigned& nloc, unsigned& nx) {
    const unsigned G = gridDim.x * gridDim.y * gridDim.z;
    unsigned sum, cnt, mine, sp = 0u;
    for (;;) {
        sum = 0u; cnt = 0u; mine = 0u;
#pragma unroll
        for (unsigned j = 0; j < 16; ++j) { const unsigned c = xb_ld(&bar[XB_XCNT(j)]); sum += c; cnt += (c > 0u) ? 1u : 0u; mine = (j == x) ? c : mine; }
        if (sum == G) break;
        __builtin_amdgcn_s_sleep(1);
        if ((++sp & 255u) == 0u) { if (xb_ld(&bar[XB_TMO])) break; if (sp > XB_SPIN_CAP) { atomicAdd(&bar[XB_TMO], 1u); break; } }
    }
    nloc = mine > 0u ? mine : 1u; nx = cnt > 0u ? cnt : 1u;
}

__device__ __forceinline__ void xcd_barrier(const XcdBarrier& b) {
    asm volatile("s_waitcnt vmcnt(0)" ::: "memory");
    __syncthreads();
    if (threadIdx.x == 0) {
        unsigned* bar = b.bar;
        __builtin_amdgcn_s_waitcnt(0);
        unsigned nloc = b.st[0], nx = b.st[1];
        if (nloc == 0u) { xcd_barrier_complete(bar, b.x, nloc, nx); b.st[0] = nloc; b.st[1] = nx; }
        const unsigned old = xb_add(&bar[XB_XSUB(b.x)], 1u);
        const unsigned gen = old / nloc;
        if (old + 1u == (gen + 1u) * nloc) {
            __builtin_amdgcn_fence(__ATOMIC_RELEASE, "agent");
            asm volatile("s_waitcnt vmcnt(0)" ::: "memory");
            const unsigned og = xb_add(&bar[XB_TOP], 1u);
            const unsigned tg = og / nx;
            if (og + 1u == (tg + 1u) * nx) xb_add(&bar[XB_TOPGEN], 1u);
            else XB_SPIN(xb_ld(&bar[XB_TOPGEN]) == tg, bar);
            __builtin_amdgcn_fence(__ATOMIC_ACQUIRE, "agent");
            xb_add(&bar[XB_XGEN(b.x)], 1u);
            asm volatile("s_waitcnt vmcnt(0)" ::: "memory");
        } else {
            XB_SPIN(xb_ld(&bar[XB_XGEN(b.x)]) == gen, bar);
            __builtin_amdgcn_fence(__ATOMIC_ACQUIRE, "agent");
            asm volatile("s_waitcnt vmcnt(0)" ::: "memory");
        }
    }
    __syncthreads();
}

#ifndef REPEAT_K
#define REPEAT_K -1
#endif
#define SEAM() do { XcdBarrier xb; xb.bar = (unsigned*)(opaque_ptr(a.ws) + OFF_BAR); xb.x = xb_xcc_id(); xb.st = (volatile LAS unsigned*)(lds + 131072 + 512); xcd_barrier(xb); } while (0)
#define REP(k) for (int rep_ = 0; rep_ < (REPEAT_K == (k) ? 2 : 1); ++rep_)
template <int l> __device__ __forceinline__ void run_layer(const Args& a, LAS unsigned char* lds) {
    constexpr int Mout = (l == 0) ? MT : ML;
    REP(0) phase_norm(a, l);
    SEAM();
    REP(1) {
        unsigned char* ws = opaque_ptr(a.ws); const int G = opaque_s(gridDim.x);
        pg8::Gemm g{(const bf16_t*)(ws + OFF_H), (const bf16_t*)(ws + OFF_WIN + (size_t)l * SZ_WIN), MT, NZ, DM, DM, DM, 0};
        pg8::EpiBf16 E{(bf16_t*)(ws + OFF_Z), NZ};
        if (l == 0) { pg8::StaticOrder S; S.init(MT, NZ, G, BID); pg8::gemm_phase<pg8::EpiBf16, pg8::StaticOrder, true, true>(lds, g, S, E);
 }
        else { pg8::CtxSkipOrder S; S.init(G, BID); pg8::gemm_phase<pg8::EpiBf16, pg8::CtxSkipOrder, true, true>(lds, g, S, E); }
    }
    SEAM();
    REP(2) phase_prep(a, l, lds);
    SEAM();
    REP(3) phase_mix(a, l, lds);
    SEAM();
    REP(4) phase_post(a, l);
    SEAM();
    REP(5) {
        unsigned char* ws = opaque_ptr(a.ws); const int G = opaque_s(gridDim.x);
        pg8::SegOrder3 S; S.base.init(Mout, DM, G, BID);
        const bf16_t* wb = (const bf16_t*)(ws + OFF_WB + (size_t)l * SZ_WB);
        pg8::Gemm g{(const bf16_t*)(ws + OFF_POOLO), wb, Mout, DM, 1024, 1024, 1024, 0,
                    (const bf16_t*)(ws + OFF_DIFFO), (const bf16_t*)(ws + OFF_GLAO), wb + (size_t)DM * 1024, wb + (size_t)2 * DM * 1024};
        pg8::EpiMerge3 E{(bf16_t*)(ws + OFF_H), (const bf16_t*)(ws + OFF_Z) + ZC_MG};
        pg8::gemm_phase<pg8::EpiMerge3, pg8::SegOrder3, true, true, 3>(lds, g, S, E);
        if (l == 0 && rep_ == 0) {
            const int rem = ((Mout / 256) * (DM / 256)) % G, bid = BID;
            if (rem == 0) { ada_items(a, lds, 1, bid, G); convert_layer_weights(a, lds, 1, bid * 8 + (int)(threadIdx.x >> 6), G * 8); }
            else if (bid >= rem) { ada_items(a, lds, 1, G - 1 - bid, G - rem); convert_layer_weights(a, lds, 1, (bid - rem) * 8 + (int)(threadIdx.x >> 6), (G - rem) * 8); }
        }
    }
    SEAM();
    REP(6) {
        unsigned char* ws = opaque_ptr(a.ws); const int G = opaque_s(gridDim.x);
        pg8::Gemm g{(const bf16_t*)(ws + OFF_H), (const bf16_t*)(ws + OFF_WOUT + (size_t)l * SZ_WOUT), Mout, DM, DM, DM, DM, 0};
        pg8::StaticOrder S; S.init(Mout, DM, G, BID);
        pg8::EpiOut E{l == 0 ? inp(I_X) : (const float*)(ws + OFF_X1), l == 0 ? inp(I_CTX) : (const float*)(ws + OFF_X1) + (size_t)ML * DM,
                      l == 0 ? (float*)(ws + OFF_X1) : arg_out(), (const float*)(ws + OFF_MOD) + (size_t)l * 5 * 6144};
        pg8::gemm_phase<pg8::EpiOut, pg8::StaticOrder, true, true>(lds, g, S, E);
    }
}

__global__ void __launch_bounds__(512, 2) hybrid_fwd(Args a) {
    extern __shared__ __attribute__((aligned(16))) unsigned char smem[];
    LAS unsigned char* lds = (LAS unsigned char*)smem;
    cg::grid_group grid = cg::this_grid();
    volatile LAS unsigned* bst = (volatile LAS unsigned*)(lds + 131072 + 512);
    if (threadIdx.x < 2) bst[threadIdx.x] = 0u;
    __syncthreads();
    (void)xcd_barrier_post((unsigned*)(a.ws + OFF_BAR), bst);
    REP(7) phase_p0(a, lds);
    grid.sync();
    run_layer<0>(a, lds);
    SEAM();
    run_layer<1>(a, lds);
}

extern "C" void kernel_launch(void* const* d_in, const int* in_sizes, int n_in, void* d_out, int out_size, void* d_ws, size_t ws_size, hipStream_t stream) {
    static int grid = 0;
    if (grid == 0) {
        if (n_in != 26 || out_size != ML * DM || ws_size < WS_END) { fprintf(stderr, "kernel_launch: expected 26 inputs, out %d, ws >= %zu; got n_in %d out %d ws %zu\n", ML * DM, (size_t)WS_END, n_in, out_size, ws_size); grid = -1; return; }
        int dev = 0, cus = 0, per_cu = 0;
        if (hipGetDevice(&dev) != hipSuccess || hipDeviceGetAttribute(&cus, hipDeviceAttributeMultiprocessorCount, dev) != hipSuccess) { grid = -1; return; }
        if (hipFuncSetAttribute((const void*)hybrid_fwd, hipFuncAttributeMaxDynamicSharedMemorySize, LDS_BYTES) != hipSuccess) { fprintf(stderr, "kernel_launch: hipFuncSetAttribute failed\n"); grid = -1; return; }
        if (hipOccupancyMaxActiveBlocksPerMultiprocessor(&per_cu, (const void*)hybrid_fwd, 512, LDS_BYTES) != hipSuccess || per_cu < 1) { fprintf(stderr, "kernel_launch: occupancy query says %d blocks per CU\n", per_cu); (void)hipGetLastError(); grid = -1; return; }
        grid = cus;
    }
    if (grid < 0) return;
    if (hipMemsetAsync((char*)d_ws + OFF_BAR, 0, BAR_BYTES, stream) != hipSuccess) { fprintf(stderr, "kernel_launch: memset of the barrier words failed\n"); return; }
    Args a{};
    for (int i = 0; i < 26; ++i) a.in[i] = (const float*)d_in[i];
    a.out = (float*)d_out; a.ws = (unsigned char*)d_ws;
    a.ph_lo = 0; a.ph_hi = NPH;
    void* args[] = {&a};
    const hipError_t e = hipLaunchCooperativeKernel((const void*)hybrid_fwd, dim3(grid), dim3(512), args, LDS_BYTES, stream);
    if (e != hipSuccess) fprintf(stderr, "kernel_launch: cooperative launch failed: %s (grid %d)\n", hipGetErrorString(e), grid);
}
```

```cpp
#include <hip/hip_runtime.h>
#include <hip/hip_cooperative_groups.h>
#include <cstdio>
#include <cstdint>
namespace cg = cooperative_groups;

#ifndef MK_N_LAUNCHES
#define MK_N_LAUNCHES 1
#endif

#define LAS __attribute__((address_space(3)))
typedef unsigned short bf16_t;
typedef short bf16x8 __attribute__((ext_vector_type(8)));
typedef float f32x4 __attribute__((ext_vector_type(4)));
typedef float f32x16 __attribute__((ext_vector_type(16)));
typedef unsigned u32x4 __attribute__((ext_vector_type(4)));
typedef unsigned u32x2 __attribute__((ext_vector_type(2)));

constexpr int DM = 2048, NB = 4, SEQ = 2048, LC = 256, ML = NB * SEQ, MC = NB * LC, MT = ML + MC;
constexpr int DIN = 15392, NZ = 15616;
constexpr int ZC_PU = 0, ZC_PG = 1024, ZC_DQ = 2048, ZC_DK = 3072, ZC_DV = 4096, ZC_DG = 5120, ZC_GQ = 6144, ZC_GK = 6656, ZC_GV = 7168, ZC_GG = 8192, ZC_LR = 9216, ZC_MG = 9472;
constexpr int LK = LC + SEQ;
constexpr float EPS = 1e-6f, LOG2E = 1.4426950408889634f;
constexpr int NPH = 15;

constexpr size_t SZ_WIN = (size_t)NZ * DM * 2, SZ_WB = (size_t)3 * DM * 1024 * 2, SZ_WOUT = (size_t)DM * DM * 2, SZ_POOLT = (size_t)4 * 256 * 256 * 2;
constexpr size_t OFF_WIN = 0;
constexpr size_t OFF_WB = OFF_WIN + 2 * SZ_WIN;
constexpr size_t OFF_WOUT = OFF_WB + 2 * SZ_WB;
constexpr size_t OFF_POOLT = OFF_WOUT + 2 * SZ_WOUT;
constexpr size_t OFF_MOD = OFF_POOLT + 2 * SZ_POOLT;
constexpr size_t OFF_SCAL = OFF_MOD + (size_t)2 * 5 * 6144 * 4;
constexpr size_t OFF_H = OFF_SCAL + 256;
constexpr size_t OFF_Z = OFF_H + (size_t)MT * DM * 2;
constexpr size_t OFF_QN = OFF_Z + (size_t)MT * NZ * 2;
constexpr size_t OFF_QNC = OFF_QN + (size_t)ML * 1024 * 2;
constexpr size_t OFF_KN = OFF_QNC + (size_t)MC * 1024 * 2;
constexpr size_t OFF_VT = OFF_KN + (size_t)MT * 1024 * 2;
constexpr size_t SZ_G = (size_t)MT * 512 * 2;
constexpr size_t OFF_GQ = OFF_VT + (size_t)MT * 1024 * 2;
constexpr size_t OFF_GK = OFF_GQ + 2 * SZ_G;
constexpr size_t OFF_GH = OFF_GK + 2 * SZ_G;
constexpr size_t OFF_DEC = OFF_GH + 2 * SZ_G;
constexpr size_t OFF_OF = OFF_DEC + (size_t)2 * 144 * 512 * 4;
constexpr size_t OFF_DPOOL = OFF_OF + 2 * (size_t)MT * 1024 * 2;
constexpr size_t OFF_POOLO = OFF_DPOOL + (size_t)MT * 1024 * 2;
constexpr size_t OFF_DIFFO = OFF_POOLO + (size_t)MT * 1024 * 2;
constexpr size_t OFF_GLAO = OFF_DIFFO + (size_t)MT * 1024 * 2;
constexpr size_t OFF_YACC = OFF_GLAO + (size_t)MT * 1024 * 2;
constexpr size_t OFF_X1 = OFF_YACC + (size_t)MT * DM * 4;
constexpr size_t OFF_PGATE = OFF_X1 + (size_t)MT * DM * 4;
constexpr size_t OFF_BAR = OFF_PGATE + (size_t)MT * 1024 * 2;
constexpr size_t BAR_BYTES = 16384;
constexpr size_t OFF_GVT = OFF_BAR + BAR_BYTES;
constexpr size_t WS_END = OFF_GVT + (size_t)MT * 1024 * 2;

constexpr int LDS_BYTES = 135168;

#define BID opaque_s((int)blockIdx.x)
#define GAS __attribute__((address_space(1)))
__device__ __forceinline__ unsigned char* opaque_ptr(unsigned char* p) { GAS unsigned char* q = (GAS unsigned char*)p; asm volatile("" : "+s"(q)); return (unsigned char*)q; }
__device__ __forceinline__ int opaque_s(int v) { asm volatile("" : "+s"(v)); return v; }
__device__ __forceinline__ int opaque_tid() { int t = threadIdx.x; asm volatile("" : "+v"(t)); return t; }
typedef float f32x2_t __attribute__((ext_vector_type(2))); typedef __bf16 bf16x2_t __attribute__((ext_vector_type(2)));
__device__ __forceinline__ unsigned cvt_pk_bf16(float lo, float hi) { f32x2_t v = {lo, hi}; bf16x2_t b = __builtin_convertvector(v, bf16x2_t); return __builtin_bit_cast(unsigned, b); }
__device__ __forceinline__ bf16_t f2bf(float f) { return (bf16_t)(cvt_pk_bf16(f, 0.f) & 0xffffu); }
__device__ __forceinline__ float bf2f(bf16_t v) { return __builtin_bit_cast(float, (unsigned)v << 16); }
__device__ __forceinline__ float bflo(unsigned u) { return __builtin_bit_cast(float, u << 16); }
__device__ __forceinline__ float bfhi(unsigned u) { return __builtin_bit_cast(float, u & 0xffff0000u); }
__device__ __forceinline__ float silu_f(float x) { return x * __builtin_amdgcn_rcpf(1.f + __expf(-x)); }
__device__ __forceinline__ float sigmoid_f(float x) { return __builtin_amdgcn_rcpf(1.f + __expf(-x)); }
__device__ __forceinline__ float logsig_f(float a) { return fminf(a, 0.f) - __logf(1.f + __expf(-fabsf(a))); }
__device__ __forceinline__ float wave_sum(float v) {
#pragma unroll
    for (int o = 1; o < 64; o <<= 1) v += __shfl_xor(v, o);
    return v;
}
__device__ __forceinline__ float wave_max(float v) {
#pragma unroll
    for (int o = 1; o < 64; o <<= 1) v = fmaxf(v, __shfl_xor(v, o));
    return v;
}
__device__ __forceinline__ void unpack8(u32x4 w, float* f) { f[0] = bflo(w.x); f[1] = bfhi(w.x); f[2] = bflo(w.y); f[3] = bfhi(w.y); f[4] = bflo(w.z); f[5] = bfhi(w.z); f[6] = bflo(w.w); f[7] = bfhi(w.w); }

namespace pg8 {
constexpr int BM = 256, BK = 64, HALF = 128, HTB = HALF * BK * 2, STAGE_BYTES = 8 * HTB, NXCD = 8, WGM = 8;
__host__ __device__ __forceinline__ int lds_byte(int r, int c) { const int st = (r >> 4) * 2 + (c >> 5), rr = r & 15, cc = c & 31, ob = rr * 64 + cc * 2; return st * 1024 + (ob ^ (((ob >> 9) & 1) << 5)); }
__host__ __device__ __forceinline__ void stage_rc(int b, int& R, int& C) { const int st = b / 1024, sb = b % 1024, swz = sb ^ (((sb >> 9) & 1) << 5); R = (st >> 1) * 16 + swz / 64; C = (st & 1) * 32 + (swz % 64) / 2; }
__host__ __device__ __forceinline__ int perm32(int rho) { const int n = rho >> 4, i = rho & 15; return 8 * (i >> 2) + 4 * n + (i & 3); }

struct Unit { int pm, pn, seg; };
struct Gemm { const bf16_t* A; const bf16_t* Bt; int M, N, K; int lda, ldb; int a_pn_off; const bf16_t* A1; const bf16_t* A2; const bf16_t* B1; const bf16_t* B2; };

struct StaticOrder {
    int nM, nN, nwg, G, c;
    __host__ __device__ void init(int M, int N, int G_, int c_) { nM = M / BM; nN = N / BM; nwg = nM * nN; G = G_; c = c_; }
    __host__ __device__ bool next(int i, Unit& u) const {
        const long L = (long)i * G + c; if (L >= nwg) return false;
        int wgid = (int)L; { const int q = nwg / NXCD, r = nwg % NXCD, xcd = wgid % NXCD, off = wgid / NXCD; wgid = (xcd < r ? xcd * (q + 1) : r * (q + 1) + (xcd - r) * q) + off; }
        const int nig = WGM * nN, gid = wgid / nig, fm = gid * WGM, gsz = (nM - fm) < WGM ? (nM - fm) : WGM;
        u.pm = fm + ((wgid % nig) % gsz); u.pn = (wgid % nig) / gsz; u.seg = 0; return true;
    }
    __device__ __forceinline__ void a_ready(const Unit&) const {}
    __device__ __forceinline__ void done(const Unit&) const {}
};

struct CtxSkipOrder {
    StaticOrder base; int nbase;
    __host__ __device__ void init(int G_, int c_) { base.init(ML, NZ, G_, c_); nbase = base.nwg; }
    __host__ __device__ bool next(int i, Unit& u) const {
        const long L = (long)i * base.G + base.c;
        if (L < nbase) return base.next(i, u);
        const int e = (int)(L - nbase); if (e >= 4 * 15) return false;
        const int j = e % 15; u.pm = 32 + e / 15; u.pn = j < 8 ? 12 + j : (j < 14 ? 18 + j : 36); u.seg = 0; return true;
    }
    __device__ __forceinline__ void a_ready(const Unit&) const {}
    __device__ __forceinline__ void done(const Unit&) const {}
};
struct SegOrder3 {
    StaticOrder base;
    __host__ __device__ bool next(int i, Unit& u) const { const int q = i / 3; if (!base.next(q, u)) return false; u.seg = i - 3 * q; return true; }
    __device__ __forceinline__ void a_ready(const Unit&) const {}
    __device__ __forceinline__ void done(const Unit&) const {}
};
struct EpiBf16 {
    static constexpr bool PERM = true, AFTER_DRAIN = false;
    bf16_t* O; int ldc;
    __device__ __forceinline__ void operator()(const f32x4 (&acc)[2][2][4][2], const Unit& u, int wr, int wc, int fr, int fq) const {
        const int row0 = u.pm * BM + wr * 64 + fr, col0 = u.pn * BM + wc * 32 + 8 * fq;
#pragma unroll
        for (int ai = 0; ai < 2; ++ai)
#pragma unroll
            for (int m = 0; m < 4; ++m) { bf16_t* rowp = O + (size_t)(row0 + ai * HALF + m * 16) * ldc + col0;
#pragma unroll
                for (int bj = 0; bj < 2; ++bj) { const f32x4 v0 = acc[ai][bj][m][0], v1 = acc[ai][bj][m][1];
                    u32x4 w; w.x = cvt_pk_bf16(v0[0], v0[1]); w.y = cvt_pk_bf16(v0[2], v0[3]); w.z = cvt_pk_bf16(v1[0], v1[1]); w.w = cvt_pk_bf16(v1[2], v1[3]);
                    *(u32x4*)(rowp + bj * HALF) = w; } }
    }
};

template <class Epi, class Sched, bool ALIGN_EPI = false, bool SP2 = false, int NSEG = 1>
__device__ __forceinline__ void gemm_phase(LAS unsigned char* lds, const Gemm g, const Sched& S, const Epi& E) {
    const int tid = opaque_tid(), wid = __builtin_amdgcn_readfirstlane(tid >> 6), lane = tid & 63, wr = wid >> 2, wc = wid & 3, fr = lane & 15, fq = lane >> 4;
    const int K = opaque_s(g.K), nt = K / BK;
    unsigned voffA[2], voffB[2];
#pragma unroll
    for (int i = 0; i < 2; ++i) { int R, C; stage_rc(tid * 16 + i * 8192, R, C); const int Rb = Epi::PERM ? ((R & ~31) + perm32(R & 31)) : R;
        voffA[i] = (unsigned)(R * g.lda + C) * 2u; voffB[i] = (unsigned)(Rb * g.ldb + C) * 2u; }
    const size_t kstep = (size_t)(BK * 2);
    const size_t hstepA = (size_t)HALF * g.lda * 2, hstepB = (size_t)HALF * g.ldb * 2;
    const size_t tstepA = 2 * hstepA, tstepB = 2 * hstepB;
    const size_t pnA = (size_t)g.a_pn_off * 2;
    const unsigned ldsw = (unsigned)wid * 1024u;
    const int aoff = lds_byte(wr * 64 + fr, fq * 8), boff = lds_byte(wc * 32 + fr, fq * 8);
#define PG8_SA(b, h) (((b) * 2 + (h)) * HTB)
#define PG8_SB(b, h) ((4 + (b) * 2 + (h)) * HTB)
#define PG8_STAGE(bufoff, gbase, voff) do { _Pragma("unroll") for (int _i = 0; _i < 2; ++_i) \
        __builtin_amdgcn_global_load_lds((const unsigned*)((const char*)(gbase) + (voff)[_i]), (LAS unsigned*)(lds + (bufoff) + ldsw + _i * 8192), 16, 0, 0); } while (0)
#define PG8_LDA(dst, b, h) do { _Pragma("unroll") for (int m = 0; m < 4; ++m) _Pragma("unroll") for (int k = 0; k < 2; ++k) dst[m][k] = *(const LAS bf16x8*)(lds + PG8_SA(b, h) + aoff + m * 2048 + k * 1024); } while (0)
#define PG8_LDB(dst, b, h) do { _Pragma("unroll") for (int n = 0; n < 2; ++n) _Pragma("unroll") for (int k = 0; k < 2; ++k) dst[n][k] = *(const LAS bf16x8*)(lds + PG8_SB(b, h) + boff + n * 2048 + k * 1024); } while (0)
#define PG8_MMA(ai, bj, At, Bt) do { __builtin_amdgcn_s_setprio(1); _Pragma("unroll") for (int m = 0; m < 4; ++m) _Pragma("unroll") for (int n = 0; n < 2; ++n) _Pragma("unroll") for (int k = 0; k < 2; ++k) \
        acc[ai][bj][m][n] = __builtin_amdgcn_mfma_f32_16x16x32_bf16(Bt[n][k], At[m][k], acc[ai][bj][m][n], 0, 0, 0); __builtin_amdgcn_s_setprio(0); } while (0)
#define PG8_WAIT_V(n) asm volatile("s_waitcnt vmcnt(" #n ")" ::: "memory")
#define PG8_WAIT_L(n) asm volatile("s_waitcnt lgkmcnt(" #n ")" ::: "memory")
#define PG8_BAR __builtin_amdgcn_s_barrier()
#define PG8_SCHED __builtin_amdgcn_sched_barrier(0)
    Unit cur, nxt; int ui = 0;
    if (!S.next(0, cur)) return;
    f32x4 acc[2][2][4][2];
#pragma unroll
    for (int a = 0; a < 2; ++a)
#pragma unroll
        for (int b = 0; b < 2; ++b)
#pragma unroll
            for (int m = 0; m < 4; ++m)
#pragma unroll
                for (int n = 0; n < 2; ++n) acc[a][b][m][n] = (f32x4){0.f, 0.f, 0.f, 0.f};
    bf16x8 At[4][2], B0[2][2], B1[2][2];
#define PG8_ASEG(u) ((const char*)(NSEG == 1 || (u).seg == 0 ? g.A : ((u).seg == 1 ? g.A1 : g.A2)))
#define PG8_BSEG(u) ((const char*)(NSEG == 1 || (u).seg == 0 ? g.Bt : ((u).seg == 1 ? g.B1 : g.B2)))
    const char* cA = PG8_ASEG(cur) + (size_t)cur.pm * tstepA + (size_t)cur.pn * pnA; const char* cB = PG8_BSEG(cur) + (size_t)cur.pn * tstepB;
    S.a_ready(cur);
    if constexpr (SP2) {
        PG8_STAGE(PG8_SB(0, 0), cB, voffB); PG8_STAGE(PG8_SB(0, 1), cB + hstepB, voffB); PG8_STAGE(PG8_SA(0, 0), cA, voffA); PG8_STAGE(PG8_SA(0, 1), cA + hstepA, voffA);
        if (wr == 1) PG8_BAR;
        PG8_WAIT_V(2); PG8_BAR;
        PG8_STAGE(PG8_SB(1, 0), cB + kstep, voffB); PG8_STAGE(PG8_SA(1, 0), cA + kstep, voffA); PG8_STAGE(PG8_SB(1, 1), cB + hstepB + kstep, voffB);
        PG8_WAIT_V(6); PG8_BAR;
    } else {
        PG8_STAGE(PG8_SB(0, 0), cB, voffB); PG8_STAGE(PG8_SA(0, 0), cA, voffA); PG8_STAGE(PG8_SB(0, 1), cB + hstepB, voffB); PG8_STAGE(PG8_SA(0, 1), cA + hstepA, voffA);
        if (wr == 1) PG8_BAR;
        PG8_WAIT_V(4); PG8_BAR;
        PG8_STAGE(PG8_SB(1, 0), cB + kstep, voffB); PG8_STAGE(PG8_SA(1, 0), cA + kstep, voffA); PG8_STAGE(PG8_SB(1, 1), cB + hstepB + kstep, voffB);
        PG8_WAIT_V(6); PG8_BAR;
    }
    for (;;) {
        const bool has_next = S.next(ui + 1, nxt);
        const char* nA = has_next ? PG8_ASEG(nxt) + (size_t)nxt.pm * tstepA + (size_t)nxt.pn * pnA : cA; const char* nB = has_next ? PG8_BSEG(nxt) + (size_t)nxt.pn * tstepB : cB;
        for (int t = 0; t < nt; t += 2) {
            const bool last = (t == nt - 2);
            const char* a1 = cA + (size_t)(t + 1) * kstep;
            const char* a2 = last ? nA : cA + (size_t)(t + 2) * kstep; const char* b2 = last ? nB : cB + (size_t)(t + 2) * kstep;
            const char* a3 = a2 + kstep; const char* b3 = b2 + kstep;
            if (last && has_next) S.a_ready(nxt);
            if constexpr (SP2) {
            PG8_LDB(B0, 0, 0); PG8_LDB(B1, 0, 1); PG8_SCHED; PG8_LDA(At, 0, 0); PG8_STAGE(PG8_SA(1, 1), a1 + hstepA, voffA);
            PG8_WAIT_V(8); PG8_WAIT_L(0); PG8_BAR; PG8_MMA(0, 0, At, B0); PG8_MMA(0, 1, At, B1); PG8_BAR; PG8_SCHED;
            PG8_LDA(At, 0, 1); PG8_STAGE(PG8_SB(0, 0), b2, voffB); PG8_STAGE(PG8_SB(0, 1), b2 + hstepB, voffB); PG8_STAGE(PG8_SA(0, 0), a2, voffA);
            PG8_WAIT_V(8); PG8_WAIT_L(0); PG8_BAR; PG8_MMA(1, 0, At, B0); PG8_MMA(1, 1, At, B1); PG8_BAR; PG8_SCHED;
            PG8_LDB(B0, 1, 0); PG8_LDB(B1, 1, 1); PG8_SCHED; PG8_LDA(At, 1, 0); PG8_STAGE(PG8_SA(0, 1), a2 + hstepA, voffA);
            PG8_WAIT_V(8); PG8_WAIT_L(0); PG8_BAR; PG8_MMA(0, 0, At, B0); PG8_MMA(0, 1, At, B1); PG8_BAR; PG8_SCHED;
            PG8_LDA(At, 1, 1); PG8_STAGE(PG8_SB(1, 0), b3, voffB); PG8_STAGE(PG8_SB(1, 1), b3 + hstepB, voffB); PG8_STAGE(PG8_SA(1, 0), a3, voffA);
            PG8_WAIT_V(8); PG8_WAIT_L(0); PG8_BAR; PG8_MMA(1, 0, At, B0); PG8_MMA(1, 1, At, B1); PG8_BAR; PG8_SCHED;
            } else {
            PG8_LDB(B0, 0, 0); PG8_SCHED; PG8_LDA(At, 0, 0); PG8_STAGE(PG8_SA(1, 1), a1 + hstepA, voffA);
            PG8_WAIT_L(8); PG8_BAR; PG8_WAIT_L(0); PG8_MMA(0, 0, At, B0); PG8_BAR; PG8_SCHED;
            PG8_LDB(B1, 0, 1); PG8_STAGE(PG8_SB(0, 0), b2, voffB);
            PG8_BAR; PG8_WAIT_L(0); PG8_MMA(0, 1, At, B1); PG8_BAR;
            PG8_LDA(At, 0, 1); PG8_STAGE(PG8_SA(0, 0), a2, voffA);
            PG8_BAR; PG8_WAIT_L(0); PG8_MMA(1, 0, At, B0); PG8_BAR; PG8_SCHED;
            PG8_STAGE(PG8_SB(0, 1), b2 + hstepB, voffB);
            PG8_WAIT_V(6); PG8_BAR; PG8_MMA(1, 1, At, B1); PG8_BAR;
            PG8_LDB(B0, 1, 0); PG8_SCHED; PG8_LDA(At, 1, 0); PG8_STAGE(PG8_SA(0, 1), a2 + hstepA, voffA);
            PG8_WAIT_L(8); PG8_BAR; PG8_WAIT_L(0); PG8_MMA(0, 0, At, B0); PG8_BAR; PG8_SCHED;
            PG8_LDB(B1, 1, 1); PG8_STAGE(PG8_SB(1, 0), b3, voffB);
            PG8_BAR; PG8_WAIT_L(0); PG8_MMA(0, 1, At, B1); PG8_BAR;
            PG8_LDA(At, 1, 1); PG8_STAGE(PG8_SA(1, 0), a3, voffA);
            PG8_BAR; PG8_WAIT_L(0); PG8_MMA(1, 0, At, B0); PG8_BAR; PG8_SCHED;
            PG8_STAGE(PG8_SB(1, 1), b3 + hstepB, voffB);
            PG8_WAIT_V(6); PG8_BAR; PG8_MMA(1, 1, At, B1); PG8_BAR;
            }
        }
        if constexpr (ALIGN_EPI) { if (wr == 0) PG8_BAR; }
        E(acc, cur, wr, wc, fr, fq); S.done(cur);
        if (!has_next) break;
        if (NSEG == 1 || cur.seg == NSEG - 1)
#pragma unroll
        for (int a = 0; a < 2; ++a)
#pragma unroll
            for (int b = 0; b < 2; ++b)
#pragma unroll
                for (int m = 0; m < 4; ++m)
#pragma unroll
                    for (int n = 0; n < 2; ++n) acc[a][b][m][n] = (f32x4){0.f, 0.f, 0.f, 0.f};
        cur = nxt; cA = nA; cB = nB; ++ui;
        if constexpr (ALIGN_EPI) { if (wr == 1) PG8_BAR; }
    }
    PG8_WAIT_V(0);
    if constexpr (!ALIGN_EPI) { if (wr == 0) PG8_BAR; }
    PG8_BAR;
#undef PG8_ASEG
#undef PG8_BSEG
#undef PG8_SA
#undef PG8_SB
#undef PG8_STAGE
#undef PG8_LDA
#undef PG8_LDB
#undef PG8_MMA
#undef PG8_WAIT_V
#undef PG8_WAIT_L
#undef PG8_BAR
#undef PG8_SCHED
}

struct EpiPool {
    static constexpr bool PERM = true, AFTER_DRAIN = false;
    bf16_t* O; const bf16_t* pgate;
    __device__ __forceinline__ void operator()(const f32x4 (&acc)[2][2][4][2], const Unit& u, int wr, int wc, int fr, int fq) const {
        const int row0 = u.pm * BM + wr * 64 + fr, col0 = u.pn * BM + wc * 32 + 8 * fq;
#pragma unroll
        for (int ai = 0; ai < 2; ++ai)
#pragma unroll
            for (int m = 0; m < 4; ++m)
#pragma unroll
                for (int bj = 0; bj < 2; ++bj) {
                    const int row = row0 + ai * HALF + m * 16, col = col0 + bj * HALF;
                    const u32x4 gz = *(const u32x4*)(pgate + (size_t)row * 1024 + col);
                    const f32x4 v0 = acc[ai][bj][m][0], v1 = acc[ai][bj][m][1];
                    u32x4 w;
                    w.x = cvt_pk_bf16(v0[0] * bflo(gz.x), v0[1] * bfhi(gz.x));
                    w.y = cvt_pk_bf16(v0[2] * bflo(gz.y), v0[3] * bfhi(gz.y));
                    w.z = cvt_pk_bf16(v1[0] * bflo(gz.z), v1[1] * bfhi(gz.z));
                    w.w = cvt_pk_bf16(v1[2] * bflo(gz.w), v1[3] * bfhi(gz.w));
                    *(u32x4*)(O + (size_t)row * 1024 + col) = w;
                    __builtin_amdgcn_sched_barrier(0);
                }
    }
};
template <int PASS> struct EpiMerge {
    static constexpr bool PERM = true, AFTER_DRAIN = false;
    float* yacc; bf16_t* y; const bf16_t* zg;
    __device__ __forceinline__ void operator()(const f32x4 (&acc)[2][2][4][2], const Unit& u, int wr, int wc, int fr, int fq) const {
        const int row0 = u.pm * BM + wr * 64 + fr, col0 = u.pn * BM + wc * 32 + 8 * fq;
#pragma unroll
        for (int ai = 0; ai < 2; ++ai)
#pragma unroll
            for (int m = 0; m < 4; ++m)
#pragma unroll
                for (int bj = 0; bj < 2; ++bj) {
                    const int row = row0 + ai * HALF + m * 16, col = col0 + bj * HALF;
                    float gz[8]; unpack8(*(const u32x4*)(zg + (size_t)row * NZ + col), gz);
                    const f32x4 v0 = acc[ai][bj][m][0], v1 = acc[ai][bj][m][1];
                    f32x4 r0, r1;
#pragma unroll
                    for (int e = 0; e < 4; ++e) { r0[e] = v0[e] * sigmoid_f(gz[e]); r1[e] = v1[e] * sigmoid_f(gz[4 + e]); }
                    float* yp = yacc + (size_t)row * DM + col;
                    if (PASS >= 1) { r0 += *(const f32x4*)yp; r1 += *(const f32x4*)(yp + 4); }
                    if (PASS <= 1) { *(f32x4*)yp = r0; *(f32x4*)(yp + 4) = r1; }
                    else { u32x4 w; w.x = cvt_pk_bf16(r0[0], r0[1]); w.y = cvt_pk_bf16(r0[2], r0[3]); w.z = cvt_pk_bf16(r1[0], r1[1]); w.w = cvt_pk_bf16(r1[2], r1[3]);
                        *(u32x4*)(y + (size_t)row * DM + col) = w; }
                    __builtin_amdgcn_sched_barrier(0);
                }
    }
};
struct EpiMerge3 {
    static constexpr bool PERM = true, AFTER_DRAIN = false;
    bf16_t* y; const bf16_t* zg;
    __device__ __forceinline__ void operator()(f32x4 (&acc)[2][2][4][2], const Unit& u, int wr, int wc, int fr, int fq) const {
        const int row0 = u.pm * BM + wr * 64 + fr, col0 = u.pn * BM + wc * 32 + 8 * fq;
#pragma unroll
        for (int ai = 0; ai < 2; ++ai)
#pragma unroll
            for (int m = 0; m < 4; ++m)
#pragma unroll
                for (int bj = 0; bj < 2; ++bj) {
                    const int row = row0 + ai * HALF + m * 16, col = col0 + bj * HALF;
                    const bf16_t* zp = zg + (size_t)row * NZ + col + u.seg * 2048;
                    float ga[8]; unpack8(*(const u32x4*)zp, ga);
                    if (u.seg < 2) {
                        float gb[8]; unpack8(*(const u32x4*)(zp + 2048), gb);
#pragma unroll
                        for (int e = 0; e < 8; ++e) { const float ea = __expf(-fminf(fmaxf(ga[e], -30.f), 30.f)), eb = __expf(-fminf(fmaxf(gb[e], -30.f), 30.f));
                            const float ratio = (1.f + eb) / (1.f + ea); acc[ai][bj][m][e >> 2][e & 3] *= ratio; }
                    } else {
                        float r[8];
#pragma unroll
                        for (int e = 0; e < 8; ++e) r[e] = acc[ai][bj][m][e >> 2][e & 3] / (1.f + __expf(-fminf(fmaxf(ga[e], -30.f), 30.f)));
                        u32x4 w; w.x = cvt_pk_bf16(r[0], r[1]); w.y = cvt_pk_bf16(r[2], r[3]); w.z = cvt_pk_bf16(r[4], r[5]); w.w = cvt_pk_bf16(r[6], r[7]);
                        *(u32x4*)(y + (size_t)row * DM + col) = w;
                    }
                    __builtin_amdgcn_sched_barrier(0);
                }
    }
};
struct EpiOut {
    static constexpr bool PERM = true, AFTER_DRAIN = false;
    const float* xlat; const float* xctx; float* xnew; const float* mod;
    __device__ __forceinline__ void operator()(const f32x4 (&acc)[2][2][4][2], const Unit& u, int wr, int wc, int fr, int fq) const {
        const int row0 = u.pm * BM + wr * 64 + fr, col0 = u.pn * BM + wc * 32 + 8 * fq;
        const int tile_row = u.pm * BM; const int mr = tile_row < ML ? tile_row / SEQ : 4;
        const float* xo = tile_row < ML ? xlat : (xctx - (size_t)ML * DM);
        const float* gm = mod + mr * 6144 + 4096;
#pragma unroll
        for (int ai = 0; ai < 2; ++ai)
#pragma unroll
            for (int m = 0; m < 4; ++m)
#pragma unroll
                for (int bj = 0; bj < 2; ++bj) {
                    const int row = row0 + ai * HALF + m * 16, col = col0 + bj * HALF;
                    const f32x4 g0 = *(const f32x4*)(gm + col), g1 = *(const f32x4*)(gm + col + 4);
                    const float* xp = xo + (size_t)row * DM + col;
                    const f32x4 r0 = *(const f32x4*)xp + g0 * acc[ai][bj][m][0], r1 = *(const f32x4*)(xp + 4) + g1 * acc[ai][bj][m][1];
                    float* op = xnew + (size_t)row * DM + col;
                    *(f32x4*)op = r0; *(f32x4*)(op + 4) = r1;
                    __builtin_amdgcn_sched_barrier(0);
                }
    }
};
}

struct Args { const float* in[26]; float* out; unsigned char* ws; int ph_lo, ph_hi; };
enum { I_X = 0, I_C, I_CTX, I_CCTX, I_NORMG, I_WADA, I_BADA, I_WIN, I_POOLW, I_POOLS, I_QNORM, I_KNORM, I_LQ1, I_LK1, I_LQ2, I_LK2, I_SUBLN, I_WGF, I_BGF, I_WGB, I_BGB, I_GLAN, I_WBP, I_WBD, I_WBG, I_WOUT };

__device__ __forceinline__ const float* inp(int i) { const float* const volatile __attribute__((address_space(4)))* kp = (const float* const volatile __attribute__((address_space(4)))*)__builtin_amdgcn_kernarg_segment_ptr(); const GAS float* q = (const GAS float*)kp[i]; asm volatile("" : "+s"(q)); return (const float*)q; }
__device__ __forceinline__ float* arg_out() { float* const volatile __attribute__((address_space(4)))* kp = (float* const volatile __attribute__((address_space(4)))*)__builtin_amdgcn_kernarg_segment_ptr(); GAS float* q = (GAS float*)kp[26]; asm volatile("" : "+s"(q)); return (float*)q; }
__device__ __forceinline__ void transpose_item(const float* W, int K, int N, bf16_t* WT, int row_off, LAS float* scr, int kb, int nb, int lane) {
    const int k0 = 64 * kb, n0 = 32 * nb;
    float tv[32];
#pragma unroll
    for (int i = 0; i < 32; ++i) { const int kk = 2 * i + (lane >> 5); tv[i] = __builtin_nontemporal_load(W + (size_t)(k0 + kk) * N + n0 + (lane & 31)); }
#pragma unroll
    for (int i = 0; i < 32; ++i) { const int kk = 2 * i + (lane >> 5); scr[kk * 33 + (lane & 31)] = tv[i]; }
    asm volatile("s_waitcnt lgkmcnt(0)" ::: "memory");
    const int c = lane & 7;
#pragma unroll
    for (int j = 0; j < 4; ++j) { const int n = (lane >> 3) + 8 * j; const LAS float* s = scr + (8 * c) * 33 + n;
        u32x4 o; o.x = cvt_pk_bf16(s[0 * 33], s[1 * 33]); o.y = cvt_pk_bf16(s[2 * 33], s[3 * 33]); o.z = cvt_pk_bf16(s[4 * 33], s[5 * 33]); o.w = cvt_pk_bf16(s[6 * 33], s[7 * 33]);
        *(u32x4*)(WT + (size_t)(row_off + n0 + n) * K + k0 + 8 * c) = o; }
    asm volatile("s_waitcnt lgkmcnt(0)" ::: "memory");
}

__device__ __forceinline__ void ada_items(const Args& a, LAS unsigned char* lds, int l, int bidx, int nb) {
    const int tid = opaque_tid(), lane = tid & 63, wave = __builtin_amdgcn_readfirstlane(tid >> 6);
    unsigned char* ws = opaque_ptr(a.ws);
    LAS float* sc = (LAS float*)(lds + 69632);
    LAS float* part = (LAS float*)(lds + 69632 + 40960);
    if (bidx < 96) {
        for (int i = tid; i < 5 * 2048; i += 512) { const int r = i >> 11, k = i & 2047; const float v = r < 4 ? inp(I_C)[r * 2048 + k] : inp(I_CCTX)[k]; sc[i] = silu_f(v); }
        __syncthreads();
    }
    for (int it = bidx; it < 96; it += nb) {
        const int cgp = it, col = cgp * 64 + lane;
        const float* W = inp(I_WADA) + (size_t)l * 2048 * 6144 + col;
        float acc[5] = {0.f, 0.f, 0.f, 0.f, 0.f};
#pragma unroll 32
        for (int kk = 0; kk < 256; ++kk) { const int k = wave * 256 + kk; const float wv = __builtin_nontemporal_load(W + (size_t)k * 6144);
#pragma unroll
            for (int r = 0; r < 5; ++r) acc[r] += sc[r * 2048 + k] * wv; }
#pragma unroll
        for (int r = 0; r < 5; ++r) part[(wave * 5 + r) * 64 + lane] = acc[r];
        __syncthreads();
        if (tid < 320) { const int r = tid >> 6, ln = tid & 63; float s2 = inp(I_BADA)[l * 6144 + cgp * 64 + ln];
#pragma unroll
            for (int w = 0; w < 8; ++w) s2 += part[(w * 5 + r) * 64 + ln];
            ((float*)(ws + OFF_MOD))[(l * 5 + r) * 6144 + cgp * 64 + ln] = s2; }
        __syncthreads();
    }
}

__device__ __forceinline__ void convert_layer_weights(const Args& a, LAS unsigned char* lds, int l, int widx, int nw) {
    const int lane = opaque_tid() & 63, wave = __builtin_amdgcn_readfirstlane((int)threadIdx.x >> 6);
    unsigned char* ws = opaque_ptr(a.ws);
    LAS float* scr = (LAS float*)(lds + wave * 8704);
    constexpr int I_IN = 32 * 481, I_B = 16 * 64, I_O = 32 * 64, I_P = 4 * 32, PER_L = I_IN + 3 * I_B + I_O + I_P;
    for (int it = widx; it < PER_L; it += nw) {
        int r = it;
        if (r < I_IN) { const int kb = r / 481, nb = r % 481;
            transpose_item(inp(I_WIN) + (size_t)l * DM * DIN, DM, DIN, (bf16_t*)(ws + OFF_WIN + (size_t)l * SZ_WIN), nb >= 289 ? 224 : 0, scr, kb, nb, lane); continue; }
        r -= I_IN;
        if (r < 3 * I_B) { const int br = r / I_B, rr = r % I_B; const float* W = (br == 0 ? inp(I_WBP) : br == 1 ? inp(I_WBD) : inp(I_WBG)) + (size_t)l * 1024 * DM;
            transpose_item(W, 1024, DM, (bf16_t*)(ws + OFF_WB + (size_t)l * SZ_WB + (size_t)br * DM * 1024 * 2), 0, scr, rr / 64, rr % 64, lane); continue; }
        r -= 3 * I_B;
        if (r < I_O) { transpose_item(inp(I_WOUT) + (size_t)l * DM * DM, DM, DM, (bf16_t*)(ws + OFF_WOUT + (size_t)l * SZ_WOUT), 0, scr, r / 64, r % 64, lane); continue; }
        r -= I_O;
        { const int g = r / 32, rr = r % 32;
          transpose_item(inp(I_POOLW) + (size_t)(l * 4 + g) * 65536, 256, 256, (bf16_t*)(ws + OFF_POOLT + (size_t)l * SZ_POOLT + (size_t)g * 65536 * 2), 0, scr, rr / 8, rr % 8, lane); }
    }
}

__device__ __forceinline__ void phase_p0(const Args& a, LAS unsigned char* lds) {
    const int tid = opaque_tid(), lane = tid & 63, wave = __builtin_amdgcn_readfirstlane(tid >> 6), G = opaque_s(gridDim.x);
    unsigned char* ws = opaque_ptr(a.ws);
    ada_items(a, lds, 0, BID, G);
    if (BID == G - 1 && wave == 0) {
        for (int l = 0; l < 2; ++l) {
            const float s1 = wave_sum(inp(I_LQ1)[l * 64 + lane] * inp(I_LK1)[l * 64 + lane]);
            const float s2 = wave_sum(inp(I_LQ2)[l * 64 + lane] * inp(I_LK2)[l * 64 + lane]);
            const float mq = wave_max(fabsf(inp(I_QNORM)[l * 64 + lane])), mk = wave_max(fabsf(inp(I_KNORM)[l * 64 + lane]));
            const float lam_init = 0.8f - 0.6f * expf(-0.3f * (float)l);
            if (lane == 0) { float* sp = (float*)(ws + OFF_SCAL) + l * 4; sp[0] = expf(s1) - expf(s2) + lam_init; sp[1] = 8.f * LOG2E * mq * mk; sp[2] = lam_init; sp[3] = 0.f; }
        }
    }
    {
        const int nper = 224 * 2048 * 2 / 16;
        for (int i = BID * 512 + tid; i < 2 * nper; i += G * 512) { const int l = i / nper, j = i % nper;
            *(u32x4*)(ws + OFF_WIN + (size_t)l * SZ_WIN + (size_t)9248 * DM * 2 + (size_t)j * 16) = (u32x4){0u, 0u, 0u, 0u}; }
    }
    convert_layer_weights(a, lds, 0, BID * 8 + wave, G * 8);
}

__device__ __forceinline__ void phase_norm(const Args& a, int l) {
    const int tid = opaque_tid(), lane = tid & 63, wave = tid >> 6, G = opaque_s(gridDim.x);
    const int gw = BID * 8 + wave, NGW = G * 8;
    const float* mod = (const float*)(opaque_ptr(a.ws) + OFF_MOD) + (size_t)l * 5 * 6144;
    const float* x1 = (const float*)(opaque_ptr(a.ws) + OFF_X1);
    bf16_t* h = (bf16_t*)(opaque_ptr(a.ws) + OFF_H);
    const float* ng = inp(I_NORMG) + l * DM;
    for (int row = gw; row < MT; row += NGW) {
        const float* src = (l == 0) ? (row < ML ? inp(I_X) + (size_t)row * DM : inp(I_CTX) + (size_t)(row - ML) * DM) : x1 + (size_t)row * DM;
        const int mr = row < ML ? row / SEQ : 4;
        const float* md = mod + mr * 6144;
        f32x4 v[8]; float ss = 0.f;
#pragma unroll
        for (int j = 0; j < 8; ++j) { v[j] = *(const f32x4*)(src + 4 * lane + 256 * j); ss += (v[j][0] * v[j][0] + v[j][1] * v[j][1]) + (v[j][2] * v[j][2] + v[j][3] * v[j][3]); }
        ss = wave_sum(ss);
        const float rstd = rsqrtf(ss * (1.f / DM) + EPS);
#pragma unroll
        for (int j = 0; j < 8; ++j) { const int idx = 4 * lane + 256 * j;
            const f32x4 gg = *(const f32x4*)(ng + idx), sc = *(const f32x4*)(md + 2048 + idx), sh = *(const f32x4*)(md + idx);
            f32x4 o;
#pragma unroll
            for (int e = 0; e < 4; ++e) o[e] = v[j][e] * rstd * gg[e] * (1.f + sc[e]) + sh[e];
            u32x2 w; w.x = cvt_pk_bf16(o[0], o[1]); w.y = cvt_pk_bf16(o[2], o[3]);
            *(u32x2*)(h + (size_t)row * DM + idx) = w; }
    }
}

__device__ __forceinline__ int vt_pos(int key) { const int k = key & 15; return (key & ~15) | (((k >> 2) & 1) << 3) | (k & 3) | (((k >> 3) & 1) << 2); }

__device__ __forceinline__ void phase_prep(const Args& a, int l, LAS unsigned char* lds) {
    const int tid = opaque_tid(), lane = tid & 63, wave = tid >> 6, G = opaque_s(gridDim.x);
    unsigned char* ws = opaque_ptr(a.ws);
    const bf16_t* z = (const bf16_t*)(ws + OFF_Z);
    const bool need_ctx = (l == 0);
    for (int it = BID; it < 1440; it += G) {
        if (it < 576) {
            const int c = it >> 2, cgp = it & 3, rb = 64 * c;
            LAS float* lrs = (LAS float*)lds;
            LAS float* segs = (LAS float*)(lds + 8192);
            for (int i = tid; i < 64 * 32; i += 512) { const int r = i >> 5, cc = i & 31; lrs[i] = bf2f(z[(size_t)(rb + r) * NZ + ZC_LR + cc]); }
            __syncthreads();
            const int seg = tid >> 6, cp = tid & 63, ch = cgp * 128 + 2 * cp;
            typedef float f32x2v __attribute__((ext_vector_type(2)));
            const float* wgf = inp(I_WGF) + (size_t)l * 16 * 512 + ch; const float* wgb = inp(I_WGB) + (size_t)l * 16 * 512 + ch;
            f32x2v wf[16], wb[16];
#pragma unroll
            for (int r = 0; r < 16; ++r) { wf[r] = *(const f32x2v*)(wgf + r * 512); wb[r] = *(const f32x2v*)(wgb + r * 512); }
            const f32x2v bfv = *(const f32x2v*)(inp(I_BGF) + l * 512 + ch), bbv = *(const f32x2v*)(inp(I_BGB) + l * 512 + ch);
            f32x2v gf[8], gb[8]; f32x2v sf = {0.f, 0.f}, sb = {0.f, 0.f};
#pragma unroll
            for (int i = 0; i < 8; ++i) { const int t = seg * 8 + i; f32x2v af = bfv, ab = bbv;
#pragma unroll
                for (int r4 = 0; r4 < 4; ++r4) { const f32x4 lf = *(const LAS f32x4*)(lrs + t * 32 + 4 * r4), lb = *(const LAS f32x4*)(lrs + t * 32 + 16 + 4 * r4);
#pragma unroll
                    for (int e = 0; e < 4; ++e) { af += lf[e] * wf[4 * r4 + e]; ab += lb[e] * wb[4 * r4 + e]; } }
                gf[i].x = logsig_f(af.x) * (1.f / 16.f); gf[i].y = logsig_f(af.y) * (1.f / 16.f);
                gb[i].x = logsig_f(ab.x) * (1.f / 16.f); gb[i].y = logsig_f(ab.y) * (1.f / 16.f); sf += gf[i]; sb += gb[i]; }
            *(LAS f32x2v*)(segs + seg * 128 + 2 * cp) = sf; *(LAS f32x2v*)(segs + 1024 + seg * 128 + 2 * cp) = sb;
            __syncthreads();
            f32x2v pf = {0.f, 0.f}, pb = {0.f, 0.f}, totf = {0.f, 0.f}, totb = {0.f, 0.f};
#pragma unroll
            for (int s2 = 0; s2 < 8; ++s2) { const f32x2v vf = *(const LAS f32x2v*)(segs + s2 * 128 + 2 * cp), vb = *(const LAS f32x2v*)(segs + 1024 + s2 * 128 + 2 * cp);
                totf += vf; totb += vb; if (s2 < seg) { pf += vf; pb += vb; } }
            unsigned* gq0 = (unsigned*)(ws + OFF_GQ), *gq1 = (unsigned*)(ws + OFF_GQ + SZ_G);
            unsigned* gk0 = (unsigned*)(ws + OFF_GK), *gk1 = (unsigned*)(ws + OFF_GK + SZ_G);
            bf16_t* gh0 = (bf16_t*)(ws + OFF_GH), *gh1 = (bf16_t*)(ws + OFF_GH + SZ_G);
            f32x2v h0[8], h1[8];
#pragma unroll
            for (int i = 0; i < 8; ++i) { const int t = seg * 8 + i;
                pf += gf[i]; const f32x2v bs = totb - pb; pb += gb[i];
                const size_t row = rb + t;
                const unsigned qw = *(const unsigned*)(z + row * NZ + ZC_GQ + ch), kw = *(const unsigned*)(z + row * NZ + ZC_GK + ch);
                const float q0 = bflo(qw) * 0.08838834764831845f, q1 = bfhi(qw) * 0.08838834764831845f, k0 = bflo(kw), k1 = bfhi(kw);
                const size_t o = (row * 512 + ch) >> 1;
                gq0[o] = cvt_pk_bf16(q0 * __expf(pf.x), q1 * __expf(pf.y)); gk0[o] = cvt_pk_bf16(k0 * __expf(-pf.x), k1 * __expf(-pf.y));
                gq1[o] = cvt_pk_bf16(q0 * __expf(bs.x), q1 * __expf(bs.y)); gk1[o] = cvt_pk_bf16(k0 * __expf(-bs.x), k1 * __expf(-bs.y));
                h0[i].x = k0 * __expf(totf.x - pf.x); h0[i].y = k1 * __expf(totf.y - pf.y);
                h1[i].x = k0 * __expf(totb.x - bs.x); h1[i].y = k1 * __expf(totb.y - bs.y); }
            {
#pragma unroll
                for (int cc = 0; cc < 2; ++cc) { u32x4 w0, w1;
                    w0.x = cvt_pk_bf16(h0[0][cc], h0[1][cc]); w0.y = cvt_pk_bf16(h0[2][cc], h0[3][cc]); w0.z = cvt_pk_bf16(h0[4][cc], h0[5][cc]); w0.w = cvt_pk_bf16(h0[6][cc], h0[7][cc]);
                    w1.x = cvt_pk_bf16(h1[0][cc], h1[1][cc]); w1.y = cvt_pk_bf16(h1[2][cc], h1[3][cc]); w1.z = cvt_pk_bf16(h1[4][cc], h1[5][cc]); w1.w = cvt_pk_bf16(h1[6][cc], h1[7][cc]);
                    const size_t oh = ((size_t)c * 512 + ch + cc) * 64 + seg * 8;
                    *(u32x4*)(gh0 + oh) = w0; *(u32x4*)(gh1 + oh) = w1; } }
            if (seg == 0) { float* dec = (float*)(ws + OFF_DEC);
                *(f32x2v*)(dec + (size_t)c * 512 + ch) = (f32x2v){__expf(totf.x), __expf(totf.y)}; *(f32x2v*)(dec + (size_t)(144 + c) * 512 + ch) = (f32x2v){__expf(totb.x), __expf(totb.y)}; }
            __syncthreads();
        } else if (it < 864) {
            const int rb = 32 * (it - 576); if (!need_ctx && rb >= ML) continue;
            const int seq0 = rb < ML ? (rb / SEQ) * SEQ : ML + ((rb - ML) / LC) * LC; const int L = rb < ML ? SEQ : LC;
            const int ts = rb - seq0;
            bf16_t* dp = (bf16_t*)(ws + OFF_DPOOL); bf16_t* pgt = (bf16_t*)(ws + OFF_PGATE);
#pragma unroll
            for (int i = 0; i < 12; ++i) { const int idx = tid + 512 * i, rr = idx >> 7, c8 = (idx & 127) * 8, p = ts - 8 + rr;
                if (p >= 0 && p < L) *(LAS u32x4*)(lds + rr * 2048 + c8 * 2) = *(const u32x4*)(z + (size_t)(seq0 + p) * NZ + ZC_PU + c8); }
            __syncthreads();
            const int ch8 = 8 * (tid & 127), tg = tid >> 7, hw = 1 << (ch8 >> 8);
            const int tl0 = ts + 8 * tg;
            float psc[8];
            { const float* pp = inp(I_POOLS) + l * 1024 + ch8; const f32x4 p0 = *(const f32x4*)pp, p1 = *(const f32x4*)(pp + 4);
#pragma unroll
              for (int e = 0; e < 4; ++e) { psc[e] = p0[e]; psc[4 + e] = p1[e]; } }
            u32x4 pgw[8];
#pragma unroll
            for (int t = 0; t < 8; ++t) pgw[t] = *(const u32x4*)(z + (size_t)(seq0 + tl0 + t) * NZ + ZC_PG + ch8);
            const LAS unsigned char* lc = lds + ch8 * 2 - (ts - 8) * 2048;
            float sm[8] = {0.f, 0.f, 0.f, 0.f, 0.f, 0.f, 0.f, 0.f};
            { const int lo = max(tl0 - hw, 0), hi = min(tl0 + hw, L);
              for (int p = lo; p < hi; ++p) { float u[8]; unpack8(*(const LAS u32x4*)(lc + p * 2048), u);
#pragma unroll
                  for (int e = 0; e < 8; ++e) sm[e] += u[e]; } }
#pragma unroll
            for (int t = 0; t < 8; ++t) { const int tl = tl0 + t; const int lo = max(tl - hw, 0), hi = min(tl + hw, L);
                const float rc = __builtin_amdgcn_rcpf((float)(hi - lo));
                float cur[8], pgv[8], ua[8], ur[8];
                unpack8(*(const LAS u32x4*)(lc + tl * 2048), cur); unpack8(pgw[t], pgv);
                unpack8(*(const LAS u32x4*)(lc + min(tl + hw, L - 1) * 2048), ua); unpack8(*(const LAS u32x4*)(lc + max(tl - hw, 0) * 2048), ur);
                const float ma = (tl + hw < L) ? 1.f : 0.f, mr = (tl - hw >= 0) ? 1.f : 0.f;
                u32x4 wd, wg;
                wd.x = cvt_pk_bf16(sm[0] * rc - cur[0], sm[1] * rc - cur[1]); wd.y = cvt_pk_bf16(sm[2] * rc - cur[2], sm[3] * rc - cur[3]);
                wd.z = cvt_pk_bf16(sm[4] * rc - cur[4], sm[5] * rc - cur[5]); wd.w = cvt_pk_bf16(sm[6] * rc - cur[6], sm[7] * rc - cur[7]);
                wg.x = cvt_pk_bf16(psc[0] * silu_f(pgv[0]), psc[1] * silu_f(pgv[1])); wg.y = cvt_pk_bf16(psc[2] * silu_f(pgv[2]), psc[3] * silu_f(pgv[3]));
                wg.z = cvt_pk_bf16(psc[4] * silu_f(pgv[4]), psc[5] * silu_f(pgv[5])); wg.w = cvt_pk_bf16(psc[6] * silu_f(pgv[6]), psc[7] * silu_f(pgv[7]));
                const size_t o = (size_t)(seq0 + tl) * 1024 + ch8;
                *(u32x4*)(dp + o) = wd; *(u32x4*)(pgt + o) = wg;
#pragma unroll
                for (int e = 0; e < 8; ++e) sm[e] += ma * ua[e] - mr * ur[e]; }
            __syncthreads();
        } else {
            const int vi = it - 864, isg = vi >= 288, vj = isg ? vi - 288 : vi, c = vj >> 1, hv = vj & 1, rb = 64 * c;
            int b, key0; if (rb < ML) { b = rb >> 11; key0 = LC + (rb & 2047); } else { b = (rb - ML) >> 8; key0 = (rb - ML) & 255; }
            bf16_t* vT = (bf16_t*)(ws + OFF_VT); bf16_t* gvT = (bf16_t*)(ws + OFF_GVT);
#pragma unroll
            for (int i = 0; i < 8; ++i) { const int idx = tid + 512 * i, key = idx & 63, c8 = (idx >> 6) * 8;
                const u32x4 w = *(const u32x4*)(z + (size_t)(rb + key) * NZ + (isg ? ZC_GV : ZC_DV) + hv * 512 + c8);
                const unsigned ww[4] = {w.x, w.y, w.z, w.w}; const int pos = isg ? key : vt_pos(key);
#pragma unroll
                for (int e = 0; e < 8; ++e) *(LAS bf16_t*)(lds + (c8 + e) * 144 + pos * 2) = (bf16_t)((e & 1) ? (ww[e >> 1] >> 16) : (ww[e >> 1] & 0xffffu)); }
            __syncthreads();
#pragma unroll
            for (int i = 0; i < 8; ++i) { const int idx = tid + 512 * i, col = idx >> 3, k8 = idx & 7, colg = hv * 512 + col, h = colg >> 7, v = colg & 127;
                bf16_t* dst = isg ? gvT + ((size_t)c * 1024 + colg) * 64 + k8 * 8 : vT + ((size_t)(b * 8 + h) * 128 + v) * LK + key0 + k8 * 8;
                *(u32x4*)dst = *(const LAS u32x4*)(lds + col * 144 + k8 * 16); }
            __syncthreads();
        }
    }
    {
        const int gw = BID * 8 + wave, NGW = G * 8;
        bf16_t* qn = (bf16_t*)(ws + OFF_QN); bf16_t* qnc = (bf16_t*)(ws + OFF_QNC); bf16_t* kn = (bf16_t*)(ws + OFF_KN);
        for (int it = gw; it < MT * 2; it += NGW) {
            const int row = it >> 1, which = it & 1;
            const bool isctx = row >= ML; int b, t; if (!isctx) { b = row >> 11; t = row & 2047; } else { b = (row - ML) >> 8; t = (row - ML) & 255; }
            const bf16_t* zr = z + (size_t)row * NZ;
            {
                if (which == 0 && isctx && !need_ctx) continue;
                float x[16]; const bf16_t* src = zr + (which == 0 ? ZC_DQ : ZC_DK) + 16 * lane;
                unpack8(*(const u32x4*)src, x); unpack8(*(const u32x4*)(src + 8), x + 8);
                float ss = 0.f;
#pragma unroll
                for (int e = 0; e < 16; ++e) ss += x[e] * x[e];
                ss += __shfl_xor(ss, 1); ss += __shfl_xor(ss, 2);
                const float rstd = rsqrtf(ss * (1.f / 64.f) + EPS);
                const int m = lane & 3, sh = lane >> 2, h = sh >> 1, j = sh & 1;
                const float* gain = (which == 0 ? inp(I_QNORM) : inp(I_KNORM)) + l * 64 + 16 * m;
                float y[16];
#pragma unroll
                for (int e = 0; e < 16; ++e) y[e] = x[e] * rstd * gain[e];
                if (!isctx) {
                    const float posf = (float)((m & 1) ? (t & 63) : (t >> 6));
#pragma unroll
                    for (int e = 0; e < 16; ++e) { const float yp = __shfl_xor(y[e], 2);
                        const float ang = posf * exp2f(-(float)e * 0.8304820237218405f);
                        const float cs = __cosf(ang), sn = __sinf(ang);
                        y[e] = (m < 2) ? (y[e] * cs - yp * sn) : (y[e] * cs + yp * sn); }
                }
                bf16_t* dst;
                if (which == 0) {
#pragma unroll
                    for (int e = 0; e < 16; ++e) y[e] *= 0.125f * LOG2E;
                    dst = isctx ? qnc + (((size_t)(b * 8 + h) * 2 + j) * LC + t) * 64 + 16 * m : qn + (((size_t)(b * 8 + h) * 2 + j) * SEQ + t) * 64 + 16 * m;
                } else dst = kn + (((size_t)(b * 8 + h) * 2 + j) * LK + (isctx ? t : LC + t)) * 64 + 16 * m;
                u32x4 w0, w1;
                w0.x = cvt_pk_bf16(y[0], y[1]); w0.y = cvt_pk_bf16(y[2], y[3]); w0.z = cvt_pk_bf16(y[4], y[5]); w0.w = cvt_pk_bf16(y[6], y[7]);
                w1.x = cvt_pk_bf16(y[8], y[9]); w1.y = cvt_pk_bf16(y[10], y[11]); w1.z = cvt_pk_bf16(y[12], y[13]); w1.w = cvt_pk_bf16(y[14], y[15]);
                *(u32x4*)dst = w0; *(u32x4*)(dst + 8) = w1;
            }
        }
    }
}

constexpr int GL_Q = 0, GL_K = 17408, GL_KH = 34816, GL_VT = 53248, GL_ATT = 57856, GL_ST = 67072;
__device__ __forceinline__ void gla_unit(const Args& a, int l, LAS unsigned char* lds, int item) {
    const int tid = opaque_tid(), lane = tid & 63, w = __builtin_amdgcn_readfirstlane(tid >> 6);
    const int vs = item & 7, dir = (item >> 3) & 1, h = (item >> 4) & 3, b = item >> 6;
    const bool need_ctx = (l == 0);
    unsigned char* ws = opaque_ptr(a.ws);
    const bf16_t* z = (const bf16_t*)(ws + OFF_Z);
    const bf16_t* gq = (const bf16_t*)(ws + OFF_GQ + dir * SZ_G) + h * 128;
    const bf16_t* gk = (const bf16_t*)(ws + OFF_GK + dir * SZ_G) + h * 128;
    const bf16_t* gh = (const bf16_t*)(ws + OFF_GH + dir * SZ_G) + (size_t)h * 128 * 64;
    const float* dec = (const float*)(ws + OFF_DEC) + (size_t)dir * 144 * 512 + h * 128;
    bf16_t* od = (bf16_t*)(ws + OFF_OF + (size_t)dir * MT * 1024 * 2) + h * 256 + vs * 32;
    const bf16_t* gvt = (const bf16_t*)(ws + OFF_GVT) + (size_t)(h * 256 + vs * 32) * 64;
    const int fr = lane & 15, fq = lane >> 4;
    f32x4 sacc[2] = {(f32x4){0.f, 0.f, 0.f, 0.f}, (f32x4){0.f, 0.f, 0.f, 0.f}};
    for (int i = tid; i < 32 * 136 / 2; i += 512) ((LAS unsigned*)(lds + GL_ST))[i] = 0u;
    u32x4 rqA[2], rkA[2], rhA[2], rvA, rqB[2], rkB[2], rhB[2], rvB; float rdecA, rdecB;
    auto rowbase = [&](int s) -> int { if (s < 4) { const int ci = dir == 0 ? s : 3 - s; return ML + b * LC + 64 * ci; } const int ci = dir == 0 ? s - 4 : 35 - s; return b * SEQ + 64 * ci; };
#define GLA_LOADA(s) do { const int _rb = rowbase(s); _Pragma("unroll") for (int _i = 0; _i < 2; ++_i) { const int _idx = tid + 512 * _i, _r = _idx >> 4, _c = (_idx & 15) * 8; const size_t _o = (size_t)(_rb + _r) * 512 + _c; \
        rqA[_i] = *(const u32x4*)(gq + _o); rkA[_i] = *(const u32x4*)(gk + _o); rhA[_i] = *(const u32x4*)(gh + ((size_t)(_rb >> 6) * 512 + (_idx >> 3)) * 64 + (_idx & 7) * 8); } \
        if (tid < 256) rvA = *(const u32x4*)(gvt + ((size_t)(_rb >> 6) * 1024 + (tid >> 3)) * 64 + (tid & 7) * 8); \
        rdecA = dec[(size_t)(_rb >> 6) * 512 + 16 * w + fr]; } while (0)
#define GLA_LOADB(s) do { const int _rb = rowbase(s); _Pragma("unroll") for (int _i = 0; _i < 2; ++_i) { const int _idx = tid + 512 * _i, _r = _idx >> 4, _c = (_idx & 15) * 8; const size_t _o = (size_t)(_rb + _r) * 512 + _c; \
        rqB[_i] = *(const u32x4*)(gq + _o); rkB[_i] = *(const u32x4*)(gk + _o); rhB[_i] = *(const u32x4*)(gh + ((size_t)(_rb >> 6) * 512 + (_idx >> 3)) * 64 + (_idx & 7) * 8); } \
        if (tid < 256) rvB = *(const u32x4*)(gvt + ((size_t)(_rb >> 6) * 1024 + (tid >> 3)) * 64 + (tid & 7) * 8); \
        rdecB = dec[(size_t)(_rb >> 6) * 512 + 16 * w + fr]; } while (0)
    GLA_LOADA(0); GLA_LOADB(1);
    for (int s0_ = 0; s0_ < 36; s0_ += 2) {
      { const int s = s0_;
        const int rb = rowbase(s);
        const float dk = rdecA;
#pragma unroll
        for (int i = 0; i < 2; ++i) { const int idx = tid + 512 * i, r = idx >> 4, c = (idx & 15) * 8;
            *(LAS u32x4*)(lds + GL_Q + r * 272 + c * 2) = rqA[i]; *(LAS u32x4*)(lds + GL_K + r * 272 + c * 2) = rkA[i];
            const int s0 = (idx & 7) * 8, p1 = (s0 & 32) + 8 * ((s0 & 15) >> 2) + 4 * ((s0 >> 4) & 1);
            *(LAS u32x2*)(lds + GL_KH + (idx >> 3) * 144 + p1 * 2) = (u32x2){rhA[i].x, rhA[i].y}; *(LAS u32x2*)(lds + GL_KH + (idx >> 3) * 144 + (p1 + 8) * 2) = (u32x2){rhA[i].z, rhA[i].w}; }
        if (tid < 256) { const int s0 = (tid & 7) * 8, p1 = (s0 & 32) + 8 * ((s0 & 15) >> 2) + 4 * ((s0 >> 4) & 1);
            *(LAS u32x2*)(lds + GL_VT + (tid >> 3) * 144 + p1 * 2) = (u32x2){rvA.x, rvA.y}; *(LAS u32x2*)(lds + GL_VT + (tid >> 3) * 144 + (p1 + 8) * 2) = (u32x2){rvA.z, rvA.w}; }
        __syncthreads();
        if (s + 2 < 36) GLA_LOADA(s + 2);
        const int tt = w >> 1, vt = w & 1;
        bf16x8 pb[2];
        {
            f32x4 at[4];
#pragma unroll
            for (int st = 0; st < 4; ++st) { f32x4 acc = (f32x4){0.f, 0.f, 0.f, 0.f};
#pragma unroll
                for (int kk = 0; kk < 4; ++kk) { const bf16x8 af = *(const LAS bf16x8*)(lds + GL_K + (16 * st + fr) * 272 + (32 * kk + 8 * fq) * 2);
                    const bf16x8 bfr = *(const LAS bf16x8*)(lds + GL_Q + (16 * tt + fr) * 272 + (32 * kk + 8 * fq) * 2);
                    acc = __builtin_amdgcn_mfma_f32_16x16x32_bf16(af, bfr, acc, 0, 0, 0); }
#pragma unroll
                for (int j = 0; j < 4; ++j) { const int sc = 16 * st + 4 * fq + j, t = 16 * tt + fr; const bool keep = dir == 0 ? (sc <= t) : (sc >= t); acc[j] = keep ? acc[j] : 0.f; }
                at[st] = acc; }
#pragma unroll
            for (int p = 0; p < 2; ++p) { u32x4 pw; pw.x = cvt_pk_bf16(at[2 * p][0], at[2 * p][1]); pw.y = cvt_pk_bf16(at[2 * p][2], at[2 * p][3]);
                pw.z = cvt_pk_bf16(at[2 * p + 1][0], at[2 * p + 1][1]); pw.w = cvt_pk_bf16(at[2 * p + 1][2], at[2 * p + 1][3]); pb[p] = __builtin_bit_cast(bf16x8, pw); }
        }
        {
            f32x4 acc = (f32x4){0.f, 0.f, 0.f, 0.f};
#pragma unroll
            for (int kk = 0; kk < 4; ++kk) { const bf16x8 af = *(const LAS bf16x8*)(lds + GL_ST + (16 * vt + fr) * 272 + (32 * kk + 8 * fq) * 2);
                const bf16x8 bfr = *(const LAS bf16x8*)(lds + GL_Q + (16 * tt + fr) * 272 + (32 * kk + 8 * fq) * 2);
                acc = __builtin_amdgcn_mfma_f32_16x16x32_bf16(af, bfr, acc, 0, 0, 0); }
#pragma unroll
            for (int p = 0; p < 2; ++p) { const bf16x8 af = *(const LAS bf16x8*)(lds + GL_VT + (16 * vt + fr) * 144 + (32 * p + 8 * fq) * 2);
                acc = __builtin_amdgcn_mfma_f32_16x16x32_bf16(af, pb[p], acc, 0, 0, 0); }
            if (s >= 4 || need_ctx) { u32x2 wv; wv.x = cvt_pk_bf16(acc[0], acc[1]); wv.y = cvt_pk_bf16(acc[2], acc[3]);
                *(u32x2*)(od + (size_t)(rb + 16 * tt + fr) * 1024 + 16 * vt + 4 * fq) = wv; }
        }
#pragma unroll
        for (int vt2 = 0; vt2 < 2; ++vt2) { f32x4 acc = sacc[vt2] * dk;
#pragma unroll
            for (int kk = 0; kk < 2; ++kk) { const bf16x8 af = *(const LAS bf16x8*)(lds + GL_VT + (16 * vt2 + fr) * 144 + (32 * kk + 8 * fq) * 2);
                const bf16x8 bfr = *(const LAS bf16x8*)(lds + GL_KH + (16 * w + fr) * 144 + (32 * kk + 8 * fq) * 2);
                acc = __builtin_amdgcn_mfma_f32_16x16x32_bf16(af, bfr, acc, 0, 0, 0); }
            sacc[vt2] = acc; }
        __syncthreads();
#pragma unroll
        for (int vt = 0; vt < 2; ++vt)
#pragma unroll
            for (int j = 0; j < 4; ++j) *(LAS bf16_t*)(lds + GL_ST + (16 * vt + 4 * fq + j) * 272 + (16 * w + fr) * 2) = f2bf(sacc[vt][j]);
      }
      { const int s = s0_ + 1;
        const int rb = rowbase(s);
        const float dk = rdecB;
#pragma unroll
        for (int i = 0; i < 2; ++i) { const int idx = tid + 512 * i, r = idx >> 4, c = (idx & 15) * 8;
            *(LAS u32x4*)(lds + GL_Q + r * 272 + c * 2) = rqB[i]; *(LAS u32x4*)(lds + GL_K + r * 272 + c * 2) = rkB[i];
            const int s0 = (idx & 7) * 8, p1 = (s0 & 32) + 8 * ((s0 & 15) >> 2) + 4 * ((s0 >> 4) & 1);
            *(LAS u32x2*)(lds + GL_KH + (idx >> 3) * 144 + p1 * 2) = (u32x2){rhB[i].x, rhB[i].y}; *(LAS u32x2*)(lds + GL_KH + (idx >> 3) * 144 + (p1 + 8) * 2) = (u32x2){rhB[i].z, rhB[i].w}; }
        if (tid < 256) { const int s0 = (tid & 7) * 8, p1 = (s0 & 32) + 8 * ((s0 & 15) >> 2) + 4 * ((s0 >> 4) & 1);
            *(LAS u32x2*)(lds + GL_VT + (tid >> 3) * 144 + p1 * 2) = (u32x2){rvB.x, rvB.y}; *(LAS u32x2*)(lds + GL_VT + (tid >> 3) * 144 + (p1 + 8) * 2) = (u32x2){rvB.z, rvB.w}; }
        __syncthreads();
        if (s + 2 < 36) GLA_LOADB(s + 2);
        const int tt = w >> 1, vt = w & 1;
        bf16x8 pb[2];
        {
            f32x4 at[4];
#pragma unroll
            for (int st = 0; st < 4; ++st) { f32x4 acc = (f32x4){0.f, 0.f, 0.f, 0.f};
#pragma unroll
                for (int kk = 0; kk < 4; ++kk) { const bf16x8 af = *(const LAS bf16x8*)(lds + GL_K + (16 * st + fr) * 272 + (32 * kk + 8 * fq) * 2);
                    const bf16x8 bfr = *(const LAS bf16x8*)(lds + GL_Q + (16 * tt + fr) * 272 + (32 * kk + 8 * fq) * 2);
                    acc = __builtin_amdgcn_mfma_f32_16x16x32_bf16(af, bfr, acc, 0, 0, 0); }
#pragma unroll
                for (int j = 0; j < 4; ++j) { const int sc = 16 * st + 4 * fq + j, t = 16 * tt + fr; const bool keep = dir == 0 ? (sc <= t) : (sc >= t); acc[j] = keep ? acc[j] : 0.f; }
                at[st] = acc; }
#pragma unroll
            for (int p = 0; p < 2; ++p) { u32x4 pw; pw.x = cvt_pk_bf16(at[2 * p][0], at[2 * p][1]); pw.y = cvt_pk_bf16(at[2 * p][2], at[2 * p][3]);
                pw.z = cvt_pk_bf16(at[2 * p + 1][0], at[2 * p + 1][1]); pw.w = cvt_pk_bf16(at[2 * p + 1][2], at[2 * p + 1][3]); pb[p] = __builtin_bit_cast(bf16x8, pw); }
        }
        {
            f32x4 acc = (f32x4){0.f, 0.f, 0.f, 0.f};
#pragma unroll
            for (int kk = 0; kk < 4; ++kk) { const bf16x8 af = *(const LAS bf16x8*)(lds + GL_ST + (16 * vt + fr) * 272 + (32 * kk + 8 * fq) * 2);
                const bf16x8 bfr = *(const LAS bf16x8*)(lds + GL_Q + (16 * tt + fr) * 272 + (32 * kk + 8 * fq) * 2);
                acc = __builtin_amdgcn_mfma_f32_16x16x32_bf16(af, bfr, acc, 0, 0, 0); }
#pragma unroll
            for (int p = 0; p < 2; ++p) { const bf16x8 af = *(const LAS bf16x8*)(lds + GL_VT + (16 * vt + fr) * 144 + (32 * p + 8 * fq) * 2);
                acc = __builtin_amdgcn_mfma_f32_16x16x32_bf16(af, pb[p], acc, 0, 0, 0); }
            if (s >= 4 || need_ctx) { u32x2 wv; wv.x = cvt_pk_bf16(acc[0], acc[1]); wv.y = cvt_pk_bf16(acc[2], acc[3]);
                *(u32x2*)(od + (size_t)(rb + 16 * tt + fr) * 1024 + 16 * vt + 4 * fq) = wv; }
        }
#pragma unroll
        for (int vt2 = 0; vt2 < 2; ++vt2) { f32x4 acc = sacc[vt2] * dk;
#pragma unroll
            for (int kk = 0; kk < 2; ++kk) { const bf16x8 af = *(const LAS bf16x8*)(lds + GL_VT + (16 * vt2 + fr) * 144 + (32 * kk + 8 * fq) * 2);
                const bf16x8 bfr = *(const LAS bf16x8*)(lds + GL_KH + (16 * w + fr) * 144 + (32 * kk + 8 * fq) * 2);
                acc = __builtin_amdgcn_mfma_f32_16x16x32_bf16(af, bfr, acc, 0, 0, 0); }
            sacc[vt2] = acc; }
        __syncthreads();
#pragma unroll
        for (int vt = 0; vt < 2; ++vt)
#pragma unroll
            for (int j = 0; j < 4; ++j) *(LAS bf16_t*)(lds + GL_ST + (16 * vt + 4 * fq + j) * 272 + (16 * w + fr) * 2) = f2bf(sacc[vt][j]);
      }
    }
    __syncthreads();
#undef GLA_LOADA
#undef GLA_LOADB
}

constexpr int AT_BUF = 36864, AT_K = 0, AT_V = 18432;
template <bool SHIFT>
__device__ __forceinline__ void attn_unit(LAS unsigned char* lds, const bf16_t* qbase, int Lq, int q0, const bf16_t* kbase, const bf16_t* vtbase, int nkeys,
                                          float c2, float lam, float post_scale, const float* subln, const bf16_t* dg, bf16_t* outp, int row0) {
    const int tid = opaque_tid(), lane = tid & 63, w = __builtin_amdgcn_readfirstlane(tid >> 6), q32 = lane & 31, hi = lane >> 5;
    const int j = w >> 2, qg = w & 3;
    bf16x8 qf[4];
#pragma unroll
    for (int kk = 0; kk < 4; ++kk) qf[kk] = *(const bf16x8*)(qbase + ((size_t)j * Lq + q0 + 32 * qg + q32) * 64 + 16 * kk + 8 * hi);
    f32x16 o[4];
#pragma unroll
    for (int vt = 0; vt < 4; ++vt)
#pragma unroll
        for (int r = 0; r < 16; ++r) o[vt][r] = 0.f;
    float lsum = 0.f;
    const int nt = nkeys >> 6;
    u32x4 skA[2], svA[2];
#define AT_LOAD(sk, sv, i) do { _Pragma("unroll") for (int _c = 0; _c < 2; ++_c) { const int _idx = tid + 512 * _c; \
        sk[_c] = *(const u32x4*)(kbase + ((size_t)(_idx >> 9) * LK + 64 * (i) + ((_idx & 511) >> 3)) * 64 + (_idx & 7) * 8); \
        sv[_c] = *(const u32x4*)(vtbase + (size_t)(_idx >> 3) * LK + 64 * (i) + (_idx & 7) * 8); } } while (0)
#define AT_STORE(sk, sv, p) do { _Pragma("unroll") for (int _c = 0; _c < 2; ++_c) { const int _idx = tid + 512 * _c; \
        *(LAS u32x4*)(lds + (p) * AT_BUF + AT_K + ((_idx >> 9) * 64 + ((_idx & 511) >> 3)) * 144 + (_idx & 7) * 16) = sk[_c]; \
        *(LAS u32x4*)(lds + (p) * AT_BUF + AT_V + (_idx >> 3) * 144 + (_idx & 7) * 16) = sv[_c]; } } while (0)
#define AT_KF(kb, kk) (*(const LAS bf16x8*)(Kb + (32 * (kb) + q32) * 144 + (16 * (kk) + 8 * hi) * 2))
#define AT_VF(ks, vt) (*(const LAS bf16x8*)(Vb + (32 * (vt) + q32) * 144 + (16 * (ks) + 8 * hi) * 2))
#define AT_TILE(p) do { \
        LAS unsigned char* Kb = lds + (p) * AT_BUF + AT_K + j * (64 * 144); LAS unsigned char* Vb = lds + (p) * AT_BUF + AT_V; \
        bf16x8 kf[4], vf[4], vg[4]; \
        _Pragma("unroll") for (int kk = 0; kk < 4; ++kk) kf[kk] = AT_KF(0, kk); \
        _Pragma("unroll") for (int kb = 0; kb < 2; ++kb) { \
            _Pragma("unroll") for (int vt = 0; vt < 4; ++vt) vf[vt] = AT_VF(2 * kb, vt); \
            __builtin_amdgcn_sched_barrier(0); \
            f32x16 s; \
            _Pragma("unroll") for (int r = 0; r < 16; ++r) s[r] = 0.f; \
            _Pragma("unroll") for (int kk = 0; kk < 4; ++kk) s = __builtin_amdgcn_mfma_f32_32x32x16_bf16(kf[kk], qf[kk], s, 0, 0, 0); \
            __builtin_amdgcn_sched_barrier(0); \
            _Pragma("unroll") for (int vt = 0; vt < 4; ++vt) vg[vt] = AT_VF(2 * kb + 1, vt); \
            if (kb == 0) { _Pragma("unroll") for (int kk = 0; kk < 4; ++kk) kf[kk] = AT_KF(1, kk); } \
            __builtin_amdgcn_sched_barrier(0); \
            _Pragma("unroll") for (int r = 0; r < 16; ++r) { s[r] = __builtin_amdgcn_exp2f(SHIFT ? s[r] - c2 : s[r]); lsum += s[r]; } \
            u32x4 pw0, pw1; \
            pw0.x = cvt_pk_bf16(s[0], s[1]); pw0.y = cvt_pk_bf16(s[2], s[3]); pw0.z = cvt_pk_bf16(s[4], s[5]); pw0.w = cvt_pk_bf16(s[6], s[7]); \
            pw1.x = cvt_pk_bf16(s[8], s[9]); pw1.y = cvt_pk_bf16(s[10], s[11]); pw1.z = cvt_pk_bf16(s[12], s[13]); pw1.w = cvt_pk_bf16(s[14], s[15]); \
            const bf16x8 pb0 = __builtin_bit_cast(bf16x8, pw0), pb1 = __builtin_bit_cast(bf16x8, pw1); \
            _Pragma("unroll") for (int vt = 0; vt < 4; ++vt) o[vt] = __builtin_amdgcn_mfma_f32_32x32x16_bf16(vf[vt], pb0, o[vt], 0, 0, 0); \
            _Pragma("unroll") for (int vt = 0; vt < 4; ++vt) o[vt] = __builtin_amdgcn_mfma_f32_32x32x16_bf16(vg[vt], pb1, o[vt], 0, 0, 0); \
            __builtin_amdgcn_sched_barrier(0); \
        } } while (0)
    AT_LOAD(skA, svA, 0); AT_STORE(skA, svA, 0);
    __syncthreads();
    for (int i = 0; i < nt; i += 2) {
        AT_LOAD(skA, svA, i + 1);
        AT_TILE(0);
        AT_STORE(skA, svA, 1);
        __syncthreads();
        if (i + 2 < nt) AT_LOAD(skA, svA, i + 2);
        AT_TILE(1);
        if (i + 2 < nt) AT_STORE(skA, svA, 0);
        __syncthreads();
    }
#undef AT_TILE
#undef AT_KF
#undef AT_VF
#undef AT_LOAD
#undef AT_STORE
    lsum += __shfl_xor(lsum, 32);
    LAS float* xch = (LAS float*)lds + (size_t)qg * 4096 + lane;
    if (j == 1) {
        const float sc = lam / lsum;
#pragma unroll
        for (int vt = 0; vt < 4; ++vt)
#pragma unroll
            for (int r = 0; r < 16; ++r) xch[(vt * 16 + r) * 64] = o[vt][r] * sc;
    }
    __syncthreads();
    if (j == 0) {
        const float i0 = 1.f / lsum;
        float ss = 0.f;
#pragma unroll
        for (int vt = 0; vt < 4; ++vt)
#pragma unroll
            for (int r = 0; r < 16; ++r) { const float v = o[vt][r] * i0 - xch[(vt * 16 + r) * 64]; o[vt][r] = v; ss += v * v; }
        ss += __shfl_xor(ss, 32);
        const float rstd = rsqrtf(ss * (1.f / 128.f) + EPS) * post_scale;
        const size_t row = (size_t)row0 + 32 * qg + q32;
#pragma unroll
        for (int vt = 0; vt < 4; ++vt)
#pragma unroll
            for (int g4 = 0; g4 < 4; ++g4) {
                const int v0 = 32 * vt + 8 * g4 + 4 * hi;
                const u32x2 gz = *(const u32x2*)(dg + row * NZ + v0);
                const f32x4 sl = *(const f32x4*)(subln + v0);
                const float r0 = o[vt][4 * g4 + 0] * rstd * sl[0] * silu_f(bflo(gz.x)), r1 = o[vt][4 * g4 + 1] * rstd * sl[1] * silu_f(bfhi(gz.x));
                const float r2 = o[vt][4 * g4 + 2] * rstd * sl[2] * silu_f(bflo(gz.y)), r3 = o[vt][4 * g4 + 3] * rstd * sl[3] * silu_f(bfhi(gz.y));
                u32x2 wv; wv.x = cvt_pk_bf16(r0, r1); wv.y = cvt_pk_bf16(r2, r3);
                *(u32x2*)(outp + row * 1024 + v0) = wv;
            }
    }
    __syncthreads();
}

__device__ __forceinline__ void phase_mix(const Args& a, int l, LAS unsigned char* lds) {
    const int G = opaque_s(gridDim.x);
    unsigned char* ws = opaque_ptr(a.ws);
    const bool need_ctx = (l == 0);
#ifndef NO_GLA
    for (int it = BID; it < 256; it += G) gla_unit(a, l, lds, ((it & 7) * 4 + (it >> 6)) * 8 + ((it >> 3) & 7));
#if defined(REPEAT_SUB) && REPEAT_SUB == 1
    for (int it = BID; it < 256; it += G) gla_unit(a, l, lds, it);
#endif
#endif
#ifndef NO_ATT
    {
        const float* scal = (const float*)(ws + OFF_SCAL) + l * 4;
        const float lam = scal[0], c2 = scal[1], post = 1.f - scal[2];
        const bf16_t* z = (const bf16_t*)(ws + OFF_Z);
        const int nun = 512 + (need_ctx ? 64 : 0);
        const bool big = c2 > 48.f;
#define ATTN_UNIT(...) do { if (big) attn_unit<true>(__VA_ARGS__); else attn_unit<false>(__VA_ARGS__); } while (0)
#if defined(REPEAT_SUB) && REPEAT_SUB == 2
        for (int rep = 0; rep < 2; ++rep)
#endif
        for (int u = BID; u < nun; u += G) {
            if (u < 512) { const int vc = (u & 7) * 64 + (u >> 3), bh = vc >> 4, qb = vc & 15, b = bh >> 3, h = bh & 7;
                ATTN_UNIT(lds, (const bf16_t*)(ws + OFF_QN) + (size_t)bh * 2 * SEQ * 64, SEQ, 128 * qb, (const bf16_t*)(ws + OFF_KN) + (size_t)bh * 2 * LK * 64,
                          (const bf16_t*)(ws + OFF_VT) + (size_t)bh * 128 * LK, LK, c2, lam, post, inp(I_SUBLN) + l * 128, z + ZC_DG + h * 128, (bf16_t*)(ws + OFF_DIFFO) + h * 128, b * SEQ + 128 * qb);
            } else { const int uu = u - 512, bh = uu >> 1, qb = uu & 1, b = bh >> 3, h = bh & 7;
                ATTN_UNIT(lds, (const bf16_t*)(ws + OFF_QNC) + (size_t)bh * 2 * LC * 64, LC, 128 * qb, (const bf16_t*)(ws + OFF_KN) + (size_t)bh * 2 * LK * 64,
                          (const bf16_t*)(ws + OFF_VT) + (size_t)bh * 128 * LK, LC, c2, lam, post, inp(I_SUBLN) + l * 128, z + ZC_DG + h * 128, (bf16_t*)(ws + OFF_DIFFO) + h * 128, ML + b * LC + 128 * qb);
            }
        }
    }
#endif
#ifndef NO_POOL
    {
        const int Mrows = need_ctx ? MT : ML;
        pg8::Gemm g{(const bf16_t*)(ws + OFF_DPOOL), (const bf16_t*)(ws + OFF_POOLT + (size_t)l * SZ_POOLT), Mrows, 1024, 256, 1024, 256, 256};
        pg8::StaticOrder S; S.init(Mrows, 1024, G, BID);
        pg8::EpiPool E{(bf16_t*)(ws + OFF_POOLO), (const bf16_t*)(ws + OFF_PGATE)};
        pg8::gemm_phase<pg8::EpiPool, pg8::StaticOrder, true, true>(lds, g, S, E);
    }
#endif
}

__device__ __forceinline__ void phase_post(const Args& a, int l) {
    const int tid = opaque_tid(), lane = tid & 63, wave = tid >> 6, G = opaque_s(gridDim.x);
    const int gw = BID * 8 + wave, NGW = G * 8;
    unsigned char* ws = opaque_ptr(a.ws);
    const bf16_t* z = (const bf16_t*)(ws + OFF_Z);
    const bf16_t* of = (const bf16_t*)(ws + OFF_OF); const bf16_t* ob = of + (size_t)MT * 1024;
    bf16_t* go = (bf16_t*)(ws + OFF_GLAO);
    const int Mrows = (l == 0) ? MT : ML;
    const float* gn = inp(I_GLAN) + l * 256 + ((16 * lane) & 255);
    for (int row = gw; row < Mrows; row += NGW) {
        float x[16], y[16], gz[16];
        const size_t o = (size_t)row * 1024 + 16 * lane;
        unpack8(*(const u32x4*)(of + o), x); unpack8(*(const u32x4*)(of + o + 8), x + 8);
        unpack8(*(const u32x4*)(ob + o), y); unpack8(*(const u32x4*)(ob + o + 8), y + 8);
        unpack8(*(const u32x4*)(z + (size_t)row * NZ + ZC_GG + 16 * lane), gz); unpack8(*(const u32x4*)(z + (size_t)row * NZ + ZC_GG + 16 * lane + 8), gz + 8);
        float ss = 0.f;
#pragma unroll
        for (int e = 0; e < 16; ++e) { x[e] += y[e]; ss += x[e] * x[e]; }
        ss += __shfl_xor(ss, 1); ss += __shfl_xor(ss, 2); ss += __shfl_xor(ss, 4); ss += __shfl_xor(ss, 8);
        const float rstd = rsqrtf(ss * (1.f / 256.f) + EPS);
        float r[16];
#pragma unroll
        for (int e = 0; e < 16; ++e) r[e] = x[e] * rstd * gn[e] * silu_f(gz[e]);
        u32x4 w0, w1;
        w0.x = cvt_pk_bf16(r[0], r[1]); w0.y = cvt_pk_bf16(r[2], r[3]); w0.z = cvt_pk_bf16(r[4], r[5]); w0.w = cvt_pk_bf16(r[6], r[7]);
        w1.x = cvt_pk_bf16(r[8], r[9]); w1.y = cvt_pk_bf16(r[10], r[11]); w1.z = cvt_pk_bf16(r[12], r[13]); w1.w = cvt_pk_bf16(r[14], r[15]);
        *(u32x4*)(go + o) = w0; *(u32x4*)(go + o + 8) = w1;
    }
}

#define XB_TMO      128
#define XB_XCNT(j)  (256  + 64 * (j))
#define XB_XSUB(j)  (1280 + 64 * (j))
#define XB_XGEN(j)  (2304 + 64 * (j))
#define XB_TOP      3328
#define XB_TOPGEN   3392
#define XCD_BAR_WORDS 3456
#define XB_SPIN_CAP (1u << 18)

__device__ __forceinline__ unsigned xb_ld(unsigned* p)              { return __hip_atomic_load(p, __ATOMIC_RELAXED, __HIP_MEMORY_SCOPE_AGENT); }
__device__ __forceinline__ unsigned xb_add(unsigned* p, unsigned v) { return __hip_atomic_fetch_add(p, v, __ATOMIC_RELAXED, __HIP_MEMORY_SCOPE_AGENT); }
__device__ __forceinline__ unsigned xb_xcc_id() { return (unsigned)__builtin_amdgcn_s_getreg((3 << 11) | 20) & 0xFu; }
#define XB_SPIN(cond, bar) do { unsigned _sp = 0; while (cond) { __builtin_amdgcn_s_sleep(1); \
    if ((++_sp & 255u) == 0u) { if (xb_ld(&(bar)[XB_TMO])) break; if (_sp > XB_SPIN_CAP) { atomicAdd(&(bar)[XB_TMO], 1u); break; } } } } while (0)

struct XcdBarrier {
    unsigned* bar; unsigned x;
    volatile LAS unsigned* st;
};

__device__ __forceinline__ XcdBarrier xcd_barrier_post(unsigned* bar, volatile LAS unsigned* st) {
    XcdBarrier b; b.bar = bar; b.x = xb_xcc_id(); b.st = st;
    if (threadIdx.x == 0) (void)xb_add(&bar[XB_XCNT(b.x)], 1u);
    return b;
}
__device__ __forceinline__ void xcd_barrier_complete(unsigned* bar, unsigned x, unsigned& nloc, unsigned& nx) {
    const unsigned G = gridDim.x * gridDim.y * gridDim.z;
    unsigned sum, cnt, mine, sp = 0u;
    for (;;) {
        sum = 0u; cnt = 0u; mine = 0u;
#pragma unroll
        for (unsigned j = 0; j < 16; ++j) { const unsigned c = xb_ld(&bar[XB_XCNT(j)]); sum += c; cnt += (c > 0u) ? 1u : 0u; mine = (j == x) ? c : mine; }
        if (sum == G) break;
        __builtin_amdgcn_s_sleep(1);
        if ((++sp & 255u) == 0u) { if (xb_ld(&bar[XB_TMO])) break; if (sp > XB_SPIN_CAP) { atomicAdd(&bar[XB_TMO], 1u); break; } }
    }
    nloc = mine > 0u ? mine : 1u; nx = cnt > 0u ? cnt : 1u;
}

__device__ __forceinline__ void xcd_barrier(const XcdBarrier& b) {
    asm volatile("s_waitcnt vmcnt(0)" ::: "memory");
    __syncthreads();
    if (threadIdx.x == 0) {
        unsigned* bar = b.bar;
        __builtin_amdgcn_s_waitcnt(0);
        unsigned nloc = b.st[0], nx = b.st[1];
        if (nloc == 0u) { xcd_barrier_complete(bar, b.x, nloc, nx); b.st[0] = nloc; b.st[1] = nx; }
        const unsigned old = xb_add(&bar[XB_XSUB(b.x)], 1u);
        const unsigned gen = old / nloc;
        if (old + 1u == (gen + 1u) * nloc) {
            __builtin_amdgcn_fence(__ATOMIC_RELEASE, "agent");
            asm volatile("s_waitcnt vmcnt(0)" ::: "memory");
            const unsigned og = xb_add(&bar[XB_TOP], 1u);
            const unsigned tg = og / nx;
            if (og + 1u == (tg + 1u) * nx) xb_add(&bar[XB_TOPGEN], 1u);
            else XB_SPIN(xb_ld(&bar[XB_TOPGEN]) == tg, bar);
            __builtin_amdgcn_fence(__ATOMIC_ACQUIRE, "agent");
            xb_add(&bar[XB_XGEN(b.x)], 1u);
            asm volatile("s_waitcnt vmcnt(0)" ::: "memory");
        } else {
            XB_SPIN(xb_ld(&bar[XB_XGEN(b.x)]) == gen, bar);
            __builtin_amdgcn_fence(__ATOMIC_ACQUIRE, "agent");
            asm volatile("s_waitcnt vmcnt(0)" ::: "memory");
        }
    }
    __syncthreads();
}

#ifndef REPEAT_K
#define REPEAT_K -1
#endif
#define SEAM() do { XcdBarrier xb; xb.bar = (unsigned*)(opaque_ptr(a.ws) + OFF_BAR); xb.x = xb_xcc_id(); xb.st = (volatile LAS unsigned*)(lds + 131072 + 512); xcd_barrier(xb); } while (0)
#define REP(k) for (int rep_ = 0; rep_ < (REPEAT_K == (k) ? 2 : 1); ++rep_)
template <int l> __device__ __forceinline__ void run_layer(const Args& a, LAS unsigned char* lds) {
    constexpr int Mout = (l == 0) ? MT : ML;
    REP(0) phase_norm(a, l);
    SEAM();
    REP(1) {
        unsigned char* ws = opaque_ptr(a.ws); const int G = opaque_s(gridDim.x);
        pg8::Gemm g{(const bf16_t*)(ws + OFF_H), (const bf16_t*)(ws + OFF_WIN + (size_t)l * SZ_WIN), MT, NZ, DM, DM, DM, 0};
        pg8::EpiBf16 E{(bf16_t*)(ws + OFF_Z), NZ};
        if (l == 0) { pg8::StaticOrder S; S.init(MT, NZ, G, BID); pg8::gemm_phase<pg8::EpiBf16, pg8::StaticOrder, true, true>(lds, g, S, E);
 }
        else { pg8::CtxSkipOrder S; S.init(G, BID); pg8::gemm_phase<pg8::EpiBf16, pg8::CtxSkipOrder, true, true>(lds, g, S, E); }
    }
    SEAM();
    REP(2) phase_prep(a, l, lds);
    SEAM();
    REP(3) phase_mix(a, l, lds);
    SEAM();
    REP(4) phase_post(a, l);
    SEAM();
    REP(5) {
        unsigned char* ws = opaque_ptr(a.ws); const int G = opaque_s(gridDim.x);
        pg8::SegOrder3 S; S.base.init(Mout, DM, G, BID);
        const bf16_t* wb = (const bf16_t*)(ws + OFF_WB + (size_t)l * SZ_WB);
        pg8::Gemm g{(const bf16_t*)(ws + OFF_POOLO), wb, Mout, DM, 1024, 1024, 1024, 0,
                    (const bf16_t*)(ws + OFF_DIFFO), (const bf16_t*)(ws + OFF_GLAO), wb + (size_t)DM * 1024, wb + (size_t)2 * DM * 1024};
        pg8::EpiMerge3 E{(bf16_t*)(ws + OFF_H), (const bf16_t*)(ws + OFF_Z) + ZC_MG};
        pg8::gemm_phase<pg8::EpiMerge3, pg8::SegOrder3, true, true, 3>(lds, g, S, E);
        if (l == 0 && rep_ == 0) {
            const int rem = ((Mout / 256) * (DM / 256)) % G, bid = BID;
            if (rem == 0) { ada_items(a, lds, 1, bid, G); convert_layer_weights(a, lds, 1, bid * 8 + (int)(threadIdx.x >> 6), G * 8); }
            else if (bid >= rem) { ada_items(a, lds, 1, G - 1 - bid, G - rem); convert_layer_weights(a, lds, 1, (bid - rem) * 8 + (int)(threadIdx.x >> 6), (G - rem) * 8); }
        }
    }
    SEAM();
    REP(6) {
        unsigned char* ws = opaque_ptr(a.ws); const int G = opaque_s(gridDim.x);
        pg8::Gemm g{(const bf16_t*)(ws + OFF_H), (const bf16_t*)(ws + OFF_WOUT + (size_t)l * SZ_WOUT), Mout, DM, DM, DM, DM, 0};
        pg8::StaticOrder S; S.init(Mout, DM, G, BID);
        pg8::EpiOut E{l == 0 ? inp(I_X) : (const float*)(ws + OFF_X1), l == 0 ? inp(I_CTX) : (const float*)(ws + OFF_X1) + (size_t)ML * DM,
                      l == 0 ? (float*)(ws + OFF_X1) : arg_out(), (const float*)(ws + OFF_MOD) + (size_t)l * 5 * 6144};
        pg8::gemm_phase<pg8::EpiOut, pg8::StaticOrder, true, true>(lds, g, S, E);
    }
}

__global__ void __launch_bounds__(512, 2) hybrid_fwd(Args a) {
    extern __shared__ __attribute__((aligned(16))) unsigned char smem[];
    LAS unsigned char* lds = (LAS unsigned char*)smem;
    cg::grid_group grid = cg::this_grid();
    volatile LAS unsigned* bst = (volatile LAS unsigned*)(lds + 131072 + 512);
    if (threadIdx.x < 2) bst[threadIdx.x] = 0u;
    __syncthreads();
    (void)xcd_barrier_post((unsigned*)(a.ws + OFF_BAR), bst);
    REP(7) phase_p0(a, lds);
    grid.sync();
    run_layer<0>(a, lds);
    SEAM();
    run_layer<1>(a, lds);
}

extern "C" void kernel_launch(void* const* d_in, const int* in_sizes, int n_in, void* d_out, int out_size, void* d_ws, size_t ws_size, hipStream_t stream) {
    static int grid = 0;
    if (grid == 0) {
        if (n_in != 26 || out_size != ML * DM || ws_size < WS_END) { fprintf(stderr, "kernel_launch: expected 26 inputs, out %d, ws >= %zu; got n_in %d out %d ws %zu\n", ML * DM, (size_t)WS_END, n_in, out_size, ws_size); grid = -1; return; }
        int dev = 0, cus = 0, per_cu = 0;
        if (hipGetDevice(&dev) != hipSuccess || hipDeviceGetAttribute(&cus, hipDeviceAttributeMultiprocessorCount, dev) != hipSuccess) { grid = -1; return; }
        if (hipFuncSetAttribute((const void*)hybrid_fwd, hipFuncAttributeMaxDynamicSharedMemorySize, LDS_BYTES) != hipSuccess) { fprintf(stderr, "kernel_launch: hipFuncSetAttribute failed\n"); grid = -1; return; }
        if (hipOccupancyMaxActiveBlocksPerMultiprocessor(&per_cu, (const void*)hybrid_fwd, 512, LDS_BYTES) != hipSuccess || per_cu < 1) { fprintf(stderr, "kernel_launch: occupancy query says %d blocks per CU\n", per_cu); (void)hipGetLastError(); grid = -1; return; }
        grid = cus;
    }
    if (grid < 0) return;
    if (hipMemsetAsync((char*)d_ws + OFF_BAR, 0, BAR_BYTES, stream) != hipSuccess) { fprintf(stderr, "kernel_launch: memset of the barrier words failed\n"); return; }
    Args a{};
    for (int i = 0; i < 26; ++i) a.in[i] = (const float*)d_in[i];
    a.out = (float*)d_out; a.ws = (unsigned char*)d_ws;
    a.ph_lo = 0; a.ph_hi = NPH;
    void* args[] = {&a};
    const hipError_t e = hipLaunchCooperativeKernel((const void*)hybrid_fwd, dim3(grid), dim3(512), args, LDS_BYTES, stream);
    if (e != hipSuccess) fprintf(stderr, "kernel_launch: cooperative launch failed: %s (grid %d)\n", hipGetErrorString(e), grid);
}
```

```cpp
#include <hip/hip_runtime.h>
#include <hip/hip_cooperative_groups.h>
#include <cstdio>
#include <cstdint>
namespace cg = cooperative_groups;

#ifndef MK_N_LAUNCHES
#define MK_N_LAUNCHES 1
#endif

#define LAS __attribute__((address_space(3)))
typedef unsigned short bf16_t;
typedef short bf16x8 __attribute__((ext_vector_type(8)));
typedef float f32x4 __attribute__((ext_vector_type(4)));
typedef float f32x16 __attribute__((ext_vector_type(16)));
typedef unsigned u32x4 __attribute__((ext_vector_type(4)));
typedef unsigned u32x2 __attribute__((ext_vector_type(2)));

constexpr int DM = 2048, NB = 4, SEQ = 2048, LC = 256, ML = NB * SEQ, MC = NB * LC, MT = ML + MC;
constexpr int DIN = 15392, NZ = 15616;
constexpr int ZC_PU = 0, ZC_PG = 1024, ZC_DQ = 2048, ZC_DK = 3072, ZC_DV = 4096, ZC_DG = 5120, ZC_GQ = 6144, ZC_GK = 6656, ZC_GV = 7168, ZC_GG = 8192, ZC_LR = 9216, ZC_MG = 9472;
constexpr int LK = LC + SEQ;
constexpr float EPS = 1e-6f, LOG2E = 1.4426950408889634f;
constexpr int NPH = 15;

constexpr size_t SZ_WIN = (size_t)NZ * DM * 2, SZ_WB = (size_t)3 * DM * 1024 * 2, SZ_WOUT = (size_t)DM * DM * 2, SZ_POOLT = (size_t)4 * 256 * 256 * 2;
constexpr size_t OFF_WIN = 0;
constexpr size_t OFF_WB = OFF_WIN + 2 * SZ_WIN;
constexpr size_t OFF_WOUT = OFF_WB + 2 * SZ_WB;
constexpr size_t OFF_POOLT = OFF_WOUT + 2 * SZ_WOUT;
constexpr size_t OFF_MOD = OFF_POOLT + 2 * SZ_POOLT;
constexpr size_t OFF_SCAL = OFF_MOD + (size_t)2 * 5 * 6144 * 4;
constexpr size_t OFF_H = OFF_SCAL + 256;
constexpr size_t OFF_Z = OFF_H + (size_t)MT * DM * 2;
constexpr size_t OFF_QN = OFF_Z + (size_t)MT * NZ * 2;
constexpr size_t OFF_QNC = OFF_QN + (size_t)ML * 1024 * 2;
constexpr size_t OFF_KN = OFF_QNC + (size_t)MC * 1024 * 2;
constexpr size_t OFF_VT = OFF_KN + (size_t)MT * 1024 * 2;
constexpr size_t SZ_G = (size_t)MT * 512 * 2;
constexpr size_t OFF_GQ = OFF_VT + (size_t)MT * 1024 * 2;
constexpr size_t OFF_GK = OFF_GQ + 2 * SZ_G;
constexpr size_t OFF_GH = OFF_GK + 2 * SZ_G;
constexpr size_t OFF_DEC = OFF_GH + 2 * SZ_G;
constexpr size_t OFF_OF = OFF_DEC + (size_t)2 * 144 * 512 * 4;
constexpr size_t OFF_DPOOL = OFF_OF + 2 * (size_t)MT * 1024 * 2;
constexpr size_t OFF_POOLO = OFF_DPOOL + (size_t)MT * 1024 * 2;
constexpr size_t OFF_DIFFO = OFF_POOLO + (size_t)MT * 1024 * 2;
constexpr size_t OFF_GLAO = OFF_DIFFO + (size_t)MT * 1024 * 2;
constexpr size_t OFF_YACC = OFF_GLAO + (size_t)MT * 1024 * 2;
constexpr size_t OFF_X1 = OFF_YACC + (size_t)MT * DM * 4;
constexpr size_t OFF_PGATE = OFF_X1 + (size_t)MT * DM * 4;
constexpr size_t OFF_BAR = OFF_PGATE + (size_t)MT * 1024 * 2;
constexpr size_t BAR_BYTES = 16384;
constexpr size_t OFF_GVT = OFF_BAR + BAR_BYTES;
constexpr size_t WS_END = OFF_GVT + (size_t)MT * 1024 * 2;

constexpr int LDS_BYTES = 135168;

#define BID opaque_s((int)blockIdx.x)
#define GAS __attribute__((address_space(1)))
__device__ __forceinline__ unsigned char* opaque_ptr(unsigned char* p) { GAS unsigned char* q = (GAS unsigned char*)p; asm volatile("" : "+s"(q)); return (unsigned char*)q; }
__device__ __forceinline__ int opaque_s(int v) { asm volatile("" : "+s"(v)); return v; }
__device__ __forceinline__ int opaque_tid() { int t = threadIdx.x; asm volatile("" : "+v"(t)); return t; }
typedef float f32x2_t __attribute__((ext_vector_type(2))); typedef __bf16 bf16x2_t __attribute__((ext_vector_type(2)));
__device__ __forceinline__ unsigned cvt_pk_bf16(float lo, float hi) { f32x2_t v = {lo, hi}; bf16x2_t b = __builtin_convertvector(v, bf16x2_t); return __builtin_bit_cast(unsigned, b); }
__device__ __forceinline__ bf16_t f2bf(float f) { return (bf16_t)(cvt_pk_bf16(f, 0.f) & 0xffffu); }
__device__ __forceinline__ float bf2f(bf16_t v) { return __builtin_bit_cast(float, (unsigned)v << 16); }
__device__ __forceinline__ float bflo(unsigned u) { return __builtin_bit_cast(float, u << 16); }
__device__ __forceinline__ float bfhi(unsigned u) { return __builtin_bit_cast(float, u & 0xffff0000u); }
__device__ __forceinline__ float silu_f(float x) { return x * __builtin_amdgcn_rcpf(1.f + __expf(-x)); }
__device__ __forceinline__ float sigmoid_f(float x) { return __builtin_amdgcn_rcpf(1.f + __expf(-x)); }
__device__ __forceinline__ float logsig_f(float a) { return fminf(a, 0.f) - __logf(1.f + __expf(-fabsf(a))); }
__device__ __forceinline__ float wave_sum(float v) {
#pragma unroll
    for (int o = 1; o < 64; o <<= 1) v += __shfl_xor(v, o);
    return v;
}
__device__ __forceinline__ float wave_max(float v) {
#pragma unroll
    for (int o = 1; o < 64; o <<= 1) v = fmaxf(v, __shfl_xor(v, o));
    return v;
}
__device__ __forceinline__ void unpack8(u32x4 w, float* f) { f[0] = bflo(w.x); f[1] = bfhi(w.x); f[2] = bflo(w.y); f[3] = bfhi(w.y); f[4] = bflo(w.z); f[5] = bfhi(w.z); f[6] = bflo(w.w); f[7] = bfhi(w.w); }

namespace pg8 {
constexpr int BM = 256, BK = 64, HALF = 128, HTB = HALF * BK * 2, STAGE_BYTES = 8 * HTB, NXCD = 8, WGM = 8;
__host__ __device__ __forceinline__ int lds_byte(int r, int c) { const int st = (r >> 4) * 2 + (c >> 5), rr = r & 15, cc = c & 31, ob = rr * 64 + cc * 2; return st * 1024 + (ob ^ (((ob >> 9) & 1) << 5)); }
__host__ __device__ __forceinline__ void stage_rc(int b, int& R, int& C) { const int st = b / 1024, sb = b % 1024, swz = sb ^ (((sb >> 9) & 1) << 5); R = (st >> 1) * 16 + swz / 64; C = (st & 1) * 32 + (swz % 64) / 2; }
__host__ __device__ __forceinline__ int perm32(int rho) { const int n = rho >> 4, i = rho & 15; return 8 * (i >> 2) + 4 * n + (i & 3); }

struct Unit { int pm, pn, seg; };
struct Gemm { const bf16_t* A; const bf16_t* Bt; int M, N, K; int lda, ldb; int a_pn_off; const bf16_t* A1; const bf16_t* A2; const bf16_t* B1; const bf16_t* B2; };

struct StaticOrder {
    int nM, nN, nwg, G, c;
    __host__ __device__ void init(int M, int N, int G_, int c_) { nM = M / BM; nN = N / BM; nwg = nM * nN; G = G_; c = c_; }
    __host__ __device__ bool next(int i, Unit& u) const {
        const long L = (long)i * G + c; if (L >= nwg) return false;
        int wgid = (int)L; { const int q = nwg / NXCD, r = nwg % NXCD, xcd = wgid % NXCD, off = wgid / NXCD; wgid = (xcd < r ? xcd * (q + 1) : r * (q + 1) + (xcd - r) * q) + off; }
        const int nig = WGM * nN, gid = wgid / nig, fm = gid * WGM, gsz = (nM - fm) < WGM ? (nM - fm) : WGM;
        u.pm = fm + ((wgid % nig) % gsz); u.pn = (wgid % nig) / gsz; u.seg = 0; return true;
    }
    __device__ __forceinline__ void a_ready(const Unit&) const {}
    __device__ __forceinline__ void done(const Unit&) const {}
};

struct CtxSkipOrder {
    StaticOrder base; int nbase;
    __host__ __device__ void init(int G_, int c_) { base.init(ML, NZ, G_, c_); nbase = base.nwg; }
    __host__ __device__ bool next(int i, Unit& u) const {
        const long L = (long)i * base.G + base.c;
        if (L < nbase) return base.next(i, u);
        const int e = (int)(L - nbase); if (e >= 4 * 15) return false;
        const int j = e % 15; u.pm = 32 + e / 15; u.pn = j < 8 ? 12 + j : (j < 14 ? 18 + j : 36); u.seg = 0; return true;
    }
    __device__ __forceinline__ void a_ready(const Unit&) const {}
    __device__ __forceinline__ void done(const Unit&) const {}
};
struct SegOrder3 {
    StaticOrder base;
    __host__ __device__ bool next(int i, Unit& u) const { const int q = i / 3; if (!base.next(q, u)) return false; u.seg = i - 3 * q; return true; }
    __device__ __forceinline__ void a_ready(const Unit&) const {}
    __device__ __forceinline__ void done(const Unit&) const {}
};
struct EpiBf16 {
    static constexpr bool PERM = true, AFTER_DRAIN = false;
    bf16_t* O; int ldc;
    __device__ __forceinline__ void operator()(const f32x4 (&acc)[2][2][4][2], const Unit& u, int wr, int wc, int fr, int fq) const {
        const int row0 = u.pm * BM + wr * 64 + fr, col0 = u.pn * BM + wc * 32 + 8 * fq;
#pragma unroll
        for (int ai = 0; ai < 2; ++ai)
#pragma unroll
            for (int m = 0; m < 4; ++m) { bf16_t* rowp = O + (size_t)(row0 + ai * HALF + m * 16) * ldc + col0;
#pragma unroll
                for (int bj = 0; bj < 2; ++bj) { const f32x4 v0 = acc[ai][bj][m][0], v1 = acc[ai][bj][m][1];
                    u32x4 w; w.x = cvt_pk_bf16(v0[0], v0[1]); w.y = cvt_pk_bf16(v0[2], v0[3]); w.z = cvt_pk_bf16(v1[0], v1[1]); w.w = cvt_pk_bf16(v1[2], v1[3]);
                    *(u32x4*)(rowp + bj * HALF) = w; } }
    }
};

template <class Epi, class Sched, bool ALIGN_EPI = false, bool SP2 = false, int NSEG = 1>
__device__ __forceinline__ void gemm_phase(LAS unsigned char* lds, const Gemm g, const Sched& S, const Epi& E) {
    const int tid = opaque_tid(), wid = __builtin_amdgcn_readfirstlane(tid >> 6), lane = tid & 63, wr = wid >> 2, wc = wid & 3, fr = lane & 15, fq = lane >> 4;
    const int K = opaque_s(g.K), nt = K / BK;
    unsigned voffA[2], voffB[2];
#pragma unroll
    for (int i = 0; i < 2; ++i) { int R, C; stage_rc(tid * 16 + i * 8192, R, C); const int Rb = Epi::PERM ? ((R & ~31) + perm32(R & 31)) : R;
        voffA[i] = (unsigned)(R * g.lda + C) * 2u; voffB[i] = (unsigned)(Rb * g.ldb + C) * 2u; }
    const size_t kstep = (size_t)(BK * 2);
    const size_t hstepA = (size_t)HALF * g.lda * 2, hstepB = (size_t)HALF * g.ldb * 2;
    const size_t tstepA = 2 * hstepA, tstepB = 2 * hstepB;
    const size_t pnA = (size_t)g.a_pn_off * 2;
    const unsigned ldsw = (unsigned)wid * 1024u;
    const int aoff = lds_byte(wr * 64 + fr, fq * 8), boff = lds_byte(wc * 32 + fr, fq * 8);
#define PG8_SA(b, h) (((b) * 2 + (h)) * HTB)
#define PG8_SB(b, h) ((4 + (b) * 2 + (h)) * HTB)
#define PG8_STAGE(bufoff, gbase, voff) do { _Pragma("unroll") for (int _i = 0; _i < 2; ++_i) \
        __builtin_amdgcn_global_load_lds((const unsigned*)((const char*)(gbase) + (voff)[_i]), (LAS unsigned*)(lds + (bufoff) + ldsw + _i * 8192), 16, 0, 0); } while (0)
#define PG8_LDA(dst, b, h) do { _Pragma("unroll") for (int m = 0; m < 4; ++m) _Pragma("unroll") for (int k = 0; k < 2; ++k) dst[m][k] = *(const LAS bf16x8*)(lds + PG8_SA(b, h) + aoff + m * 2048 + k * 1024); } while (0)
#define PG8_LDB(dst, b, h) do { _Pragma("unroll") for (int n = 0; n < 2; ++n) _Pragma("unroll") for (int k = 0; k < 2; ++k) dst[n][k] = *(const LAS bf16x8*)(lds + PG8_SB(b, h) + boff + n * 2048 + k * 1024); } while (0)
#define PG8_MMA(ai, bj, At, Bt) do { __builtin_amdgcn_s_setprio(1); _Pragma("unroll") for (int m = 0; m < 4; ++m) _Pragma("unroll") for (int n = 0; n < 2; ++n) _Pragma("unroll") for (int k = 0; k < 2; ++k) \
        acc[ai][bj][m][n] = __builtin_amdgcn_mfma_f32_16x16x32_bf16(Bt[n][k], At[m][k], acc[ai][bj][m][n], 0, 0, 0); __builtin_amdgcn_s_setprio(0); } while (0)
#define PG8_WAIT_V(n) asm volatile("s_waitcnt vmcnt(" #n ")" ::: "memory")
#define PG8_WAIT_L(n) asm volatile("s_waitcnt lgkmcnt(" #n ")" ::: "memory")
#define PG8_BAR __builtin_amdgcn_s_barrier()
#define PG8_SCHED __builtin_amdgcn_sched_barrier(0)
    Unit cur, nxt; int ui = 0;
    if (!S.next(0, cur)) return;
    f32x4 acc[2][2][4][2];
#pragma unroll
    for (int a = 0; a < 2; ++a)
#pragma unroll
        for (int b = 0; b < 2; ++b)
#pragma unroll
            for (int m = 0; m < 4; ++m)
#pragma unroll
                for (int n = 0; n < 2; ++n) acc[a][b][m][n] = (f32x4){0.f, 0.f, 0.f, 0.f};
    bf16x8 At[4][2], B0[2][2], B1[2][2];
#define PG8_ASEG(u) ((const char*)(NSEG == 1 || (u).seg == 0 ? g.A : ((u).seg == 1 ? g.A1 : g.A2)))
#define PG8_BSEG(u) ((const char*)(NSEG == 1 || (u).seg == 0 ? g.Bt : ((u).seg == 1 ? g.B1 : g.B2)))
    const char* cA = PG8_ASEG(cur) + (size_t)cur.pm * tstepA + (size_t)cur.pn * pnA; const char* cB = PG8_BSEG(cur) + (size_t)cur.pn * tstepB;
    S.a_ready(cur);
    if constexpr (SP2) {
        PG8_STAGE(PG8_SB(0, 0), cB, voffB); PG8_STAGE(PG8_SB(0, 1), cB + hstepB, voffB); PG8_STAGE(PG8_SA(0, 0), cA, voffA); PG8_STAGE(PG8_SA(0, 1), cA + hstepA, voffA);
        if (wr == 1) PG8_BAR;
        PG8_WAIT_V(2); PG8_BAR;
        PG8_STAGE(PG8_SB(1, 0), cB + kstep, voffB); PG8_STAGE(PG8_SA(1, 0), cA + kstep, voffA); PG8_STAGE(PG8_SB(1, 1), cB + hstepB + kstep, voffB);
        PG8_WAIT_V(6); PG8_BAR;
    } else {
        PG8_STAGE(PG8_SB(0, 0), cB, voffB); PG8_STAGE(PG8_SA(0, 0), cA, voffA); PG8_STAGE(PG8_SB(0, 1), cB + hstepB, voffB); PG8_STAGE(PG8_SA(0, 1), cA + hstepA, voffA);
        if (wr == 1) PG8_BAR;
        PG8_WAIT_V(4); PG8_BAR;
        PG8_STAGE(PG8_SB(1, 0), cB + kstep, voffB); PG8_STAGE(PG8_SA(1, 0), cA + kstep, voffA); PG8_STAGE(PG8_SB(1, 1), cB + hstepB + kstep, voffB);
        PG8_WAIT_V(6); PG8_BAR;
    }
    for (;;) {
        const bool has_next = S.next(ui + 1, nxt);
        const char* nA = has_next ? PG8_ASEG(nxt) + (size_t)nxt.pm * tstepA + (size_t)nxt.pn * pnA : cA; const char* nB = has_next ? PG8_BSEG(nxt) + (size_t)nxt.pn * tstepB : cB;
        for (int t = 0; t < nt; t += 2) {
            const bool last = (t == nt - 2);
            const char* a1 = cA + (size_t)(t + 1) * kstep;
            const char* a2 = last ? nA : cA + (size_t)(t + 2) * kstep; const char* b2 = last ? nB : cB + (size_t)(t + 2) * kstep;
            const char* a3 = a2 + kstep; const char* b3 = b2 + kstep;
            if (last && has_next) S.a_ready(nxt);
            if constexpr (SP2) {
            PG8_LDB(B0, 0, 0); PG8_LDB(B1, 0, 1); PG8_SCHED; PG8_LDA(At, 0, 0); PG8_STAGE(PG8_SA(1, 1), a1 + hstepA, voffA);
            PG8_WAIT_V(8); PG8_WAIT_L(0); PG8_BAR; PG8_MMA(0, 0, At, B0); PG8_MMA(0, 1, At, B1); PG8_BAR; PG8_SCHED;
            PG8_LDA(At, 0, 1); PG8_STAGE(PG8_SB(0, 0), b2, voffB); PG8_STAGE(PG8_SB(0, 1), b2 + hstepB, voffB); PG8_STAGE(PG8_SA(0, 0), a2, voffA);
            PG8_WAIT_V(8); PG8_WAIT_L(0); PG8_BAR; PG8_MMA(1, 0, At, B0); PG8_MMA(1, 1, At, B1); PG8_BAR; PG8_SCHED;
            PG8_LDB(B0, 1, 0); PG8_LDB(B1, 1, 1); PG8_SCHED; PG8_LDA(At, 1, 0); PG8_STAGE(PG8_SA(0, 1), a2 + hstepA, voffA);
            PG8_WAIT_V(8); PG8_WAIT_L(0); PG8_BAR; PG8_MMA(0, 0, At, B0); PG8_MMA(0, 1, At, B1); PG8_BAR; PG8_SCHED;
            PG8_LDA(At, 1, 1); PG8_STAGE(PG8_SB(1, 0), b3, voffB); PG8_STAGE(PG8_SB(1, 1), b3 + hstepB, voffB); PG8_STAGE(PG8_SA(1, 0), a3, voffA);
            PG8_WAIT_V(8); PG8_WAIT_L(0); PG8_BAR; PG8_MMA(1, 0, At, B0); PG8_MMA(1, 1, At, B1); PG8_BAR; PG8_SCHED;
            } else {
            PG8_LDB(B0, 0, 0); PG8_SCHED; PG8_LDA(At, 0, 0); PG8_STAGE(PG8_SA(1, 1), a1 + hstepA, voffA);
            PG8_WAIT_L(8); PG8_BAR; PG8_WAIT_L(0); PG8_MMA(0, 0, At, B0); PG8_BAR; PG8_SCHED;
            PG8_LDB(B1, 0, 1); PG8_STAGE(PG8_SB(0, 0), b2, voffB);
            PG8_BAR; PG8_WAIT_L(0); PG8_MMA(0, 1, At, B1); PG8_BAR;
            PG8_LDA(At, 0, 1); PG8_STAGE(PG8_SA(0, 0), a2, voffA);
            PG8_BAR; PG8_WAIT_L(0); PG8_MMA(1, 0, At, B0); PG8_BAR; PG8_SCHED;
            PG8_STAGE(PG8_SB(0, 1), b2 + hstepB, voffB);
            PG8_WAIT_V(6); PG8_BAR; PG8_MMA(1, 1, At, B1); PG8_BAR;
            PG8_LDB(B0, 1, 0); PG8_SCHED; PG8_LDA(At, 1, 0); PG8_STAGE(PG8_SA(0, 1), a2 + hstepA, voffA);
            PG8_WAIT_L(8); PG8_BAR; PG8_WAIT_L(0); PG8_MMA(0, 0, At, B0); PG8_BAR; PG8_SCHED;
            PG8_LDB(B1, 1, 1); PG8_STAGE(PG8_SB(1, 0), b3, voffB);
            PG8_BAR; PG8_WAIT_L(0); PG8_MMA(0, 1, At, B1); PG8_BAR;
            PG8_LDA(At, 1, 1); PG8_STAGE(PG8_SA(1, 0), a3, voffA);
            PG8_BAR; PG8_WAIT_L(0); PG8_MMA(1, 0, At, B0); PG8_BAR; PG8_SCHED;
            PG8_STAGE(PG8_SB(1, 1), b3 + hstepB, voffB);
            PG8_WAIT_V(6); PG8_BAR; PG8_MMA(1, 1, At, B1); PG8_BAR;
            }
        }
        if constexpr (ALIGN_EPI) { if (wr == 0) PG8_BAR; }
        E(acc, cur, wr, wc, fr, fq); S.done(cur);
        if (!has_next) break;
        if (NSEG == 1 || cur.seg == NSEG - 1)
#pragma unroll
        for (int a = 0; a < 2; ++a)
#pragma unroll
            for (int b = 0; b < 2; ++b)
#pragma unroll
                for (int m = 0; m < 4; ++m)
#pragma unroll
                    for (int n = 0; n < 2; ++n) acc[a][b][m][n] = (f32x4){0.f, 0.f, 0.f, 0.f};
        cur = nxt; cA = nA; cB = nB; ++ui;
        if constexpr (ALIGN_EPI) { if (wr == 1) PG8_BAR; }
    }
    PG8_WAIT_V(0);
    if constexpr (!ALIGN_EPI) { if (wr == 0) PG8_BAR; }
    PG8_BAR;
#undef PG8_ASEG
#undef PG8_BSEG
#undef PG8_SA
#undef PG8_SB
#undef PG8_STAGE
#undef PG8_LDA
#undef PG8_LDB
#undef PG8_MMA
#undef PG8_WAIT_V
#undef PG8_WAIT_L
#undef PG8_BAR
#undef PG8_SCHED
}

struct EpiPool {
    static constexpr bool PERM = true, AFTER_DRAIN = false;
    bf16_t* O; const bf16_t* pgate;
    __device__ __forceinline__ void operator()(const f32x4 (&acc)[2][2][4][2], const Unit& u, int wr, int wc, int fr, int fq) const {
        const int row0 = u.pm * BM + wr * 64 + fr, col0 = u.pn * BM + wc * 32 + 8 * fq;
#pragma unroll
        for (int ai = 0; ai < 2; ++ai) {
            u32x4 gz4[4][2];
#pragma unroll
            for (int m = 0; m < 4; ++m)
#pragma unroll
                for (int bj = 0; bj < 2; ++bj) gz4[m][bj] = *(const u32x4*)(pgate + (size_t)(row0 + ai * HALF + m * 16) * 1024 + col0 + bj * HALF);
            __builtin_amdgcn_sched_barrier(0);
#pragma unroll
            for (int m = 0; m < 4; ++m)
#pragma unroll
                for (int bj = 0; bj < 2; ++bj) {
                    const int row = row0 + ai * HALF + m * 16, col = col0 + bj * HALF;
                    const u32x4 gz = gz4[m][bj];
                    const f32x4 v0 = acc[ai][bj][m][0], v1 = acc[ai][bj][m][1];
                    u32x4 w;
                    w.x = cvt_pk_bf16(v0[0] * bflo(gz.x), v0[1] * bfhi(gz.x));
                    w.y = cvt_pk_bf16(v0[2] * bflo(gz.y), v0[3] * bfhi(gz.y));
                    w.z = cvt_pk_bf16(v1[0] * bflo(gz.z), v1[1] * bfhi(gz.z));
                    w.w = cvt_pk_bf16(v1[2] * bflo(gz.w), v1[3] * bfhi(gz.w));
                    *(u32x4*)(O + (size_t)row * 1024 + col) = w;
                }
            __builtin_amdgcn_sched_barrier(0);
        }
    }
};
template <int PASS> struct EpiMerge {
    static constexpr bool PERM = true, AFTER_DRAIN = false;
    float* yacc; bf16_t* y; const bf16_t* zg;
    __device__ __forceinline__ void operator()(const f32x4 (&acc)[2][2][4][2], const Unit& u, int wr, int wc, int fr, int fq) const {
        const int row0 = u.pm * BM + wr * 64 + fr, col0 = u.pn * BM + wc * 32 + 8 * fq;
#pragma unroll
        for (int ai = 0; ai < 2; ++ai)
#pragma unroll
            for (int m = 0; m < 4; ++m)
#pragma unroll
                for (int bj = 0; bj < 2; ++bj) {
                    const int row = row0 + ai * HALF + m * 16, col = col0 + bj * HALF;
                    float gz[8]; unpack8(*(const u32x4*)(zg + (size_t)row * NZ + col), gz);
                    const f32x4 v0 = acc[ai][bj][m][0], v1 = acc[ai][bj][m][1];
                    f32x4 r0, r1;
#pragma unroll
                    for (int e = 0; e < 4; ++e) { r0[e] = v0[e] * sigmoid_f(gz[e]); r1[e] = v1[e] * sigmoid_f(gz[4 + e]); }
                    float* yp = yacc + (size_t)row * DM + col;
                    if (PASS >= 1) { r0 += *(const f32x4*)yp; r1 += *(const f32x4*)(yp + 4); }
                    if (PASS <= 1) { *(f32x4*)yp = r0; *(f32x4*)(yp + 4) = r1; }
                    else { u32x4 w; w.x = cvt_pk_bf16(r0[0], r0[1]); w.y = cvt_pk_bf16(r0[2], r0[3]); w.z = cvt_pk_bf16(r1[0], r1[1]); w.w = cvt_pk_bf16(r1[2], r1[3]);
                        *(u32x4*)(y + (size_t)row * DM + col) = w; }
                    __builtin_amdgcn_sched_barrier(0);
                }
    }
};
struct EpiMerge3 {
    static constexpr bool PERM = true, AFTER_DRAIN = false;
    bf16_t* y; const bf16_t* zg;
    __device__ __forceinline__ void operator()(f32x4 (&acc)[2][2][4][2], const Unit& u, int wr, int wc, int fr, int fq) const {
        const int row0 = u.pm * BM + wr * 64 + fr, col0 = u.pn * BM + wc * 32 + 8 * fq;
#pragma unroll
        for (int ai = 0; ai < 2; ++ai) {
            u32x4 ga4[4][2], gb4[4][2];
#pragma unroll
            for (int m = 0; m < 4; ++m)
#pragma unroll
                for (int bj = 0; bj < 2; ++bj) {
                    const bf16_t* zp = zg + (size_t)(row0 + ai * HALF + m * 16) * NZ + col0 + bj * HALF + u.seg * 2048;
                    ga4[m][bj] = *(const u32x4*)zp; gb4[m][bj] = (u.seg < 2) ? *(const u32x4*)(zp + 2048) : (u32x4){0u, 0u, 0u, 0u}; }
            __builtin_amdgcn_sched_barrier(0);
#pragma unroll
            for (int m = 0; m < 4; ++m)
#pragma unroll
                for (int bj = 0; bj < 2; ++bj) {
                    const int row = row0 + ai * HALF + m * 16, col = col0 + bj * HALF;
                    float ga[8]; unpack8(ga4[m][bj], ga);
                    if (u.seg < 2) {
                        float gb[8]; unpack8(gb4[m][bj], gb);
#pragma unroll
                        for (int e = 0; e < 8; ++e) { const float ea = __expf(-fminf(fmaxf(ga[e], -30.f), 30.f)), eb = __expf(-fminf(fmaxf(gb[e], -30.f), 30.f));
                            const float ratio = (1.f + eb) * __builtin_amdgcn_rcpf(1.f + ea); acc[ai][bj][m][e >> 2][e & 3] *= ratio; }
                    } else {
                        float r[8];
#pragma unroll
                        for (int e = 0; e < 8; ++e) r[e] = acc[ai][bj][m][e >> 2][e & 3] * __builtin_amdgcn_rcpf(1.f + __expf(-fminf(fmaxf(ga[e], -30.f), 30.f)));
                        u32x4 w; w.x = cvt_pk_bf16(r[0], r[1]); w.y = cvt_pk_bf16(r[2], r[3]); w.z = cvt_pk_bf16(r[4], r[5]); w.w = cvt_pk_bf16(r[6], r[7]);
                        *(u32x4*)(y + (size_t)row * DM + col) = w;
                    }
                }
            __builtin_amdgcn_sched_barrier(0);
        }
    }
};
struct EpiOut {
    static constexpr bool PERM = true, AFTER_DRAIN = false;
    const float* xlat; const float* xctx; float* xnew; const float* mod;
    __device__ __forceinline__ void operator()(const f32x4 (&acc)[2][2][4][2], const Unit& u, int wr, int wc, int fr, int fq) const {
        const int row0 = u.pm * BM + wr * 64 + fr, col0 = u.pn * BM + wc * 32 + 8 * fq;
        const int tile_row = u.pm * BM; const int mr = tile_row < ML ? tile_row / SEQ : 4;
        const float* xo = tile_row < ML ? xlat : (xctx - (size_t)ML * DM);
        const float* gm = mod + mr * 6144 + 4096;
        f32x4 g0[2], g1[2];
#pragma unroll
        for (int bj = 0; bj < 2; ++bj) { g0[bj] = *(const f32x4*)(gm + col0 + bj * HALF); g1[bj] = *(const f32x4*)(gm + col0 + bj * HALF + 4); }
#pragma unroll
        for (int ai = 0; ai < 2; ++ai) {
            f32x4 x0[4][2], x1[4][2];
#pragma unroll
            for (int m = 0; m < 4; ++m)
#pragma unroll
                for (int bj = 0; bj < 2; ++bj) { const float* xp = xo + (size_t)(row0 + ai * HALF + m * 16) * DM + col0 + bj * HALF; x0[m][bj] = *(const f32x4*)xp; x1[m][bj] = *(const f32x4*)(xp + 4); }
            __builtin_amdgcn_sched_barrier(0);
#pragma unroll
            for (int m = 0; m < 4; ++m)
#pragma unroll
                for (int bj = 0; bj < 2; ++bj) {
                    float* op = xnew + (size_t)(row0 + ai * HALF + m * 16) * DM + col0 + bj * HALF;
                    *(f32x4*)op = x0[m][bj] + g0[bj] * acc[ai][bj][m][0]; *(f32x4*)(op + 4) = x1[m][bj] + g1[bj] * acc[ai][bj][m][1];
                }
            __builtin_amdgcn_sched_barrier(0);
        }
    }
};
}

struct Args { const float* in[26]; float* out; unsigned char* ws; int ph_lo, ph_hi; };
enum { I_X = 0, I_C, I_CTX, I_CCTX, I_NORMG, I_WADA, I_BADA, I_WIN, I_POOLW, I_POOLS, I_QNORM, I_KNORM, I_LQ1, I_LK1, I_LQ2, I_LK2, I_SUBLN, I_WGF, I_BGF, I_WGB, I_BGB, I_GLAN, I_WBP, I_WBD, I_WBG, I_WOUT };

__device__ __forceinline__ const float* inp(int i) { const float* const volatile __attribute__((address_space(4)))* kp = (const float* const volatile __attribute__((address_space(4)))*)__builtin_amdgcn_kernarg_segment_ptr(); const GAS float* q = (const GAS float*)kp[i]; asm volatile("" : "+s"(q)); return (const float*)q; }
__device__ __forceinline__ float* arg_out() { float* const volatile __attribute__((address_space(4)))* kp = (float* const volatile __attribute__((address_space(4)))*)__builtin_amdgcn_kernarg_segment_ptr(); GAS float* q = (GAS float*)kp[26]; asm volatile("" : "+s"(q)); return (float*)q; }
__device__ __forceinline__ void transpose_item(const float* W, int K, int N, bf16_t* WT, int row_off, LAS float* scr, int kb, int nb, int lane) {
    const int k0 = 64 * kb, n0 = 32 * nb;
    float tv[32];
#pragma unroll
    for (int i = 0; i < 32; ++i) { const int kk = 2 * i + (lane >> 5); tv[i] = __builtin_nontemporal_load(W + (size_t)(k0 + kk) * N + n0 + (lane & 31)); }
#pragma unroll
    for (int i = 0; i < 32; ++i) { const int kk = 2 * i + (lane >> 5); scr[kk * 33 + (lane & 31)] = tv[i]; }
    asm volatile("s_waitcnt lgkmcnt(0)" ::: "memory");
    const int c = lane & 7;
#pragma unroll
    for (int j = 0; j < 4; ++j) { const int n = (lane >> 3) + 8 * j; const LAS float* s = scr + (8 * c) * 33 + n;
        u32x4 o; o.x = cvt_pk_bf16(s[0 * 33], s[1 * 33]); o.y = cvt_pk_bf16(s[2 * 33], s[3 * 33]); o.z = cvt_pk_bf16(s[4 * 33], s[5 * 33]); o.w = cvt_pk_bf16(s[6 * 33], s[7 * 33]);
        *(u32x4*)(WT + (size_t)(row_off + n0 + n) * K + k0 + 8 * c) = o; }
    asm volatile("s_waitcnt lgkmcnt(0)" ::: "memory");
}

__device__ __forceinline__ void ada_items(const Args& a, LAS unsigned char* lds, int l, int bidx, int nb) {
    const int tid = opaque_tid(), lane = tid & 63, wave = __builtin_amdgcn_readfirstlane(tid >> 6);
    unsigned char* ws = opaque_ptr(a.ws);
    LAS float* sc = (LAS float*)(lds + 69632);
    LAS float* part = (LAS float*)(lds + 69632 + 40960);
    if (bidx < 96) {
        for (int i = tid; i < 5 * 2048; i += 512) { const int r = i >> 11, k = i & 2047; const float v = r < 4 ? inp(I_C)[r * 2048 + k] : inp(I_CCTX)[k]; sc[i] = silu_f(v); }
        __syncthreads();
    }
    for (int it = bidx; it < 96; it += nb) {
        const int cgp = it, col = cgp * 64 + lane;
        const float* W = inp(I_WADA) + (size_t)l * 2048 * 6144 + col;
        float acc[5] = {0.f, 0.f, 0.f, 0.f, 0.f};
#pragma unroll 32
        for (int kk = 0; kk < 256; ++kk) { const int k = wave * 256 + kk; const float wv = __builtin_nontemporal_load(W + (size_t)k * 6144);
#pragma unroll
            for (int r = 0; r < 5; ++r) acc[r] += sc[r * 2048 + k] * wv; }
#pragma unroll
        for (int r = 0; r < 5; ++r) part[(wave * 5 + r) * 64 + lane] = acc[r];
        __syncthreads();
        if (tid < 320) { const int r = tid >> 6, ln = tid & 63; float s2 = inp(I_BADA)[l * 6144 + cgp * 64 + ln];
#pragma unroll
            for (int w = 0; w < 8; ++w) s2 += part[(w * 5 + r) * 64 + ln];
            ((float*)(ws + OFF_MOD))[(l * 5 + r) * 6144 + cgp * 64 + ln] = s2; }
        __syncthreads();
    }
}

__device__ __forceinline__ void convert_layer_weights(const Args& a, LAS unsigned char* lds, int l, int widx, int nw) {
    const int lane = opaque_tid() & 63, wave = __builtin_amdgcn_readfirstlane((int)threadIdx.x >> 6);
    unsigned char* ws = opaque_ptr(a.ws);
    LAS float* scr = (LAS float*)(lds + wave * 8704);
    constexpr int I_IN = 32 * 481, I_B = 16 * 64, I_O = 32 * 64, I_P = 4 * 32, PER_L = I_IN + 3 * I_B + I_O + I_P;
    for (int it = widx; it < PER_L; it += nw) {
        int r = it;
        if (r < I_IN) { const int kb = r / 481, nb = r % 481;
            transpose_item(inp(I_WIN) + (size_t)l * DM * DIN, DM, DIN, (bf16_t*)(ws + OFF_WIN + (size_t)l * SZ_WIN), nb >= 289 ? 224 : 0, scr, kb, nb, lane); continue; }
        r -= I_IN;
        if (r < 3 * I_B) { const int br = r / I_B, rr = r % I_B; const float* W = (br == 0 ? inp(I_WBP) : br == 1 ? inp(I_WBD) : inp(I_WBG)) + (size_t)l * 1024 * DM;
            transpose_item(W, 1024, DM, (bf16_t*)(ws + OFF_WB + (size_t)l * SZ_WB + (size_t)br * DM * 1024 * 2), 0, scr, rr / 64, rr % 64, lane); continue; }
        r -= 3 * I_B;
        if (r < I_O) { transpose_item(inp(I_WOUT) + (size_t)l * DM * DM, DM, DM, (bf16_t*)(ws + OFF_WOUT + (size_t)l * SZ_WOUT), 0, scr, r / 64, r % 64, lane); continue; }
        r -= I_O;
        { const int g = r / 32, rr = r % 32;
          transpose_item(inp(I_POOLW) + (size_t)(l * 4 + g) * 65536, 256, 256, (bf16_t*)(ws + OFF_POOLT + (size_t)l * SZ_POOLT + (size_t)g * 65536 * 2), 0, scr, rr / 8, rr % 8, lane); }
    }
}

__device__ __forceinline__ void phase_p0(const Args& a, LAS unsigned char* lds) {
    const int tid = opaque_tid(), lane = tid & 63, wave = __builtin_amdgcn_readfirstlane(tid >> 6), G = opaque_s(gridDim.x);
    unsigned char* ws = opaque_ptr(a.ws);
    ada_items(a, lds, 0, BID, G);
    if (BID == G - 1 && wave == 0) {
        for (int l = 0; l < 2; ++l) {
            const float s1 = wave_sum(inp(I_LQ1)[l * 64 + lane] * inp(I_LK1)[l * 64 + lane]);
            const float s2 = wave_sum(inp(I_LQ2)[l * 64 + lane] * inp(I_LK2)[l * 64 + lane]);
            const float mq = wave_max(fabsf(inp(I_QNORM)[l * 64 + lane])), mk = wave_max(fabsf(inp(I_KNORM)[l * 64 + lane]));
            const float lam_init = 0.8f - 0.6f * expf(-0.3f * (float)l);
            if (lane == 0) { float* sp = (float*)(ws + OFF_SCAL) + l * 4; sp[0] = expf(s1) - expf(s2) + lam_init; sp[1] = 8.f * LOG2E * mq * mk; sp[2] = lam_init; sp[3] = 0.f; }
        }
    }
    {
        const int nper = 224 * 2048 * 2 / 16;
        for (int i = BID * 512 + tid; i < 2 * nper; i += G * 512) { const int l = i / nper, j = i % nper;
            *(u32x4*)(ws + OFF_WIN + (size_t)l * SZ_WIN + (size_t)9248 * DM * 2 + (size_t)j * 16) = (u32x4){0u, 0u, 0u, 0u}; }
    }
    convert_layer_weights(a, lds, 0, BID * 8 + wave, G * 8);
}

__device__ __forceinline__ void phase_norm(const Args& a, int l) {
    const int tid = opaque_tid(), lane = tid & 63, wave = tid >> 6, G = opaque_s(gridDim.x);
    const int gw = BID * 8 + wave, NGW = G * 8;
    const float* mod = (const float*)(opaque_ptr(a.ws) + OFF_MOD) + (size_t)l * 5 * 6144;
    const float* x1 = (const float*)(opaque_ptr(a.ws) + OFF_X1);
    bf16_t* h = (bf16_t*)(opaque_ptr(a.ws) + OFF_H);
    const float* ng = inp(I_NORMG) + l * DM;
    for (int row = gw; row < MT; row += NGW) {
        const float* src = (l == 0) ? (row < ML ? inp(I_X) + (size_t)row * DM : inp(I_CTX) + (size_t)(row - ML) * DM) : x1 + (size_t)row * DM;
        const int mr = row < ML ? row / SEQ : 4;
        const float* md = mod + mr * 6144;
        f32x4 v[8]; float ss = 0.f;
#pragma unroll
        for (int j = 0; j < 8; ++j) { v[j] = *(const f32x4*)(src + 4 * lane + 256 * j); ss += (v[j][0] * v[j][0] + v[j][1] * v[j][1]) + (v[j][2] * v[j][2] + v[j][3] * v[j][3]); }
        ss = wave_sum(ss);
        const float rstd = rsqrtf(ss * (1.f / DM) + EPS);
#pragma unroll
        for (int j = 0; j < 8; ++j) { const int idx = 4 * lane + 256 * j;
            const f32x4 gg = *(const f32x4*)(ng + idx), sc = *(const f32x4*)(md + 2048 + idx), sh = *(const f32x4*)(md + idx);
            f32x4 o;
#pragma unroll
            for (int e = 0; e < 4; ++e) o[e] = v[j][e] * rstd * gg[e] * (1.f + sc[e]) + sh[e];
            u32x2 w; w.x = cvt_pk_bf16(o[0], o[1]); w.y = cvt_pk_bf16(o[2], o[3]);
            *(u32x2*)(h + (size_t)row * DM + idx) = w; }
    }
}

__device__ __forceinline__ int vt_pos(int key) { const int k = key & 15; return (key & ~15) | (((k >> 2) & 1) << 3) | (k & 3) | (((k >> 3) & 1) << 2); }

__device__ __forceinline__ void phase_prep(const Args& a, int l, LAS unsigned char* lds) {
    const int tid = opaque_tid(), lane = tid & 63, wave = tid >> 6, G = opaque_s(gridDim.x);
    unsigned char* ws = opaque_ptr(a.ws);
    const bf16_t* z = (const bf16_t*)(ws + OFF_Z);
    const bool need_ctx = (l == 0);
    for (int it = BID; it < 1440; it += G) {
        if (it < 576) {
            const int c = it >> 2, cgp = it & 3, rb = 64 * c;
            LAS float* lrs = (LAS float*)lds;
            LAS float* segs = (LAS float*)(lds + 8192);
            for (int i = tid; i < 64 * 32; i += 512) { const int r = i >> 5, cc = i & 31; lrs[i] = bf2f(z[(size_t)(rb + r) * NZ + ZC_LR + cc]); }
            __syncthreads();
            const int seg = tid >> 6, cp = tid & 63, ch = cgp * 128 + 2 * cp;
            typedef float f32x2v __attribute__((ext_vector_type(2)));
            const float* wgf = inp(I_WGF) + (size_t)l * 16 * 512 + ch; const float* wgb = inp(I_WGB) + (size_t)l * 16 * 512 + ch;
            f32x2v wf[16], wb[16];
#pragma unroll
            for (int r = 0; r < 16; ++r) { wf[r] = *(const f32x2v*)(wgf + r * 512); wb[r] = *(const f32x2v*)(wgb + r * 512); }
            const f32x2v bfv = *(const f32x2v*)(inp(I_BGF) + l * 512 + ch), bbv = *(const f32x2v*)(inp(I_BGB) + l * 512 + ch);
            f32x2v gf[8], gb[8]; f32x2v sf = {0.f, 0.f}, sb = {0.f, 0.f};
#pragma unroll
            for (int i = 0; i < 8; ++i) { const int t = seg * 8 + i; f32x2v af = bfv, ab = bbv;
#pragma unroll
                for (int r4 = 0; r4 < 4; ++r4) { const f32x4 lf = *(const LAS f32x4*)(lrs + t * 32 + 4 * r4), lb = *(const LAS f32x4*)(lrs + t * 32 + 16 + 4 * r4);
#pragma unroll
                    for (int e = 0; e < 4; ++e) { af += lf[e] * wf[4 * r4 + e]; ab += lb[e] * wb[4 * r4 + e]; } }
                gf[i].x = logsig_f(af.x) * (1.f / 16.f); gf[i].y = logsig_f(af.y) * (1.f / 16.f);
                gb[i].x = logsig_f(ab.x) * (1.f / 16.f); gb[i].y = logsig_f(ab.y) * (1.f / 16.f); sf += gf[i]; sb += gb[i]; }
            *(LAS f32x2v*)(segs + seg * 128 + 2 * cp) = sf; *(LAS f32x2v*)(segs + 1024 + seg * 128 + 2 * cp) = sb;
            __syncthreads();
            f32x2v pf = {0.f, 0.f}, pb = {0.f, 0.f}, totf = {0.f, 0.f}, totb = {0.f, 0.f};
#pragma unroll
            for (int s2 = 0; s2 < 8; ++s2) { const f32x2v vf = *(const LAS f32x2v*)(segs + s2 * 128 + 2 * cp), vb = *(const LAS f32x2v*)(segs + 1024 + s2 * 128 + 2 * cp);
                totf += vf; totb += vb; if (s2 < seg) { pf += vf; pb += vb; } }
            unsigned* gq0 = (unsigned*)(ws + OFF_GQ), *gq1 = (unsigned*)(ws + OFF_GQ + SZ_G);
            unsigned* gk0 = (unsigned*)(ws + OFF_GK), *gk1 = (unsigned*)(ws + OFF_GK + SZ_G);
            bf16_t* gh0 = (bf16_t*)(ws + OFF_GH), *gh1 = (bf16_t*)(ws + OFF_GH + SZ_G);
            f32x2v h0[8], h1[8];
#pragma unroll
            for (int i = 0; i < 8; ++i) { const int t = seg * 8 + i;
                pf += gf[i]; const f32x2v bs = totb - pb; pb += gb[i];
                const size_t row = rb + t;
                const unsigned qw = *(const unsigned*)(z + row * NZ + ZC_GQ + ch), kw = *(const unsigned*)(z + row * NZ + ZC_GK + ch);
                const float q0 = bflo(qw) * 0.08838834764831845f, q1 = bfhi(qw) * 0.08838834764831845f, k0 = bflo(kw), k1 = bfhi(kw);
                const size_t o = (row * 512 + ch) >> 1;
                gq0[o] = cvt_pk_bf16(q0 * __expf(pf.x), q1 * __expf(pf.y)); gk0[o] = cvt_pk_bf16(k0 * __expf(-pf.x), k1 * __expf(-pf.y));
                gq1[o] = cvt_pk_bf16(q0 * __expf(bs.x), q1 * __expf(bs.y)); gk1[o] = cvt_pk_bf16(k0 * __expf(-bs.x), k1 * __expf(-bs.y));
                h0[i].x = k0 * __expf(totf.x - pf.x); h0[i].y = k1 * __expf(totf.y - pf.y);
                h1[i].x = k0 * __expf(totb.x - bs.x); h1[i].y = k1 * __expf(totb.y - bs.y); }
            {
#pragma unroll
                for (int cc = 0; cc < 2; ++cc) { u32x4 w0, w1;
                    w0.x = cvt_pk_bf16(h0[0][cc], h0[1][cc]); w0.y = cvt_pk_bf16(h0[2][cc], h0[3][cc]); w0.z = cvt_pk_bf16(h0[4][cc], h0[5][cc]); w0.w = cvt_pk_bf16(h0[6][cc], h0[7][cc]);
                    w1.x = cvt_pk_bf16(h1[0][cc], h1[1][cc]); w1.y = cvt_pk_bf16(h1[2][cc], h1[3][cc]); w1.z = cvt_pk_bf16(h1[4][cc], h1[5][cc]); w1.w = cvt_pk_bf16(h1[6][cc], h1[7][cc]);
                    const size_t oh = ((size_t)c * 512 + ch + cc) * 64 + seg * 8;
                    *(u32x4*)(gh0 + oh) = w0; *(u32x4*)(gh1 + oh) = w1; } }
            if (seg == 0) { float* dec = (float*)(ws + OFF_DEC);
                *(f32x2v*)(dec + (size_t)c * 512 + ch) = (f32x2v){__expf(totf.x), __expf(totf.y)}; *(f32x2v*)(dec + (size_t)(144 + c) * 512 + ch) = (f32x2v){__expf(totb.x), __expf(totb.y)}; }
            __syncthreads();
        } else if (it < 864) {
            const int rb = 32 * (it - 576); if (!need_ctx && rb >= ML) continue;
            const int seq0 = rb < ML ? (rb / SEQ) * SEQ : ML + ((rb - ML) / LC) * LC; const int L = rb < ML ? SEQ : LC;
            const int ts = rb - seq0;
            bf16_t* dp = (bf16_t*)(ws + OFF_DPOOL); bf16_t* pgt = (bf16_t*)(ws + OFF_PGATE);
#pragma unroll
            for (int i = 0; i < 12; ++i) { const int idx = tid + 512 * i, rr = idx >> 7, c8 = (idx & 127) * 8, p = ts - 8 + rr;
                if (p >= 0 && p < L) *(LAS u32x4*)(lds + rr * 2048 + c8 * 2) = *(const u32x4*)(z + (size_t)(seq0 + p) * NZ + ZC_PU + c8); }
            __syncthreads();
            const int ch8 = 8 * (tid & 127), tg = tid >> 7, hw = 1 << (ch8 >> 8);
            const int tl0 = ts + 8 * tg;
            float psc[8];
            { const float* pp = inp(I_POOLS) + l * 1024 + ch8; const f32x4 p0 = *(const f32x4*)pp, p1 = *(const f32x4*)(pp + 4);
#pragma unroll
              for (int e = 0; e < 4; ++e) { psc[e] = p0[e]; psc[4 + e] = p1[e]; } }
            u32x4 pgw[8];
#pragma unroll
            for (int t = 0; t < 8; ++t) pgw[t] = *(const u32x4*)(z + (size_t)(seq0 + tl0 + t) * NZ + ZC_PG + ch8);
            const LAS unsigned char* lc = lds + ch8 * 2 - (ts - 8) * 2048;
            float sm[8] = {0.f, 0.f, 0.f, 0.f, 0.f, 0.f, 0.f, 0.f};
            { const int lo = max(tl0 - hw, 0), hi = min(tl0 + hw, L);
              for (int p = lo; p < hi; ++p) { float u[8]; unpack8(*(const LAS u32x4*)(lc + p * 2048), u);
#pragma unroll
                  for (int e = 0; e < 8; ++e) sm[e] += u[e]; } }
#pragma unroll
            for (int t = 0; t < 8; ++t) { const int tl = tl0 + t; const int lo = max(tl - hw, 0), hi = min(tl + hw, L);
                const float rc = __builtin_amdgcn_rcpf((float)(hi - lo));
                float cur[8], pgv[8], ua[8], ur[8];
                unpack8(*(const LAS u32x4*)(lc + tl * 2048), cur); unpack8(pgw[t], pgv);
                unpack8(*(const LAS u32x4*)(lc + min(tl + hw, L - 1) * 2048), ua); unpack8(*(const LAS u32x4*)(lc + max(tl - hw, 0) * 2048), ur);
                const float ma = (tl + hw < L) ? 1.f : 0.f, mr = (tl - hw >= 0) ? 1.f : 0.f;
                u32x4 wd, wg;
                wd.x = cvt_pk_bf16(sm[0] * rc - cur[0], sm[1] * rc - cur[1]); wd.y = cvt_pk_bf16(sm[2] * rc - cur[2], sm[3] * rc - cur[3]);
                wd.z = cvt_pk_bf16(sm[4] * rc - cur[4], sm[5] * rc - cur[5]); wd.w = cvt_pk_bf16(sm[6] * rc - cur[6], sm[7] * rc - cur[7]);
                wg.x = cvt_pk_bf16(psc[0] * silu_f(pgv[0]), psc[1] * silu_f(pgv[1])); wg.y = cvt_pk_bf16(psc[2] * silu_f(pgv[2]), psc[3] * silu_f(pgv[3]));
                wg.z = cvt_pk_bf16(psc[4] * silu_f(pgv[4]), psc[5] * silu_f(pgv[5])); wg.w = cvt_pk_bf16(psc[6] * silu_f(pgv[6]), psc[7] * silu_f(pgv[7]));
                const size_t o = (size_t)(seq0 + tl) * 1024 + ch8;
                *(u32x4*)(dp + o) = wd; *(u32x4*)(pgt + o) = wg;
#pragma unroll
                for (int e = 0; e < 8; ++e) sm[e] += ma * ua[e] - mr * ur[e]; }
            __syncthreads();
        } else {
            const int vi = it - 864, isg = vi >= 288, vj = isg ? vi - 288 : vi, c = vj >> 1, hv = vj & 1, rb = 64 * c;
            int b, key0; if (rb < ML) { b = rb >> 11; key0 = LC + (rb & 2047); } else { b = (rb - ML) >> 8; key0 = (rb - ML) & 255; }
            bf16_t* vT = (bf16_t*)(ws + OFF_VT); bf16_t* gvT = (bf16_t*)(ws + OFF_GVT);
#pragma unroll
            for (int i = 0; i < 8; ++i) { const int idx = tid + 512 * i, key = idx & 63, c8 = (idx >> 6) * 8;
                const u32x4 w = *(const u32x4*)(z + (size_t)(rb + key) * NZ + (isg ? ZC_GV : ZC_DV) + hv * 512 + c8);
                const unsigned ww[4] = {w.x, w.y, w.z, w.w}; const int pos = isg ? key : vt_pos(key);
#pragma unroll
                for (int e = 0; e < 8; ++e) *(LAS bf16_t*)(lds + (c8 + e) * 144 + pos * 2) = (bf16_t)((e & 1) ? (ww[e >> 1] >> 16) : (ww[e >> 1] & 0xffffu)); }
            __syncthreads();
#pragma unroll
            for (int i = 0; i < 8; ++i) { const int idx = tid + 512 * i, col = idx >> 3, k8 = idx & 7, colg = hv * 512 + col, h = colg >> 7, v = colg & 127;
                bf16_t* dst = isg ? gvT + ((size_t)c * 1024 + colg) * 64 + k8 * 8 : vT + ((size_t)(b * 8 + h) * 128 + v) * LK + key0 + k8 * 8;
                *(u32x4*)dst = *(const LAS u32x4*)(lds + col * 144 + k8 * 16); }
            __syncthreads();
        }
    }
    {
        const int gw = BID * 8 + wave, NGW = G * 8;
        bf16_t* qn = (bf16_t*)(ws + OFF_QN); bf16_t* qnc = (bf16_t*)(ws + OFF_QNC); bf16_t* kn = (bf16_t*)(ws + OFF_KN);
        for (int it = gw; it < MT * 2; it += NGW) {
            const int row = it >> 1, which = it & 1;
            const bool isctx = row >= ML; int b, t; if (!isctx) { b = row >> 11; t = row & 2047; } else { b = (row - ML) >> 8; t = (row - ML) & 255; }
            const bf16_t* zr = z + (size_t)row * NZ;
            {
                if (which == 0 && isctx && !need_ctx) continue;
                float x[16]; const bf16_t* src = zr + (which == 0 ? ZC_DQ : ZC_DK) + 16 * lane;
                unpack8(*(const u32x4*)src, x); unpack8(*(const u32x4*)(src + 8), x + 8);
                float ss = 0.f;
#pragma unroll
                for (int e = 0; e < 16; ++e) ss += x[e] * x[e];
                ss += __shfl_xor(ss, 1); ss += __shfl_xor(ss, 2);
                const float rstd = rsqrtf(ss * (1.f / 64.f) + EPS);
                const int m = lane & 3, sh = lane >> 2, h = sh >> 1, j = sh & 1;
                const float* gain = (which == 0 ? inp(I_QNORM) : inp(I_KNORM)) + l * 64 + 16 * m;
                float y[16];
#pragma unroll
                for (int e = 0; e < 16; ++e) y[e] = x[e] * rstd * gain[e];
                if (!isctx) {
                    const float posf = (float)((m & 1) ? (t & 63) : (t >> 6));
#pragma unroll
                    for (int e = 0; e < 16; ++e) { const float yp = __shfl_xor(y[e], 2);
                        const float ang = posf * exp2f(-(float)e * 0.8304820237218405f);
                        const float cs = __cosf(ang), sn = __sinf(ang);
                        y[e] = (m < 2) ? (y[e] * cs - yp * sn) : (y[e] * cs + yp * sn); }
                }
                bf16_t* dst;
                if (which == 0) {
#pragma unroll
                    for (int e = 0; e < 16; ++e) y[e] *= 0.125f * LOG2E;
                    dst = isctx ? qnc + (((size_t)(b * 8 + h) * 2 + j) * LC + t) * 64 + 16 * m : qn + (((size_t)(b * 8 + h) * 2 + j) * SEQ + t) * 64 + 16 * m;
                } else dst = kn + (((size_t)(b * 8 + h) * 2 + j) * LK + (isctx ? t : LC + t)) * 64 + 16 * m;
                u32x4 w0, w1;
                w0.x = cvt_pk_bf16(y[0], y[1]); w0.y = cvt_pk_bf16(y[2], y[3]); w0.z = cvt_pk_bf16(y[4], y[5]); w0.w = cvt_pk_bf16(y[6], y[7]);
                w1.x = cvt_pk_bf16(y[8], y[9]); w1.y = cvt_pk_bf16(y[10], y[11]); w1.z = cvt_pk_bf16(y[12], y[13]); w1.w = cvt_pk_bf16(y[14], y[15]);
                *(u32x4*)dst = w0; *(u32x4*)(dst + 8) = w1;
            }
        }
    }
}

constexpr int GL_Q = 0, GL_K = 17408, GL_KH = 34816, GL_VT = 53248, GL_ATT = 57856, GL_ST = 67072;
__device__ __forceinline__ void gla_unit(const Args& a, int l, LAS unsigned char* lds, int item) {
    const int tid = opaque_tid(), lane = tid & 63, w = __builtin_amdgcn_readfirstlane(tid >> 6);
    const int vs = item & 7, dir = (item >> 3) & 1, h = (item >> 4) & 3, b = item >> 6;
    const bool need_ctx = (l == 0);
    unsigned char* ws = opaque_ptr(a.ws);
    const bf16_t* z = (const bf16_t*)(ws + OFF_Z);
    const bf16_t* gq = (const bf16_t*)(ws + OFF_GQ + dir * SZ_G) + h * 128;
    const bf16_t* gk = (const bf16_t*)(ws + OFF_GK + dir * SZ_G) + h * 128;
    const bf16_t* gh = (const bf16_t*)(ws + OFF_GH + dir * SZ_G) + (size_t)h * 128 * 64;
    const float* dec = (const float*)(ws + OFF_DEC) + (size_t)dir * 144 * 512 + h * 128;
    bf16_t* od = (bf16_t*)(ws + OFF_OF + (size_t)dir * MT * 1024 * 2) + h * 256 + vs * 32;
    const bf16_t* gvt = (const bf16_t*)(ws + OFF_GVT) + (size_t)(h * 256 + vs * 32) * 64;
    const int fr = lane & 15, fq = lane >> 4;
    f32x4 sacc[2] = {(f32x4){0.f, 0.f, 0.f, 0.f}, (f32x4){0.f, 0.f, 0.f, 0.f}};
    for (int i = tid; i < 32 * 136 / 2; i += 512) ((LAS unsigned*)(lds + GL_ST))[i] = 0u;
    u32x4 rqA[2], rkA[2], rhA[2], rvA, rqB[2], rkB[2], rhB[2], rvB; float rdecA, rdecB;
    auto rowbase = [&](int s) -> int { if (s < 4) { const int ci = dir == 0 ? s : 3 - s; return ML + b * LC + 64 * ci; } const int ci = dir == 0 ? s - 4 : 35 - s; return b * SEQ + 64 * ci; };
#define GLA_LOADA(s) do { const int _rb = rowbase(s); _Pragma("unroll") for (int _i = 0; _i < 2; ++_i) { const int _idx = tid + 512 * _i, _r = _idx >> 4, _c = (_idx & 15) * 8; const size_t _o = (size_t)(_rb + _r) * 512 + _c; \
        rqA[_i] = *(const u32x4*)(gq + _o); rkA[_i] = *(const u32x4*)(gk + _o); rhA[_i] = *(const u32x4*)(gh + ((size_t)(_rb >> 6) * 512 + (_idx >> 3)) * 64 + (_idx & 7) * 8); } \
        if (tid < 256) rvA = *(const u32x4*)(gvt + ((size_t)(_rb >> 6) * 1024 + (tid >> 3)) * 64 + (tid & 7) * 8); \
        rdecA = dec[(size_t)(_rb >> 6) * 512 + 16 * w + fr]; } while (0)
#define GLA_LOADB(s) do { const int _rb = rowbase(s); _Pragma("unroll") for (int _i = 0; _i < 2; ++_i) { const int _idx = tid + 512 * _i, _r = _idx >> 4, _c = (_idx & 15) * 8; const size_t _o = (size_t)(_rb + _r) * 512 + _c; \
        rqB[_i] = *(const u32x4*)(gq + _o); rkB[_i] = *(const u32x4*)(gk + _o); rhB[_i] = *(const u32x4*)(gh + ((size_t)(_rb >> 6) * 512 + (_idx >> 3)) * 64 + (_idx & 7) * 8); } \
        if (tid < 256) rvB = *(const u32x4*)(gvt + ((size_t)(_rb >> 6) * 1024 + (tid >> 3)) * 64 + (tid & 7) * 8); \
        rdecB = dec[(size_t)(_rb >> 6) * 512 + 16 * w + fr]; } while (0)
    GLA_LOADA(0); GLA_LOADB(1);
    for (int s0_ = 0; s0_ < 36; s0_ += 2) {
      { const int s = s0_;
        const int rb = rowbase(s);
        const float dk = rdecA;
#pragma unroll
        for (int i = 0; i < 2; ++i) { const int idx = tid + 512 * i, r = idx >> 4, c = (idx & 15) * 8;
            *(LAS u32x4*)(lds + GL_Q + r * 272 + c * 2) = rqA[i]; *(LAS u32x4*)(lds + GL_K + r * 272 + c * 2) = rkA[i];
            const int s0 = (idx & 7) * 8, p1 = (s0 & 32) + 8 * ((s0 & 15) >> 2) + 4 * ((s0 >> 4) & 1);
            *(LAS u32x2*)(lds + GL_KH + (idx >> 3) * 144 + p1 * 2) = (u32x2){rhA[i].x, rhA[i].y}; *(LAS u32x2*)(lds + GL_KH + (idx >> 3) * 144 + (p1 + 8) * 2) = (u32x2){rhA[i].z, rhA[i].w}; }
        if (tid < 256) { const int s0 = (tid & 7) * 8, p1 = (s0 & 32) + 8 * ((s0 & 15) >> 2) + 4 * ((s0 >> 4) & 1);
            *(LAS u32x2*)(lds + GL_VT + (tid >> 3) * 144 + p1 * 2) = (u32x2){rvA.x, rvA.y}; *(LAS u32x2*)(lds + GL_VT + (tid >> 3) * 144 + (p1 + 8) * 2) = (u32x2){rvA.z, rvA.w}; }
        __syncthreads();
        if (s + 2 < 36) GLA_LOADA(s + 2);
        const int tt = w >> 1, vt = w & 1;
        bf16x8 pb[2];
        {
            f32x4 at[4];
#pragma unroll
            for (int st = 0; st < 4; ++st) { f32x4 acc = (f32x4){0.f, 0.f, 0.f, 0.f};
#pragma unroll
                for (int kk = 0; kk < 4; ++kk) { const bf16x8 af = *(const LAS bf16x8*)(lds + GL_K + (16 * st + fr) * 272 + (32 * kk + 8 * fq) * 2);
                    const bf16x8 bfr = *(const LAS bf16x8*)(lds + GL_Q + (16 * tt + fr) * 272 + (32 * kk + 8 * fq) * 2);
                    acc = __builtin_amdgcn_mfma_f32_16x16x32_bf16(af, bfr, acc, 0, 0, 0); }
#pragma unroll
                for (int j = 0; j < 4; ++j) { const int sc = 16 * st + 4 * fq + j, t = 16 * tt + fr; const bool keep = dir == 0 ? (sc <= t) : (sc >= t); acc[j] = keep ? acc[j] : 0.f; }
                at[st] = acc; }
#pragma unroll
            for (int p = 0; p < 2; ++p) { u32x4 pw; pw.x = cvt_pk_bf16(at[2 * p][0], at[2 * p][1]); pw.y = cvt_pk_bf16(at[2 * p][2], at[2 * p][3]);
                pw.z = cvt_pk_bf16(at[2 * p + 1][0], at[2 * p + 1][1]); pw.w = cvt_pk_bf16(at[2 * p + 1][2], at[2 * p + 1][3]); pb[p] = __builtin_bit_cast(bf16x8, pw); }
        }
        {
            f32x4 acc = (f32x4){0.f, 0.f, 0.f, 0.f};
#pragma unroll
            for (int kk = 0; kk < 4; ++kk) { const bf16x8 af = *(const LAS bf16x8*)(lds + GL_ST + (16 * vt + fr) * 272 + (32 * kk + 8 * fq) * 2);
                const bf16x8 bfr = *(const LAS bf16x8*)(lds + GL_Q + (16 * tt + fr) * 272 + (32 * kk + 8 * fq) * 2);
                acc = __builtin_amdgcn_mfma_f32_16x16x32_bf16(af, bfr, acc, 0, 0, 0); }
#pragma unroll
            for (int p = 0; p < 2; ++p) { const bf16x8 af = *(const LAS bf16x8*)(lds + GL_VT + (16 * vt + fr) * 144 + (32 * p + 8 * fq) * 2);
                acc = __builtin_amdgcn_mfma_f32_16x16x32_bf16(af, pb[p], acc, 0, 0, 0); }
            if (s >= 4 || need_ctx) { u32x2 wv; wv.x = cvt_pk_bf16(acc[0], acc[1]); wv.y = cvt_pk_bf16(acc[2], acc[3]);
                *(u32x2*)(od + (size_t)(rb + 16 * tt + fr) * 1024 + 16 * vt + 4 * fq) = wv; }
        }
#pragma unroll
        for (int vt2 = 0; vt2 < 2; ++vt2) { f32x4 acc = sacc[vt2] * dk;
#pragma unroll
            for (int kk = 0; kk < 2; ++kk) { const bf16x8 af = *(const LAS bf16x8*)(lds + GL_VT + (16 * vt2 + fr) * 144 + (32 * kk + 8 * fq) * 2);
                const bf16x8 bfr = *(const LAS bf16x8*)(lds + GL_KH + (16 * w + fr) * 144 + (32 * kk + 8 * fq) * 2);
                acc = __builtin_amdgcn_mfma_f32_16x16x32_bf16(af, bfr, acc, 0, 0, 0); }
            sacc[vt2] = acc; }
        __syncthreads();
#pragma unroll
        for (int vt = 0; vt < 2; ++vt)
#pragma unroll
            for (int j = 0; j < 4; ++j) *(LAS bf16_t*)(lds + GL_ST + (16 * vt + 4 * fq + j) * 272 + (16 * w + fr) * 2) = f2bf(sacc[vt][j]);
      }
      { const int s = s0_ + 1;
        const int rb = rowbase(s);
        const float dk = rdecB;
#pragma unroll
        for (int i = 0; i < 2; ++i) { const int idx = tid + 512 * i, r = idx >> 4, c = (idx & 15) * 8;
            *(LAS u32x4*)(lds + GL_Q + r * 272 + c * 2) = rqB[i]; *(LAS u32x4*)(lds + GL_K + r * 272 + c * 2) = rkB[i];
            const int s0 = (idx & 7) * 8, p1 = (s0 & 32) + 8 * ((s0 & 15) >> 2) + 4 * ((s0 >> 4) & 1);
            *(LAS u32x2*)(lds + GL_KH + (idx >> 3) * 144 + p1 * 2) = (u32x2){rhB[i].x, rhB[i].y}; *(LAS u32x2*)(lds + GL_KH + (idx >> 3) * 144 + (p1 + 8) * 2) = (u32x2){rhB[i].z, rhB[i].w}; }
        if (tid < 256) { const int s0 = (tid & 7) * 8, p1 = (s0 & 32) + 8 * ((s0 & 15) >> 2) + 4 * ((s0 >> 4) & 1);
            *(LAS u32x2*)(lds + GL_VT + (tid >> 3) * 144 + p1 * 2) = (u32x2){rvB.x, rvB.y}; *(LAS u32x2*)(lds + GL_VT + (tid >> 3) * 144 + (p1 + 8) * 2) = (u32x2){rvB.z, rvB.w}; }
        __syncthreads();
        if (s + 2 < 36) GLA_LOADB(s + 2);
        const int tt = w >> 1, vt = w & 1;
        bf16x8 pb[2];
        {
            f32x4 at[4];
#pragma unroll
            for (int st = 0; st < 4; ++st) { f32x4 acc = (f32x4){0.f, 0.f, 0.f, 0.f};
#pragma unroll
                for (int kk = 0; kk < 4; ++kk) { const bf16x8 af = *(const LAS bf16x8*)(lds + GL_K + (16 * st + fr) * 272 + (32 * kk + 8 * fq) * 2);
                    const bf16x8 bfr = *(const LAS bf16x8*)(lds + GL_Q + (16 * tt + fr) * 272 + (32 * kk + 8 * fq) * 2);
                    acc = __builtin_amdgcn_mfma_f32_16x16x32_bf16(af, bfr, acc, 0, 0, 0); }
#pragma unroll
                for (int j = 0; j < 4; ++j) { const int sc = 16 * st + 4 * fq + j, t = 16 * tt + fr; const bool keep = dir == 0 ? (sc <= t) : (sc >= t); acc[j] = keep ? acc[j] : 0.f; }
                at[st] = acc; }
#pragma unroll
            for (int p = 0; p < 2; ++p) { u32x4 pw; pw.x = cvt_pk_bf16(at[2 * p][0], at[2 * p][1]); pw.y = cvt_pk_bf16(at[2 * p][2], at[2 * p][3]);
                pw.z = cvt_pk_bf16(at[2 * p + 1][0], at[2 * p + 1][1]); pw.w = cvt_pk_bf16(at[2 * p + 1][2], at[2 * p + 1][3]); pb[p] = __builtin_bit_cast(bf16x8, pw); }
        }
        {
            f32x4 acc = (f32x4){0.f, 0.f, 0.f, 0.f};
#pragma unroll
            for (int kk = 0; kk < 4; ++kk) { const bf16x8 af = *(const LAS bf16x8*)(lds + GL_ST + (16 * vt + fr) * 272 + (32 * kk + 8 * fq) * 2);
                const bf16x8 bfr = *(const LAS bf16x8*)(lds + GL_Q + (16 * tt + fr) * 272 + (32 * kk + 8 * fq) * 2);
                acc = __builtin_amdgcn_mfma_f32_16x16x32_bf16(af, bfr, acc, 0, 0, 0); }
#pragma unroll
            for (int p = 0; p < 2; ++p) { const bf16x8 af = *(const LAS bf16x8*)(lds + GL_VT + (16 * vt + fr) * 144 + (32 * p + 8 * fq) * 2);
                acc = __builtin_amdgcn_mfma_f32_16x16x32_bf16(af, pb[p], acc, 0, 0, 0); }
            if (s >= 4 || need_ctx) { u32x2 wv; wv.x = cvt_pk_bf16(acc[0], acc[1]); wv.y = cvt_pk_bf16(acc[2], acc[3]);
                *(u32x2*)(od + (size_t)(rb + 16 * tt + fr) * 1024 + 16 * vt + 4 * fq) = wv; }
        }
#pragma unroll
        for (int vt2 = 0; vt2 < 2; ++vt2) { f32x4 acc = sacc[vt2] * dk;
#pragma unroll
            for (int kk = 0; kk < 2; ++kk) { const bf16x8 af = *(const LAS bf16x8*)(lds + GL_VT + (16 * vt2 + fr) * 144 + (32 * kk + 8 * fq) * 2);
                const bf16x8 bfr = *(const LAS bf16x8*)(lds + GL_KH + (16 * w + fr) * 144 + (32 * kk + 8 * fq) * 2);
                acc = __builtin_amdgcn_mfma_f32_16x16x32_bf16(af, bfr, acc, 0, 0, 0); }
            sacc[vt2] = acc; }
        __syncthreads();
#pragma unroll
        for (int vt = 0; vt < 2; ++vt)
#pragma unroll
            for (int j = 0; j < 4; ++j) *(LAS bf16_t*)(lds + GL_ST + (16 * vt + 4 * fq + j) * 272 + (16 * w + fr) * 2) = f2bf(sacc[vt][j]);
      }
    }
    __syncthreads();
#undef GLA_LOADA
#undef GLA_LOADB
}

constexpr int AT_BUF = 36864, AT_K = 0, AT_V = 18432;
template <bool SHIFT>
__device__ __forceinline__ void attn_unit(LAS unsigned char* lds, const bf16_t* qbase, int Lq, int q0, const bf16_t* kbase, const bf16_t* vtbase, int nkeys,
                                          float c2, float lam, float post_scale, const float* subln, const bf16_t* dg, bf16_t* outp, int row0) {
    const int tid = opaque_tid(), lane = tid & 63, w = __builtin_amdgcn_readfirstlane(tid >> 6), q32 = lane & 31, hi = lane >> 5;
    const int j = w >> 2, qg = w & 3;
    bf16x8 qf[4];
#pragma unroll
    for (int kk = 0; kk < 4; ++kk) qf[kk] = *(const bf16x8*)(qbase + ((size_t)j * Lq + q0 + 32 * qg + q32) * 64 + 16 * kk + 8 * hi);
    f32x16 o[4];
#pragma unroll
    for (int vt = 0; vt < 4; ++vt)
#pragma unroll
        for (int r = 0; r < 16; ++r) o[vt][r] = 0.f;
    float lsum = 0.f;
    const int nt = nkeys >> 6;
    u32x4 skA[2], svA[2];
#define AT_LOAD(sk, sv, i) do { _Pragma("unroll") for (int _c = 0; _c < 2; ++_c) { const int _idx = tid + 512 * _c; \
        sk[_c] = *(const u32x4*)(kbase + ((size_t)(_idx >> 9) * LK + 64 * (i) + ((_idx & 511) >> 3)) * 64 + (_idx & 7) * 8); \
        sv[_c] = *(const u32x4*)(vtbase + (size_t)(_idx >> 3) * LK + 64 * (i) + (_idx & 7) * 8); } } while (0)
#define AT_STORE(sk, sv, p) do { _Pragma("unroll") for (int _c = 0; _c < 2; ++_c) { const int _idx = tid + 512 * _c; \
        *(LAS u32x4*)(lds + (p) * AT_BUF + AT_K + ((_idx >> 9) * 64 + ((_idx & 511) >> 3)) * 144 + (_idx & 7) * 16) = sk[_c]; \
        *(LAS u32x4*)(lds + (p) * AT_BUF + AT_V + (_idx >> 3) * 144 + (_idx & 7) * 16) = sv[_c]; } } while (0)
#define AT_KF(kb, kk) (*(const LAS bf16x8*)(Kb + (32 * (kb) + q32) * 144 + (16 * (kk) + 8 * hi) * 2))
#define AT_VF(ks, vt) (*(const LAS bf16x8*)(Vb + (32 * (vt) + q32) * 144 + (16 * (ks) + 8 * hi) * 2))
#define AT_TILE(p) do { \
        LAS unsigned char* Kb = lds + (p) * AT_BUF + AT_K + j * (64 * 144); LAS unsigned char* Vb = lds + (p) * AT_BUF + AT_V; \
        bf16x8 kf[4], vf[4], vg[4]; \
        _Pragma("unroll") for (int kk = 0; kk < 4; ++kk) kf[kk] = AT_KF(0, kk); \
        _Pragma("unroll") for (int kb = 0; kb < 2; ++kb) { \
            _Pragma("unroll") for (int vt = 0; vt < 4; ++vt) vf[vt] = AT_VF(2 * kb, vt); \
            __builtin_amdgcn_sched_barrier(0); \
            f32x16 s; \
            _Pragma("unroll") for (int r = 0; r < 16; ++r) s[r] = 0.f; \
            _Pragma("unroll") for (int kk = 0; kk < 4; ++kk) s = __builtin_amdgcn_mfma_f32_32x32x16_bf16(kf[kk], qf[kk], s, 0, 0, 0); \
            __builtin_amdgcn_sched_barrier(0); \
            _Pragma("unroll") for (int vt = 0; vt < 4; ++vt) vg[vt] = AT_VF(2 * kb + 1, vt); \
            if (kb == 0) { _Pragma("unroll") for (int kk = 0; kk < 4; ++kk) kf[kk] = AT_KF(1, kk); } \
            __builtin_amdgcn_sched_barrier(0); \
            _Pragma("unroll") for (int r = 0; r < 16; ++r) { s[r] = __builtin_amdgcn_exp2f(SHIFT ? s[r] - c2 : s[r]); lsum += s[r]; } \
            u32x4 pw0, pw1; \
            pw0.x = cvt_pk_bf16(s[0], s[1]); pw0.y = cvt_pk_bf16(s[2], s[3]); pw0.z = cvt_pk_bf16(s[4], s[5]); pw0.w = cvt_pk_bf16(s[6], s[7]); \
            pw1.x = cvt_pk_bf16(s[8], s[9]); pw1.y = cvt_pk_bf16(s[10], s[11]); pw1.z = cvt_pk_bf16(s[12], s[13]); pw1.w = cvt_pk_bf16(s[14], s[15]); \
            const bf16x8 pb0 = __builtin_bit_cast(bf16x8, pw0), pb1 = __builtin_bit_cast(bf16x8, pw1); \
            _Pragma("unroll") for (int vt = 0; vt < 4; ++vt) o[vt] = __builtin_amdgcn_mfma_f32_32x32x16_bf16(vf[vt], pb0, o[vt], 0, 0, 0); \
            _Pragma("unroll") for (int vt = 0; vt < 4; ++vt) o[vt] = __builtin_amdgcn_mfma_f32_32x32x16_bf16(vg[vt], pb1, o[vt], 0, 0, 0); \
            __builtin_amdgcn_sched_barrier(0); \
        } } while (0)
    AT_LOAD(skA, svA, 0); AT_STORE(skA, svA, 0);
    __syncthreads();
    for (int i = 0; i < nt; i += 2) {
        AT_LOAD(skA, svA, i + 1);
        AT_TILE(0);
        AT_STORE(skA, svA, 1);
        __syncthreads();
        if (i + 2 < nt) AT_LOAD(skA, svA, i + 2);
        AT_TILE(1);
        if (i + 2 < nt) AT_STORE(skA, svA, 0);
        __syncthreads();
    }
#undef AT_TILE
#undef AT_KF
#undef AT_VF
#undef AT_LOAD
#undef AT_STORE
    lsum += __shfl_xor(lsum, 32);
    LAS float* xch = (LAS float*)lds + (size_t)qg * 4096 + lane;
    if (j == 1) {
        const float sc = lam / lsum;
#pragma unroll
        for (int vt = 0; vt < 4; ++vt)
#pragma unroll
            for (int r = 0; r < 16; ++r) xch[(vt * 16 + r) * 64] = o[vt][r] * sc;
    }
    __syncthreads();
    if (j == 0) {
        const float i0 = 1.f / lsum;
        float ss = 0.f;
#pragma unroll
        for (int vt = 0; vt < 4; ++vt)
#pragma unroll
            for (int r = 0; r < 16; ++r) { const float v = o[vt][r] * i0 - xch[(vt * 16 + r) * 64]; o[vt][r] = v; ss += v * v; }
        ss += __shfl_xor(ss, 32);
        const float rstd = rsqrtf(ss * (1.f / 128.f) + EPS) * post_scale;
        const size_t row = (size_t)row0 + 32 * qg + q32;
#pragma unroll
        for (int vt = 0; vt < 4; ++vt)
#pragma unroll
            for (int g4 = 0; g4 < 4; ++g4) {
                const int v0 = 32 * vt + 8 * g4 + 4 * hi;
                const u32x2 gz = *(const u32x2*)(dg + row * NZ + v0);
                const f32x4 sl = *(const f32x4*)(subln + v0);
                const float r0 = o[vt][4 * g4 + 0] * rstd * sl[0] * silu_f(bflo(gz.x)), r1 = o[vt][4 * g4 + 1] * rstd * sl[1] * silu_f(bfhi(gz.x));
                const float r2 = o[vt][4 * g4 + 2] * rstd * sl[2] * silu_f(bflo(gz.y)), r3 = o[vt][4 * g4 + 3] * rstd * sl[3] * silu_f(bfhi(gz.y));
                u32x2 wv; wv.x = cvt_pk_bf16(r0, r1); wv.y = cvt_pk_bf16(r2, r3);
                *(u32x2*)(outp + row * 1024 + v0) = wv;
            }
    }
    __syncthreads();
}

__device__ __forceinline__ void phase_mix(const Args& a, int l, LAS unsigned char* lds) {
    const int G = opaque_s(gridDim.x);
    unsigned char* ws = opaque_ptr(a.ws);
    const bool need_ctx = (l == 0);
#ifndef NO_GLA
    for (int it = BID; it < 256; it += G) gla_unit(a, l, lds, ((it & 7) * 4 + (it >> 6)) * 8 + ((it >> 3) & 7));
#if defined(REPEAT_SUB) && REPEAT_SUB == 1
    for (int it = BID; it < 256; it += G) gla_unit(a, l, lds, it);
#endif
#endif
#ifndef NO_ATT
    {
        const float* scal = (const float*)(ws + OFF_SCAL) + l * 4;
        const float lam = scal[0], c2 = scal[1], post = 1.f - scal[2];
        const bf16_t* z = (const bf16_t*)(ws + OFF_Z);
        const int nun = 512 + (need_ctx ? 64 : 0);
        const bool big = c2 > 48.f;
#define ATTN_UNIT(...) do { if (big) attn_unit<true>(__VA_ARGS__); else attn_unit<false>(__VA_ARGS__); } while (0)
#if defined(REPEAT_SUB) && REPEAT_SUB == 2
        for (int rep = 0; rep < 2; ++rep)
#endif
        for (int u = BID; u < nun; u += G) {
            if (u < 512) { const int vc = (u & 7) * 64 + (u >> 3), bh = vc >> 4, qb = vc & 15, b = bh >> 3, h = bh & 7;
                ATTN_UNIT(lds, (const bf16_t*)(ws + OFF_QN) + (size_t)bh * 2 * SEQ * 64, SEQ, 128 * qb, (const bf16_t*)(ws + OFF_KN) + (size_t)bh * 2 * LK * 64,
                          (const bf16_t*)(ws + OFF_VT) + (size_t)bh * 128 * LK, LK, c2, lam, post, inp(I_SUBLN) + l * 128, z + ZC_DG + h * 128, (bf16_t*)(ws + OFF_DIFFO) + h * 128, b * SEQ + 128 * qb);
            } else { const int uu = u - 512, bh = uu >> 1, qb = uu & 1, b = bh >> 3, h = bh & 7;
                ATTN_UNIT(lds, (const bf16_t*)(ws + OFF_QNC) + (size_t)bh * 2 * LC * 64, LC, 128 * qb, (const bf16_t*)(ws + OFF_KN) + (size_t)bh * 2 * LK * 64,
                          (const bf16_t*)(ws + OFF_VT) + (size_t)bh * 128 * LK, LC, c2, lam, post, inp(I_SUBLN) + l * 128, z + ZC_DG + h * 128, (bf16_t*)(ws + OFF_DIFFO) + h * 128, ML + b * LC + 128 * qb);
            }
        }
    }
#endif
#ifndef NO_POOL
    {
        const int Mrows = need_ctx ? MT : ML;
        pg8::Gemm g{(const bf16_t*)(ws + OFF_DPOOL), (const bf16_t*)(ws + OFF_POOLT + (size_t)l * SZ_POOLT), Mrows, 1024, 256, 1024, 256, 256};
        pg8::StaticOrder S; S.init(Mrows, 1024, G, BID);
        pg8::EpiPool E{(bf16_t*)(ws + OFF_POOLO), (const bf16_t*)(ws + OFF_PGATE)};
        pg8::gemm_phase<pg8::EpiPool, pg8::StaticOrder, true, true>(lds, g, S, E);
    }
#endif
}

__device__ __forceinline__ void phase_post(const Args& a, int l) {
    const int tid = opaque_tid(), lane = tid & 63, wave = tid >> 6, G = opaque_s(gridDim.x);
    const int gw = BID * 8 + wave, NGW = G * 8;
    unsigned char* ws = opaque_ptr(a.ws);
    const bf16_t* z = (const bf16_t*)(ws + OFF_Z);
    const bf16_t* of = (const bf16_t*)(ws + OFF_OF); const bf16_t* ob = of + (size_t)MT * 1024;
    bf16_t* go = (bf16_t*)(ws + OFF_GLAO);
    const int Mrows = (l == 0) ? MT : ML;
    const float* gn = inp(I_GLAN) + l * 256 + ((16 * lane) & 255);
    for (int row = gw; row < Mrows; row += NGW) {
        float x[16], y[16], gz[16];
        const size_t o = (size_t)row * 1024 + 16 * lane;
        unpack8(*(const u32x4*)(of + o), x); unpack8(*(const u32x4*)(of + o + 8), x + 8);
        unpack8(*(const u32x4*)(ob + o), y); unpack8(*(const u32x4*)(ob + o + 8), y + 8);
        unpack8(*(const u32x4*)(z + (size_t)row * NZ + ZC_GG + 16 * lane), gz); unpack8(*(const u32x4*)(z + (size_t)row * NZ + ZC_GG + 16 * lane + 8), gz + 8);
        float ss = 0.f;
#pragma unroll
        for (int e = 0; e < 16; ++e) { x[e] += y[e]; ss += x[e] * x[e]; }
        ss += __shfl_xor(ss, 1); ss += __shfl_xor(ss, 2); ss += __shfl_xor(ss, 4); ss += __shfl_xor(ss, 8);
        const float rstd = rsqrtf(ss * (1.f / 256.f) + EPS);
        float r[16];
#pragma unroll
        for (int e = 0; e < 16; ++e) r[e] = x[e] * rstd * gn[e] * silu_f(gz[e]);
        u32x4 w0, w1;
        w0.x = cvt_pk_bf16(r[0], r[1]); w0.y = cvt_pk_bf16(r[2], r[3]); w0.z = cvt_pk_bf16(r[4], r[5]); w0.w = cvt_pk_bf16(r[6], r[7]);
        w1.x = cvt_pk_bf16(r[8], r[9]); w1.y = cvt_pk_bf16(r[10], r[11]); w1.z = cvt_pk_bf16(r[12], r[13]); w1.w = cvt_pk_bf16(r[14], r[15]);
        *(u32x4*)(go + o) = w0; *(u32x4*)(go + o + 8) = w1;
    }
}

#define XB_TMO      128
#define XB_XCNT(j)  (256  + 64 * (j))
#define XB_XSUB(j)  (1280 + 64 * (j))
#define XB_XGEN(j)  (2304 + 64 * (j))
#define XB_TOP      3328
#define XB_TOPGEN   3392
#define XCD_BAR_WORDS 3456
#define XB_SPIN_CAP (1u << 18)

__device__ __forceinline__ unsigned xb_ld(unsigned* p)              { return __hip_atomic_load(p, __ATOMIC_RELAXED, __HIP_MEMORY_SCOPE_AGENT); }
__device__ __forceinline__ unsigned xb_add(unsigned* p, unsigned v) { return __hip_atomic_fetch_add(p, v, __ATOMIC_RELAXED, __HIP_MEMORY_SCOPE_AGENT); }
__device__ __forceinline__ unsigned xb_xcc_id() { return (unsigned)__builtin_amdgcn_s_getreg((3 << 11) | 20) & 0xFu; }
#define XB_SPIN(cond, bar) do { unsigned _sp = 0; while (cond) { __builtin_amdgcn_s_sleep(1); \
    if ((++_sp & 255u) == 0u) { if (xb_ld(&(bar)[XB_TMO])) break; if (_sp > XB_SPIN_CAP) { atomicAdd(&(bar)[XB_TMO], 1u); break; } } } } while (0)

struct XcdBarrier {
    unsigned* bar; unsigned x;
    volatile LAS unsigned* st;
};

__device__ __forceinline__ XcdBarrier xcd_barrier_post(unsigned* bar, volatile LAS unsigned* st) {
    XcdBarrier b; b.bar = bar; b.x = xb_xcc_id(); b.st = st;
    if (threadIdx.x == 0) (void)xb_add(&bar[XB_XCNT(b.x)], 1u);
    return b;
}
__device__ __forceinline__ void xcd_barrier_complete(unsigned* bar, unsigned x, unsigned& nloc, unsigned& nx) {
    const unsigned G = gridDim.x * gridDim.y * gridDim.z;
    unsigned sum, cnt, mine, sp = 0u;
    for (;;) {
        sum = 0u; cnt = 0u; mine = 0u;
#pragma unroll
        for (unsigned j = 0; j < 16; ++j) { const unsigned c = xb_ld(&bar[XB_XCNT(j)]); sum += c; cnt += (c > 0u) ? 1u : 0u; mine = (j == x) ? c : mine; }
        if (sum == G) break;
        __builtin_amdgcn_s_sleep(1);
        if ((++sp & 255u) == 0u) { if (xb_ld(&bar[XB_TMO])) break; if (sp > XB_SPIN_CAP) { atomicAdd(&bar[XB_TMO], 1u); break; } }
    }
    nloc = mine > 0u ? mine : 1u; nx = cnt > 0u ? cnt : 1u;
}

__device__ __forceinline__ void xcd_barrier(const XcdBarrier& b) {
    asm volatile("s_waitcnt vmcnt(0)" ::: "memory");
    __syncthreads();
    if (threadIdx.x == 0) {
        unsigned* bar = b.bar;
        __builtin_amdgcn_s_waitcnt(0);
        unsigned nloc = b.st[0], nx = b.st[1];
        if (nloc == 0u) { xcd_barrier_complete(bar, b.x, nloc, nx); b.st[0] = nloc; b.st[1] = nx; }
        const unsigned old = xb_add(&bar[XB_XSUB(b.x)], 1u);
        const unsigned gen = old / nloc;
        if (old + 1u == (gen + 1u) * nloc) {
            __builtin_amdgcn_fence(__ATOMIC_RELEASE, "agent");
            asm volatile("s_waitcnt vmcnt(0)" ::: "memory");
            const unsigned og = xb_add(&bar[XB_TOP], 1u);
            const unsigned tg = og / nx;
            if (og + 1u == (tg + 1u) * nx) xb_add(&bar[XB_TOPGEN], 1u);
            else XB_SPIN(xb_ld(&bar[XB_TOPGEN]) == tg, bar);
            __builtin_amdgcn_fence(__ATOMIC_ACQUIRE, "agent");
            xb_add(&bar[XB_XGEN(b.x)], 1u);
            asm volatile("s_waitcnt vmcnt(0)" ::: "memory");
        } else {
            XB_SPIN(xb_ld(&bar[XB_XGEN(b.x)]) == gen, bar);
            __builtin_amdgcn_fence(__ATOMIC_ACQUIRE, "agent");
            asm volatile("s_waitcnt vmcnt(0)" ::: "memory");
        }
    }
    __syncthreads();
}

#ifndef REPEAT_K
#define REPEAT_K -1
#endif
#define SEAM() do { XcdBarrier xb; xb.bar = (unsigned*)(opaque_ptr(a.ws) + OFF_BAR); xb.x = xb_xcc_id(); xb.st = (volatile LAS unsigned*)(lds + 131072 + 512); xcd_barrier(xb); } while (0)
#define REP(k) for (int rep_ = 0; rep_ < (REPEAT_K == (k) ? 2 : 1); ++rep_)
template <int l> __device__ __forceinline__ void run_layer(const Args& a, LAS unsigned char* lds) {
    constexpr int Mout = (l == 0) ? MT : ML;
    REP(0) phase_norm(a, l);
    SEAM();
    REP(1) {
        unsigned char* ws = opaque_ptr(a.ws); const int G = opaque_s(gridDim.x);
        pg8::Gemm g{(const bf16_t*)(ws + OFF_H), (const bf16_t*)(ws + OFF_WIN + (size_t)l * SZ_WIN), MT, NZ, DM, DM, DM, 0};
        pg8::EpiBf16 E{(bf16_t*)(ws + OFF_Z), NZ};
        if (l == 0) { pg8::StaticOrder S; S.init(MT, NZ, G, BID); pg8::gemm_phase<pg8::EpiBf16, pg8::StaticOrder, true, true>(lds, g, S, E);
 }
        else { pg8::CtxSkipOrder S; S.init(G, BID); pg8::gemm_phase<pg8::EpiBf16, pg8::CtxSkipOrder, true, true>(lds, g, S, E); }
    }
    SEAM();
    REP(2) phase_prep(a, l, lds);
    SEAM();
    REP(3) phase_mix(a, l, lds);
    SEAM();
    REP(4) phase_post(a, l);
    SEAM();
    REP(5) {
        unsigned char* ws = opaque_ptr(a.ws); const int G = opaque_s(gridDim.x);
        pg8::SegOrder3 S; S.base.init(Mout, DM, G, BID);
        const bf16_t* wb = (const bf16_t*)(ws + OFF_WB + (size_t)l * SZ_WB);
        pg8::Gemm g{(const bf16_t*)(ws + OFF_POOLO), wb, Mout, DM, 1024, 1024, 1024, 0,
                    (const bf16_t*)(ws + OFF_DIFFO), (const bf16_t*)(ws + OFF_GLAO), wb + (size_t)DM * 1024, wb + (size_t)2 * DM * 1024};
        pg8::EpiMerge3 E{(bf16_t*)(ws + OFF_H), (const bf16_t*)(ws + OFF_Z) + ZC_MG};
        pg8::gemm_phase<pg8::EpiMerge3, pg8::SegOrder3, true, true, 3>(lds, g, S, E);
        if (l == 0 && rep_ == 0) {
            const int rem = ((Mout / 256) * (DM / 256)) % G, bid = BID;
            if (rem == 0) { ada_items(a, lds, 1, bid, G); convert_layer_weights(a, lds, 1, bid * 8 + (int)(threadIdx.x >> 6), G * 8); }
            else if (bid >= rem) { ada_items(a, lds, 1, G - 1 - bid, G - rem); convert_layer_weights(a, lds, 1, (bid - rem) * 8 + (int)(threadIdx.x >> 6), (G - rem) * 8); }
        }
    }
    SEAM();
    REP(6) {
        unsigned char* ws = opaque_ptr(a.ws); const int G = opaque_s(gridDim.x);
        pg8::Gemm g{(const bf16_t*)(ws + OFF_H), (const bf16_t*)(ws + OFF_WOUT + (size_t)l * SZ_WOUT), Mout, DM, DM, DM, DM, 0};
        pg8::StaticOrder S; S.init(Mout, DM, G, BID);
        pg8::EpiOut E{l == 0 ? inp(I_X) : (const float*)(ws + OFF_X1), l == 0 ? inp(I_CTX) : (const float*)(ws + OFF_X1) + (size_t)ML * DM,
                      l == 0 ? (float*)(ws + OFF_X1) : arg_out(), (const float*)(ws + OFF_MOD) + (size_t)l * 5 * 6144};
        pg8::gemm_phase<pg8::EpiOut, pg8::StaticOrder, true, true>(lds, g, S, E);
    }
}

__global__ void __launch_bounds__(512, 2) hybrid_fwd(Args a) {
    extern __shared__ __attribute__((aligned(16))) unsigned char smem[];
    LAS unsigned char* lds = (LAS unsigned char*)smem;
    cg::grid_group grid = cg::this_grid();
    volatile LAS unsigned* bst = (volatile LAS unsigned*)(lds + 131072 + 512);
    if (threadIdx.x < 2) bst[threadIdx.x] = 0u;
    __syncthreads();
    (void)xcd_barrier_post((unsigned*)(a.ws + OFF_BAR), bst);
    REP(7) phase_p0(a, lds);
    grid.sync();
    run_layer<0>(a, lds);
    SEAM();
    run_layer<1>(a, lds);
}

extern "C" void kernel_launch(void* const* d_in, const int* in_sizes, int n_in, void* d_out, int out_size, void* d_ws, size_t ws_size, hipStream_t stream) {
    static int grid = 0;
    if (grid == 0) {
        if (n_in != 26 || out_size != ML * DM || ws_size < WS_END) { fprintf(stderr, "kernel_launch: expected 26 inputs, out %d, ws >= %zu; got n_in %d out %d ws %zu\n", ML * DM, (size_t)WS_END, n_in, out_size, ws_size); grid = -1; return; }
        int dev = 0, cus = 0, per_cu = 0;
        if (hipGetDevice(&dev) != hipSuccess || hipDeviceGetAttribute(&cus, hipDeviceAttributeMultiprocessorCount, dev) != hipSuccess) { grid = -1; return; }
        if (hipFuncSetAttribute((const void*)hybrid_fwd, hipFuncAttributeMaxDynamicSharedMemorySize, LDS_BYTES) != hipSuccess) { fprintf(stderr, "kernel_launch: hipFuncSetAttribute failed\n"); grid = -1; return; }
        if (hipOccupancyMaxActiveBlocksPerMultiprocessor(&per_cu, (const void*)hybrid_fwd, 512, LDS_BYTES) != hipSuccess || per_cu < 1) { fprintf(stderr, "kernel_launch: occupancy query says %d blocks per CU\n", per_cu); (void)hipGetLastError(); grid = -1; return; }
        grid = cus;
    }
    if (grid < 0) return;
    if (hipMemsetAsync((char*)d_ws + OFF_BAR, 0, BAR_BYTES, stream) != hipSuccess) { fprintf(stderr, "kernel_launch: memset of the barrier words failed\n"); return; }
    Args a{};
    for (int i = 0; i < 26; ++i) a.in[i] = (const float*)d_in[i];
    a.out = (float*)d_out; a.ws = (unsigned char*)d_ws;
    a.ph_lo = 0; a.ph_hi = NPH;
    void* args[] = {&a};
    const hipError_t e = hipLaunchCooperativeKernel((const void*)hybrid_fwd, dim3(grid), dim3(512), args, LDS_BYTES, stream);
    if (e != hipSuccess) fprintf(stderr, "kernel_launch: cooperative launch failed: %s (grid %d)\n", hipGetErrorString(e), grid);
}
```

```cpp
#include <hip/hip_runtime.h>
#include <hip/hip_cooperative_groups.h>
#include <cstdio>
#include <cstdint>
namespace cg = cooperative_groups;

#ifndef MK_N_LAUNCHES
#define MK_N_LAUNCHES 1
#endif

#define LAS __attribute__((address_space(3)))
typedef unsigned short bf16_t;
typedef short bf16x8 __attribute__((ext_vector_type(8)));
typedef float f32x4 __attribute__((ext_vector_type(4)));
typedef float f32x16 __attribute__((ext_vector_type(16)));
typedef unsigned u32x4 __attribute__((ext_vector_type(4)));
typedef unsigned u32x2 __attribute__((ext_vector_type(2)));

constexpr int DM = 2048, NB = 4, SEQ = 2048, LC = 256, ML = NB * SEQ, MC = NB * LC, MT = ML + MC;
constexpr int DIN = 15392, NZ = 15616;
constexpr int ZC_PU = 0, ZC_PG = 1024, ZC_DQ = 2048, ZC_DK = 3072, ZC_DV = 4096, ZC_DG = 5120, ZC_GQ = 6144, ZC_GK = 6656, ZC_GV = 7168, ZC_GG = 8192, ZC_LR = 9216, ZC_MG = 9472;
constexpr int LK = LC + SEQ;
constexpr float EPS = 1e-6f, LOG2E = 1.4426950408889634f;
constexpr int NPH = 15;

constexpr size_t SZ_WIN = (size_t)NZ * DM * 2, SZ_WB = (size_t)3 * DM * 1024 * 2, SZ_WOUT = (size_t)DM * DM * 2, SZ_POOLT = (size_t)4 * 256 * 256 * 2;
constexpr size_t OFF_WIN = 0;
constexpr size_t OFF_WB = OFF_WIN + 2 * SZ_WIN;
constexpr size_t OFF_WOUT = OFF_WB + 2 * SZ_WB;
constexpr size_t OFF_POOLT = OFF_WOUT + 2 * SZ_WOUT;
constexpr size_t OFF_MOD = OFF_POOLT + 2 * SZ_POOLT;
constexpr size_t OFF_SCAL = OFF_MOD + (size_t)2 * 5 * 6144 * 4;
constexpr size_t OFF_H = OFF_SCAL + 256;
constexpr size_t OFF_Z = OFF_H + (size_t)MT * DM * 2;
constexpr size_t OFF_QN = OFF_Z + (size_t)MT * NZ * 2;
constexpr size_t OFF_QNC = OFF_QN + (size_t)ML * 1024 * 2;
constexpr size_t OFF_KN = OFF_QNC + (size_t)MC * 1024 * 2;
constexpr size_t OFF_VT = OFF_KN + (size_t)MT * 1024 * 2;
constexpr size_t SZ_G = (size_t)MT * 512 * 2;
constexpr size_t OFF_GQ = OFF_VT + (size_t)MT * 1024 * 2;
constexpr size_t OFF_GK = OFF_GQ + 2 * SZ_G;
constexpr size_t OFF_GH = OFF_GK + 2 * SZ_G;
constexpr size_t OFF_DEC = OFF_GH + 2 * SZ_G;
constexpr size_t OFF_OF = OFF_DEC + (size_t)2 * 144 * 512 * 4;
constexpr size_t OFF_DPOOL = OFF_OF + 2 * (size_t)MT * 1024 * 2;
constexpr size_t OFF_POOLO = OFF_DPOOL + (size_t)MT * 1024 * 2;
constexpr size_t OFF_DIFFO = OFF_POOLO + (size_t)MT * 1024 * 2;
constexpr size_t OFF_GLAO = OFF_DIFFO + (size_t)MT * 1024 * 2;
constexpr size_t OFF_YACC = OFF_GLAO + (size_t)MT * 1024 * 2;
constexpr size_t OFF_X1 = OFF_YACC + (size_t)MT * DM * 4;
constexpr size_t OFF_PGATE = OFF_X1 + (size_t)MT * DM * 4;
constexpr size_t OFF_BAR = OFF_PGATE + (size_t)MT * 1024 * 2;
constexpr size_t BAR_BYTES = 16384;
constexpr size_t OFF_GVT = OFF_BAR + BAR_BYTES;
constexpr size_t WS_END = OFF_GVT + (size_t)MT * 1024 * 2;

constexpr int LDS_BYTES = 135168;

#define BID opaque_s((int)blockIdx.x)
#define GAS __attribute__((address_space(1)))
__device__ __forceinline__ unsigned char* opaque_ptr(unsigned char* p) { GAS unsigned char* q = (GAS unsigned char*)p; asm volatile("" : "+s"(q)); return (unsigned char*)q; }
__device__ __forceinline__ int opaque_s(int v) { asm volatile("" : "+s"(v)); return v; }
__device__ __forceinline__ int opaque_tid() { int t = threadIdx.x; asm volatile("" : "+v"(t)); return t; }
typedef float f32x2_t __attribute__((ext_vector_type(2))); typedef __bf16 bf16x2_t __attribute__((ext_vector_type(2)));
__device__ __forceinline__ unsigned cvt_pk_bf16(float lo, float hi) { f32x2_t v = {lo, hi}; bf16x2_t b = __builtin_convertvector(v, bf16x2_t); return __builtin_bit_cast(unsigned, b); }
__device__ __forceinline__ bf16_t f2bf(float f) { return (bf16_t)(cvt_pk_bf16(f, 0.f) & 0xffffu); }
__device__ __forceinline__ float bf2f(bf16_t v) { return __builtin_bit_cast(float, (unsigned)v << 16); }
__device__ __forceinline__ float bflo(unsigned u) { return __builtin_bit_cast(float, u << 16); }
__device__ __forceinline__ float bfhi(unsigned u) { return __builtin_bit_cast(float, u & 0xffff0000u); }
__device__ __forceinline__ float silu_f(float x) { return x * __builtin_amdgcn_rcpf(1.f + __expf(-x)); }
__device__ __forceinline__ float sigmoid_f(float x) { return __builtin_amdgcn_rcpf(1.f + __expf(-x)); }
__device__ __forceinline__ float logsig_f(float a) { return fminf(a, 0.f) - __logf(1.f + __expf(-fabsf(a))); }
__device__ __forceinline__ float wave_sum(float v) {
#pragma unroll
    for (int o = 1; o < 64; o <<= 1) v += __shfl_xor(v, o);
    return v;
}
__device__ __forceinline__ float wave_max(float v) {
#pragma unroll
    for (int o = 1; o < 64; o <<= 1) v = fmaxf(v, __shfl_xor(v, o));
    return v;
}
__device__ __forceinline__ void unpack8(u32x4 w, float* f) { f[0] = bflo(w.x); f[1] = bfhi(w.x); f[2] = bflo(w.y); f[3] = bfhi(w.y); f[4] = bflo(w.z); f[5] = bfhi(w.z); f[6] = bflo(w.w); f[7] = bfhi(w.w); }

namespace pg8 {
constexpr int BM = 256, BK = 64, HALF = 128, HTB = HALF * BK * 2, STAGE_BYTES = 8 * HTB, NXCD = 8, WGM = 8;
__host__ __device__ __forceinline__ int lds_byte(int r, int c) { const int st = (r >> 4) * 2 + (c >> 5), rr = r & 15, cc = c & 31, ob = rr * 64 + cc * 2; return st * 1024 + (ob ^ (((ob >> 9) & 1) << 5)); }
__host__ __device__ __forceinline__ void stage_rc(int b, int& R, int& C) { const int st = b / 1024, sb = b % 1024, swz = sb ^ (((sb >> 9) & 1) << 5); R = (st >> 1) * 16 + swz / 64; C = (st & 1) * 32 + (swz % 64) / 2; }
__host__ __device__ __forceinline__ int perm32(int rho) { const int n = rho >> 4, i = rho & 15; return 8 * (i >> 2) + 4 * n + (i & 3); }

struct Unit { int pm, pn, seg; };
struct Gemm { const bf16_t* A; const bf16_t* Bt; int M, N, K; int lda, ldb; int a_pn_off; const bf16_t* A1; const bf16_t* A2; const bf16_t* B1; const bf16_t* B2; };

struct StaticOrder {
    int nM, nN, nwg, G, c;
    __host__ __device__ void init(int M, int N, int G_, int c_) { nM = M / BM; nN = N / BM; nwg = nM * nN; G = G_; c = c_; }
    __host__ __device__ bool next(int i, Unit& u) const {
        const long L = (long)i * G + c; if (L >= nwg) return false;
        int wgid = (int)L; { const int q = nwg / NXCD, r = nwg % NXCD, xcd = wgid % NXCD, off = wgid / NXCD; wgid = (xcd < r ? xcd * (q + 1) : r * (q + 1) + (xcd - r) * q) + off; }
        const int nig = WGM * nN, gid = wgid / nig, fm = gid * WGM, gsz = (nM - fm) < WGM ? (nM - fm) : WGM;
        u.pm = fm + ((wgid % nig) % gsz); u.pn = (wgid % nig) / gsz; u.seg = 0; return true;
    }
    __device__ __forceinline__ void a_ready(const Unit&) const {}
    __device__ __forceinline__ void done(const Unit&) const {}
};

struct CtxSkipOrder {
    StaticOrder base; int nbase;
    __host__ __device__ void init(int G_, int c_) { base.init(ML, NZ, G_, c_); nbase = base.nwg; }
    __host__ __device__ bool next(int i, Unit& u) const {
        const long L = (long)i * base.G + base.c;
        if (L < nbase) return base.next(i, u);
        const int e = (int)(L - nbase); if (e >= 4 * 15) return false;
        const int j = e % 15; u.pm = 32 + e / 15; u.pn = j < 8 ? 12 + j : (j < 14 ? 18 + j : 36); u.seg = 0; return true;
    }
    __device__ __forceinline__ void a_ready(const Unit&) const {}
    __device__ __forceinline__ void done(const Unit&) const {}
};
struct SegOrder3 {
    StaticOrder base;
    __host__ __device__ bool next(int i, Unit& u) const { const int q = i / 3; if (!base.next(q, u)) return false; u.seg = i - 3 * q; return true; }
    __device__ __forceinline__ void a_ready(const Unit&) const {}
    __device__ __forceinline__ void done(const Unit&) const {}
};
struct EpiBf16 {
    static constexpr bool PERM = true, AFTER_DRAIN = false;
    bf16_t* O; int ldc;
    __device__ __forceinline__ void operator()(const f32x4 (&acc)[2][2][4][2], const Unit& u, int wr, int wc, int fr, int fq) const {
        const int row0 = u.pm * BM + wr * 64 + fr, col0 = u.pn * BM + wc * 32 + 8 * fq;
#pragma unroll
        for (int ai = 0; ai < 2; ++ai)
#pragma unroll
            for (int m = 0; m < 4; ++m) { bf16_t* rowp = O + (size_t)(row0 + ai * HALF + m * 16) * ldc + col0;
#pragma unroll
                for (int bj = 0; bj < 2; ++bj) { const f32x4 v0 = acc[ai][bj][m][0], v1 = acc[ai][bj][m][1];
                    u32x4 w; w.x = cvt_pk_bf16(v0[0], v0[1]); w.y = cvt_pk_bf16(v0[2], v0[3]); w.z = cvt_pk_bf16(v1[0], v1[1]); w.w = cvt_pk_bf16(v1[2], v1[3]);
                    *(u32x4*)(rowp + bj * HALF) = w; } }
    }
};

template <class Epi, class Sched, bool ALIGN_EPI = false, bool SP2 = false, int NSEG = 1>
__device__ __forceinline__ void gemm_phase(LAS unsigned char* lds, const Gemm g, const Sched& S, const Epi& E) {
    const int tid = opaque_tid(), wid = __builtin_amdgcn_readfirstlane(tid >> 6), lane = tid & 63, wr = wid >> 2, wc = wid & 3, fr = lane & 15, fq = lane >> 4;
    const int K = opaque_s(g.K), nt = K / BK;
    unsigned voffA[2], voffB[2];
#pragma unroll
    for (int i = 0; i < 2; ++i) { int R, C; stage_rc(tid * 16 + i * 8192, R, C); const int Rb = Epi::PERM ? ((R & ~31) + perm32(R & 31)) : R;
        voffA[i] = (unsigned)(R * g.lda + C) * 2u; voffB[i] = (unsigned)(Rb * g.ldb + C) * 2u; }
    const size_t kstep = (size_t)(BK * 2);
    const size_t hstepA = (size_t)HALF * g.lda * 2, hstepB = (size_t)HALF * g.ldb * 2;
    const size_t tstepA = 2 * hstepA, tstepB = 2 * hstepB;
    const size_t pnA = (size_t)g.a_pn_off * 2;
    const unsigned ldsw = (unsigned)wid * 1024u;
    const int aoff = lds_byte(wr * 64 + fr, fq * 8), boff = lds_byte(wc * 32 + fr, fq * 8);
#define PG8_SA(b, h) (((b) * 2 + (h)) * HTB)
#define PG8_SB(b, h) ((4 + (b) * 2 + (h)) * HTB)
#define PG8_STAGE(bufoff, gbase, voff) do { _Pragma("unroll") for (int _i = 0; _i < 2; ++_i) \
        __builtin_amdgcn_global_load_lds((const unsigned*)((const char*)(gbase) + (voff)[_i]), (LAS unsigned*)(lds + (bufoff) + ldsw + _i * 8192), 16, 0, 0); } while (0)
#define PG8_LDA(dst, b, h) do { _Pragma("unroll") for (int m = 0; m < 4; ++m) _Pragma("unroll") for (int k = 0; k < 2; ++k) dst[m][k] = *(const LAS bf16x8*)(lds + PG8_SA(b, h) + aoff + m * 2048 + k * 1024); } while (0)
#define PG8_LDB(dst, b, h) do { _Pragma("unroll") for (int n = 0; n < 2; ++n) _Pragma("unroll") for (int k = 0; k < 2; ++k) dst[n][k] = *(const LAS bf16x8*)(lds + PG8_SB(b, h) + boff + n * 2048 + k * 1024); } while (0)
#define PG8_MMA(ai, bj, At, Bt) do { __builtin_amdgcn_s_setprio(1); _Pragma("unroll") for (int m = 0; m < 4; ++m) _Pragma("unroll") for (int n = 0; n < 2; ++n) _Pragma("unroll") for (int k = 0; k < 2; ++k) \
        acc[ai][bj][m][n] = __builtin_amdgcn_mfma_f32_16x16x32_bf16(Bt[n][k], At[m][k], acc[ai][bj][m][n], 0, 0, 0); __builtin_amdgcn_s_setprio(0); } while (0)
#define PG8_WAIT_V(n) asm volatile("s_waitcnt vmcnt(" #n ")" ::: "memory")
#define PG8_WAIT_L(n) asm volatile("s_waitcnt lgkmcnt(" #n ")" ::: "memory")
#define PG8_BAR __builtin_amdgcn_s_barrier()
#define PG8_SCHED __builtin_amdgcn_sched_barrier(0)
    Unit cur, nxt; int ui = 0;
    if (!S.next(0, cur)) return;
    f32x4 acc[2][2][4][2];
#pragma unroll
    for (int a = 0; a < 2; ++a)
#pragma unroll
        for (int b = 0; b < 2; ++b)
#pragma unroll
            for (int m = 0; m < 4; ++m)
#pragma unroll
                for (int n = 0; n < 2; ++n) acc[a][b][m][n] = (f32x4){0.f, 0.f, 0.f, 0.f};
    bf16x8 At[4][2], B0[2][2], B1[2][2];
#define PG8_ASEG(u) ((const char*)(NSEG == 1 || (u).seg == 0 ? g.A : ((u).seg == 1 ? g.A1 : g.A2)))
#define PG8_BSEG(u) ((const char*)(NSEG == 1 || (u).seg == 0 ? g.Bt : ((u).seg == 1 ? g.B1 : g.B2)))
    const char* cA = PG8_ASEG(cur) + (size_t)cur.pm * tstepA + (size_t)cur.pn * pnA; const char* cB = PG8_BSEG(cur) + (size_t)cur.pn * tstepB;
    S.a_ready(cur);
    if constexpr (SP2) {
        PG8_STAGE(PG8_SB(0, 0), cB, voffB); PG8_STAGE(PG8_SB(0, 1), cB + hstepB, voffB); PG8_STAGE(PG8_SA(0, 0), cA, voffA); PG8_STAGE(PG8_SA(0, 1), cA + hstepA, voffA);
        if (wr == 1) PG8_BAR;
        PG8_WAIT_V(2); PG8_BAR;
        PG8_STAGE(PG8_SB(1, 0), cB + kstep, voffB); PG8_STAGE(PG8_SA(1, 0), cA + kstep, voffA); PG8_STAGE(PG8_SB(1, 1), cB + hstepB + kstep, voffB);
        PG8_WAIT_V(6); PG8_BAR;
    } else {
        PG8_STAGE(PG8_SB(0, 0), cB, voffB); PG8_STAGE(PG8_SA(0, 0), cA, voffA); PG8_STAGE(PG8_SB(0, 1), cB + hstepB, voffB); PG8_STAGE(PG8_SA(0, 1), cA + hstepA, voffA);
        if (wr == 1) PG8_BAR;
        PG8_WAIT_V(4); PG8_BAR;
        PG8_STAGE(PG8_SB(1, 0), cB + kstep, voffB); PG8_STAGE(PG8_SA(1, 0), cA + kstep, voffA); PG8_STAGE(PG8_SB(1, 1), cB + hstepB + kstep, voffB);
        PG8_WAIT_V(6); PG8_BAR;
    }
    for (;;) {
        const bool has_next = S.next(ui + 1, nxt);
        const char* nA = has_next ? PG8_ASEG(nxt) + (size_t)nxt.pm * tstepA + (size_t)nxt.pn * pnA : cA; const char* nB = has_next ? PG8_BSEG(nxt) + (size_t)nxt.pn * tstepB : cB;
        for (int t = 0; t < nt; t += 2) {
            const bool last = (t == nt - 2);
            const char* a1 = cA + (size_t)(t + 1) * kstep;
            const char* a2 = last ? nA : cA + (size_t)(t + 2) * kstep; const char* b2 = last ? nB : cB + (size_t)(t + 2) * kstep;
            const char* a3 = a2 + kstep; const char* b3 = b2 + kstep;
            if (last && has_next) S.a_ready(nxt);
            if constexpr (SP2) {
            PG8_LDB(B0, 0, 0); PG8_LDB(B1, 0, 1); PG8_SCHED; PG8_LDA(At, 0, 0); PG8_STAGE(PG8_SA(1, 1), a1 + hstepA, voffA);
            PG8_WAIT_V(8); PG8_WAIT_L(0); PG8_BAR; PG8_MMA(0, 0, At, B0); PG8_MMA(0, 1, At, B1); PG8_BAR; PG8_SCHED;
            PG8_LDA(At, 0, 1); PG8_STAGE(PG8_SB(0, 0), b2, voffB); PG8_STAGE(PG8_SB(0, 1), b2 + hstepB, voffB); PG8_STAGE(PG8_SA(0, 0), a2, voffA);
            PG8_WAIT_V(8); PG8_WAIT_L(0); PG8_BAR; PG8_MMA(1, 0, At, B0); PG8_MMA(1, 1, At, B1); PG8_BAR; PG8_SCHED;
            PG8_LDB(B0, 1, 0); PG8_LDB(B1, 1, 1); PG8_SCHED; PG8_LDA(At, 1, 0); PG8_STAGE(PG8_SA(0, 1), a2 + hstepA, voffA);
            PG8_WAIT_V(8); PG8_WAIT_L(0); PG8_BAR; PG8_MMA(0, 0, At, B0); PG8_MMA(0, 1, At, B1); PG8_BAR; PG8_SCHED;
            PG8_LDA(At, 1, 1); PG8_STAGE(PG8_SB(1, 0), b3, voffB); PG8_STAGE(PG8_SB(1, 1), b3 + hstepB, voffB); PG8_STAGE(PG8_SA(1, 0), a3, voffA);
            PG8_WAIT_V(8); PG8_WAIT_L(0); PG8_BAR; PG8_MMA(1, 0, At, B0); PG8_MMA(1, 1, At, B1); PG8_BAR; PG8_SCHED;
            } else {
            PG8_LDB(B0, 0, 0); PG8_SCHED; PG8_LDA(At, 0, 0); PG8_STAGE(PG8_SA(1, 1), a1 + hstepA, voffA);
            PG8_WAIT_L(8); PG8_BAR; PG8_WAIT_L(0); PG8_MMA(0, 0, At, B0); PG8_BAR; PG8_SCHED;
            PG8_LDB(B1, 0, 1); PG8_STAGE(PG8_SB(0, 0), b2, voffB);
            PG8_BAR; PG8_WAIT_L(0); PG8_MMA(0, 1, At, B1); PG8_BAR;
            PG8_LDA(At, 0, 1); PG8_STAGE(PG8_SA(0, 0), a2, voffA);
            PG8_BAR; PG8_WAIT_L(0); PG8_MMA(1, 0, At, B0); PG8_BAR; PG8_SCHED;
            PG8_STAGE(PG8_SB(0, 1), b2 + hstepB, voffB);
            PG8_WAIT_V(6); PG8_BAR; PG8_MMA(1, 1, At, B1); PG8_BAR;
            PG8_LDB(B0, 1, 0); PG8_SCHED; PG8_LDA(At, 1, 0); PG8_STAGE(PG8_SA(0, 1), a2 + hstepA, voffA);
            PG8_WAIT_L(8); PG8_BAR; PG8_WAIT_L(0); PG8_MMA(0, 0, At, B0); PG8_BAR; PG8_SCHED;
            PG8_LDB(B1, 1, 1); PG8_STAGE(PG8_SB(1, 0), b3, voffB);
            PG8_BAR; PG8_WAIT_L(0); PG8_MMA(0, 1, At, B1); PG8_BAR;
            PG8_LDA(At, 1, 1); PG8_STAGE(PG8_SA(1, 0), a3, voffA);
            PG8_BAR; PG8_WAIT_L(0); PG8_MMA(1, 0, At, B0); PG8_BAR; PG8_SCHED;
            PG8_STAGE(PG8_SB(1, 1), b3 + hstepB, voffB);
            PG8_WAIT_V(6); PG8_BAR; PG8_MMA(1, 1, At, B1); PG8_BAR;
            }
        }
        if constexpr (ALIGN_EPI) { if (wr == 0) PG8_BAR; }
        E(acc, cur, wr, wc, fr, fq); S.done(cur);
        if (!has_next) break;
        if (NSEG == 1 || cur.seg == NSEG - 1)
#pragma unroll
        for (int a = 0; a < 2; ++a)
#pragma unroll
            for (int b = 0; b < 2; ++b)
#pragma unroll
                for (int m = 0; m < 4; ++m)
#pragma unroll
                    for (int n = 0; n < 2; ++n) acc[a][b][m][n] = (f32x4){0.f, 0.f, 0.f, 0.f};
        cur = nxt; cA = nA; cB = nB; ++ui;
        if constexpr (ALIGN_EPI) { if (wr == 1) PG8_BAR; }
    }
    PG8_WAIT_V(0);
    if constexpr (!ALIGN_EPI) { if (wr == 0) PG8_BAR; }
    PG8_BAR;
#undef PG8_ASEG
#undef PG8_BSEG
#undef PG8_SA
#undef PG8_SB
#undef PG8_STAGE
#undef PG8_LDA
#undef PG8_LDB
#undef PG8_MMA
#undef PG8_WAIT_V
#undef PG8_WAIT_L
#undef PG8_BAR
#undef PG8_SCHED
}

struct EpiPool {
    static constexpr bool PERM = true, AFTER_DRAIN = false;
    bf16_t* O; const bf16_t* pgate;
    __device__ __forceinline__ void operator()(const f32x4 (&acc)[2][2][4][2], const Unit& u, int wr, int wc, int fr, int fq) const {
        const int row0 = u.pm * BM + wr * 64 + fr, col0 = u.pn * BM + wc * 32 + 8 * fq;
#pragma unroll
        for (int ai = 0; ai < 2; ++ai) {
            u32x4 gz4[4][2];
#pragma unroll
            for (int m = 0; m < 4; ++m)
#pragma unroll
                for (int bj = 0; bj < 2; ++bj) gz4[m][bj] = *(const u32x4*)(pgate + (size_t)(row0 + ai * HALF + m * 16) * 1024 + col0 + bj * HALF);
            __builtin_amdgcn_sched_barrier(0);
#pragma unroll
            for (int m = 0; m < 4; ++m)
#pragma unroll
                for (int bj = 0; bj < 2; ++bj) {
                    const int row = row0 + ai * HALF + m * 16, col = col0 + bj * HALF;
                    const u32x4 gz = gz4[m][bj];
                    const f32x4 v0 = acc[ai][bj][m][0], v1 = acc[ai][bj][m][1];
                    u32x4 w;
                    w.x = cvt_pk_bf16(v0[0] * bflo(gz.x), v0[1] * bfhi(gz.x));
                    w.y = cvt_pk_bf16(v0[2] * bflo(gz.y), v0[3] * bfhi(gz.y));
                    w.z = cvt_pk_bf16(v1[0] * bflo(gz.z), v1[1] * bfhi(gz.z));
                    w.w = cvt_pk_bf16(v1[2] * bflo(gz.w), v1[3] * bfhi(gz.w));
                    *(u32x4*)(O + (size_t)row * 1024 + col) = w;
                }
            __builtin_amdgcn_sched_barrier(0);
        }
    }
};
template <int PASS> struct EpiMerge {
    static constexpr bool PERM = true, AFTER_DRAIN = false;
    float* yacc; bf16_t* y; const bf16_t* zg;
    __device__ __forceinline__ void operator()(const f32x4 (&acc)[2][2][4][2], const Unit& u, int wr, int wc, int fr, int fq) const {
        const int row0 = u.pm * BM + wr * 64 + fr, col0 = u.pn * BM + wc * 32 + 8 * fq;
#pragma unroll
        for (int ai = 0; ai < 2; ++ai)
#pragma unroll
            for (int m = 0; m < 4; ++m)
#pragma unroll
                for (int bj = 0; bj < 2; ++bj) {
                    const int row = row0 + ai * HALF + m * 16, col = col0 + bj * HALF;
                    float gz[8]; unpack8(*(const u32x4*)(zg + (size_t)row * NZ + col), gz);
                    const f32x4 v0 = acc[ai][bj][m][0], v1 = acc[ai][bj][m][1];
                    f32x4 r0, r1;
#pragma unroll
                    for (int e = 0; e < 4; ++e) { r0[e] = v0[e] * sigmoid_f(gz[e]); r1[e] = v1[e] * sigmoid_f(gz[4 + e]); }
                    float* yp = yacc + (size_t)row * DM + col;
                    if (PASS >= 1) { r0 += *(const f32x4*)yp; r1 += *(const f32x4*)(yp + 4); }
                    if (PASS <= 1) { *(f32x4*)yp = r0; *(f32x4*)(yp + 4) = r1; }
                    else { u32x4 w; w.x = cvt_pk_bf16(r0[0], r0[1]); w.y = cvt_pk_bf16(r0[2], r0[3]); w.z = cvt_pk_bf16(r1[0], r1[1]); w.w = cvt_pk_bf16(r1[2], r1[3]);
                        *(u32x4*)(y + (size_t)row * DM + col) = w; }
                    __builtin_amdgcn_sched_barrier(0);
                }
    }
};
struct EpiMerge3 {
    static constexpr bool PERM = true, AFTER_DRAIN = false;
    bf16_t* y; const bf16_t* zg;
    __device__ __forceinline__ void operator()(f32x4 (&acc)[2][2][4][2], const Unit& u, int wr, int wc, int fr, int fq) const {
        const int row0 = u.pm * BM + wr * 64 + fr, col0 = u.pn * BM + wc * 32 + 8 * fq;
        u32x4 ga4[2][4], gb4[2][4];
#pragma unroll
        for (int b = 0; b < 5; ++b) {
            if (b < 4) {
#pragma unroll
                for (int p = 0; p < 4; ++p) { const int ai = b >> 1, m = 2 * (b & 1) + (p >> 1), bj = p & 1;
                    const bf16_t* zp = zg + (size_t)(row0 + ai * HALF + m * 16) * NZ + col0 + bj * HALF + u.seg * 2048;
                    ga4[b & 1][p] = *(const u32x4*)zp; gb4[b & 1][p] = (u.seg < 2) ? *(const u32x4*)(zp + 2048) : (u32x4){0u, 0u, 0u, 0u}; }
            }
            __builtin_amdgcn_sched_barrier(0);
            if (b >= 1) {
                const int c = b - 1;
#pragma unroll
                for (int p = 0; p < 4; ++p) { const int ai = c >> 1, m = 2 * (c & 1) + (p >> 1), bj = p & 1;
                    const int row = row0 + ai * HALF + m * 16, col = col0 + bj * HALF;
                    float ga[8]; unpack8(ga4[c & 1][p], ga);
                    if (u.seg < 2) {
                        float gb[8]; unpack8(gb4[c & 1][p], gb);
#pragma unroll
                        for (int e = 0; e < 8; ++e) { const float ea = __expf(-fminf(fmaxf(ga[e], -30.f), 30.f)), eb = __expf(-fminf(fmaxf(gb[e], -30.f), 30.f));
                            const float ratio = (1.f + eb) * __builtin_amdgcn_rcpf(1.f + ea); acc[ai][bj][m][e >> 2][e & 3] *= ratio; }
                    } else {
                        float r[8];
#pragma unroll
                        for (int e = 0; e < 8; ++e) r[e] = acc[ai][bj][m][e >> 2][e & 3] * __builtin_amdgcn_rcpf(1.f + __expf(-fminf(fmaxf(ga[e], -30.f), 30.f)));
                        u32x4 w; w.x = cvt_pk_bf16(r[0], r[1]); w.y = cvt_pk_bf16(r[2], r[3]); w.z = cvt_pk_bf16(r[4], r[5]); w.w = cvt_pk_bf16(r[6], r[7]);
                        *(u32x4*)(y + (size_t)row * DM + col) = w;
                    }
                }
                __builtin_amdgcn_sched_barrier(0);
            }
        }
    }
};
struct EpiOut {
    static constexpr bool PERM = true, AFTER_DRAIN = false;
    const float* xlat; const float* xctx; float* xnew; const float* mod;
    __device__ __forceinline__ void operator()(const f32x4 (&acc)[2][2][4][2], const Unit& u, int wr, int wc, int fr, int fq) const {
        const int row0 = u.pm * BM + wr * 64 + fr, col0 = u.pn * BM + wc * 32 + 8 * fq;
        const int tile_row = u.pm * BM; const int mr = tile_row < ML ? tile_row / SEQ : 4;
        const float* xo = tile_row < ML ? xlat : (xctx - (size_t)ML * DM);
        const float* gm = mod + mr * 6144 + 4096;
        f32x4 g0[2], g1[2];
#pragma unroll
        for (int bj = 0; bj < 2; ++bj) { g0[bj] = *(const f32x4*)(gm + col0 + bj * HALF); g1[bj] = *(const f32x4*)(gm + col0 + bj * HALF + 4); }
        f32x4 x0[2][4], x1[2][4];
#pragma unroll
        for (int b = 0; b < 5; ++b) {
            if (b < 4) {
#pragma unroll
                for (int p = 0; p < 4; ++p) { const int ai = b >> 1, m = 2 * (b & 1) + (p >> 1), bj = p & 1;
                    const float* xp = xo + (size_t)(row0 + ai * HALF + m * 16) * DM + col0 + bj * HALF; x0[b & 1][p] = *(const f32x4*)xp; x1[b & 1][p] = *(const f32x4*)(xp + 4); }
            }
            __builtin_amdgcn_sched_barrier(0);
            if (b >= 1) {
                const int c = b - 1;
#pragma unroll
                for (int p = 0; p < 4; ++p) { const int ai = c >> 1, m = 2 * (c & 1) + (p >> 1), bj = p & 1;
                    float* op = xnew + (size_t)(row0 + ai * HALF + m * 16) * DM + col0 + bj * HALF;
                    *(f32x4*)op = x0[c & 1][p] + g0[bj] * acc[ai][bj][m][0]; *(f32x4*)(op + 4) = x1[c & 1][p] + g1[bj] * acc[ai][bj][m][1]; }
                __builtin_amdgcn_sched_barrier(0);
            }
        }
    }
};
}

struct Args { const float* in[26]; float* out; unsigned char* ws; int ph_lo, ph_hi; };
enum { I_X = 0, I_C, I_CTX, I_CCTX, I_NORMG, I_WADA, I_BADA, I_WIN, I_POOLW, I_POOLS, I_QNORM, I_KNORM, I_LQ1, I_LK1, I_LQ2, I_LK2, I_SUBLN, I_WGF, I_BGF, I_WGB, I_BGB, I_GLAN, I_WBP, I_WBD, I_WBG, I_WOUT };

__device__ __forceinline__ const float* inp(int i) { const float* const volatile __attribute__((address_space(4)))* kp = (const float* const volatile __attribute__((address_space(4)))*)__builtin_amdgcn_kernarg_segment_ptr(); const GAS float* q = (const GAS float*)kp[i]; asm volatile("" : "+s"(q)); return (const float*)q; }
__device__ __forceinline__ float* arg_out() { float* const volatile __attribute__((address_space(4)))* kp = (float* const volatile __attribute__((address_space(4)))*)__builtin_amdgcn_kernarg_segment_ptr(); GAS float* q = (GAS float*)kp[26]; asm volatile("" : "+s"(q)); return (float*)q; }
__device__ __forceinline__ void transpose_item(const float* W, int K, int N, bf16_t* WT, int row_off, LAS float* scr, int kb, int nb, int lane) {
    const int k0 = 64 * kb, n0 = 32 * nb;
    float tv[32];
#pragma unroll
    for (int i = 0; i < 32; ++i) { const int kk = 2 * i + (lane >> 5); tv[i] = __builtin_nontemporal_load(W + (size_t)(k0 + kk) * N + n0 + (lane & 31)); }
#pragma unroll
    for (int i = 0; i < 32; ++i) { const int kk = 2 * i + (lane >> 5); scr[kk * 33 + (lane & 31)] = tv[i]; }
    asm volatile("s_waitcnt lgkmcnt(0)" ::: "memory");
    const int c = lane & 7;
#pragma unroll
    for (int j = 0; j < 4; ++j) { const int n = (lane >> 3) + 8 * j; const LAS float* s = scr + (8 * c) * 33 + n;
        u32x4 o; o.x = cvt_pk_bf16(s[0 * 33], s[1 * 33]); o.y = cvt_pk_bf16(s[2 * 33], s[3 * 33]); o.z = cvt_pk_bf16(s[4 * 33], s[5 * 33]); o.w = cvt_pk_bf16(s[6 * 33], s[7 * 33]);
        *(u32x4*)(WT + (size_t)(row_off + n0 + n) * K + k0 + 8 * c) = o; }
    asm volatile("s_waitcnt lgkmcnt(0)" ::: "memory");
}

__device__ __forceinline__ void ada_items(const Args& a, LAS unsigned char* lds, int l, int bidx, int nb) {
    const int tid = opaque_tid(), lane = tid & 63, wave = __builtin_amdgcn_readfirstlane(tid >> 6);
    unsigned char* ws = opaque_ptr(a.ws);
    LAS float* sc = (LAS float*)(lds + 69632);
    LAS float* part = (LAS float*)(lds + 69632 + 40960);
    if (bidx < 96) {
        for (int i = tid; i < 5 * 2048; i += 512) { const int r = i >> 11, k = i & 2047; const float v = r < 4 ? inp(I_C)[r * 2048 + k] : inp(I_CCTX)[k]; sc[i] = silu_f(v); }
        __syncthreads();
    }
    for (int it = bidx; it < 96; it += nb) {
        const int cgp = it, col = cgp * 64 + lane;
        const float* W = inp(I_WADA) + (size_t)l * 2048 * 6144 + col;
        float acc[5] = {0.f, 0.f, 0.f, 0.f, 0.f};
#pragma unroll 32
        for (int kk = 0; kk < 256; ++kk) { const int k = wave * 256 + kk; const float wv = __builtin_nontemporal_load(W + (size_t)k * 6144);
#pragma unroll
            for (int r = 0; r < 5; ++r) acc[r] += sc[r * 2048 + k] * wv; }
#pragma unroll
        for (int r = 0; r < 5; ++r) part[(wave * 5 + r) * 64 + lane] = acc[r];
        __syncthreads();
        if (tid < 320) { const int r = tid >> 6, ln = tid & 63; float s2 = inp(I_BADA)[l * 6144 + cgp * 64 + ln];
#pragma unroll
            for (int w = 0; w < 8; ++w) s2 += part[(w * 5 + r) * 64 + ln];
            ((float*)(ws + OFF_MOD))[(l * 5 + r) * 6144 + cgp * 64 + ln] = s2; }
        __syncthreads();
    }
}

__device__ __forceinline__ void convert_layer_weights(const Args& a, LAS unsigned char* lds, int l, int widx, int nw) {
    const int lane = opaque_tid() & 63, wave = __builtin_amdgcn_readfirstlane((int)threadIdx.x >> 6);
    unsigned char* ws = opaque_ptr(a.ws);
    LAS float* scr = (LAS float*)(lds + wave * 8704);
    constexpr int I_IN = 32 * 481, I_B = 16 * 64, I_O = 32 * 64, I_P = 4 * 32, PER_L = I_IN + 3 * I_B + I_O + I_P;
    for (int it = widx; it < PER_L; it += nw) {
        int r = it;
        if (r < I_IN) { const int kb = r / 481, nb = r % 481;
            transpose_item(inp(I_WIN) + (size_t)l * DM * DIN, DM, DIN, (bf16_t*)(ws + OFF_WIN + (size_t)l * SZ_WIN), nb >= 289 ? 224 : 0, scr, kb, nb, lane); continue; }
        r -= I_IN;
        if (r < 3 * I_B) { const int br = r / I_B, rr = r % I_B; const float* W = (br == 0 ? inp(I_WBP) : br == 1 ? inp(I_WBD) : inp(I_WBG)) + (size_t)l * 1024 * DM;
            transpose_item(W, 1024, DM, (bf16_t*)(ws + OFF_WB + (size_t)l * SZ_WB + (size_t)br * DM * 1024 * 2), 0, scr, rr / 64, rr % 64, lane); continue; }
        r -= 3 * I_B;
        if (r < I_O) { transpose_item(inp(I_WOUT) + (size_t)l * DM * DM, DM, DM, (bf16_t*)(ws + OFF_WOUT + (size_t)l * SZ_WOUT), 0, scr, r / 64, r % 64, lane); continue; }
        r -= I_O;
        { const int g = r / 32, rr = r % 32;
          transpose_item(inp(I_POOLW) + (size_t)(l * 4 + g) * 65536, 256, 256, (bf16_t*)(ws + OFF_POOLT + (size_t)l * SZ_POOLT + (size_t)g * 65536 * 2), 0, scr, rr / 8, rr % 8, lane); }
    }
}

__device__ __forceinline__ void phase_p0(const Args& a, LAS unsigned char* lds) {
    const int tid = opaque_tid(), lane = tid & 63, wave = __builtin_amdgcn_readfirstlane(tid >> 6), G = opaque_s(gridDim.x);
    unsigned char* ws = opaque_ptr(a.ws);
    ada_items(a, lds, 0, BID, G);
    if (BID == G - 1 && wave == 0) {
        for (int l = 0; l < 2; ++l) {
            const float s1 = wave_sum(inp(I_LQ1)[l * 64 + lane] * inp(I_LK1)[l * 64 + lane]);
            const float s2 = wave_sum(inp(I_LQ2)[l * 64 + lane] * inp(I_LK2)[l * 64 + lane]);
            const float mq = wave_max(fabsf(inp(I_QNORM)[l * 64 + lane])), mk = wave_max(fabsf(inp(I_KNORM)[l * 64 + lane]));
            const float lam_init = 0.8f - 0.6f * expf(-0.3f * (float)l);
            if (lane == 0) { float* sp = (float*)(ws + OFF_SCAL) + l * 4; sp[0] = expf(s1) - expf(s2) + lam_init; sp[1] = 8.f * LOG2E * mq * mk; sp[2] = lam_init; sp[3] = 0.f; }
        }
    }
    {
        const int nper = 224 * 2048 * 2 / 16;
        for (int i = BID * 512 + tid; i < 2 * nper; i += G * 512) { const int l = i / nper, j = i % nper;
            *(u32x4*)(ws + OFF_WIN + (size_t)l * SZ_WIN + (size_t)9248 * DM * 2 + (size_t)j * 16) = (u32x4){0u, 0u, 0u, 0u}; }
    }
    convert_layer_weights(a, lds, 0, BID * 8 + wave, G * 8);
}

__device__ __forceinline__ void phase_norm(const Args& a, int l) {
    const int tid = opaque_tid(), lane = tid & 63, wave = tid >> 6, G = opaque_s(gridDim.x);
    const int gw = BID * 8 + wave, NGW = G * 8;
    const float* mod = (const float*)(opaque_ptr(a.ws) + OFF_MOD) + (size_t)l * 5 * 6144;
    const float* x1 = (const float*)(opaque_ptr(a.ws) + OFF_X1);
    bf16_t* h = (bf16_t*)(opaque_ptr(a.ws) + OFF_H);
    const float* ng = inp(I_NORMG) + l * DM;
    for (int row = gw; row < MT; row += NGW) {
        const float* src = (l == 0) ? (row < ML ? inp(I_X) + (size_t)row * DM : inp(I_CTX) + (size_t)(row - ML) * DM) : x1 + (size_t)row * DM;
        const int mr = row < ML ? row / SEQ : 4;
        const float* md = mod + mr * 6144;
        f32x4 v[8]; float ss = 0.f;
#pragma unroll
        for (int j = 0; j < 8; ++j) { v[j] = *(const f32x4*)(src + 4 * lane + 256 * j); ss += (v[j][0] * v[j][0] + v[j][1] * v[j][1]) + (v[j][2] * v[j][2] + v[j][3] * v[j][3]); }
        ss = wave_sum(ss);
        const float rstd = rsqrtf(ss * (1.f / DM) + EPS);
#pragma unroll
        for (int j = 0; j < 8; ++j) { const int idx = 4 * lane + 256 * j;
            const f32x4 gg = *(const f32x4*)(ng + idx), sc = *(const f32x4*)(md + 2048 + idx), sh = *(const f32x4*)(md + idx);
            f32x4 o;
#pragma unroll
            for (int e = 0; e < 4; ++e) o[e] = v[j][e] * rstd * gg[e] * (1.f + sc[e]) + sh[e];
            u32x2 w; w.x = cvt_pk_bf16(o[0], o[1]); w.y = cvt_pk_bf16(o[2], o[3]);
            *(u32x2*)(h + (size_t)row * DM + idx) = w; }
    }
}

__device__ __forceinline__ int vt_pos(int key) { const int k = key & 15; return (key & ~15) | (((k >> 2) & 1) << 3) | (k & 3) | (((k >> 3) & 1) << 2); }

__device__ __forceinline__ void phase_prep(const Args& a, int l, LAS unsigned char* lds) {
    const int tid = opaque_tid(), lane = tid & 63, wave = tid >> 6, G = opaque_s(gridDim.x);
    unsigned char* ws = opaque_ptr(a.ws);
    const bf16_t* z = (const bf16_t*)(ws + OFF_Z);
    const bool need_ctx = (l == 0);
    for (int it = BID; it < 1440; it += G) {
        if (it < 576) {
            const int c = it >> 2, cgp = it & 3, rb = 64 * c;
            LAS float* lrs = (LAS float*)lds;
            LAS float* segs = (LAS float*)(lds + 8192);
            for (int i = tid; i < 64 * 32; i += 512) { const int r = i >> 5, cc = i & 31; lrs[i] = bf2f(z[(size_t)(rb + r) * NZ + ZC_LR + cc]); }
            __syncthreads();
            const int seg = tid >> 6, cp = tid & 63, ch = cgp * 128 + 2 * cp;
            typedef float f32x2v __attribute__((ext_vector_type(2)));
            const float* wgf = inp(I_WGF) + (size_t)l * 16 * 512 + ch; const float* wgb = inp(I_WGB) + (size_t)l * 16 * 512 + ch;
            f32x2v wf[16], wb[16];
#pragma unroll
            for (int r = 0; r < 16; ++r) { wf[r] = *(const f32x2v*)(wgf + r * 512); wb[r] = *(const f32x2v*)(wgb + r * 512); }
            const f32x2v bfv = *(const f32x2v*)(inp(I_BGF) + l * 512 + ch), bbv = *(const f32x2v*)(inp(I_BGB) + l * 512 + ch);
            f32x2v gf[8], gb[8]; f32x2v sf = {0.f, 0.f}, sb = {0.f, 0.f};
#pragma unroll
            for (int i = 0; i < 8; ++i) { const int t = seg * 8 + i; f32x2v af = bfv, ab = bbv;
#pragma unroll
                for (int r4 = 0; r4 < 4; ++r4) { const f32x4 lf = *(const LAS f32x4*)(lrs + t * 32 + 4 * r4), lb = *(const LAS f32x4*)(lrs + t * 32 + 16 + 4 * r4);
#pragma unroll
                    for (int e = 0; e < 4; ++e) { af += lf[e] * wf[4 * r4 + e]; ab += lb[e] * wb[4 * r4 + e]; } }
                gf[i].x = logsig_f(af.x) * (1.f / 16.f); gf[i].y = logsig_f(af.y) * (1.f / 16.f);
                gb[i].x = logsig_f(ab.x) * (1.f / 16.f); gb[i].y = logsig_f(ab.y) * (1.f / 16.f); sf += gf[i]; sb += gb[i]; }
            *(LAS f32x2v*)(segs + seg * 128 + 2 * cp) = sf; *(LAS f32x2v*)(segs + 1024 + seg * 128 + 2 * cp) = sb;
            __syncthreads();
            f32x2v pf = {0.f, 0.f}, pb = {0.f, 0.f}, totf = {0.f, 0.f}, totb = {0.f, 0.f};
#pragma unroll
            for (int s2 = 0; s2 < 8; ++s2) { const f32x2v vf = *(const LAS f32x2v*)(segs + s2 * 128 + 2 * cp), vb = *(const LAS f32x2v*)(segs + 1024 + s2 * 128 + 2 * cp);
                totf += vf; totb += vb; if (s2 < seg) { pf += vf; pb += vb; } }
            unsigned* gq0 = (unsigned*)(ws + OFF_GQ), *gq1 = (unsigned*)(ws + OFF_GQ + SZ_G);
            unsigned* gk0 = (unsigned*)(ws + OFF_GK), *gk1 = (unsigned*)(ws + OFF_GK + SZ_G);
            bf16_t* gh0 = (bf16_t*)(ws + OFF_GH), *gh1 = (bf16_t*)(ws + OFF_GH + SZ_G);
            f32x2v h0[8], h1[8];
#pragma unroll
            for (int i = 0; i < 8; ++i) { const int t = seg * 8 + i;
                pf += gf[i]; const f32x2v bs = totb - pb; pb += gb[i];
                const size_t row = rb + t;
                const unsigned qw = *(const unsigned*)(z + row * NZ + ZC_GQ + ch), kw = *(const unsigned*)(z + row * NZ + ZC_GK + ch);
                const float q0 = bflo(qw) * 0.08838834764831845f, q1 = bfhi(qw) * 0.08838834764831845f, k0 = bflo(kw), k1 = bfhi(kw);
                const size_t o = (row * 512 + ch) >> 1;
                gq0[o] = cvt_pk_bf16(q0 * __expf(pf.x), q1 * __expf(pf.y)); gk0[o] = cvt_pk_bf16(k0 * __expf(-pf.x), k1 * __expf(-pf.y));
                gq1[o] = cvt_pk_bf16(q0 * __expf(bs.x), q1 * __expf(bs.y)); gk1[o] = cvt_pk_bf16(k0 * __expf(-bs.x), k1 * __expf(-bs.y));
                h0[i].x = k0 * __expf(totf.x - pf.x); h0[i].y = k1 * __expf(totf.y - pf.y);
                h1[i].x = k0 * __expf(totb.x - bs.x); h1[i].y = k1 * __expf(totb.y - bs.y); }
            {
#pragma unroll
                for (int cc = 0; cc < 2; ++cc) { u32x4 w0, w1;
                    w0.x = cvt_pk_bf16(h0[0][cc], h0[1][cc]); w0.y = cvt_pk_bf16(h0[2][cc], h0[3][cc]); w0.z = cvt_pk_bf16(h0[4][cc], h0[5][cc]); w0.w = cvt_pk_bf16(h0[6][cc], h0[7][cc]);
                    w1.x = cvt_pk_bf16(h1[0][cc], h1[1][cc]); w1.y = cvt_pk_bf16(h1[2][cc], h1[3][cc]); w1.z = cvt_pk_bf16(h1[4][cc], h1[5][cc]); w1.w = cvt_pk_bf16(h1[6][cc], h1[7][cc]);
                    const size_t oh = ((size_t)c * 512 + ch + cc) * 64 + seg * 8;
                    *(u32x4*)(gh0 + oh) = w0; *(u32x4*)(gh1 + oh) = w1; } }
            if (seg == 0) { float* dec = (float*)(ws + OFF_DEC);
                *(f32x2v*)(dec + (size_t)c * 512 + ch) = (f32x2v){__expf(totf.x), __expf(totf.y)}; *(f32x2v*)(dec + (size_t)(144 + c) * 512 + ch) = (f32x2v){__expf(totb.x), __expf(totb.y)}; }
            __syncthreads();
        } else if (it < 864) {
            const int rb = 32 * (it - 576); if (!need_ctx && rb >= ML) continue;
            const int seq0 = rb < ML ? (rb / SEQ) * SEQ : ML + ((rb - ML) / LC) * LC; const int L = rb < ML ? SEQ : LC;
            const int ts = rb - seq0;
            bf16_t* dp = (bf16_t*)(ws + OFF_DPOOL); bf16_t* pgt = (bf16_t*)(ws + OFF_PGATE);
#pragma unroll
            for (int i = 0; i < 12; ++i) { const int idx = tid + 512 * i, rr = idx >> 7, c8 = (idx & 127) * 8, p = ts - 8 + rr;
                if (p >= 0 && p < L) *(LAS u32x4*)(lds + rr * 2048 + c8 * 2) = *(const u32x4*)(z + (size_t)(seq0 + p) * NZ + ZC_PU + c8); }
            __syncthreads();
            const int ch8 = 8 * (tid & 127), tg = tid >> 7, hw = 1 << (ch8 >> 8);
            const int tl0 = ts + 8 * tg;
            float psc[8];
            { const float* pp = inp(I_POOLS) + l * 1024 + ch8; const f32x4 p0 = *(const f32x4*)pp, p1 = *(const f32x4*)(pp + 4);
#pragma unroll
              for (int e = 0; e < 4; ++e) { psc[e] = p0[e]; psc[4 + e] = p1[e]; } }
            u32x4 pgw[8];
#pragma unroll
            for (int t = 0; t < 8; ++t) pgw[t] = *(const u32x4*)(z + (size_t)(seq0 + tl0 + t) * NZ + ZC_PG + ch8);
            const LAS unsigned char* lc = lds + ch8 * 2 - (ts - 8) * 2048;
            float sm[8] = {0.f, 0.f, 0.f, 0.f, 0.f, 0.f, 0.f, 0.f};
            { const int lo = max(tl0 - hw, 0), hi = min(tl0 + hw, L);
              for (int p = lo; p < hi; ++p) { float u[8]; unpack8(*(const LAS u32x4*)(lc + p * 2048), u);
#pragma unroll
                  for (int e = 0; e < 8; ++e) sm[e] += u[e]; } }
#pragma unroll
            for (int t = 0; t < 8; ++t) { const int tl = tl0 + t; const int lo = max(tl - hw, 0), hi = min(tl + hw, L);
                const float rc = __builtin_amdgcn_rcpf((float)(hi - lo));
                float cur[8], pgv[8], ua[8], ur[8];
                unpack8(*(const LAS u32x4*)(lc + tl * 2048), cur); unpack8(pgw[t], pgv);
                unpack8(*(const LAS u32x4*)(lc + min(tl + hw, L - 1) * 2048), ua); unpack8(*(const LAS u32x4*)(lc + max(tl - hw, 0) * 2048), ur);
                const float ma = (tl + hw < L) ? 1.f : 0.f, mr = (tl - hw >= 0) ? 1.f : 0.f;
                u32x4 wd, wg;
                wd.x = cvt_pk_bf16(sm[0] * rc - cur[0], sm[1] * rc - cur[1]); wd.y = cvt_pk_bf16(sm[2] * rc - cur[2], sm[3] * rc - cur[3]);
                wd.z = cvt_pk_bf16(sm[4] * rc - cur[4], sm[5] * rc - cur[5]); wd.w = cvt_pk_bf16(sm[6] * rc - cur[6], sm[7] * rc - cur[7]);
                wg.x = cvt_pk_bf16(psc[0] * silu_f(pgv[0]), psc[1] * silu_f(pgv[1])); wg.y = cvt_pk_bf16(psc[2] * silu_f(pgv[2]), psc[3] * silu_f(pgv[3]));
                wg.z = cvt_pk_bf16(psc[4] * silu_f(pgv[4]), psc[5] * silu_f(pgv[5])); wg.w = cvt_pk_bf16(psc[6] * silu_f(pgv[6]), psc[7] * silu_f(pgv[7]));
                const size_t o = (size_t)(seq0 + tl) * 1024 + ch8;
                *(u32x4*)(dp + o) = wd; *(u32x4*)(pgt + o) = wg;
#pragma unroll
                for (int e = 0; e < 8; ++e) sm[e] += ma * ua[e] - mr * ur[e]; }
            __syncthreads();
        } else {
            const int vi = it - 864, isg = vi >= 288, vj = isg ? vi - 288 : vi, c = vj >> 1, hv = vj & 1, rb = 64 * c;
            int b, key0; if (rb < ML) { b = rb >> 11; key0 = LC + (rb & 2047); } else { b = (rb - ML) >> 8; key0 = (rb - ML) & 255; }
            bf16_t* vT = (bf16_t*)(ws + OFF_VT); bf16_t* gvT = (bf16_t*)(ws + OFF_GVT);
#pragma unroll
            for (int i = 0; i < 8; ++i) { const int idx = tid + 512 * i, key = idx & 63, c8 = (idx >> 6) * 8;
                const u32x4 w = *(const u32x4*)(z + (size_t)(rb + key) * NZ + (isg ? ZC_GV : ZC_DV) + hv * 512 + c8);
                const unsigned ww[4] = {w.x, w.y, w.z, w.w}; const int pos = isg ? key : vt_pos(key);
#pragma unroll
                for (int e = 0; e < 8; ++e) *(LAS bf16_t*)(lds + (c8 + e) * 144 + pos * 2) = (bf16_t)((e & 1) ? (ww[e >> 1] >> 16) : (ww[e >> 1] & 0xffffu)); }
            __syncthreads();
#pragma unroll
            for (int i = 0; i < 8; ++i) { const int idx = tid + 512 * i, col = idx >> 3, k8 = idx & 7, colg = hv * 512 + col, h = colg >> 7, v = colg & 127;
                bf16_t* dst = isg ? gvT + ((size_t)c * 1024 + colg) * 64 + k8 * 8 : vT + ((size_t)(b * 8 + h) * 128 + v) * LK + key0 + k8 * 8;
                *(u32x4*)dst = *(const LAS u32x4*)(lds + col * 144 + k8 * 16); }
            __syncthreads();
        }
    }
    {
        const int gw = BID * 8 + wave, NGW = G * 8;
        bf16_t* qn = (bf16_t*)(ws + OFF_QN); bf16_t* qnc = (bf16_t*)(ws + OFF_QNC); bf16_t* kn = (bf16_t*)(ws + OFF_KN);
        for (int it = gw; it < MT * 2; it += NGW) {
            const int row = it >> 1, which = it & 1;
            const bool isctx = row >= ML; int b, t; if (!isctx) { b = row >> 11; t = row & 2047; } else { b = (row - ML) >> 8; t = (row - ML) & 255; }
            const bf16_t* zr = z + (size_t)row * NZ;
            {
                if (which == 0 && isctx && !need_ctx) continue;
                float x[16]; const bf16_t* src = zr + (which == 0 ? ZC_DQ : ZC_DK) + 16 * lane;
                unpack8(*(const u32x4*)src, x); unpack8(*(const u32x4*)(src + 8), x + 8);
                float ss = 0.f;
#pragma unroll
                for (int e = 0; e < 16; ++e) ss += x[e] * x[e];
                ss += __shfl_xor(ss, 1); ss += __shfl_xor(ss, 2);
                const float rstd = rsqrtf(ss * (1.f / 64.f) + EPS);
                const int m = lane & 3, sh = lane >> 2, h = sh >> 1, j = sh & 1;
                const float* gain = (which == 0 ? inp(I_QNORM) : inp(I_KNORM)) + l * 64 + 16 * m;
                float y[16];
#pragma unroll
                for (int e = 0; e < 16; ++e) y[e] = x[e] * rstd * gain[e];
                if (!isctx) {
                    const float posf = (float)((m & 1) ? (t & 63) : (t >> 6));
#pragma unroll
                    for (int e = 0; e < 16; ++e) { const float yp = __shfl_xor(y[e], 2);
                        const float ang = posf * exp2f(-(float)e * 0.8304820237218405f);
                        const float cs = __cosf(ang), sn = __sinf(ang);
                        y[e] = (m < 2) ? (y[e] * cs - yp * sn) : (y[e] * cs + yp * sn); }
                }
                bf16_t* dst;
                if (which == 0) {
#pragma unroll
                    for (int e = 0; e < 16; ++e) y[e] *= 0.125f * LOG2E;
                    dst = isctx ? qnc + (((size_t)(b * 8 + h) * 2 + j) * LC + t) * 64 + 16 * m : qn + (((size_t)(b * 8 + h) * 2 + j) * SEQ + t) * 64 + 16 * m;
                } else dst = kn + (((size_t)(b * 8 + h) * 2 + j) * LK + (isctx ? t : LC + t)) * 64 + 16 * m;
                u32x4 w0, w1;
                w0.x = cvt_pk_bf16(y[0], y[1]); w0.y = cvt_pk_bf16(y[2], y[3]); w0.z = cvt_pk_bf16(y[4], y[5]); w0.w = cvt_pk_bf16(y[6], y[7]);
                w1.x = cvt_pk_bf16(y[8], y[9]); w1.y = cvt_pk_bf16(y[10], y[11]); w1.z = cvt_pk_bf16(y[12], y[13]); w1.w = cvt_pk_bf16(y[14], y[15]);
                *(u32x4*)dst = w0; *(u32x4*)(dst + 8) = w1;
            }
        }
    }
}

constexpr int GL_Q = 0, GL_K = 17408, GL_KH = 34816, GL_VT = 53248, GL_ATT = 57856, GL_ST = 67072;
__device__ __forceinline__ void gla_unit(const Args& a, int l, LAS unsigned char* lds, int item) {
    const int tid = opaque_tid(), lane = tid & 63, w = __builtin_amdgcn_readfirstlane(tid >> 6);
    const int vs = item & 7, dir = (item >> 3) & 1, h = (item >> 4) & 3, b = item >> 6;
    const bool need_ctx = (l == 0);
    unsigned char* ws = opaque_ptr(a.ws);
    const bf16_t* z = (const bf16_t*)(ws + OFF_Z);
    const bf16_t* gq = (const bf16_t*)(ws + OFF_GQ + dir * SZ_G) + h * 128;
    const bf16_t* gk = (const bf16_t*)(ws + OFF_GK + dir * SZ_G) + h * 128;
    const bf16_t* gh = (const bf16_t*)(ws + OFF_GH + dir * SZ_G) + (size_t)h * 128 * 64;
    const float* dec = (const float*)(ws + OFF_DEC) + (size_t)dir * 144 * 512 + h * 128;
    bf16_t* od = (bf16_t*)(ws + OFF_OF + (size_t)dir * MT * 1024 * 2) + h * 256 + vs * 32;
    const bf16_t* gvt = (const bf16_t*)(ws + OFF_GVT) + (size_t)(h * 256 + vs * 32) * 64;
    const int fr = lane & 15, fq = lane >> 4;
    f32x4 sacc[2] = {(f32x4){0.f, 0.f, 0.f, 0.f}, (f32x4){0.f, 0.f, 0.f, 0.f}};
    for (int i = tid; i < 32 * 136 / 2; i += 512) ((LAS unsigned*)(lds + GL_ST))[i] = 0u;
    u32x4 rqA[2], rkA[2], rhA[2], rvA, rqB[2], rkB[2], rhB[2], rvB; float rdecA, rdecB;
    auto rowbase = [&](int s) -> int { if (s < 4) { const int ci = dir == 0 ? s : 3 - s; return ML + b * LC + 64 * ci; } const int ci = dir == 0 ? s - 4 : 35 - s; return b * SEQ + 64 * ci; };
#define GLA_LOADA(s) do { const int _rb = rowbase(s); _Pragma("unroll") for (int _i = 0; _i < 2; ++_i) { const int _idx = tid + 512 * _i, _r = _idx >> 4, _c = (_idx & 15) * 8; const size_t _o = (size_t)(_rb + _r) * 512 + _c; \
        rqA[_i] = *(const u32x4*)(gq + _o); rkA[_i] = *(const u32x4*)(gk + _o); rhA[_i] = *(const u32x4*)(gh + ((size_t)(_rb >> 6) * 512 + (_idx >> 3)) * 64 + (_idx & 7) * 8); } \
        if (tid < 256) rvA = *(const u32x4*)(gvt + ((size_t)(_rb >> 6) * 1024 + (tid >> 3)) * 64 + (tid & 7) * 8); \
        rdecA = dec[(size_t)(_rb >> 6) * 512 + 16 * w + fr]; } while (0)
#define GLA_LOADB(s) do { const int _rb = rowbase(s); _Pragma("unroll") for (int _i = 0; _i < 2; ++_i) { const int _idx = tid + 512 * _i, _r = _idx >> 4, _c = (_idx & 15) * 8; const size_t _o = (size_t)(_rb + _r) * 512 + _c; \
        rqB[_i] = *(const u32x4*)(gq + _o); rkB[_i] = *(const u32x4*)(gk + _o); rhB[_i] = *(const u32x4*)(gh + ((size_t)(_rb >> 6) * 512 + (_idx >> 3)) * 64 + (_idx & 7) * 8); } \
        if (tid < 256) rvB = *(const u32x4*)(gvt + ((size_t)(_rb >> 6) * 1024 + (tid >> 3)) * 64 + (tid & 7) * 8); \
        rdecB = dec[(size_t)(_rb >> 6) * 512 + 16 * w + fr]; } while (0)
    GLA_LOADA(0); GLA_LOADB(1);
    for (int s0_ = 0; s0_ < 36; s0_ += 2) {
      { const int s = s0_;
        const int rb = rowbase(s);
        const float dk = rdecA;
#pragma unroll
        for (int i = 0; i < 2; ++i) { const int idx = tid + 512 * i, r = idx >> 4, c = (idx & 15) * 8;
            *(LAS u32x4*)(lds + GL_Q + r * 272 + c * 2) = rqA[i]; *(LAS u32x4*)(lds + GL_K + r * 272 + c * 2) = rkA[i];
            const int s0 = (idx & 7) * 8, p1 = (s0 & 32) + 8 * ((s0 & 15) >> 2) + 4 * ((s0 >> 4) & 1);
            *(LAS u32x2*)(lds + GL_KH + (idx >> 3) * 144 + p1 * 2) = (u32x2){rhA[i].x, rhA[i].y}; *(LAS u32x2*)(lds + GL_KH + (idx >> 3) * 144 + (p1 + 8) * 2) = (u32x2){rhA[i].z, rhA[i].w}; }
        if (tid < 256) { const int s0 = (tid & 7) * 8, p1 = (s0 & 32) + 8 * ((s0 & 15) >> 2) + 4 * ((s0 >> 4) & 1);
            *(LAS u32x2*)(lds + GL_VT + (tid >> 3) * 144 + p1 * 2) = (u32x2){rvA.x, rvA.y}; *(LAS u32x2*)(lds + GL_VT + (tid >> 3) * 144 + (p1 + 8) * 2) = (u32x2){rvA.z, rvA.w}; }
        __syncthreads();
        if (s + 2 < 36) GLA_LOADA(s + 2);
        const int tt = w >> 1, vt = w & 1;
        bf16x8 pb[2];
        {
            f32x4 at[4];
#pragma unroll
            for (int st = 0; st < 4; ++st) { f32x4 acc = (f32x4){0.f, 0.f, 0.f, 0.f};
#pragma unroll
                for (int kk = 0; kk < 4; ++kk) { const bf16x8 af = *(const LAS bf16x8*)(lds + GL_K + (16 * st + fr) * 272 + (32 * kk + 8 * fq) * 2);
                    const bf16x8 bfr = *(const LAS bf16x8*)(lds + GL_Q + (16 * tt + fr) * 272 + (32 * kk + 8 * fq) * 2);
                    acc = __builtin_amdgcn_mfma_f32_16x16x32_bf16(af, bfr, acc, 0, 0, 0); }
#pragma unroll
                for (int j = 0; j < 4; ++j) { const int sc = 16 * st + 4 * fq + j, t = 16 * tt + fr; const bool keep = dir == 0 ? (sc <= t) : (sc >= t); acc[j] = keep ? acc[j] : 0.f; }
                at[st] = acc; }
#pragma unroll
            for (int p = 0; p < 2; ++p) { u32x4 pw; pw.x = cvt_pk_bf16(at[2 * p][0], at[2 * p][1]); pw.y = cvt_pk_bf16(at[2 * p][2], at[2 * p][3]);
                pw.z = cvt_pk_bf16(at[2 * p + 1][0], at[2 * p + 1][1]); pw.w = cvt_pk_bf16(at[2 * p + 1][2], at[2 * p + 1][3]); pb[p] = __builtin_bit_cast(bf16x8, pw); }
        }
        {
            f32x4 acc = (f32x4){0.f, 0.f, 0.f, 0.f};
#pragma unroll
            for (int kk = 0; kk < 4; ++kk) { const bf16x8 af = *(const LAS bf16x8*)(lds + GL_ST + (16 * vt + fr) * 272 + (32 * kk + 8 * fq) * 2);
                const bf16x8 bfr = *(const LAS bf16x8*)(lds + GL_Q + (16 * tt + fr) * 272 + (32 * kk + 8 * fq) * 2);
                acc = __builtin_amdgcn_mfma_f32_16x16x32_bf16(af, bfr, acc, 0, 0, 0); }
#pragma unroll
            for (int p = 0; p < 2; ++p) { const bf16x8 af = *(const LAS bf16x8*)(lds + GL_VT + (16 * vt + fr) * 144 + (32 * p + 8 * fq) * 2);
                acc = __builtin_amdgcn_mfma_f32_16x16x32_bf16(af, pb[p], acc, 0, 0, 0); }
            if (s >= 4 || need_ctx) { u32x2 wv; wv.x = cvt_pk_bf16(acc[0], acc[1]); wv.y = cvt_pk_bf16(acc[2], acc[3]);
                *(u32x2*)(od + (size_t)(rb + 16 * tt + fr) * 1024 + 16 * vt + 4 * fq) = wv; }
        }
#pragma unroll
        for (int vt2 = 0; vt2 < 2; ++vt2) { f32x4 acc = sacc[vt2] * dk;
#pragma unroll
            for (int kk = 0; kk < 2; ++kk) { const bf16x8 af = *(const LAS bf16x8*)(lds + GL_VT + (16 * vt2 + fr) * 144 + (32 * kk + 8 * fq) * 2);
                const bf16x8 bfr = *(const LAS bf16x8*)(lds + GL_KH + (16 * w + fr) * 144 + (32 * kk + 8 * fq) * 2);
                acc = __builtin_amdgcn_mfma_f32_16x16x32_bf16(af, bfr, acc, 0, 0, 0); }
            sacc[vt2] = acc; }
        __syncthreads();
#pragma unroll
        for (int vt = 0; vt < 2; ++vt)
#pragma unroll
            for (int j = 0; j < 4; ++j) *(LAS bf16_t*)(lds + GL_ST + (16 * vt + 4 * fq + j) * 272 + (16 * w + fr) * 2) = f2bf(sacc[vt][j]);
      }
      { const int s = s0_ + 1;
        const int rb = rowbase(s);
        const float dk = rdecB;
#pragma unroll
        for (int i = 0; i < 2; ++i) { const int idx = tid + 512 * i, r = idx >> 4, c = (idx & 15) * 8;
            *(LAS u32x4*)(lds + GL_Q + r * 272 + c * 2) = rqB[i]; *(LAS u32x4*)(lds + GL_K + r * 272 + c * 2) = rkB[i];
            const int s0 = (idx & 7) * 8, p1 = (s0 & 32) + 8 * ((s0 & 15) >> 2) + 4 * ((s0 >> 4) & 1);
            *(LAS u32x2*)(lds + GL_KH + (idx >> 3) * 144 + p1 * 2) = (u32x2){rhB[i].x, rhB[i].y}; *(LAS u32x2*)(lds + GL_KH + (idx >> 3) * 144 + (p1 + 8) * 2) = (u32x2){rhB[i].z, rhB[i].w}; }
        if (tid < 256) { const int s0 = (tid & 7) * 8, p1 = (s0 & 32) + 8 * ((s0 & 15) >> 2) + 4 * ((s0 >> 4) & 1);
            *(LAS u32x2*)(lds + GL_VT + (tid >> 3) * 144 + p1 * 2) = (u32x2){rvB.x, rvB.y}; *(LAS u32x2*)(lds + GL_VT + (tid >> 3) * 144 + (p1 + 8) * 2) = (u32x2){rvB.z, rvB.w}; }
        __syncthreads();
        if (s + 2 < 36) GLA_LOADB(s + 2);
        const int tt = w >> 1, vt = w & 1;
        bf16x8 pb[2];
        {
            f32x4 at[4];
#pragma unroll
            for (int st = 0; st < 4; ++st) { f32x4 acc = (f32x4){0.f, 0.f, 0.f, 0.f};
#pragma unroll
                for (int kk = 0; kk < 4; ++kk) { const bf16x8 af = *(const LAS bf16x8*)(lds + GL_K + (16 * st + fr) * 272 + (32 * kk + 8 * fq) * 2);
                    const bf16x8 bfr = *(const LAS bf16x8*)(lds + GL_Q + (16 * tt + fr) * 272 + (32 * kk + 8 * fq) * 2);
                    acc = __builtin_amdgcn_mfma_f32_16x16x32_bf16(af, bfr, acc, 0, 0, 0); }
#pragma unroll
                for (int j = 0; j < 4; ++j) { const int sc = 16 * st + 4 * fq + j, t = 16 * tt + fr; const bool keep = dir == 0 ? (sc <= t) : (sc >= t); acc[j] = keep ? acc[j] : 0.f; }
                at[st] = acc; }
#pragma unroll
            for (int p = 0; p < 2; ++p) { u32x4 pw; pw.x = cvt_pk_bf16(at[2 * p][0], at[2 * p][1]); pw.y = cvt_pk_bf16(at[2 * p][2], at[2 * p][3]);
                pw.z = cvt_pk_bf16(at[2 * p + 1][0], at[2 * p + 1][1]); pw.w = cvt_pk_bf16(at[2 * p + 1][2], at[2 * p + 1][3]); pb[p] = __builtin_bit_cast(bf16x8, pw); }
        }
        {
            f32x4 acc = (f32x4){0.f, 0.f, 0.f, 0.f};
#pragma unroll
            for (int kk = 0; kk < 4; ++kk) { const bf16x8 af = *(const LAS bf16x8*)(lds + GL_ST + (16 * vt + fr) * 272 + (32 * kk + 8 * fq) * 2);
                const bf16x8 bfr = *(const LAS bf16x8*)(lds + GL_Q + (16 * tt + fr) * 272 + (32 * kk + 8 * fq) * 2);
                acc = __builtin_amdgcn_mfma_f32_16x16x32_bf16(af, bfr, acc, 0, 0, 0); }
#pragma unroll
            for (int p = 0; p < 2; ++p) { const bf16x8 af = *(const LAS bf16x8*)(lds + GL_VT + (16 * vt + fr) * 144 + (32 * p + 8 * fq) * 2);
                acc = __builtin_amdgcn_mfma_f32_16x16x32_bf16(af, pb[p], acc, 0, 0, 0); }
            if (s >= 4 || need_ctx) { u32x2 wv; wv.x = cvt_pk_bf16(acc[0], acc[1]); wv.y = cvt_pk_bf16(acc[2], acc[3]);
                *(u32x2*)(od + (size_t)(rb + 16 * tt + fr) * 1024 + 16 * vt + 4 * fq) = wv; }
        }
#pragma unroll
        for (int vt2 = 0; vt2 < 2; ++vt2) { f32x4 acc = sacc[vt2] * dk;
#pragma unroll
            for (int kk = 0; kk < 2; ++kk) { const bf16x8 af = *(const LAS bf16x8*)(lds + GL_VT + (16 * vt2 + fr) * 144 + (32 * kk + 8 * fq) * 2);
                const bf16x8 bfr = *(const LAS bf16x8*)(lds + GL_KH + (16 * w + fr) * 144 + (32 * kk + 8 * fq) * 2);
                acc = __builtin_amdgcn_mfma_f32_16x16x32_bf16(af, bfr, acc, 0, 0, 0); }
            sacc[vt2] = acc; }
        __syncthreads();
#pragma unroll
        for (int vt = 0; vt < 2; ++vt)
#pragma unroll
            for (int j = 0; j < 4; ++j) *(LAS bf16_t*)(lds + GL_ST + (16 * vt + 4 * fq + j) * 272 + (16 * w + fr) * 2) = f2bf(sacc[vt][j]);
      }
    }
    __syncthreads();
#undef GLA_LOADA
#undef GLA_LOADB
}

constexpr int AT_BUF = 36864, AT_K = 0, AT_V = 18432;
template <bool SHIFT>
__device__ __forceinline__ void attn_unit(LAS unsigned char* lds, const bf16_t* qbase, int Lq, int q0, const bf16_t* kbase, const bf16_t* vtbase, int nkeys,
                                          float c2, float lam, float post_scale, const float* subln, const bf16_t* dg, bf16_t* outp, int row0) {
    const int tid = opaque_tid(), lane = tid & 63, w = __builtin_amdgcn_readfirstlane(tid >> 6), q32 = lane & 31, hi = lane >> 5;
    const int j = w >> 2, qg = w & 3;
    bf16x8 qf[4];
#pragma unroll
    for (int kk = 0; kk < 4; ++kk) qf[kk] = *(const bf16x8*)(qbase + ((size_t)j * Lq + q0 + 32 * qg + q32) * 64 + 16 * kk + 8 * hi);
    f32x16 o[4];
#pragma unroll
    for (int vt = 0; vt < 4; ++vt)
#pragma unroll
        for (int r = 0; r < 16; ++r) o[vt][r] = 0.f;
    float lsum = 0.f;
    const int nt = nkeys >> 6;
    u32x4 skA[2], svA[2];
#define AT_LOAD(sk, sv, i) do { _Pragma("unroll") for (int _c = 0; _c < 2; ++_c) { const int _idx = tid + 512 * _c; \
        sk[_c] = *(const u32x4*)(kbase + ((size_t)(_idx >> 9) * LK + 64 * (i) + ((_idx & 511) >> 3)) * 64 + (_idx & 7) * 8); \
        sv[_c] = *(const u32x4*)(vtbase + (size_t)(_idx >> 3) * LK + 64 * (i) + (_idx & 7) * 8); } } while (0)
#define AT_STORE(sk, sv, p) do { _Pragma("unroll") for (int _c = 0; _c < 2; ++_c) { const int _idx = tid + 512 * _c; \
        *(LAS u32x4*)(lds + (p) * AT_BUF + AT_K + ((_idx >> 9) * 64 + ((_idx & 511) >> 3)) * 144 + (_idx & 7) * 16) = sk[_c]; \
        *(LAS u32x4*)(lds + (p) * AT_BUF + AT_V + (_idx >> 3) * 144 + (_idx & 7) * 16) = sv[_c]; } } while (0)
#define AT_KF(kb, kk) (*(const LAS bf16x8*)(Kb + (32 * (kb) + q32) * 144 + (16 * (kk) + 8 * hi) * 2))
#define AT_VF(ks, vt) (*(const LAS bf16x8*)(Vb + (32 * (vt) + q32) * 144 + (16 * (ks) + 8 * hi) * 2))
#define AT_TILE(p) do { \
        LAS unsigned char* Kb = lds + (p) * AT_BUF + AT_K + j * (64 * 144); LAS unsigned char* Vb = lds + (p) * AT_BUF + AT_V; \
        bf16x8 kf[4], vf[4], vg[4]; \
        _Pragma("unroll") for (int kk = 0; kk < 4; ++kk) kf[kk] = AT_KF(0, kk); \
        _Pragma("unroll") for (int kb = 0; kb < 2; ++kb) { \
            _Pragma("unroll") for (int vt = 0; vt < 4; ++vt) vf[vt] = AT_VF(2 * kb, vt); \
            __builtin_amdgcn_sched_barrier(0); \
            f32x16 s; \
            _Pragma("unroll") for (int r = 0; r < 16; ++r) s[r] = 0.f; \
            _Pragma("unroll") for (int kk = 0; kk < 4; ++kk) s = __builtin_amdgcn_mfma_f32_32x32x16_bf16(kf[kk], qf[kk], s, 0, 0, 0); \
            __builtin_amdgcn_sched_barrier(0); \
            _Pragma("unroll") for (int vt = 0; vt < 4; ++vt) vg[vt] = AT_VF(2 * kb + 1, vt); \
            if (kb == 0) { _Pragma("unroll") for (int kk = 0; kk < 4; ++kk) kf[kk] = AT_KF(1, kk); } \
            __builtin_amdgcn_sched_barrier(0); \
            _Pragma("unroll") for (int r = 0; r < 16; ++r) { s[r] = __builtin_amdgcn_exp2f(SHIFT ? s[r] - c2 : s[r]); lsum += s[r]; } \
            u32x4 pw0, pw1; \
            pw0.x = cvt_pk_bf16(s[0], s[1]); pw0.y = cvt_pk_bf16(s[2], s[3]); pw0.z = cvt_pk_bf16(s[4], s[5]); pw0.w = cvt_pk_bf16(s[6], s[7]); \
            pw1.x = cvt_pk_bf16(s[8], s[9]); pw1.y = cvt_pk_bf16(s[10], s[11]); pw1.z = cvt_pk_bf16(s[12], s[13]); pw1.w = cvt_pk_bf16(s[14], s[15]); \
            const bf16x8 pb0 = __builtin_bit_cast(bf16x8, pw0), pb1 = __builtin_bit_cast(bf16x8, pw1); \
            _Pragma("unroll") for (int vt = 0; vt < 4; ++vt) o[vt] = __builtin_amdgcn_mfma_f32_32x32x16_bf16(vf[vt], pb0, o[vt], 0, 0, 0); \
            _Pragma("unroll") for (int vt = 0; vt < 4; ++vt) o[vt] = __builtin_amdgcn_mfma_f32_32x32x16_bf16(vg[vt], pb1, o[vt], 0, 0, 0); \
            __builtin_amdgcn_sched_barrier(0); \
        } } while (0)
    AT_LOAD(skA, svA, 0); AT_STORE(skA, svA, 0);
    __syncthreads();
    for (int i = 0; i < nt; i += 2) {
        AT_LOAD(skA, svA, i + 1);
        AT_TILE(0);
        AT_STORE(skA, svA, 1);
        __syncthreads();
        if (i + 2 < nt) AT_LOAD(skA, svA, i + 2);
        AT_TILE(1);
        if (i + 2 < nt) AT_STORE(skA, svA, 0);
        __syncthreads();
    }
#undef AT_TILE
#undef AT_KF
#undef AT_VF
#undef AT_LOAD
#undef AT_STORE
    lsum += __shfl_xor(lsum, 32);
    LAS float* xch = (LAS float*)lds + (size_t)qg * 4096 + lane;
    if (j == 1) {
        const float sc = lam / lsum;
#pragma unroll
        for (int vt = 0; vt < 4; ++vt)
#pragma unroll
            for (int r = 0; r < 16; ++r) xch[(vt * 16 + r) * 64] = o[vt][r] * sc;
    }
    __syncthreads();
    if (j == 0) {
        const float i0 = 1.f / lsum;
        float ss = 0.f;
#pragma unroll
        for (int vt = 0; vt < 4; ++vt)
#pragma unroll
            for (int r = 0; r < 16; ++r) { const float v = o[vt][r] * i0 - xch[(vt * 16 + r) * 64]; o[vt][r] = v; ss += v * v; }
        ss += __shfl_xor(ss, 32);
        const float rstd = rsqrtf(ss * (1.f / 128.f) + EPS) * post_scale;
        const size_t row = (size_t)row0 + 32 * qg + q32;
#pragma unroll
        for (int vt = 0; vt < 4; ++vt)
#pragma unroll
            for (int g4 = 0; g4 < 4; ++g4) {
                const int v0 = 32 * vt + 8 * g4 + 4 * hi;
                const u32x2 gz = *(const u32x2*)(dg + row * NZ + v0);
                const f32x4 sl = *(const f32x4*)(subln + v0);
                const float r0 = o[vt][4 * g4 + 0] * rstd * sl[0] * silu_f(bflo(gz.x)), r1 = o[vt][4 * g4 + 1] * rstd * sl[1] * silu_f(bfhi(gz.x));
                const float r2 = o[vt][4 * g4 + 2] * rstd * sl[2] * silu_f(bflo(gz.y)), r3 = o[vt][4 * g4 + 3] * rstd * sl[3] * silu_f(bfhi(gz.y));
                u32x2 wv; wv.x = cvt_pk_bf16(r0, r1); wv.y = cvt_pk_bf16(r2, r3);
                *(u32x2*)(outp + row * 1024 + v0) = wv;
            }
    }
    __syncthreads();
}

__device__ __forceinline__ void phase_mix(const Args& a, int l, LAS unsigned char* lds) {
    const int G = opaque_s(gridDim.x);
    unsigned char* ws = opaque_ptr(a.ws);
    const bool need_ctx = (l == 0);
#ifndef NO_GLA
    for (int it = BID; it < 256; it += G) gla_unit(a, l, lds, ((it & 7) * 4 + (it >> 6)) * 8 + ((it >> 3) & 7));
#if defined(REPEAT_SUB) && REPEAT_SUB == 1
    for (int it = BID; it < 256; it += G) gla_unit(a, l, lds, it);
#endif
#endif
#ifndef NO_ATT
    {
        const float* scal = (const float*)(ws + OFF_SCAL) + l * 4;
        const float lam = scal[0], c2 = scal[1], post = 1.f - scal[2];
        const bf16_t* z = (const bf16_t*)(ws + OFF_Z);
        const int nun = 512 + (need_ctx ? 64 : 0);
        const bool big = c2 > 48.f;
#define ATTN_UNIT(...) do { if (big) attn_unit<true>(__VA_ARGS__); else attn_unit<false>(__VA_ARGS__); } while (0)
#if defined(REPEAT_SUB) && REPEAT_SUB == 2
        for (int rep = 0; rep < 2; ++rep)
#endif
        for (int u = BID; u < nun; u += G) {
            if (u < 512) { const int vc = (u & 7) * 64 + (u >> 3), bh = vc >> 4, qb = vc & 15, b = bh >> 3, h = bh & 7;
                ATTN_UNIT(lds, (const bf16_t*)(ws + OFF_QN) + (size_t)bh * 2 * SEQ * 64, SEQ, 128 * qb, (const bf16_t*)(ws + OFF_KN) + (size_t)bh * 2 * LK * 64,
                          (const bf16_t*)(ws + OFF_VT) + (size_t)bh * 128 * LK, LK, c2, lam, post, inp(I_SUBLN) + l * 128, z + ZC_DG + h * 128, (bf16_t*)(ws + OFF_DIFFO) + h * 128, b * SEQ + 128 * qb);
            } else { const int uu = u - 512, bh = uu >> 1, qb = uu & 1, b = bh >> 3, h = bh & 7;
                ATTN_UNIT(lds, (const bf16_t*)(ws + OFF_QNC) + (size_t)bh * 2 * LC * 64, LC, 128 * qb, (const bf16_t*)(ws + OFF_KN) + (size_t)bh * 2 * LK * 64,
                          (const bf16_t*)(ws + OFF_VT) + (size_t)bh * 128 * LK, LC, c2, lam, post, inp(I_SUBLN) + l * 128, z + ZC_DG + h * 128, (bf16_t*)(ws + OFF_DIFFO) + h * 128, ML + b * LC + 128 * qb);
            }
        }
    }
#endif
#ifndef NO_POOL
    {
        const int Mrows = need_ctx ? MT : ML;
        pg8::Gemm g{(const bf16_t*)(ws + OFF_DPOOL), (const bf16_t*)(ws + OFF_POOLT + (size_t)l * SZ_POOLT), Mrows, 1024, 256, 1024, 256, 256};
        pg8::StaticOrder S; S.init(Mrows, 1024, G, BID);
        pg8::EpiPool E{(bf16_t*)(ws + OFF_POOLO), (const bf16_t*)(ws + OFF_PGATE)};
        pg8::gemm_phase<pg8::EpiPool, pg8::StaticOrder, true, true>(lds, g, S, E);
    }
#endif
}

__device__ __forceinline__ void phase_post(const Args& a, int l) {
    const int tid = opaque_tid(), lane = tid & 63, wave = tid >> 6, G = opaque_s(gridDim.x);
    const int gw = BID * 8 + wave, NGW = G * 8;
    unsigned char* ws = opaque_ptr(a.ws);
    const bf16_t* z = (const bf16_t*)(ws + OFF_Z);
    const bf16_t* of = (const bf16_t*)(ws + OFF_OF); const bf16_t* ob = of + (size_t)MT * 1024;
    bf16_t* go = (bf16_t*)(ws + OFF_GLAO);
    const int Mrows = (l == 0) ? MT : ML;
    const float* gn = inp(I_GLAN) + l * 256 + ((16 * lane) & 255);
    for (int row = gw; row < Mrows; row += NGW) {
        float x[16], y[16], gz[16];
        const size_t o = (size_t)row * 1024 + 16 * lane;
        unpack8(*(const u32x4*)(of + o), x); unpack8(*(const u32x4*)(of + o + 8), x + 8);
        unpack8(*(const u32x4*)(ob + o), y); unpack8(*(const u32x4*)(ob + o + 8), y + 8);
        unpack8(*(const u32x4*)(z + (size_t)row * NZ + ZC_GG + 16 * lane), gz); unpack8(*(const u32x4*)(z + (size_t)row * NZ + ZC_GG + 16 * lane + 8), gz + 8);
        float ss = 0.f;
#pragma unroll
        for (int e = 0; e < 16; ++e) { x[e] += y[e]; ss += x[e] * x[e]; }
        ss += __shfl_xor(ss, 1); ss += __shfl_xor(ss, 2); ss += __shfl_xor(ss, 4); ss += __shfl_xor(ss, 8);
        const float rstd = rsqrtf(ss * (1.f / 256.f) + EPS);
        float r[16];
#pragma unroll
        for (int e = 0; e < 16; ++e) r[e] = x[e] * rstd * gn[e] * silu_f(gz[e]);
        u32x4 w0, w1;
        w0.x = cvt_pk_bf16(r[0], r[1]); w0.y = cvt_pk_bf16(r[2], r[3]); w0.z = cvt_pk_bf16(r[4], r[5]); w0.w = cvt_pk_bf16(r[6], r[7]);
        w1.x = cvt_pk_bf16(r[8], r[9]); w1.y = cvt_pk_bf16(r[10], r[11]); w1.z = cvt_pk_bf16(r[12], r[13]); w1.w = cvt_pk_bf16(r[14], r[15]);
        *(u32x4*)(go + o) = w0; *(u32x4*)(go + o + 8) = w1;
    }
}

#define XB_TMO      128
#define XB_XCNT(j)  (256  + 64 * (j))
#define XB_XSUB(j)  (1280 + 64 * (j))
#define XB_XGEN(j)  (2304 + 64 * (j))
#define XB_TOP      3328
#define XB_TOPGEN   3392
#define XCD_BAR_WORDS 3456
#define XB_SPIN_CAP (1u << 18)

__device__ __forceinline__ unsigned xb_ld(unsigned* p)              { return __hip_atomic_load(p, __ATOMIC_RELAXED, __HIP_MEMORY_SCOPE_AGENT); }
__device__ __forceinline__ unsigned xb_add(unsigned* p, unsigned v) { return __hip_atomic_fetch_add(p, v, __ATOMIC_RELAXED, __HIP_MEMORY_SCOPE_AGENT); }
__device__ __forceinline__ unsigned xb_xcc_id() { return (unsigned)__builtin_amdgcn_s_getreg((3 << 11) | 20) & 0xFu; }
#define XB_SPIN(cond, bar) do { unsigned _sp = 0; while (cond) { __builtin_amdgcn_s_sleep(1); \
    if ((++_sp & 255u) == 0u) { if (xb_ld(&(bar)[XB_TMO])) break; if (_sp > XB_SPIN_CAP) { atomicAdd(&(bar)[XB_TMO], 1u); break; } } } } while (0)

struct XcdBarrier {
    unsigned* bar; unsigned x;
    volatile LAS unsigned* st;
};

__device__ __forceinline__ XcdBarrier xcd_barrier_post(unsigned* bar, volatile LAS unsigned* st) {
    XcdBarrier b; b.bar = bar; b.x = xb_xcc_id(); b.st = st;
    if (threadIdx.x == 0) (void)xb_add(&bar[XB_XCNT(b.x)], 1u);
    return b;
}
__device__ __forceinline__ void xcd_barrier_complete(unsigned* bar, unsigned x, unsigned& nloc, unsigned& nx) {
    const unsigned G = gridDim.x * gridDim.y * gridDim.z;
    unsigned sum, cnt, mine, sp = 0u;
    for (;;) {
        sum = 0u; cnt = 0u; mine = 0u;
#pragma unroll
        for (unsigned j = 0; j < 16; ++j) { const unsigned c = xb_ld(&bar[XB_XCNT(j)]); sum += c; cnt += (c > 0u) ? 1u : 0u; mine = (j == x) ? c : mine; }
        if (sum == G) break;
        __builtin_amdgcn_s_sleep(1);
        if ((++sp & 255u) == 0u) { if (xb_ld(&bar[XB_TMO])) break; if (sp > XB_SPIN_CAP) { atomicAdd(&bar[XB_TMO], 1u); break; } }
    }
    nloc = mine > 0u ? mine : 1u; nx = cnt > 0u ? cnt : 1u;
}

__device__ __forceinline__ void xcd_barrier(const XcdBarrier& b) {
    asm volatile("s_waitcnt vmcnt(0)" ::: "memory");
    __syncthreads();
    if (threadIdx.x == 0) {
        unsigned* bar = b.bar;
        __builtin_amdgcn_s_waitcnt(0);
        unsigned nloc = b.st[0], nx = b.st[1];
        if (nloc == 0u) { xcd_barrier_complete(bar, b.x, nloc, nx); b.st[0] = nloc; b.st[1] = nx; }
        const unsigned old = xb_add(&bar[XB_XSUB(b.x)], 1u);
        const unsigned gen = old / nloc;
        if (old + 1u == (gen + 1u) * nloc) {
            __builtin_amdgcn_fence(__ATOMIC_RELEASE, "agent");
            asm volatile("s_waitcnt vmcnt(0)" ::: "memory");
            const unsigned og = xb_add(&bar[XB_TOP], 1u);
            const unsigned tg = og / nx;
            if (og + 1u == (tg + 1u) * nx) xb_add(&bar[XB_TOPGEN], 1u);
            else XB_SPIN(xb_ld(&bar[XB_TOPGEN]) == tg, bar);
            __builtin_amdgcn_fence(__ATOMIC_ACQUIRE, "agent");
            xb_add(&bar[XB_XGEN(b.x)], 1u);
            asm volatile("s_waitcnt vmcnt(0)" ::: "memory");
        } else {
            XB_SPIN(xb_ld(&bar[XB_XGEN(b.x)]) == gen, bar);
            __builtin_amdgcn_fence(__ATOMIC_ACQUIRE, "agent");
            asm volatile("s_waitcnt vmcnt(0)" ::: "memory");
        }
    }
    __syncthreads();
}

#ifndef REPEAT_K
#define REPEAT_K -1
#endif
#define SEAM() do { XcdBarrier xb; xb.bar = (unsigned*)(opaque_ptr(a.ws) + OFF_BAR); xb.x = xb_xcc_id(); xb.st = (volatile LAS unsigned*)(lds + 131072 + 512); xcd_barrier(xb); } while (0)
#define REP(k) for (int rep_ = 0; rep_ < (REPEAT_K == (k) ? 2 : 1); ++rep_)
template <int l> __device__ __forceinline__ void run_layer(const Args& a, LAS unsigned char* lds) {
    constexpr int Mout = (l == 0) ? MT : ML;
    REP(0) phase_norm(a, l);
    SEAM();
    REP(1) {
        unsigned char* ws = opaque_ptr(a.ws); const int G = opaque_s(gridDim.x);
        pg8::Gemm g{(const bf16_t*)(ws + OFF_H), (const bf16_t*)(ws + OFF_WIN + (size_t)l * SZ_WIN), MT, NZ, DM, DM, DM, 0};
        pg8::EpiBf16 E{(bf16_t*)(ws + OFF_Z), NZ};
        if (l == 0) { pg8::StaticOrder S; S.init(MT, NZ, G, BID); pg8::gemm_phase<pg8::EpiBf16, pg8::StaticOrder, true, true>(lds, g, S, E);
 }
        else { pg8::CtxSkipOrder S; S.init(G, BID); pg8::gemm_phase<pg8::EpiBf16, pg8::CtxSkipOrder, true, true>(lds, g, S, E); }
    }
    SEAM();
    REP(2) phase_prep(a, l, lds);
    SEAM();
    REP(3) phase_mix(a, l, lds);
    SEAM();
    REP(4) phase_post(a, l);
    SEAM();
    REP(5) {
        unsigned char* ws = opaque_ptr(a.ws); const int G = opaque_s(gridDim.x);
        pg8::SegOrder3 S; S.base.init(Mout, DM, G, BID);
        const bf16_t* wb = (const bf16_t*)(ws + OFF_WB + (size_t)l * SZ_WB);
        pg8::Gemm g{(const bf16_t*)(ws + OFF_POOLO), wb, Mout, DM, 1024, 1024, 1024, 0,
                    (const bf16_t*)(ws + OFF_DIFFO), (const bf16_t*)(ws + OFF_GLAO), wb + (size_t)DM * 1024, wb + (size_t)2 * DM * 1024};
        pg8::EpiMerge3 E{(bf16_t*)(ws + OFF_H), (const bf16_t*)(ws + OFF_Z) + ZC_MG};
        pg8::gemm_phase<pg8::EpiMerge3, pg8::SegOrder3, true, true, 3>(lds, g, S, E);
        if (l == 0 && rep_ == 0) {
            const int rem = ((Mout / 256) * (DM / 256)) % G, bid = BID;
            if (rem == 0) { ada_items(a, lds, 1, bid, G); convert_layer_weights(a, lds, 1, bid * 8 + (int)(threadIdx.x >> 6), G * 8); }
            else if (bid >= rem) { ada_items(a, lds, 1, G - 1 - bid, G - rem); convert_layer_weights(a, lds, 1, (bid - rem) * 8 + (int)(threadIdx.x >> 6), (G - rem) * 8); }
        }
    }
    SEAM();
    REP(6) {
        unsigned char* ws = opaque_ptr(a.ws); const int G = opaque_s(gridDim.x);
        pg8::Gemm g{(const bf16_t*)(ws + OFF_H), (const bf16_t*)(ws + OFF_WOUT + (size_t)l * SZ_WOUT), Mout, DM, DM, DM, DM, 0};
        pg8::StaticOrder S; S.init(Mout, DM, G, BID);
        pg8::EpiOut E{l == 0 ? inp(I_X) : (const float*)(ws + OFF_X1), l == 0 ? inp(I_CTX) : (const float*)(ws + OFF_X1) + (size_t)ML * DM,
                      l == 0 ? (float*)(ws + OFF_X1) : arg_out(), (const float*)(ws + OFF_MOD) + (size_t)l * 5 * 6144};
        pg8::gemm_phase<pg8::EpiOut, pg8::StaticOrder, true, true>(lds, g, S, E);
    }
}

__global__ void __launch_bounds__(512, 2) hybrid_fwd(Args a) {
    extern __shared__ __attribute__((aligned(16))) unsigned char smem[];
    LAS unsigned char* lds = (LAS unsigned char*)smem;
    cg::grid_group grid = cg::this_grid();
    volatile LAS unsigned* bst = (volatile LAS unsigned*)(lds + 131072 + 512);
    if (threadIdx.x < 2) bst[threadIdx.x] = 0u;
    __syncthreads();
    (void)xcd_barrier_post((unsigned*)(a.ws + OFF_BAR), bst);
    REP(7) phase_p0(a, lds);
    grid.sync();
    run_layer<0>(a, lds);
    SEAM();
    run_layer<1>(a, lds);
}

extern "C" void kernel_launch(void* const* d_in, const int* in_sizes, int n_in, void* d_out, int out_size, void* d_ws, size_t ws_size, hipStream_t stream) {
    static int grid = 0;
    if (grid == 0) {
        if (n_in != 26 || out_size != ML * DM || ws_size < WS_END) { fprintf(stderr, "kernel_launch: expected 26 inputs, out %d, ws >= %zu; got n_in %d out %d ws %zu\n", ML * DM, (size_t)WS_END, n_in, out_size, ws_size); grid = -1; return; }
        int dev = 0, cus = 0, per_cu = 0;
        if (hipGetDevice(&dev) != hipSuccess || hipDeviceGetAttribute(&cus, hipDeviceAttributeMultiprocessorCount, dev) != hipSuccess) { grid = -1; return; }
        if (hipFuncSetAttribute((const void*)hybrid_fwd, hipFuncAttributeMaxDynamicSharedMemorySize, LDS_BYTES) != hipSuccess) { fprintf(stderr, "kernel_launch: hipFuncSetAttribute failed\n"); grid = -1; return; }
        if (hipOccupancyMaxActiveBlocksPerMultiprocessor(&per_cu, (const void*)hybrid_fwd, 512, LDS_BYTES) != hipSuccess || per_cu < 1) { fprintf(stderr, "kernel_launch: occupancy query says %d blocks per CU\n", per_cu); (void)hipGetLastError(); grid = -1; return; }
        grid = cus;
    }
    if (grid < 0) return;
    if (hipMemsetAsync((char*)d_ws + OFF_BAR, 0, BAR_BYTES, stream) != hipSuccess) { fprintf(stderr, "kernel_launch: memset of the barrier words failed\n"); return; }
    Args a{};
    for (int i = 0; i < 26; ++i) a.in[i] = (const float*)d_in[i];
    a.out = (float*)d_out; a.ws = (unsigned char*)d_ws;
    a.ph_lo = 0; a.ph_hi = NPH;
    void* args[] = {&a};
    const hipError_t e = hipLaunchCooperativeKernel((const void*)hybrid_fwd, dim3(grid), dim3(512), args, LDS_BYTES, stream);
    if (e != hipSuccess) fprintf(stderr, "kernel_launch: cooperative launch failed: %s (grid %d)\n", hipGetErrorString(e), grid);
}
```

```cpp
#include <hip/hip_runtime.h>
#include <hip/hip_cooperative_groups.h>
#include <cstdio>
#include <cstdint>
namespace cg = cooperative_groups;

#ifndef MK_N_LAUNCHES
#define MK_N_LAUNCHES 1
#endif

#define LAS __attribute__((address_space(3)))
typedef unsigned short bf16_t;
typedef short bf16x8 __attribute__((ext_vector_type(8)));
typedef float f32x4 __attribute__((ext_vector_type(4)));
typedef float f32x16 __attribute__((ext_vector_type(16)));
typedef unsigned u32x4 __attribute__((ext_vector_type(4)));
typedef unsigned u32x2 __attribute__((ext_vector_type(2)));

constexpr int DM = 2048, NB = 4, SEQ = 2048, LC = 256, ML = NB * SEQ, MC = NB * LC, MT = ML + MC;
constexpr int DIN = 15392, NZ = 15616;
constexpr int ZC_PU = 0, ZC_PG = 1024, ZC_DQ = 2048, ZC_DK = 3072, ZC_DV = 4096, ZC_DG = 5120, ZC_GQ = 6144, ZC_GK = 6656, ZC_GV = 7168, ZC_GG = 8192, ZC_LR = 9216, ZC_MG = 9472;
constexpr int LK = LC + SEQ;
constexpr float EPS = 1e-6f, LOG2E = 1.4426950408889634f;
constexpr int NPH = 15;

constexpr size_t SZ_WIN = (size_t)NZ * DM * 2, SZ_WB = (size_t)3 * DM * 1024 * 2, SZ_WOUT = (size_t)DM * DM * 2, SZ_POOLT = (size_t)4 * 256 * 256 * 2;
constexpr size_t OFF_WIN = 0;
constexpr size_t OFF_WB = OFF_WIN + 2 * SZ_WIN;
constexpr size_t OFF_WOUT = OFF_WB + 2 * SZ_WB;
constexpr size_t OFF_POOLT = OFF_WOUT + 2 * SZ_WOUT;
constexpr size_t OFF_MOD = OFF_POOLT + 2 * SZ_POOLT;
constexpr size_t OFF_SCAL = OFF_MOD + (size_t)2 * 5 * 6144 * 4;
constexpr size_t OFF_H = OFF_SCAL + 256;
constexpr size_t OFF_Z = OFF_H + (size_t)MT * DM * 2;
constexpr size_t OFF_QN = OFF_Z + (size_t)MT * NZ * 2;
constexpr size_t OFF_QNC = OFF_QN + (size_t)ML * 1024 * 2;
constexpr size_t OFF_KN = OFF_QNC + (size_t)MC * 1024 * 2;
constexpr size_t OFF_VT = OFF_KN + (size_t)MT * 1024 * 2;
constexpr size_t SZ_G = (size_t)MT * 512 * 2;
constexpr size_t OFF_GQ = OFF_VT + (size_t)MT * 1024 * 2;
constexpr size_t OFF_GK = OFF_GQ + 2 * SZ_G;
constexpr size_t OFF_GH = OFF_GK + 2 * SZ_G;
constexpr size_t OFF_DEC = OFF_GH + 2 * SZ_G;
constexpr size_t OFF_OF = OFF_DEC + (size_t)2 * 144 * 512 * 4;
constexpr size_t OFF_DPOOL = OFF_OF + 2 * (size_t)MT * 1024 * 2;
constexpr size_t OFF_POOLO = OFF_DPOOL + (size_t)MT * 1024 * 2;
constexpr size_t OFF_DIFFO = OFF_POOLO + (size_t)MT * 1024 * 2;
constexpr size_t OFF_GLAO = OFF_DIFFO + (size_t)MT * 1024 * 2;
constexpr size_t OFF_YACC = OFF_GLAO + (size_t)MT * 1024 * 2;
constexpr size_t OFF_X1 = OFF_YACC + (size_t)MT * DM * 4;
constexpr size_t OFF_PGATE = OFF_X1 + (size_t)MT * DM * 4;
constexpr size_t OFF_BAR = OFF_PGATE + (size_t)MT * 1024 * 2;
constexpr size_t BAR_BYTES = 16384;
constexpr size_t OFF_GVT = OFF_BAR + BAR_BYTES;
constexpr size_t WS_END = OFF_GVT + (size_t)MT * 1024 * 2;

constexpr int LDS_BYTES = 135168;

#define BID opaque_s((int)blockIdx.x)
#define GAS __attribute__((address_space(1)))
__device__ __forceinline__ unsigned char* opaque_ptr(unsigned char* p) { GAS unsigned char* q = (GAS unsigned char*)p; asm volatile("" : "+s"(q)); return (unsigned char*)q; }
__device__ __forceinline__ int opaque_s(int v) { asm volatile("" : "+s"(v)); return v; }
__device__ __forceinline__ int opaque_tid() { int t = threadIdx.x; asm volatile("" : "+v"(t)); return t; }
typedef float f32x2_t __attribute__((ext_vector_type(2))); typedef __bf16 bf16x2_t __attribute__((ext_vector_type(2)));
__device__ __forceinline__ unsigned cvt_pk_bf16(float lo, float hi) { f32x2_t v = {lo, hi}; bf16x2_t b = __builtin_convertvector(v, bf16x2_t); return __builtin_bit_cast(unsigned, b); }
__device__ __forceinline__ bf16_t f2bf(float f) { return (bf16_t)(cvt_pk_bf16(f, 0.f) & 0xffffu); }
__device__ __forceinline__ float bf2f(bf16_t v) { return __builtin_bit_cast(float, (unsigned)v << 16); }
__device__ __forceinline__ float bflo(unsigned u) { return __builtin_bit_cast(float, u << 16); }
__device__ __forceinline__ float bfhi(unsigned u) { return __builtin_bit_cast(float, u & 0xffff0000u); }
__device__ __forceinline__ float silu_f(float x) { return x * __builtin_amdgcn_rcpf(1.f + __expf(-x)); }
__device__ __forceinline__ float sigmoid_f(float x) { return __builtin_amdgcn_rcpf(1.f + __expf(-x)); }
__device__ __forceinline__ float logsig_f(float a) { return fminf(a, 0.f) - __logf(1.f + __expf(-fabsf(a))); }
__device__ __forceinline__ float wave_sum(float v) {
#pragma unroll
    for (int o = 1; o < 64; o <<= 1) v += __shfl_xor(v, o);
    return v;
}
__device__ __forceinline__ float wave_max(float v) {
#pragma unroll
    for (int o = 1; o < 64; o <<= 1) v = fmaxf(v, __shfl_xor(v, o));
    return v;
}
__device__ __forceinline__ void unpack8(u32x4 w, float* f) { f[0] = bflo(w.x); f[1] = bfhi(w.x); f[2] = bflo(w.y); f[3] = bfhi(w.y); f[4] = bflo(w.z); f[5] = bfhi(w.z); f[6] = bflo(w.w); f[7] = bfhi(w.w); }

namespace pg8 {
constexpr int BM = 256, BK = 64, HALF = 128, HTB = HALF * BK * 2, STAGE_BYTES = 8 * HTB, NXCD = 8, WGM = 8;
__host__ __device__ __forceinline__ int lds_byte(int r, int c) { const int st = (r >> 4) * 2 + (c >> 5), rr = r & 15, cc = c & 31, ob = rr * 64 + cc * 2; return st * 1024 + (ob ^ (((ob >> 9) & 1) << 5)); }
__host__ __device__ __forceinline__ void stage_rc(int b, int& R, int& C) { const int st = b / 1024, sb = b % 1024, swz = sb ^ (((sb >> 9) & 1) << 5); R = (st >> 1) * 16 + swz / 64; C = (st & 1) * 32 + (swz % 64) / 2; }
__host__ __device__ __forceinline__ int perm32(int rho) { const int n = rho >> 4, i = rho & 15; return 8 * (i >> 2) + 4 * n + (i & 3); }

struct Unit { int pm, pn, seg; };
struct Gemm { const bf16_t* A; const bf16_t* Bt; int M, N, K; int lda, ldb; int a_pn_off; const bf16_t* A1; const bf16_t* A2; const bf16_t* B1; const bf16_t* B2; };

struct StaticOrder {
    int nM, nN, nwg, G, c;
    __host__ __device__ void init(int M, int N, int G_, int c_) { nM = M / BM; nN = N / BM; nwg = nM * nN; G = G_; c = c_; }
    __host__ __device__ bool next(int i, Unit& u) const {
        const long L = (long)i * G + c; if (L >= nwg) return false;
        int wgid = (int)L; { const int q = nwg / NXCD, r = nwg % NXCD, xcd = wgid % NXCD, off = wgid / NXCD; wgid = (xcd < r ? xcd * (q + 1) : r * (q + 1) + (xcd - r) * q) + off; }
        const int nig = WGM * nN, gid = wgid / nig, fm = gid * WGM, gsz = (nM - fm) < WGM ? (nM - fm) : WGM;
        u.pm = fm + ((wgid % nig) % gsz); u.pn = (wgid % nig) / gsz; u.seg = 0; return true;
    }
    __device__ __forceinline__ void a_ready(const Unit&) const {}
    __device__ __forceinline__ void done(const Unit&) const {}
};

struct CtxSkipOrder {
    StaticOrder base; int nbase;
    __host__ __device__ void init(int G_, int c_) { base.init(ML, NZ, G_, c_); nbase = base.nwg; }
    __host__ __device__ bool next(int i, Unit& u) const {
        const long L = (long)i * base.G + base.c;
        if (L < nbase) return base.next(i, u);
        const int e = (int)(L - nbase); if (e >= 4 * 15) return false;
        const int j = e % 15; u.pm = 32 + e / 15; u.pn = j < 8 ? 12 + j : (j < 14 ? 18 + j : 36); u.seg = 0; return true;
    }
    __device__ __forceinline__ void a_ready(const Unit&) const {}
    __device__ __forceinline__ void done(const Unit&) const {}
};
struct SegOrder3 {
    StaticOrder base;
    __host__ __device__ bool next(int i, Unit& u) const { const int q = i / 3; if (!base.next(q, u)) return false; u.seg = i - 3 * q; return true; }
    __device__ __forceinline__ void a_ready(const Unit&) const {}
    __device__ __forceinline__ void done(const Unit&) const {}
};
struct EpiBf16 {
    static constexpr bool PERM = true, AFTER_DRAIN = false;
    bf16_t* O; int ldc;
    __device__ __forceinline__ void operator()(const f32x4 (&acc)[2][2][4][2], const Unit& u, int wr, int wc, int fr, int fq) const {
        const int row0 = u.pm * BM + wr * 64 + fr, col0 = u.pn * BM + wc * 32 + 8 * fq;
#pragma unroll
        for (int ai = 0; ai < 2; ++ai)
#pragma unroll
            for (int m = 0; m < 4; ++m) { bf16_t* rowp = O + (size_t)(row0 + ai * HALF + m * 16) * ldc + col0;
#pragma unroll
                for (int bj = 0; bj < 2; ++bj) { const f32x4 v0 = acc[ai][bj][m][0], v1 = acc[ai][bj][m][1];
                    u32x4 w; w.x = cvt_pk_bf16(v0[0], v0[1]); w.y = cvt_pk_bf16(v0[2], v0[3]); w.z = cvt_pk_bf16(v1[0], v1[1]); w.w = cvt_pk_bf16(v1[2], v1[3]);
                    *(u32x4*)(rowp + bj * HALF) = w; } }
    }
};

template <class Epi, class Sched, bool ALIGN_EPI = false, bool SP2 = false, int NSEG = 1>
__device__ __forceinline__ void gemm_phase(LAS unsigned char* lds, const Gemm g, const Sched& S, const Epi& E) {
    const int tid = opaque_tid(), wid = __builtin_amdgcn_readfirstlane(tid >> 6), lane = tid & 63, wr = wid >> 2, wc = wid & 3, fr = lane & 15, fq = lane >> 4;
    const int K = opaque_s(g.K), nt = K / BK;
    unsigned voffA[2], voffB[2];
#pragma unroll
    for (int i = 0; i < 2; ++i) { int R, C; stage_rc(tid * 16 + i * 8192, R, C); const int Rb = Epi::PERM ? ((R & ~31) + perm32(R & 31)) : R;
        voffA[i] = (unsigned)(R * g.lda + C) * 2u; voffB[i] = (unsigned)(Rb * g.ldb + C) * 2u; }
    const size_t kstep = (size_t)(BK * 2);
    const size_t hstepA = (size_t)HALF * g.lda * 2, hstepB = (size_t)HALF * g.ldb * 2;
    const size_t tstepA = 2 * hstepA, tstepB = 2 * hstepB;
    const size_t pnA = (size_t)g.a_pn_off * 2;
    const unsigned ldsw = (unsigned)wid * 1024u;
    const int aoff = lds_byte(wr * 64 + fr, fq * 8), boff = lds_byte(wc * 32 + fr, fq * 8);
#define PG8_SA(b, h) (((b) * 2 + (h)) * HTB)
#define PG8_SB(b, h) ((4 + (b) * 2 + (h)) * HTB)
#define PG8_STAGE(bufoff, gbase, voff) do { _Pragma("unroll") for (int _i = 0; _i < 2; ++_i) \
        __builtin_amdgcn_global_load_lds((const unsigned*)((const char*)(gbase) + (voff)[_i]), (LAS unsigned*)(lds + (bufoff) + ldsw + _i * 8192), 16, 0, 0); } while (0)
#define PG8_LDA(dst, b, h) do { _Pragma("unroll") for (int m = 0; m < 4; ++m) _Pragma("unroll") for (int k = 0; k < 2; ++k) dst[m][k] = *(const LAS bf16x8*)(lds + PG8_SA(b, h) + aoff + m * 2048 + k * 1024); } while (0)
#define PG8_LDB(dst, b, h) do { _Pragma("unroll") for (int n = 0; n < 2; ++n) _Pragma("unroll") for (int k = 0; k < 2; ++k) dst[n][k] = *(const LAS bf16x8*)(lds + PG8_SB(b, h) + boff + n * 2048 + k * 1024); } while (0)
#define PG8_MMA(ai, bj, At, Bt) do { __builtin_amdgcn_s_setprio(1); _Pragma("unroll") for (int m = 0; m < 4; ++m) _Pragma("unroll") for (int n = 0; n < 2; ++n) _Pragma("unroll") for (int k = 0; k < 2; ++k) \
        acc[ai][bj][m][n] = __builtin_amdgcn_mfma_f32_16x16x32_bf16(Bt[n][k], At[m][k], acc[ai][bj][m][n], 0, 0, 0); __builtin_amdgcn_s_setprio(0); } while (0)
#define PG8_WAIT_V(n) asm volatile("s_waitcnt vmcnt(" #n ")" ::: "memory")
#define PG8_WAIT_L(n) asm volatile("s_waitcnt lgkmcnt(" #n ")" ::: "memory")
#define PG8_BAR __builtin_amdgcn_s_barrier()
#define PG8_SCHED __builtin_amdgcn_sched_barrier(0)
    Unit cur, nxt; int ui = 0;
    if (!S.next(0, cur)) return;
    f32x4 acc[2][2][4][2];
#pragma unroll
    for (int a = 0; a < 2; ++a)
#pragma unroll
        for (int b = 0; b < 2; ++b)
#pragma unroll
            for (int m = 0; m < 4; ++m)
#pragma unroll
                for (int n = 0; n < 2; ++n) acc[a][b][m][n] = (f32x4){0.f, 0.f, 0.f, 0.f};
    bf16x8 At[4][2], B0[2][2], B1[2][2];
#define PG8_ASEG(u) ((const char*)(NSEG == 1 || (u).seg == 0 ? g.A : ((u).seg == 1 ? g.A1 : g.A2)))
#define PG8_BSEG(u) ((const char*)(NSEG == 1 || (u).seg == 0 ? g.Bt : ((u).seg == 1 ? g.B1 : g.B2)))
    const char* cA = PG8_ASEG(cur) + (size_t)cur.pm * tstepA + (size_t)cur.pn * pnA; const char* cB = PG8_BSEG(cur) + (size_t)cur.pn * tstepB;
    S.a_ready(cur);
    if constexpr (SP2) {
        PG8_STAGE(PG8_SB(0, 0), cB, voffB); PG8_STAGE(PG8_SB(0, 1), cB + hstepB, voffB); PG8_STAGE(PG8_SA(0, 0), cA, voffA); PG8_STAGE(PG8_SA(0, 1), cA + hstepA, voffA);
        if (wr == 1) PG8_BAR;
        PG8_WAIT_V(2); PG8_BAR;
        PG8_STAGE(PG8_SB(1, 0), cB + kstep, voffB); PG8_STAGE(PG8_SA(1, 0), cA + kstep, voffA); PG8_STAGE(PG8_SB(1, 1), cB + hstepB + kstep, voffB);
        PG8_WAIT_V(6); PG8_BAR;
    } else {
        PG8_STAGE(PG8_SB(0, 0), cB, voffB); PG8_STAGE(PG8_SA(0, 0), cA, voffA); PG8_STAGE(PG8_SB(0, 1), cB + hstepB, voffB); PG8_STAGE(PG8_SA(0, 1), cA + hstepA, voffA);
        if (wr == 1) PG8_BAR;
        PG8_WAIT_V(4); PG8_BAR;
        PG8_STAGE(PG8_SB(1, 0), cB + kstep, voffB); PG8_STAGE(PG8_SA(1, 0), cA + kstep, voffA); PG8_STAGE(PG8_SB(1, 1), cB + hstepB + kstep, voffB);
        PG8_WAIT_V(6); PG8_BAR;
    }
    for (;;) {
        const bool has_next = S.next(ui + 1, nxt);
        const char* nA = has_next ? PG8_ASEG(nxt) + (size_t)nxt.pm * tstepA + (size_t)nxt.pn * pnA : cA; const char* nB = has_next ? PG8_BSEG(nxt) + (size_t)nxt.pn * tstepB : cB;
        for (int t = 0; t < nt; t += 2) {
            const bool last = (t == nt - 2);
            const char* a1 = cA + (size_t)(t + 1) * kstep;
            const char* a2 = last ? nA : cA + (size_t)(t + 2) * kstep; const char* b2 = last ? nB : cB + (size_t)(t + 2) * kstep;
            const char* a3 = a2 + kstep; const char* b3 = b2 + kstep;
            if (last && has_next) S.a_ready(nxt);
            if constexpr (SP2) {
            PG8_LDB(B0, 0, 0); PG8_LDB(B1, 0, 1); PG8_SCHED; PG8_LDA(At, 0, 0); PG8_STAGE(PG8_SA(1, 1), a1 + hstepA, voffA);
            PG8_WAIT_V(8); PG8_WAIT_L(0); PG8_BAR; PG8_MMA(0, 0, At, B0); PG8_MMA(0, 1, At, B1); PG8_BAR; PG8_SCHED;
            PG8_LDA(At, 0, 1); PG8_STAGE(PG8_SB(0, 0), b2, voffB); PG8_STAGE(PG8_SB(0, 1), b2 + hstepB, voffB); PG8_STAGE(PG8_SA(0, 0), a2, voffA);
            PG8_WAIT_V(8); PG8_WAIT_L(0); PG8_BAR; PG8_MMA(1, 0, At, B0); PG8_MMA(1, 1, At, B1); PG8_BAR; PG8_SCHED;
            PG8_LDB(B0, 1, 0); PG8_LDB(B1, 1, 1); PG8_SCHED; PG8_LDA(At, 1, 0); PG8_STAGE(PG8_SA(0, 1), a2 + hstepA, voffA);
            PG8_WAIT_V(8); PG8_WAIT_L(0); PG8_BAR; PG8_MMA(0, 0, At, B0); PG8_MMA(0, 1, At, B1); PG8_BAR; PG8_SCHED;
            PG8_LDA(At, 1, 1); PG8_STAGE(PG8_SB(1, 0), b3, voffB); PG8_STAGE(PG8_SB(1, 1), b3 + hstepB, voffB); PG8_STAGE(PG8_SA(1, 0), a3, voffA);
            PG8_WAIT_V(8); PG8_WAIT_L(0); PG8_BAR; PG8_MMA(1, 0, At, B0); PG8_MMA(1, 1, At, B1); PG8_BAR; PG8_SCHED;
            } else {
            PG8_LDB(B0, 0, 0); PG8_SCHED; PG8_LDA(At, 0, 0); PG8_STAGE(PG8_SA(1, 1), a1 + hstepA, voffA);
            PG8_WAIT_L(8); PG8_BAR; PG8_WAIT_L(0); PG8_MMA(0, 0, At, B0); PG8_BAR; PG8_SCHED;
            PG8_LDB(B1, 0, 1); PG8_STAGE(PG8_SB(0, 0), b2, voffB);
            PG8_BAR; PG8_WAIT_L(0); PG8_MMA(0, 1, At, B1); PG8_BAR;
            PG8_LDA(At, 0, 1); PG8_STAGE(PG8_SA(0, 0), a2, voffA);
            PG8_BAR; PG8_WAIT_L(0); PG8_MMA(1, 0, At, B0); PG8_BAR; PG8_SCHED;
            PG8_STAGE(PG8_SB(0, 1), b2 + hstepB, voffB);
            PG8_WAIT_V(6); PG8_BAR; PG8_MMA(1, 1, At, B1); PG8_BAR;
            PG8_LDB(B0, 1, 0); PG8_SCHED; PG8_LDA(At, 1, 0); PG8_STAGE(PG8_SA(0, 1), a2 + hstepA, voffA);
            PG8_WAIT_L(8); PG8_BAR; PG8_WAIT_L(0); PG8_MMA(0, 0, At, B0); PG8_BAR; PG8_SCHED;
            PG8_LDB(B1, 1, 1); PG8_STAGE(PG8_SB(1, 0), b3, voffB);
            PG8_BAR; PG8_WAIT_L(0); PG8_MMA(0, 1, At, B1); PG8_BAR;
            PG8_LDA(At, 1, 1); PG8_STAGE(PG8_SA(1, 0), a3, voffA);
            PG8_BAR; PG8_WAIT_L(0); PG8_MMA(1, 0, At, B0); PG8_BAR; PG8_SCHED;
            PG8_STAGE(PG8_SB(1, 1), b3 + hstepB, voffB);
            PG8_WAIT_V(6); PG8_BAR; PG8_MMA(1, 1, At, B1); PG8_BAR;
            }
        }
        if constexpr (ALIGN_EPI) { if (wr == 0) PG8_BAR; }
        E(acc, cur, wr, wc, fr, fq); S.done(cur);
        if (!has_next) break;
        if (NSEG == 1 || cur.seg == NSEG - 1)
#pragma unroll
        for (int a = 0; a < 2; ++a)
#pragma unroll
            for (int b = 0; b < 2; ++b)
#pragma unroll
                for (int m = 0; m < 4; ++m)
#pragma unroll
                    for (int n = 0; n < 2; ++n) acc[a][b][m][n] = (f32x4){0.f, 0.f, 0.f, 0.f};
        cur = nxt; cA = nA; cB = nB; ++ui;
        if constexpr (ALIGN_EPI) { if (wr == 1) PG8_BAR; }
    }
    PG8_WAIT_V(0);
    if constexpr (!ALIGN_EPI) { if (wr == 0) PG8_BAR; }
    PG8_BAR;
#undef PG8_ASEG
#undef PG8_BSEG
#undef PG8_SA
#undef PG8_SB
#undef PG8_STAGE
#undef PG8_LDA
#undef PG8_LDB
#undef PG8_MMA
#undef PG8_WAIT_V
#undef PG8_WAIT_L
#undef PG8_BAR
#undef PG8_SCHED
}

struct EpiPool {
    static constexpr bool PERM = true, AFTER_DRAIN = false;
    bf16_t* O; const bf16_t* pgate;
    __device__ __forceinline__ void operator()(const f32x4 (&acc)[2][2][4][2], const Unit& u, int wr, int wc, int fr, int fq) const {
        const int row0 = u.pm * BM + wr * 64 + fr, col0 = u.pn * BM + wc * 32 + 8 * fq;
#pragma unroll
        for (int ai = 0; ai < 2; ++ai) {
            u32x4 gz4[4][2];
#pragma unroll
            for (int m = 0; m < 4; ++m)
#pragma unroll
                for (int bj = 0; bj < 2; ++bj) gz4[m][bj] = *(const u32x4*)(pgate + (size_t)(row0 + ai * HALF + m * 16) * 1024 + col0 + bj * HALF);
            __builtin_amdgcn_sched_barrier(0);
#pragma unroll
            for (int m = 0; m < 4; ++m)
#pragma unroll
                for (int bj = 0; bj < 2; ++bj) {
                    const int row = row0 + ai * HALF + m * 16, col = col0 + bj * HALF;
                    const u32x4 gz = gz4[m][bj];
                    const f32x4 v0 = acc[ai][bj][m][0], v1 = acc[ai][bj][m][1];
                    u32x4 w;
                    w.x = cvt_pk_bf16(v0[0] * bflo(gz.x), v0[1] * bfhi(gz.x));
                    w.y = cvt_pk_bf16(v0[2] * bflo(gz.y), v0[3] * bfhi(gz.y));
                    w.z = cvt_pk_bf16(v1[0] * bflo(gz.z), v1[1] * bfhi(gz.z));
                    w.w = cvt_pk_bf16(v1[2] * bflo(gz.w), v1[3] * bfhi(gz.w));
                    *(u32x4*)(O + (size_t)row * 1024 + col) = w;
                }
            __builtin_amdgcn_sched_barrier(0);
        }
    }
};
template <int PASS> struct EpiMerge {
    static constexpr bool PERM = true, AFTER_DRAIN = false;
    float* yacc; bf16_t* y; const bf16_t* zg;
    __device__ __forceinline__ void operator()(const f32x4 (&acc)[2][2][4][2], const Unit& u, int wr, int wc, int fr, int fq) const {
        const int row0 = u.pm * BM + wr * 64 + fr, col0 = u.pn * BM + wc * 32 + 8 * fq;
#pragma unroll
        for (int ai = 0; ai < 2; ++ai)
#pragma unroll
            for (int m = 0; m < 4; ++m)
#pragma unroll
                for (int bj = 0; bj < 2; ++bj) {
                    const int row = row0 + ai * HALF + m * 16, col = col0 + bj * HALF;
                    float gz[8]; unpack8(*(const u32x4*)(zg + (size_t)row * NZ + col), gz);
                    const f32x4 v0 = acc[ai][bj][m][0], v1 = acc[ai][bj][m][1];
                    f32x4 r0, r1;
#pragma unroll
                    for (int e = 0; e < 4; ++e) { r0[e] = v0[e] * sigmoid_f(gz[e]); r1[e] = v1[e] * sigmoid_f(gz[4 + e]); }
                    float* yp = yacc + (size_t)row * DM + col;
                    if (PASS >= 1) { r0 += *(const f32x4*)yp; r1 += *(const f32x4*)(yp + 4); }
                    if (PASS <= 1) { *(f32x4*)yp = r0; *(f32x4*)(yp + 4) = r1; }
                    else { u32x4 w; w.x = cvt_pk_bf16(r0[0], r0[1]); w.y = cvt_pk_bf16(r0[2], r0[3]); w.z = cvt_pk_bf16(r1[0], r1[1]); w.w = cvt_pk_bf16(r1[2], r1[3]);
                        *(u32x4*)(y + (size_t)row * DM + col) = w; }
                    __builtin_amdgcn_sched_barrier(0);
                }
    }
};
struct EpiMerge3 {
    static constexpr bool PERM = true, AFTER_DRAIN = false;
    bf16_t* y; const bf16_t* zg;
    __device__ __forceinline__ void operator()(f32x4 (&acc)[2][2][4][2], const Unit& u, int wr, int wc, int fr, int fq) const {
        const int row0 = u.pm * BM + wr * 64 + fr, col0 = u.pn * BM + wc * 32 + 8 * fq;
        u32x4 ga4[2][4], gb4[2][4];
#pragma unroll
        for (int b = 0; b < 5; ++b) {
            if (b < 4) {
#pragma unroll
                for (int p = 0; p < 4; ++p) { const int ai = b >> 1, m = 2 * (b & 1) + (p >> 1), bj = p & 1;
                    const bf16_t* zp = zg + (size_t)(row0 + ai * HALF + m * 16) * NZ + col0 + bj * HALF + u.seg * 2048;
                    ga4[b & 1][p] = *(const u32x4*)zp; gb4[b & 1][p] = (u.seg < 2) ? *(const u32x4*)(zp + 2048) : (u32x4){0u, 0u, 0u, 0u}; }
            }
            __builtin_amdgcn_sched_barrier(0);
            if (b >= 1) {
                const int c = b - 1;
#pragma unroll
                for (int p = 0; p < 4; ++p) { const int ai = c >> 1, m = 2 * (c & 1) + (p >> 1), bj = p & 1;
                    const int row = row0 + ai * HALF + m * 16, col = col0 + bj * HALF;
                    float ga[8]; unpack8(ga4[c & 1][p], ga);
                    if (u.seg < 2) {
                        float gb[8]; unpack8(gb4[c & 1][p], gb);
#pragma unroll
                        for (int e = 0; e < 8; ++e) { const float ea = __expf(-fminf(fmaxf(ga[e], -30.f), 30.f)), eb = __expf(-fminf(fmaxf(gb[e], -30.f), 30.f));
                            const float ratio = (1.f + eb) * __builtin_amdgcn_rcpf(1.f + ea); acc[ai][bj][m][e >> 2][e & 3] *= ratio; }
                    } else {
                        float r[8];
#pragma unroll
                        for (int e = 0; e < 8; ++e) r[e] = acc[ai][bj][m][e >> 2][e & 3] * __builtin_amdgcn_rcpf(1.f + __expf(-fminf(fmaxf(ga[e], -30.f), 30.f)));
                        u32x4 w; w.x = cvt_pk_bf16(r[0], r[1]); w.y = cvt_pk_bf16(r[2], r[3]); w.z = cvt_pk_bf16(r[4], r[5]); w.w = cvt_pk_bf16(r[6], r[7]);
                        *(u32x4*)(y + (size_t)row * DM + col) = w;
                    }
                }
                __builtin_amdgcn_sched_barrier(0);
            }
        }
    }
};
struct EpiOut {
    static constexpr bool PERM = true, AFTER_DRAIN = false;
    const float* xlat; const float* xctx; float* xnew; const float* mod;
    __device__ __forceinline__ void operator()(const f32x4 (&acc)[2][2][4][2], const Unit& u, int wr, int wc, int fr, int fq) const {
        const int row0 = u.pm * BM + wr * 64 + fr, col0 = u.pn * BM + wc * 32 + 8 * fq;
        const int tile_row = u.pm * BM; const int mr = tile_row < ML ? tile_row / SEQ : 4;
        const float* xo = tile_row < ML ? xlat : (xctx - (size_t)ML * DM);
        const float* gm = mod + mr * 6144 + 4096;
        f32x4 g0[2], g1[2];
#pragma unroll
        for (int bj = 0; bj < 2; ++bj) { g0[bj] = *(const f32x4*)(gm + col0 + bj * HALF); g1[bj] = *(const f32x4*)(gm + col0 + bj * HALF + 4); }
        f32x4 x0[2][4], x1[2][4];
#pragma unroll
        for (int b = 0; b < 5; ++b) {
            if (b < 4) {
#pragma unroll
                for (int p = 0; p < 4; ++p) { const int ai = b >> 1, m = 2 * (b & 1) + (p >> 1), bj = p & 1;
                    const float* xp = xo + (size_t)(row0 + ai * HALF + m * 16) * DM + col0 + bj * HALF; x0[b & 1][p] = *(const f32x4*)xp; x1[b & 1][p] = *(const f32x4*)(xp + 4); }
            }
            __builtin_amdgcn_sched_barrier(0);
            if (b >= 1) {
                const int c = b - 1;
#pragma unroll
                for (int p = 0; p < 4; ++p) { const int ai = c >> 1, m = 2 * (c & 1) + (p >> 1), bj = p & 1;
                    float* op = xnew + (size_t)(row0 + ai * HALF + m * 16) * DM + col0 + bj * HALF;
                    *(f32x4*)op = x0[c & 1][p] + g0[bj] * acc[ai][bj][m][0]; *(f32x4*)(op + 4) = x1[c & 1][p] + g1[bj] * acc[ai][bj][m][1]; }
                __builtin_amdgcn_sched_barrier(0);
            }
        }
    }
};
}

struct Args { const float* in[26]; float* out; unsigned char* ws; int ph_lo, ph_hi; };
enum { I_X = 0, I_C, I_CTX, I_CCTX, I_NORMG, I_WADA, I_BADA, I_WIN, I_POOLW, I_POOLS, I_QNORM, I_KNORM, I_LQ1, I_LK1, I_LQ2, I_LK2, I_SUBLN, I_WGF, I_BGF, I_WGB, I_BGB, I_GLAN, I_WBP, I_WBD, I_WBG, I_WOUT };

__device__ __forceinline__ const float* inp(int i) { const float* const volatile __attribute__((address_space(4)))* kp = (const float* const volatile __attribute__((address_space(4)))*)__builtin_amdgcn_kernarg_segment_ptr(); const GAS float* q = (const GAS float*)kp[i]; asm volatile("" : "+s"(q)); return (const float*)q; }
__device__ __forceinline__ float* arg_out() { float* const volatile __attribute__((address_space(4)))* kp = (float* const volatile __attribute__((address_space(4)))*)__builtin_amdgcn_kernarg_segment_ptr(); GAS float* q = (GAS float*)kp[26]; asm volatile("" : "+s"(q)); return (float*)q; }
__device__ __forceinline__ void transpose_item(const float* W, int K, int N, bf16_t* WT, int row_off, LAS float* scr, int kb, int nb, int lane) {
    const int k0 = 64 * kb, n0 = 32 * nb;
    float tv[32];
#pragma unroll
    for (int i = 0; i < 32; ++i) { const int kk = 2 * i + (lane >> 5); tv[i] = __builtin_nontemporal_load(W + (size_t)(k0 + kk) * N + n0 + (lane & 31)); }
#pragma unroll
    for (int i = 0; i < 32; ++i) { const int kk = 2 * i + (lane >> 5); scr[kk * 33 + (lane & 31)] = tv[i]; }
    asm volatile("s_waitcnt lgkmcnt(0)" ::: "memory");
    const int c = lane & 7;
#pragma unroll
    for (int j = 0; j < 4; ++j) { const int n = (lane >> 3) + 8 * j; const LAS float* s = scr + (8 * c) * 33 + n;
        u32x4 o; o.x = cvt_pk_bf16(s[0 * 33], s[1 * 33]); o.y = cvt_pk_bf16(s[2 * 33], s[3 * 33]); o.z = cvt_pk_bf16(s[4 * 33], s[5 * 33]); o.w = cvt_pk_bf16(s[6 * 33], s[7 * 33]);
        *(u32x4*)(WT + (size_t)(row_off + n0 + n) * K + k0 + 8 * c) = o; }
    asm volatile("s_waitcnt lgkmcnt(0)" ::: "memory");
}

__device__ __forceinline__ void ada_items(const Args& a, LAS unsigned char* lds, int l, int bidx, int nb) {
    const int tid = opaque_tid(), lane = tid & 63, wave = __builtin_amdgcn_readfirstlane(tid >> 6);
    unsigned char* ws = opaque_ptr(a.ws);
    LAS float* sc = (LAS float*)(lds + 69632);
    LAS float* part = (LAS float*)(lds + 69632 + 40960);
    if (bidx < 96) {
        for (int i = tid; i < 5 * 2048; i += 512) { const int r = i >> 11, k = i & 2047; const float v = r < 4 ? inp(I_C)[r * 2048 + k] : inp(I_CCTX)[k]; sc[i] = silu_f(v); }
        __syncthreads();
    }
    for (int it = bidx; it < 96; it += nb) {
        const int cgp = it, col = cgp * 64 + lane;
        const float* W = inp(I_WADA) + (size_t)l * 2048 * 6144 + col;
        float acc[5] = {0.f, 0.f, 0.f, 0.f, 0.f};
#pragma unroll 32
        for (int kk = 0; kk < 256; ++kk) { const int k = wave * 256 + kk; const float wv = __builtin_nontemporal_load(W + (size_t)k * 6144);
#pragma unroll
            for (int r = 0; r < 5; ++r) acc[r] += sc[r * 2048 + k] * wv; }
#pragma unroll
        for (int r = 0; r < 5; ++r) part[(wave * 5 + r) * 64 + lane] = acc[r];
        __syncthreads();
        if (tid < 320) { const int r = tid >> 6, ln = tid & 63; float s2 = inp(I_BADA)[l * 6144 + cgp * 64 + ln];
#pragma unroll
            for (int w = 0; w < 8; ++w) s2 += part[(w * 5 + r) * 64 + ln];
            ((float*)(ws + OFF_MOD))[(l * 5 + r) * 6144 + cgp * 64 + ln] = s2; }
        __syncthreads();
    }
}

__device__ __forceinline__ void convert_layer_weights(const Args& a, LAS unsigned char* lds, int l, int widx, int nw) {
    const int lane = opaque_tid() & 63, wave = __builtin_amdgcn_readfirstlane((int)threadIdx.x >> 6);
    unsigned char* ws = opaque_ptr(a.ws);
    LAS float* scr = (LAS float*)(lds + wave * 8704);
    constexpr int I_IN = 32 * 481, I_B = 16 * 64, I_O = 32 * 64, I_P = 4 * 32, PER_L = I_IN + 3 * I_B + I_O + I_P;
    for (int it = widx; it < PER_L; it += nw) {
        int r = it;
        if (r < I_IN) { const int kb = r / 481, nb = r % 481;
            transpose_item(inp(I_WIN) + (size_t)l * DM * DIN, DM, DIN, (bf16_t*)(ws + OFF_WIN + (size_t)l * SZ_WIN), nb >= 289 ? 224 : 0, scr, kb, nb, lane); continue; }
        r -= I_IN;
        if (r < 3 * I_B) { const int br = r / I_B, rr = r % I_B; const float* W = (br == 0 ? inp(I_WBP) : br == 1 ? inp(I_WBD) : inp(I_WBG)) + (size_t)l * 1024 * DM;
            transpose_item(W, 1024, DM, (bf16_t*)(ws + OFF_WB + (size_t)l * SZ_WB + (size_t)br * DM * 1024 * 2), 0, scr, rr / 64, rr % 64, lane); continue; }
        r -= 3 * I_B;
        if (r < I_O) { transpose_item(inp(I_WOUT) + (size_t)l * DM * DM, DM, DM, (bf16_t*)(ws + OFF_WOUT + (size_t)l * SZ_WOUT), 0, scr, r / 64, r % 64, lane); continue; }
        r -= I_O;
        { const int g = r / 32, rr = r % 32;
          transpose_item(inp(I_POOLW) + (size_t)(l * 4 + g) * 65536, 256, 256, (bf16_t*)(ws + OFF_POOLT + (size_t)l * SZ_POOLT + (size_t)g * 65536 * 2), 0, scr, rr / 8, rr % 8, lane); }
    }
}

__device__ __forceinline__ void phase_p0(const Args& a, LAS unsigned char* lds) {
    const int tid = opaque_tid(), lane = tid & 63, wave = __builtin_amdgcn_readfirstlane(tid >> 6), G = opaque_s(gridDim.x);
    unsigned char* ws = opaque_ptr(a.ws);
    ada_items(a, lds, 0, BID, G);
    if (BID == G - 1 && wave == 0) {
        for (int l = 0; l < 2; ++l) {
            const float s1 = wave_sum(inp(I_LQ1)[l * 64 + lane] * inp(I_LK1)[l * 64 + lane]);
            const float s2 = wave_sum(inp(I_LQ2)[l * 64 + lane] * inp(I_LK2)[l * 64 + lane]);
            const float mq = wave_max(fabsf(inp(I_QNORM)[l * 64 + lane])), mk = wave_max(fabsf(inp(I_KNORM)[l * 64 + lane]));
            const float lam_init = 0.8f - 0.6f * expf(-0.3f * (float)l);
            if (lane == 0) { float* sp = (float*)(ws + OFF_SCAL) + l * 4; sp[0] = expf(s1) - expf(s2) + lam_init; sp[1] = 8.f * LOG2E * mq * mk; sp[2] = lam_init; sp[3] = 0.f; }
        }
    }
    {
        const int nper = 224 * 2048 * 2 / 16;
        for (int i = BID * 512 + tid; i < 2 * nper; i += G * 512) { const int l = i / nper, j = i % nper;
            *(u32x4*)(ws + OFF_WIN + (size_t)l * SZ_WIN + (size_t)9248 * DM * 2 + (size_t)j * 16) = (u32x4){0u, 0u, 0u, 0u}; }
    }
    convert_layer_weights(a, lds, 0, BID * 8 + wave, G * 8);
}

__device__ __forceinline__ void phase_norm(const Args& a, int l) {
    const int tid = opaque_tid(), lane = tid & 63, wave = tid >> 6, G = opaque_s(gridDim.x);
    const int gw = BID * 8 + wave, NGW = G * 8;
    const float* mod = (const float*)(opaque_ptr(a.ws) + OFF_MOD) + (size_t)l * 5 * 6144;
    const float* x1 = (const float*)(opaque_ptr(a.ws) + OFF_X1);
    bf16_t* h = (bf16_t*)(opaque_ptr(a.ws) + OFF_H);
    const float* ng = inp(I_NORMG) + l * DM;
    for (int row = gw; row < MT; row += NGW) {
        const float* src = (l == 0) ? (row < ML ? inp(I_X) + (size_t)row * DM : inp(I_CTX) + (size_t)(row - ML) * DM) : x1 + (size_t)row * DM;
        const int mr = row < ML ? row / SEQ : 4;
        const float* md = mod + mr * 6144;
        f32x4 v[8]; float ss = 0.f;
#pragma unroll
        for (int j = 0; j < 8; ++j) { v[j] = *(const f32x4*)(src + 4 * lane + 256 * j); ss += (v[j][0] * v[j][0] + v[j][1] * v[j][1]) + (v[j][2] * v[j][2] + v[j][3] * v[j][3]); }
        ss = wave_sum(ss);
        const float rstd = rsqrtf(ss * (1.f / DM) + EPS);
#pragma unroll
        for (int j = 0; j < 8; ++j) { const int idx = 4 * lane + 256 * j;
            const f32x4 gg = *(const f32x4*)(ng + idx), sc = *(const f32x4*)(md + 2048 + idx), sh = *(const f32x4*)(md + idx);
            f32x4 o;
#pragma unroll
            for (int e = 0; e < 4; ++e) o[e] = v[j][e] * rstd * gg[e] * (1.f + sc[e]) + sh[e];
            u32x2 w; w.x = cvt_pk_bf16(o[0], o[1]); w.y = cvt_pk_bf16(o[2], o[3]);
            *(u32x2*)(h + (size_t)row * DM + idx) = w; }
    }
}

__device__ __forceinline__ int vt_pos(int key) { const int k = key & 15; return (key & ~15) | (((k >> 2) & 1) << 3) | (k & 3) | (((k >> 3) & 1) << 2); }

__device__ __forceinline__ void phase_prep(const Args& a, int l, LAS unsigned char* lds) {
    const int tid = opaque_tid(), lane = tid & 63, wave = tid >> 6, G = opaque_s(gridDim.x);
    unsigned char* ws = opaque_ptr(a.ws);
    const bf16_t* z = (const bf16_t*)(ws + OFF_Z);
    const bool need_ctx = (l == 0);
    for (int it = BID; it < 1440; it += G) {
        if (it < 576) {
            const int c = it >> 2, cgp = it & 3, rb = 64 * c;
            LAS float* lrs = (LAS float*)lds;
            LAS float* segs = (LAS float*)(lds + 8192);
            for (int i = tid; i < 64 * 32; i += 512) { const int r = i >> 5, cc = i & 31; lrs[i] = bf2f(z[(size_t)(rb + r) * NZ + ZC_LR + cc]); }
            __syncthreads();
            const int seg = tid >> 6, cp = tid & 63, ch = cgp * 128 + 2 * cp;
            typedef float f32x2v __attribute__((ext_vector_type(2)));
            const float* wgf = inp(I_WGF) + (size_t)l * 16 * 512 + ch; const float* wgb = inp(I_WGB) + (size_t)l * 16 * 512 + ch;
            f32x2v wf[16], wb[16];
#pragma unroll
            for (int r = 0; r < 16; ++r) { wf[r] = *(const f32x2v*)(wgf + r * 512); wb[r] = *(const f32x2v*)(wgb + r * 512); }
            const f32x2v bfv = *(const f32x2v*)(inp(I_BGF) + l * 512 + ch), bbv = *(const f32x2v*)(inp(I_BGB) + l * 512 + ch);
            f32x2v gf[8], gb[8]; f32x2v sf = {0.f, 0.f}, sb = {0.f, 0.f};
#pragma unroll
            for (int i = 0; i < 8; ++i) { const int t = seg * 8 + i; f32x2v af = bfv, ab = bbv;
#pragma unroll
                for (int r4 = 0; r4 < 4; ++r4) { const f32x4 lf = *(const LAS f32x4*)(lrs + t * 32 + 4 * r4), lb = *(const LAS f32x4*)(lrs + t * 32 + 16 + 4 * r4);
#pragma unroll
                    for (int e = 0; e < 4; ++e) { af += lf[e] * wf[4 * r4 + e]; ab += lb[e] * wb[4 * r4 + e]; } }
                gf[i].x = logsig_f(af.x) * (1.f / 16.f); gf[i].y = logsig_f(af.y) * (1.f / 16.f);
                gb[i].x = logsig_f(ab.x) * (1.f / 16.f); gb[i].y = logsig_f(ab.y) * (1.f / 16.f); sf += gf[i]; sb += gb[i]; }
            *(LAS f32x2v*)(segs + seg * 128 + 2 * cp) = sf; *(LAS f32x2v*)(segs + 1024 + seg * 128 + 2 * cp) = sb;
            __syncthreads();
            f32x2v pf = {0.f, 0.f}, pb = {0.f, 0.f}, totf = {0.f, 0.f}, totb = {0.f, 0.f};
#pragma unroll
            for (int s2 = 0; s2 < 8; ++s2) { const f32x2v vf = *(const LAS f32x2v*)(segs + s2 * 128 + 2 * cp), vb = *(const LAS f32x2v*)(segs + 1024 + s2 * 128 + 2 * cp);
                totf += vf; totb += vb; if (s2 < seg) { pf += vf; pb += vb; } }
            unsigned* gq0 = (unsigned*)(ws + OFF_GQ), *gq1 = (unsigned*)(ws + OFF_GQ + SZ_G);
            unsigned* gk0 = (unsigned*)(ws + OFF_GK), *gk1 = (unsigned*)(ws + OFF_GK + SZ_G);
            bf16_t* gh0 = (bf16_t*)(ws + OFF_GH), *gh1 = (bf16_t*)(ws + OFF_GH + SZ_G);
            f32x2v h0[8], h1[8];
#pragma unroll
            for (int i = 0; i < 8; ++i) { const int t = seg * 8 + i;
                pf += gf[i]; const f32x2v bs = totb - pb; pb += gb[i];
                const size_t row = rb + t;
                const unsigned qw = *(const unsigned*)(z + row * NZ + ZC_GQ + ch), kw = *(const unsigned*)(z + row * NZ + ZC_GK + ch);
                const float q0 = bflo(qw) * 0.08838834764831845f, q1 = bfhi(qw) * 0.08838834764831845f, k0 = bflo(kw), k1 = bfhi(kw);
                const size_t o = (row * 512 + ch) >> 1;
                gq0[o] = cvt_pk_bf16(q0 * __expf(pf.x), q1 * __expf(pf.y)); gk0[o] = cvt_pk_bf16(k0 * __expf(-pf.x), k1 * __expf(-pf.y));
                gq1[o] = cvt_pk_bf16(q0 * __expf(bs.x), q1 * __expf(bs.y)); gk1[o] = cvt_pk_bf16(k0 * __expf(-bs.x), k1 * __expf(-bs.y));
                h0[i].x = k0 * __expf(totf.x - pf.x); h0[i].y = k1 * __expf(totf.y - pf.y);
                h1[i].x = k0 * __expf(totb.x - bs.x); h1[i].y = k1 * __expf(totb.y - bs.y); }
            {
#pragma unroll
                for (int cc = 0; cc < 2; ++cc) { u32x4 w0, w1;
                    w0.x = cvt_pk_bf16(h0[0][cc], h0[1][cc]); w0.y = cvt_pk_bf16(h0[2][cc], h0[3][cc]); w0.z = cvt_pk_bf16(h0[4][cc], h0[5][cc]); w0.w = cvt_pk_bf16(h0[6][cc], h0[7][cc]);
                    w1.x = cvt_pk_bf16(h1[0][cc], h1[1][cc]); w1.y = cvt_pk_bf16(h1[2][cc], h1[3][cc]); w1.z = cvt_pk_bf16(h1[4][cc], h1[5][cc]); w1.w = cvt_pk_bf16(h1[6][cc], h1[7][cc]);
                    const size_t oh = ((size_t)c * 512 + ch + cc) * 64 + seg * 8;
                    *(u32x4*)(gh0 + oh) = w0; *(u32x4*)(gh1 + oh) = w1; } }
            if (seg == 0) { float* dec = (float*)(ws + OFF_DEC);
                *(f32x2v*)(dec + (size_t)c * 512 + ch) = (f32x2v){__expf(totf.x), __expf(totf.y)}; *(f32x2v*)(dec + (size_t)(144 + c) * 512 + ch) = (f32x2v){__expf(totb.x), __expf(totb.y)}; }
            __syncthreads();
        } else if (it < 864) {
            const int rb = 32 * (it - 576); if (!need_ctx && rb >= ML) continue;
            const int seq0 = rb < ML ? (rb / SEQ) * SEQ : ML + ((rb - ML) / LC) * LC; const int L = rb < ML ? SEQ : LC;
            const int ts = rb - seq0;
            bf16_t* dp = (bf16_t*)(ws + OFF_DPOOL); bf16_t* pgt = (bf16_t*)(ws + OFF_PGATE);
#pragma unroll
            for (int i = 0; i < 12; ++i) { const int idx = tid + 512 * i, rr = idx >> 7, c8 = (idx & 127) * 8, p = ts - 8 + rr;
                if (p >= 0 && p < L) *(LAS u32x4*)(lds + rr * 2048 + c8 * 2) = *(const u32x4*)(z + (size_t)(seq0 + p) * NZ + ZC_PU + c8); }
            __syncthreads();
            const int ch8 = 8 * (tid & 127), tg = tid >> 7, hw = 1 << (ch8 >> 8);
            const int tl0 = ts + 8 * tg;
            float psc[8];
            { const float* pp = inp(I_POOLS) + l * 1024 + ch8; const f32x4 p0 = *(const f32x4*)pp, p1 = *(const f32x4*)(pp + 4);
#pragma unroll
              for (int e = 0; e < 4; ++e) { psc[e] = p0[e]; psc[4 + e] = p1[e]; } }
            u32x4 pgw[8];
#pragma unroll
            for (int t = 0; t < 8; ++t) pgw[t] = *(const u32x4*)(z + (size_t)(seq0 + tl0 + t) * NZ + ZC_PG + ch8);
            const LAS unsigned char* lc = lds + ch8 * 2 - (ts - 8) * 2048;
            float sm[8] = {0.f, 0.f, 0.f, 0.f, 0.f, 0.f, 0.f, 0.f};
            { const int lo = max(tl0 - hw, 0), hi = min(tl0 + hw, L);
              for (int p = lo; p < hi; ++p) { float u[8]; unpack8(*(const LAS u32x4*)(lc + p * 2048), u);
#pragma unroll
                  for (int e = 0; e < 8; ++e) sm[e] += u[e]; } }
#pragma unroll
            for (int t = 0; t < 8; ++t) { const int tl = tl0 + t; const int lo = max(tl - hw, 0), hi = min(tl + hw, L);
                const float rc = __builtin_amdgcn_rcpf((float)(hi - lo));
                float cur[8], pgv[8], ua[8], ur[8];
                unpack8(*(const LAS u32x4*)(lc + tl * 2048), cur); unpack8(pgw[t], pgv);
                unpack8(*(const LAS u32x4*)(lc + min(tl + hw, L - 1) * 2048), ua); unpack8(*(const LAS u32x4*)(lc + max(tl - hw, 0) * 2048), ur);
                const float ma = (tl + hw < L) ? 1.f : 0.f, mr = (tl - hw >= 0) ? 1.f : 0.f;
                u32x4 wd, wg;
                wd.x = cvt_pk_bf16(sm[0] * rc - cur[0], sm[1] * rc - cur[1]); wd.y = cvt_pk_bf16(sm[2] * rc - cur[2], sm[3] * rc - cur[3]);
                wd.z = cvt_pk_bf16(sm[4] * rc - cur[4], sm[5] * rc - cur[5]); wd.w = cvt_pk_bf16(sm[6] * rc - cur[6], sm[7] * rc - cur[7]);
                wg.x = cvt_pk_bf16(psc[0] * silu_f(pgv[0]), psc[1] * silu_f(pgv[1])); wg.y = cvt_pk_bf16(psc[2] * silu_f(pgv[2]), psc[3] * silu_f(pgv[3]));
                wg.z = cvt_pk_bf16(psc[4] * silu_f(pgv[4]), psc[5] * silu_f(pgv[5])); wg.w = cvt_pk_bf16(psc[6] * silu_f(pgv[6]), psc[7] * silu_f(pgv[7]));
                const size_t o = (size_t)(seq0 + tl) * 1024 + ch8;
                *(u32x4*)(dp + o) = wd; *(u32x4*)(pgt + o) = wg;
#pragma unroll
                for (int e = 0; e < 8; ++e) sm[e] += ma * ua[e] - mr * ur[e]; }
            __syncthreads();
        } else {
            const int vi = it - 864, isg = vi >= 288, vj = isg ? vi - 288 : vi, c = vj >> 1, hv = vj & 1, rb = 64 * c;
            int b, key0; if (rb < ML) { b = rb >> 11; key0 = LC + (rb & 2047); } else { b = (rb - ML) >> 8; key0 = (rb - ML) & 255; }
            bf16_t* vT = (bf16_t*)(ws + OFF_VT); bf16_t* gvT = (bf16_t*)(ws + OFF_GVT);
#pragma unroll
            for (int i = 0; i < 8; ++i) { const int idx = tid + 512 * i, key = idx & 63, c8 = (idx >> 6) * 8;
                const u32x4 w = *(const u32x4*)(z + (size_t)(rb + key) * NZ + (isg ? ZC_GV : ZC_DV) + hv * 512 + c8);
                const unsigned ww[4] = {w.x, w.y, w.z, w.w}; const int pos = isg ? key : vt_pos(key);
#pragma unroll
                for (int e = 0; e < 8; ++e) *(LAS bf16_t*)(lds + (c8 + e) * 144 + pos * 2) = (bf16_t)((e & 1) ? (ww[e >> 1] >> 16) : (ww[e >> 1] & 0xffffu)); }
            __syncthreads();
#pragma unroll
            for (int i = 0; i < 8; ++i) { const int idx = tid + 512 * i, col = idx >> 3, k8 = idx & 7, colg = hv * 512 + col, h = colg >> 7, v = colg & 127;
                bf16_t* dst = isg ? gvT + ((size_t)c * 1024 + colg) * 64 + k8 * 8 : vT + ((size_t)(b * 8 + h) * 128 + v) * LK + key0 + k8 * 8;
                *(u32x4*)dst = *(const LAS u32x4*)(lds + col * 144 + k8 * 16); }
            __syncthreads();
        }
    }
    {
        const int gw = BID * 8 + wave, NGW = G * 8;
        bf16_t* qn = (bf16_t*)(ws + OFF_QN); bf16_t* qnc = (bf16_t*)(ws + OFF_QNC); bf16_t* kn = (bf16_t*)(ws + OFF_KN);
        for (int it = gw; it < MT * 2; it += NGW) {
            const int row = it >> 1, which = it & 1;
            const bool isctx = row >= ML; int b, t; if (!isctx) { b = row >> 11; t = row & 2047; } else { b = (row - ML) >> 8; t = (row - ML) & 255; }
            const bf16_t* zr = z + (size_t)row * NZ;
            {
                if (which == 0 && isctx && !need_ctx) continue;
                float x[16]; const bf16_t* src = zr + (which == 0 ? ZC_DQ : ZC_DK) + 16 * lane;
                unpack8(*(const u32x4*)src, x); unpack8(*(const u32x4*)(src + 8), x + 8);
                float ss = 0.f;
#pragma unroll
                for (int e = 0; e < 16; ++e) ss += x[e] * x[e];
                ss += __shfl_xor(ss, 1); ss += __shfl_xor(ss, 2);
                const float rstd = rsqrtf(ss * (1.f / 64.f) + EPS);
                const int m = lane & 3, sh = lane >> 2, h = sh >> 1, j = sh & 1;
                const float* gain = (which == 0 ? inp(I_QNORM) : inp(I_KNORM)) + l * 64 + 16 * m;
                float y[16];
#pragma unroll
                for (int e = 0; e < 16; ++e) y[e] = x[e] * rstd * gain[e];
                if (!isctx) {
                    const float posf = (float)((m & 1) ? (t & 63) : (t >> 6));
#pragma unroll
                    for (int e = 0; e < 16; ++e) { const float yp = __shfl_xor(y[e], 2);
                        const float ang = posf * exp2f(-(float)e * 0.8304820237218405f);
                        const float cs = __cosf(ang), sn = __sinf(ang);
                        y[e] = (m < 2) ? (y[e] * cs - yp * sn) : (y[e] * cs + yp * sn); }
                }
                bf16_t* dst;
                if (which == 0) {
#pragma unroll
                    for (int e = 0; e < 16; ++e) y[e] *= 0.125f * LOG2E;
                    dst = isctx ? qnc + (((size_t)(b * 8 + h) * 2 + j) * LC + t) * 64 + 16 * m : qn + (((size_t)(b * 8 + h) * 2 + j) * SEQ + t) * 64 + 16 * m;
                } else dst = kn + (((size_t)(b * 8 + h) * 2 + j) * LK + (isctx ? t : LC + t)) * 64 + 16 * m;
                u32x4 w0, w1;
                w0.x = cvt_pk_bf16(y[0], y[1]); w0.y = cvt_pk_bf16(y[2], y[3]); w0.z = cvt_pk_bf16(y[4], y[5]); w0.w = cvt_pk_bf16(y[6], y[7]);
                w1.x = cvt_pk_bf16(y[8], y[9]); w1.y = cvt_pk_bf16(y[10], y[11]); w1.z = cvt_pk_bf16(y[12], y[13]); w1.w = cvt_pk_bf16(y[14], y[15]);
                *(u32x4*)dst = w0; *(u32x4*)(dst + 8) = w1;
            }
        }
    }
}

constexpr int GL_Q = 0, GL_K = 17408, GL_KH = 34816, GL_VT = 53248, GL_ATT = 57856, GL_ST = 67072;
__device__ __forceinline__ void gla_unit(const Args& a, int l, LAS unsigned char* lds, int item) {
    const int tid = opaque_tid(), lane = tid & 63, w = __builtin_amdgcn_readfirstlane(tid >> 6);
    const int vs = item & 7, dir = (item >> 3) & 1, h = (item >> 4) & 3, b = item >> 6;
    const bool need_ctx = (l == 0);
    unsigned char* ws = opaque_ptr(a.ws);
    const bf16_t* z = (const bf16_t*)(ws + OFF_Z);
    const bf16_t* gq = (const bf16_t*)(ws + OFF_GQ + dir * SZ_G) + h * 128;
    const bf16_t* gk = (const bf16_t*)(ws + OFF_GK + dir * SZ_G) + h * 128;
    const bf16_t* gh = (const bf16_t*)(ws + OFF_GH + dir * SZ_G) + (size_t)h * 128 * 64;
    const float* dec = (const float*)(ws + OFF_DEC) + (size_t)dir * 144 * 512 + h * 128;
    bf16_t* od = (bf16_t*)(ws + OFF_OF + (size_t)dir * MT * 1024 * 2) + h * 256 + vs * 32;
    const bf16_t* gvt = (const bf16_t*)(ws + OFF_GVT) + (size_t)(h * 256 + vs * 32) * 64;
    const int fr = lane & 15, fq = lane >> 4;
    f32x4 sacc[2] = {(f32x4){0.f, 0.f, 0.f, 0.f}, (f32x4){0.f, 0.f, 0.f, 0.f}};
    for (int i = tid; i < 32 * 136 / 2; i += 512) ((LAS unsigned*)(lds + GL_ST))[i] = 0u;
    u32x4 rqA[2], rkA[2], rhA[2], rvA, rqB[2], rkB[2], rhB[2], rvB; float rdecA, rdecB;
    auto rowbase = [&](int s) -> int { if (s < 4) { const int ci = dir == 0 ? s : 3 - s; return ML + b * LC + 64 * ci; } const int ci = dir == 0 ? s - 4 : 35 - s; return b * SEQ + 64 * ci; };
#define GLA_LOADA(s) do { const int _rb = rowbase(s); _Pragma("unroll") for (int _i = 0; _i < 2; ++_i) { const int _idx = tid + 512 * _i, _r = _idx >> 4, _c = (_idx & 15) * 8; const size_t _o = (size_t)(_rb + _r) * 512 + _c; \
        rqA[_i] = *(const u32x4*)(gq + _o); rkA[_i] = *(const u32x4*)(gk + _o); rhA[_i] = *(const u32x4*)(gh + ((size_t)(_rb >> 6) * 512 + (_idx >> 3)) * 64 + (_idx & 7) * 8); } \
        if (tid < 256) rvA = *(const u32x4*)(gvt + ((size_t)(_rb >> 6) * 1024 + (tid >> 3)) * 64 + (tid & 7) * 8); \
        rdecA = dec[(size_t)(_rb >> 6) * 512 + 16 * w + fr]; } while (0)
#define GLA_LOADB(s) do { const int _rb = rowbase(s); _Pragma("unroll") for (int _i = 0; _i < 2; ++_i) { const int _idx = tid + 512 * _i, _r = _idx >> 4, _c = (_idx & 15) * 8; const size_t _o = (size_t)(_rb + _r) * 512 + _c; \
        rqB[_i] = *(const u32x4*)(gq + _o); rkB[_i] = *(const u32x4*)(gk + _o); rhB[_i] = *(const u32x4*)(gh + ((size_t)(_rb >> 6) * 512 + (_idx >> 3)) * 64 + (_idx & 7) * 8); } \
        if (tid < 256) rvB = *(const u32x4*)(gvt + ((size_t)(_rb >> 6) * 1024 + (tid >> 3)) * 64 + (tid & 7) * 8); \
        rdecB = dec[(size_t)(_rb >> 6) * 512 + 16 * w + fr]; } while (0)
    GLA_LOADA(0); GLA_LOADB(1);
    for (int s0_ = 0; s0_ < 36; s0_ += 2) {
      { const int s = s0_;
        const int rb = rowbase(s);
        const float dk = rdecA;
#pragma unroll
        for (int i = 0; i < 2; ++i) { const int idx = tid + 512 * i, r = idx >> 4, c = (idx & 15) * 8;
            *(LAS u32x4*)(lds + GL_Q + r * 272 + c * 2) = rqA[i]; *(LAS u32x4*)(lds + GL_K + r * 272 + c * 2) = rkA[i];
            const int s0 = (idx & 7) * 8, p1 = (s0 & 32) + 8 * ((s0 & 15) >> 2) + 4 * ((s0 >> 4) & 1);
            *(LAS u32x2*)(lds + GL_KH + (idx >> 3) * 144 + p1 * 2) = (u32x2){rhA[i].x, rhA[i].y}; *(LAS u32x2*)(lds + GL_KH + (idx >> 3) * 144 + (p1 + 8) * 2) = (u32x2){rhA[i].z, rhA[i].w}; }
        if (tid < 256) { const int s0 = (tid & 7) * 8, p1 = (s0 & 32) + 8 * ((s0 & 15) >> 2) + 4 * ((s0 >> 4) & 1);
            *(LAS u32x2*)(lds + GL_VT + (tid >> 3) * 144 + p1 * 2) = (u32x2){rvA.x, rvA.y}; *(LAS u32x2*)(lds + GL_VT + (tid >> 3) * 144 + (p1 + 8) * 2) = (u32x2){rvA.z, rvA.w}; }
        __syncthreads();
        if (s + 2 < 36) GLA_LOADA(s + 2);
        const int tt = w >> 1, vt = w & 1;
        bf16x8 pb[2];
        {
            f32x4 at[4];
#pragma unroll
            for (int st = 0; st < 4; ++st) { f32x4 acc = (f32x4){0.f, 0.f, 0.f, 0.f};
#pragma unroll
                for (int kk = 0; kk < 4; ++kk) { const bf16x8 af = *(const LAS bf16x8*)(lds + GL_K + (16 * st + fr) * 272 + (32 * kk + 8 * fq) * 2);
                    const bf16x8 bfr = *(const LAS bf16x8*)(lds + GL_Q + (16 * tt + fr) * 272 + (32 * kk + 8 * fq) * 2);
                    acc = __builtin_amdgcn_mfma_f32_16x16x32_bf16(af, bfr, acc, 0, 0, 0); }
#pragma unroll
                for (int j = 0; j < 4; ++j) { const int sc = 16 * st + 4 * fq + j, t = 16 * tt + fr; const bool keep = dir == 0 ? (sc <= t) : (sc >= t); acc[j] = keep ? acc[j] : 0.f; }
                at[st] = acc; }
#pragma unroll
            for (int p = 0; p < 2; ++p) { u32x4 pw; pw.x = cvt_pk_bf16(at[2 * p][0], at[2 * p][1]); pw.y = cvt_pk_bf16(at[2 * p][2], at[2 * p][3]);
                pw.z = cvt_pk_bf16(at[2 * p + 1][0], at[2 * p + 1][1]); pw.w = cvt_pk_bf16(at[2 * p + 1][2], at[2 * p + 1][3]); pb[p] = __builtin_bit_cast(bf16x8, pw); }
        }
        {
            f32x4 acc = (f32x4){0.f, 0.f, 0.f, 0.f};
#pragma unroll
            for (int kk = 0; kk < 4; ++kk) { const bf16x8 af = *(const LAS bf16x8*)(lds + GL_ST + (16 * vt + fr) * 272 + (32 * kk + 8 * fq) * 2);
                const bf16x8 bfr = *(const LAS bf16x8*)(lds + GL_Q + (16 * tt + fr) * 272 + (32 * kk + 8 * fq) * 2);
                acc = __builtin_amdgcn_mfma_f32_16x16x32_bf16(af, bfr, acc, 0, 0, 0); }
#pragma unroll
            for (int p = 0; p < 2; ++p) { const bf16x8 af = *(const LAS bf16x8*)(lds + GL_VT + (16 * vt + fr) * 144 + (32 * p + 8 * fq) * 2);
                acc = __builtin_amdgcn_mfma_f32_16x16x32_bf16(af, pb[p], acc, 0, 0, 0); }
            if (s >= 4 || need_ctx) { u32x2 wv; wv.x = cvt_pk_bf16(acc[0], acc[1]); wv.y = cvt_pk_bf16(acc[2], acc[3]);
                *(u32x2*)(od + (size_t)(rb + 16 * tt + fr) * 1024 + 16 * vt + 4 * fq) = wv; }
        }
#pragma unroll
        for (int vt2 = 0; vt2 < 2; ++vt2) { f32x4 acc = sacc[vt2] * dk;
#pragma unroll
            for (int kk = 0; kk < 2; ++kk) { const bf16x8 af = *(const LAS bf16x8*)(lds + GL_VT + (16 * vt2 + fr) * 144 + (32 * kk + 8 * fq) * 2);
                const bf16x8 bfr = *(const LAS bf16x8*)(lds + GL_KH + (16 * w + fr) * 144 + (32 * kk + 8 * fq) * 2);
                acc = __builtin_amdgcn_mfma_f32_16x16x32_bf16(af, bfr, acc, 0, 0, 0); }
            sacc[vt2] = acc; }
        __syncthreads();
#pragma unroll
        for (int vt = 0; vt < 2; ++vt)
#pragma unroll
            for (int j = 0; j < 4; ++j) *(LAS bf16_t*)(lds + GL_ST + (16 * vt + 4 * fq + j) * 272 + (16 * w + fr) * 2) = f2bf(sacc[vt][j]);
      }
      { const int s = s0_ + 1;
        const int rb = rowbase(s);
        const float dk = rdecB;
#pragma unroll
        for (int i = 0; i < 2; ++i) { const int idx = tid + 512 * i, r = idx >> 4, c = (idx & 15) * 8;
            *(LAS u32x4*)(lds + GL_Q + r * 272 + c * 2) = rqB[i]; *(LAS u32x4*)(lds + GL_K + r * 272 + c * 2) = rkB[i];
            const int s0 = (idx & 7) * 8, p1 = (s0 & 32) + 8 * ((s0 & 15) >> 2) + 4 * ((s0 >> 4) & 1);
            *(LAS u32x2*)(lds + GL_KH + (idx >> 3) * 144 + p1 * 2) = (u32x2){rhB[i].x, rhB[i].y}; *(LAS u32x2*)(lds + GL_KH + (idx >> 3) * 144 + (p1 + 8) * 2) = (u32x2){rhB[i].z, rhB[i].w}; }
        if (tid < 256) { const int s0 = (tid & 7) * 8, p1 = (s0 & 32) + 8 * ((s0 & 15) >> 2) + 4 * ((s0 >> 4) & 1);
            *(LAS u32x2*)(lds + GL_VT + (tid >> 3) * 144 + p1 * 2) = (u32x2){rvB.x, rvB.y}; *(LAS u32x2*)(lds + GL_VT + (tid >> 3) * 144 + (p1 + 8) * 2) = (u32x2){rvB.z, rvB.w}; }
        __syncthreads();
        if (s + 2 < 36) GLA_LOADB(s + 2);
        const int tt = w >> 1, vt = w & 1;
        bf16x8 pb[2];
        {
            f32x4 at[4];
#pragma unroll
            for (int st = 0; st < 4; ++st) { f32x4 acc = (f32x4){0.f, 0.f, 0.f, 0.f};
#pragma unroll
                for (int kk = 0; kk < 4; ++kk) { const bf16x8 af = *(const LAS bf16x8*)(lds + GL_K + (16 * st + fr) * 272 + (32 * kk + 8 * fq) * 2);
                    const bf16x8 bfr = *(const LAS bf16x8*)(lds + GL_Q + (16 * tt + fr) * 272 + (32 * kk + 8 * fq) * 2);
                    acc = __builtin_amdgcn_mfma_f32_16x16x32_bf16(af, bfr, acc, 0, 0, 0); }
#pragma unroll
                for (int j = 0; j < 4; ++j) { const int sc = 16 * st + 4 * fq + j, t = 16 * tt + fr; const bool keep = dir == 0 ? (sc <= t) : (sc >= t); acc[j] = keep ? acc[j] : 0.f; }
                at[st] = acc; }
#pragma unroll
            for (int p = 0; p < 2; ++p) { u32x4 pw; pw.x = cvt_pk_bf16(at[2 * p][0], at[2 * p][1]); pw.y = cvt_pk_bf16(at[2 * p][2], at[2 * p][3]);
                pw.z = cvt_pk_bf16(at[2 * p + 1][0], at[2 * p + 1][1]); pw.w = cvt_pk_bf16(at[2 * p + 1][2], at[2 * p + 1][3]); pb[p] = __builtin_bit_cast(bf16x8, pw); }
        }
        {
            f32x4 acc = (f32x4){0.f, 0.f, 0.f, 0.f};
#pragma unroll
            for (int kk = 0; kk < 4; ++kk) { const bf16x8 af = *(const LAS bf16x8*)(lds + GL_ST + (16 * vt + fr) * 272 + (32 * kk + 8 * fq) * 2);
                const bf16x8 bfr = *(const LAS bf16x8*)(lds + GL_Q + (16 * tt + fr) * 272 + (32 * kk + 8 * fq) * 2);
                acc = __builtin_amdgcn_mfma_f32_16x16x32_bf16(af, bfr, acc, 0, 0, 0); }
#pragma unroll
            for (int p = 0; p < 2; ++p) { const bf16x8 af = *(const LAS bf16x8*)(lds + GL_VT + (16 * vt + fr) * 144 + (32 * p + 8 * fq) * 2);
                acc = __builtin_amdgcn_mfma_f32_16x16x32_bf16(af, pb[p], acc, 0, 0, 0); }
            if (s >= 4 || need_ctx) { u32x2 wv; wv.x = cvt_pk_bf16(acc[0], acc[1]); wv.y = cvt_pk_bf16(acc[2], acc[3]);
                *(u32x2*)(od + (size_t)(rb + 16 * tt + fr) * 1024 + 16 * vt + 4 * fq) = wv; }
        }
#pragma unroll
        for (int vt2 = 0; vt2 < 2; ++vt2) { f32x4 acc = sacc[vt2] * dk;
#pragma unroll
            for (int kk = 0; kk < 2; ++kk) { const bf16x8 af = *(const LAS bf16x8*)(lds + GL_VT + (16 * vt2 + fr) * 144 + (32 * kk + 8 * fq) * 2);
                const bf16x8 bfr = *(const LAS bf16x8*)(lds + GL_KH + (16 * w + fr) * 144 + (32 * kk + 8 * fq) * 2);
                acc = __builtin_amdgcn_mfma_f32_16x16x32_bf16(af, bfr, acc, 0, 0, 0); }
            sacc[vt2] = acc; }
        __syncthreads();
#pragma unroll
        for (int vt = 0; vt < 2; ++vt)
#pragma unroll
            for (int j = 0; j < 4; ++j) *(LAS bf16_t*)(lds + GL_ST + (16 * vt + 4 * fq + j) * 272 + (16 * w + fr) * 2) = f2bf(sacc[vt][j]);
      }
    }
    __syncthreads();
#undef GLA_LOADA
#undef GLA_LOADB
}


constexpr int G2_Q = 0, G2_K = 17408, G2_KH = 34816, G2_VT = 53248, G2_ST = 62464;
__device__ __forceinline__ void gla_unit2(const Args& a, int l, LAS unsigned char* lds, int item) {
    const int tid = opaque_tid(), lane = tid & 63, w = __builtin_amdgcn_readfirstlane(tid >> 6);
    const int vs2 = item & 3, dir = (item >> 2) & 1, h = (item >> 3) & 3, b = item >> 5;
    const bool need_ctx = (l == 0);
    unsigned char* ws = opaque_ptr(a.ws);
    const bf16_t* gq = (const bf16_t*)(ws + OFF_GQ + dir * SZ_G) + h * 128;
    const bf16_t* gk = (const bf16_t*)(ws + OFF_GK + dir * SZ_G) + h * 128;
    const bf16_t* gh = (const bf16_t*)(ws + OFF_GH + dir * SZ_G) + (size_t)h * 128 * 64;
    const float* dec = (const float*)(ws + OFF_DEC) + (size_t)dir * 144 * 512 + h * 128;
    bf16_t* od = (bf16_t*)(ws + OFF_OF + (size_t)dir * MT * 1024 * 2) + h * 256 + vs2 * 64;
    const bf16_t* gvt = (const bf16_t*)(ws + OFF_GVT) + (size_t)(h * 256 + vs2 * 64) * 64;
    const int fr = lane & 15, fq = lane >> 4;
    f32x4 sacc[4];
#pragma unroll
    for (int i = 0; i < 4; ++i) sacc[i] = (f32x4){0.f, 0.f, 0.f, 0.f};
    for (int i = tid; i < 64 * 136 / 2; i += 512) ((LAS unsigned*)(lds + G2_ST))[i] = 0u;
    u32x4 rqA[2], rkA[2], rhA[2], rvA, rqB[2], rkB[2], rhB[2], rvB; float rdecA, rdecB;
    auto rowbase = [&](int s) -> int { if (s < 4) { const int ci = dir == 0 ? s : 3 - s; return ML + b * LC + 64 * ci; } const int ci = dir == 0 ? s - 4 : 35 - s; return b * SEQ + 64 * ci; };
#define G2_LOAD(X, s) do { const int _rb = rowbase(s); _Pragma("unroll") for (int _i = 0; _i < 2; ++_i) { const int _idx = tid + 512 * _i, _r = _idx >> 4, _c = (_idx & 15) * 8; const size_t _o = (size_t)(_rb + _r) * 512 + _c; \
        rq##X[_i] = *(const u32x4*)(gq + _o); rk##X[_i] = *(const u32x4*)(gk + _o); rh##X[_i] = *(const u32x4*)(gh + ((size_t)(_rb >> 6) * 512 + (_idx >> 3)) * 64 + (_idx & 7) * 8); } \
        rv##X = *(const u32x4*)(gvt + ((size_t)(_rb >> 6) * 1024 + (tid >> 3)) * 64 + (tid & 7) * 8); \
        rdec##X = dec[(size_t)(_rb >> 6) * 512 + 16 * w + fr]; } while (0)
#define G2_STEP(X, s) do { \
        const int rb = rowbase(s); const float dk = rdec##X; \
        _Pragma("unroll") for (int i = 0; i < 2; ++i) { const int idx = tid + 512 * i, r = idx >> 4, c = (idx & 15) * 8; \
            *(LAS u32x4*)(lds + G2_Q + r * 272 + c * 2) = rq##X[i]; *(LAS u32x4*)(lds + G2_K + r * 272 + c * 2) = rk##X[i]; \
            const int s0 = (idx & 7) * 8, p1 = (s0 & 32) + 8 * ((s0 & 15) >> 2) + 4 * ((s0 >> 4) & 1); \
            *(LAS u32x2*)(lds + G2_KH + (idx >> 3) * 144 + p1 * 2) = (u32x2){rh##X[i].x, rh##X[i].y}; *(LAS u32x2*)(lds + G2_KH + (idx >> 3) * 144 + (p1 + 8) * 2) = (u32x2){rh##X[i].z, rh##X[i].w}; } \
        { const int s0 = (tid & 7) * 8, p1 = (s0 & 32) + 8 * ((s0 & 15) >> 2) + 4 * ((s0 >> 4) & 1); \
            *(LAS u32x2*)(lds + G2_VT + (tid >> 3) * 144 + p1 * 2) = (u32x2){rv##X.x, rv##X.y}; *(LAS u32x2*)(lds + G2_VT + (tid >> 3) * 144 + (p1 + 8) * 2) = (u32x2){rv##X.z, rv##X.w}; } \
        __syncthreads(); \
        if ((s) + 2 < 36) G2_LOAD(X, (s) + 2); \
        const int tt = w >> 1, vp = w & 1; \
        { \
            bf16x8 qf[4], kf[4][4]; \
            _Pragma("unroll") for (int kk = 0; kk < 4; ++kk) qf[kk] = *(const LAS bf16x8*)(lds + G2_Q + (16 * tt + fr) * 272 + (32 * kk + 8 * fq) * 2); \
            _Pragma("unroll") for (int st = 0; st < 4; ++st) _Pragma("unroll") for (int kk = 0; kk < 4; ++kk) kf[st][kk] = *(const LAS bf16x8*)(lds + G2_K + (16 * st + fr) * 272 + (32 * kk + 8 * fq) * 2); \
            __builtin_amdgcn_sched_barrier(0); \
            f32x4 at[4]; \
            _Pragma("unroll") for (int st = 0; st < 4; ++st) at[st] = (f32x4){0.f, 0.f, 0.f, 0.f}; \
            _Pragma("unroll") for (int kk = 0; kk < 4; ++kk) _Pragma("unroll") for (int st = 0; st < 4; ++st) at[st] = __builtin_amdgcn_mfma_f32_16x16x32_bf16(kf[st][kk], qf[kk], at[st], 0, 0, 0); \
            __builtin_amdgcn_sched_barrier(0); \
            bf16x8 sf[2][4], vfr[4][2], khf[2], vfo[2][2]; \
            _Pragma("unroll") for (int i = 0; i < 2; ++i) _Pragma("unroll") for (int kk = 0; kk < 4; ++kk) sf[i][kk] = *(const LAS bf16x8*)(lds + G2_ST + (16 * (2 * vp + i) + fr) * 272 + (32 * kk + 8 * fq) * 2); \
            _Pragma("unroll") for (int v2 = 0; v2 < 4; ++v2) _Pragma("unroll") for (int kk = 0; kk < 2; ++kk) vfr[v2][kk] = *(const LAS bf16x8*)(lds + G2_VT + (16 * v2 + fr) * 144 + (32 * kk + 8 * fq) * 2); \
            _Pragma("unroll") for (int kk = 0; kk < 2; ++kk) khf[kk] = *(const LAS bf16x8*)(lds + G2_KH + (16 * w + fr) * 144 + (32 * kk + 8 * fq) * 2); \
            _Pragma("unroll") for (int i = 0; i < 2; ++i) _Pragma("unroll") for (int p = 0; p < 2; ++p) vfo[i][p] = *(const LAS bf16x8*)(lds + G2_VT + (16 * (2 * vp + i) + fr) * 144 + (32 * p + 8 * fq) * 2); \
            __builtin_amdgcn_sched_barrier(0); \
            _Pragma("unroll") for (int v2 = 0; v2 < 4; ++v2) { f32x4 acc = sacc[v2] * dk; \
                _Pragma("unroll") for (int kk = 0; kk < 2; ++kk) acc = __builtin_amdgcn_mfma_f32_16x16x32_bf16(vfr[v2][kk], khf[kk], acc, 0, 0, 0); \
                sacc[v2] = acc; } \
            f32x4 oacc[2]; \
            _Pragma("unroll") for (int i = 0; i < 2; ++i) { oacc[i] = (f32x4){0.f, 0.f, 0.f, 0.f}; \
                _Pragma("unroll") for (int kk = 0; kk < 4; ++kk) oacc[i] = __builtin_amdgcn_mfma_f32_16x16x32_bf16(sf[i][kk], qf[kk], oacc[i], 0, 0, 0); } \
            bf16x8 pb[2]; \
            _Pragma("unroll") for (int st = 0; st < 4; ++st) _Pragma("unroll") for (int j = 0; j < 4; ++j) { const int sc = 16 * st + 4 * fq + j, t = 16 * tt + fr; const bool keep = dir == 0 ? (sc <= t) : (sc >= t); at[st][j] = keep ? at[st][j] : 0.f; } \
            _Pragma("unroll") for (int p = 0; p < 2; ++p) { u32x4 pw; pw.x = cvt_pk_bf16(at[2 * p][0], at[2 * p][1]); pw.y = cvt_pk_bf16(at[2 * p][2], at[2 * p][3]); \
                pw.z = cvt_pk_bf16(at[2 * p + 1][0], at[2 * p + 1][1]); pw.w = cvt_pk_bf16(at[2 * p + 1][2], at[2 * p + 1][3]); pb[p] = __builtin_bit_cast(bf16x8, pw); } \
            _Pragma("unroll") for (int i = 0; i < 2; ++i) { \
                _Pragma("unroll") for (int p = 0; p < 2; ++p) oacc[i] = __builtin_amdgcn_mfma_f32_16x16x32_bf16(vfo[i][p], pb[p], oacc[i], 0, 0, 0); \
                if ((s) >= 4 || need_ctx) { u32x2 wv; wv.x = cvt_pk_bf16(oacc[i][0], oacc[i][1]); wv.y = cvt_pk_bf16(oacc[i][2], oacc[i][3]); \
                    *(u32x2*)(od + (size_t)(rb + 16 * tt + fr) * 1024 + 16 * (2 * vp + i) + 4 * fq) = wv; } } \
        } \
        __syncthreads(); \
        _Pragma("unroll") for (int v2 = 0; v2 < 4; ++v2) _Pragma("unroll") for (int j = 0; j < 4; ++j) *(LAS bf16_t*)(lds + G2_ST + (16 * v2 + 4 * fq + j) * 272 + (16 * w + fr) * 2) = f2bf(sacc[v2][j]); \
    } while (0)
    G2_LOAD(A, 0); G2_LOAD(B, 1);
    for (int s0_ = 0; s0_ < 36; s0_ += 2) { G2_STEP(A, s0_); G2_STEP(B, s0_ + 1); }
    __syncthreads();
#undef G2_LOAD
#undef G2_STEP
}

constexpr int AT_BUF = 36864, AT_K = 0, AT_V = 18432;
template <bool SHIFT>
__device__ __forceinline__ void attn_unit(LAS unsigned char* lds, const bf16_t* qbase, int Lq, int q0, const bf16_t* kbase, const bf16_t* vtbase, int nkeys,
                                          float c2, float lam, float post_scale, const float* subln, const bf16_t* dg, bf16_t* outp, int row0) {
    const int tid = opaque_tid(), lane = tid & 63, w = __builtin_amdgcn_readfirstlane(tid >> 6), q32 = lane & 31, hi = lane >> 5;
    const int j = w >> 2, qg = w & 3;
    bf16x8 qf[4];
#pragma unroll
    for (int kk = 0; kk < 4; ++kk) qf[kk] = *(const bf16x8*)(qbase + ((size_t)j * Lq + q0 + 32 * qg + q32) * 64 + 16 * kk + 8 * hi);
    f32x16 o[4];
#pragma unroll
    for (int vt = 0; vt < 4; ++vt)
#pragma unroll
        for (int r = 0; r < 16; ++r) o[vt][r] = 0.f;
    float lsum = 0.f;
    const int nt = nkeys >> 6;
    u32x4 skA[2], svA[2];
#define AT_LOAD(sk, sv, i) do { _Pragma("unroll") for (int _c = 0; _c < 2; ++_c) { const int _idx = tid + 512 * _c; \
        sk[_c] = *(const u32x4*)(kbase + ((size_t)(_idx >> 9) * LK + 64 * (i) + ((_idx & 511) >> 3)) * 64 + (_idx & 7) * 8); \
        sv[_c] = *(const u32x4*)(vtbase + (size_t)(_idx >> 3) * LK + 64 * (i) + (_idx & 7) * 8); } } while (0)
#define AT_STORE(sk, sv, p) do { _Pragma("unroll") for (int _c = 0; _c < 2; ++_c) { const int _idx = tid + 512 * _c; \
        *(LAS u32x4*)(lds + (p) * AT_BUF + AT_K + ((_idx >> 9) * 64 + ((_idx & 511) >> 3)) * 144 + (_idx & 7) * 16) = sk[_c]; \
        *(LAS u32x4*)(lds + (p) * AT_BUF + AT_V + (_idx >> 3) * 144 + (_idx & 7) * 16) = sv[_c]; } } while (0)
#define AT_KF(kb, kk) (*(const LAS bf16x8*)(Kb + (32 * (kb) + q32) * 144 + (16 * (kk) + 8 * hi) * 2))
#define AT_VF(ks, vt) (*(const LAS bf16x8*)(Vb + (32 * (vt) + q32) * 144 + (16 * (ks) + 8 * hi) * 2))
#define AT_TILE(p) do { \
        LAS unsigned char* Kb = lds + (p) * AT_BUF + AT_K + j * (64 * 144); LAS unsigned char* Vb = lds + (p) * AT_BUF + AT_V; \
        bf16x8 kf[4], vf[4], vg[4]; \
        _Pragma("unroll") for (int kk = 0; kk < 4; ++kk) kf[kk] = AT_KF(0, kk); \
        _Pragma("unroll") for (int kb = 0; kb < 2; ++kb) { \
            _Pragma("unroll") for (int vt = 0; vt < 4; ++vt) vf[vt] = AT_VF(2 * kb, vt); \
            __builtin_amdgcn_sched_barrier(0); \
            f32x16 s; \
            _Pragma("unroll") for (int r = 0; r < 16; ++r) s[r] = 0.f; \
            _Pragma("unroll") for (int kk = 0; kk < 4; ++kk) s = __builtin_amdgcn_mfma_f32_32x32x16_bf16(kf[kk], qf[kk], s, 0, 0, 0); \
            __builtin_amdgcn_sched_barrier(0); \
            _Pragma("unroll") for (int vt = 0; vt < 4; ++vt) vg[vt] = AT_VF(2 * kb + 1, vt); \
            if (kb == 0) { _Pragma("unroll") for (int kk = 0; kk < 4; ++kk) kf[kk] = AT_KF(1, kk); } \
            __builtin_amdgcn_sched_barrier(0); \
            _Pragma("unroll") for (int r = 0; r < 16; ++r) { s[r] = __builtin_amdgcn_exp2f(SHIFT ? s[r] - c2 : s[r]); lsum += s[r]; } \
            u32x4 pw0, pw1; \
            pw0.x = cvt_pk_bf16(s[0], s[1]); pw0.y = cvt_pk_bf16(s[2], s[3]); pw0.z = cvt_pk_bf16(s[4], s[5]); pw0.w = cvt_pk_bf16(s[6], s[7]); \
            pw1.x = cvt_pk_bf16(s[8], s[9]); pw1.y = cvt_pk_bf16(s[10], s[11]); pw1.z = cvt_pk_bf16(s[12], s[13]); pw1.w = cvt_pk_bf16(s[14], s[15]); \
            const bf16x8 pb0 = __builtin_bit_cast(bf16x8, pw0), pb1 = __builtin_bit_cast(bf16x8, pw1); \
            _Pragma("unroll") for (int vt = 0; vt < 4; ++vt) o[vt] = __builtin_amdgcn_mfma_f32_32x32x16_bf16(vf[vt], pb0, o[vt], 0, 0, 0); \
            _Pragma("unroll") for (int vt = 0; vt < 4; ++vt) o[vt] = __builtin_amdgcn_mfma_f32_32x32x16_bf16(vg[vt], pb1, o[vt], 0, 0, 0); \
            __builtin_amdgcn_sched_barrier(0); \
        } } while (0)
    AT_LOAD(skA, svA, 0); AT_STORE(skA, svA, 0);
    __syncthreads();
    for (int i = 0; i < nt; i += 2) {
        AT_LOAD(skA, svA, i + 1);
        AT_TILE(0);
        AT_STORE(skA, svA, 1);
        __syncthreads();
        if (i + 2 < nt) AT_LOAD(skA, svA, i + 2);
        AT_TILE(1);
        if (i + 2 < nt) AT_STORE(skA, svA, 0);
        __syncthreads();
    }
#undef AT_TILE
#undef AT_KF
#undef AT_VF
#undef AT_LOAD
#undef AT_STORE
    lsum += __shfl_xor(lsum, 32);
    LAS float* xch = (LAS float*)lds + (size_t)qg * 4096 + lane;
    if (j == 1) {
        const float sc = lam / lsum;
#pragma unroll
        for (int vt = 0; vt < 4; ++vt)
#pragma unroll
            for (int r = 0; r < 16; ++r) xch[(vt * 16 + r) * 64] = o[vt][r] * sc;
    }
    __syncthreads();
    if (j == 0) {
        const float i0 = 1.f / lsum;
        float ss = 0.f;
#pragma unroll
        for (int vt = 0; vt < 4; ++vt)
#pragma unroll
            for (int r = 0; r < 16; ++r) { const float v = o[vt][r] * i0 - xch[(vt * 16 + r) * 64]; o[vt][r] = v; ss += v * v; }
        ss += __shfl_xor(ss, 32);
        const float rstd = rsqrtf(ss * (1.f / 128.f) + EPS) * post_scale;
        const size_t row = (size_t)row0 + 32 * qg + q32;
#pragma unroll
        for (int vt = 0; vt < 4; ++vt)
#pragma unroll
            for (int g4 = 0; g4 < 4; ++g4) {
                const int v0 = 32 * vt + 8 * g4 + 4 * hi;
                const u32x2 gz = *(const u32x2*)(dg + row * NZ + v0);
                const f32x4 sl = *(const f32x4*)(subln + v0);
                const float r0 = o[vt][4 * g4 + 0] * rstd * sl[0] * silu_f(bflo(gz.x)), r1 = o[vt][4 * g4 + 1] * rstd * sl[1] * silu_f(bfhi(gz.x));
                const float r2 = o[vt][4 * g4 + 2] * rstd * sl[2] * silu_f(bflo(gz.y)), r3 = o[vt][4 * g4 + 3] * rstd * sl[3] * silu_f(bfhi(gz.y));
                u32x2 wv; wv.x = cvt_pk_bf16(r0, r1); wv.y = cvt_pk_bf16(r2, r3);
                *(u32x2*)(outp + row * 1024 + v0) = wv;
            }
    }
    __syncthreads();
}

__device__ __forceinline__ void phase_mix(const Args& a, int l, LAS unsigned char* lds) {
    const int G = opaque_s(gridDim.x);
    unsigned char* ws = opaque_ptr(a.ws);
    const bool need_ctx = (l == 0);
    const float* scal = (const float*)(ws + OFF_SCAL) + l * 4;
    const float lam = scal[0], c2 = scal[1], post = 1.f - scal[2];
    const bf16_t* z = (const bf16_t*)(ws + OFF_Z);
    const bool big = c2 > 48.f;
#define ATTN_UNIT(...) do { if (big) attn_unit<true>(__VA_ARGS__); else attn_unit<false>(__VA_ARGS__); } while (0)
#define ATTN_LATENT(vc_) do { const int vc = (vc_), bh = vc >> 4, qb = vc & 15, b = bh >> 3, h = bh & 7; \
        ATTN_UNIT(lds, (const bf16_t*)(ws + OFF_QN) + (size_t)bh * 2 * SEQ * 64, SEQ, 128 * qb, (const bf16_t*)(ws + OFF_KN) + (size_t)bh * 2 * LK * 64, \
                  (const bf16_t*)(ws + OFF_VT) + (size_t)bh * 128 * LK, LK, c2, lam, post, inp(I_SUBLN) + l * 128, z + ZC_DG + h * 128, (bf16_t*)(ws + OFF_DIFFO) + h * 128, b * SEQ + 128 * qb); } while (0)
#define ATTN_CTX(uu_) do { const int uu = (uu_), bh = uu >> 1, qb = uu & 1, b = bh >> 3, h = bh & 7; \
        ATTN_UNIT(lds, (const bf16_t*)(ws + OFF_QNC) + (size_t)bh * 2 * LC * 64, LC, 128 * qb, (const bf16_t*)(ws + OFF_KN) + (size_t)bh * 2 * LK * 64, \
                  (const bf16_t*)(ws + OFF_VT) + (size_t)bh * 128 * LK, LC, c2, lam, post, inp(I_SUBLN) + l * 128, z + ZC_DG + h * 128, (bf16_t*)(ws + OFF_DIFFO) + h * 128, ML + b * LC + 128 * qb); } while (0)
    if (G == 256) {
        const int B_ = BID;
        if (B_ < 128) {
            gla_unit2(a, l, lds, ((B_ & 7) * 4 + (B_ >> 5)) * 4 + ((B_ >> 3) & 3));
            { const int u = 384 + B_; ATTN_LATENT((u & 7) * 64 + (u >> 3)); }
            if (need_ctx && B_ < 64) ATTN_CTX(B_);
        } else {
            for (int k = 0; k < 3; ++k) { const int u = (B_ - 128) + 128 * k; ATTN_LATENT((u & 7) * 64 + (u >> 3)); }
        }
    } else {
        for (int it = BID; it < 256; it += G) gla_unit(a, l, lds, ((it & 7) * 4 + (it >> 6)) * 8 + ((it >> 3) & 7));
        const int nun = 512 + (need_ctx ? 64 : 0);
        for (int u = BID; u < nun; u += G) { if (u < 512) ATTN_LATENT((u & 7) * 64 + (u >> 3)); else ATTN_CTX(u - 512); }
    }
#ifndef NO_POOL
    {
        const int Mrows = need_ctx ? MT : ML;
        pg8::Gemm g{(const bf16_t*)(ws + OFF_DPOOL), (const bf16_t*)(ws + OFF_POOLT + (size_t)l * SZ_POOLT), Mrows, 1024, 256, 1024, 256, 256};
        pg8::StaticOrder S; S.init(Mrows, 1024, G, BID);
        pg8::EpiPool E{(bf16_t*)(ws + OFF_POOLO), (const bf16_t*)(ws + OFF_PGATE)};
        pg8::gemm_phase<pg8::EpiPool, pg8::StaticOrder, true, true>(lds, g, S, E);
    }
#endif
}

__device__ __forceinline__ void phase_post(const Args& a, int l) {
    const int tid = opaque_tid(), lane = tid & 63, wave = tid >> 6, G = opaque_s(gridDim.x);
    const int gw = BID * 8 + wave, NGW = G * 8;
    unsigned char* ws = opaque_ptr(a.ws);
    const bf16_t* z = (const bf16_t*)(ws + OFF_Z);
    const bf16_t* of = (const bf16_t*)(ws + OFF_OF); const bf16_t* ob = of + (size_t)MT * 1024;
    bf16_t* go = (bf16_t*)(ws + OFF_GLAO);
    const int Mrows = (l == 0) ? MT : ML;
    const float* gn = inp(I_GLAN) + l * 256 + ((16 * lane) & 255);
    for (int row = gw; row < Mrows; row += NGW) {
        float x[16], y[16], gz[16];
        const size_t o = (size_t)row * 1024 + 16 * lane;
        unpack8(*(const u32x4*)(of + o), x); unpack8(*(const u32x4*)(of + o + 8), x + 8);
        unpack8(*(const u32x4*)(ob + o), y); unpack8(*(const u32x4*)(ob + o + 8), y + 8);
        unpack8(*(const u32x4*)(z + (size_t)row * NZ + ZC_GG + 16 * lane), gz); unpack8(*(const u32x4*)(z + (size_t)row * NZ + ZC_GG + 16 * lane + 8), gz + 8);
        float ss = 0.f;
#pragma unroll
        for (int e = 0; e < 16; ++e) { x[e] += y[e]; ss += x[e] * x[e]; }
        ss += __shfl_xor(ss, 1); ss += __shfl_xor(ss, 2); ss += __shfl_xor(ss, 4); ss += __shfl_xor(ss, 8);
        const float rstd = rsqrtf(ss * (1.f / 256.f) + EPS);
        float r[16];
#pragma unroll
        for (int e = 0; e < 16; ++e) r[e] = x[e] * rstd * gn[e] * silu_f(gz[e]);
        u32x4 w0, w1;
        w0.x = cvt_pk_bf16(r[0], r[1]); w0.y = cvt_pk_bf16(r[2], r[3]); w0.z = cvt_pk_bf16(r[4], r[5]); w0.w = cvt_pk_bf16(r[6], r[7]);
        w1.x = cvt_pk_bf16(r[8], r[9]); w1.y = cvt_pk_bf16(r[10], r[11]); w1.z = cvt_pk_bf16(r[12], r[13]); w1.w = cvt_pk_bf16(r[14], r[15]);
        *(u32x4*)(go + o) = w0; *(u32x4*)(go + o + 8) = w1;
    }
}

#define XB_TMO      128
#define XB_XCNT(j)  (256  + 64 * (j))
#define XB_XSUB(j)  (1280 + 64 * (j))
#define XB_XGEN(j)  (2304 + 64 * (j))
#define XB_TOP      3328
#define XB_TOPGEN   3392
#define XCD_BAR_WORDS 3456
#define XB_SPIN_CAP (1u << 18)

__device__ __forceinline__ unsigned xb_ld(unsigned* p)              { return __hip_atomic_load(p, __ATOMIC_RELAXED, __HIP_MEMORY_SCOPE_AGENT); }
__device__ __forceinline__ unsigned xb_add(unsigned* p, unsigned v) { return __hip_atomic_fetch_add(p, v, __ATOMIC_RELAXED, __HIP_MEMORY_SCOPE_AGENT); }
__device__ __forceinline__ unsigned xb_xcc_id() { return (unsigned)__builtin_amdgcn_s_getreg((3 << 11) | 20) & 0xFu; }
#define XB_SPIN(cond, bar) do { unsigned _sp = 0; while (cond) { __builtin_amdgcn_s_sleep(1); \
    if ((++_sp & 255u) == 0u) { if (xb_ld(&(bar)[XB_TMO])) break; if (_sp > XB_SPIN_CAP) { atomicAdd(&(bar)[XB_TMO], 1u); break; } } } } while (0)

struct XcdBarrier {
    unsigned* bar; unsigned x;
    volatile LAS unsigned* st;
};

__device__ __forceinline__ XcdBarrier xcd_barrier_post(unsigned* bar, volatile LAS unsigned* st) {
    XcdBarrier b; b.bar = bar; b.x = xb_xcc_id(); b.st = st;
    if (threadIdx.x == 0) (void)xb_add(&bar[XB_XCNT(b.x)], 1u);
    return b;
}
__device__ __forceinline__ void xcd_barrier_complete(unsigned* bar, unsigned x, unsigned& nloc, unsigned& nx) {
    const unsigned G = gridDim.x * gridDim.y * gridDim.z;
    unsigned sum, cnt, mine, sp = 0u;
    for (;;) {
        sum = 0u; cnt = 0u; mine = 0u;
#pragma unroll
        for (unsigned j = 0; j < 16; ++j) { const unsigned c = xb_ld(&bar[XB_XCNT(j)]); sum += c; cnt += (c > 0u) ? 1u : 0u; mine = (j == x) ? c : mine; }
        if (sum == G) break;
        __builtin_amdgcn_s_sleep(1);
        if ((++sp & 255u) == 0u) { if (xb_ld(&bar[XB_TMO])) break; if (sp > XB_SPIN_CAP) { atomicAdd(&bar[XB_TMO], 1u); break; } }
    }
    nloc = mine > 0u ? mine : 1u; nx = cnt > 0u ? cnt : 1u;
}

__device__ __forceinline__ void xcd_barrier(const XcdBarrier& b) {
    asm volatile("s_waitcnt vmcnt(0)" ::: "memory");
    __syncthreads();
    if (threadIdx.x == 0) {
        unsigned* bar = b.bar;
        __builtin_amdgcn_s_waitcnt(0);
        unsigned nloc = b.st[0], nx = b.st[1];
        if (nloc == 0u) { xcd_barrier_complete(bar, b.x, nloc, nx); b.st[0] = nloc; b.st[1] = nx; }
        const unsigned old = xb_add(&bar[XB_XSUB(b.x)], 1u);
        const unsigned gen = old / nloc;
        if (old + 1u == (gen + 1u) * nloc) {
            __builtin_amdgcn_fence(__ATOMIC_RELEASE, "agent");
            asm volatile("s_waitcnt vmcnt(0)" ::: "memory");
            const unsigned og = xb_add(&bar[XB_TOP], 1u);
            const unsigned tg = og / nx;
            if (og + 1u == (tg + 1u) * nx) xb_add(&bar[XB_TOPGEN], 1u);
            else XB_SPIN(xb_ld(&bar[XB_TOPGEN]) == tg, bar);
            __builtin_amdgcn_fence(__ATOMIC_ACQUIRE, "agent");
            xb_add(&bar[XB_XGEN(b.x)], 1u);
            asm volatile("s_waitcnt vmcnt(0)" ::: "memory");
        } else {
            XB_SPIN(xb_ld(&bar[XB_XGEN(b.x)]) == gen, bar);
            __builtin_amdgcn_fence(__ATOMIC_ACQUIRE, "agent");
            asm volatile("s_waitcnt vmcnt(0)" ::: "memory");
        }
    }
    __syncthreads();
}

#ifndef REPEAT_K
#define REPEAT_K -1
#endif
#define SEAM() do { XcdBarrier xb; xb.bar = (unsigned*)(opaque_ptr(a.ws) + OFF_BAR); xb.x = xb_xcc_id(); xb.st = (volatile LAS unsigned*)(lds + 131072 + 512); xcd_barrier(xb); } while (0)
#define REP(k) for (int rep_ = 0; rep_ < (REPEAT_K == (k) ? 2 : 1); ++rep_)
template <int l> __device__ __forceinline__ void run_layer(const Args& a, LAS unsigned char* lds) {
    constexpr int Mout = (l == 0) ? MT : ML;
    REP(0) phase_norm(a, l);
    SEAM();
    REP(1) {
        unsigned char* ws = opaque_ptr(a.ws); const int G = opaque_s(gridDim.x);
        pg8::Gemm g{(const bf16_t*)(ws + OFF_H), (const bf16_t*)(ws + OFF_WIN + (size_t)l * SZ_WIN), MT, NZ, DM, DM, DM, 0};
        pg8::EpiBf16 E{(bf16_t*)(ws + OFF_Z), NZ};
        if (l == 0) { pg8::StaticOrder S; S.init(MT, NZ, G, BID); pg8::gemm_phase<pg8::EpiBf16, pg8::StaticOrder, true, true>(lds, g, S, E);
 }
        else { pg8::CtxSkipOrder S; S.init(G, BID); pg8::gemm_phase<pg8::EpiBf16, pg8::CtxSkipOrder, true, true>(lds, g, S, E); }
    }
    SEAM();
    REP(2) phase_prep(a, l, lds);
    SEAM();
    REP(3) phase_mix(a, l, lds);
    SEAM();
    REP(4) phase_post(a, l);
    SEAM();
    REP(5) {
        unsigned char* ws = opaque_ptr(a.ws); const int G = opaque_s(gridDim.x);
        pg8::SegOrder3 S; S.base.init(Mout, DM, G, BID);
        const bf16_t* wb = (const bf16_t*)(ws + OFF_WB + (size_t)l * SZ_WB);
        pg8::Gemm g{(const bf16_t*)(ws + OFF_POOLO), wb, Mout, DM, 1024, 1024, 1024, 0,
                    (const bf16_t*)(ws + OFF_DIFFO), (const bf16_t*)(ws + OFF_GLAO), wb + (size_t)DM * 1024, wb + (size_t)2 * DM * 1024};
        pg8::EpiMerge3 E{(bf16_t*)(ws + OFF_H), (const bf16_t*)(ws + OFF_Z) + ZC_MG};
        pg8::gemm_phase<pg8::EpiMerge3, pg8::SegOrder3, true, true, 3>(lds, g, S, E);
        if (l == 0 && rep_ == 0) {
            const int rem = ((Mout / 256) * (DM / 256)) % G, bid = BID;
            if (rem == 0) { ada_items(a, lds, 1, bid, G); convert_layer_weights(a, lds, 1, bid * 8 + (int)(threadIdx.x >> 6), G * 8); }
            else if (bid >= rem) { ada_items(a, lds, 1, G - 1 - bid, G - rem); convert_layer_weights(a, lds, 1, (bid - rem) * 8 + (int)(threadIdx.x >> 6), (G - rem) * 8); }
        }
    }
    SEAM();
    REP(6) {
        unsigned char* ws = opaque_ptr(a.ws); const int G = opaque_s(gridDim.x);
        pg8::Gemm g{(const bf16_t*)(ws + OFF_H), (const bf16_t*)(ws + OFF_WOUT + (size_t)l * SZ_WOUT), Mout, DM, DM, DM, DM, 0};
        pg8::StaticOrder S; S.init(Mout, DM, G, BID);
        pg8::EpiOut E{l == 0 ? inp(I_X) : (const float*)(ws + OFF_X1), l == 0 ? inp(I_CTX) : (const float*)(ws + OFF_X1) + (size_t)ML * DM,
                      l == 0 ? (float*)(ws + OFF_X1) : arg_out(), (const float*)(ws + OFF_MOD) + (size_t)l * 5 * 6144};
        pg8::gemm_phase<pg8::EpiOut, pg8::StaticOrder, true, true>(lds, g, S, E);
    }
}

__global__ void __launch_bounds__(512, 2) hybrid_fwd(Args a) {
    extern __shared__ __attribute__((aligned(16))) unsigned char smem[];
    LAS unsigned char* lds = (LAS unsigned char*)smem;
    cg::grid_group grid = cg::this_grid();
    volatile LAS unsigned* bst = (volatile LAS unsigned*)(lds + 131072 + 512);
    if (threadIdx.x < 2) bst[threadIdx.x] = 0u;
    __syncthreads();
    (void)xcd_barrier_post((unsigned*)(a.ws + OFF_BAR), bst);
    REP(7) phase_p0(a, lds);
    grid.sync();
    run_layer<0>(a, lds);
    SEAM();
    run_layer<1>(a, lds);
}

extern "C" void kernel_launch(void* const* d_in, const int* in_sizes, int n_in, void* d_out, int out_size, void* d_ws, size_t ws_size, hipStream_t stream) {
    static int grid = 0;
    if (grid == 0) {
        if (n_in != 26 || out_size != ML * DM || ws_size < WS_END) { fprintf(stderr, "kernel_launch: expected 26 inputs, out %d, ws >= %zu; got n_in %d out %d ws %zu\n", ML * DM, (size_t)WS_END, n_in, out_size, ws_size); grid = -1; return; }
        int dev = 0, cus = 0, per_cu = 0;
        if (hipGetDevice(&dev) != hipSuccess || hipDeviceGetAttribute(&cus, hipDeviceAttributeMultiprocessorCount, dev) != hipSuccess) { grid = -1; return; }
        if (hipFuncSetAttribute((const void*)hybrid_fwd, hipFuncAttributeMaxDynamicSharedMemorySize, LDS_BYTES) != hipSuccess) { fprintf(stderr, "kernel_launch: hipFuncSetAttribute failed\n"); grid = -1; return; }
        if (hipOccupancyMaxActiveBlocksPerMultiprocessor(&per_cu, (const void*)hybrid_fwd, 512, LDS_BYTES) != hipSuccess || per_cu < 1) { fprintf(stderr, "kernel_launch: occupancy query says %d blocks per CU\n", per_cu); (void)hipGetLastError(); grid = -1; return; }
        grid = cus;
    }
    if (grid < 0) return;
    if (hipMemsetAsync((char*)d_ws + OFF_BAR, 0, BAR_BYTES, stream) != hipSuccess) { fprintf(stderr, "kernel_launch: memset of the barrier words failed\n"); return; }
    Args a{};
    for (int i = 0; i < 26; ++i) a.in[i] = (const float*)d_in[i];
    a.out = (float*)d_out; a.ws = (unsigned char*)d_ws;
    a.ph_lo = 0; a.ph_hi = NPH;
    void* args[] = {&a};
    const hipError_t e = hipLaunchCooperativeKernel((const void*)hybrid_fwd, dim3(grid), dim3(512), args, LDS_BYTES, stream);
    if (e != hipSuccess) fprintf(stderr, "kernel_launch: cooperative launch failed: %s (grid %d)\n", hipGetErrorString(e), grid);
}
```

```cpp
#include <hip/hip_runtime.h>
#include <hip/hip_cooperative_groups.h>
#include <cstdio>
#include <cstdint>
namespace cg = cooperative_groups;

#ifndef MK_N_LAUNCHES
#define MK_N_LAUNCHES 1
#endif

#define LAS __attribute__((address_space(3)))
typedef unsigned short bf16_t;
typedef short bf16x8 __attribute__((ext_vector_type(8)));
typedef float f32x4 __attribute__((ext_vector_type(4)));
typedef float f32x16 __attribute__((ext_vector_type(16)));
typedef unsigned u32x4 __attribute__((ext_vector_type(4)));
typedef unsigned u32x2 __attribute__((ext_vector_type(2)));

constexpr int DM = 2048, NB = 4, SEQ = 2048, LC = 256, ML = NB * SEQ, MC = NB * LC, MT = ML + MC;
constexpr int DIN = 15392, NZ = 15616;
constexpr int ZC_PU = 0, ZC_PG = 1024, ZC_DQ = 2048, ZC_DK = 3072, ZC_DV = 4096, ZC_DG = 5120, ZC_GQ = 6144, ZC_GK = 6656, ZC_GV = 7168, ZC_GG = 8192, ZC_LR = 9216, ZC_MG = 9472;
constexpr int LK = LC + SEQ;
constexpr float EPS = 1e-6f, LOG2E = 1.4426950408889634f;
constexpr int NPH = 15;

constexpr size_t SZ_WIN = (size_t)NZ * DM * 2, SZ_WB = (size_t)3 * DM * 1024 * 2, SZ_WOUT = (size_t)DM * DM * 2, SZ_POOLT = (size_t)4 * 256 * 256 * 2;
constexpr size_t OFF_WIN = 0;
constexpr size_t OFF_WB = OFF_WIN + 2 * SZ_WIN;
constexpr size_t OFF_WOUT = OFF_WB + 2 * SZ_WB;
constexpr size_t OFF_POOLT = OFF_WOUT + 2 * SZ_WOUT;
constexpr size_t OFF_MOD = OFF_POOLT + 2 * SZ_POOLT;
constexpr size_t OFF_SCAL = OFF_MOD + (size_t)2 * 5 * 6144 * 4;
constexpr size_t OFF_H = OFF_SCAL + 256;
constexpr size_t OFF_Z = OFF_H + (size_t)MT * DM * 2;
constexpr size_t OFF_QN = OFF_Z + (size_t)MT * NZ * 2;
constexpr size_t OFF_QNC = OFF_QN + (size_t)ML * 1024 * 2;
constexpr size_t OFF_KN = OFF_QNC + (size_t)MC * 1024 * 2;
constexpr size_t OFF_VT = OFF_KN + (size_t)MT * 1024 * 2;
constexpr size_t SZ_G = (size_t)MT * 512 * 2;
constexpr size_t OFF_GQ = OFF_VT + (size_t)MT * 1024 * 2;
constexpr size_t OFF_GK = OFF_GQ + 2 * SZ_G;
constexpr size_t OFF_GH = OFF_GK + 2 * SZ_G;
constexpr size_t OFF_DEC = OFF_GH + 2 * SZ_G;
constexpr size_t OFF_OF = OFF_DEC + (size_t)2 * 144 * 512 * 4;
constexpr size_t OFF_DPOOL = OFF_OF + 2 * (size_t)MT * 1024 * 2;
constexpr size_t OFF_POOLO = OFF_DPOOL + (size_t)MT * 1024 * 2;
constexpr size_t OFF_DIFFO = OFF_POOLO + (size_t)MT * 1024 * 2;
constexpr size_t OFF_GLAO = OFF_DIFFO + (size_t)MT * 1024 * 2;
constexpr size_t OFF_YACC = OFF_GLAO + (size_t)MT * 1024 * 2;
constexpr size_t OFF_X1 = OFF_YACC + (size_t)MT * DM * 4;
constexpr size_t OFF_PGATE = OFF_X1 + (size_t)MT * DM * 4;
constexpr size_t OFF_BAR = OFF_PGATE + (size_t)MT * 1024 * 2;
constexpr size_t BAR_BYTES = 16384;
constexpr size_t OFF_GVT = OFF_BAR + BAR_BYTES;
constexpr size_t WS_END = OFF_GVT + (size_t)MT * 1024 * 2;

constexpr int LDS_BYTES = 135168;

#define BID opaque_s((int)blockIdx.x)
#define GAS __attribute__((address_space(1)))
__device__ __forceinline__ unsigned char* opaque_ptr(unsigned char* p) { GAS unsigned char* q = (GAS unsigned char*)p; asm volatile("" : "+s"(q)); return (unsigned char*)q; }
__device__ __forceinline__ int opaque_s(int v) { asm volatile("" : "+s"(v)); return v; }
__device__ __forceinline__ int opaque_tid() { int t = threadIdx.x; asm volatile("" : "+v"(t)); return t; }
typedef float f32x2_t __attribute__((ext_vector_type(2))); typedef __bf16 bf16x2_t __attribute__((ext_vector_type(2)));
__device__ __forceinline__ unsigned cvt_pk_bf16(float lo, float hi) { f32x2_t v = {lo, hi}; bf16x2_t b = __builtin_convertvector(v, bf16x2_t); return __builtin_bit_cast(unsigned, b); }
__device__ __forceinline__ bf16_t f2bf(float f) { return (bf16_t)(cvt_pk_bf16(f, 0.f) & 0xffffu); }
__device__ __forceinline__ float bf2f(bf16_t v) { return __builtin_bit_cast(float, (unsigned)v << 16); }
__device__ __forceinline__ float bflo(unsigned u) { return __builtin_bit_cast(float, u << 16); }
__device__ __forceinline__ float bfhi(unsigned u) { return __builtin_bit_cast(float, u & 0xffff0000u); }
__device__ __forceinline__ float silu_f(float x) { return x * __builtin_amdgcn_rcpf(1.f + __expf(-x)); }
__device__ __forceinline__ float sigmoid_f(float x) { return __builtin_amdgcn_rcpf(1.f + __expf(-x)); }
__device__ __forceinline__ float logsig_f(float a) { return fminf(a, 0.f) - __logf(1.f + __expf(-fabsf(a))); }
__device__ __forceinline__ float wave_sum(float v) {
#pragma unroll
    for (int o = 1; o < 64; o <<= 1) v += __shfl_xor(v, o);
    return v;
}
__device__ __forceinline__ float wave_max(float v) {
#pragma unroll
    for (int o = 1; o < 64; o <<= 1) v = fmaxf(v, __shfl_xor(v, o));
    return v;
}
__device__ __forceinline__ void unpack8(u32x4 w, float* f) { f[0] = bflo(w.x); f[1] = bfhi(w.x); f[2] = bflo(w.y); f[3] = bfhi(w.y); f[4] = bflo(w.z); f[5] = bfhi(w.z); f[6] = bflo(w.w); f[7] = bfhi(w.w); }

namespace pg8 {
constexpr int BM = 256, BK = 64, HALF = 128, HTB = HALF * BK * 2, STAGE_BYTES = 8 * HTB, NXCD = 8, WGM = 8;
__host__ __device__ __forceinline__ int lds_byte(int r, int c) { const int st = (r >> 4) * 2 + (c >> 5), rr = r & 15, cc = c & 31, ob = rr * 64 + cc * 2; return st * 1024 + (ob ^ (((ob >> 9) & 1) << 5)); }
__host__ __device__ __forceinline__ void stage_rc(int b, int& R, int& C) { const int st = b / 1024, sb = b % 1024, swz = sb ^ (((sb >> 9) & 1) << 5); R = (st >> 1) * 16 + swz / 64; C = (st & 1) * 32 + (swz % 64) / 2; }
__host__ __device__ __forceinline__ int perm32(int rho) { const int n = rho >> 4, i = rho & 15; return 8 * (i >> 2) + 4 * n + (i & 3); }

struct Unit { int pm, pn, seg; };
struct Gemm { const bf16_t* A; const bf16_t* Bt; int M, N, K; int lda, ldb; int a_pn_off; const bf16_t* A1; const bf16_t* A2; const bf16_t* B1; const bf16_t* B2; };

struct StaticOrder {
    int nM, nN, nwg, G, c;
    __host__ __device__ void init(int M, int N, int G_, int c_) { nM = M / BM; nN = N / BM; nwg = nM * nN; G = G_; c = c_; }
    __host__ __device__ bool next(int i, Unit& u) const {
        const long L = (long)i * G + c; if (L >= nwg) return false;
        int wgid = (int)L; { const int q = nwg / NXCD, r = nwg % NXCD, xcd = wgid % NXCD, off = wgid / NXCD; wgid = (xcd < r ? xcd * (q + 1) : r * (q + 1) + (xcd - r) * q) + off; }
        const int nig = WGM * nN, gid = wgid / nig, fm = gid * WGM, gsz = (nM - fm) < WGM ? (nM - fm) : WGM;
        u.pm = fm + ((wgid % nig) % gsz); u.pn = (wgid % nig) / gsz; u.seg = 0; return true;
    }
    __device__ __forceinline__ void a_ready(const Unit&) const {}
    __device__ __forceinline__ void done(const Unit&) const {}
};

struct CtxSkipOrder {
    StaticOrder base; int nbase;
    __host__ __device__ void init(int G_, int c_) { base.init(ML, NZ, G_, c_); nbase = base.nwg; }
    __host__ __device__ bool next(int i, Unit& u) const {
        const long L = (long)i * base.G + base.c;
        if (L < nbase) return base.next(i, u);
        const int e = (int)(L - nbase); if (e >= 4 * 15) return false;
        const int j = e % 15; u.pm = 32 + e / 15; u.pn = j < 8 ? 12 + j : (j < 14 ? 18 + j : 36); u.seg = 0; return true;
    }
    __device__ __forceinline__ void a_ready(const Unit&) const {}
    __device__ __forceinline__ void done(const Unit&) const {}
};
struct SegOrder3 {
    StaticOrder base;
    __host__ __device__ bool next(int i, Unit& u) const { const int q = i / 3; if (!base.next(q, u)) return false; u.seg = i - 3 * q; return true; }
    __device__ __forceinline__ void a_ready(const Unit&) const {}
    __device__ __forceinline__ void done(const Unit&) const {}
};
struct EpiBf16 {
    static constexpr bool PERM = true, AFTER_DRAIN = false;
    bf16_t* O; int ldc;
    __device__ __forceinline__ void operator()(const f32x4 (&acc)[2][2][4][2], const Unit& u, int wr, int wc, int fr, int fq) const {
        const int row0 = u.pm * BM + wr * 64 + fr, col0 = u.pn * BM + wc * 32 + 8 * fq;
#pragma unroll
        for (int ai = 0; ai < 2; ++ai)
#pragma unroll
            for (int m = 0; m < 4; ++m) { bf16_t* rowp = O + (size_t)(row0 + ai * HALF + m * 16) * ldc + col0;
#pragma unroll
                for (int bj = 0; bj < 2; ++bj) { const f32x4 v0 = acc[ai][bj][m][0], v1 = acc[ai][bj][m][1];
                    u32x4 w; w.x = cvt_pk_bf16(v0[0], v0[1]); w.y = cvt_pk_bf16(v0[2], v0[3]); w.z = cvt_pk_bf16(v1[0], v1[1]); w.w = cvt_pk_bf16(v1[2], v1[3]);
                    *(u32x4*)(rowp + bj * HALF) = w; } }
    }
};

template <class Epi, class Sched, bool ALIGN_EPI = false, bool SP2 = false, int NSEG = 1>
__device__ __forceinline__ void gemm_phase(LAS unsigned char* lds, const Gemm g, const Sched& S, const Epi& E) {
    const int tid = opaque_tid(), wid = __builtin_amdgcn_readfirstlane(tid >> 6), lane = tid & 63, wr = wid >> 2, wc = wid & 3, fr = lane & 15, fq = lane >> 4;
    const int K = opaque_s(g.K), nt = K / BK;
    unsigned voffA[2], voffB[2];
#pragma unroll
    for (int i = 0; i < 2; ++i) { int R, C; stage_rc(tid * 16 + i * 8192, R, C); const int Rb = Epi::PERM ? ((R & ~31) + perm32(R & 31)) : R;
        voffA[i] = (unsigned)(R * g.lda + C) * 2u; voffB[i] = (unsigned)(Rb * g.ldb + C) * 2u; }
    const size_t kstep = (size_t)(BK * 2);
    const size_t hstepA = (size_t)HALF * g.lda * 2, hstepB = (size_t)HALF * g.ldb * 2;
    const size_t tstepA = 2 * hstepA, tstepB = 2 * hstepB;
    const size_t pnA = (size_t)g.a_pn_off * 2;
    const unsigned ldsw = (unsigned)wid * 1024u;
    const int aoff = lds_byte(wr * 64 + fr, fq * 8), boff = lds_byte(wc * 32 + fr, fq * 8);
#define PG8_SA(b, h) (((b) * 2 + (h)) * HTB)
#define PG8_SB(b, h) ((4 + (b) * 2 + (h)) * HTB)
#define PG8_STAGE(bufoff, gbase, voff) do { _Pragma("unroll") for (int _i = 0; _i < 2; ++_i) \
        __builtin_amdgcn_global_load_lds((const unsigned*)((const char*)(gbase) + (voff)[_i]), (LAS unsigned*)(lds + (bufoff) + ldsw + _i * 8192), 16, 0, 0); } while (0)
#define PG8_LDA(dst, b, h) do { _Pragma("unroll") for (int m = 0; m < 4; ++m) _Pragma("unroll") for (int k = 0; k < 2; ++k) dst[m][k] = *(const LAS bf16x8*)(lds + PG8_SA(b, h) + aoff + m * 2048 + k * 1024); } while (0)
#define PG8_LDB(dst, b, h) do { _Pragma("unroll") for (int n = 0; n < 2; ++n) _Pragma("unroll") for (int k = 0; k < 2; ++k) dst[n][k] = *(const LAS bf16x8*)(lds + PG8_SB(b, h) + boff + n * 2048 + k * 1024); } while (0)
#define PG8_MMA(ai, bj, At, Bt) do { __builtin_amdgcn_s_setprio(1); _Pragma("unroll") for (int m = 0; m < 4; ++m) _Pragma("unroll") for (int n = 0; n < 2; ++n) _Pragma("unroll") for (int k = 0; k < 2; ++k) \
        acc[ai][bj][m][n] = __builtin_amdgcn_mfma_f32_16x16x32_bf16(Bt[n][k], At[m][k], acc[ai][bj][m][n], 0, 0, 0); __builtin_amdgcn_s_setprio(0); } while (0)
#define PG8_WAIT_V(n) asm volatile("s_waitcnt vmcnt(" #n ")" ::: "memory")
#define PG8_WAIT_L(n) asm volatile("s_waitcnt lgkmcnt(" #n ")" ::: "memory")
#define PG8_BAR __builtin_amdgcn_s_barrier()
#define PG8_SCHED __builtin_amdgcn_sched_barrier(0)
    Unit cur, nxt; int ui = 0;
    if (!S.next(0, cur)) return;
    f32x4 acc[2][2][4][2];
#pragma unroll
    for (int a = 0; a < 2; ++a)
#pragma unroll
        for (int b = 0; b < 2; ++b)
#pragma unroll
            for (int m = 0; m < 4; ++m)
#pragma unroll
                for (int n = 0; n < 2; ++n) acc[a][b][m][n] = (f32x4){0.f, 0.f, 0.f, 0.f};
    bf16x8 At[4][2], B0[2][2], B1[2][2];
#define PG8_ASEG(u) ((const char*)(NSEG == 1 || (u).seg == 0 ? g.A : ((u).seg == 1 ? g.A1 : g.A2)))
#define PG8_BSEG(u) ((const char*)(NSEG == 1 || (u).seg == 0 ? g.Bt : ((u).seg == 1 ? g.B1 : g.B2)))
    const char* cA = PG8_ASEG(cur) + (size_t)cur.pm * tstepA + (size_t)cur.pn * pnA; const char* cB = PG8_BSEG(cur) + (size_t)cur.pn * tstepB;
    S.a_ready(cur);
    if constexpr (SP2) {
        PG8_STAGE(PG8_SB(0, 0), cB, voffB); PG8_STAGE(PG8_SB(0, 1), cB + hstepB, voffB); PG8_STAGE(PG8_SA(0, 0), cA, voffA); PG8_STAGE(PG8_SA(0, 1), cA + hstepA, voffA);
        if (wr == 1) PG8_BAR;
        PG8_WAIT_V(2); PG8_BAR;
        PG8_STAGE(PG8_SB(1, 0), cB + kstep, voffB); PG8_STAGE(PG8_SA(1, 0), cA + kstep, voffA); PG8_STAGE(PG8_SB(1, 1), cB + hstepB + kstep, voffB);
        PG8_WAIT_V(6); PG8_BAR;
    } else {
        PG8_STAGE(PG8_SB(0, 0), cB, voffB); PG8_STAGE(PG8_SA(0, 0), cA, voffA); PG8_STAGE(PG8_SB(0, 1), cB + hstepB, voffB); PG8_STAGE(PG8_SA(0, 1), cA + hstepA, voffA);
        if (wr == 1) PG8_BAR;
        PG8_WAIT_V(4); PG8_BAR;
        PG8_STAGE(PG8_SB(1, 0), cB + kstep, voffB); PG8_STAGE(PG8_SA(1, 0), cA + kstep, voffA); PG8_STAGE(PG8_SB(1, 1), cB + hstepB + kstep, voffB);
        PG8_WAIT_V(6); PG8_BAR;
    }
    for (;;) {
        const bool has_next = S.next(ui + 1, nxt);
        const char* nA = has_next ? PG8_ASEG(nxt) + (size_t)nxt.pm * tstepA + (size_t)nxt.pn * pnA : cA; const char* nB = has_next ? PG8_BSEG(nxt) + (size_t)nxt.pn * tstepB : cB;
        for (int t = 0; t < nt; t += 2) {
            const bool last = (t == nt - 2);
            const char* a1 = cA + (size_t)(t + 1) * kstep;
            const char* a2 = last ? nA : cA + (size_t)(t + 2) * kstep; const char* b2 = last ? nB : cB + (size_t)(t + 2) * kstep;
            const char* a3 = a2 + kstep; const char* b3 = b2 + kstep;
            if (last && has_next) S.a_ready(nxt);
            if constexpr (SP2) {
            PG8_LDB(B0, 0, 0); PG8_LDB(B1, 0, 1); PG8_SCHED; PG8_LDA(At, 0, 0); PG8_STAGE(PG8_SA(1, 1), a1 + hstepA, voffA);
            PG8_WAIT_V(8); PG8_WAIT_L(0); PG8_BAR; PG8_MMA(0, 0, At, B0); PG8_MMA(0, 1, At, B1); PG8_BAR; PG8_SCHED;
            PG8_LDA(At, 0, 1); PG8_STAGE(PG8_SB(0, 0), b2, voffB); PG8_STAGE(PG8_SB(0, 1), b2 + hstepB, voffB); PG8_STAGE(PG8_SA(0, 0), a2, voffA);
            PG8_WAIT_V(8); PG8_WAIT_L(0); PG8_BAR; PG8_MMA(1, 0, At, B0); PG8_MMA(1, 1, At, B1); PG8_BAR; PG8_SCHED;
            PG8_LDB(B0, 1, 0); PG8_LDB(B1, 1, 1); PG8_SCHED; PG8_LDA(At, 1, 0); PG8_STAGE(PG8_SA(0, 1), a2 + hstepA, voffA);
            PG8_WAIT_V(8); PG8_WAIT_L(0); PG8_BAR; PG8_MMA(0, 0, At, B0); PG8_MMA(0, 1, At, B1); PG8_BAR; PG8_SCHED;
            PG8_LDA(At, 1, 1); PG8_STAGE(PG8_SB(1, 0), b3, voffB); PG8_STAGE(PG8_SB(1, 1), b3 + hstepB, voffB); PG8_STAGE(PG8_SA(1, 0), a3, voffA);
            PG8_WAIT_V(8); PG8_WAIT_L(0); PG8_BAR; PG8_MMA(1, 0, At, B0); PG8_MMA(1, 1, At, B1); PG8_BAR; PG8_SCHED;
            } else {
            PG8_LDB(B0, 0, 0); PG8_SCHED; PG8_LDA(At, 0, 0); PG8_STAGE(PG8_SA(1, 1), a1 + hstepA, voffA);
            PG8_WAIT_L(8); PG8_BAR; PG8_WAIT_L(0); PG8_MMA(0, 0, At, B0); PG8_BAR; PG8_SCHED;
            PG8_LDB(B1, 0, 1); PG8_STAGE(PG8_SB(0, 0), b2, voffB);
            PG8_BAR; PG8_WAIT_L(0); PG8_MMA(0, 1, At, B1); PG8_BAR;
            PG8_LDA(At, 0, 1); PG8_STAGE(PG8_SA(0, 0), a2, voffA);
            PG8_BAR; PG8_WAIT_L(0); PG8_MMA(1, 0, At, B0); PG8_BAR; PG8_SCHED;
            PG8_STAGE(PG8_SB(0, 1), b2 + hstepB, voffB);
            PG8_WAIT_V(6); PG8_BAR; PG8_MMA(1, 1, At, B1); PG8_BAR;
            PG8_LDB(B0, 1, 0); PG8_SCHED; PG8_LDA(At, 1, 0); PG8_STAGE(PG8_SA(0, 1), a2 + hstepA, voffA);
            PG8_WAIT_L(8); PG8_BAR; PG8_WAIT_L(0); PG8_MMA(0, 0, At, B0); PG8_BAR; PG8_SCHED;
            PG8_LDB(B1, 1, 1); PG8_STAGE(PG8_SB(1, 0), b3, voffB);
            PG8_BAR; PG8_WAIT_L(0); PG8_MMA(0, 1, At, B1); PG8_BAR;
            PG8_LDA(At, 1, 1); PG8_STAGE(PG8_SA(1, 0), a3, voffA);
            PG8_BAR; PG8_WAIT_L(0); PG8_MMA(1, 0, At, B0); PG8_BAR; PG8_SCHED;
            PG8_STAGE(PG8_SB(1, 1), b3 + hstepB, voffB);
            PG8_WAIT_V(6); PG8_BAR; PG8_MMA(1, 1, At, B1); PG8_BAR;
            }
        }
        if constexpr (ALIGN_EPI) { if (wr == 0) PG8_BAR; }
        E(acc, cur, wr, wc, fr, fq); S.done(cur);
        if (!has_next) break;
        if (NSEG == 1 || cur.seg == NSEG - 1)
#pragma unroll
        for (int a = 0; a < 2; ++a)
#pragma unroll
            for (int b = 0; b < 2; ++b)
#pragma unroll
                for (int m = 0; m < 4; ++m)
#pragma unroll
                    for (int n = 0; n < 2; ++n) acc[a][b][m][n] = (f32x4){0.f, 0.f, 0.f, 0.f};
        cur = nxt; cA = nA; cB = nB; ++ui;
        if constexpr (ALIGN_EPI) { if (wr == 1) PG8_BAR; }
    }
    PG8_WAIT_V(0);
    if constexpr (!ALIGN_EPI) { if (wr == 0) PG8_BAR; }
    PG8_BAR;
#undef PG8_ASEG
#undef PG8_BSEG
#undef PG8_SA
#undef PG8_SB
#undef PG8_STAGE
#undef PG8_LDA
#undef PG8_LDB
#undef PG8_MMA
#undef PG8_WAIT_V
#undef PG8_WAIT_L
#undef PG8_BAR
#undef PG8_SCHED
}

struct EpiPool {
    static constexpr bool PERM = true, AFTER_DRAIN = false;
    bf16_t* O; const bf16_t* pgate;
    __device__ __forceinline__ void operator()(const f32x4 (&acc)[2][2][4][2], const Unit& u, int wr, int wc, int fr, int fq) const {
        const int row0 = u.pm * BM + wr * 64 + fr, col0 = u.pn * BM + wc * 32 + 8 * fq;
#pragma unroll
        for (int ai = 0; ai < 2; ++ai) {
            u32x4 gz4[4][2];
#pragma unroll
            for (int m = 0; m < 4; ++m)
#pragma unroll
                for (int bj = 0; bj < 2; ++bj) gz4[m][bj] = *(const u32x4*)(pgate + (size_t)(row0 + ai * HALF + m * 16) * 1024 + col0 + bj * HALF);
            __builtin_amdgcn_sched_barrier(0);
#pragma unroll
            for (int m = 0; m < 4; ++m)
#pragma unroll
                for (int bj = 0; bj < 2; ++bj) {
                    const int row = row0 + ai * HALF + m * 16, col = col0 + bj * HALF;
                    const u32x4 gz = gz4[m][bj];
                    const f32x4 v0 = acc[ai][bj][m][0], v1 = acc[ai][bj][m][1];
                    u32x4 w;
                    w.x = cvt_pk_bf16(v0[0] * bflo(gz.x), v0[1] * bfhi(gz.x));
                    w.y = cvt_pk_bf16(v0[2] * bflo(gz.y), v0[3] * bfhi(gz.y));
                    w.z = cvt_pk_bf16(v1[0] * bflo(gz.z), v1[1] * bfhi(gz.z));
                    w.w = cvt_pk_bf16(v1[2] * bflo(gz.w), v1[3] * bfhi(gz.w));
                    *(u32x4*)(O + (size_t)row * 1024 + col) = w;
                }
            __builtin_amdgcn_sched_barrier(0);
        }
    }
};
template <int PASS> struct EpiMerge {
    static constexpr bool PERM = true, AFTER_DRAIN = false;
    float* yacc; bf16_t* y; const bf16_t* zg;
    __device__ __forceinline__ void operator()(const f32x4 (&acc)[2][2][4][2], const Unit& u, int wr, int wc, int fr, int fq) const {
        const int row0 = u.pm * BM + wr * 64 + fr, col0 = u.pn * BM + wc * 32 + 8 * fq;
#pragma unroll
        for (int ai = 0; ai < 2; ++ai)
#pragma unroll
            for (int m = 0; m < 4; ++m)
#pragma unroll
                for (int bj = 0; bj < 2; ++bj) {
                    const int row = row0 + ai * HALF + m * 16, col = col0 + bj * HALF;
                    float gz[8]; unpack8(*(const u32x4*)(zg + (size_t)row * NZ + col), gz);
                    const f32x4 v0 = acc[ai][bj][m][0], v1 = acc[ai][bj][m][1];
                    f32x4 r0, r1;
#pragma unroll
                    for (int e = 0; e < 4; ++e) { r0[e] = v0[e] * sigmoid_f(gz[e]); r1[e] = v1[e] * sigmoid_f(gz[4 + e]); }
                    float* yp = yacc + (size_t)row * DM + col;
                    if (PASS >= 1) { r0 += *(const f32x4*)yp; r1 += *(const f32x4*)(yp + 4); }
                    if (PASS <= 1) { *(f32x4*)yp = r0; *(f32x4*)(yp + 4) = r1; }
                    else { u32x4 w; w.x = cvt_pk_bf16(r0[0], r0[1]); w.y = cvt_pk_bf16(r0[2], r0[3]); w.z = cvt_pk_bf16(r1[0], r1[1]); w.w = cvt_pk_bf16(r1[2], r1[3]);
                        *(u32x4*)(y + (size_t)row * DM + col) = w; }
                    __builtin_amdgcn_sched_barrier(0);
                }
    }
};
struct EpiMerge3 {
    static constexpr bool PERM = true, AFTER_DRAIN = false;
    bf16_t* y; const bf16_t* zg;
    __device__ __forceinline__ void operator()(f32x4 (&acc)[2][2][4][2], const Unit& u, int wr, int wc, int fr, int fq) const {
        const int row0 = u.pm * BM + wr * 64 + fr, col0 = u.pn * BM + wc * 32 + 8 * fq;
        u32x4 ga4[2][4], gb4[2][4];
#pragma unroll
        for (int b = 0; b < 5; ++b) {
            if (b < 4) {
#pragma unroll
                for (int p = 0; p < 4; ++p) { const int ai = b >> 1, m = 2 * (b & 1) + (p >> 1), bj = p & 1;
                    const bf16_t* zp = zg + (size_t)(row0 + ai * HALF + m * 16) * NZ + col0 + bj * HALF + u.seg * 2048;
                    ga4[b & 1][p] = *(const u32x4*)zp; gb4[b & 1][p] = (u.seg < 2) ? *(const u32x4*)(zp + 2048) : (u32x4){0u, 0u, 0u, 0u}; }
            }
            __builtin_amdgcn_sched_barrier(0);
            if (b >= 1) {
                const int c = b - 1;
#pragma unroll
                for (int p = 0; p < 4; ++p) { const int ai = c >> 1, m = 2 * (c & 1) + (p >> 1), bj = p & 1;
                    const int row = row0 + ai * HALF + m * 16, col = col0 + bj * HALF;
                    float ga[8]; unpack8(ga4[c & 1][p], ga);
                    if (u.seg < 2) {
                        float gb[8]; unpack8(gb4[c & 1][p], gb);
#pragma unroll
                        for (int e = 0; e < 8; ++e) { const float ea = __expf(-fminf(fmaxf(ga[e], -30.f), 30.f)), eb = __expf(-fminf(fmaxf(gb[e], -30.f), 30.f));
                            const float ratio = (1.f + eb) * __builtin_amdgcn_rcpf(1.f + ea); acc[ai][bj][m][e >> 2][e & 3] *= ratio; }
                    } else {
                        float r[8];
#pragma unroll
                        for (int e = 0; e < 8; ++e) r[e] = acc[ai][bj][m][e >> 2][e & 3] * __builtin_amdgcn_rcpf(1.f + __expf(-fminf(fmaxf(ga[e], -30.f), 30.f)));
                        u32x4 w; w.x = cvt_pk_bf16(r[0], r[1]); w.y = cvt_pk_bf16(r[2], r[3]); w.z = cvt_pk_bf16(r[4], r[5]); w.w = cvt_pk_bf16(r[6], r[7]);
                        *(u32x4*)(y + (size_t)row * DM + col) = w;
                    }
                }
                __builtin_amdgcn_sched_barrier(0);
            }
        }
    }
};
struct EpiOut {
    static constexpr bool PERM = true, AFTER_DRAIN = false;
    const float* xlat; const float* xctx; float* xnew; const float* mod;
    __device__ __forceinline__ void operator()(const f32x4 (&acc)[2][2][4][2], const Unit& u, int wr, int wc, int fr, int fq) const {
        const int row0 = u.pm * BM + wr * 64 + fr, col0 = u.pn * BM + wc * 32 + 8 * fq;
        const int tile_row = u.pm * BM; const int mr = tile_row < ML ? tile_row / SEQ : 4;
        const float* xo = tile_row < ML ? xlat : (xctx - (size_t)ML * DM);
        const float* gm = mod + mr * 6144 + 4096;
        f32x4 g0[2], g1[2];
#pragma unroll
        for (int bj = 0; bj < 2; ++bj) { g0[bj] = *(const f32x4*)(gm + col0 + bj * HALF); g1[bj] = *(const f32x4*)(gm + col0 + bj * HALF + 4); }
        f32x4 x0[2][4], x1[2][4];
#pragma unroll
        for (int b = 0; b < 5; ++b) {
            if (b < 4) {
#pragma unroll
                for (int p = 0; p < 4; ++p) { const int ai = b >> 1, m = 2 * (b & 1) + (p >> 1), bj = p & 1;
                    const float* xp = xo + (size_t)(row0 + ai * HALF + m * 16) * DM + col0 + bj * HALF; x0[b & 1][p] = *(const f32x4*)xp; x1[b & 1][p] = *(const f32x4*)(xp + 4); }
            }
            __builtin_amdgcn_sched_barrier(0);
            if (b >= 1) {
                const int c = b - 1;
#pragma unroll
                for (int p = 0; p < 4; ++p) { const int ai = c >> 1, m = 2 * (c & 1) + (p >> 1), bj = p & 1;
                    float* op = xnew + (size_t)(row0 + ai * HALF + m * 16) * DM + col0 + bj * HALF;
                    *(f32x4*)op = x0[c & 1][p] + g0[bj] * acc[ai][bj][m][0]; *(f32x4*)(op + 4) = x1[c & 1][p] + g1[bj] * acc[ai][bj][m][1]; }
                __builtin_amdgcn_sched_barrier(0);
            }
        }
    }
};
}

struct Args { const float* in[26]; float* out; unsigned char* ws; int ph_lo, ph_hi; };
enum { I_X = 0, I_C, I_CTX, I_CCTX, I_NORMG, I_WADA, I_BADA, I_WIN, I_POOLW, I_POOLS, I_QNORM, I_KNORM, I_LQ1, I_LK1, I_LQ2, I_LK2, I_SUBLN, I_WGF, I_BGF, I_WGB, I_BGB, I_GLAN, I_WBP, I_WBD, I_WBG, I_WOUT };

__device__ __forceinline__ const float* inp(int i) { const float* const volatile __attribute__((address_space(4)))* kp = (const float* const volatile __attribute__((address_space(4)))*)__builtin_amdgcn_kernarg_segment_ptr(); const GAS float* q = (const GAS float*)kp[i]; asm volatile("" : "+s"(q)); return (const float*)q; }
__device__ __forceinline__ float* arg_out() { float* const volatile __attribute__((address_space(4)))* kp = (float* const volatile __attribute__((address_space(4)))*)__builtin_amdgcn_kernarg_segment_ptr(); GAS float* q = (GAS float*)kp[26]; asm volatile("" : "+s"(q)); return (float*)q; }
__device__ __forceinline__ void transpose_item(const float* W, int K, int N, bf16_t* WT, int row_off, LAS float* scr, int kb, int nb, int lane) {
    const int k0 = 64 * kb, n0 = 32 * nb;
    float tv[32];
#pragma unroll
    for (int i = 0; i < 32; ++i) { const int kk = 2 * i + (lane >> 5); tv[i] = __builtin_nontemporal_load(W + (size_t)(k0 + kk) * N + n0 + (lane & 31)); }
#pragma unroll
    for (int i = 0; i < 32; ++i) { const int kk = 2 * i + (lane >> 5); scr[kk * 33 + (lane & 31)] = tv[i]; }
    asm volatile("s_waitcnt lgkmcnt(0)" ::: "memory");
    const int c = lane & 7;
#pragma unroll
    for (int j = 0; j < 4; ++j) { const int n = (lane >> 3) + 8 * j; const LAS float* s = scr + (8 * c) * 33 + n;
        u32x4 o; o.x = cvt_pk_bf16(s[0 * 33], s[1 * 33]); o.y = cvt_pk_bf16(s[2 * 33], s[3 * 33]); o.z = cvt_pk_bf16(s[4 * 33], s[5 * 33]); o.w = cvt_pk_bf16(s[6 * 33], s[7 * 33]);
        *(u32x4*)(WT + (size_t)(row_off + n0 + n) * K + k0 + 8 * c) = o; }
    asm volatile("s_waitcnt lgkmcnt(0)" ::: "memory");
}

__device__ __forceinline__ void ada_items(const Args& a, LAS unsigned char* lds, int l, int bidx, int nb) {
    const int tid = opaque_tid(), lane = tid & 63, wave = __builtin_amdgcn_readfirstlane(tid >> 6);
    unsigned char* ws = opaque_ptr(a.ws);
    LAS float* sc = (LAS float*)(lds + 69632);
    LAS float* part = (LAS float*)(lds + 69632 + 40960);
    if (bidx < 96) {
        for (int i = tid; i < 5 * 2048; i += 512) { const int r = i >> 11, k = i & 2047; const float v = r < 4 ? inp(I_C)[r * 2048 + k] : inp(I_CCTX)[k]; sc[i] = silu_f(v); }
        __syncthreads();
    }
    for (int it = bidx; it < 96; it += nb) {
        const int cgp = it, col = cgp * 64 + lane;
        const float* W = inp(I_WADA) + (size_t)l * 2048 * 6144 + col;
        float acc[5] = {0.f, 0.f, 0.f, 0.f, 0.f};
#pragma unroll 32
        for (int kk = 0; kk < 256; ++kk) { const int k = wave * 256 + kk; const float wv = __builtin_nontemporal_load(W + (size_t)k * 6144);
#pragma unroll
            for (int r = 0; r < 5; ++r) acc[r] += sc[r * 2048 + k] * wv; }
#pragma unroll
        for (int r = 0; r < 5; ++r) part[(wave * 5 + r) * 64 + lane] = acc[r];
        __syncthreads();
        if (tid < 320) { const int r = tid >> 6, ln = tid & 63; float s2 = inp(I_BADA)[l * 6144 + cgp * 64 + ln];
#pragma unroll
            for (int w = 0; w < 8; ++w) s2 += part[(w * 5 + r) * 64 + ln];
            ((float*)(ws + OFF_MOD))[(l * 5 + r) * 6144 + cgp * 64 + ln] = s2; }
        __syncthreads();
    }
}

__device__ __forceinline__ void convert_layer_weights(const Args& a, LAS unsigned char* lds, int l, int widx, int nw) {
    const int lane = opaque_tid() & 63, wave = __builtin_amdgcn_readfirstlane((int)threadIdx.x >> 6);
    unsigned char* ws = opaque_ptr(a.ws);
    LAS float* scr = (LAS float*)(lds + wave * 8704);
    constexpr int I_IN = 32 * 481, I_B = 16 * 64, I_O = 32 * 64, I_P = 4 * 32, PER_L = I_IN + 3 * I_B + I_O + I_P;
    for (int it = widx; it < PER_L; it += nw) {
        int r = it;
        if (r < I_IN) { const int kb = r / 481, nb = r % 481;
            transpose_item(inp(I_WIN) + (size_t)l * DM * DIN, DM, DIN, (bf16_t*)(ws + OFF_WIN + (size_t)l * SZ_WIN), nb >= 289 ? 224 : 0, scr, kb, nb, lane); continue; }
        r -= I_IN;
        if (r < 3 * I_B) { const int br = r / I_B, rr = r % I_B; const float* W = (br == 0 ? inp(I_WBP) : br == 1 ? inp(I_WBD) : inp(I_WBG)) + (size_t)l * 1024 * DM;
            transpose_item(W, 1024, DM, (bf16_t*)(ws + OFF_WB + (size_t)l * SZ_WB + (size_t)br * DM * 1024 * 2), 0, scr, rr / 64, rr % 64, lane); continue; }
        r -= 3 * I_B;
        if (r < I_O) { transpose_item(inp(I_WOUT) + (size_t)l * DM * DM, DM, DM, (bf16_t*)(ws + OFF_WOUT + (size_t)l * SZ_WOUT), 0, scr, r / 64, r % 64, lane); continue; }
        r -= I_O;
        { const int g = r / 32, rr = r % 32;
          transpose_item(inp(I_POOLW) + (size_t)(l * 4 + g) * 65536, 256, 256, (bf16_t*)(ws + OFF_POOLT + (size_t)l * SZ_POOLT + (size_t)g * 65536 * 2), 0, scr, rr / 8, rr % 8, lane); }
    }
}

__device__ __forceinline__ void phase_p0(const Args& a, LAS unsigned char* lds) {
    const int tid = opaque_tid(), lane = tid & 63, wave = __builtin_amdgcn_readfirstlane(tid >> 6), G = opaque_s(gridDim.x);
    unsigned char* ws = opaque_ptr(a.ws);
    ada_items(a, lds, 0, BID, G);
    if (BID == G - 1 && wave == 0) {
        for (int l = 0; l < 2; ++l) {
            const float s1 = wave_sum(inp(I_LQ1)[l * 64 + lane] * inp(I_LK1)[l * 64 + lane]);
            const float s2 = wave_sum(inp(I_LQ2)[l * 64 + lane] * inp(I_LK2)[l * 64 + lane]);
            const float mq = wave_max(fabsf(inp(I_QNORM)[l * 64 + lane])), mk = wave_max(fabsf(inp(I_KNORM)[l * 64 + lane]));
            const float lam_init = 0.8f - 0.6f * expf(-0.3f * (float)l);
            if (lane == 0) { float* sp = (float*)(ws + OFF_SCAL) + l * 4; sp[0] = expf(s1) - expf(s2) + lam_init; sp[1] = 8.f * LOG2E * mq * mk; sp[2] = lam_init; sp[3] = 0.f; }
        }
    }
    {
        const int nper = 224 * 2048 * 2 / 16;
        for (int i = BID * 512 + tid; i < 2 * nper; i += G * 512) { const int l = i / nper, j = i % nper;
            *(u32x4*)(ws + OFF_WIN + (size_t)l * SZ_WIN + (size_t)9248 * DM * 2 + (size_t)j * 16) = (u32x4){0u, 0u, 0u, 0u}; }
    }
    convert_layer_weights(a, lds, 0, BID * 8 + wave, G * 8);
}

__device__ __forceinline__ void phase_norm(const Args& a, int l) {
    const int tid = opaque_tid(), lane = tid & 63, wave = tid >> 6, G = opaque_s(gridDim.x);
    const int gw = BID * 8 + wave, NGW = G * 8;
    const float* mod = (const float*)(opaque_ptr(a.ws) + OFF_MOD) + (size_t)l * 5 * 6144;
    const float* x1 = (const float*)(opaque_ptr(a.ws) + OFF_X1);
    bf16_t* h = (bf16_t*)(opaque_ptr(a.ws) + OFF_H);
    const float* ng = inp(I_NORMG) + l * DM;
    for (int row = gw; row < MT; row += NGW) {
        const float* src = (l == 0) ? (row < ML ? inp(I_X) + (size_t)row * DM : inp(I_CTX) + (size_t)(row - ML) * DM) : x1 + (size_t)row * DM;
        const int mr = row < ML ? row / SEQ : 4;
        const float* md = mod + mr * 6144;
        f32x4 v[8]; float ss = 0.f;
#pragma unroll
        for (int j = 0; j < 8; ++j) { v[j] = *(const f32x4*)(src + 4 * lane + 256 * j); ss += (v[j][0] * v[j][0] + v[j][1] * v[j][1]) + (v[j][2] * v[j][2] + v[j][3] * v[j][3]); }
        ss = wave_sum(ss);
        const float rstd = rsqrtf(ss * (1.f / DM) + EPS);
#pragma unroll
        for (int j = 0; j < 8; ++j) { const int idx = 4 * lane + 256 * j;
            const f32x4 gg = *(const f32x4*)(ng + idx), sc = *(const f32x4*)(md + 2048 + idx), sh = *(const f32x4*)(md + idx);
            f32x4 o;
#pragma unroll
            for (int e = 0; e < 4; ++e) o[e] = v[j][e] * rstd * gg[e] * (1.f + sc[e]) + sh[e];
            u32x2 w; w.x = cvt_pk_bf16(o[0], o[1]); w.y = cvt_pk_bf16(o[2], o[3]);
            *(u32x2*)(h + (size_t)row * DM + idx) = w; }
    }
}

__device__ __forceinline__ int vt_pos(int key) { const int k = key & 15; return (key & ~15) | (((k >> 2) & 1) << 3) | (k & 3) | (((k >> 3) & 1) << 2); }

__device__ __forceinline__ void phase_prep(const Args& a, int l, LAS unsigned char* lds) {
    const int tid = opaque_tid(), lane = tid & 63, wave = tid >> 6, G = opaque_s(gridDim.x);
    unsigned char* ws = opaque_ptr(a.ws);
    const bf16_t* z = (const bf16_t*)(ws + OFF_Z);
    const bool need_ctx = (l == 0);
    for (int it = BID; it < 1440; it += G) {
        if (it < 576) {
            const int c = it >> 2, cgp = it & 3, rb = 64 * c;
            LAS float* lrs = (LAS float*)lds;
            LAS float* segs = (LAS float*)(lds + 8192);
            for (int i = tid; i < 64 * 32; i += 512) { const int r = i >> 5, cc = i & 31; lrs[i] = bf2f(z[(size_t)(rb + r) * NZ + ZC_LR + cc]); }
            __syncthreads();
            const int seg = tid >> 6, cp = tid & 63, ch = cgp * 128 + 2 * cp;
            typedef float f32x2v __attribute__((ext_vector_type(2)));
            const float* wgf = inp(I_WGF) + (size_t)l * 16 * 512 + ch; const float* wgb = inp(I_WGB) + (size_t)l * 16 * 512 + ch;
            f32x2v wf[16], wb[16];
#pragma unroll
            for (int r = 0; r < 16; ++r) { wf[r] = *(const f32x2v*)(wgf + r * 512); wb[r] = *(const f32x2v*)(wgb + r * 512); }
            const f32x2v bfv = *(const f32x2v*)(inp(I_BGF) + l * 512 + ch), bbv = *(const f32x2v*)(inp(I_BGB) + l * 512 + ch);
            f32x2v gf[8], gb[8]; f32x2v sf = {0.f, 0.f}, sb = {0.f, 0.f};
#pragma unroll
            for (int i = 0; i < 8; ++i) { const int t = seg * 8 + i; f32x2v af = bfv, ab = bbv;
#pragma unroll
                for (int r4 = 0; r4 < 4; ++r4) { const f32x4 lf = *(const LAS f32x4*)(lrs + t * 32 + 4 * r4), lb = *(const LAS f32x4*)(lrs + t * 32 + 16 + 4 * r4);
#pragma unroll
                    for (int e = 0; e < 4; ++e) { af += lf[e] * wf[4 * r4 + e]; ab += lb[e] * wb[4 * r4 + e]; } }
                gf[i].x = logsig_f(af.x) * (1.f / 16.f); gf[i].y = logsig_f(af.y) * (1.f / 16.f);
                gb[i].x = logsig_f(ab.x) * (1.f / 16.f); gb[i].y = logsig_f(ab.y) * (1.f / 16.f); sf += gf[i]; sb += gb[i]; }
            *(LAS f32x2v*)(segs + seg * 128 + 2 * cp) = sf; *(LAS f32x2v*)(segs + 1024 + seg * 128 + 2 * cp) = sb;
            __syncthreads();
            f32x2v pf = {0.f, 0.f}, pb = {0.f, 0.f}, totf = {0.f, 0.f}, totb = {0.f, 0.f};
#pragma unroll
            for (int s2 = 0; s2 < 8; ++s2) { const f32x2v vf = *(const LAS f32x2v*)(segs + s2 * 128 + 2 * cp), vb = *(const LAS f32x2v*)(segs + 1024 + s2 * 128 + 2 * cp);
                totf += vf; totb += vb; if (s2 < seg) { pf += vf; pb += vb; } }
            unsigned* gq0 = (unsigned*)(ws + OFF_GQ), *gq1 = (unsigned*)(ws + OFF_GQ + SZ_G);
            unsigned* gk0 = (unsigned*)(ws + OFF_GK), *gk1 = (unsigned*)(ws + OFF_GK + SZ_G);
            bf16_t* gh0 = (bf16_t*)(ws + OFF_GH), *gh1 = (bf16_t*)(ws + OFF_GH + SZ_G);
            f32x2v h0[8], h1[8];
#pragma unroll
            for (int i = 0; i < 8; ++i) { const int t = seg * 8 + i;
                pf += gf[i]; const f32x2v bs = totb - pb; pb += gb[i];
                const size_t row = rb + t;
                const unsigned qw = *(const unsigned*)(z + row * NZ + ZC_GQ + ch), kw = *(const unsigned*)(z + row * NZ + ZC_GK + ch);
                const float q0 = bflo(qw) * 0.08838834764831845f, q1 = bfhi(qw) * 0.08838834764831845f, k0 = bflo(kw), k1 = bfhi(kw);
                const size_t o = (row * 512 + ch) >> 1;
                gq0[o] = cvt_pk_bf16(q0 * __expf(pf.x), q1 * __expf(pf.y)); gk0[o] = cvt_pk_bf16(k0 * __expf(-pf.x), k1 * __expf(-pf.y));
                gq1[o] = cvt_pk_bf16(q0 * __expf(bs.x), q1 * __expf(bs.y)); gk1[o] = cvt_pk_bf16(k0 * __expf(-bs.x), k1 * __expf(-bs.y));
                h0[i].x = k0 * __expf(totf.x - pf.x); h0[i].y = k1 * __expf(totf.y - pf.y);
                h1[i].x = k0 * __expf(totb.x - bs.x); h1[i].y = k1 * __expf(totb.y - bs.y); }
            {
#pragma unroll
                for (int cc = 0; cc < 2; ++cc) { u32x4 w0, w1;
                    w0.x = cvt_pk_bf16(h0[0][cc], h0[1][cc]); w0.y = cvt_pk_bf16(h0[2][cc], h0[3][cc]); w0.z = cvt_pk_bf16(h0[4][cc], h0[5][cc]); w0.w = cvt_pk_bf16(h0[6][cc], h0[7][cc]);
                    w1.x = cvt_pk_bf16(h1[0][cc], h1[1][cc]); w1.y = cvt_pk_bf16(h1[2][cc], h1[3][cc]); w1.z = cvt_pk_bf16(h1[4][cc], h1[5][cc]); w1.w = cvt_pk_bf16(h1[6][cc], h1[7][cc]);
                    const size_t oh = ((size_t)c * 512 + ch + cc) * 64 + seg * 8;
                    *(u32x4*)(gh0 + oh) = w0; *(u32x4*)(gh1 + oh) = w1; } }
            if (seg == 0) { float* dec = (float*)(ws + OFF_DEC);
                *(f32x2v*)(dec + (size_t)c * 512 + ch) = (f32x2v){__expf(totf.x), __expf(totf.y)}; *(f32x2v*)(dec + (size_t)(144 + c) * 512 + ch) = (f32x2v){__expf(totb.x), __expf(totb.y)}; }
            __syncthreads();
        } else if (it < 864) {
            const int rb = 32 * (it - 576); if (!need_ctx && rb >= ML) continue;
            const int seq0 = rb < ML ? (rb / SEQ) * SEQ : ML + ((rb - ML) / LC) * LC; const int L = rb < ML ? SEQ : LC;
            const int ts = rb - seq0;
            bf16_t* dp = (bf16_t*)(ws + OFF_DPOOL); bf16_t* pgt = (bf16_t*)(ws + OFF_PGATE);
#pragma unroll
            for (int i = 0; i < 12; ++i) { const int idx = tid + 512 * i, rr = idx >> 7, c8 = (idx & 127) * 8, p = ts - 8 + rr;
                if (p >= 0 && p < L) *(LAS u32x4*)(lds + rr * 2048 + c8 * 2) = *(const u32x4*)(z + (size_t)(seq0 + p) * NZ + ZC_PU + c8); }
            __syncthreads();
            const int ch8 = 8 * (tid & 127), tg = tid >> 7, hw = 1 << (ch8 >> 8);
            const int tl0 = ts + 8 * tg;
            float psc[8];
            { const float* pp = inp(I_POOLS) + l * 1024 + ch8; const f32x4 p0 = *(const f32x4*)pp, p1 = *(const f32x4*)(pp + 4);
#pragma unroll
              for (int e = 0; e < 4; ++e) { psc[e] = p0[e]; psc[4 + e] = p1[e]; } }
            u32x4 pgw[8];
#pragma unroll
            for (int t = 0; t < 8; ++t) pgw[t] = *(const u32x4*)(z + (size_t)(seq0 + tl0 + t) * NZ + ZC_PG + ch8);
            const LAS unsigned char* lc = lds + ch8 * 2 - (ts - 8) * 2048;
            float sm[8] = {0.f, 0.f, 0.f, 0.f, 0.f, 0.f, 0.f, 0.f};
            { const int lo = max(tl0 - hw, 0), hi = min(tl0 + hw, L);
              for (int p = lo; p < hi; ++p) { float u[8]; unpack8(*(const LAS u32x4*)(lc + p * 2048), u);
#pragma unroll
                  for (int e = 0; e < 8; ++e) sm[e] += u[e]; } }
#pragma unroll
            for (int t = 0; t < 8; ++t) { const int tl = tl0 + t; const int lo = max(tl - hw, 0), hi = min(tl + hw, L);
                const float rc = __builtin_amdgcn_rcpf((float)(hi - lo));
                float cur[8], pgv[8], ua[8], ur[8];
                unpack8(*(const LAS u32x4*)(lc + tl * 2048), cur); unpack8(pgw[t], pgv);
                unpack8(*(const LAS u32x4*)(lc + min(tl + hw, L - 1) * 2048), ua); unpack8(*(const LAS u32x4*)(lc + max(tl - hw, 0) * 2048), ur);
                const float ma = (tl + hw < L) ? 1.f : 0.f, mr = (tl - hw >= 0) ? 1.f : 0.f;
                u32x4 wd, wg;
                wd.x = cvt_pk_bf16(sm[0] * rc - cur[0], sm[1] * rc - cur[1]); wd.y = cvt_pk_bf16(sm[2] * rc - cur[2], sm[3] * rc - cur[3]);
                wd.z = cvt_pk_bf16(sm[4] * rc - cur[4], sm[5] * rc - cur[5]); wd.w = cvt_pk_bf16(sm[6] * rc - cur[6], sm[7] * rc - cur[7]);
                wg.x = cvt_pk_bf16(psc[0] * silu_f(pgv[0]), psc[1] * silu_f(pgv[1])); wg.y = cvt_pk_bf16(psc[2] * silu_f(pgv[2]), psc[3] * silu_f(pgv[3]));
                wg.z = cvt_pk_bf16(psc[4] * silu_f(pgv[4]), psc[5] * silu_f(pgv[5])); wg.w = cvt_pk_bf16(psc[6] * silu_f(pgv[6]), psc[7] * silu_f(pgv[7]));
                const size_t o = (size_t)(seq0 + tl) * 1024 + ch8;
                *(u32x4*)(dp + o) = wd; *(u32x4*)(pgt + o) = wg;
#pragma unroll
                for (int e = 0; e < 8; ++e) sm[e] += ma * ua[e] - mr * ur[e]; }
            __syncthreads();
        } else {
            const int vi = it - 864, isg = vi >= 288, vj = isg ? vi - 288 : vi, c = vj >> 1, hv = vj & 1, rb = 64 * c;
            int b, key0; if (rb < ML) { b = rb >> 11; key0 = LC + (rb & 2047); } else { b = (rb - ML) >> 8; key0 = (rb - ML) & 255; }
            bf16_t* vT = (bf16_t*)(ws + OFF_VT); bf16_t* gvT = (bf16_t*)(ws + OFF_GVT);
#pragma unroll
            for (int i = 0; i < 8; ++i) { const int idx = tid + 512 * i, key = idx & 63, c8 = (idx >> 6) * 8;
                const u32x4 w = *(const u32x4*)(z + (size_t)(rb + key) * NZ + (isg ? ZC_GV : ZC_DV) + hv * 512 + c8);
                const unsigned ww[4] = {w.x, w.y, w.z, w.w}; const int pos = isg ? key : vt_pos(key);
#pragma unroll
                for (int e = 0; e < 8; ++e) *(LAS bf16_t*)(lds + (c8 + e) * 144 + pos * 2) = (bf16_t)((e & 1) ? (ww[e >> 1] >> 16) : (ww[e >> 1] & 0xffffu)); }
            __syncthreads();
#pragma unroll
            for (int i = 0; i < 8; ++i) { const int idx = tid + 512 * i, col = idx >> 3, k8 = idx & 7, colg = hv * 512 + col, h = colg >> 7, v = colg & 127;
                bf16_t* dst = isg ? gvT + ((size_t)c * 1024 + colg) * 64 + k8 * 8 : vT + ((size_t)(b * 8 + h) * 128 + v) * LK + key0 + k8 * 8;
                *(u32x4*)dst = *(const LAS u32x4*)(lds + col * 144 + k8 * 16); }
            __syncthreads();
        }
    }
    {
        const int gw = BID * 8 + wave, NGW = G * 8;
        bf16_t* qn = (bf16_t*)(ws + OFF_QN); bf16_t* qnc = (bf16_t*)(ws + OFF_QNC); bf16_t* kn = (bf16_t*)(ws + OFF_KN);
        u32x4 cw0 = {0u, 0u, 0u, 0u}, cw1 = {0u, 0u, 0u, 0u};
        if (gw < MT * 2) { const bf16_t* src0 = z + (size_t)(gw >> 1) * NZ + ((gw & 1) == 0 ? ZC_DQ : ZC_DK) + 16 * lane; cw0 = *(const u32x4*)src0; cw1 = *(const u32x4*)(src0 + 8); }
        for (int it = gw; it < MT * 2; it += NGW) {
            const int row = it >> 1, which = it & 1;
            const u32x4 xw0 = cw0, xw1 = cw1;
            { const int nit = it + NGW; if (nit < MT * 2) { const bf16_t* srcn = z + (size_t)(nit >> 1) * NZ + ((nit & 1) == 0 ? ZC_DQ : ZC_DK) + 16 * lane; cw0 = *(const u32x4*)srcn; cw1 = *(const u32x4*)(srcn + 8); } }
            const bool isctx = row >= ML; int b, t; if (!isctx) { b = row >> 11; t = row & 2047; } else { b = (row - ML) >> 8; t = (row - ML) & 255; }
            {
                if (which == 0 && isctx && !need_ctx) continue;
                float x[16];
                unpack8(xw0, x); unpack8(xw1, x + 8);
                float ss = 0.f;
#pragma unroll
                for (int e = 0; e < 16; ++e) ss += x[e] * x[e];
                ss += __shfl_xor(ss, 1); ss += __shfl_xor(ss, 2);
                const float rstd = rsqrtf(ss * (1.f / 64.f) + EPS);
                const int m = lane & 3, sh = lane >> 2, h = sh >> 1, j = sh & 1;
                const float* gain = (which == 0 ? inp(I_QNORM) : inp(I_KNORM)) + l * 64 + 16 * m;
                float y[16];
#pragma unroll
                for (int e = 0; e < 16; ++e) y[e] = x[e] * rstd * gain[e];
                if (!isctx) {
                    const float posf = (float)((m & 1) ? (t & 63) : (t >> 6));
#pragma unroll
                    for (int e = 0; e < 16; ++e) { const float yp = __shfl_xor(y[e], 2);
                        const float ang = posf * exp2f(-(float)e * 0.8304820237218405f);
                        const float cs = __cosf(ang), sn = __sinf(ang);
                        y[e] = (m < 2) ? (y[e] * cs - yp * sn) : (y[e] * cs + yp * sn); }
                }
                bf16_t* dst;
                if (which == 0) {
#pragma unroll
                    for (int e = 0; e < 16; ++e) y[e] *= 0.125f * LOG2E;
                    dst = isctx ? qnc + (((size_t)(b * 8 + h) * 2 + j) * LC + t) * 64 + 16 * m : qn + (((size_t)(b * 8 + h) * 2 + j) * SEQ + t) * 64 + 16 * m;
                } else dst = kn + (((size_t)(b * 8 + h) * 2 + j) * LK + (isctx ? t : LC + t)) * 64 + 16 * m;
                u32x4 w0, w1;
                w0.x = cvt_pk_bf16(y[0], y[1]); w0.y = cvt_pk_bf16(y[2], y[3]); w0.z = cvt_pk_bf16(y[4], y[5]); w0.w = cvt_pk_bf16(y[6], y[7]);
                w1.x = cvt_pk_bf16(y[8], y[9]); w1.y = cvt_pk_bf16(y[10], y[11]); w1.z = cvt_pk_bf16(y[12], y[13]); w1.w = cvt_pk_bf16(y[14], y[15]);
                *(u32x4*)dst = w0; *(u32x4*)(dst + 8) = w1;
            }
        }
    }
}

constexpr int GL_Q = 0, GL_K = 17408, GL_KH = 34816, GL_VT = 53248, GL_ATT = 57856, GL_ST = 67072;
__device__ __forceinline__ void gla_unit(const Args& a, int l, LAS unsigned char* lds, int item) {
    const int tid = opaque_tid(), lane = tid & 63, w = __builtin_amdgcn_readfirstlane(tid >> 6);
    const int vs = item & 7, dir = (item >> 3) & 1, h = (item >> 4) & 3, b = item >> 6;
    const bool need_ctx = (l == 0);
    unsigned char* ws = opaque_ptr(a.ws);
    const bf16_t* z = (const bf16_t*)(ws + OFF_Z);
    const bf16_t* gq = (const bf16_t*)(ws + OFF_GQ + dir * SZ_G) + h * 128;
    const bf16_t* gk = (const bf16_t*)(ws + OFF_GK + dir * SZ_G) + h * 128;
    const bf16_t* gh = (const bf16_t*)(ws + OFF_GH + dir * SZ_G) + (size_t)h * 128 * 64;
    const float* dec = (const float*)(ws + OFF_DEC) + (size_t)dir * 144 * 512 + h * 128;
    bf16_t* od = (bf16_t*)(ws + OFF_OF + (size_t)dir * MT * 1024 * 2) + h * 256 + vs * 32;
    const bf16_t* gvt = (const bf16_t*)(ws + OFF_GVT) + (size_t)(h * 256 + vs * 32) * 64;
    const int fr = lane & 15, fq = lane >> 4;
    f32x4 sacc[2] = {(f32x4){0.f, 0.f, 0.f, 0.f}, (f32x4){0.f, 0.f, 0.f, 0.f}};
    for (int i = tid; i < 32 * 136 / 2; i += 512) ((LAS unsigned*)(lds + GL_ST))[i] = 0u;
    u32x4 rqA[2], rkA[2], rhA[2], rvA, rqB[2], rkB[2], rhB[2], rvB; float rdecA, rdecB;
    auto rowbase = [&](int s) -> int { if (s < 4) { const int ci = dir == 0 ? s : 3 - s; return ML + b * LC + 64 * ci; } const int ci = dir == 0 ? s - 4 : 35 - s; return b * SEQ + 64 * ci; };
#define GLA_LOADA(s) do { const int _rb = rowbase(s); _Pragma("unroll") for (int _i = 0; _i < 2; ++_i) { const int _idx = tid + 512 * _i, _r = _idx >> 4, _c = (_idx & 15) * 8; const size_t _o = (size_t)(_rb + _r) * 512 + _c; \
        rqA[_i] = *(const u32x4*)(gq + _o); rkA[_i] = *(const u32x4*)(gk + _o); rhA[_i] = *(const u32x4*)(gh + ((size_t)(_rb >> 6) * 512 + (_idx >> 3)) * 64 + (_idx & 7) * 8); } \
        if (tid < 256) rvA = *(const u32x4*)(gvt + ((size_t)(_rb >> 6) * 1024 + (tid >> 3)) * 64 + (tid & 7) * 8); \
        rdecA = dec[(size_t)(_rb >> 6) * 512 + 16 * w + fr]; } while (0)
#define GLA_LOADB(s) do { const int _rb = rowbase(s); _Pragma("unroll") for (int _i = 0; _i < 2; ++_i) { const int _idx = tid + 512 * _i, _r = _idx >> 4, _c = (_idx & 15) * 8; const size_t _o = (size_t)(_rb + _r) * 512 + _c; \
        rqB[_i] = *(const u32x4*)(gq + _o); rkB[_i] = *(const u32x4*)(gk + _o); rhB[_i] = *(const u32x4*)(gh + ((size_t)(_rb >> 6) * 512 + (_idx >> 3)) * 64 + (_idx & 7) * 8); } \
        if (tid < 256) rvB = *(const u32x4*)(gvt + ((size_t)(_rb >> 6) * 1024 + (tid >> 3)) * 64 + (tid & 7) * 8); \
        rdecB = dec[(size_t)(_rb >> 6) * 512 + 16 * w + fr]; } while (0)
    GLA_LOADA(0); GLA_LOADB(1);
    for (int s0_ = 0; s0_ < 36; s0_ += 2) {
      { const int s = s0_;
        const int rb = rowbase(s);
        const float dk = rdecA;
#pragma unroll
        for (int i = 0; i < 2; ++i) { const int idx = tid + 512 * i, r = idx >> 4, c = (idx & 15) * 8;
            *(LAS u32x4*)(lds + GL_Q + r * 272 + c * 2) = rqA[i]; *(LAS u32x4*)(lds + GL_K + r * 272 + c * 2) = rkA[i];
            const int s0 = (idx & 7) * 8, p1 = (s0 & 32) + 8 * ((s0 & 15) >> 2) + 4 * ((s0 >> 4) & 1);
            *(LAS u32x2*)(lds + GL_KH + (idx >> 3) * 144 + p1 * 2) = (u32x2){rhA[i].x, rhA[i].y}; *(LAS u32x2*)(lds + GL_KH + (idx >> 3) * 144 + (p1 + 8) * 2) = (u32x2){rhA[i].z, rhA[i].w}; }
        if (tid < 256) { const int s0 = (tid & 7) * 8, p1 = (s0 & 32) + 8 * ((s0 & 15) >> 2) + 4 * ((s0 >> 4) & 1);
            *(LAS u32x2*)(lds + GL_VT + (tid >> 3) * 144 + p1 * 2) = (u32x2){rvA.x, rvA.y}; *(LAS u32x2*)(lds + GL_VT + (tid >> 3) * 144 + (p1 + 8) * 2) = (u32x2){rvA.z, rvA.w}; }
        __syncthreads();
        if (s + 2 < 36) GLA_LOADA(s + 2);
        const int tt = w >> 1, vt = w & 1;
        bf16x8 pb[2];
        {
            f32x4 at[4];
#pragma unroll
            for (int st = 0; st < 4; ++st) { f32x4 acc = (f32x4){0.f, 0.f, 0.f, 0.f};
#pragma unroll
                for (int kk = 0; kk < 4; ++kk) { const bf16x8 af = *(const LAS bf16x8*)(lds + GL_K + (16 * st + fr) * 272 + (32 * kk + 8 * fq) * 2);
                    const bf16x8 bfr = *(const LAS bf16x8*)(lds + GL_Q + (16 * tt + fr) * 272 + (32 * kk + 8 * fq) * 2);
                    acc = __builtin_amdgcn_mfma_f32_16x16x32_bf16(af, bfr, acc, 0, 0, 0); }
#pragma unroll
                for (int j = 0; j < 4; ++j) { const int sc = 16 * st + 4 * fq + j, t = 16 * tt + fr; const bool keep = dir == 0 ? (sc <= t) : (sc >= t); acc[j] = keep ? acc[j] : 0.f; }
                at[st] = acc; }
#pragma unroll
            for (int p = 0; p < 2; ++p) { u32x4 pw; pw.x = cvt_pk_bf16(at[2 * p][0], at[2 * p][1]); pw.y = cvt_pk_bf16(at[2 * p][2], at[2 * p][3]);
                pw.z = cvt_pk_bf16(at[2 * p + 1][0], at[2 * p + 1][1]); pw.w = cvt_pk_bf16(at[2 * p + 1][2], at[2 * p + 1][3]); pb[p] = __builtin_bit_cast(bf16x8, pw); }
        }
        {
            f32x4 acc = (f32x4){0.f, 0.f, 0.f, 0.f};
#pragma unroll
            for (int kk = 0; kk < 4; ++kk) { const bf16x8 af = *(const LAS bf16x8*)(lds + GL_ST + (16 * vt + fr) * 272 + (32 * kk + 8 * fq) * 2);
                const bf16x8 bfr = *(const LAS bf16x8*)(lds + GL_Q + (16 * tt + fr) * 272 + (32 * kk + 8 * fq) * 2);
                acc = __builtin_amdgcn_mfma_f32_16x16x32_bf16(af, bfr, acc, 0, 0, 0); }
#pragma unroll
            for (int p = 0; p < 2; ++p) { const bf16x8 af = *(const LAS bf16x8*)(lds + GL_VT + (16 * vt + fr) * 144 + (32 * p + 8 * fq) * 2);
                acc = __builtin_amdgcn_mfma_f32_16x16x32_bf16(af, pb[p], acc, 0, 0, 0); }
            if (s >= 4 || need_ctx) { u32x2 wv; wv.x = cvt_pk_bf16(acc[0], acc[1]); wv.y = cvt_pk_bf16(acc[2], acc[3]);
                *(u32x2*)(od + (size_t)(rb + 16 * tt + fr) * 1024 + 16 * vt + 4 * fq) = wv; }
        }
#pragma unroll
        for (int vt2 = 0; vt2 < 2; ++vt2) { f32x4 acc = sacc[vt2] * dk;
#pragma unroll
            for (int kk = 0; kk < 2; ++kk) { const bf16x8 af = *(const LAS bf16x8*)(lds + GL_VT + (16 * vt2 + fr) * 144 + (32 * kk + 8 * fq) * 2);
                const bf16x8 bfr = *(const LAS bf16x8*)(lds + GL_KH + (16 * w + fr) * 144 + (32 * kk + 8 * fq) * 2);
                acc = __builtin_amdgcn_mfma_f32_16x16x32_bf16(af, bfr, acc, 0, 0, 0); }
            sacc[vt2] = acc; }
        __syncthreads();
#pragma unroll
        for (int vt = 0; vt < 2; ++vt)
#pragma unroll
            for (int j = 0; j < 4; ++j) *(LAS bf16_t*)(lds + GL_ST + (16 * vt + 4 * fq + j) * 272 + (16 * w + fr) * 2) = f2bf(sacc[vt][j]);
      }
      { const int s = s0_ + 1;
        const int rb = rowbase(s);
        const float dk = rdecB;
#pragma unroll
        for (int i = 0; i < 2; ++i) { const int idx = tid + 512 * i, r = idx >> 4, c = (idx & 15) * 8;
            *(LAS u32x4*)(lds + GL_Q + r * 272 + c * 2) = rqB[i]; *(LAS u32x4*)(lds + GL_K + r * 272 + c * 2) = rkB[i];
            const int s0 = (idx & 7) * 8, p1 = (s0 & 32) + 8 * ((s0 & 15) >> 2) + 4 * ((s0 >> 4) & 1);
            *(LAS u32x2*)(lds + GL_KH + (idx >> 3) * 144 + p1 * 2) = (u32x2){rhB[i].x, rhB[i].y}; *(LAS u32x2*)(lds + GL_KH + (idx >> 3) * 144 + (p1 + 8) * 2) = (u32x2){rhB[i].z, rhB[i].w}; }
        if (tid < 256) { const int s0 = (tid & 7) * 8, p1 = (s0 & 32) + 8 * ((s0 & 15) >> 2) + 4 * ((s0 >> 4) & 1);
            *(LAS u32x2*)(lds + GL_VT + (tid >> 3) * 144 + p1 * 2) = (u32x2){rvB.x, rvB.y}; *(LAS u32x2*)(lds + GL_VT + (tid >> 3) * 144 + (p1 + 8) * 2) = (u32x2){rvB.z, rvB.w}; }
        __syncthreads();
        if (s + 2 < 36) GLA_LOADB(s + 2);
        const int tt = w >> 1, vt = w & 1;
        bf16x8 pb[2];
        {
            f32x4 at[4];
#pragma unroll
            for (int st = 0; st < 4; ++st) { f32x4 acc = (f32x4){0.f, 0.f, 0.f, 0.f};
#pragma unroll
                for (int kk = 0; kk < 4; ++kk) { const bf16x8 af = *(const LAS bf16x8*)(lds + GL_K + (16 * st + fr) * 272 + (32 * kk + 8 * fq) * 2);
                    const bf16x8 bfr = *(const LAS bf16x8*)(lds + GL_Q + (16 * tt + fr) * 272 + (32 * kk + 8 * fq) * 2);
                    acc = __builtin_amdgcn_mfma_f32_16x16x32_bf16(af, bfr, acc, 0, 0, 0); }
#pragma unroll
                for (int j = 0; j < 4; ++j) { const int sc = 16 * st + 4 * fq + j, t = 16 * tt + fr; const bool keep = dir == 0 ? (sc <= t) : (sc >= t); acc[j] = keep ? acc[j] : 0.f; }
                at[st] = acc; }
#pragma unroll
            for (int p = 0; p < 2; ++p) { u32x4 pw; pw.x = cvt_pk_bf16(at[2 * p][0], at[2 * p][1]); pw.y = cvt_pk_bf16(at[2 * p][2], at[2 * p][3]);
                pw.z = cvt_pk_bf16(at[2 * p + 1][0], at[2 * p + 1][1]); pw.w = cvt_pk_bf16(at[2 * p + 1][2], at[2 * p + 1][3]); pb[p] = __builtin_bit_cast(bf16x8, pw); }
        }
        {
            f32x4 acc = (f32x4){0.f, 0.f, 0.f, 0.f};
#pragma unroll
            for (int kk = 0; kk < 4; ++kk) { const bf16x8 af = *(const LAS bf16x8*)(lds + GL_ST + (16 * vt + fr) * 272 + (32 * kk + 8 * fq) * 2);
                const bf16x8 bfr = *(const LAS bf16x8*)(lds + GL_Q + (16 * tt + fr) * 272 + (32 * kk + 8 * fq) * 2);
                acc = __builtin_amdgcn_mfma_f32_16x16x32_bf16(af, bfr, acc, 0, 0, 0); }
#pragma unroll
            for (int p = 0; p < 2; ++p) { const bf16x8 af = *(const LAS bf16x8*)(lds + GL_VT + (16 * vt + fr) * 144 + (32 * p + 8 * fq) * 2);
                acc = __builtin_amdgcn_mfma_f32_16x16x32_bf16(af, pb[p], acc, 0, 0, 0); }
            if (s >= 4 || need_ctx) { u32x2 wv; wv.x = cvt_pk_bf16(acc[0], acc[1]); wv.y = cvt_pk_bf16(acc[2], acc[3]);
                *(u32x2*)(od + (size_t)(rb + 16 * tt + fr) * 1024 + 16 * vt + 4 * fq) = wv; }
        }
#pragma unroll
        for (int vt2 = 0; vt2 < 2; ++vt2) { f32x4 acc = sacc[vt2] * dk;
#pragma unroll
            for (int kk = 0; kk < 2; ++kk) { const bf16x8 af = *(const LAS bf16x8*)(lds + GL_VT + (16 * vt2 + fr) * 144 + (32 * kk + 8 * fq) * 2);
                const bf16x8 bfr = *(const LAS bf16x8*)(lds + GL_KH + (16 * w + fr) * 144 + (32 * kk + 8 * fq) * 2);
                acc = __builtin_amdgcn_mfma_f32_16x16x32_bf16(af, bfr, acc, 0, 0, 0); }
            sacc[vt2] = acc; }
        __syncthreads();
#pragma unroll
        for (int vt = 0; vt < 2; ++vt)
#pragma unroll
            for (int j = 0; j < 4; ++j) *(LAS bf16_t*)(lds + GL_ST + (16 * vt + 4 * fq + j) * 272 + (16 * w + fr) * 2) = f2bf(sacc[vt][j]);
      }
    }
    __syncthreads();
#undef GLA_LOADA
#undef GLA_LOADB
}


constexpr int G2_Q = 0, G2_K = 17408, G2_KH = 34816, G2_VT = 53248, G2_ST = 62464;
__device__ __forceinline__ void gla_unit2(const Args& a, int l, LAS unsigned char* lds, int item) {
    const int tid = opaque_tid(), lane = tid & 63, w = __builtin_amdgcn_readfirstlane(tid >> 6);
    const int vs2 = item & 3, dir = (item >> 2) & 1, h = (item >> 3) & 3, b = item >> 5;
    const bool need_ctx = (l == 0);
    unsigned char* ws = opaque_ptr(a.ws);
    const bf16_t* gq = (const bf16_t*)(ws + OFF_GQ + dir * SZ_G) + h * 128;
    const bf16_t* gk = (const bf16_t*)(ws + OFF_GK + dir * SZ_G) + h * 128;
    const bf16_t* gh = (const bf16_t*)(ws + OFF_GH + dir * SZ_G) + (size_t)h * 128 * 64;
    const float* dec = (const float*)(ws + OFF_DEC) + (size_t)dir * 144 * 512 + h * 128;
    bf16_t* od = (bf16_t*)(ws + OFF_OF + (size_t)dir * MT * 1024 * 2) + h * 256 + vs2 * 64;
    const bf16_t* gvt = (const bf16_t*)(ws + OFF_GVT) + (size_t)(h * 256 + vs2 * 64) * 64;
    const int fr = lane & 15, fq = lane >> 4;
    f32x4 sacc[4];
#pragma unroll
    for (int i = 0; i < 4; ++i) sacc[i] = (f32x4){0.f, 0.f, 0.f, 0.f};
    for (int i = tid; i < 64 * 136 / 2; i += 512) ((LAS unsigned*)(lds + G2_ST))[i] = 0u;
    u32x4 rqA[2], rkA[2], rhA[2], rvA, rqB[2], rkB[2], rhB[2], rvB; float rdecA, rdecB;
    auto rowbase = [&](int s) -> int { if (s < 4) { const int ci = dir == 0 ? s : 3 - s; return ML + b * LC + 64 * ci; } const int ci = dir == 0 ? s - 4 : 35 - s; return b * SEQ + 64 * ci; };
#define G2_LOAD(X, s) do { const int _rb = rowbase(s); _Pragma("unroll") for (int _i = 0; _i < 2; ++_i) { const int _idx = tid + 512 * _i, _r = _idx >> 4, _c = (_idx & 15) * 8; const size_t _o = (size_t)(_rb + _r) * 512 + _c; \
        rq##X[_i] = *(const u32x4*)(gq + _o); rk##X[_i] = *(const u32x4*)(gk + _o); rh##X[_i] = *(const u32x4*)(gh + ((size_t)(_rb >> 6) * 512 + (_idx >> 3)) * 64 + (_idx & 7) * 8); } \
        rv##X = *(const u32x4*)(gvt + ((size_t)(_rb >> 6) * 1024 + (tid >> 3)) * 64 + (tid & 7) * 8); \
        rdec##X = dec[(size_t)(_rb >> 6) * 512 + 16 * w + fr]; } while (0)
#define G2_STEP(X, s) do { \
        const int rb = rowbase(s); const float dk = rdec##X; \
        _Pragma("unroll") for (int i = 0; i < 2; ++i) { const int idx = tid + 512 * i, r = idx >> 4, c = (idx & 15) * 8; \
            *(LAS u32x4*)(lds + G2_Q + r * 272 + c * 2) = rq##X[i]; *(LAS u32x4*)(lds + G2_K + r * 272 + c * 2) = rk##X[i]; \
            const int s0 = (idx & 7) * 8, p1 = (s0 & 32) + 8 * ((s0 & 15) >> 2) + 4 * ((s0 >> 4) & 1); \
            *(LAS u32x2*)(lds + G2_KH + (idx >> 3) * 144 + p1 * 2) = (u32x2){rh##X[i].x, rh##X[i].y}; *(LAS u32x2*)(lds + G2_KH + (idx >> 3) * 144 + (p1 + 8) * 2) = (u32x2){rh##X[i].z, rh##X[i].w}; } \
        { const int s0 = (tid & 7) * 8, p1 = (s0 & 32) + 8 * ((s0 & 15) >> 2) + 4 * ((s0 >> 4) & 1); \
            *(LAS u32x2*)(lds + G2_VT + (tid >> 3) * 144 + p1 * 2) = (u32x2){rv##X.x, rv##X.y}; *(LAS u32x2*)(lds + G2_VT + (tid >> 3) * 144 + (p1 + 8) * 2) = (u32x2){rv##X.z, rv##X.w}; } \
        __syncthreads(); \
        if ((s) + 2 < 36) G2_LOAD(X, (s) + 2); \
        const int tt = w >> 1, vp = w & 1; \
        { \
            bf16x8 qf[4], kf[4][4]; \
            _Pragma("unroll") for (int kk = 0; kk < 4; ++kk) qf[kk] = *(const LAS bf16x8*)(lds + G2_Q + (16 * tt + fr) * 272 + (32 * kk + 8 * fq) * 2); \
            _Pragma("unroll") for (int st = 0; st < 4; ++st) _Pragma("unroll") for (int kk = 0; kk < 4; ++kk) kf[st][kk] = *(const LAS bf16x8*)(lds + G2_K + (16 * st + fr) * 272 + (32 * kk + 8 * fq) * 2); \
            __builtin_amdgcn_sched_barrier(0); \
            f32x4 at[4]; \
            _Pragma("unroll") for (int st = 0; st < 4; ++st) at[st] = (f32x4){0.f, 0.f, 0.f, 0.f}; \
            _Pragma("unroll") for (int kk = 0; kk < 4; ++kk) _Pragma("unroll") for (int st = 0; st < 4; ++st) at[st] = __builtin_amdgcn_mfma_f32_16x16x32_bf16(kf[st][kk], qf[kk], at[st], 0, 0, 0); \
            __builtin_amdgcn_sched_barrier(0); \
            bf16x8 sf[2][4], vfr[4][2], khf[2], vfo[2][2]; \
            _Pragma("unroll") for (int i = 0; i < 2; ++i) _Pragma("unroll") for (int kk = 0; kk < 4; ++kk) sf[i][kk] = *(const LAS bf16x8*)(lds + G2_ST + (16 * (2 * vp + i) + fr) * 272 + (32 * kk + 8 * fq) * 2); \
            _Pragma("unroll") for (int v2 = 0; v2 < 4; ++v2) _Pragma("unroll") for (int kk = 0; kk < 2; ++kk) vfr[v2][kk] = *(const LAS bf16x8*)(lds + G2_VT + (16 * v2 + fr) * 144 + (32 * kk + 8 * fq) * 2); \
            _Pragma("unroll") for (int kk = 0; kk < 2; ++kk) khf[kk] = *(const LAS bf16x8*)(lds + G2_KH + (16 * w + fr) * 144 + (32 * kk + 8 * fq) * 2); \
            _Pragma("unroll") for (int i = 0; i < 2; ++i) _Pragma("unroll") for (int p = 0; p < 2; ++p) vfo[i][p] = *(const LAS bf16x8*)(lds + G2_VT + (16 * (2 * vp + i) + fr) * 144 + (32 * p + 8 * fq) * 2); \
            __builtin_amdgcn_sched_barrier(0); \
            _Pragma("unroll") for (int v2 = 0; v2 < 4; ++v2) { f32x4 acc = sacc[v2] * dk; \
                _Pragma("unroll") for (int kk = 0; kk < 2; ++kk) acc = __builtin_amdgcn_mfma_f32_16x16x32_bf16(vfr[v2][kk], khf[kk], acc, 0, 0, 0); \
                sacc[v2] = acc; } \
            f32x4 oacc[2]; \
            _Pragma("unroll") for (int i = 0; i < 2; ++i) { oacc[i] = (f32x4){0.f, 0.f, 0.f, 0.f}; \
                _Pragma("unroll") for (int kk = 0; kk < 4; ++kk) oacc[i] = __builtin_amdgcn_mfma_f32_16x16x32_bf16(sf[i][kk], qf[kk], oacc[i], 0, 0, 0); } \
            bf16x8 pb[2]; \
            _Pragma("unroll") for (int st = 0; st < 4; ++st) _Pragma("unroll") for (int j = 0; j < 4; ++j) { const int sc = 16 * st + 4 * fq + j, t = 16 * tt + fr; const bool keep = dir == 0 ? (sc <= t) : (sc >= t); at[st][j] = keep ? at[st][j] : 0.f; } \
            _Pragma("unroll") for (int p = 0; p < 2; ++p) { u32x4 pw; pw.x = cvt_pk_bf16(at[2 * p][0], at[2 * p][1]); pw.y = cvt_pk_bf16(at[2 * p][2], at[2 * p][3]); \
                pw.z = cvt_pk_bf16(at[2 * p + 1][0], at[2 * p + 1][1]); pw.w = cvt_pk_bf16(at[2 * p + 1][2], at[2 * p + 1][3]); pb[p] = __builtin_bit_cast(bf16x8, pw); } \
            _Pragma("unroll") for (int i = 0; i < 2; ++i) { \
                _Pragma("unroll") for (int p = 0; p < 2; ++p) oacc[i] = __builtin_amdgcn_mfma_f32_16x16x32_bf16(vfo[i][p], pb[p], oacc[i], 0, 0, 0); \
                if ((s) >= 4 || need_ctx) { u32x2 wv; wv.x = cvt_pk_bf16(oacc[i][0], oacc[i][1]); wv.y = cvt_pk_bf16(oacc[i][2], oacc[i][3]); \
                    *(u32x2*)(od + (size_t)(rb + 16 * tt + fr) * 1024 + 16 * (2 * vp + i) + 4 * fq) = wv; } } \
        } \
        __syncthreads(); \
        _Pragma("unroll") for (int v2 = 0; v2 < 4; ++v2) _Pragma("unroll") for (int j = 0; j < 4; ++j) *(LAS bf16_t*)(lds + G2_ST + (16 * v2 + 4 * fq + j) * 272 + (16 * w + fr) * 2) = f2bf(sacc[v2][j]); \
    } while (0)
    G2_LOAD(A, 0); G2_LOAD(B, 1);
    for (int s0_ = 0; s0_ < 36; s0_ += 2) { G2_STEP(A, s0_); G2_STEP(B, s0_ + 1); }
    __syncthreads();
#undef G2_LOAD
#undef G2_STEP
}

constexpr int AT_BUF = 36864, AT_K = 0, AT_V = 18432;
template <bool SHIFT>
__device__ __forceinline__ void attn_unit(LAS unsigned char* lds, const bf16_t* qbase, int Lq, int q0, const bf16_t* kbase, const bf16_t* vtbase, int nkeys,
                                          float c2, float lam, float post_scale, const float* subln, const bf16_t* dg, bf16_t* outp, int row0) {
    const int tid = opaque_tid(), lane = tid & 63, w = __builtin_amdgcn_readfirstlane(tid >> 6), q32 = lane & 31, hi = lane >> 5;
    const int j = w >> 2, qg = w & 3;
    bf16x8 qf[4];
#pragma unroll
    for (int kk = 0; kk < 4; ++kk) qf[kk] = *(const bf16x8*)(qbase + ((size_t)j * Lq + q0 + 32 * qg + q32) * 64 + 16 * kk + 8 * hi);
    f32x16 o[4];
#pragma unroll
    for (int vt = 0; vt < 4; ++vt)
#pragma unroll
        for (int r = 0; r < 16; ++r) o[vt][r] = 0.f;
    float lsum = 0.f;
    const int nt = nkeys >> 6;
    u32x4 skA[2], svA[2];
#define AT_LOAD(sk, sv, i) do { _Pragma("unroll") for (int _c = 0; _c < 2; ++_c) { const int _idx = tid + 512 * _c; \
        sk[_c] = *(const u32x4*)(kbase + ((size_t)(_idx >> 9) * LK + 64 * (i) + ((_idx & 511) >> 3)) * 64 + (_idx & 7) * 8); \
        sv[_c] = *(const u32x4*)(vtbase + (size_t)(_idx >> 3) * LK + 64 * (i) + (_idx & 7) * 8); } } while (0)
#define AT_STORE(sk, sv, p) do { _Pragma("unroll") for (int _c = 0; _c < 2; ++_c) { const int _idx = tid + 512 * _c; \
        *(LAS u32x4*)(lds + (p) * AT_BUF + AT_K + ((_idx >> 9) * 64 + ((_idx & 511) >> 3)) * 144 + (_idx & 7) * 16) = sk[_c]; \
        *(LAS u32x4*)(lds + (p) * AT_BUF + AT_V + (_idx >> 3) * 144 + (_idx & 7) * 16) = sv[_c]; } } while (0)
#define AT_KF(kb, kk) (*(const LAS bf16x8*)(Kb + (32 * (kb) + q32) * 144 + (16 * (kk) + 8 * hi) * 2))
#define AT_VF(ks, vt) (*(const LAS bf16x8*)(Vb + (32 * (vt) + q32) * 144 + (16 * (ks) + 8 * hi) * 2))
#define AT_TILE(p) do { \
        LAS unsigned char* Kb = lds + (p) * AT_BUF + AT_K + j * (64 * 144); LAS unsigned char* Vb = lds + (p) * AT_BUF + AT_V; \
        bf16x8 kf[4], vf[4], vg[4]; \
        _Pragma("unroll") for (int kk = 0; kk < 4; ++kk) kf[kk] = AT_KF(0, kk); \
        _Pragma("unroll") for (int kb = 0; kb < 2; ++kb) { \
            _Pragma("unroll") for (int vt = 0; vt < 4; ++vt) vf[vt] = AT_VF(2 * kb, vt); \
            __builtin_amdgcn_sched_barrier(0); \
            f32x16 s; \
            _Pragma("unroll") for (int r = 0; r < 16; ++r) s[r] = 0.f; \
            _Pragma("unroll") for (int kk = 0; kk < 4; ++kk) s = __builtin_amdgcn_mfma_f32_32x32x16_bf16(kf[kk], qf[kk], s, 0, 0, 0); \
            __builtin_amdgcn_sched_barrier(0); \
            _Pragma("unroll") for (int vt = 0; vt < 4; ++vt) vg[vt] = AT_VF(2 * kb + 1, vt); \
            if (kb == 0) { _Pragma("unroll") for (int kk = 0; kk < 4; ++kk) kf[kk] = AT_KF(1, kk); } \
            __builtin_amdgcn_sched_barrier(0); \
            _Pragma("unroll") for (int r = 0; r < 16; ++r) { s[r] = __builtin_amdgcn_exp2f(SHIFT ? s[r] - c2 : s[r]); lsum += s[r]; } \
            u32x4 pw0, pw1; \
            pw0.x = cvt_pk_bf16(s[0], s[1]); pw0.y = cvt_pk_bf16(s[2], s[3]); pw0.z = cvt_pk_bf16(s[4], s[5]); pw0.w = cvt_pk_bf16(s[6], s[7]); \
            pw1.x = cvt_pk_bf16(s[8], s[9]); pw1.y = cvt_pk_bf16(s[10], s[11]); pw1.z = cvt_pk_bf16(s[12], s[13]); pw1.w = cvt_pk_bf16(s[14], s[15]); \
            const bf16x8 pb0 = __builtin_bit_cast(bf16x8, pw0), pb1 = __builtin_bit_cast(bf16x8, pw1); \
            _Pragma("unroll") for (int vt = 0; vt < 4; ++vt) o[vt] = __builtin_amdgcn_mfma_f32_32x32x16_bf16(vf[vt], pb0, o[vt], 0, 0, 0); \
            _Pragma("unroll") for (int vt = 0; vt < 4; ++vt) o[vt] = __builtin_amdgcn_mfma_f32_32x32x16_bf16(vg[vt], pb1, o[vt], 0, 0, 0); \
            __builtin_amdgcn_sched_barrier(0); \
        } } while (0)
    AT_LOAD(skA, svA, 0); AT_STORE(skA, svA, 0);
    __syncthreads();
    for (int i = 0; i < nt; i += 2) {
        AT_LOAD(skA, svA, i + 1);
        AT_TILE(0);
        AT_STORE(skA, svA, 1);
        __syncthreads();
        if (i + 2 < nt) AT_LOAD(skA, svA, i + 2);
        AT_TILE(1);
        if (i + 2 < nt) AT_STORE(skA, svA, 0);
        __syncthreads();
    }
#undef AT_TILE
#undef AT_KF
#undef AT_VF
#undef AT_LOAD
#undef AT_STORE
    lsum += __shfl_xor(lsum, 32);
    LAS float* xch = (LAS float*)lds + (size_t)qg * 4096 + lane;
    if (j == 1) {
        const float sc = lam / lsum;
#pragma unroll
        for (int vt = 0; vt < 4; ++vt)
#pragma unroll
            for (int r = 0; r < 16; ++r) xch[(vt * 16 + r) * 64] = o[vt][r] * sc;
    }
    __syncthreads();
    if (j == 0) {
        const float i0 = 1.f / lsum;
        float ss = 0.f;
#pragma unroll
        for (int vt = 0; vt < 4; ++vt)
#pragma unroll
            for (int r = 0; r < 16; ++r) { const float v = o[vt][r] * i0 - xch[(vt * 16 + r) * 64]; o[vt][r] = v; ss += v * v; }
        ss += __shfl_xor(ss, 32);
        const float rstd = rsqrtf(ss * (1.f / 128.f) + EPS) * post_scale;
        const size_t row = (size_t)row0 + 32 * qg + q32;
#pragma unroll
        for (int vt = 0; vt < 4; ++vt)
#pragma unroll
            for (int g4 = 0; g4 < 4; ++g4) {
                const int v0 = 32 * vt + 8 * g4 + 4 * hi;
                const u32x2 gz = *(const u32x2*)(dg + row * NZ + v0);
                const f32x4 sl = *(const f32x4*)(subln + v0);
                const float r0 = o[vt][4 * g4 + 0] * rstd * sl[0] * silu_f(bflo(gz.x)), r1 = o[vt][4 * g4 + 1] * rstd * sl[1] * silu_f(bfhi(gz.x));
                const float r2 = o[vt][4 * g4 + 2] * rstd * sl[2] * silu_f(bflo(gz.y)), r3 = o[vt][4 * g4 + 3] * rstd * sl[3] * silu_f(bfhi(gz.y));
                u32x2 wv; wv.x = cvt_pk_bf16(r0, r1); wv.y = cvt_pk_bf16(r2, r3);
                *(u32x2*)(outp + row * 1024 + v0) = wv;
            }
    }
    __syncthreads();
}

__device__ __forceinline__ void phase_mix(const Args& a, int l, LAS unsigned char* lds) {
    const int G = opaque_s(gridDim.x);
    unsigned char* ws = opaque_ptr(a.ws);
    const bool need_ctx = (l == 0);
    const float* scal = (const float*)(ws + OFF_SCAL) + l * 4;
    const float lam = scal[0], c2 = scal[1], post = 1.f - scal[2];
    const bf16_t* z = (const bf16_t*)(ws + OFF_Z);
    const bool big = c2 > 48.f;
#define ATTN_UNIT(...) do { if (big) attn_unit<true>(__VA_ARGS__); else attn_unit<false>(__VA_ARGS__); } while (0)
#define ATTN_LATENT(vc_) do { const int vc = (vc_), bh = vc >> 4, qb = vc & 15, b = bh >> 3, h = bh & 7; \
        ATTN_UNIT(lds, (const bf16_t*)(ws + OFF_QN) + (size_t)bh * 2 * SEQ * 64, SEQ, 128 * qb, (const bf16_t*)(ws + OFF_KN) + (size_t)bh * 2 * LK * 64, \
                  (const bf16_t*)(ws + OFF_VT) + (size_t)bh * 128 * LK, LK, c2, lam, post, inp(I_SUBLN) + l * 128, z + ZC_DG + h * 128, (bf16_t*)(ws + OFF_DIFFO) + h * 128, b * SEQ + 128 * qb); } while (0)
#define ATTN_CTX(uu_) do { const int uu = (uu_), bh = uu >> 1, qb = uu & 1, b = bh >> 3, h = bh & 7; \
        ATTN_UNIT(lds, (const bf16_t*)(ws + OFF_QNC) + (size_t)bh * 2 * LC * 64, LC, 128 * qb, (const bf16_t*)(ws + OFF_KN) + (size_t)bh * 2 * LK * 64, \
                  (const bf16_t*)(ws + OFF_VT) + (size_t)bh * 128 * LK, LC, c2, lam, post, inp(I_SUBLN) + l * 128, z + ZC_DG + h * 128, (bf16_t*)(ws + OFF_DIFFO) + h * 128, ML + b * LC + 128 * qb); } while (0)
    if (G == 256) {
        const int B_ = BID;
        if (B_ < 128) {
            gla_unit2(a, l, lds, ((B_ & 7) * 4 + (B_ >> 5)) * 4 + ((B_ >> 3) & 3));
            { const int u = 384 + B_; ATTN_LATENT((u & 7) * 64 + (u >> 3)); }
            if (need_ctx && B_ < 64) ATTN_CTX(B_);
        } else {
            for (int k = 0; k < 3; ++k) { const int u = (B_ - 128) + 128 * k; ATTN_LATENT((u & 7) * 64 + (u >> 3)); }
        }
    } else {
        for (int it = BID; it < 256; it += G) gla_unit(a, l, lds, ((it & 7) * 4 + (it >> 6)) * 8 + ((it >> 3) & 7));
        const int nun = 512 + (need_ctx ? 64 : 0);
        for (int u = BID; u < nun; u += G) { if (u < 512) ATTN_LATENT((u & 7) * 64 + (u >> 3)); else ATTN_CTX(u - 512); }
    }
#ifndef NO_POOL
    {
        const int Mrows = need_ctx ? MT : ML;
        pg8::Gemm g{(const bf16_t*)(ws + OFF_DPOOL), (const bf16_t*)(ws + OFF_POOLT + (size_t)l * SZ_POOLT), Mrows, 1024, 256, 1024, 256, 256};
        pg8::StaticOrder S; S.init(Mrows, 1024, G, BID);
        pg8::EpiPool E{(bf16_t*)(ws + OFF_POOLO), (const bf16_t*)(ws + OFF_PGATE)};
        pg8::gemm_phase<pg8::EpiPool, pg8::StaticOrder, true, true>(lds, g, S, E);
    }
#endif
}

__device__ __forceinline__ void phase_post(const Args& a, int l) {
    const int tid = opaque_tid(), lane = tid & 63, wave = tid >> 6, G = opaque_s(gridDim.x);
    const int gw = BID * 8 + wave, NGW = G * 8;
    unsigned char* ws = opaque_ptr(a.ws);
    const bf16_t* z = (const bf16_t*)(ws + OFF_Z);
    const bf16_t* of = (const bf16_t*)(ws + OFF_OF); const bf16_t* ob = of + (size_t)MT * 1024;
    bf16_t* go = (bf16_t*)(ws + OFF_GLAO);
    const int Mrows = (l == 0) ? MT : ML;
    const float* gn = inp(I_GLAN) + l * 256 + ((16 * lane) & 255);
    for (int row = gw; row < Mrows; row += NGW) {
        float x[16], y[16], gz[16];
        const size_t o = (size_t)row * 1024 + 16 * lane;
        unpack8(*(const u32x4*)(of + o), x); unpack8(*(const u32x4*)(of + o + 8), x + 8);
        unpack8(*(const u32x4*)(ob + o), y); unpack8(*(const u32x4*)(ob + o + 8), y + 8);
        unpack8(*(const u32x4*)(z + (size_t)row * NZ + ZC_GG + 16 * lane), gz); unpack8(*(const u32x4*)(z + (size_t)row * NZ + ZC_GG + 16 * lane + 8), gz + 8);
        float ss = 0.f;
#pragma unroll
        for (int e = 0; e < 16; ++e) { x[e] += y[e]; ss += x[e] * x[e]; }
        ss += __shfl_xor(ss, 1); ss += __shfl_xor(ss, 2); ss += __shfl_xor(ss, 4); ss += __shfl_xor(ss, 8);
        const float rstd = rsqrtf(ss * (1.f / 256.f) + EPS);
        float r[16];
#pragma unroll
        for (int e = 0; e < 16; ++e) r[e] = x[e] * rstd * gn[e] * silu_f(gz[e]);
        u32x4 w0, w1;
        w0.x = cvt_pk_bf16(r[0], r[1]); w0.y = cvt_pk_bf16(r[2], r[3]); w0.z = cvt_pk_bf16(r[4], r[5]); w0.w = cvt_pk_bf16(r[6], r[7]);
        w1.x = cvt_pk_bf16(r[8], r[9]); w1.y = cvt_pk_bf16(r[10], r[11]); w1.z = cvt_pk_bf16(r[12], r[13]); w1.w = cvt_pk_bf16(r[14], r[15]);
        *(u32x4*)(go + o) = w0; *(u32x4*)(go + o + 8) = w1;
    }
}

#define XB_TMO      128
#define XB_XCNT(j)  (256  + 64 * (j))
#define XB_XSUB(j)  (1280 + 64 * (j))
#define XB_XGEN(j)  (2304 + 64 * (j))
#define XB_TOP      3328
#define XB_TOPGEN   3392
#define XCD_BAR_WORDS 3456
#define XB_SPIN_CAP (1u << 18)

__device__ __forceinline__ unsigned xb_ld(unsigned* p)              { return __hip_atomic_load(p, __ATOMIC_RELAXED, __HIP_MEMORY_SCOPE_AGENT); }
__device__ __forceinline__ unsigned xb_add(unsigned* p, unsigned v) { return __hip_atomic_fetch_add(p, v, __ATOMIC_RELAXED, __HIP_MEMORY_SCOPE_AGENT); }
__device__ __forceinline__ unsigned xb_xcc_id() { return (unsigned)__builtin_amdgcn_s_getreg((3 << 11) | 20) & 0xFu; }
#define XB_SPIN(cond, bar) do { unsigned _sp = 0; while (cond) { __builtin_amdgcn_s_sleep(1); \
    if ((++_sp & 255u) == 0u) { if (xb_ld(&(bar)[XB_TMO])) break; if (_sp > XB_SPIN_CAP) { atomicAdd(&(bar)[XB_TMO], 1u); break; } } } } while (0)

struct XcdBarrier {
    unsigned* bar; unsigned x;
    volatile LAS unsigned* st;
};

__device__ __forceinline__ XcdBarrier xcd_barrier_post(unsigned* bar, volatile LAS unsigned* st) {
    XcdBarrier b; b.bar = bar; b.x = xb_xcc_id(); b.st = st;
    if (threadIdx.x == 0) (void)xb_add(&bar[XB_XCNT(b.x)], 1u);
    return b;
}
__device__ __forceinline__ void xcd_barrier_complete(unsigned* bar, unsigned x, unsigned& nloc, unsigned& nx) {
    const unsigned G = gridDim.x * gridDim.y * gridDim.z;
    unsigned sum, cnt, mine, sp = 0u;
    for (;;) {
        sum = 0u; cnt = 0u; mine = 0u;
#pragma unroll
        for (unsigned j = 0; j < 16; ++j) { const unsigned c = xb_ld(&bar[XB_XCNT(j)]); sum += c; cnt += (c > 0u) ? 1u : 0u; mine = (j == x) ? c : mine; }
        if (sum == G) break;
        __builtin_amdgcn_s_sleep(1);
        if ((++sp & 255u) == 0u) { if (xb_ld(&bar[XB_TMO])) break; if (sp > XB_SPIN_CAP) { atomicAdd(&bar[XB_TMO], 1u); break; } }
    }
    nloc = mine > 0u ? mine : 1u; nx = cnt > 0u ? cnt : 1u;
}

__device__ __forceinline__ void xcd_barrier(const XcdBarrier& b) {
    asm volatile("s_waitcnt vmcnt(0)" ::: "memory");
    __syncthreads();
    if (threadIdx.x == 0) {
        unsigned* bar = b.bar;
        __builtin_amdgcn_s_waitcnt(0);
        unsigned nloc = b.st[0], nx = b.st[1];
        if (nloc == 0u) { xcd_barrier_complete(bar, b.x, nloc, nx); b.st[0] = nloc; b.st[1] = nx; }
        const unsigned old = xb_add(&bar[XB_XSUB(b.x)], 1u);
        const unsigned gen = old / nloc;
        if (old + 1u == (gen + 1u) * nloc) {
            __builtin_amdgcn_fence(__ATOMIC_RELEASE, "agent");
            asm volatile("s_waitcnt vmcnt(0)" ::: "memory");
            const unsigned og = xb_add(&bar[XB_TOP], 1u);
            const unsigned tg = og / nx;
            if (og + 1u == (tg + 1u) * nx) xb_add(&bar[XB_TOPGEN], 1u);
            else XB_SPIN(xb_ld(&bar[XB_TOPGEN]) == tg, bar);
            __builtin_amdgcn_fence(__ATOMIC_ACQUIRE, "agent");
            xb_add(&bar[XB_XGEN(b.x)], 1u);
            asm volatile("s_waitcnt vmcnt(0)" ::: "memory");
        } else {
            XB_SPIN(xb_ld(&bar[XB_XGEN(b.x)]) == gen, bar);
            __builtin_amdgcn_fence(__ATOMIC_ACQUIRE, "agent");
            asm volatile("s_waitcnt vmcnt(0)" ::: "memory");
        }
    }
    __syncthreads();
}

#ifndef REPEAT_K
#define REPEAT_K -1
#endif
#define SEAM() do { XcdBarrier xb; xb.bar = (unsigned*)(opaque_ptr(a.ws) + OFF_BAR); xb.x = xb_xcc_id(); xb.st = (volatile LAS unsigned*)(lds + 131072 + 512); xcd_barrier(xb); } while (0)
#define REP(k) for (int rep_ = 0; rep_ < (REPEAT_K == (k) ? 2 : 1); ++rep_)
template <int l> __device__ __forceinline__ void run_layer(const Args& a, LAS unsigned char* lds) {
    constexpr int Mout = (l == 0) ? MT : ML;
    REP(0) phase_norm(a, l);
    SEAM();
    REP(1) {
        unsigned char* ws = opaque_ptr(a.ws); const int G = opaque_s(gridDim.x);
        pg8::Gemm g{(const bf16_t*)(ws + OFF_H), (const bf16_t*)(ws + OFF_WIN + (size_t)l * SZ_WIN), MT, NZ, DM, DM, DM, 0};
        pg8::EpiBf16 E{(bf16_t*)(ws + OFF_Z), NZ};
        if (l == 0) { pg8::StaticOrder S; S.init(MT, NZ, G, BID); pg8::gemm_phase<pg8::EpiBf16, pg8::StaticOrder, true, true>(lds, g, S, E);
 }
        else { pg8::CtxSkipOrder S; S.init(G, BID); pg8::gemm_phase<pg8::EpiBf16, pg8::CtxSkipOrder, true, true>(lds, g, S, E); }
    }
    SEAM();
    REP(2) phase_prep(a, l, lds);
    SEAM();
    REP(3) phase_mix(a, l, lds);
    SEAM();
    REP(4) phase_post(a, l);
    SEAM();
    REP(5) {
        unsigned char* ws = opaque_ptr(a.ws); const int G = opaque_s(gridDim.x);
        pg8::SegOrder3 S; S.base.init(Mout, DM, G, BID);
        const bf16_t* wb = (const bf16_t*)(ws + OFF_WB + (size_t)l * SZ_WB);
        pg8::Gemm g{(const bf16_t*)(ws + OFF_POOLO), wb, Mout, DM, 1024, 1024, 1024, 0,
                    (const bf16_t*)(ws + OFF_DIFFO), (const bf16_t*)(ws + OFF_GLAO), wb + (size_t)DM * 1024, wb + (size_t)2 * DM * 1024};
        pg8::EpiMerge3 E{(bf16_t*)(ws + OFF_H), (const bf16_t*)(ws + OFF_Z) + ZC_MG};
        pg8::gemm_phase<pg8::EpiMerge3, pg8::SegOrder3, true, true, 3>(lds, g, S, E);
        if (l == 0 && rep_ == 0) {
            const int rem = ((Mout / 256) * (DM / 256)) % G, bid = BID;
            if (rem == 0) { ada_items(a, lds, 1, bid, G); convert_layer_weights(a, lds, 1, bid * 8 + (int)(threadIdx.x >> 6), G * 8); }
            else if (bid >= rem) { ada_items(a, lds, 1, G - 1 - bid, G - rem); convert_layer_weights(a, lds, 1, (bid - rem) * 8 + (int)(threadIdx.x >> 6), (G - rem) * 8); }
        }
    }
    SEAM();
    REP(6) {
        unsigned char* ws = opaque_ptr(a.ws); const int G = opaque_s(gridDim.x);
        pg8::Gemm g{(const bf16_t*)(ws + OFF_H), (const bf16_t*)(ws + OFF_WOUT + (size_t)l * SZ_WOUT), Mout, DM, DM, DM, DM, 0};
        pg8::StaticOrder S; S.init(Mout, DM, G, BID);
        pg8::EpiOut E{l == 0 ? inp(I_X) : (const float*)(ws + OFF_X1), l == 0 ? inp(I_CTX) : (const float*)(ws + OFF_X1) + (size_t)ML * DM,
                      l == 0 ? (float*)(ws + OFF_X1) : arg_out(), (const float*)(ws + OFF_MOD) + (size_t)l * 5 * 6144};
        pg8::gemm_phase<pg8::EpiOut, pg8::StaticOrder, true, true>(lds, g, S, E);
    }
}

__global__ void __launch_bounds__(512, 2) hybrid_fwd(Args a) {
    extern __shared__ __attribute__((aligned(16))) unsigned char smem[];
    LAS unsigned char* lds = (LAS unsigned char*)smem;
    cg::grid_group grid = cg::this_grid();
    volatile LAS unsigned* bst = (volatile LAS unsigned*)(lds + 131072 + 512);
    if (threadIdx.x < 2) bst[threadIdx.x] = 0u;
    __syncthreads();
    (void)xcd_barrier_post((unsigned*)(a.ws + OFF_BAR), bst);
    REP(7) phase_p0(a, lds);
    grid.sync();
    run_layer<0>(a, lds);
    SEAM();
    run_layer<1>(a, lds);
}

extern "C" void kernel_launch(void* const* d_in, const int* in_sizes, int n_in, void* d_out, int out_size, void* d_ws, size_t ws_size, hipStream_t stream) {
    static int grid = 0;
    if (grid == 0) {
        if (n_in != 26 || out_size != ML * DM || ws_size < WS_END) { fprintf(stderr, "kernel_launch: expected 26 inputs, out %d, ws >= %zu; got n_in %d out %d ws %zu\n", ML * DM, (size_t)WS_END, n_in, out_size, ws_size); grid = -1; return; }
        int dev = 0, cus = 0, per_cu = 0;
        if (hipGetDevice(&dev) != hipSuccess || hipDeviceGetAttribute(&cus, hipDeviceAttributeMultiprocessorCount, dev) != hipSuccess) { grid = -1; return; }
        if (hipFuncSetAttribute((const void*)hybrid_fwd, hipFuncAttributeMaxDynamicSharedMemorySize, LDS_BYTES) != hipSuccess) { fprintf(stderr, "kernel_launch: hipFuncSetAttribute failed\n"); grid = -1; return; }
        if (hipOccupancyMaxActiveBlocksPerMultiprocessor(&per_cu, (const void*)hybrid_fwd, 512, LDS_BYTES) != hipSuccess || per_cu < 1) { fprintf(stderr, "kernel_launch: occupancy query says %d blocks per CU\n", per_cu); (void)hipGetLastError(); grid = -1; return; }
        grid = cus;
    }
    if (grid < 0) return;
    if (hipMemsetAsync((char*)d_ws + OFF_BAR, 0, BAR_BYTES, stream) != hipSuccess) { fprintf(stderr, "kernel_launch: memset of the barrier words failed\n"); return; }
    Args a{};
    for (int i = 0; i < 26; ++i) a.in[i] = (const float*)d_in[i];
    a.out = (float*)d_out; a.ws = (unsigned char*)d_ws;
    a.ph_lo = 0; a.ph_hi = NPH;
    void* args[] = {&a};
    const hipError_t e = hipLaunchCooperativeKernel((const void*)hybrid_fwd, dim3(grid), dim3(512), args, LDS_BYTES, stream);
    if (e != hipSuccess) fprintf(stderr, "kernel_launch: cooperative launch failed: %s (grid %d)\n", hipGetErrorString(e), grid);
}
```

```cpp
#include <hip/hip_runtime.h>
#include <hip/hip_cooperative_groups.h>
#include <cstdio>
#include <cstdint>
namespace cg = cooperative_groups;

#ifndef MK_N_LAUNCHES
#define MK_N_LAUNCHES 1
#endif

#define LAS __attribute__((address_space(3)))
typedef unsigned short bf16_t;
typedef short bf16x8 __attribute__((ext_vector_type(8)));
typedef float f32x4 __attribute__((ext_vector_type(4)));
typedef float f32x16 __attribute__((ext_vector_type(16)));
typedef unsigned u32x4 __attribute__((ext_vector_type(4)));
typedef unsigned u32x2 __attribute__((ext_vector_type(2)));

constexpr int DM = 2048, NB = 4, SEQ = 2048, LC = 256, ML = NB * SEQ, MC = NB * LC, MT = ML + MC;
constexpr int DIN = 15392, NZ = 15616;
constexpr int ZC_PU = 0, ZC_PG = 1024, ZC_DQ = 2048, ZC_DK = 3072, ZC_DV = 4096, ZC_DG = 5120, ZC_GQ = 6144, ZC_GK = 6656, ZC_GV = 7168, ZC_GG = 8192, ZC_LR = 9216, ZC_MG = 9472;
constexpr int LK = LC + SEQ;
constexpr float EPS = 1e-6f, LOG2E = 1.4426950408889634f;
constexpr int NPH = 15;

constexpr size_t SZ_WIN = (size_t)NZ * DM * 2, SZ_WB = (size_t)3 * DM * 1024 * 2, SZ_WOUT = (size_t)DM * DM * 2, SZ_POOLT = (size_t)4 * 256 * 256 * 2;
constexpr size_t OFF_WIN = 0;
constexpr size_t OFF_WB = OFF_WIN + 2 * SZ_WIN;
constexpr size_t OFF_WOUT = OFF_WB + 2 * SZ_WB;
constexpr size_t OFF_POOLT = OFF_WOUT + 2 * SZ_WOUT;
constexpr size_t OFF_MOD = OFF_POOLT + 2 * SZ_POOLT;
constexpr size_t OFF_SCAL = OFF_MOD + (size_t)2 * 5 * 6144 * 4;
constexpr size_t OFF_H = OFF_SCAL + 256;
constexpr size_t OFF_Z = OFF_H + (size_t)MT * DM * 2;
constexpr size_t OFF_QN = OFF_Z + (size_t)MT * NZ * 2;
constexpr size_t OFF_QNC = OFF_QN + (size_t)ML * 1024 * 2;
constexpr size_t OFF_KN = OFF_QNC + (size_t)MC * 1024 * 2;
constexpr size_t OFF_VT = OFF_KN + (size_t)MT * 1024 * 2;
constexpr size_t SZ_G = (size_t)MT * 512 * 2;
constexpr size_t OFF_GQ = OFF_VT + (size_t)MT * 1024 * 2;
constexpr size_t OFF_GK = OFF_GQ + 2 * SZ_G;
constexpr size_t OFF_GH = OFF_GK + 2 * SZ_G;
constexpr size_t OFF_DEC = OFF_GH + 2 * SZ_G;
constexpr size_t OFF_OF = OFF_DEC + (size_t)2 * 144 * 512 * 4;
constexpr size_t OFF_DPOOL = OFF_OF + 2 * (size_t)MT * 1024 * 2;
constexpr size_t OFF_POOLO = OFF_DPOOL + (size_t)MT * 1024 * 2;
constexpr size_t OFF_DIFFO = OFF_POOLO + (size_t)MT * 1024 * 2;
constexpr size_t OFF_GLAO = OFF_DIFFO + (size_t)MT * 1024 * 2;
constexpr size_t OFF_YACC = OFF_GLAO + (size_t)MT * 1024 * 2;
constexpr size_t OFF_X1 = OFF_YACC + (size_t)MT * DM * 4;
constexpr size_t OFF_PGATE = OFF_X1 + (size_t)MT * DM * 4;
constexpr size_t OFF_BAR = OFF_PGATE + (size_t)MT * 1024 * 2;
constexpr size_t BAR_BYTES = 16384;
constexpr size_t OFF_GVT = OFF_BAR + BAR_BYTES;
constexpr size_t WS_END = OFF_GVT + (size_t)MT * 1024 * 2;

constexpr int LDS_BYTES = 135168;

#define BID opaque_s((int)blockIdx.x)
#define GAS __attribute__((address_space(1)))
__device__ __forceinline__ unsigned char* opaque_ptr(unsigned char* p) { GAS unsigned char* q = (GAS unsigned char*)p; asm volatile("" : "+s"(q)); return (unsigned char*)q; }
__device__ __forceinline__ int opaque_s(int v) { asm volatile("" : "+s"(v)); return v; }
__device__ __forceinline__ int opaque_tid() { int t = threadIdx.x; asm volatile("" : "+v"(t)); return t; }
typedef float f32x2_t __attribute__((ext_vector_type(2))); typedef __bf16 bf16x2_t __attribute__((ext_vector_type(2)));
__device__ __forceinline__ unsigned cvt_pk_bf16(float lo, float hi) { f32x2_t v = {lo, hi}; bf16x2_t b = __builtin_convertvector(v, bf16x2_t); return __builtin_bit_cast(unsigned, b); }
__device__ __forceinline__ bf16_t f2bf(float f) { return (bf16_t)(cvt_pk_bf16(f, 0.f) & 0xffffu); }
__device__ __forceinline__ float bf2f(bf16_t v) { return __builtin_bit_cast(float, (unsigned)v << 16); }
__device__ __forceinline__ float bflo(unsigned u) { return __builtin_bit_cast(float, u << 16); }
__device__ __forceinline__ float bfhi(unsigned u) { return __builtin_bit_cast(float, u & 0xffff0000u); }
__device__ __forceinline__ float silu_f(float x) { return x * __builtin_amdgcn_rcpf(1.f + __expf(-x)); }
__device__ __forceinline__ float sigmoid_f(float x) { return __builtin_amdgcn_rcpf(1.f + __expf(-x)); }
__device__ __forceinline__ float logsig_f(float a) { return fminf(a, 0.f) - __logf(1.f + __expf(-fabsf(a))); }
__device__ __forceinline__ float wave_sum(float v) {
#pragma unroll
    for (int o = 1; o < 64; o <<= 1) v += __shfl_xor(v, o);
    return v;
}
__device__ __forceinline__ float wave_max(float v) {
#pragma unroll
    for (int o = 1; o < 64; o <<= 1) v = fmaxf(v, __shfl_xor(v, o));
    return v;
}
__device__ __forceinline__ void unpack8(u32x4 w, float* f) { f[0] = bflo(w.x); f[1] = bfhi(w.x); f[2] = bflo(w.y); f[3] = bfhi(w.y); f[4] = bflo(w.z); f[5] = bfhi(w.z); f[6] = bflo(w.w); f[7] = bfhi(w.w); }

namespace pg8 {
constexpr int BM = 256, BK = 64, HALF = 128, HTB = HALF * BK * 2, STAGE_BYTES = 8 * HTB, NXCD = 8, WGM = 8;
__host__ __device__ __forceinline__ int lds_byte(int r, int c) { const int st = (r >> 4) * 2 + (c >> 5), rr = r & 15, cc = c & 31, ob = rr * 64 + cc * 2; return st * 1024 + (ob ^ (((ob >> 9) & 1) << 5)); }
__host__ __device__ __forceinline__ void stage_rc(int b, int& R, int& C) { const int st = b / 1024, sb = b % 1024, swz = sb ^ (((sb >> 9) & 1) << 5); R = (st >> 1) * 16 + swz / 64; C = (st & 1) * 32 + (swz % 64) / 2; }
__host__ __device__ __forceinline__ int perm32(int rho) { const int n = rho >> 4, i = rho & 15; return 8 * (i >> 2) + 4 * n + (i & 3); }

struct Unit { int pm, pn, seg; };
struct Gemm { const bf16_t* A; const bf16_t* Bt; int M, N, K; int lda, ldb; int a_pn_off; const bf16_t* A1; const bf16_t* A2; const bf16_t* B1; const bf16_t* B2; };

struct StaticOrder {
    int nM, nN, nwg, G, c;
    __host__ __device__ void init(int M, int N, int G_, int c_) { nM = M / BM; nN = N / BM; nwg = nM * nN; G = G_; c = c_; }
    __host__ __device__ bool next(int i, Unit& u) const {
        const long L = (long)i * G + c; if (L >= nwg) return false;
        int wgid = (int)L; { const int q = nwg / NXCD, r = nwg % NXCD, xcd = wgid % NXCD, off = wgid / NXCD; wgid = (xcd < r ? xcd * (q + 1) : r * (q + 1) + (xcd - r) * q) + off; }
        const int nig = WGM * nN, gid = wgid / nig, fm = gid * WGM, gsz = (nM - fm) < WGM ? (nM - fm) : WGM;
        u.pm = fm + ((wgid % nig) % gsz); u.pn = (wgid % nig) / gsz; u.seg = 0; return true;
    }
    __device__ __forceinline__ void a_ready(const Unit&) const {}
    __device__ __forceinline__ void done(const Unit&) const {}
};

struct CtxSkipOrder {
    StaticOrder base; int nbase;
    __host__ __device__ void init(int G_, int c_) { base.init(ML, NZ, G_, c_); nbase = base.nwg; }
    __host__ __device__ bool next(int i, Unit& u) const {
        const long L = (long)i * base.G + base.c;
        if (L < nbase) return base.next(i, u);
        const int e = (int)(L - nbase); if (e >= 4 * 15) return false;
        const int j = e % 15; u.pm = 32 + e / 15; u.pn = j < 8 ? 12 + j : (j < 14 ? 18 + j : 36); u.seg = 0; return true;
    }
    __device__ __forceinline__ void a_ready(const Unit&) const {}
    __device__ __forceinline__ void done(const Unit&) const {}
};
struct SegOrder3 {
    StaticOrder base;
    __host__ __device__ bool next(int i, Unit& u) const { const int q = i / 3; if (!base.next(q, u)) return false; u.seg = i - 3 * q; return true; }
    __device__ __forceinline__ void a_ready(const Unit&) const {}
    __device__ __forceinline__ void done(const Unit&) const {}
};
struct EpiBf16 {
    static constexpr bool PERM = true, AFTER_DRAIN = false;
    bf16_t* O; int ldc;
    __device__ __forceinline__ void operator()(const f32x4 (&acc)[2][2][4][2], const Unit& u, int wr, int wc, int fr, int fq) const {
        const int row0 = u.pm * BM + wr * 64 + fr, col0 = u.pn * BM + wc * 32 + 8 * fq;
#pragma unroll
        for (int ai = 0; ai < 2; ++ai)
#pragma unroll
            for (int m = 0; m < 4; ++m) { bf16_t* rowp = O + (size_t)(row0 + ai * HALF + m * 16) * ldc + col0;
#pragma unroll
                for (int bj = 0; bj < 2; ++bj) { const f32x4 v0 = acc[ai][bj][m][0], v1 = acc[ai][bj][m][1];
                    u32x4 w; w.x = cvt_pk_bf16(v0[0], v0[1]); w.y = cvt_pk_bf16(v0[2], v0[3]); w.z = cvt_pk_bf16(v1[0], v1[1]); w.w = cvt_pk_bf16(v1[2], v1[3]);
                    *(u32x4*)(rowp + bj * HALF) = w; } }
    }
};

template <class Epi, class Sched, bool ALIGN_EPI = false, bool SP2 = false, int NSEG = 1>
__device__ __forceinline__ void gemm_phase(LAS unsigned char* lds, const Gemm g, const Sched& S, const Epi& E) {
    const int tid = opaque_tid(), wid = __builtin_amdgcn_readfirstlane(tid >> 6), lane = tid & 63, wr = wid >> 2, wc = wid & 3, fr = lane & 15, fq = lane >> 4;
    const int K = opaque_s(g.K), nt = K / BK;
    unsigned voffA[2], voffB[2];
#pragma unroll
    for (int i = 0; i < 2; ++i) { int R, C; stage_rc(tid * 16 + i * 8192, R, C); const int Rb = Epi::PERM ? ((R & ~31) + perm32(R & 31)) : R;
        voffA[i] = (unsigned)(R * g.lda + C) * 2u; voffB[i] = (unsigned)(Rb * g.ldb + C) * 2u; }
    const size_t kstep = (size_t)(BK * 2);
    const size_t hstepA = (size_t)HALF * g.lda * 2, hstepB = (size_t)HALF * g.ldb * 2;
    const size_t tstepA = 2 * hstepA, tstepB = 2 * hstepB;
    const size_t pnA = (size_t)g.a_pn_off * 2;
    const unsigned ldsw = (unsigned)wid * 1024u;
    const int aoff = lds_byte(wr * 64 + fr, fq * 8), boff = lds_byte(wc * 32 + fr, fq * 8);
#define PG8_SA(b, h) (((b) * 2 + (h)) * HTB)
#define PG8_SB(b, h) ((4 + (b) * 2 + (h)) * HTB)
#define PG8_STAGE(bufoff, gbase, voff) do { _Pragma("unroll") for (int _i = 0; _i < 2; ++_i) \
        __builtin_amdgcn_global_load_lds((const unsigned*)((const char*)(gbase) + (voff)[_i]), (LAS unsigned*)(lds + (bufoff) + ldsw + _i * 8192), 16, 0, 0); } while (0)
#define PG8_LDA(dst, b, h) do { _Pragma("unroll") for (int m = 0; m < 4; ++m) _Pragma("unroll") for (int k = 0; k < 2; ++k) dst[m][k] = *(const LAS bf16x8*)(lds + PG8_SA(b, h) + aoff + m * 2048 + k * 1024); } while (0)
#define PG8_LDB(dst, b, h) do { _Pragma("unroll") for (int n = 0; n < 2; ++n) _Pragma("unroll") for (int k = 0; k < 2; ++k) dst[n][k] = *(const LAS bf16x8*)(lds + PG8_SB(b, h) + boff + n * 2048 + k * 1024); } while (0)
#define PG8_MMA(ai, bj, At, Bt) do { __builtin_amdgcn_s_setprio(1); _Pragma("unroll") for (int m = 0; m < 4; ++m) _Pragma("unroll") for (int n = 0; n < 2; ++n) _Pragma("unroll") for (int k = 0; k < 2; ++k) \
        acc[ai][bj][m][n] = __builtin_amdgcn_mfma_f32_16x16x32_bf16(Bt[n][k], At[m][k], acc[ai][bj][m][n], 0, 0, 0); __builtin_amdgcn_s_setprio(0); } while (0)
#define PG8_WAIT_V(n) asm volatile("s_waitcnt vmcnt(" #n ")" ::: "memory")
#define PG8_WAIT_L(n) asm volatile("s_waitcnt lgkmcnt(" #n ")" ::: "memory")
#define PG8_BAR __builtin_amdgcn_s_barrier()
#define PG8_SCHED __builtin_amdgcn_sched_barrier(0)
    Unit cur, nxt; int ui = 0;
    if (!S.next(0, cur)) return;
    f32x4 acc[2][2][4][2];
#pragma unroll
    for (int a = 0; a < 2; ++a)
#pragma unroll
        for (int b = 0; b < 2; ++b)
#pragma unroll
            for (int m = 0; m < 4; ++m)
#pragma unroll
                for (int n = 0; n < 2; ++n) acc[a][b][m][n] = (f32x4){0.f, 0.f, 0.f, 0.f};
    bf16x8 At[4][2], B0[2][2], B1[2][2];
#define PG8_ASEG(u) ((const char*)(NSEG == 1 || (u).seg == 0 ? g.A : ((u).seg == 1 ? g.A1 : g.A2)))
#define PG8_BSEG(u) ((const char*)(NSEG == 1 || (u).seg == 0 ? g.Bt : ((u).seg == 1 ? g.B1 : g.B2)))
    const char* cA = PG8_ASEG(cur) + (size_t)cur.pm * tstepA + (size_t)cur.pn * pnA; const char* cB = PG8_BSEG(cur) + (size_t)cur.pn * tstepB;
    S.a_ready(cur);
    if constexpr (SP2) {
        PG8_STAGE(PG8_SB(0, 0), cB, voffB); PG8_STAGE(PG8_SB(0, 1), cB + hstepB, voffB); PG8_STAGE(PG8_SA(0, 0), cA, voffA); PG8_STAGE(PG8_SA(0, 1), cA + hstepA, voffA);
        if (wr == 1) PG8_BAR;
        PG8_WAIT_V(2); PG8_BAR;
        PG8_STAGE(PG8_SB(1, 0), cB + kstep, voffB); PG8_STAGE(PG8_SA(1, 0), cA + kstep, voffA); PG8_STAGE(PG8_SB(1, 1), cB + hstepB + kstep, voffB);
        PG8_WAIT_V(6); PG8_BAR;
    } else {
        PG8_STAGE(PG8_SB(0, 0), cB, voffB); PG8_STAGE(PG8_SA(0, 0), cA, voffA); PG8_STAGE(PG8_SB(0, 1), cB + hstepB, voffB); PG8_STAGE(PG8_SA(0, 1), cA + hstepA, voffA);
        if (wr == 1) PG8_BAR;
        PG8_WAIT_V(4); PG8_BAR;
        PG8_STAGE(PG8_SB(1, 0), cB + kstep, voffB); PG8_STAGE(PG8_SA(1, 0), cA + kstep, voffA); PG8_STAGE(PG8_SB(1, 1), cB + hstepB + kstep, voffB);
        PG8_WAIT_V(6); PG8_BAR;
    }
    for (;;) {
        const bool has_next = S.next(ui + 1, nxt);
        const char* nA = has_next ? PG8_ASEG(nxt) + (size_t)nxt.pm * tstepA + (size_t)nxt.pn * pnA : cA; const char* nB = has_next ? PG8_BSEG(nxt) + (size_t)nxt.pn * tstepB : cB;
        for (int t = 0; t < nt; t += 2) {
            const bool last = (t == nt - 2);
            const char* a1 = cA + (size_t)(t + 1) * kstep;
            const char* a2 = last ? nA : cA + (size_t)(t + 2) * kstep; const char* b2 = last ? nB : cB + (size_t)(t + 2) * kstep;
            const char* a3 = a2 + kstep; const char* b3 = b2 + kstep;
            if (last && has_next) S.a_ready(nxt);
            if constexpr (SP2) {
            PG8_LDB(B0, 0, 0); PG8_LDB(B1, 0, 1); PG8_SCHED; PG8_LDA(At, 0, 0); PG8_STAGE(PG8_SA(1, 1), a1 + hstepA, voffA);
            PG8_WAIT_V(8); PG8_WAIT_L(0); PG8_BAR; PG8_MMA(0, 0, At, B0); PG8_MMA(0, 1, At, B1); PG8_BAR; PG8_SCHED;
            PG8_LDA(At, 0, 1); PG8_STAGE(PG8_SB(0, 0), b2, voffB); PG8_STAGE(PG8_SB(0, 1), b2 + hstepB, voffB); PG8_STAGE(PG8_SA(0, 0), a2, voffA);
            PG8_WAIT_V(8); PG8_WAIT_L(0); PG8_BAR; PG8_MMA(1, 0, At, B0); PG8_MMA(1, 1, At, B1); PG8_BAR; PG8_SCHED;
            PG8_LDB(B0, 1, 0); PG8_LDB(B1, 1, 1); PG8_SCHED; PG8_LDA(At, 1, 0); PG8_STAGE(PG8_SA(0, 1), a2 + hstepA, voffA);
            PG8_WAIT_V(8); PG8_WAIT_L(0); PG8_BAR; PG8_MMA(0, 0, At, B0); PG8_MMA(0, 1, At, B1); PG8_BAR; PG8_SCHED;
            PG8_LDA(At, 1, 1); PG8_STAGE(PG8_SB(1, 0), b3, voffB); PG8_STAGE(PG8_SB(1, 1), b3 + hstepB, voffB); PG8_STAGE(PG8_SA(1, 0), a3, voffA);
            PG8_WAIT_V(8); PG8_WAIT_L(0); PG8_BAR; PG8_MMA(1, 0, At, B0); PG8_MMA(1, 1, At, B1); PG8_BAR; PG8_SCHED;
            } else {
            PG8_LDB(B0, 0, 0); PG8_SCHED; PG8_LDA(At, 0, 0); PG8_STAGE(PG8_SA(1, 1), a1 + hstepA, voffA);
            PG8_WAIT_L(8); PG8_BAR; PG8_WAIT_L(0); PG8_MMA(0, 0, At, B0); PG8_BAR; PG8_SCHED;
            PG8_LDB(B1, 0, 1); PG8_STAGE(PG8_SB(0, 0), b2, voffB);
            PG8_BAR; PG8_WAIT_L(0); PG8_MMA(0, 1, At, B1); PG8_BAR;
            PG8_LDA(At, 0, 1); PG8_STAGE(PG8_SA(0, 0), a2, voffA);
            PG8_BAR; PG8_WAIT_L(0); PG8_MMA(1, 0, At, B0); PG8_BAR; PG8_SCHED;
            PG8_STAGE(PG8_SB(0, 1), b2 + hstepB, voffB);
            PG8_WAIT_V(6); PG8_BAR; PG8_MMA(1, 1, At, B1); PG8_BAR;
            PG8_LDB(B0, 1, 0); PG8_SCHED; PG8_LDA(At, 1, 0); PG8_STAGE(PG8_SA(0, 1), a2 + hstepA, voffA);
            PG8_WAIT_L(8); PG8_BAR; PG8_WAIT_L(0); PG8_MMA(0, 0, At, B0); PG8_BAR; PG8_SCHED;
            PG8_LDB(B1, 1, 1); PG8_STAGE(PG8_SB(1, 0), b3, voffB);
            PG8_BAR; PG8_WAIT_L(0); PG8_MMA(0, 1, At, B1); PG8_BAR;
            PG8_LDA(At, 1, 1); PG8_STAGE(PG8_SA(1, 0), a3, voffA);
            PG8_BAR; PG8_WAIT_L(0); PG8_MMA(1, 0, At, B0); PG8_BAR; PG8_SCHED;
            PG8_STAGE(PG8_SB(1, 1), b3 + hstepB, voffB);
            PG8_WAIT_V(6); PG8_BAR; PG8_MMA(1, 1, At, B1); PG8_BAR;
            }
        }
        if constexpr (ALIGN_EPI) { if (wr == 0) PG8_BAR; }
        E(acc, cur, wr, wc, fr, fq); S.done(cur);
        if (!has_next) break;
        if (NSEG == 1 || cur.seg == NSEG - 1)
#pragma unroll
        for (int a = 0; a < 2; ++a)
#pragma unroll
            for (int b = 0; b < 2; ++b)
#pragma unroll
                for (int m = 0; m < 4; ++m)
#pragma unroll
                    for (int n = 0; n < 2; ++n) acc[a][b][m][n] = (f32x4){0.f, 0.f, 0.f, 0.f};
        cur = nxt; cA = nA; cB = nB; ++ui;
        if constexpr (ALIGN_EPI) { if (wr == 1) PG8_BAR; }
    }
    PG8_WAIT_V(0);
    if constexpr (!ALIGN_EPI) { if (wr == 0) PG8_BAR; }
    PG8_BAR;
#undef PG8_ASEG
#undef PG8_BSEG
#undef PG8_SA
#undef PG8_SB
#undef PG8_STAGE
#undef PG8_LDA
#undef PG8_LDB
#undef PG8_MMA
#undef PG8_WAIT_V
#undef PG8_WAIT_L
#undef PG8_BAR
#undef PG8_SCHED
}

struct EpiPool {
    static constexpr bool PERM = true, AFTER_DRAIN = false;
    bf16_t* O; const bf16_t* pgate;
    __device__ __forceinline__ void operator()(const f32x4 (&acc)[2][2][4][2], const Unit& u, int wr, int wc, int fr, int fq) const {
        const int row0 = u.pm * BM + wr * 64 + fr, col0 = u.pn * BM + wc * 32 + 8 * fq;
#pragma unroll
        for (int ai = 0; ai < 2; ++ai) {
            u32x4 gz4[4][2];
#pragma unroll
            for (int m = 0; m < 4; ++m)
#pragma unroll
                for (int bj = 0; bj < 2; ++bj) gz4[m][bj] = *(const u32x4*)(pgate + (size_t)(row0 + ai * HALF + m * 16) * 1024 + col0 + bj * HALF);
            __builtin_amdgcn_sched_barrier(0);
#pragma unroll
            for (int m = 0; m < 4; ++m)
#pragma unroll
                for (int bj = 0; bj < 2; ++bj) {
                    const int row = row0 + ai * HALF + m * 16, col = col0 + bj * HALF;
                    const u32x4 gz = gz4[m][bj];
                    const f32x4 v0 = acc[ai][bj][m][0], v1 = acc[ai][bj][m][1];
                    u32x4 w;
                    w.x = cvt_pk_bf16(v0[0] * bflo(gz.x), v0[1] * bfhi(gz.x));
                    w.y = cvt_pk_bf16(v0[2] * bflo(gz.y), v0[3] * bfhi(gz.y));
                    w.z = cvt_pk_bf16(v1[0] * bflo(gz.z), v1[1] * bfhi(gz.z));
                    w.w = cvt_pk_bf16(v1[2] * bflo(gz.w), v1[3] * bfhi(gz.w));
                    *(u32x4*)(O + (size_t)row * 1024 + col) = w;
                }
            __builtin_amdgcn_sched_barrier(0);
        }
    }
};
template <int PASS> struct EpiMerge {
    static constexpr bool PERM = true, AFTER_DRAIN = false;
    float* yacc; bf16_t* y; const bf16_t* zg;
    __device__ __forceinline__ void operator()(const f32x4 (&acc)[2][2][4][2], const Unit& u, int wr, int wc, int fr, int fq) const {
        const int row0 = u.pm * BM + wr * 64 + fr, col0 = u.pn * BM + wc * 32 + 8 * fq;
#pragma unroll
        for (int ai = 0; ai < 2; ++ai)
#pragma unroll
            for (int m = 0; m < 4; ++m)
#pragma unroll
                for (int bj = 0; bj < 2; ++bj) {
                    const int row = row0 + ai * HALF + m * 16, col = col0 + bj * HALF;
                    float gz[8]; unpack8(*(const u32x4*)(zg + (size_t)row * NZ + col), gz);
                    const f32x4 v0 = acc[ai][bj][m][0], v1 = acc[ai][bj][m][1];
                    f32x4 r0, r1;
#pragma unroll
                    for (int e = 0; e < 4; ++e) { r0[e] = v0[e] * sigmoid_f(gz[e]); r1[e] = v1[e] * sigmoid_f(gz[4 + e]); }
                    float* yp = yacc + (size_t)row * DM + col;
                    if (PASS >= 1) { r0 += *(const f32x4*)yp; r1 += *(const f32x4*)(yp + 4); }
                    if (PASS <= 1) { *(f32x4*)yp = r0; *(f32x4*)(yp + 4) = r1; }
                    else { u32x4 w; w.x = cvt_pk_bf16(r0[0], r0[1]); w.y = cvt_pk_bf16(r0[2], r0[3]); w.z = cvt_pk_bf16(r1[0], r1[1]); w.w = cvt_pk_bf16(r1[2], r1[3]);
                        *(u32x4*)(y + (size_t)row * DM + col) = w; }
                    __builtin_amdgcn_sched_barrier(0);
                }
    }
};
struct EpiMerge3 {
    static constexpr bool PERM = true, AFTER_DRAIN = false;
    bf16_t* y; const bf16_t* zg;
    __device__ __forceinline__ void operator()(f32x4 (&acc)[2][2][4][2], const Unit& u, int wr, int wc, int fr, int fq) const {
        const int row0 = u.pm * BM + wr * 64 + fr, col0 = u.pn * BM + wc * 32 + 8 * fq;
        u32x4 ga4[2][4], gb4[2][4];
#pragma unroll
        for (int b = 0; b < 5; ++b) {
            if (b < 4) {
#pragma unroll
                for (int p = 0; p < 4; ++p) { const int ai = b >> 1, m = 2 * (b & 1) + (p >> 1), bj = p & 1;
                    const bf16_t* zp = zg + (size_t)(row0 + ai * HALF + m * 16) * NZ + col0 + bj * HALF + u.seg * 2048;
                    ga4[b & 1][p] = *(const u32x4*)zp; gb4[b & 1][p] = (u.seg < 2) ? *(const u32x4*)(zp + 2048) : (u32x4){0u, 0u, 0u, 0u}; }
            }
            __builtin_amdgcn_sched_barrier(0);
            if (b >= 1) {
                const int c = b - 1;
#pragma unroll
                for (int p = 0; p < 4; ++p) { const int ai = c >> 1, m = 2 * (c & 1) + (p >> 1), bj = p & 1;
                    const int row = row0 + ai * HALF + m * 16, col = col0 + bj * HALF;
                    float ga[8]; unpack8(ga4[c & 1][p], ga);
                    if (u.seg < 2) {
                        float gb[8]; unpack8(gb4[c & 1][p], gb);
#pragma unroll
                        for (int e = 0; e < 8; ++e) { const float ea = __expf(-fminf(fmaxf(ga[e], -30.f), 30.f)), eb = __expf(-fminf(fmaxf(gb[e], -30.f), 30.f));
                            const float ratio = (1.f + eb) * __builtin_amdgcn_rcpf(1.f + ea); acc[ai][bj][m][e >> 2][e & 3] *= ratio; }
                    } else {
                        float r[8];
#pragma unroll
                        for (int e = 0; e < 8; ++e) r[e] = acc[ai][bj][m][e >> 2][e & 3] * __builtin_amdgcn_rcpf(1.f + __expf(-fminf(fmaxf(ga[e], -30.f), 30.f)));
                        u32x4 w; w.x = cvt_pk_bf16(r[0], r[1]); w.y = cvt_pk_bf16(r[2], r[3]); w.z = cvt_pk_bf16(r[4], r[5]); w.w = cvt_pk_bf16(r[6], r[7]);
                        *(u32x4*)(y + (size_t)row * DM + col) = w;
                    }
                }
                __builtin_amdgcn_sched_barrier(0);
            }
        }
    }
};
struct EpiOut {
    static constexpr bool PERM = true, AFTER_DRAIN = false;
    const float* xlat; const float* xctx; float* xnew; const float* mod;
    __device__ __forceinline__ void operator()(const f32x4 (&acc)[2][2][4][2], const Unit& u, int wr, int wc, int fr, int fq) const {
        const int row0 = u.pm * BM + wr * 64 + fr, col0 = u.pn * BM + wc * 32 + 8 * fq;
        const int tile_row = u.pm * BM; const int mr = tile_row < ML ? tile_row / SEQ : 4;
        const float* xo = tile_row < ML ? xlat : (xctx - (size_t)ML * DM);
        const float* gm = mod + mr * 6144 + 4096;
        f32x4 g0[2], g1[2];
#pragma unroll
        for (int bj = 0; bj < 2; ++bj) { g0[bj] = *(const f32x4*)(gm + col0 + bj * HALF); g1[bj] = *(const f32x4*)(gm + col0 + bj * HALF + 4); }
        f32x4 x0[2][4], x1[2][4];
#pragma unroll
        for (int b = 0; b < 5; ++b) {
            if (b < 4) {
#pragma unroll
                for (int p = 0; p < 4; ++p) { const int ai = b >> 1, m = 2 * (b & 1) + (p >> 1), bj = p & 1;
                    const float* xp = xo + (size_t)(row0 + ai * HALF + m * 16) * DM + col0 + bj * HALF; x0[b & 1][p] = *(const f32x4*)xp; x1[b & 1][p] = *(const f32x4*)(xp + 4); }
            }
            __builtin_amdgcn_sched_barrier(0);
            if (b >= 1) {
                const int c = b - 1;
#pragma unroll
                for (int p = 0; p < 4; ++p) { const int ai = c >> 1, m = 2 * (c & 1) + (p >> 1), bj = p & 1;
                    float* op = xnew + (size_t)(row0 + ai * HALF + m * 16) * DM + col0 + bj * HALF;
                    *(f32x4*)op = x0[c & 1][p] + g0[bj] * acc[ai][bj][m][0]; *(f32x4*)(op + 4) = x1[c & 1][p] + g1[bj] * acc[ai][bj][m][1]; }
                __builtin_amdgcn_sched_barrier(0);
            }
        }
    }
};
}

struct Args { const float* in[26]; float* out; unsigned char* ws; int ph_lo, ph_hi; };
enum { I_X = 0, I_C, I_CTX, I_CCTX, I_NORMG, I_WADA, I_BADA, I_WIN, I_POOLW, I_POOLS, I_QNORM, I_KNORM, I_LQ1, I_LK1, I_LQ2, I_LK2, I_SUBLN, I_WGF, I_BGF, I_WGB, I_BGB, I_GLAN, I_WBP, I_WBD, I_WBG, I_WOUT };

__device__ __forceinline__ const float* inp(int i) { const float* const volatile __attribute__((address_space(4)))* kp = (const float* const volatile __attribute__((address_space(4)))*)__builtin_amdgcn_kernarg_segment_ptr(); const GAS float* q = (const GAS float*)kp[i]; asm volatile("" : "+s"(q)); return (const float*)q; }
__device__ __forceinline__ float* arg_out() { float* const volatile __attribute__((address_space(4)))* kp = (float* const volatile __attribute__((address_space(4)))*)__builtin_amdgcn_kernarg_segment_ptr(); GAS float* q = (GAS float*)kp[26]; asm volatile("" : "+s"(q)); return (float*)q; }
__device__ __forceinline__ void transpose_item(const float* W, int K, int N, bf16_t* WT, int row_off, LAS float* scr, int kb, int nb, int lane) {
    const int k0 = 64 * kb, n0 = 32 * nb;
    float tv[32];
#pragma unroll
    for (int i = 0; i < 32; ++i) { const int kk = 2 * i + (lane >> 5); tv[i] = __builtin_nontemporal_load(W + (size_t)(k0 + kk) * N + n0 + (lane & 31)); }
#pragma unroll
    for (int i = 0; i < 32; ++i) { const int kk = 2 * i + (lane >> 5); scr[kk * 33 + (lane & 31)] = tv[i]; }
    asm volatile("s_waitcnt lgkmcnt(0)" ::: "memory");
    const int c = lane & 7;
#pragma unroll
    for (int j = 0; j < 4; ++j) { const int n = (lane >> 3) + 8 * j; const LAS float* s = scr + (8 * c) * 33 + n;
        u32x4 o; o.x = cvt_pk_bf16(s[0 * 33], s[1 * 33]); o.y = cvt_pk_bf16(s[2 * 33], s[3 * 33]); o.z = cvt_pk_bf16(s[4 * 33], s[5 * 33]); o.w = cvt_pk_bf16(s[6 * 33], s[7 * 33]);
        *(u32x4*)(WT + (size_t)(row_off + n0 + n) * K + k0 + 8 * c) = o; }
    asm volatile("s_waitcnt lgkmcnt(0)" ::: "memory");
}

__device__ __forceinline__ void ada_items(const Args& a, LAS unsigned char* lds, int l, int bidx, int nb) {
    const int tid = opaque_tid(), lane = tid & 63, wave = __builtin_amdgcn_readfirstlane(tid >> 6);
    unsigned char* ws = opaque_ptr(a.ws);
    LAS float* sc = (LAS float*)(lds + 69632);
    LAS float* part = (LAS float*)(lds + 69632 + 40960);
    if (bidx < 96) {
        for (int i = tid; i < 5 * 2048; i += 512) { const int r = i >> 11, k = i & 2047; const float v = r < 4 ? inp(I_C)[r * 2048 + k] : inp(I_CCTX)[k]; sc[i] = silu_f(v); }
        __syncthreads();
    }
    for (int it = bidx; it < 96; it += nb) {
        const int cgp = it, col = cgp * 64 + lane;
        const float* W = inp(I_WADA) + (size_t)l * 2048 * 6144 + col;
        float acc[5] = {0.f, 0.f, 0.f, 0.f, 0.f};
#pragma unroll 32
        for (int kk = 0; kk < 256; ++kk) { const int k = wave * 256 + kk; const float wv = __builtin_nontemporal_load(W + (size_t)k * 6144);
#pragma unroll
            for (int r = 0; r < 5; ++r) acc[r] += sc[r * 2048 + k] * wv; }
#pragma unroll
        for (int r = 0; r < 5; ++r) part[(wave * 5 + r) * 64 + lane] = acc[r];
        __syncthreads();
        if (tid < 320) { const int r = tid >> 6, ln = tid & 63; float s2 = inp(I_BADA)[l * 6144 + cgp * 64 + ln];
#pragma unroll
            for (int w = 0; w < 8; ++w) s2 += part[(w * 5 + r) * 64 + ln];
            ((float*)(ws + OFF_MOD))[(l * 5 + r) * 6144 + cgp * 64 + ln] = s2; }
        __syncthreads();
    }
}

__device__ __forceinline__ void convert_layer_weights(const Args& a, LAS unsigned char* lds, int l, int widx, int nw) {
    const int lane = opaque_tid() & 63, wave = __builtin_amdgcn_readfirstlane((int)threadIdx.x >> 6);
    unsigned char* ws = opaque_ptr(a.ws);
    LAS float* scr = (LAS float*)(lds + wave * 8704);
    constexpr int I_IN = 32 * 481, I_B = 16 * 64, I_O = 32 * 64, I_P = 4 * 32, PER_L = I_IN + 3 * I_B + I_O + I_P;
    for (int it = widx; it < PER_L; it += nw) {
        int r = it;
        if (r < I_IN) { const int kb = r / 481, nb = r % 481;
            transpose_item(inp(I_WIN) + (size_t)l * DM * DIN, DM, DIN, (bf16_t*)(ws + OFF_WIN + (size_t)l * SZ_WIN), nb >= 289 ? 224 : 0, scr, kb, nb, lane); continue; }
        r -= I_IN;
        if (r < 3 * I_B) { const int br = r / I_B, rr = r % I_B; const float* W = (br == 0 ? inp(I_WBP) : br == 1 ? inp(I_WBD) : inp(I_WBG)) + (size_t)l * 1024 * DM;
            transpose_item(W, 1024, DM, (bf16_t*)(ws + OFF_WB + (size_t)l * SZ_WB + (size_t)br * DM * 1024 * 2), 0, scr, rr / 64, rr % 64, lane); continue; }
        r -= 3 * I_B;
        if (r < I_O) { transpose_item(inp(I_WOUT) + (size_t)l * DM * DM, DM, DM, (bf16_t*)(ws + OFF_WOUT + (size_t)l * SZ_WOUT), 0, scr, r / 64, r % 64, lane); continue; }
        r -= I_O;
        { const int g = r / 32, rr = r % 32;
          transpose_item(inp(I_POOLW) + (size_t)(l * 4 + g) * 65536, 256, 256, (bf16_t*)(ws + OFF_POOLT + (size_t)l * SZ_POOLT + (size_t)g * 65536 * 2), 0, scr, rr / 8, rr % 8, lane); }
    }
}

__device__ __forceinline__ void phase_p0(const Args& a, LAS unsigned char* lds) {
    const int tid = opaque_tid(), lane = tid & 63, wave = __builtin_amdgcn_readfirstlane(tid >> 6), G = opaque_s(gridDim.x);
    unsigned char* ws = opaque_ptr(a.ws);
    ada_items(a, lds, 0, BID, G);
    if (BID == G - 1 && wave == 0) {
        for (int l = 0; l < 2; ++l) {
            const float s1 = wave_sum(inp(I_LQ1)[l * 64 + lane] * inp(I_LK1)[l * 64 + lane]);
            const float s2 = wave_sum(inp(I_LQ2)[l * 64 + lane] * inp(I_LK2)[l * 64 + lane]);
            const float mq = wave_max(fabsf(inp(I_QNORM)[l * 64 + lane])), mk = wave_max(fabsf(inp(I_KNORM)[l * 64 + lane]));
            const float lam_init = 0.8f - 0.6f * expf(-0.3f * (float)l);
            if (lane == 0) { float* sp = (float*)(ws + OFF_SCAL) + l * 4; sp[0] = expf(s1) - expf(s2) + lam_init; sp[1] = 8.f * LOG2E * mq * mk; sp[2] = lam_init; sp[3] = 0.f; }
        }
    }
    {
        const int nper = 224 * 2048 * 2 / 16;
        for (int i = BID * 512 + tid; i < 2 * nper; i += G * 512) { const int l = i / nper, j = i % nper;
            *(u32x4*)(ws + OFF_WIN + (size_t)l * SZ_WIN + (size_t)9248 * DM * 2 + (size_t)j * 16) = (u32x4){0u, 0u, 0u, 0u}; }
    }
    convert_layer_weights(a, lds, 0, BID * 8 + wave, G * 8);
}

__device__ __forceinline__ void phase_norm(const Args& a, int l) {
    const int tid = opaque_tid(), lane = tid & 63, wave = tid >> 6, G = opaque_s(gridDim.x);
    const int gw = BID * 8 + wave, NGW = G * 8;
    const float* mod = (const float*)(opaque_ptr(a.ws) + OFF_MOD) + (size_t)l * 5 * 6144;
    const float* x1 = (const float*)(opaque_ptr(a.ws) + OFF_X1);
    bf16_t* h = (bf16_t*)(opaque_ptr(a.ws) + OFF_H);
    const float* ng = inp(I_NORMG) + l * DM;
    for (int row = gw; row < MT; row += NGW) {
        const float* src = (l == 0) ? (row < ML ? inp(I_X) + (size_t)row * DM : inp(I_CTX) + (size_t)(row - ML) * DM) : x1 + (size_t)row * DM;
        const int mr = row < ML ? row / SEQ : 4;
        const float* md = mod + mr * 6144;
        f32x4 v[8]; float ss = 0.f;
#pragma unroll
        for (int j = 0; j < 8; ++j) { v[j] = *(const f32x4*)(src + 4 * lane + 256 * j); ss += (v[j][0] * v[j][0] + v[j][1] * v[j][1]) + (v[j][2] * v[j][2] + v[j][3] * v[j][3]); }
        ss = wave_sum(ss);
        const float rstd = rsqrtf(ss * (1.f / DM) + EPS);
#pragma unroll
        for (int j = 0; j < 8; ++j) { const int idx = 4 * lane + 256 * j;
            const f32x4 gg = *(const f32x4*)(ng + idx), sc = *(const f32x4*)(md + 2048 + idx), sh = *(const f32x4*)(md + idx);
            f32x4 o;
#pragma unroll
            for (int e = 0; e < 4; ++e) o[e] = v[j][e] * rstd * gg[e] * (1.f + sc[e]) + sh[e];
            u32x2 w; w.x = cvt_pk_bf16(o[0], o[1]); w.y = cvt_pk_bf16(o[2], o[3]);
            *(u32x2*)(h + (size_t)row * DM + idx) = w; }
    }
}

__device__ __forceinline__ int vt_pos(int key) { const int k = key & 15; return (key & ~15) | (((k >> 2) & 1) << 3) | (k & 3) | (((k >> 3) & 1) << 2); }

__device__ __forceinline__ void phase_prep(const Args& a, int l, LAS unsigned char* lds) {
    const int tid = opaque_tid(), lane = tid & 63, wave = tid >> 6, G = opaque_s(gridDim.x);
    unsigned char* ws = opaque_ptr(a.ws);
    const bf16_t* z = (const bf16_t*)(ws + OFF_Z);
    const bool need_ctx = (l == 0);
    for (int it = BID; it < 1440; it += G) {
        if (it < 576) {
            const int c = it >> 2, cgp = it & 3, rb = 64 * c;
            LAS float* lrs = (LAS float*)lds;
            LAS float* segs = (LAS float*)(lds + 8192);
            for (int i = tid; i < 64 * 32; i += 512) { const int r = i >> 5, cc = i & 31; lrs[i] = bf2f(z[(size_t)(rb + r) * NZ + ZC_LR + cc]); }
            __syncthreads();
            const int seg = tid >> 6, cp = tid & 63, ch = cgp * 128 + 2 * cp;
            typedef float f32x2v __attribute__((ext_vector_type(2)));
            const float* wgf = inp(I_WGF) + (size_t)l * 16 * 512 + ch; const float* wgb = inp(I_WGB) + (size_t)l * 16 * 512 + ch;
            f32x2v wf[16], wb[16];
#pragma unroll
            for (int r = 0; r < 16; ++r) { wf[r] = *(const f32x2v*)(wgf + r * 512); wb[r] = *(const f32x2v*)(wgb + r * 512); }
            const f32x2v bfv = *(const f32x2v*)(inp(I_BGF) + l * 512 + ch), bbv = *(const f32x2v*)(inp(I_BGB) + l * 512 + ch);
            f32x2v gf[8], gb[8]; f32x2v sf = {0.f, 0.f}, sb = {0.f, 0.f};
#pragma unroll
            for (int i = 0; i < 8; ++i) { const int t = seg * 8 + i; f32x2v af = bfv, ab = bbv;
#pragma unroll
                for (int r4 = 0; r4 < 4; ++r4) { const f32x4 lf = *(const LAS f32x4*)(lrs + t * 32 + 4 * r4), lb = *(const LAS f32x4*)(lrs + t * 32 + 16 + 4 * r4);
#pragma unroll
                    for (int e = 0; e < 4; ++e) { af += lf[e] * wf[4 * r4 + e]; ab += lb[e] * wb[4 * r4 + e]; } }
                gf[i].x = logsig_f(af.x) * (1.f / 16.f); gf[i].y = logsig_f(af.y) * (1.f / 16.f);
                gb[i].x = logsig_f(ab.x) * (1.f / 16.f); gb[i].y = logsig_f(ab.y) * (1.f / 16.f); sf += gf[i]; sb += gb[i]; }
            *(LAS f32x2v*)(segs + seg * 128 + 2 * cp) = sf; *(LAS f32x2v*)(segs + 1024 + seg * 128 + 2 * cp) = sb;
            __syncthreads();
            f32x2v pf = {0.f, 0.f}, pb = {0.f, 0.f}, totf = {0.f, 0.f}, totb = {0.f, 0.f};
#pragma unroll
            for (int s2 = 0; s2 < 8; ++s2) { const f32x2v vf = *(const LAS f32x2v*)(segs + s2 * 128 + 2 * cp), vb = *(const LAS f32x2v*)(segs + 1024 + s2 * 128 + 2 * cp);
                totf += vf; totb += vb; if (s2 < seg) { pf += vf; pb += vb; } }
            unsigned* gq0 = (unsigned*)(ws + OFF_GQ), *gq1 = (unsigned*)(ws + OFF_GQ + SZ_G);
            unsigned* gk0 = (unsigned*)(ws + OFF_GK), *gk1 = (unsigned*)(ws + OFF_GK + SZ_G);
            bf16_t* gh0 = (bf16_t*)(ws + OFF_GH), *gh1 = (bf16_t*)(ws + OFF_GH + SZ_G);
            f32x2v h0[8], h1[8];
#pragma unroll
            for (int i = 0; i < 8; ++i) { const int t = seg * 8 + i;
                pf += gf[i]; const f32x2v bs = totb - pb; pb += gb[i];
                const size_t row = rb + t;
                const unsigned qw = *(const unsigned*)(z + row * NZ + ZC_GQ + ch), kw = *(const unsigned*)(z + row * NZ + ZC_GK + ch);
                const float q0 = bflo(qw) * 0.08838834764831845f, q1 = bfhi(qw) * 0.08838834764831845f, k0 = bflo(kw), k1 = bfhi(kw);
                const size_t o = (row * 512 + ch) >> 1;
                gq0[o] = cvt_pk_bf16(q0 * __expf(pf.x), q1 * __expf(pf.y)); gk0[o] = cvt_pk_bf16(k0 * __expf(-pf.x), k1 * __expf(-pf.y));
                gq1[o] = cvt_pk_bf16(q0 * __expf(bs.x), q1 * __expf(bs.y)); gk1[o] = cvt_pk_bf16(k0 * __expf(-bs.x), k1 * __expf(-bs.y));
                h0[i].x = k0 * __expf(totf.x - pf.x); h0[i].y = k1 * __expf(totf.y - pf.y);
                h1[i].x = k0 * __expf(totb.x - bs.x); h1[i].y = k1 * __expf(totb.y - bs.y); }
            {
#pragma unroll
                for (int cc = 0; cc < 2; ++cc) { u32x4 w0, w1;
                    w0.x = cvt_pk_bf16(h0[0][cc], h0[1][cc]); w0.y = cvt_pk_bf16(h0[2][cc], h0[3][cc]); w0.z = cvt_pk_bf16(h0[4][cc], h0[5][cc]); w0.w = cvt_pk_bf16(h0[6][cc], h0[7][cc]);
                    w1.x = cvt_pk_bf16(h1[0][cc], h1[1][cc]); w1.y = cvt_pk_bf16(h1[2][cc], h1[3][cc]); w1.z = cvt_pk_bf16(h1[4][cc], h1[5][cc]); w1.w = cvt_pk_bf16(h1[6][cc], h1[7][cc]);
                    const size_t oh = ((size_t)c * 512 + ch + cc) * 64 + seg * 8;
                    *(u32x4*)(gh0 + oh) = w0; *(u32x4*)(gh1 + oh) = w1; } }
            if (seg == 0) { float* dec = (float*)(ws + OFF_DEC);
                *(f32x2v*)(dec + (size_t)c * 512 + ch) = (f32x2v){__expf(totf.x), __expf(totf.y)}; *(f32x2v*)(dec + (size_t)(144 + c) * 512 + ch) = (f32x2v){__expf(totb.x), __expf(totb.y)}; }
            __syncthreads();
        } else if (it < 864) {
            const int rb = 32 * (it - 576); if (!need_ctx && rb >= ML) continue;
            const int seq0 = rb < ML ? (rb / SEQ) * SEQ : ML + ((rb - ML) / LC) * LC; const int L = rb < ML ? SEQ : LC;
            const int ts = rb - seq0;
            bf16_t* dp = (bf16_t*)(ws + OFF_DPOOL); bf16_t* pgt = (bf16_t*)(ws + OFF_PGATE);
#pragma unroll
            for (int i = 0; i < 12; ++i) { const int idx = tid + 512 * i, rr = idx >> 7, c8 = (idx & 127) * 8, p = ts - 8 + rr;
                if (p >= 0 && p < L) *(LAS u32x4*)(lds + rr * 2048 + c8 * 2) = *(const u32x4*)(z + (size_t)(seq0 + p) * NZ + ZC_PU + c8); }
            __syncthreads();
            const int ch8 = 8 * (tid & 127), tg = tid >> 7, hw = 1 << (ch8 >> 8);
            const int tl0 = ts + 8 * tg;
            float psc[8];
            { const float* pp = inp(I_POOLS) + l * 1024 + ch8; const f32x4 p0 = *(const f32x4*)pp, p1 = *(const f32x4*)(pp + 4);
#pragma unroll
              for (int e = 0; e < 4; ++e) { psc[e] = p0[e]; psc[4 + e] = p1[e]; } }
            u32x4 pgw[8];
#pragma unroll
            for (int t = 0; t < 8; ++t) pgw[t] = *(const u32x4*)(z + (size_t)(seq0 + tl0 + t) * NZ + ZC_PG + ch8);
            const LAS unsigned char* lc = lds + ch8 * 2 - (ts - 8) * 2048;
            float sm[8] = {0.f, 0.f, 0.f, 0.f, 0.f, 0.f, 0.f, 0.f};
            { const int lo = max(tl0 - hw, 0), hi = min(tl0 + hw, L);
              for (int p = lo; p < hi; ++p) { float u[8]; unpack8(*(const LAS u32x4*)(lc + p * 2048), u);
#pragma unroll
                  for (int e = 0; e < 8; ++e) sm[e] += u[e]; } }
#pragma unroll
            for (int t = 0; t < 8; ++t) { const int tl = tl0 + t; const int lo = max(tl - hw, 0), hi = min(tl + hw, L);
                const float rc = __builtin_amdgcn_rcpf((float)(hi - lo));
                float cur[8], pgv[8], ua[8], ur[8];
                unpack8(*(const LAS u32x4*)(lc + tl * 2048), cur); unpack8(pgw[t], pgv);
                unpack8(*(const LAS u32x4*)(lc + min(tl + hw, L - 1) * 2048), ua); unpack8(*(const LAS u32x4*)(lc + max(tl - hw, 0) * 2048), ur);
                const float ma = (tl + hw < L) ? 1.f : 0.f, mr = (tl - hw >= 0) ? 1.f : 0.f;
                u32x4 wd, wg;
                wd.x = cvt_pk_bf16(sm[0] * rc - cur[0], sm[1] * rc - cur[1]); wd.y = cvt_pk_bf16(sm[2] * rc - cur[2], sm[3] * rc - cur[3]);
                wd.z = cvt_pk_bf16(sm[4] * rc - cur[4], sm[5] * rc - cur[5]); wd.w = cvt_pk_bf16(sm[6] * rc - cur[6], sm[7] * rc - cur[7]);
                wg.x = cvt_pk_bf16(psc[0] * silu_f(pgv[0]), psc[1] * silu_f(pgv[1])); wg.y = cvt_pk_bf16(psc[2] * silu_f(pgv[2]), psc[3] * silu_f(pgv[3]));
                wg.z = cvt_pk_bf16(psc[4] * silu_f(pgv[4]), psc[5] * silu_f(pgv[5])); wg.w = cvt_pk_bf16(psc[6] * silu_f(pgv[6]), psc[7] * silu_f(pgv[7]));
                const size_t o = (size_t)(seq0 + tl) * 1024 + ch8;
                *(u32x4*)(dp + o) = wd; *(u32x4*)(pgt + o) = wg;
#pragma unroll
                for (int e = 0; e < 8; ++e) sm[e] += ma * ua[e] - mr * ur[e]; }
            __syncthreads();
        } else {
            const int vi = it - 864, isg = vi >= 288, vj = isg ? vi - 288 : vi, c = vj >> 1, hv = vj & 1, rb = 64 * c;
            int b, key0; if (rb < ML) { b = rb >> 11; key0 = LC + (rb & 2047); } else { b = (rb - ML) >> 8; key0 = (rb - ML) & 255; }
            bf16_t* vT = (bf16_t*)(ws + OFF_VT); bf16_t* gvT = (bf16_t*)(ws + OFF_GVT);
#pragma unroll
            for (int i = 0; i < 8; ++i) { const int idx = tid + 512 * i, key = idx & 63, c8 = (idx >> 6) * 8;
                const u32x4 w = *(const u32x4*)(z + (size_t)(rb + key) * NZ + (isg ? ZC_GV : ZC_DV) + hv * 512 + c8);
                const unsigned ww[4] = {w.x, w.y, w.z, w.w}; const int pos = isg ? key : vt_pos(key);
#pragma unroll
                for (int e = 0; e < 8; ++e) *(LAS bf16_t*)(lds + (c8 + e) * 144 + pos * 2) = (bf16_t)((e & 1) ? (ww[e >> 1] >> 16) : (ww[e >> 1] & 0xffffu)); }
            __syncthreads();
#pragma unroll
            for (int i = 0; i < 8; ++i) { const int idx = tid + 512 * i, col = idx >> 3, k8 = idx & 7, colg = hv * 512 + col, h = colg >> 7, v = colg & 127;
                bf16_t* dst = isg ? gvT + ((size_t)c * 1024 + colg) * 64 + k8 * 8 : vT + ((size_t)(b * 8 + h) * 128 + v) * LK + key0 + k8 * 8;
                *(u32x4*)dst = *(const LAS u32x4*)(lds + col * 144 + k8 * 16); }
            __syncthreads();
        }
    }
    {
        const int gw = BID * 8 + wave, NGW = G * 8;
        bf16_t* qn = (bf16_t*)(ws + OFF_QN); bf16_t* qnc = (bf16_t*)(ws + OFF_QNC); bf16_t* kn = (bf16_t*)(ws + OFF_KN);
        u32x4 cw0 = {0u, 0u, 0u, 0u}, cw1 = {0u, 0u, 0u, 0u};
        if (gw < MT * 2) { const bf16_t* src0 = z + (size_t)(gw >> 1) * NZ + ((gw & 1) == 0 ? ZC_DQ : ZC_DK) + 16 * lane; cw0 = *(const u32x4*)src0; cw1 = *(const u32x4*)(src0 + 8); }
        for (int it = gw; it < MT * 2; it += NGW) {
            const int row = it >> 1, which = it & 1;
            const u32x4 xw0 = cw0, xw1 = cw1;
            { const int nit = it + NGW; if (nit < MT * 2) { const bf16_t* srcn = z + (size_t)(nit >> 1) * NZ + ((nit & 1) == 0 ? ZC_DQ : ZC_DK) + 16 * lane; cw0 = *(const u32x4*)srcn; cw1 = *(const u32x4*)(srcn + 8); } }
            const bool isctx = row >= ML; int b, t; if (!isctx) { b = row >> 11; t = row & 2047; } else { b = (row - ML) >> 8; t = (row - ML) & 255; }
            {
                if (which == 0 && isctx && !need_ctx) continue;
                float x[16];
                unpack8(xw0, x); unpack8(xw1, x + 8);
                float ss = 0.f;
#pragma unroll
                for (int e = 0; e < 16; ++e) ss += x[e] * x[e];
                ss += __shfl_xor(ss, 1); ss += __shfl_xor(ss, 2);
                const float rstd = rsqrtf(ss * (1.f / 64.f) + EPS);
                const int m = lane & 3, sh = lane >> 2, h = sh >> 1, j = sh & 1;
                const float* gain = (which == 0 ? inp(I_QNORM) : inp(I_KNORM)) + l * 64 + 16 * m;
                float y[16];
#pragma unroll
                for (int e = 0; e < 16; ++e) y[e] = x[e] * rstd * gain[e];
                if (!isctx) {
                    const float posf = (float)((m & 1) ? (t & 63) : (t >> 6));
#pragma unroll
                    for (int e = 0; e < 16; ++e) { const float yp = __shfl_xor(y[e], 2);
                        const float ang = posf * exp2f(-(float)e * 0.8304820237218405f);
                        const float cs = __cosf(ang), sn = __sinf(ang);
                        y[e] = (m < 2) ? (y[e] * cs - yp * sn) : (y[e] * cs + yp * sn); }
                }
                bf16_t* dst;
                if (which == 0) {
#pragma unroll
                    for (int e = 0; e < 16; ++e) y[e] *= 0.125f * LOG2E;
                    dst = isctx ? qnc + (((size_t)(b * 8 + h) * 2 + j) * LC + t) * 64 + 16 * m : qn + (((size_t)(b * 8 + h) * 2 + j) * SEQ + t) * 64 + 16 * m;
                } else dst = kn + (((size_t)(b * 8 + h) * 2 + j) * LK + (isctx ? t : LC + t)) * 64 + 16 * m;
                u32x4 w0, w1;
                w0.x = cvt_pk_bf16(y[0], y[1]); w0.y = cvt_pk_bf16(y[2], y[3]); w0.z = cvt_pk_bf16(y[4], y[5]); w0.w = cvt_pk_bf16(y[6], y[7]);
                w1.x = cvt_pk_bf16(y[8], y[9]); w1.y = cvt_pk_bf16(y[10], y[11]); w1.z = cvt_pk_bf16(y[12], y[13]); w1.w = cvt_pk_bf16(y[14], y[15]);
                *(u32x4*)dst = w0; *(u32x4*)(dst + 8) = w1;
            }
        }
    }
}

constexpr int GL_Q = 0, GL_K = 17408, GL_KH = 34816, GL_VT = 53248, GL_ATT = 57856, GL_ST = 67072;
__device__ __forceinline__ void gla_unit(const Args& a, int l, LAS unsigned char* lds, int item) {
    const int tid = opaque_tid(), lane = tid & 63, w = __builtin_amdgcn_readfirstlane(tid >> 6);
    const int vs = item & 7, dir = (item >> 3) & 1, h = (item >> 4) & 3, b = item >> 6;
    const bool need_ctx = (l == 0);
    unsigned char* ws = opaque_ptr(a.ws);
    const bf16_t* z = (const bf16_t*)(ws + OFF_Z);
    const bf16_t* gq = (const bf16_t*)(ws + OFF_GQ + dir * SZ_G) + h * 128;
    const bf16_t* gk = (const bf16_t*)(ws + OFF_GK + dir * SZ_G) + h * 128;
    const bf16_t* gh = (const bf16_t*)(ws + OFF_GH + dir * SZ_G) + (size_t)h * 128 * 64;
    const float* dec = (const float*)(ws + OFF_DEC) + (size_t)dir * 144 * 512 + h * 128;
    bf16_t* od = (bf16_t*)(ws + OFF_OF + (size_t)dir * MT * 1024 * 2) + h * 256 + vs * 32;
    const bf16_t* gvt = (const bf16_t*)(ws + OFF_GVT) + (size_t)(h * 256 + vs * 32) * 64;
    const int fr = lane & 15, fq = lane >> 4;
    f32x4 sacc[2] = {(f32x4){0.f, 0.f, 0.f, 0.f}, (f32x4){0.f, 0.f, 0.f, 0.f}};
    for (int i = tid; i < 32 * 136 / 2; i += 512) ((LAS unsigned*)(lds + GL_ST))[i] = 0u;
    u32x4 rqA[2], rkA[2], rhA[2], rvA, rqB[2], rkB[2], rhB[2], rvB; float rdecA, rdecB;
    auto rowbase = [&](int s) -> int { if (s < 4) { const int ci = dir == 0 ? s : 3 - s; return ML + b * LC + 64 * ci; } const int ci = dir == 0 ? s - 4 : 35 - s; return b * SEQ + 64 * ci; };
#define GLA_LOADA(s) do { const int _rb = rowbase(s); _Pragma("unroll") for (int _i = 0; _i < 2; ++_i) { const int _idx = tid + 512 * _i, _r = _idx >> 4, _c = (_idx & 15) * 8; const size_t _o = (size_t)(_rb + _r) * 512 + _c; \
        rqA[_i] = *(const u32x4*)(gq + _o); rkA[_i] = *(const u32x4*)(gk + _o); rhA[_i] = *(const u32x4*)(gh + ((size_t)(_rb >> 6) * 512 + (_idx >> 3)) * 64 + (_idx & 7) * 8); } \
        if (tid < 256) rvA = *(const u32x4*)(gvt + ((size_t)(_rb >> 6) * 1024 + (tid >> 3)) * 64 + (tid & 7) * 8); \
        rdecA = dec[(size_t)(_rb >> 6) * 512 + 16 * w + fr]; } while (0)
#define GLA_LOADB(s) do { const int _rb = rowbase(s); _Pragma("unroll") for (int _i = 0; _i < 2; ++_i) { const int _idx = tid + 512 * _i, _r = _idx >> 4, _c = (_idx & 15) * 8; const size_t _o = (size_t)(_rb + _r) * 512 + _c; \
        rqB[_i] = *(const u32x4*)(gq + _o); rkB[_i] = *(const u32x4*)(gk + _o); rhB[_i] = *(const u32x4*)(gh + ((size_t)(_rb >> 6) * 512 + (_idx >> 3)) * 64 + (_idx & 7) * 8); } \
        if (tid < 256) rvB = *(const u32x4*)(gvt + ((size_t)(_rb >> 6) * 1024 + (tid >> 3)) * 64 + (tid & 7) * 8); \
        rdecB = dec[(size_t)(_rb >> 6) * 512 + 16 * w + fr]; } while (0)
    GLA_LOADA(0); GLA_LOADB(1);
    for (int s0_ = 0; s0_ < 36; s0_ += 2) {
      { const int s = s0_;
        const int rb = rowbase(s);
        const float dk = rdecA;
#pragma unroll
        for (int i = 0; i < 2; ++i) { const int idx = tid + 512 * i, r = idx >> 4, c = (idx & 15) * 8;
            *(LAS u32x4*)(lds + GL_Q + r * 272 + c * 2) = rqA[i]; *(LAS u32x4*)(lds + GL_K + r * 272 + c * 2) = rkA[i];
            const int s0 = (idx & 7) * 8, p1 = (s0 & 32) + 8 * ((s0 & 15) >> 2) + 4 * ((s0 >> 4) & 1);
            *(LAS u32x2*)(lds + GL_KH + (idx >> 3) * 144 + p1 * 2) = (u32x2){rhA[i].x, rhA[i].y}; *(LAS u32x2*)(lds + GL_KH + (idx >> 3) * 144 + (p1 + 8) * 2) = (u32x2){rhA[i].z, rhA[i].w}; }
        if (tid < 256) { const int s0 = (tid & 7) * 8, p1 = (s0 & 32) + 8 * ((s0 & 15) >> 2) + 4 * ((s0 >> 4) & 1);
            *(LAS u32x2*)(lds + GL_VT + (tid >> 3) * 144 + p1 * 2) = (u32x2){rvA.x, rvA.y}; *(LAS u32x2*)(lds + GL_VT + (tid >> 3) * 144 + (p1 + 8) * 2) = (u32x2){rvA.z, rvA.w}; }
        __syncthreads();
        if (s + 2 < 36) GLA_LOADA(s + 2);
        const int tt = w >> 1, vt = w & 1;
        bf16x8 pb[2];
        {
            f32x4 at[4];
#pragma unroll
            for (int st = 0; st < 4; ++st) { f32x4 acc = (f32x4){0.f, 0.f, 0.f, 0.f};
#pragma unroll
                for (int kk = 0; kk < 4; ++kk) { const bf16x8 af = *(const LAS bf16x8*)(lds + GL_K + (16 * st + fr) * 272 + (32 * kk + 8 * fq) * 2);
                    const bf16x8 bfr = *(const LAS bf16x8*)(lds + GL_Q + (16 * tt + fr) * 272 + (32 * kk + 8 * fq) * 2);
                    acc = __builtin_amdgcn_mfma_f32_16x16x32_bf16(af, bfr, acc, 0, 0, 0); }
#pragma unroll
                for (int j = 0; j < 4; ++j) { const int sc = 16 * st + 4 * fq + j, t = 16 * tt + fr; const bool keep = dir == 0 ? (sc <= t) : (sc >= t); acc[j] = keep ? acc[j] : 0.f; }
                at[st] = acc; }
#pragma unroll
            for (int p = 0; p < 2; ++p) { u32x4 pw; pw.x = cvt_pk_bf16(at[2 * p][0], at[2 * p][1]); pw.y = cvt_pk_bf16(at[2 * p][2], at[2 * p][3]);
                pw.z = cvt_pk_bf16(at[2 * p + 1][0], at[2 * p + 1][1]); pw.w = cvt_pk_bf16(at[2 * p + 1][2], at[2 * p + 1][3]); pb[p] = __builtin_bit_cast(bf16x8, pw); }
        }
        {
            f32x4 acc = (f32x4){0.f, 0.f, 0.f, 0.f};
#pragma unroll
            for (int kk = 0; kk < 4; ++kk) { const bf16x8 af = *(const LAS bf16x8*)(lds + GL_ST + (16 * vt + fr) * 272 + (32 * kk + 8 * fq) * 2);
                const bf16x8 bfr = *(const LAS bf16x8*)(lds + GL_Q + (16 * tt + fr) * 272 + (32 * kk + 8 * fq) * 2);
                acc = __builtin_amdgcn_mfma_f32_16x16x32_bf16(af, bfr, acc, 0, 0, 0); }
#pragma unroll
            for (int p = 0; p < 2; ++p) { const bf16x8 af = *(const LAS bf16x8*)(lds + GL_VT + (16 * vt + fr) * 144 + (32 * p + 8 * fq) * 2);
                acc = __builtin_amdgcn_mfma_f32_16x16x32_bf16(af, pb[p], acc, 0, 0, 0); }
            if (s >= 4 || need_ctx) { u32x2 wv; wv.x = cvt_pk_bf16(acc[0], acc[1]); wv.y = cvt_pk_bf16(acc[2], acc[3]);
                *(u32x2*)(od + (size_t)(rb + 16 * tt + fr) * 1024 + 16 * vt + 4 * fq) = wv; }
        }
#pragma unroll
        for (int vt2 = 0; vt2 < 2; ++vt2) { f32x4 acc = sacc[vt2] * dk;
#pragma unroll
            for (int kk = 0; kk < 2; ++kk) { const bf16x8 af = *(const LAS bf16x8*)(lds + GL_VT + (16 * vt2 + fr) * 144 + (32 * kk + 8 * fq) * 2);
                const bf16x8 bfr = *(const LAS bf16x8*)(lds + GL_KH + (16 * w + fr) * 144 + (32 * kk + 8 * fq) * 2);
                acc = __builtin_amdgcn_mfma_f32_16x16x32_bf16(af, bfr, acc, 0, 0, 0); }
            sacc[vt2] = acc; }
        __syncthreads();
#pragma unroll
        for (int vt = 0; vt < 2; ++vt)
#pragma unroll
            for (int j = 0; j < 4; ++j) *(LAS bf16_t*)(lds + GL_ST + (16 * vt + 4 * fq + j) * 272 + (16 * w + fr) * 2) = f2bf(sacc[vt][j]);
      }
      { const int s = s0_ + 1;
        const int rb = rowbase(s);
        const float dk = rdecB;
#pragma unroll
        for (int i = 0; i < 2; ++i) { const int idx = tid + 512 * i, r = idx >> 4, c = (idx & 15) * 8;
            *(LAS u32x4*)(lds + GL_Q + r * 272 + c * 2) = rqB[i]; *(LAS u32x4*)(lds + GL_K + r * 272 + c * 2) = rkB[i];
            const int s0 = (idx & 7) * 8, p1 = (s0 & 32) + 8 * ((s0 & 15) >> 2) + 4 * ((s0 >> 4) & 1);
            *(LAS u32x2*)(lds + GL_KH + (idx >> 3) * 144 + p1 * 2) = (u32x2){rhB[i].x, rhB[i].y}; *(LAS u32x2*)(lds + GL_KH + (idx >> 3) * 144 + (p1 + 8) * 2) = (u32x2){rhB[i].z, rhB[i].w}; }
        if (tid < 256) { const int s0 = (tid & 7) * 8, p1 = (s0 & 32) + 8 * ((s0 & 15) >> 2) + 4 * ((s0 >> 4) & 1);
            *(LAS u32x2*)(lds + GL_VT + (tid >> 3) * 144 + p1 * 2) = (u32x2){rvB.x, rvB.y}; *(LAS u32x2*)(lds + GL_VT + (tid >> 3) * 144 + (p1 + 8) * 2) = (u32x2){rvB.z, rvB.w}; }
        __syncthreads();
        if (s + 2 < 36) GLA_LOADB(s + 2);
        const int tt = w >> 1, vt = w & 1;
        bf16x8 pb[2];
        {
            f32x4 at[4];
#pragma unroll
            for (int st = 0; st < 4; ++st) { f32x4 acc = (f32x4){0.f, 0.f, 0.f, 0.f};
#pragma unroll
                for (int kk = 0; kk < 4; ++kk) { const bf16x8 af = *(const LAS bf16x8*)(lds + GL_K + (16 * st + fr) * 272 + (32 * kk + 8 * fq) * 2);
                    const bf16x8 bfr = *(const LAS bf16x8*)(lds + GL_Q + (16 * tt + fr) * 272 + (32 * kk + 8 * fq) * 2);
                    acc = __builtin_amdgcn_mfma_f32_16x16x32_bf16(af, bfr, acc, 0, 0, 0); }
#pragma unroll
                for (int j = 0; j < 4; ++j) { const int sc = 16 * st + 4 * fq + j, t = 16 * tt + fr; const bool keep = dir == 0 ? (sc <= t) : (sc >= t); acc[j] = keep ? acc[j] : 0.f; }
                at[st] = acc; }
#pragma unroll
            for (int p = 0; p < 2; ++p) { u32x4 pw; pw.x = cvt_pk_bf16(at[2 * p][0], at[2 * p][1]); pw.y = cvt_pk_bf16(at[2 * p][2], at[2 * p][3]);
                pw.z = cvt_pk_bf16(at[2 * p + 1][0], at[2 * p + 1][1]); pw.w = cvt_pk_bf16(at[2 * p + 1][2], at[2 * p + 1][3]); pb[p] = __builtin_bit_cast(bf16x8, pw); }
        }
        {
            f32x4 acc = (f32x4){0.f, 0.f, 0.f, 0.f};
#pragma unroll
            for (int kk = 0; kk < 4; ++kk) { const bf16x8 af = *(const LAS bf16x8*)(lds + GL_ST + (16 * vt + fr) * 272 + (32 * kk + 8 * fq) * 2);
                const bf16x8 bfr = *(const LAS bf16x8*)(lds + GL_Q + (16 * tt + fr) * 272 + (32 * kk + 8 * fq) * 2);
                acc = __builtin_amdgcn_mfma_f32_16x16x32_bf16(af, bfr, acc, 0, 0, 0); }
#pragma unroll
            for (int p = 0; p < 2; ++p) { const bf16x8 af = *(const LAS bf16x8*)(lds + GL_VT + (16 * vt + fr) * 144 + (32 * p + 8 * fq) * 2);
                acc = __builtin_amdgcn_mfma_f32_16x16x32_bf16(af, pb[p], acc, 0, 0, 0); }
            if (s >= 4 || need_ctx) { u32x2 wv; wv.x = cvt_pk_bf16(acc[0], acc[1]); wv.y = cvt_pk_bf16(acc[2], acc[3]);
                *(u32x2*)(od + (size_t)(rb + 16 * tt + fr) * 1024 + 16 * vt + 4 * fq) = wv; }
        }
#pragma unroll
        for (int vt2 = 0; vt2 < 2; ++vt2) { f32x4 acc = sacc[vt2] * dk;
#pragma unroll
            for (int kk = 0; kk < 2; ++kk) { const bf16x8 af = *(const LAS bf16x8*)(lds + GL_VT + (16 * vt2 + fr) * 144 + (32 * kk + 8 * fq) * 2);
                const bf16x8 bfr = *(const LAS bf16x8*)(lds + GL_KH + (16 * w + fr) * 144 + (32 * kk + 8 * fq) * 2);
                acc = __builtin_amdgcn_mfma_f32_16x16x32_bf16(af, bfr, acc, 0, 0, 0); }
            sacc[vt2] = acc; }
        __syncthreads();
#pragma unroll
        for (int vt = 0; vt < 2; ++vt)
#pragma unroll
            for (int j = 0; j < 4; ++j) *(LAS bf16_t*)(lds + GL_ST + (16 * vt + 4 * fq + j) * 272 + (16 * w + fr) * 2) = f2bf(sacc[vt][j]);
      }
    }
    __syncthreads();
#undef GLA_LOADA
#undef GLA_LOADB
}


constexpr int G2_Q = 0, G2_K = 17408, G2_KH = 34816, G2_VT = 53248, G2_ST = 62464;
__device__ __forceinline__ void gla_unit2(const Args& a, int l, LAS unsigned char* lds, int item) {
    const int tid = opaque_tid(), lane = tid & 63, w = __builtin_amdgcn_readfirstlane(tid >> 6);
    const int vs2 = item & 3, dir = (item >> 2) & 1, h = (item >> 3) & 3, b = item >> 5;
    const bool need_ctx = (l == 0);
    unsigned char* ws = opaque_ptr(a.ws);
    const bf16_t* gq = (const bf16_t*)(ws + OFF_GQ + dir * SZ_G) + h * 128;
    const bf16_t* gk = (const bf16_t*)(ws + OFF_GK + dir * SZ_G) + h * 128;
    const bf16_t* gh = (const bf16_t*)(ws + OFF_GH + dir * SZ_G) + (size_t)h * 128 * 64;
    const float* dec = (const float*)(ws + OFF_DEC) + (size_t)dir * 144 * 512 + h * 128;
    bf16_t* od = (bf16_t*)(ws + OFF_OF + (size_t)dir * MT * 1024 * 2) + h * 256 + vs2 * 64;
    const bf16_t* gvt = (const bf16_t*)(ws + OFF_GVT) + (size_t)(h * 256 + vs2 * 64) * 64;
    const int fr = lane & 15, fq = lane >> 4;
    f32x4 sacc[4];
#pragma unroll
    for (int i = 0; i < 4; ++i) sacc[i] = (f32x4){0.f, 0.f, 0.f, 0.f};
    for (int i = tid; i < 64 * 136 / 2; i += 512) ((LAS unsigned*)(lds + G2_ST))[i] = 0u;
    u32x4 rqA[2], rkA[2], rhA[2], rvA, rqB[2], rkB[2], rhB[2], rvB; float rdecA, rdecB;
    auto rowbase = [&](int s) -> int { if (s < 4) { const int ci = dir == 0 ? s : 3 - s; return ML + b * LC + 64 * ci; } const int ci = dir == 0 ? s - 4 : 35 - s; return b * SEQ + 64 * ci; };
#define G2_LOAD(X, s) do { const int _rb = rowbase(s); _Pragma("unroll") for (int _i = 0; _i < 2; ++_i) { const int _idx = tid + 512 * _i, _r = _idx >> 4, _c = (_idx & 15) * 8; const size_t _o = (size_t)(_rb + _r) * 512 + _c; \
        rq##X[_i] = *(const u32x4*)(gq + _o); rk##X[_i] = *(const u32x4*)(gk + _o); rh##X[_i] = *(const u32x4*)(gh + ((size_t)(_rb >> 6) * 512 + (_idx >> 3)) * 64 + (_idx & 7) * 8); } \
        rv##X = *(const u32x4*)(gvt + ((size_t)(_rb >> 6) * 1024 + (tid >> 3)) * 64 + (tid & 7) * 8); \
        rdec##X = dec[(size_t)(_rb >> 6) * 512 + 16 * w + fr]; } while (0)
#define G2_STEP(X, s) do { \
        const int rb = rowbase(s); const float dk = rdec##X; \
        _Pragma("unroll") for (int i = 0; i < 2; ++i) { const int idx = tid + 512 * i, r = idx >> 4, c = (idx & 15) * 8; \
            *(LAS u32x4*)(lds + G2_Q + r * 272 + c * 2) = rq##X[i]; *(LAS u32x4*)(lds + G2_K + r * 272 + c * 2) = rk##X[i]; \
            const int s0 = (idx & 7) * 8, p1 = (s0 & 32) + 8 * ((s0 & 15) >> 2) + 4 * ((s0 >> 4) & 1); \
            *(LAS u32x2*)(lds + G2_KH + (idx >> 3) * 144 + p1 * 2) = (u32x2){rh##X[i].x, rh##X[i].y}; *(LAS u32x2*)(lds + G2_KH + (idx >> 3) * 144 + (p1 + 8) * 2) = (u32x2){rh##X[i].z, rh##X[i].w}; } \
        { const int s0 = (tid & 7) * 8, p1 = (s0 & 32) + 8 * ((s0 & 15) >> 2) + 4 * ((s0 >> 4) & 1); \
            *(LAS u32x2*)(lds + G2_VT + (tid >> 3) * 144 + p1 * 2) = (u32x2){rv##X.x, rv##X.y}; *(LAS u32x2*)(lds + G2_VT + (tid >> 3) * 144 + (p1 + 8) * 2) = (u32x2){rv##X.z, rv##X.w}; } \
        __syncthreads(); \
        if ((s) + 2 < 36) G2_LOAD(X, (s) + 2); \
        const int tt = w >> 1, vp = w & 1; \
        { \
            bf16x8 qf[4], kf[4][4]; \
            _Pragma("unroll") for (int kk = 0; kk < 4; ++kk) qf[kk] = *(const LAS bf16x8*)(lds + G2_Q + (16 * tt + fr) * 272 + (32 * kk + 8 * fq) * 2); \
            _Pragma("unroll") for (int st = 0; st < 4; ++st) _Pragma("unroll") for (int kk = 0; kk < 4; ++kk) kf[st][kk] = *(const LAS bf16x8*)(lds + G2_K + (16 * st + fr) * 272 + (32 * kk + 8 * fq) * 2); \
            __builtin_amdgcn_sched_barrier(0); \
            f32x4 at[4]; \
            _Pragma("unroll") for (int st = 0; st < 4; ++st) at[st] = (f32x4){0.f, 0.f, 0.f, 0.f}; \
            _Pragma("unroll") for (int kk = 0; kk < 4; ++kk) _Pragma("unroll") for (int st = 0; st < 4; ++st) at[st] = __builtin_amdgcn_mfma_f32_16x16x32_bf16(kf[st][kk], qf[kk], at[st], 0, 0, 0); \
            __builtin_amdgcn_sched_barrier(0); \
            bf16x8 sf[2][4], vfr[4][2], khf[2], vfo[2][2]; \
            _Pragma("unroll") for (int i = 0; i < 2; ++i) _Pragma("unroll") for (int kk = 0; kk < 4; ++kk) sf[i][kk] = *(const LAS bf16x8*)(lds + G2_ST + (16 * (2 * vp + i) + fr) * 272 + (32 * kk + 8 * fq) * 2); \
            _Pragma("unroll") for (int v2 = 0; v2 < 4; ++v2) _Pragma("unroll") for (int kk = 0; kk < 2; ++kk) vfr[v2][kk] = *(const LAS bf16x8*)(lds + G2_VT + (16 * v2 + fr) * 144 + (32 * kk + 8 * fq) * 2); \
            _Pragma("unroll") for (int kk = 0; kk < 2; ++kk) khf[kk] = *(const LAS bf16x8*)(lds + G2_KH + (16 * w + fr) * 144 + (32 * kk + 8 * fq) * 2); \
            _Pragma("unroll") for (int i = 0; i < 2; ++i) _Pragma("unroll") for (int p = 0; p < 2; ++p) vfo[i][p] = *(const LAS bf16x8*)(lds + G2_VT + (16 * (2 * vp + i) + fr) * 144 + (32 * p + 8 * fq) * 2); \
            __builtin_amdgcn_sched_barrier(0); \
            _Pragma("unroll") for (int v2 = 0; v2 < 4; ++v2) { f32x4 acc = sacc[v2] * dk; \
                _Pragma("unroll") for (int kk = 0; kk < 2; ++kk) acc = __builtin_amdgcn_mfma_f32_16x16x32_bf16(vfr[v2][kk], khf[kk], acc, 0, 0, 0); \
                sacc[v2] = acc; } \
            f32x4 oacc[2]; \
            _Pragma("unroll") for (int i = 0; i < 2; ++i) { oacc[i] = (f32x4){0.f, 0.f, 0.f, 0.f}; \
                _Pragma("unroll") for (int kk = 0; kk < 4; ++kk) oacc[i] = __builtin_amdgcn_mfma_f32_16x16x32_bf16(sf[i][kk], qf[kk], oacc[i], 0, 0, 0); } \
            bf16x8 pb[2]; \
            _Pragma("unroll") for (int st = 0; st < 4; ++st) _Pragma("unroll") for (int j = 0; j < 4; ++j) { const int sc = 16 * st + 4 * fq + j, t = 16 * tt + fr; const bool keep = dir == 0 ? (sc <= t) : (sc >= t); at[st][j] = keep ? at[st][j] : 0.f; } \
            _Pragma("unroll") for (int p = 0; p < 2; ++p) { u32x4 pw; pw.x = cvt_pk_bf16(at[2 * p][0], at[2 * p][1]); pw.y = cvt_pk_bf16(at[2 * p][2], at[2 * p][3]); \
                pw.z = cvt_pk_bf16(at[2 * p + 1][0], at[2 * p + 1][1]); pw.w = cvt_pk_bf16(at[2 * p + 1][2], at[2 * p + 1][3]); pb[p] = __builtin_bit_cast(bf16x8, pw); } \
            _Pragma("unroll") for (int i = 0; i < 2; ++i) { \
                _Pragma("unroll") for (int p = 0; p < 2; ++p) oacc[i] = __builtin_amdgcn_mfma_f32_16x16x32_bf16(vfo[i][p], pb[p], oacc[i], 0, 0, 0); \
                if ((s) >= 4 || need_ctx) { u32x2 wv; wv.x = cvt_pk_bf16(oacc[i][0], oacc[i][1]); wv.y = cvt_pk_bf16(oacc[i][2], oacc[i][3]); \
                    *(u32x2*)(od + (size_t)(rb + 16 * tt + fr) * 1024 + 16 * (2 * vp + i) + 4 * fq) = wv; } } \
        } \
        __syncthreads(); \
        _Pragma("unroll") for (int v2 = 0; v2 < 4; ++v2) _Pragma("unroll") for (int j = 0; j < 4; ++j) *(LAS bf16_t*)(lds + G2_ST + (16 * v2 + 4 * fq + j) * 272 + (16 * w + fr) * 2) = f2bf(sacc[v2][j]); \
    } while (0)
    G2_LOAD(A, 0); G2_LOAD(B, 1);
    for (int s0_ = 0; s0_ < 36; s0_ += 2) { G2_STEP(A, s0_); G2_STEP(B, s0_ + 1); }
    __syncthreads();
#undef G2_LOAD
#undef G2_STEP
}

constexpr int AT_BUF = 36864, AT_K = 0, AT_V = 18432;
template <bool SHIFT>
__device__ __forceinline__ void attn_unit(LAS unsigned char* lds, const bf16_t* qbase, int Lq, int q0, const bf16_t* kbase, const bf16_t* vtbase, int nkeys,
                                          float c2, float lam, float post_scale, const float* subln, const bf16_t* dg, bf16_t* outp, int row0) {
    const int tid = opaque_tid(), lane = tid & 63, w = __builtin_amdgcn_readfirstlane(tid >> 6), q32 = lane & 31, hi = lane >> 5;
    const int j = w >> 2, qg = w & 3;
    bf16x8 qf[4];
#pragma unroll
    for (int kk = 0; kk < 4; ++kk) qf[kk] = *(const bf16x8*)(qbase + ((size_t)j * Lq + q0 + 32 * qg + q32) * 64 + 16 * kk + 8 * hi);
    f32x16 o[4];
#pragma unroll
    for (int vt = 0; vt < 4; ++vt)
#pragma unroll
        for (int r = 0; r < 16; ++r) o[vt][r] = 0.f;
    float lsum = 0.f;
    const int nt = nkeys >> 6;
    u32x4 skA[2], svA[2];
#define AT_LOAD(sk, sv, i) do { _Pragma("unroll") for (int _c = 0; _c < 2; ++_c) { const int _idx = tid + 512 * _c; \
        sk[_c] = *(const u32x4*)(kbase + ((size_t)(_idx >> 9) * LK + 64 * (i) + ((_idx & 511) >> 3)) * 64 + (_idx & 7) * 8); \
        sv[_c] = *(const u32x4*)(vtbase + (size_t)(_idx >> 3) * LK + 64 * (i) + (_idx & 7) * 8); } } while (0)
#define AT_STORE(sk, sv, p) do { _Pragma("unroll") for (int _c = 0; _c < 2; ++_c) { const int _idx = tid + 512 * _c; \
        *(LAS u32x4*)(lds + (p) * AT_BUF + AT_K + ((_idx >> 9) * 64 + ((_idx & 511) >> 3)) * 144 + (_idx & 7) * 16) = sk[_c]; \
        *(LAS u32x4*)(lds + (p) * AT_BUF + AT_V + (_idx >> 3) * 144 + (_idx & 7) * 16) = sv[_c]; } } while (0)
#define AT_KF(kb, kk) (*(const LAS bf16x8*)(Kb + (32 * (kb) + q32) * 144 + (16 * (kk) + 8 * hi) * 2))
#define AT_VF(ks, vt) (*(const LAS bf16x8*)(Vb + (32 * (vt) + q32) * 144 + (16 * (ks) + 8 * hi) * 2))
#define AT_TILE(p) do { \
        LAS unsigned char* Kb = lds + (p) * AT_BUF + AT_K + j * (64 * 144); LAS unsigned char* Vb = lds + (p) * AT_BUF + AT_V; \
        bf16x8 kf[4], vf[4], vg[4]; \
        _Pragma("unroll") for (int kk = 0; kk < 4; ++kk) kf[kk] = AT_KF(0, kk); \
        _Pragma("unroll") for (int kb = 0; kb < 2; ++kb) { \
            _Pragma("unroll") for (int vt = 0; vt < 4; ++vt) vf[vt] = AT_VF(2 * kb, vt); \
            __builtin_amdgcn_sched_barrier(0); \
            f32x16 s; \
            _Pragma("unroll") for (int r = 0; r < 16; ++r) s[r] = 0.f; \
            _Pragma("unroll") for (int kk = 0; kk < 4; ++kk) s = __builtin_amdgcn_mfma_f32_32x32x16_bf16(kf[kk], qf[kk], s, 0, 0, 0); \
            __builtin_amdgcn_sched_barrier(0); \
            _Pragma("unroll") for (int vt = 0; vt < 4; ++vt) vg[vt] = AT_VF(2 * kb + 1, vt); \
            if (kb == 0) { _Pragma("unroll") for (int kk = 0; kk < 4; ++kk) kf[kk] = AT_KF(1, kk); } \
            __builtin_amdgcn_sched_barrier(0); \
            _Pragma("unroll") for (int r = 0; r < 16; ++r) { s[r] = __builtin_amdgcn_exp2f(SHIFT ? s[r] - c2 : s[r]); lsum += s[r]; } \
            u32x4 pw0, pw1; \
            pw0.x = cvt_pk_bf16(s[0], s[1]); pw0.y = cvt_pk_bf16(s[2], s[3]); pw0.z = cvt_pk_bf16(s[4], s[5]); pw0.w = cvt_pk_bf16(s[6], s[7]); \
            pw1.x = cvt_pk_bf16(s[8], s[9]); pw1.y = cvt_pk_bf16(s[10], s[11]); pw1.z = cvt_pk_bf16(s[12], s[13]); pw1.w = cvt_pk_bf16(s[14], s[15]); \
            const bf16x8 pb0 = __builtin_bit_cast(bf16x8, pw0), pb1 = __builtin_bit_cast(bf16x8, pw1); \
            _Pragma("unroll") for (int vt = 0; vt < 4; ++vt) o[vt] = __builtin_amdgcn_mfma_f32_32x32x16_bf16(vf[vt], pb0, o[vt], 0, 0, 0); \
            _Pragma("unroll") for (int vt = 0; vt < 4; ++vt) o[vt] = __builtin_amdgcn_mfma_f32_32x32x16_bf16(vg[vt], pb1, o[vt], 0, 0, 0); \
            __builtin_amdgcn_sched_barrier(0); \
        } } while (0)
    AT_LOAD(skA, svA, 0); AT_STORE(skA, svA, 0);
    __syncthreads();
    for (int i = 0; i < nt; i += 2) {
        AT_LOAD(skA, svA, i + 1);
        AT_TILE(0);
        AT_STORE(skA, svA, 1);
        __syncthreads();
        if (i + 2 < nt) AT_LOAD(skA, svA, i + 2);
        AT_TILE(1);
        if (i + 2 < nt) AT_STORE(skA, svA, 0);
        __syncthreads();
    }
#undef AT_TILE
#undef AT_KF
#undef AT_VF
#undef AT_LOAD
#undef AT_STORE
    lsum += __shfl_xor(lsum, 32);
    LAS float* xch = (LAS float*)lds + (size_t)qg * 4096 + lane;
    if (j == 1) {
        const float sc = lam / lsum;
#pragma unroll
        for (int vt = 0; vt < 4; ++vt)
#pragma unroll
            for (int r = 0; r < 16; ++r) xch[(vt * 16 + r) * 64] = o[vt][r] * sc;
    }
    __syncthreads();
    if (j == 0) {
        const float i0 = 1.f / lsum;
        float ss = 0.f;
#pragma unroll
        for (int vt = 0; vt < 4; ++vt)
#pragma unroll
            for (int r = 0; r < 16; ++r) { const float v = o[vt][r] * i0 - xch[(vt * 16 + r) * 64]; o[vt][r] = v; ss += v * v; }
        ss += __shfl_xor(ss, 32);
        const float rstd = rsqrtf(ss * (1.f / 128.f) + EPS) * post_scale;
        const size_t row = (size_t)row0 + 32 * qg + q32;
#pragma unroll
        for (int vt = 0; vt < 4; ++vt)
#pragma unroll
            for (int g4 = 0; g4 < 4; ++g4) {
                const int v0 = 32 * vt + 8 * g4 + 4 * hi;
                const u32x2 gz = *(const u32x2*)(dg + row * NZ + v0);
                const f32x4 sl = *(const f32x4*)(subln + v0);
                const float r0 = o[vt][4 * g4 + 0] * rstd * sl[0] * silu_f(bflo(gz.x)), r1 = o[vt][4 * g4 + 1] * rstd * sl[1] * silu_f(bfhi(gz.x));
                const float r2 = o[vt][4 * g4 + 2] * rstd * sl[2] * silu_f(bflo(gz.y)), r3 = o[vt][4 * g4 + 3] * rstd * sl[3] * silu_f(bfhi(gz.y));
                u32x2 wv; wv.x = cvt_pk_bf16(r0, r1); wv.y = cvt_pk_bf16(r2, r3);
                *(u32x2*)(outp + row * 1024 + v0) = wv;
            }
    }
    __syncthreads();
}

__device__ __forceinline__ void phase_mix(const Args& a, int l, LAS unsigned char* lds) {
    const int G = opaque_s(gridDim.x);
    unsigned char* ws = opaque_ptr(a.ws);
    const bool need_ctx = (l == 0);
    const float* scal = (const float*)(ws + OFF_SCAL) + l * 4;
    const float lam = scal[0], c2 = scal[1], post = 1.f - scal[2];
    const bf16_t* z = (const bf16_t*)(ws + OFF_Z);
    const bool big = c2 > 48.f;
#define ATTN_UNIT(...) do { if (big) attn_unit<true>(__VA_ARGS__); else attn_unit<false>(__VA_ARGS__); } while (0)
#define ATTN_LATENT(vc_) do { const int vc = (vc_), bh = vc >> 4, qb = vc & 15, b = bh >> 3, h = bh & 7; \
        ATTN_UNIT(lds, (const bf16_t*)(ws + OFF_QN) + (size_t)bh * 2 * SEQ * 64, SEQ, 128 * qb, (const bf16_t*)(ws + OFF_KN) + (size_t)bh * 2 * LK * 64, \
                  (const bf16_t*)(ws + OFF_VT) + (size_t)bh * 128 * LK, LK, c2, lam, post, inp(I_SUBLN) + l * 128, z + ZC_DG + h * 128, (bf16_t*)(ws + OFF_DIFFO) + h * 128, b * SEQ + 128 * qb); } while (0)
#define ATTN_CTX(uu_) do { const int uu = (uu_), bh = uu >> 1, qb = uu & 1, b = bh >> 3, h = bh & 7; \
        ATTN_UNIT(lds, (const bf16_t*)(ws + OFF_QNC) + (size_t)bh * 2 * LC * 64, LC, 128 * qb, (const bf16_t*)(ws + OFF_KN) + (size_t)bh * 2 * LK * 64, \
                  (const bf16_t*)(ws + OFF_VT) + (size_t)bh * 128 * LK, LC, c2, lam, post, inp(I_SUBLN) + l * 128, z + ZC_DG + h * 128, (bf16_t*)(ws + OFF_DIFFO) + h * 128, ML + b * LC + 128 * qb); } while (0)
    if (G == 256) {
        const int B_ = BID;
        if (B_ < 128) {
            gla_unit2(a, l, lds, ((B_ & 7) * 4 + (B_ >> 5)) * 4 + ((B_ >> 3) & 3));
            { const int u = 384 + B_; ATTN_LATENT((u & 7) * 64 + (u >> 3)); }
            if (need_ctx && B_ < 64) ATTN_CTX(B_);
        } else {
            for (int k = 0; k < 3; ++k) { const int u = (B_ - 128) + 128 * k; ATTN_LATENT((u & 7) * 64 + (u >> 3)); }
        }
    } else {
        for (int it = BID; it < 256; it += G) gla_unit(a, l, lds, ((it & 7) * 4 + (it >> 6)) * 8 + ((it >> 3) & 7));
        const int nun = 512 + (need_ctx ? 64 : 0);
        for (int u = BID; u < nun; u += G) { if (u < 512) ATTN_LATENT((u & 7) * 64 + (u >> 3)); else ATTN_CTX(u - 512); }
    }
#ifndef NO_POOL
    {
        const int Mrows = need_ctx ? MT : ML;
        pg8::Gemm g{(const bf16_t*)(ws + OFF_DPOOL), (const bf16_t*)(ws + OFF_POOLT + (size_t)l * SZ_POOLT), Mrows, 1024, 256, 1024, 256, 256};
        pg8::StaticOrder S; S.init(Mrows, 1024, G, BID);
        pg8::EpiPool E{(bf16_t*)(ws + OFF_POOLO), (const bf16_t*)(ws + OFF_PGATE)};
        pg8::gemm_phase<pg8::EpiPool, pg8::StaticOrder, true, true>(lds, g, S, E);
    }
#endif
}

__device__ __forceinline__ void phase_post(const Args& a, int l) {
    const int tid = opaque_tid(), lane = tid & 63, wave = tid >> 6, G = opaque_s(gridDim.x);
    const int gw = BID * 8 + wave, NGW = G * 8;
    unsigned char* ws = opaque_ptr(a.ws);
    const bf16_t* z = (const bf16_t*)(ws + OFF_Z);
    const bf16_t* of = (const bf16_t*)(ws + OFF_OF); const bf16_t* ob = of + (size_t)MT * 1024;
    bf16_t* go = (bf16_t*)(ws + OFF_GLAO);
    const int Mrows = (l == 0) ? MT : ML;
    const float* gn = inp(I_GLAN) + l * 256 + ((16 * lane) & 255);
    for (int row = gw; row < Mrows; row += NGW) {
        float x[16], y[16], gz[16];
        const size_t o = (size_t)row * 1024 + 16 * lane;
        unpack8(*(const u32x4*)(of + o), x); unpack8(*(const u32x4*)(of + o + 8), x + 8);
        unpack8(*(const u32x4*)(ob + o), y); unpack8(*(const u32x4*)(ob + o + 8), y + 8);
        unpack8(*(const u32x4*)(z + (size_t)row * NZ + ZC_GG + 16 * lane), gz); unpack8(*(const u32x4*)(z + (size_t)row * NZ + ZC_GG + 16 * lane + 8), gz + 8);
        float ss = 0.f;
#pragma unroll
        for (int e = 0; e < 16; ++e) { x[e] += y[e]; ss += x[e] * x[e]; }
        ss += __shfl_xor(ss, 1); ss += __shfl_xor(ss, 2); ss += __shfl_xor(ss, 4); ss += __shfl_xor(ss, 8);
        const float rstd = rsqrtf(ss * (1.f / 256.f) + EPS);
        float r[16];
#pragma unroll
        for (int e = 0; e < 16; ++e) r[e] = x[e] * rstd * gn[e] * silu_f(gz[e]);
        u32x4 w0, w1;
        w0.x = cvt_pk_bf16(r[0], r[1]); w0.y = cvt_pk_bf16(r[2], r[3]); w0.z = cvt_pk_bf16(r[4], r[5]); w0.w = cvt_pk_bf16(r[6], r[7]);
        w1.x = cvt_pk_bf16(r[8], r[9]); w1.y = cvt_pk_bf16(r[10], r[11]); w1.z = cvt_pk_bf16(r[12], r[13]); w1.w = cvt_pk_bf16(r[14], r[15]);
        *(u32x4*)(go + o) = w0; *(u32x4*)(go + o + 8) = w1;
    }
}

#define XB_TMO      128
#define XB_XCNT(j)  (256  + 64 * (j))
#define XB_XSUB(j)  (1280 + 64 * (j))
#define XB_XGEN(j)  (2304 + 64 * (j))
#define XB_TOP      3328
#define XB_TOPGEN   3392
#define XCD_BAR_WORDS 3456
#define XB_SPIN_CAP (1u << 18)

__device__ __forceinline__ unsigned xb_ld(unsigned* p)              { return __hip_atomic_load(p, __ATOMIC_RELAXED, __HIP_MEMORY_SCOPE_AGENT); }
__device__ __forceinline__ unsigned xb_add(unsigned* p, unsigned v) { return __hip_atomic_fetch_add(p, v, __ATOMIC_RELAXED, __HIP_MEMORY_SCOPE_AGENT); }
__device__ __forceinline__ unsigned xb_xcc_id() { return (unsigned)__builtin_amdgcn_s_getreg((3 << 11) | 20) & 0xFu; }
#define XB_SPIN(cond, bar) do { unsigned _sp = 0; while (cond) { __builtin_amdgcn_s_sleep(1); \
    if ((++_sp & 255u) == 0u) { if (xb_ld(&(bar)[XB_TMO])) break; if (_sp > XB_SPIN_CAP) { atomicAdd(&(bar)[XB_TMO], 1u); break; } } } } while (0)

struct XcdBarrier {
    unsigned* bar; unsigned x;
    volatile LAS unsigned* st;
};

__device__ __forceinline__ XcdBarrier xcd_barrier_post(unsigned* bar, volatile LAS unsigned* st) {
    XcdBarrier b; b.bar = bar; b.x = xb_xcc_id(); b.st = st;
    if (threadIdx.x == 0) (void)xb_add(&bar[XB_XCNT(b.x)], 1u);
    return b;
}
__device__ __forceinline__ void xcd_barrier_complete(unsigned* bar, unsigned x, unsigned& nloc, unsigned& nx) {
    const unsigned G = gridDim.x * gridDim.y * gridDim.z;
    unsigned sum, cnt, mine, sp = 0u;
    for (;;) {
        sum = 0u; cnt = 0u; mine = 0u;
#pragma unroll
        for (unsigned j = 0; j < 16; ++j) { const unsigned c = xb_ld(&bar[XB_XCNT(j)]); sum += c; cnt += (c > 0u) ? 1u : 0u; mine = (j == x) ? c : mine; }
        if (sum == G) break;
        __builtin_amdgcn_s_sleep(1);
        if ((++sp & 255u) == 0u) { if (xb_ld(&bar[XB_TMO])) break; if (sp > XB_SPIN_CAP) { atomicAdd(&bar[XB_TMO], 1u); break; } }
    }
    nloc = mine > 0u ? mine : 1u; nx = cnt > 0u ? cnt : 1u;
}

__device__ __forceinline__ void xcd_barrier(const XcdBarrier& b) {
    asm volatile("s_waitcnt vmcnt(0)" ::: "memory");
    __syncthreads();
    if (threadIdx.x == 0) {
        unsigned* bar = b.bar;
        __builtin_amdgcn_s_waitcnt(0);
        unsigned nloc = b.st[0], nx = b.st[1];
        if (nloc == 0u) { xcd_barrier_complete(bar, b.x, nloc, nx); b.st[0] = nloc; b.st[1] = nx; }
        const unsigned old = xb_add(&bar[XB_XSUB(b.x)], 1u);
        const unsigned gen = old / nloc;
        if (old + 1u == (gen + 1u) * nloc) {
            __builtin_amdgcn_fence(__ATOMIC_RELEASE, "agent");
            asm volatile("s_waitcnt vmcnt(0)" ::: "memory");
            const unsigned og = xb_add(&bar[XB_TOP], 1u);
            const unsigned tg = og / nx;
            if (og + 1u == (tg + 1u) * nx) xb_add(&bar[XB_TOPGEN], 1u);
            else XB_SPIN(xb_ld(&bar[XB_TOPGEN]) == tg, bar);
            __builtin_amdgcn_fence(__ATOMIC_ACQUIRE, "agent");
            xb_add(&bar[XB_XGEN(b.x)], 1u);
            asm volatile("s_waitcnt vmcnt(0)" ::: "memory");
        } else {
            XB_SPIN(xb_ld(&bar[XB_XGEN(b.x)]) == gen, bar);
            __builtin_amdgcn_fence(__ATOMIC_ACQUIRE, "agent");
            asm volatile("s_waitcnt vmcnt(0)" ::: "memory");
        }
    }
    __syncthreads();
}

#ifndef REPEAT_K
#define REPEAT_K -1
#endif
#define SEAM() do { XcdBarrier xb; xb.bar = (unsigned*)(opaque_ptr(a.ws) + OFF_BAR); xb.x = xb_xcc_id(); xb.st = (volatile LAS unsigned*)(lds + 131072 + 512); xcd_barrier(xb); } while (0)
#define REP(k) for (int rep_ = 0; rep_ < (REPEAT_K == (k) ? 2 : 1); ++rep_)
template <int l> __device__ __forceinline__ void run_layer(const Args& a, LAS unsigned char* lds) {
    constexpr int Mout = (l == 0) ? MT : ML;
    REP(0) phase_norm(a, l);
    SEAM();
    REP(1) {
        unsigned char* ws = opaque_ptr(a.ws); const int G = opaque_s(gridDim.x);
        pg8::Gemm g{(const bf16_t*)(ws + OFF_H), (const bf16_t*)(ws + OFF_WIN + (size_t)l * SZ_WIN), MT, NZ, DM, DM, DM, 0};
        pg8::EpiBf16 E{(bf16_t*)(ws + OFF_Z), NZ};
        if (l == 0) { pg8::StaticOrder S; S.init(MT, NZ, G, BID); pg8::gemm_phase<pg8::EpiBf16, pg8::StaticOrder, true, true>(lds, g, S, E);
 }
        else { pg8::CtxSkipOrder S; S.init(G, BID); pg8::gemm_phase<pg8::EpiBf16, pg8::CtxSkipOrder, true, true>(lds, g, S, E); }
    }
    SEAM();
    REP(2) phase_prep(a, l, lds);
    SEAM();
    REP(3) phase_mix(a, l, lds);
    if (l == 0) cg::this_grid().sync();
    else SEAM();
    REP(4) phase_post(a, l);
    SEAM();
    REP(5) {
        unsigned char* ws = opaque_ptr(a.ws); const int G = opaque_s(gridDim.x);
        pg8::SegOrder3 S; S.base.init(Mout, DM, G, BID);
        const bf16_t* wb = (const bf16_t*)(ws + OFF_WB + (size_t)l * SZ_WB);
        pg8::Gemm g{(const bf16_t*)(ws + OFF_POOLO), wb, Mout, DM, 1024, 1024, 1024, 0,
                    (const bf16_t*)(ws + OFF_DIFFO), (const bf16_t*)(ws + OFF_GLAO), wb + (size_t)DM * 1024, wb + (size_t)2 * DM * 1024};
        pg8::EpiMerge3 E{(bf16_t*)(ws + OFF_H), (const bf16_t*)(ws + OFF_Z) + ZC_MG};
        pg8::gemm_phase<pg8::EpiMerge3, pg8::SegOrder3, true, true, 3>(lds, g, S, E);
        if (l == 0 && rep_ == 0) {
            const int rem = ((Mout / 256) * (DM / 256)) % G, bid = BID;
            if (rem == 0) { ada_items(a, lds, 1, bid, G); convert_layer_weights(a, lds, 1, bid * 8 + (int)(threadIdx.x >> 6), G * 8); }
            else if (bid >= rem) { ada_items(a, lds, 1, G - 1 - bid, G - rem); convert_layer_weights(a, lds, 1, (bid - rem) * 8 + (int)(threadIdx.x >> 6), (G - rem) * 8); }
        }
    }
    SEAM();
    REP(6) {
        unsigned char* ws = opaque_ptr(a.ws); const int G = opaque_s(gridDim.x);
        pg8::Gemm g{(const bf16_t*)(ws + OFF_H), (const bf16_t*)(ws + OFF_WOUT + (size_t)l * SZ_WOUT), Mout, DM, DM, DM, DM, 0};
        pg8::StaticOrder S; S.init(Mout, DM, G, BID);
        pg8::EpiOut E{l == 0 ? inp(I_X) : (const float*)(ws + OFF_X1), l == 0 ? inp(I_CTX) : (const float*)(ws + OFF_X1) + (size_t)ML * DM,
                      l == 0 ? (float*)(ws + OFF_X1) : arg_out(), (const float*)(ws + OFF_MOD) + (size_t)l * 5 * 6144};
        pg8::gemm_phase<pg8::EpiOut, pg8::StaticOrder, true, true>(lds, g, S, E);
    }
}

__global__ void __launch_bounds__(512, 2) hybrid_fwd(Args a) {
    extern __shared__ __attribute__((aligned(16))) unsigned char smem[];
    LAS unsigned char* lds = (LAS unsigned char*)smem;
    volatile LAS unsigned* bst = (volatile LAS unsigned*)(lds + 131072 + 512);
    if (threadIdx.x < 2) bst[threadIdx.x] = 0u;
    __syncthreads();
    (void)xcd_barrier_post((unsigned*)(a.ws + OFF_BAR), bst);
    REP(7) phase_p0(a, lds);
    SEAM();
    run_layer<0>(a, lds);
    SEAM();
    run_layer<1>(a, lds);
}

extern "C" void kernel_launch(void* const* d_in, const int* in_sizes, int n_in, void* d_out, int out_size, void* d_ws, size_t ws_size, hipStream_t stream) {
    static int grid = 0;
    if (grid == 0) {
        if (n_in != 26 || out_size != ML * DM || ws_size < WS_END) { fprintf(stderr, "kernel_launch: expected 26 inputs, out %d, ws >= %zu; got n_in %d out %d ws %zu\n", ML * DM, (size_t)WS_END, n_in, out_size, ws_size); grid = -1; return; }
        int dev = 0, cus = 0, per_cu = 0;
        if (hipGetDevice(&dev) != hipSuccess || hipDeviceGetAttribute(&cus, hipDeviceAttributeMultiprocessorCount, dev) != hipSuccess) { grid = -1; return; }
        if (hipFuncSetAttribute((const void*)hybrid_fwd, hipFuncAttributeMaxDynamicSharedMemorySize, LDS_BYTES) != hipSuccess) { fprintf(stderr, "kernel_launch: hipFuncSetAttribute failed\n"); grid = -1; return; }
        if (hipOccupancyMaxActiveBlocksPerMultiprocessor(&per_cu, (const void*)hybrid_fwd, 512, LDS_BYTES) != hipSuccess || per_cu < 1) { fprintf(stderr, "kernel_launch: occupancy query says %d blocks per CU\n", per_cu); (void)hipGetLastError(); grid = -1; return; }
        grid = cus;
    }
    if (grid < 0) return;
    if (hipMemsetAsync((char*)d_ws + OFF_BAR, 0, BAR_BYTES, stream) != hipSuccess) { fprintf(stderr, "kernel_launch: memset of the barrier words failed\n"); return; }
    Args a{};
    for (int i = 0; i < 26; ++i) a.in[i] = (const float*)d_in[i];
    a.out = (float*)d_out; a.ws = (unsigned char*)d_ws;
    a.ph_lo = 0; a.ph_hi = NPH;
    void* args[] = {&a};
    const hipError_t e = hipLaunchCooperativeKernel((const void*)hybrid_fwd, dim3(grid), dim3(512), args, LDS_BYTES, stream);
    if (e != hipSuccess) fprintf(stderr, "kernel_launch: cooperative launch failed: %s (grid %d)\n", hipGetErrorString(e), grid);
}
```
